# Optimizing an MI355X kernel written in HIP

```python
import math
import jax, jax.numpy as jnp
from jax import lax
import numpy as np

D_MODEL = 1024
BATCH = 32
SEQ = 2048
DEPTH = 4

CTX_LEN = 256
GRID_W = 64
HEAD_DIM = 64
N_HEADS_A = (D_MODEL // 2) // HEAD_DIM
N_KV_A = N_HEADS_A // 4
GQA_GROUP = N_HEADS_A // N_KV_A
WINDOW = 128
BLOCK = 128
BAND = BLOCK + 2 * WINDOW
CONV_CH = D_MODEL // 4
CONV_W = 3
DIFF_DIM = 32
N_HEADS_C = (D_MODEL // 4) // (2 * DIFF_DIM)
N_EXPERTS = 16
EXPERT_FF = D_MODEL
CAPACITY_FACTOR = 2
ROPE_THETA = 10000.0
EPS = 1e-6
NEG_INF = -1e30

A_Q = N_HEADS_A * HEAD_DIM
A_KV = N_KV_A * HEAD_DIM
C_QK = N_HEADS_C * 2 * DIFF_DIM
C_V = N_HEADS_C * 2 * DIFF_DIM
PROJ_SPLITS = (A_Q, A_KV, A_KV, CONV_CH, CONV_CH, CONV_CH, C_QK, C_QK, C_V)
PROJ_DIM = A_Q + 2 * A_KV + 3 * CONV_CH + 2 * C_QK + C_V
MIX_DIM = A_Q + CONV_CH + C_V

kernel_name = 'hybrid_parallel_heads_ec_moe_dit'


def _rmsnorm(x, g):
    xf = x.astype(jnp.float32)
    y = xf * lax.rsqrt(jnp.mean(xf * xf, axis=-1, keepdims=True) + EPS)
    return (y * g.astype(jnp.float32)).astype(x.dtype)


def _split_proj(p):
    outs, start = [], 0
    for w in PROJ_SPLITS:
        outs.append(p[..., start:start + w])
        start += w
    return outs


def _axial_angles(L, n):
    rows = L // GRID_W
    row = jnp.broadcast_to(jnp.arange(rows, dtype=jnp.float32)[:, None], (rows, GRID_W)).reshape(-1)
    col = jnp.broadcast_to(jnp.arange(GRID_W, dtype=jnp.float32)[None, :], (rows, GRID_W)).reshape(-1)
    inv = ROPE_THETA ** (-jnp.arange(0, n, 2, dtype=jnp.float32) / n)
    return row[:, None] * inv[None, :], col[:, None] * inv[None, :]


def _rotate(x, ang):
    shape = (1, ang.shape[0]) + (1,) * (x.ndim - 3) + (ang.shape[1],)
    cos = jnp.cos(ang).reshape(shape).astype(x.dtype)
    sin = jnp.sin(ang).reshape(shape).astype(x.dtype)
    x1, x2 = jnp.split(x, 2, axis=-1)
    return jnp.concatenate([x1 * cos - x2 * sin, x2 * cos + x1 * sin], axis=-1)


def _rope_2d(x):
    L, d = x.shape[1], x.shape[-1]
    ang_r, ang_c = _axial_angles(L, d // 2)
    xr, xc = jnp.split(x, 2, axis=-1)
    return jnp.concatenate([_rotate(xr, ang_r), _rotate(xc, ang_c)], axis=-1)


def _window_gqa(q, k, v, kc, vc, sink):
    B, L, H, dh = q.shape
    Lc = kc.shape[1]
    nblk = L // BLOCK
    qb = jnp.moveaxis((q * dh ** -0.5).reshape(B, nblk, BLOCK, N_KV_A, GQA_GROUP, dh), 1, 0)
    pad = ((0, 0), (WINDOW, WINDOW), (0, 0), (0, 0))
    kp = jnp.pad(k, pad)
    vp = jnp.pad(v, pad)
    sink_l = jnp.broadcast_to(sink.astype(jnp.float32).reshape(1, N_KV_A, GQA_GROUP, 1, 1),
                              (B, N_KV_A, GQA_GROUP, BLOCK, 1))

    def block(args):
        qi, i = args
        start = i * BLOCK
        kb = lax.dynamic_slice_in_dim(kp, start, BAND, axis=1)
        vb = lax.dynamic_slice_in_dim(vp, start, BAND, axis=1)
        qpos = start + jnp.arange(BLOCK)
        kpos = start - WINDOW + jnp.arange(BAND)
        ok = (jnp.abs(qpos[:, None] - kpos[None, :]) <= WINDOW) & (kpos >= 0)[None, :] & (kpos < L)[None, :]
        s_loc = jnp.einsum('bqkgd,bskd->bkgqs', qi, kb).astype(jnp.float32)
        s_loc = jnp.where(ok, s_loc, NEG_INF)
        s_ctx = jnp.einsum('bqkgd,bckd->bkgqc', qi, kc).astype(jnp.float32)
        p = jax.nn.softmax(jnp.concatenate([s_ctx, s_loc, sink_l], axis=-1), axis=-1).astype(v.dtype)
        return (jnp.einsum('bkgqc,bckd->bqkgd', p[..., :Lc], vc)
                + jnp.einsum('bkgqs,bskd->bqkgd', p[..., Lc:Lc + BAND], vb))

    out = lax.map(block, (qb, jnp.arange(nblk)))
    return jnp.moveaxis(out, 0, 1).reshape(B, L, H * dh)


def _ctx_gqa(qc, kc, vc, sink):
    B, Lc, H, dh = qc.shape
    qg = (qc * dh ** -0.5).reshape(B, Lc, N_KV_A, GQA_GROUP, dh)
    s = jnp.einsum('bqkgd,bckd->bkgqc', qg, kc).astype(jnp.float32)
    sink_l = jnp.broadcast_to(sink.astype(jnp.float32).reshape(1, N_KV_A, GQA_GROUP, 1, 1),
                              (B, N_KV_A, GQA_GROUP, Lc, 1))
    p = jax.nn.softmax(jnp.concatenate([s, sink_l], axis=-1), axis=-1)[..., :Lc].astype(vc.dtype)
    return jnp.einsum('bkgqc,bckd->bqkgd', p, vc).reshape(B, Lc, H * dh)


def _short_conv(h, gb, gc, w):
    L = h.shape[1]
    half = CONV_W // 2
    up = jnp.pad(gc * h, ((0, 0), (half, half), (0, 0)))
    y = sum(up[:, j:j + L] * w[j] for j in range(CONV_W))
    return gb * y


def _diff_weights(qi, K, lam):
    d = qi.shape[-1]
    s = jnp.einsum('bqhjd,bkhjd->bhjqk', qi * d ** -0.5, K).astype(jnp.float32)
    p = jax.nn.softmax(s, axis=-1)
    return p[:, :, 0] - lam * p[:, :, 1]


def _diff_attn_latent(q, k, v, kc, vc, lam):
    B, L, H, _, d = q.shape
    K = jnp.concatenate([kc, k], axis=1)
    V = jnp.concatenate([vc, v], axis=1)
    qb = jnp.moveaxis(q.reshape(B, L // BLOCK, BLOCK, H, 2, d), 1, 0)

    def block(qi):
        a = _diff_weights(qi, K, lam).astype(V.dtype)
        return jnp.einsum('bhqk,bkhe->bqhe', a, V)

    out = lax.map(block, qb)
    return jnp.moveaxis(out, 0, 1).reshape(B, L, H, 2 * d)


def _diff_attn_ctx(qc, kc, vc, lam):
    a = _diff_weights(qc, kc, lam).astype(vc.dtype)
    return jnp.einsum('bhqk,bkhe->bqhe', a, vc)


def _mixer(hx, hc, w_in, w_out, sink, conv_w, lam_p, subln, lam_init, need_ctx):
    B, L, _ = hx.shape
    Lc = hc.shape[1]
    qa, ka, va, cin, cb, cc, qd, kd, vd = _split_proj(hx @ w_in)
    qa_c, ka_c, va_c, cin_c, cb_c, cc_c, qd_c, kd_c, vd_c = _split_proj(hc @ w_in)
    ka_c = ka_c.reshape(B, Lc, N_KV_A, HEAD_DIM)
    va_c = va_c.reshape(B, Lc, N_KV_A, HEAD_DIM)
    ya = _window_gqa(_rope_2d(qa.reshape(B, L, N_HEADS_A, HEAD_DIM)),
                     _rope_2d(ka.reshape(B, L, N_KV_A, HEAD_DIM)),
                     va.reshape(B, L, N_KV_A, HEAD_DIM), ka_c, va_c, sink)
    yb = _short_conv(cin, cb, cc, conv_w)
    lp = lam_p.astype(jnp.float32)
    lam = jnp.exp(jnp.sum(lp[0] * lp[1])) - jnp.exp(jnp.sum(lp[2] * lp[3])) + lam_init
    kd_c = kd_c.reshape(B, Lc, N_HEADS_C, 2, DIFF_DIM)
    vd_c = vd_c.reshape(B, Lc, N_HEADS_C, 2 * DIFF_DIM)
    yd = _diff_attn_latent(_rope_2d(qd.reshape(B, L, N_HEADS_C, 2, DIFF_DIM)),
                           _rope_2d(kd.reshape(B, L, N_HEADS_C, 2, DIFF_DIM)),
                           vd.reshape(B, L, N_HEADS_C, 2 * DIFF_DIM), kd_c, vd_c, lam)
    yd = (_rmsnorm(yd, subln) * (1.0 - lam_init)).reshape(B, L, C_V)
    out_x = jnp.concatenate([ya, yb, yd], axis=-1) @ w_out
    if not need_ctx:
        return out_x, None
    yac = _ctx_gqa(qa_c.reshape(B, Lc, N_HEADS_A, HEAD_DIM), ka_c, va_c, sink)
    ybc = _short_conv(cin_c, cb_c, cc_c, conv_w)
    ydc = _diff_attn_ctx(qd_c.reshape(B, Lc, N_HEADS_C, 2, DIFF_DIM), kd_c, vd_c, lam)
    ydc = (_rmsnorm(ydc, subln) * (1.0 - lam_init)).reshape(B, Lc, C_V)
    out_c = jnp.concatenate([yac, ybc, ydc], axis=-1) @ w_out
    return out_x, out_c


def _ec_moe(h, router, w_gate, w_up, w_down):
    B, n, _ = h.shape
    cap = CAPACITY_FACTOR * n // N_EXPERTS
    aff = jax.nn.softmax((h @ router).astype(jnp.float32), axis=-1)
    g, idx = lax.top_k(jnp.swapaxes(aff, 1, 2), cap)
    bidx = jnp.arange(B)[:, None, None]
    xs = h[bidx, idx]
    a = jnp.einsum('becd,edf->becf', xs, w_gate)
    u = jnp.einsum('becd,edf->becf', xs, w_up)
    y = jnp.einsum('becf,efd->becd', jax.nn.silu(a) * u, w_down) * g[..., None].astype(h.dtype)
    return jnp.zeros_like(h).at[bidx, idx].add(y)


def setup_inputs(seed: int = 0) -> dict:
    key = jax.random.key(seed)
    ks = jax.random.split(key, 20)
    D = D_MODEL
    f32 = jnp.float32

    def nrm(k, shape, s):
        return jax.random.normal(k, shape, f32) * s

    return {
        'x': nrm(ks[0], (BATCH, SEQ, D), 1.0),
        'c': nrm(ks[1], (BATCH, D), 1.0),
        'ctx': nrm(ks[2], (BATCH, CTX_LEN, D), 1.0),
        'c_ctx': nrm(ks[3], (D,), 1.0),
        'w_ada': nrm(ks[4], (DEPTH, D, 6 * D), 0.5 * D ** -0.5),
        'b_ada': nrm(ks[5], (DEPTH, 6 * D), 0.02),
        'norm1': 1.0 + nrm(ks[6], (DEPTH, D), 0.02),
        'norm2': 1.0 + nrm(ks[7], (DEPTH, D), 0.02),
        'w_in': nrm(ks[8], (DEPTH, D, PROJ_DIM), D ** -0.5),
        'w_out': nrm(ks[9], (DEPTH, MIX_DIM, D), MIX_DIM ** -0.5),
        'attn_sink': nrm(ks[10], (DEPTH, N_HEADS_A), 0.5),
        'conv_w': nrm(ks[11], (DEPTH, CONV_W, CONV_CH), CONV_W ** -0.5),
        'diff_lambda': nrm(ks[12], (DEPTH, 4, DIFF_DIM), 0.1),
        'diff_subln': 1.0 + nrm(ks[13], (DEPTH, 2 * DIFF_DIM), 0.02),
        'router': nrm(ks[14], (DEPTH, D, N_EXPERTS), D ** -0.5),
        'w_gate': nrm(ks[15], (DEPTH, N_EXPERTS, D, EXPERT_FF), D ** -0.5),
        'w_up': nrm(ks[16], (DEPTH, N_EXPERTS, D, EXPERT_FF), D ** -0.5),
        'w_down': nrm(ks[17], (DEPTH, N_EXPERTS, EXPERT_FF, D), EXPERT_FF ** -0.5),
        'norm_final': 1.0 + nrm(ks[18], (D,), 0.02),
    }


def reference(x, c, ctx, c_ctx, w_ada, b_ada, norm1, norm2, w_in, w_out, attn_sink, conv_w,
              diff_lambda, diff_subln, router, w_gate, w_up, w_down, norm_final):
    silu_c = jax.nn.silu(c)
    silu_cc = jax.nn.silu(c_ctx)
    for l in range(DEPTH):
        need_ctx = l < DEPTH - 1
        mod_x = silu_c @ w_ada[l] + b_ada[l]
        mod_c = silu_cc @ w_ada[l] + b_ada[l]
        sh1, sc1, g1, sh2, sc2, g2 = jnp.split(mod_x[:, None, :], 6, axis=-1)
        csh1, csc1, cg1, csh2, csc2, cg2 = jnp.split(mod_c, 6, axis=-1)
        lam_init = 0.8 - 0.6 * math.exp(-0.3 * l)
        hx = _rmsnorm(x, norm1[l]) * (1.0 + sc1) + sh1
        hc = _rmsnorm(ctx, norm1[l]) * (1.0 + csc1) + csh1
        ox, oc = _mixer(hx, hc, w_in[l], w_out[l], attn_sink[l], conv_w[l], diff_lambda[l],
                        diff_subln[l], lam_init, need_ctx)
        x = x + g1 * ox
        hx2 = _rmsnorm(x, norm2[l]) * (1.0 + sc2) + sh2
        x = x + g2 * _ec_moe(hx2, router[l], w_gate[l], w_up[l], w_down[l])
        if need_ctx:
            ctx = ctx + cg1 * oc
            hc2 = _rmsnorm(ctx, norm2[l]) * (1.0 + csc2) + csh2
            ctx = ctx + cg2 * _ec_moe(hc2, router[l], w_gate[l], w_up[l], w_down[l])
    return _rmsnorm(x, norm_final)
```

```cpp
#ifndef HOST_TEST
#include <hip/hip_runtime.h>
#endif
#include <cstdio>
#include <cstdint>
#include <cstring>
#include <cmath>

#ifndef CFG_B
#define CFG_B 32
#endif
#ifndef CFG_SEQ
#define CFG_SEQ 2048
#endif
#ifndef CFG_CTX
#define CFG_CTX 256
#endif
#ifndef CFG_DEPTH
#define CFG_DEPTH 4
#endif
constexpr int D = 1024, NB = CFG_B, SEQ = CFG_SEQ, CTX = CFG_CTX, DEPTH = CFG_DEPTH;
constexpr int GRID_W = 64, NROWS = SEQ / GRID_W, HDIM = 64, NHA = 8, NKVA = 2, GQA = 4, WINDOW = 128;
constexpr int CONV_CH = 256, DD = 32, NHC = 4, NE = 16, FF = 1024, PROJ = 2304;
constexpr int RL = NB * SEQ, RC = NB * CTX, RALL = RL + RC;
constexpr int CAPL = 2 * SEQ / NE, CAPC = 2 * CTX / NE;
constexpr int SLOTS_L = NB * CAPL, SLOTS_C = NB * CAPC, SLOTS_E = SLOTS_L + SLOTS_C;
constexpr int NSLOT = NE * SLOTS_E;
constexpr int C_QA = 0, C_KA = 512, C_VA = 640, C_CIN = 768, C_CB = 1024, C_CC = 1280, C_QD = 1536, C_KD = 1792, C_VD = 2048;
constexpr int M_SH1 = 0, M_SC1 = D, M_G1 = 2 * D, M_SH2 = 3 * D, M_SC2 = 4 * D, M_G2 = 5 * D;
constexpr float EPS = 1e-6f;

#ifdef HOST_TEST
#define HD
#define KERNEL static void
static thread_local long g_gid;
#define GID g_gid
#include <omp.h>
#define LAUNCH(kern, nthreads, ...) do { const long _n = (long)(nthreads); _Pragma("omp parallel for schedule(static)") for (long _g = 0; _g < _n; ++_g) { g_gid = _g; kern(__VA_ARGS__); } } while (0)
#else
#define HD __host__ __device__ __forceinline__
#define KERNEL __global__ void __launch_bounds__(256)
#define GID ((long)blockIdx.x * blockDim.x + threadIdx.x)
#define LAUNCH(kern, nthreads, ...) do { const long _n = (long)(nthreads); if (_n > 0) hipLaunchKernelGGL(kern, dim3((unsigned)((_n + 255) / 256)), dim3(256), 0, stream, __VA_ARGS__); } while (0)
#endif

typedef unsigned short bf16_t;
HD float bf2f(bf16_t v) { unsigned u = (unsigned)v << 16; return __builtin_bit_cast(float, u); }
HD bf16_t f2bf(float f) { unsigned u = __builtin_bit_cast(unsigned, f); return (bf16_t)((u + 0x7fffu + ((u >> 16) & 1u)) >> 16); }

constexpr size_t al256(size_t x) { return (x + 255) & ~(size_t)255; }
constexpr size_t WS_CTL = 0, CTL_BYTES = 1u << 20;
constexpr size_t WS_TAB = WS_CTL + CTL_BYTES;
constexpr int T_AROW = 0, T_ACOL = T_AROW + NROWS * 16 * 2, T_DROW = T_ACOL + 64 * 16 * 2, T_DCOL = T_DROW + NROWS * 8 * 2, T_END = T_DCOL + 64 * 8 * 2;
constexpr size_t WS_SILU = WS_TAB + al256((size_t)T_END * 4);
constexpr size_t WS_MOD = WS_SILU + al256((size_t)(NB + 1) * D * 4);
constexpr size_t WS_RSTD = WS_MOD + al256((size_t)DEPTH * (NB + 1) * 6 * D * 4);
constexpr size_t WS_AFF = WS_RSTD + al256((size_t)RALL * 4);
constexpr size_t WS_SEL = WS_AFF + al256((size_t)RALL * NE * 4);
constexpr size_t WS_GATE = WS_SEL + al256((size_t)NSLOT * 4);
constexpr size_t WS_TOKSLOT = WS_GATE + al256((size_t)NSLOT * 4);
constexpr size_t WS_XC = WS_TOKSLOT + al256((size_t)RALL * NE * 4);
constexpr size_t WS_WIN = WS_XC + al256((size_t)RC * D * 4);
constexpr size_t WS_WOUT = WS_WIN + al256((size_t)DEPTH * PROJ * D * 2);
constexpr size_t WS_WGU = WS_WOUT + al256((size_t)DEPTH * D * D * 2);
constexpr size_t WS_WD = WS_WGU + al256((size_t)2 * NE * 2 * FF * D * 2);
constexpr size_t WS_R1 = WS_WD + al256((size_t)2 * NE * D * FF * 2);
constexpr size_t R1_BYTES = al256(((size_t)RALL * PROJ * 2 > (size_t)NSLOT * FF * 2) ? (size_t)RALL * PROJ * 2 : (size_t)NSLOT * FF * 2);
constexpr size_t WS_R2 = WS_R1 + R1_BYTES;
constexpr size_t R2_BYTES = al256(((size_t)NSLOT * D * 2 > (size_t)2 * RALL * D * 2) ? (size_t)NSLOT * D * 2 : (size_t)2 * RALL * D * 2);
constexpr size_t WS_R3 = WS_R2 + R2_BYTES;
constexpr size_t WS_END = WS_R3 + al256((size_t)RALL * D * 2);

struct Ptrs {
    const float *x, *c, *ctx, *c_ctx, *w_ada, *b_ada, *norm1, *norm2, *w_in, *w_out, *attn_sink, *conv_w, *diff_lambda, *diff_subln, *router, *w_gate, *w_up, *w_down, *norm_final;
    float* out; unsigned char* ws;
};

HD float* xrow_ptr(float* xl, float* xc, int row) { return row < RL ? xl + (size_t)row * D : xc + (size_t)(row - RL) * D; }
HD int row_batch(int row) { return row < RL ? row / SEQ : NB; }
HD float silu_f(float v) { return v / (1.0f + expf(-v)); }

KERNEL k_tables(float* tab) {
    const long g = GID; if (g >= (long)(NROWS + 64) * 24) return;
    const int pos = (int)(g / 24), f = (int)(g % 24);
    const double inv = f < 16 ? pow(10000.0, -(2.0 * f) / 32.0) : pow(10000.0, -(2.0 * (f - 16)) / 16.0);
    const bool isrow = pos < NROWS; const int p = isrow ? pos : pos - NROWS;
    const double ang = (double)p * inv; const float cs = (float)cos(ang), sn = (float)sin(ang);
    int idx;
    if (f < 16) idx = (isrow ? T_AROW : T_ACOL) + (p * 16 + f) * 2; else idx = (isrow ? T_DROW : T_DCOL) + (p * 8 + (f - 16)) * 2;
    tab[idx] = cs; tab[idx + 1] = sn;
}
KERNEL k_silu(const float* c, const float* c_ctx, float* out) {
    const long g = GID; if (g >= (long)(NB + 1) * D) return;
    const int b = (int)(g / D), k = (int)(g % D); const float v = b < NB ? c[b * D + k] : c_ctx[k];
    out[g] = silu_f(v);
}
KERNEL k_mod(const float* silu, const float* w_ada, const float* b_ada, float* mod) {
    const long g = GID; if (g >= (long)DEPTH * 6 * D) return;
    const int l = (int)(g / (6 * D)), j = (int)(g % (6 * D));
    float acc[NB + 1];
#pragma unroll
    for (int b = 0; b <= NB; ++b) acc[b] = 0.f;
    const float* w = w_ada + (size_t)l * D * 6 * D + j;
    for (int k = 0; k < D; ++k) { const float wv = w[(size_t)k * 6 * D];
#pragma unroll
        for (int b = 0; b <= NB; ++b) acc[b] += silu[b * D + k] * wv; }
    const float bias = b_ada[l * 6 * D + j];
#pragma unroll
    for (int b = 0; b <= NB; ++b) mod[((size_t)l * (NB + 1) + b) * 6 * D + j] = acc[b] + bias;
}
HD int permA(int p) { return (p / 32) * 32 + (p % 32) / 2 + 16 * (p % 2); }
HD int permD(int p) { return (p / 16) * 16 + (p % 16) / 2 + 8 * (p % 2); }
HD int inproj_src_col(int n) {
    if (n < C_VA) return (n / 64) * 64 + permA(n % 64);
    if (n < C_QD) return n;
    if (n < C_VD) return (n / 32) * 32 + permD(n % 32);
    return n;
}
KERNEL k_cvt_win(const float* w_in, bf16_t* wt) {
    const long g = GID; if (g >= (long)DEPTH * PROJ * D) return;
    const int k = (int)(g % D); const int n = (int)((g / D) % PROJ); const int l = (int)(g / ((long)D * PROJ));
    wt[g] = f2bf(w_in[((size_t)l * D + k) * PROJ + inproj_src_col(n)]);
}
KERNEL k_cvt_t(const float* w, bf16_t* wt, int nmat, int K, int N) {
    const long g = GID; if (g >= (long)nmat * K * N) return;
    const int k = (int)(g % K); const int n = (int)((g / K) % N); const int m = (int)(g / ((long)K * N));
    wt[g] = f2bf(w[((size_t)m * K + k) * N + n]);
}
KERNEL k_cvt_gu(const float* wg, const float* wu, bf16_t* wt) {
    const long g = GID; if (g >= (long)NE * 2 * FF * D) return;
    const int k = (int)(g % D); const int n = (int)((g / D) % (2 * FF)); const int e = (int)(g / ((long)D * 2 * FF));
    const int blk = n / 256, bj = (n % 256) / 128, j = n % 128; const float* src = bj ? wu : wg;
    wt[g] = f2bf(src[((size_t)e * D + k) * FF + blk * 128 + j]);
}
KERNEL k_rowstat(const float* xl, const float* xc, float* rstd, int nrows) {
    const long g = GID; if (g >= nrows) return;
    const float* xr = xrow_ptr((float*)xl, (float*)xc, (int)g); float s = 0.f;
    for (int k = 0; k < D; ++k) s += xr[k] * xr[k];
    rstd[g] = 1.0f / sqrtf(s / D + EPS);
}
KERNEL k_rowapply(const float* xl, const float* xc, const float* rstd, const float* nw, const float* modl, int sh_off, int sc_off, bf16_t* hx, int nrows) {
    const long g = GID; if (g >= (long)nrows * D) return;
    const int row = (int)(g / D), k = (int)(g % D); const float* xr = xrow_ptr((float*)xl, (float*)xc, row);
    const float* m = modl + (size_t)row_batch(row) * 6 * D;
    const float v = xr[k] * rstd[row] * nw[k] * (1.0f + m[sc_off + k]) + m[sh_off + k];
    hx[g] = f2bf(v);
}
struct EpiInProj {
    bf16_t* P; const float* tab;
    HD void operator()(int row, int c0, const float* v, const float*) const {
        float o[4] = {v[0], v[1], v[2], v[3]};
        const bool lat = row < RL; const int pos = lat ? row % SEQ : 0; const int gr = pos / GRID_W, gc = pos % GRID_W;
        if (c0 < C_VA) {
            if (lat) { const int p = c0 % 64, grp = p / 32, i0 = (p % 32) / 2;
                const float* t = tab + (grp == 0 ? T_AROW + gr * 32 : T_ACOL + gc * 32) + i0 * 2;
                const float a0 = o[0], b0 = o[1], a1 = o[2], b1 = o[3];
                o[0] = a0 * t[0] - b0 * t[1]; o[1] = b0 * t[0] + a0 * t[1]; o[2] = a1 * t[2] - b1 * t[3]; o[3] = b1 * t[2] + a1 * t[3]; }
            if (c0 < C_KA) { for (int j = 0; j < 4; ++j) o[j] *= 0.125f; }
        } else if (c0 >= C_QD && c0 < C_VD) {
            if (lat) { const int p = c0 % 32, grp = p / 16, i0 = (p % 16) / 2;
                const float* t = tab + (grp == 0 ? T_DROW + gr * 16 : T_DCOL + gc * 16) + i0 * 2;
                const float a0 = o[0], b0 = o[1], a1 = o[2], b1 = o[3];
                o[0] = a0 * t[0] - b0 * t[1]; o[1] = b0 * t[0] + a0 * t[1]; o[2] = a1 * t[2] - b1 * t[3]; o[3] = b1 * t[2] + a1 * t[3]; }
            if (c0 < C_KD) { for (int j = 0; j < 4; ++j) o[j] *= 0.17677669529663687f; }
        }
        bf16_t* d = P + (size_t)row * PROJ + c0;
        for (int j = 0; j < 4; ++j) d[j] = f2bf(o[j]);
    }
};
struct EpiOutProj {
    float* xl; float* xc; const float* modl;
    HD void operator()(int row, int c0, const float* v, const float*) const {
        float* xr = xrow_ptr(xl, xc, row) + c0; const float* g1 = modl + (size_t)row_batch(row) * 6 * D + M_G1 + c0;
        for (int j = 0; j < 4; ++j) xr[j] += g1[j] * v[j];
    }
};
struct EpiGateUp {
    bf16_t* H;
    HD void operator()(int row, int c0, const float* v, const float* u) const {
        bf16_t* d = H + (size_t)row * FF + c0;
        for (int j = 0; j < 4; ++j) d[j] = f2bf(silu_f(v[j]) * u[j]);
    }
};
struct EpiDown {
    bf16_t* Y; const float* gate;
    HD void operator()(int row, int c0, const float* v, const float*) const {
        const float g = gate[row]; bf16_t* d = Y + (size_t)row * D + c0;
        for (int j = 0; j < 4; ++j) d[j] = f2bf(v[j] * g);
    }
};
template <class Epi, bool DUAL>
KERNEL k_gemm_naive(const bf16_t* A, const int* rowidx, const bf16_t* Bt, int M, int N, int K, int group_rows, int valid_rows, long bstride, Epi epi) {
    const long g = GID; if (g >= (long)M * (N / 4)) return;
    const int row = (int)(g / (N / 4)), c0 = (int)(g % (N / 4)) * 4;
    if (row % group_rows >= valid_rows) return;
    const int arow = rowidx ? rowidx[row] : row;
    const bf16_t* a = A + (size_t)arow * K; const bf16_t* B = Bt + (size_t)(row / group_rows) * bstride;
    float v[4], u[4];
    for (int j = 0; j < 4; ++j) { const int c = c0 + j; const int br = DUAL ? (c / 128) * 256 + c % 128 : c;
        const bf16_t* b0 = B + (size_t)br * K; float s = 0.f, s2 = 0.f;
        for (int k = 0; k < K; ++k) s += bf2f(a[k]) * bf2f(b0[k]);
        if (DUAL) { const bf16_t* b1 = b0 + (size_t)128 * K; for (int k = 0; k < K; ++k) s2 += bf2f(a[k]) * bf2f(b1[k]); }
        v[j] = s; u[j] = s2; }
    epi(row, c0, v, u);
}
KERNEL k_attnA(const bf16_t* P, const float* sink, bf16_t* MIX, int nrows) {
    const long g = GID; if (g >= (long)nrows * NHA) return;
    const int h = (int)(g / nrows), row = (int)(g % nrows), kvh = h / GQA;
    const bool lat = row < RL; const int b = lat ? row / SEQ : (row - RL) / CTX; const int t = lat ? row % SEQ : 0;
    float q[HDIM], o[HDIM];
    const bf16_t* qp = P + (size_t)row * PROJ + C_QA + h * HDIM;
#pragma unroll
    for (int d = 0; d < HDIM; ++d) { q[d] = bf2f(qp[d]); o[d] = 0.f; }
    float m = sink[h], l = 1.0f;
    const int nctx = CTX, lo = lat ? (t - WINDOW < 0 ? 0 : t - WINDOW) : 0, hi = lat ? (t + WINDOW > SEQ - 1 ? SEQ - 1 : t + WINDOW) : -1;
    const int nkeys = nctx + (hi - lo + 1);
    for (int i = 0; i < nkeys; ++i) {
        const int krow = i < nctx ? RL + b * CTX + i : b * SEQ + lo + (i - nctx);
        const bf16_t* kp = P + (size_t)krow * PROJ + C_KA + kvh * HDIM; const bf16_t* vp = P + (size_t)krow * PROJ + C_VA + kvh * HDIM;
        float s = 0.f;
#pragma unroll
        for (int d = 0; d < HDIM; ++d) s += q[d] * bf2f(kp[d]);
        if (s > m) { const float sc = expf(m - s); l *= sc;
#pragma unroll
            for (int d = 0; d < HDIM; ++d) o[d] *= sc;
            m = s; }
        const float p = expf(s - m); l += p;
#pragma unroll
        for (int d = 0; d < HDIM; ++d) o[d] += p * bf2f(vp[d]);
    }
    const float inv = 1.0f / l; bf16_t* op = MIX + (size_t)row * D + h * HDIM;
#pragma unroll
    for (int d = 0; d < HDIM; ++d) op[d] = f2bf(o[d] * inv);
}
KERNEL k_attnD(const bf16_t* P, float* TMP, int nrows) {
    const long g = GID; if (g >= (long)nrows * NHC * 2) return;
    const int hc = (int)(g / nrows), row = (int)(g % nrows), h = hc / 2, comp = hc % 2;
    const bool lat = row < RL; const int b = lat ? row / SEQ : (row - RL) / CTX;
    float q[DD], o[2 * DD];
    const bf16_t* qp = P + (size_t)row * PROJ + C_QD + h * 2 * DD + comp * DD;
#pragma unroll
    for (int d = 0; d < DD; ++d) q[d] = bf2f(qp[d]);
#pragma unroll
    for (int d = 0; d < 2 * DD; ++d) o[d] = 0.f;
    float m = -1e30f, l = 0.f;
    const int nkeys = CTX + (lat ? SEQ : 0);
    for (int i = 0; i < nkeys; ++i) {
        const int krow = i < CTX ? RL + b * CTX + i : b * SEQ + (i - CTX);
        const bf16_t* kp = P + (size_t)krow * PROJ + C_KD + h * 2 * DD + comp * DD; const bf16_t* vp = P + (size_t)krow * PROJ + C_VD + h * 2 * DD;
        float s = 0.f;
#pragma unroll
        for (int d = 0; d < DD; ++d) s += q[d] * bf2f(kp[d]);
        if (s > m) { const float sc = expf(m - s); l *= sc;
#pragma unroll
            for (int d = 0; d < 2 * DD; ++d) o[d] *= sc;
            m = s; }
        const float p = expf(s - m); l += p;
#pragma unroll
        for (int d = 0; d < 2 * DD; ++d) o[d] += p * bf2f(vp[d]);
    }
    const float inv = 1.0f / l; float* op = TMP + (((size_t)row * NHC + h) * 2 + comp) * 2 * DD;
#pragma unroll
    for (int d = 0; d < 2 * DD; ++d) op[d] = o[d] * inv;
}
KERNEL k_diffpost(const float* TMP, const float* lam_p, const float* subln, float lam_init, bf16_t* MIX, int nrows) {
    const long g = GID; if (g >= (long)nrows * NHC) return;
    const int row = (int)(g / NHC), h = (int)(g % NHC);
    float s01 = 0.f, s23 = 0.f;
    for (int d = 0; d < DD; ++d) { s01 += lam_p[d] * lam_p[DD + d]; s23 += lam_p[2 * DD + d] * lam_p[3 * DD + d]; }
    const float lam = expf(s01) - expf(s23) + lam_init;
    const float* t = TMP + ((size_t)row * NHC + h) * 2 * 2 * DD; float y[2 * DD]; float ss = 0.f;
#pragma unroll
    for (int d = 0; d < 2 * DD; ++d) { y[d] = t[d] - lam * t[2 * DD + d]; ss += y[d] * y[d]; }
    const float r = 1.0f / sqrtf(ss / (2 * DD) + EPS) * (1.0f - lam_init);
    bf16_t* op = MIX + (size_t)row * D + 768 + h * 2 * DD;
#pragma unroll
    for (int d = 0; d < 2 * DD; ++d) op[d] = f2bf(y[d] * r * subln[d]);
}
KERNEL k_conv(const bf16_t* P, const float* cw, bf16_t* MIX, int nrows) {
    const long g = GID; if (g >= (long)nrows * CONV_CH) return;
    const int row = (int)(g / CONV_CH), ch = (int)(g % CONV_CH);
    const bool lat = row < RL; const int t = lat ? row % SEQ : (row - RL) % CTX, len = lat ? SEQ : CTX;
    float y = 0.f;
    for (int j = 0; j < 3; ++j) { const int tt = t + j - 1; if (tt < 0 || tt >= len) continue;
        const bf16_t* pr = P + (size_t)(row + j - 1) * PROJ; y += cw[j * CONV_CH + ch] * (bf2f(pr[C_CC + ch]) * bf2f(pr[C_CIN + ch])); }
    MIX[(size_t)row * D + 512 + ch] = f2bf(bf2f(P[(size_t)row * PROJ + C_CB + ch]) * y);
}
KERNEL k_router(const float* xl, const float* xc, const float* rstd, const float* nw, const float* modl, const float* router, float* logits, int nrows) {
    const long g = GID; if (g >= (long)nrows * NE) return;
    const int row = (int)(g / NE), e = (int)(g % NE); const float* xr = xrow_ptr((float*)xl, (float*)xc, row);
    const float* m = modl + (size_t)row_batch(row) * 6 * D; const float rs = rstd[row]; float s = 0.f;
    for (int k = 0; k < D; ++k) { const float v = xr[k] * rs * nw[k] * (1.0f + m[M_SC2 + k]) + m[M_SH2 + k]; s += v * router[k * NE + e]; }
    logits[g] = s;
}
KERNEL k_aff(float* aff, int nrows) {
    const long g = GID; if (g >= nrows) return;
    float* a = aff + (size_t)g * NE; float m = a[0];
    for (int e = 1; e < NE; ++e) m = a[e] > m ? a[e] : m;
    float s = 0.f; float ex[NE];
#pragma unroll
    for (int e = 0; e < NE; ++e) { ex[e] = expf(a[e] - m); s += ex[e]; }
#pragma unroll
    for (int e = 0; e < NE; ++e) a[e] = ex[e] / s;
}
KERNEL k_select(const float* aff, int* sel, float* gate, int* tokslot, int nrows) {
    const long g = GID; if (g >= (long)nrows * NE) return;
    const int row = (int)(g / NE), e = (int)(g % NE);
    const bool lat = row < RL; const int b = lat ? row / SEQ : (row - RL) / CTX; const int t = lat ? row % SEQ : (row - RL) % CTX;
    const int n = lat ? SEQ : CTX, cap = lat ? CAPL : CAPC, base = lat ? b * SEQ : RL + b * CTX;
    const float a = aff[(size_t)row * NE + e]; int rank = 0;
    for (int j = 0; j < n; ++j) { const float o = aff[(size_t)(base + j) * NE + e]; rank += (o > a || (o == a && j < t)) ? 1 : 0; }
    int slot = -1;
    if (rank < cap) { slot = e * SLOTS_E + (lat ? b * CAPL + rank : SLOTS_L + b * CAPC + rank); sel[slot] = row; gate[slot] = a; }
    tokslot[g] = slot;
}
KERNEL k_combine(float* xl, float* xc, const bf16_t* Y, const int* tokslot, const float* modl, int nrows) {
    const long g = GID; if (g >= (long)nrows * D) return;
    const int row = (int)(g / D), k = (int)(g % D); float s = 0.f;
    for (int e = 0; e < NE; ++e) { const int sl = tokslot[(size_t)row * NE + e]; if (sl >= 0) s += bf2f(Y[(size_t)sl * D + k]); }
    float* xr = xrow_ptr(xl, xc, row); xr[k] += modl[(size_t)row_batch(row) * 6 * D + M_G2 + k] * s;
}
KERNEL k_final(float* xl, const float* rstd, const float* nw) {
    const long g = GID; if (g >= (long)RL * D) return;
    const int row = (int)(g / D), k = (int)(g % D); xl[g] = xl[g] * rstd[row] * nw[k];
}

#ifndef HOST_TEST
typedef short bf16x8 __attribute__((ext_vector_type(8)));
typedef float f32x4 __attribute__((ext_vector_type(4)));
template <class Epi, bool DUAL>
__global__ void __launch_bounds__(256) k_gemm_mfma(const bf16_t* __restrict__ A, const int* __restrict__ rowidx, const bf16_t* __restrict__ Bt, int M, int N, int K, int group_rows, int valid_rows, long bstride, Epi epi) {
    const int tid = threadIdx.x, wid = tid >> 6, lane = tid & 63, fr = lane & 15, fq = lane >> 4, wr = wid >> 1, wc = wid & 1;
    const int row0 = blockIdx.y * 128 + wr * 64;
    if ((blockIdx.y * 128) % group_rows >= valid_rows) return;
    const bf16_t* B = Bt + (size_t)((blockIdx.y * 128) / group_rows) * bstride;
    int brow[4], ocol[4];
    if (!DUAL) { for (int i = 0; i < 4; ++i) { brow[i] = blockIdx.x * 128 + wc * 64 + i * 16; ocol[i] = brow[i]; } }
    else { const int hc0 = blockIdx.x * 64 + wc * 32;
        for (int i = 0; i < 2; ++i) { ocol[i] = hc0 + i * 16; brow[i] = (ocol[i] / 128) * 256 + ocol[i] % 128; brow[i + 2] = brow[i] + 128; ocol[i + 2] = ocol[i]; } }
    const bf16_t* ap[4]; const bf16_t* bp[4];
#pragma unroll
    for (int m = 0; m < 4; ++m) { const int r = row0 + m * 16 + fr; const int ar = rowidx ? rowidx[r] : r; ap[m] = A + (size_t)ar * K + fq * 8; }
#pragma unroll
    for (int i = 0; i < 4; ++i) bp[i] = B + (size_t)(brow[i] + fr) * K + fq * 8;
    f32x4 acc[4][4];
#pragma unroll
    for (int m = 0; m < 4; ++m)
#pragma unroll
        for (int i = 0; i < 4; ++i) acc[m][i] = (f32x4){0.f, 0.f, 0.f, 0.f};
    for (int k0 = 0; k0 < K; k0 += 32) {
        bf16x8 af[4], bfr[4];
#pragma unroll
        for (int m = 0; m < 4; ++m) af[m] = *(const bf16x8*)(ap[m] + k0);
#pragma unroll
        for (int i = 0; i < 4; ++i) bfr[i] = *(const bf16x8*)(bp[i] + k0);
#pragma unroll
        for (int m = 0; m < 4; ++m)
#pragma unroll
            for (int i = 0; i < 4; ++i) acc[m][i] = __builtin_amdgcn_mfma_f32_16x16x32_bf16(bfr[i], af[m], acc[m][i], 0, 0, 0);
    }
#pragma unroll
    for (int m = 0; m < 4; ++m) { const int r = row0 + m * 16 + fr;
#pragma unroll
        for (int i = 0; i < (DUAL ? 2 : 4); ++i) {
            float v[4] = {acc[m][i][0], acc[m][i][1], acc[m][i][2], acc[m][i][3]};
            float u[4] = {acc[m][DUAL ? i + 2 : i][0], acc[m][DUAL ? i + 2 : i][1], acc[m][DUAL ? i + 2 : i][2], acc[m][DUAL ? i + 2 : i][3]};
            epi(r, ocol[i] + 4 * fq, v, u); } }
}
template <class Epi, bool DUAL>
static void launch_gemm(hipStream_t stream, const bf16_t* A, const int* rowidx, const bf16_t* Bt, int M, int N, int K, int group_rows, int valid_rows, long bstride, Epi epi) {
    dim3 grid(DUAL ? N / 64 : N / 128, M / 128);
    hipLaunchKernelGGL((k_gemm_mfma<Epi, DUAL>), grid, dim3(256), 0, stream, A, rowidx, Bt, M, N, K, group_rows, valid_rows, bstride, epi);
}
#define GEMM(Epi, DUAL, ...) launch_gemm<Epi, DUAL>(stream, __VA_ARGS__)
#else
#define GEMM(Epi, DUAL, A, rowidx, Bt, M, N, K, gr, vr, bs, epi) LAUNCH((k_gemm_naive<Epi, DUAL>), (long)(M) * ((N) / 4), A, rowidx, Bt, M, N, K, gr, vr, bs, epi)
#endif

#ifdef HOST_TEST
typedef int hipStream_t;
#endif
static void forward(const Ptrs& p, hipStream_t stream) {
    (void)stream;
    unsigned char* ws = p.ws;
    float* tab = (float*)(ws + WS_TAB); float* silu = (float*)(ws + WS_SILU); float* mod = (float*)(ws + WS_MOD); float* rstd = (float*)(ws + WS_RSTD);
    float* aff = (float*)(ws + WS_AFF); int* sel = (int*)(ws + WS_SEL); float* gate = (float*)(ws + WS_GATE); int* tokslot = (int*)(ws + WS_TOKSLOT);
    float* xc = (float*)(ws + WS_XC); float* xl = p.out;
    bf16_t* win = (bf16_t*)(ws + WS_WIN); bf16_t* wout = (bf16_t*)(ws + WS_WOUT);
    bf16_t* P = (bf16_t*)(ws + WS_R1); bf16_t* H = (bf16_t*)(ws + WS_R1);
    bf16_t* Y = (bf16_t*)(ws + WS_R2); bf16_t* MIX = (bf16_t*)(ws + WS_R2); bf16_t* HX2 = (bf16_t*)(ws + WS_R2 + (size_t)RALL * D * 2); float* TMP = (float*)HX2;
    bf16_t* HX = (bf16_t*)(ws + WS_R3);
    LAUNCH(k_tables, (long)(NROWS + 64) * 24, tab);
    LAUNCH(k_silu, (long)(NB + 1) * D, p.c, p.c_ctx, silu);
    LAUNCH(k_mod, (long)DEPTH * 6 * D, silu, p.w_ada, p.b_ada, mod);
    LAUNCH(k_cvt_win, (long)DEPTH * PROJ * D, p.w_in, win);
    LAUNCH(k_cvt_t, (long)DEPTH * D * D, p.w_out, wout, DEPTH, D, D);
#ifdef HOST_TEST
    memcpy(xl, p.x, (size_t)RL * D * 4); memcpy(xc, p.ctx, (size_t)RC * D * 4);
#else
    (void)hipMemcpyAsync(xl, p.x, (size_t)RL * D * 4, hipMemcpyDeviceToDevice, stream);
    (void)hipMemcpyAsync(xc, p.ctx, (size_t)RC * D * 4, hipMemcpyDeviceToDevice, stream);
#endif
    for (int l = 0; l < DEPTH; ++l) {
        const bool need_ctx = l < DEPTH - 1; const int nq = need_ctx ? RALL : RL;
        const float* modl = mod + (size_t)l * (NB + 1) * 6 * D; const float lam_init = 0.8f - 0.6f * expf(-0.3f * (float)l);
        bf16_t* wgu = (bf16_t*)(ws + WS_WGU) + (size_t)(l & 1) * NE * 2 * FF * D; bf16_t* wd = (bf16_t*)(ws + WS_WD) + (size_t)(l & 1) * NE * D * FF;
        LAUNCH(k_cvt_gu, (long)NE * 2 * FF * D, p.w_gate + (size_t)l * NE * D * FF, p.w_up + (size_t)l * NE * D * FF, wgu);
        LAUNCH(k_cvt_t, (long)NE * FF * D, p.w_down + (size_t)l * NE * FF * D, wd, NE, FF, D);
        LAUNCH(k_rowstat, RALL, xl, xc, rstd, RALL);
        LAUNCH(k_rowapply, (long)RALL * D, xl, xc, rstd, p.norm1 + l * D, modl, M_SH1, M_SC1, HX, RALL);
        GEMM(EpiInProj, false, HX, (const int*)nullptr, win + (size_t)l * PROJ * D, RALL, PROJ, D, RALL, RALL, 0L, (EpiInProj{P, tab}));
        LAUNCH(k_attnA, (long)nq * NHA, P, p.attn_sink + l * NHA, MIX, nq);
        LAUNCH(k_attnD, (long)nq * NHC * 2, P, TMP, nq);
        LAUNCH(k_diffpost, (long)nq * NHC, TMP, p.diff_lambda + l * 4 * DD, p.diff_subln + l * 2 * DD, lam_init, MIX, nq);
        LAUNCH(k_conv, (long)nq * CONV_CH, P, p.conv_w + l * 3 * CONV_CH, MIX, nq);
        GEMM(EpiOutProj, false, MIX, (const int*)nullptr, wout + (size_t)l * D * D, nq, D, D, nq, nq, 0L, (EpiOutProj{xl, xc, modl}));
        LAUNCH(k_rowstat, nq, xl, xc, rstd, nq);
        LAUNCH(k_rowapply, (long)nq * D, xl, xc, rstd, p.norm2 + l * D, modl, M_SH2, M_SC2, HX2, nq);
        LAUNCH(k_router, (long)nq * NE, xl, xc, rstd, p.norm2 + l * D, modl, p.router + (size_t)l * D * NE, aff, nq);
        LAUNCH(k_aff, nq, aff, nq);
        LAUNCH(k_select, (long)nq * NE, aff, sel, gate, tokslot, nq);
        const int vr = need_ctx ? SLOTS_E : SLOTS_L;
        GEMM(EpiGateUp, true, HX2, sel, wgu, NSLOT, FF, D, SLOTS_E, vr, (long)2 * FF * D, (EpiGateUp{H}));
        GEMM(EpiDown, false, H, (const int*)nullptr, wd, NSLOT, D, FF, SLOTS_E, vr, (long)D * FF, (EpiDown{Y, gate}));
        LAUNCH(k_combine, (long)nq * D, xl, xc, Y, tokslot, modl, nq);
    }
    LAUNCH(k_rowstat, RL, xl, xc, rstd, RL);
    LAUNCH(k_final, (long)RL * D, xl, rstd, p.norm_final);
}

#ifndef HOST_TEST
extern "C" void kernel_launch(void* const* d_in, const int* in_sizes, int n_in, void* d_out, int out_size, void* d_ws, size_t ws_size, hipStream_t stream) {
    if (n_in != 19 || out_size != RL * D || ws_size < WS_END) { fprintf(stderr, "kernel_launch: unexpected shapes (n_in %d out %d ws %zu need %zu)\n", n_in, out_size, ws_size, (size_t)WS_END); return; }
    Ptrs p{};
    const float** f = (const float**)&p;
    for (int i = 0; i < 19; ++i) f[i] = (const float*)d_in[i];
    p.out = (float*)d_out; p.ws = (unsigned char*)d_ws;
    forward(p, stream);
}
#else
#include <vector>
#include <string>
static std::vector<float> rd(const std::string& fn) { FILE* f = fopen(fn.c_str(), "rb"); if (!f) { perror(fn.c_str()); exit(1); } fseek(f, 0, SEEK_END); long n = ftell(f); fseek(f, 0, SEEK_SET); std::vector<float> v(n / 4); if (fread(v.data(), 1, n, f) != (size_t)n) exit(1); fclose(f); return v; }
int main(int argc, char** argv) {
    std::string dir = argv[1]; std::vector<std::vector<float>> in(19);
    for (int i = 0; i < 19; ++i) in[i] = rd(dir + "/in" + std::to_string(i) + ".bin");
    std::vector<float> out((size_t)RL * D); std::vector<unsigned char> ws(WS_END, 0xAA);
    Ptrs p{}; const float** f = (const float**)&p; for (int i = 0; i < 19; ++i) f[i] = in[i].data();
    p.out = out.data(); p.ws = ws.data();
    forward(p, 0);
    FILE* fo = fopen((dir + "/out.bin").c_str(), "wb"); fwrite(out.data(), 4, out.size(), fo); fclose(fo);
    printf("done, ws bytes %zu\n", (size_t)WS_END); return 0;
}
#endif
```

```cpp
#ifndef HOST_TEST
#include <hip/hip_runtime.h>
#endif
#include <cstdio>
#include <cstdint>
#include <cstring>
#include <cmath>

#ifndef CFG_B
#define CFG_B 32
#endif
#ifndef CFG_SEQ
#define CFG_SEQ 2048
#endif
#ifndef CFG_CTX
#define CFG_CTX 256
#endif
#ifndef CFG_DEPTH
#define CFG_DEPTH 4
#endif
constexpr int D = 1024, NB = CFG_B, SEQ = CFG_SEQ, CTX = CFG_CTX, DEPTH = CFG_DEPTH;
constexpr int GRID_W = 64, NROWS = SEQ / GRID_W, HDIM = 64, NHA = 8, NKVA = 2, GQA = 4, WINDOW = 128;
constexpr int CONV_CH = 256, DD = 32, NHC = 4, NE = 16, FF = 1024, PROJ = 2304;
constexpr int RL = NB * SEQ, RC = NB * CTX, RALL = RL + RC;
constexpr int CAPL = 2 * SEQ / NE, CAPC = 2 * CTX / NE;
constexpr int SLOTS_L = NB * CAPL, SLOTS_C = NB * CAPC, SLOTS_E = SLOTS_L + SLOTS_C;
constexpr int NSLOT = NE * SLOTS_E;
constexpr int C_QA = 0, C_KA = 512, C_VA = 640, C_CIN = 768, C_CB = 1024, C_CC = 1280, C_QD = 1536, C_KD = 1792, C_VD = 2048;
constexpr int M_SH1 = 0, M_SC1 = D, M_G1 = 2 * D, M_SH2 = 3 * D, M_SC2 = 4 * D, M_G2 = 5 * D;
constexpr float EPS = 1e-6f, LOG2E = 1.4426950408889634f;
constexpr float QSCALE_A = 0.125f * LOG2E, QSCALE_D = 0.17677669529663687f * LOG2E;

#ifdef HOST_TEST
#define HD
#define KERNEL static void
static thread_local long g_gid;
#define GID g_gid
#include <omp.h>
#define LAUNCH(kern, nthreads, ...) do { const long _n = (long)(nthreads); _Pragma("omp parallel for schedule(static)") for (long _g = 0; _g < _n; ++_g) { g_gid = _g; kern(__VA_ARGS__); } } while (0)
#else
#define HD __host__ __device__ __forceinline__
#define KERNEL __global__ void __launch_bounds__(256)
#define GID ((long)blockIdx.x * blockDim.x + threadIdx.x)
#define LAUNCH(kern, nthreads, ...) do { const long _n = (long)(nthreads); if (_n > 0) hipLaunchKernelGGL(kern, dim3((unsigned)((_n + 255) / 256)), dim3(256), 0, stream, __VA_ARGS__); } while (0)
#endif

typedef unsigned short bf16_t;
HD float bf2f(bf16_t v) { unsigned u = (unsigned)v << 16; return __builtin_bit_cast(float, u); }
HD bf16_t f2bf(float f) { unsigned u = __builtin_bit_cast(unsigned, f); return (bf16_t)((u + 0x7fffu + ((u >> 16) & 1u)) >> 16); }

constexpr size_t al256(size_t x) { return (x + 255) & ~(size_t)255; }
constexpr size_t WS_CTL = 0, CTL_BYTES = 1u << 20;
constexpr size_t WS_TAB = WS_CTL + CTL_BYTES;
constexpr int T_AROW = 0, T_ACOL = T_AROW + NROWS * 16 * 2, T_DROW = T_ACOL + 64 * 16 * 2, T_DCOL = T_DROW + NROWS * 8 * 2, T_END = T_DCOL + 64 * 8 * 2;
constexpr size_t WS_SILU = WS_TAB + al256((size_t)T_END * 4);
constexpr size_t WS_MOD = WS_SILU + al256((size_t)(NB + 1) * D * 4);
constexpr size_t WS_RSTD = WS_MOD + al256((size_t)DEPTH * (NB + 1) * 6 * D * 4);
constexpr size_t WS_AFF = WS_RSTD + al256((size_t)RALL * 4);
constexpr size_t WS_SEL = WS_AFF + al256((size_t)RALL * NE * 4);
constexpr size_t WS_GATE = WS_SEL + al256((size_t)NSLOT * 4);
constexpr size_t WS_TOKSLOT = WS_GATE + al256((size_t)NSLOT * 4);
constexpr size_t WS_XC = WS_TOKSLOT + al256((size_t)RALL * NE * 4);
constexpr size_t WS_WIN = WS_XC + al256((size_t)RC * D * 4);
constexpr size_t WS_WOUT = WS_WIN + al256((size_t)DEPTH * PROJ * D * 2);
constexpr size_t WS_WGU = WS_WOUT + al256((size_t)DEPTH * D * D * 2);
constexpr size_t WS_WD = WS_WGU + al256((size_t)2 * NE * 2 * FF * D * 2);
constexpr size_t WS_R1 = WS_WD + al256((size_t)2 * NE * D * FF * 2);
constexpr size_t R1_BYTES = al256(((size_t)RALL * PROJ * 2 > (size_t)NSLOT * FF * 2) ? (size_t)RALL * PROJ * 2 : (size_t)NSLOT * FF * 2);
constexpr size_t WS_R2 = WS_R1 + R1_BYTES;
constexpr size_t R2_BYTES = al256(((size_t)NSLOT * D * 2 > (size_t)2 * RALL * D * 2) ? (size_t)NSLOT * D * 2 : (size_t)2 * RALL * D * 2);
constexpr size_t WS_R3 = WS_R2 + R2_BYTES;
constexpr size_t WS_END = WS_R3 + al256((size_t)RALL * D * 2);

struct Ptrs {
    const float *x, *c, *ctx, *c_ctx, *w_ada, *b_ada, *norm1, *norm2, *w_in, *w_out, *attn_sink, *conv_w, *diff_lambda, *diff_subln, *router, *w_gate, *w_up, *w_down, *norm_final;
    float* out; unsigned char* ws;
};

HD float* xrow_ptr(float* xl, float* xc, int row) { return row < RL ? xl + (size_t)row * D : xc + (size_t)(row - RL) * D; }
HD int row_batch(int row) { return row < RL ? row / SEQ : NB; }
HD float silu_f(float v) { return v / (1.0f + expf(-v)); }

KERNEL k_tables(float* tab) {
    const long g = GID; if (g >= (long)(NROWS + 64) * 24) return;
    const int pos = (int)(g / 24), f = (int)(g % 24);
    const double inv = f < 16 ? pow(10000.0, -(2.0 * f) / 32.0) : pow(10000.0, -(2.0 * (f - 16)) / 16.0);
    const bool isrow = pos < NROWS; const int p = isrow ? pos : pos - NROWS;
    const double ang = (double)p * inv; const float cs = (float)cos(ang), sn = (float)sin(ang);
    int idx;
    if (f < 16) idx = (isrow ? T_AROW : T_ACOL) + (p * 16 + f) * 2; else idx = (isrow ? T_DROW : T_DCOL) + (p * 8 + (f - 16)) * 2;
    tab[idx] = cs; tab[idx + 1] = sn;
}
KERNEL k_silu(const float* c, const float* c_ctx, float* out) {
    const long g = GID; if (g >= (long)(NB + 1) * D) return;
    const int b = (int)(g / D), k = (int)(g % D); const float v = b < NB ? c[b * D + k] : c_ctx[k];
    out[g] = silu_f(v);
}
KERNEL k_mod(const float* silu, const float* w_ada, const float* b_ada, float* mod) {
    const long g = GID; if (g >= (long)DEPTH * 6 * D) return;
    const int l = (int)(g / (6 * D)), j = (int)(g % (6 * D));
    float acc[NB + 1];
#pragma unroll
    for (int b = 0; b <= NB; ++b) acc[b] = 0.f;
    const float* w = w_ada + (size_t)l * D * 6 * D + j;
    for (int k = 0; k < D; ++k) { const float wv = w[(size_t)k * 6 * D];
#pragma unroll
        for (int b = 0; b <= NB; ++b) acc[b] += silu[b * D + k] * wv; }
    const float bias = b_ada[l * 6 * D + j];
#pragma unroll
    for (int b = 0; b <= NB; ++b) mod[((size_t)l * (NB + 1) + b) * 6 * D + j] = acc[b] + bias;
}
HD int permA(int p) { return (p / 32) * 32 + (p % 32) / 2 + 16 * (p % 2); }
HD int permD(int p) { return (p / 16) * 16 + (p % 16) / 2 + 8 * (p % 2); }
HD int inproj_src_col(int n) {
    if (n < C_VA) return (n / 64) * 64 + permA(n % 64);
    if (n < C_QD) return n;
    if (n < C_VD) return (n / 32) * 32 + permD(n % 32);
    return n;
}
KERNEL k_cvt_win(const float* w_in, bf16_t* wt) {
    const long g = GID; if (g >= (long)DEPTH * PROJ * D) return;
    const int k = (int)(g % D); const int n = (int)((g / D) % PROJ); const int l = (int)(g / ((long)D * PROJ));
    wt[g] = f2bf(w_in[((size_t)l * D + k) * PROJ + inproj_src_col(n)]);
}
KERNEL k_cvt_t(const float* w, bf16_t* wt, int nmat, int K, int N) {
    const long g = GID; if (g >= (long)nmat * K * N) return;
    const int k = (int)(g % K); const int n = (int)((g / K) % N); const int m = (int)(g / ((long)K * N));
    wt[g] = f2bf(w[((size_t)m * K + k) * N + n]);
}
KERNEL k_cvt_gu(const float* wg, const float* wu, bf16_t* wt) {
    const long g = GID; if (g >= (long)NE * 2 * FF * D) return;
    const int k = (int)(g % D); const int n = (int)((g / D) % (2 * FF)); const int e = (int)(g / ((long)D * 2 * FF));
    const int blk = n / 256, bj = (n % 256) / 128, j = n % 128; const float* src = bj ? wu : wg;
    wt[g] = f2bf(src[((size_t)e * D + k) * FF + blk * 128 + j]);
}
KERNEL k_rowstat(const float* xl, const float* xc, float* rstd, int nrows) {
    const long g = GID; if (g >= nrows) return;
    const float* xr = xrow_ptr((float*)xl, (float*)xc, (int)g); float s = 0.f;
    for (int k = 0; k < D; ++k) s += xr[k] * xr[k];
    rstd[g] = 1.0f / sqrtf(s / D + EPS);
}
KERNEL k_rowapply(const float* xl, const float* xc, const float* rstd, const float* nw, const float* modl, int sh_off, int sc_off, bf16_t* hx, int nrows) {
    const long g = GID; if (g >= (long)nrows * D) return;
    const int row = (int)(g / D), k = (int)(g % D); const float* xr = xrow_ptr((float*)xl, (float*)xc, row);
    const float* m = modl + (size_t)row_batch(row) * 6 * D;
    const float v = xr[k] * rstd[row] * nw[k] * (1.0f + m[sc_off + k]) + m[sh_off + k];
    hx[g] = f2bf(v);
}
struct EpiInProj {
    bf16_t* P; const float* tab;
    HD void operator()(int row, int c0, const float* v, const float*) const {
        float o[4] = {v[0], v[1], v[2], v[3]};
        const bool lat = row < RL; const int pos = lat ? row % SEQ : 0; const int gr = pos / GRID_W, gc = pos % GRID_W;
        if (c0 < C_VA) {
            if (lat) { const int p = c0 % 64, grp = p / 32, i0 = (p % 32) / 2;
                const float* t = tab + (grp == 0 ? T_AROW + gr * 32 : T_ACOL + gc * 32) + i0 * 2;
                const float a0 = o[0], b0 = o[1], a1 = o[2], b1 = o[3];
                o[0] = a0 * t[0] - b0 * t[1]; o[1] = b0 * t[0] + a0 * t[1]; o[2] = a1 * t[2] - b1 * t[3]; o[3] = b1 * t[2] + a1 * t[3]; }
            if (c0 < C_KA) { for (int j = 0; j < 4; ++j) o[j] *= QSCALE_A; }
        } else if (c0 >= C_QD && c0 < C_VD) {
            if (lat) { const int p = c0 % 32, grp = p / 16, i0 = (p % 16) / 2;
                const float* t = tab + (grp == 0 ? T_DROW + gr * 16 : T_DCOL + gc * 16) + i0 * 2;
                const float a0 = o[0], b0 = o[1], a1 = o[2], b1 = o[3];
                o[0] = a0 * t[0] - b0 * t[1]; o[1] = b0 * t[0] + a0 * t[1]; o[2] = a1 * t[2] - b1 * t[3]; o[3] = b1 * t[2] + a1 * t[3]; }
            if (c0 < C_KD) { for (int j = 0; j < 4; ++j) o[j] *= QSCALE_D; }
        }
        bf16_t* d = P + (size_t)row * PROJ + c0;
        for (int j = 0; j < 4; ++j) d[j] = f2bf(o[j]);
    }
};
struct EpiOutProj {
    float* xl; float* xc; const float* modl;
    HD void operator()(int row, int c0, const float* v, const float*) const {
        float* xr = xrow_ptr(xl, xc, row) + c0; const float* g1 = modl + (size_t)row_batch(row) * 6 * D + M_G1 + c0;
        for (int j = 0; j < 4; ++j) xr[j] += g1[j] * v[j];
    }
};
struct EpiGateUp {
    bf16_t* H;
    HD void operator()(int row, int c0, const float* v, const float* u) const {
        bf16_t* d = H + (size_t)row * FF + c0;
        for (int j = 0; j < 4; ++j) d[j] = f2bf(silu_f(v[j]) * u[j]);
    }
};
struct EpiDown {
    bf16_t* Y; const float* gate;
    HD void operator()(int row, int c0, const float* v, const float*) const {
        const float g = gate[row]; bf16_t* d = Y + (size_t)row * D + c0;
        for (int j = 0; j < 4; ++j) d[j] = f2bf(v[j] * g);
    }
};
template <class Epi, bool DUAL>
KERNEL k_gemm_naive(const bf16_t* A, const int* rowidx, const bf16_t* Bt, int M, int N, int K, int group_rows, int valid_rows, long bstride, Epi epi) {
    const long g = GID; if (g >= (long)M * (N / 4)) return;
    const int row = (int)(g / (N / 4)), c0 = (int)(g % (N / 4)) * 4;
    if (row % group_rows >= valid_rows) return;
    const int arow = rowidx ? rowidx[row] : row;
    const bf16_t* a = A + (size_t)arow * K; const bf16_t* B = Bt + (size_t)(row / group_rows) * bstride;
    float v[4], u[4];
    for (int j = 0; j < 4; ++j) { const int c = c0 + j; const int br = DUAL ? (c / 128) * 256 + c % 128 : c;
        const bf16_t* b0 = B + (size_t)br * K; float s = 0.f, s2 = 0.f;
        for (int k = 0; k < K; ++k) s += bf2f(a[k]) * bf2f(b0[k]);
        if (DUAL) { const bf16_t* b1 = b0 + (size_t)128 * K; for (int k = 0; k < K; ++k) s2 += bf2f(a[k]) * bf2f(b1[k]); }
        v[j] = s; u[j] = s2; }
    epi(row, c0, v, u);
}
HD void b_attnA(const long g, const bf16_t* P, const float* sink, bf16_t* MIX, int nrows) {
    if (g >= (long)nrows * NHA) return;
    const int h = (int)(g / nrows), row = (int)(g % nrows), kvh = h / GQA;
    const bool lat = row < RL; const int b = lat ? row / SEQ : (row - RL) / CTX; const int t = lat ? row % SEQ : 0;
    float q[HDIM], o[HDIM];
    const bf16_t* qp = P + (size_t)row * PROJ + C_QA + h * HDIM;
#pragma unroll
    for (int d = 0; d < HDIM; ++d) { q[d] = bf2f(qp[d]); o[d] = 0.f; }
    float m = sink[h] * LOG2E, l = 1.0f;
    const int nctx = CTX, lo = lat ? (t - WINDOW < 0 ? 0 : t - WINDOW) : 0, hi = lat ? (t + WINDOW > SEQ - 1 ? SEQ - 1 : t + WINDOW) : -1;
    const int nkeys = nctx + (hi - lo + 1);
    for (int i = 0; i < nkeys; ++i) {
        const int krow = i < nctx ? RL + b * CTX + i : b * SEQ + lo + (i - nctx);
        const bf16_t* kp = P + (size_t)krow * PROJ + C_KA + kvh * HDIM; const bf16_t* vp = P + (size_t)krow * PROJ + C_VA + kvh * HDIM;
        float s = 0.f;
#pragma unroll
        for (int d = 0; d < HDIM; ++d) s += q[d] * bf2f(kp[d]);
        if (s > m) { const float sc = exp2f(m - s); l *= sc;
#pragma unroll
            for (int d = 0; d < HDIM; ++d) o[d] *= sc;
            m = s; }
        const float p = exp2f(s - m); l += p;
#pragma unroll
        for (int d = 0; d < HDIM; ++d) o[d] += p * bf2f(vp[d]);
    }
    const float inv = 1.0f / l; bf16_t* op = MIX + (size_t)row * D + h * HDIM;
#pragma unroll
    for (int d = 0; d < HDIM; ++d) op[d] = f2bf(o[d] * inv);
}
KERNEL k_attnA(const bf16_t* P, const float* sink, bf16_t* MIX, int nrows) { b_attnA(GID, P, sink, MIX, nrows); }
HD void b_attnD(const long g, const bf16_t* P, float* TMP, int nrows) {
    if (g >= (long)nrows * NHC * 2) return;
    const int hc = (int)(g / nrows), row = (int)(g % nrows), h = hc / 2, comp = hc % 2;
    const bool lat = row < RL; const int b = lat ? row / SEQ : (row - RL) / CTX;
    float q[DD], o[2 * DD];
    const bf16_t* qp = P + (size_t)row * PROJ + C_QD + h * 2 * DD + comp * DD;
#pragma unroll
    for (int d = 0; d < DD; ++d) q[d] = bf2f(qp[d]);
#pragma unroll
    for (int d = 0; d < 2 * DD; ++d) o[d] = 0.f;
    float m = -1e30f, l = 0.f;
    const int nkeys = CTX + (lat ? SEQ : 0);
    for (int i = 0; i < nkeys; ++i) {
        const int krow = i < CTX ? RL + b * CTX + i : b * SEQ + (i - CTX);
        const bf16_t* kp = P + (size_t)krow * PROJ + C_KD + h * 2 * DD + comp * DD; const bf16_t* vp = P + (size_t)krow * PROJ + C_VD + h * 2 * DD;
        float s = 0.f;
#pragma unroll
        for (int d = 0; d < DD; ++d) s += q[d] * bf2f(kp[d]);
        if (s > m) { const float sc = exp2f(m - s); l *= sc;
#pragma unroll
            for (int d = 0; d < 2 * DD; ++d) o[d] *= sc;
            m = s; }
        const float p = exp2f(s - m); l += p;
#pragma unroll
        for (int d = 0; d < 2 * DD; ++d) o[d] += p * bf2f(vp[d]);
    }
    const float inv = 1.0f / l; float* op = TMP + (((size_t)row * NHC + h) * 2 + comp) * 2 * DD;
#pragma unroll
    for (int d = 0; d < 2 * DD; ++d) op[d] = o[d] * inv;
}
KERNEL k_attnD(const bf16_t* P, float* TMP, int nrows) { b_attnD(GID, P, TMP, nrows); }
HD void b_diffpost(const long g, const float* TMP, const float* lam_p, const float* subln, float lam_init, bf16_t* MIX, int nrows) {
    if (g >= (long)nrows * NHC) return;
    const int row = (int)(g / NHC), h = (int)(g % NHC);
    float s01 = 0.f, s23 = 0.f;
    for (int d = 0; d < DD; ++d) { s01 += lam_p[d] * lam_p[DD + d]; s23 += lam_p[2 * DD + d] * lam_p[3 * DD + d]; }
    const float lam = expf(s01) - expf(s23) + lam_init;
    const float* t = TMP + ((size_t)row * NHC + h) * 2 * 2 * DD; float y[2 * DD]; float ss = 0.f;
#pragma unroll
    for (int d = 0; d < 2 * DD; ++d) { y[d] = t[d] - lam * t[2 * DD + d]; ss += y[d] * y[d]; }
    const float r = 1.0f / sqrtf(ss / (2 * DD) + EPS) * (1.0f - lam_init);
    bf16_t* op = MIX + (size_t)row * D + 768 + h * 2 * DD;
#pragma unroll
    for (int d = 0; d < 2 * DD; ++d) op[d] = f2bf(y[d] * r * subln[d]);
}
KERNEL k_diffpost(const float* TMP, const float* lam_p, const float* subln, float lam_init, bf16_t* MIX, int nrows) { b_diffpost(GID, TMP, lam_p, subln, lam_init, MIX, nrows); }
HD void b_conv(const long g, const bf16_t* P, const float* cw, bf16_t* MIX, int nrows) {
    if (g >= (long)nrows * CONV_CH) return;
    const int row = (int)(g / CONV_CH), ch = (int)(g % CONV_CH);
    const bool lat = row < RL; const int t = lat ? row % SEQ : (row - RL) % CTX, len = lat ? SEQ : CTX;
    float y = 0.f;
    for (int j = 0; j < 3; ++j) { const int tt = t + j - 1; if (tt < 0 || tt >= len) continue;
        const bf16_t* pr = P + (size_t)(row + j - 1) * PROJ; y += cw[j * CONV_CH + ch] * (bf2f(pr[C_CC + ch]) * bf2f(pr[C_CIN + ch])); }
    MIX[(size_t)row * D + 512 + ch] = f2bf(bf2f(P[(size_t)row * PROJ + C_CB + ch]) * y);
}
KERNEL k_conv(const bf16_t* P, const float* cw, bf16_t* MIX, int nrows) { b_conv(GID, P, cw, MIX, nrows); }
KERNEL k_router(const float* xl, const float* xc, const float* rstd, const float* nw, const float* modl, const float* router, float* logits, int nrows) {
    const long g = GID; if (g >= (long)nrows * NE) return;
    const int row = (int)(g / NE), e = (int)(g % NE); const float* xr = xrow_ptr((float*)xl, (float*)xc, row);
    const float* m = modl + (size_t)row_batch(row) * 6 * D; const float rs = rstd[row]; float s = 0.f;
    for (int k = 0; k < D; ++k) { const float v = xr[k] * rs * nw[k] * (1.0f + m[M_SC2 + k]) + m[M_SH2 + k]; s += v * router[k * NE + e]; }
    logits[g] = s;
}
KERNEL k_aff(float* aff, int nrows) {
    const long g = GID; if (g >= nrows) return;
    float* a = aff + (size_t)g * NE; float m = a[0];
    for (int e = 1; e < NE; ++e) m = a[e] > m ? a[e] : m;
    float s = 0.f; float ex[NE];
#pragma unroll
    for (int e = 0; e < NE; ++e) { ex[e] = expf(a[e] - m); s += ex[e]; }
#pragma unroll
    for (int e = 0; e < NE; ++e) a[e] = ex[e] / s;
}
KERNEL k_select(const float* aff, int* sel, float* gate, int* tokslot, int nrows) {
    const long g = GID; if (g >= (long)nrows * NE) return;
    const int row = (int)(g / NE), e = (int)(g % NE);
    const bool lat = row < RL; const int b = lat ? row / SEQ : (row - RL) / CTX; const int t = lat ? row % SEQ : (row - RL) % CTX;
    const int n = lat ? SEQ : CTX, cap = lat ? CAPL : CAPC, base = lat ? b * SEQ : RL + b * CTX;
    const float a = aff[(size_t)row * NE + e]; int rank = 0;
    for (int j = 0; j < n; ++j) { const float o = aff[(size_t)(base + j) * NE + e]; rank += (o > a || (o == a && j < t)) ? 1 : 0; }
    int slot = -1;
    if (rank < cap) { slot = e * SLOTS_E + (lat ? b * CAPL + rank : SLOTS_L + b * CAPC + rank); sel[slot] = row; gate[slot] = a; }
    tokslot[g] = slot;
}
KERNEL k_combine(float* xl, float* xc, const bf16_t* Y, const int* tokslot, const float* modl, int nrows) {
    const long g = GID; if (g >= (long)nrows * D) return;
    const int row = (int)(g / D), k = (int)(g % D); float s = 0.f;
    for (int e = 0; e < NE; ++e) { const int sl = tokslot[(size_t)row * NE + e]; if (sl >= 0) s += bf2f(Y[(size_t)sl * D + k]); }
    float* xr = xrow_ptr(xl, xc, row); xr[k] += modl[(size_t)row_batch(row) * 6 * D + M_G2 + k] * s;
}
KERNEL k_final(float* xl, const float* rstd, const float* nw) {
    const long g = GID; if (g >= (long)RL * D) return;
    const int row = (int)(g / D), k = (int)(g % D); xl[g] = xl[g] * rstd[row] * nw[k];
}

#ifndef HOST_TEST
typedef short bf16x8 __attribute__((ext_vector_type(8)));
typedef float f32x4 __attribute__((ext_vector_type(4)));
template <class Epi, bool DUAL>
__global__ void __launch_bounds__(256) k_gemm_mfma(const bf16_t* __restrict__ A, const int* __restrict__ rowidx, const bf16_t* __restrict__ Bt, int M, int N, int K, int group_rows, int valid_rows, long bstride, Epi epi) {
    const int tid = threadIdx.x, wid = tid >> 6, lane = tid & 63, fr = lane & 15, fq = lane >> 4, wr = wid >> 1, wc = wid & 1;
    const int row0 = blockIdx.y * 128 + wr * 64;
    if ((blockIdx.y * 128) % group_rows >= valid_rows) return;
    const bf16_t* B = Bt + (size_t)((blockIdx.y * 128) / group_rows) * bstride;
    int brow[4], ocol[4];
    if (!DUAL) { for (int i = 0; i < 4; ++i) { brow[i] = blockIdx.x * 128 + wc * 64 + i * 16; ocol[i] = brow[i]; } }
    else { const int hc0 = blockIdx.x * 64 + wc * 32;
        for (int i = 0; i < 2; ++i) { ocol[i] = hc0 + i * 16; brow[i] = (ocol[i] / 128) * 256 + ocol[i] % 128; brow[i + 2] = brow[i] + 128; ocol[i + 2] = ocol[i]; } }
    const bf16_t* ap[4]; const bf16_t* bp[4];
#pragma unroll
    for (int m = 0; m < 4; ++m) { const int r = row0 + m * 16 + fr; const int ar = rowidx ? rowidx[r] : r; ap[m] = A + (size_t)ar * K + fq * 8; }
#pragma unroll
    for (int i = 0; i < 4; ++i) bp[i] = B + (size_t)(brow[i] + fr) * K + fq * 8;
    f32x4 acc[4][4];
#pragma unroll
    for (int m = 0; m < 4; ++m)
#pragma unroll
        for (int i = 0; i < 4; ++i) acc[m][i] = (f32x4){0.f, 0.f, 0.f, 0.f};
    for (int k0 = 0; k0 < K; k0 += 32) {
        bf16x8 af[4], bfr[4];
#pragma unroll
        for (int m = 0; m < 4; ++m) af[m] = *(const bf16x8*)(ap[m] + k0);
#pragma unroll
        for (int i = 0; i < 4; ++i) bfr[i] = *(const bf16x8*)(bp[i] + k0);
#pragma unroll
        for (int m = 0; m < 4; ++m)
#pragma unroll
            for (int i = 0; i < 4; ++i) acc[m][i] = __builtin_amdgcn_mfma_f32_16x16x32_bf16(bfr[i], af[m], acc[m][i], 0, 0, 0);
    }
#pragma unroll
    for (int m = 0; m < 4; ++m) { const int r = row0 + m * 16 + fr;
#pragma unroll
        for (int i = 0; i < (DUAL ? 2 : 4); ++i) {
            float v[4] = {acc[m][i][0], acc[m][i][1], acc[m][i][2], acc[m][i][3]};
            float u[4] = {acc[m][DUAL ? i + 2 : i][0], acc[m][DUAL ? i + 2 : i][1], acc[m][DUAL ? i + 2 : i][2], acc[m][DUAL ? i + 2 : i][3]};
            epi(r, ocol[i] + 4 * fq, v, u); } }
}
template <class Epi, bool DUAL>
static void launch_gemm(hipStream_t stream, const bf16_t* A, const int* rowidx, const bf16_t* Bt, int M, int N, int K, int group_rows, int valid_rows, long bstride, Epi epi) {
    dim3 grid(DUAL ? N / 64 : N / 128, M / 128);
    hipLaunchKernelGGL((k_gemm_mfma<Epi, DUAL>), grid, dim3(256), 0, stream, A, rowidx, Bt, M, N, K, group_rows, valid_rows, bstride, epi);
}
#define GEMM(Epi, DUAL, ...) launch_gemm<Epi, DUAL>(stream, __VA_ARGS__)
#else
#define GEMM(Epi, DUAL, A, rowidx, Bt, M, N, K, gr, vr, bs, epi) LAUNCH((k_gemm_naive<Epi, DUAL>), (long)(M) * ((N) / 4), A, rowidx, Bt, M, N, K, gr, vr, bs, epi)
#endif

#ifdef HOST_TEST
typedef int hipStream_t;
#endif
static void forward(const Ptrs& p, hipStream_t stream) {
    (void)stream;
    unsigned char* ws = p.ws;
    float* tab = (float*)(ws + WS_TAB); float* silu = (float*)(ws + WS_SILU); float* mod = (float*)(ws + WS_MOD); float* rstd = (float*)(ws + WS_RSTD);
    float* aff = (float*)(ws + WS_AFF); int* sel = (int*)(ws + WS_SEL); float* gate = (float*)(ws + WS_GATE); int* tokslot = (int*)(ws + WS_TOKSLOT);
    float* xc = (float*)(ws + WS_XC); float* xl = p.out;
    bf16_t* win = (bf16_t*)(ws + WS_WIN); bf16_t* wout = (bf16_t*)(ws + WS_WOUT);
    bf16_t* P = (bf16_t*)(ws + WS_R1); bf16_t* H = (bf16_t*)(ws + WS_R1);
    bf16_t* Y = (bf16_t*)(ws + WS_R2); bf16_t* MIX = (bf16_t*)(ws + WS_R2); bf16_t* HX2 = (bf16_t*)(ws + WS_R2 + (size_t)RALL * D * 2); float* TMP = (float*)HX2;
    bf16_t* HX = (bf16_t*)(ws + WS_R3);
    LAUNCH(k_tables, (long)(NROWS + 64) * 24, tab);
    LAUNCH(k_silu, (long)(NB + 1) * D, p.c, p.c_ctx, silu);
    LAUNCH(k_mod, (long)DEPTH * 6 * D, silu, p.w_ada, p.b_ada, mod);
    LAUNCH(k_cvt_win, (long)DEPTH * PROJ * D, p.w_in, win);
    LAUNCH(k_cvt_t, (long)DEPTH * D * D, p.w_out, wout, DEPTH, D, D);
#ifdef HOST_TEST
    memcpy(xl, p.x, (size_t)RL * D * 4); memcpy(xc, p.ctx, (size_t)RC * D * 4);
#else
    (void)hipMemcpyAsync(xl, p.x, (size_t)RL * D * 4, hipMemcpyDeviceToDevice, stream);
    (void)hipMemcpyAsync(xc, p.ctx, (size_t)RC * D * 4, hipMemcpyDeviceToDevice, stream);
#endif
    for (int l = 0; l < DEPTH; ++l) {
        const bool need_ctx = l < DEPTH - 1; const int nq = need_ctx ? RALL : RL;
        const float* modl = mod + (size_t)l * (NB + 1) * 6 * D; const float lam_init = 0.8f - 0.6f * expf(-0.3f * (float)l);
        bf16_t* wgu = (bf16_t*)(ws + WS_WGU) + (size_t)(l & 1) * NE * 2 * FF * D; bf16_t* wd = (bf16_t*)(ws + WS_WD) + (size_t)(l & 1) * NE * D * FF;
        LAUNCH(k_cvt_gu, (long)NE * 2 * FF * D, p.w_gate + (size_t)l * NE * D * FF, p.w_up + (size_t)l * NE * D * FF, wgu);
        LAUNCH(k_cvt_t, (long)NE * FF * D, p.w_down + (size_t)l * NE * FF * D, wd, NE, FF, D);
        LAUNCH(k_rowstat, RALL, xl, xc, rstd, RALL);
        LAUNCH(k_rowapply, (long)RALL * D, xl, xc, rstd, p.norm1 + l * D, modl, M_SH1, M_SC1, HX, RALL);
        GEMM(EpiInProj, false, HX, (const int*)nullptr, win + (size_t)l * PROJ * D, RALL, PROJ, D, RALL, RALL, 0L, (EpiInProj{P, tab}));
        LAUNCH(k_attnA, (long)nq * NHA, P, p.attn_sink + l * NHA, MIX, nq);
        LAUNCH(k_attnD, (long)nq * NHC * 2, P, TMP, nq);
        LAUNCH(k_diffpost, (long)nq * NHC, TMP, p.diff_lambda + l * 4 * DD, p.diff_subln + l * 2 * DD, lam_init, MIX, nq);
        LAUNCH(k_conv, (long)nq * CONV_CH, P, p.conv_w + l * 3 * CONV_CH, MIX, nq);
        GEMM(EpiOutProj, false, MIX, (const int*)nullptr, wout + (size_t)l * D * D, nq, D, D, nq, nq, 0L, (EpiOutProj{xl, xc, modl}));
        LAUNCH(k_rowstat, nq, xl, xc, rstd, nq);
        LAUNCH(k_rowapply, (long)nq * D, xl, xc, rstd, p.norm2 + l * D, modl, M_SH2, M_SC2, HX2, nq);
        LAUNCH(k_router, (long)nq * NE, xl, xc, rstd, p.norm2 + l * D, modl, p.router + (size_t)l * D * NE, aff, nq);
        LAUNCH(k_aff, nq, aff, nq);
        LAUNCH(k_select, (long)nq * NE, aff, sel, gate, tokslot, nq);
        const int vr = need_ctx ? SLOTS_E : SLOTS_L;
        GEMM(EpiGateUp, true, HX2, sel, wgu, NSLOT, FF, D, SLOTS_E, vr, (long)2 * FF * D, (EpiGateUp{H}));
        GEMM(EpiDown, false, H, (const int*)nullptr, wd, NSLOT, D, FF, SLOTS_E, vr, (long)D * FF, (EpiDown{Y, gate}));
        LAUNCH(k_combine, (long)nq * D, xl, xc, Y, tokslot, modl, nq);
    }
    LAUNCH(k_rowstat, RL, xl, xc, rstd, RL);
    LAUNCH(k_final, (long)RL * D, xl, rstd, p.norm_final);
}

#ifndef HOST_TEST
#define LAS __attribute__((address_space(3)))
#define GAS __attribute__((address_space(1)))
typedef unsigned u32x4 __attribute__((ext_vector_type(4)));
typedef unsigned u32x2 __attribute__((ext_vector_type(2)));
constexpr int NT = 512, NWV = 8;
constexpr int LDS_BYTES = 147456;
constexpr int LDS_MISC = LDS_BYTES - 256;
constexpr int CW_BAR = 4096;

__device__ __forceinline__ unsigned cvt_pk_bf16(float lo, float hi) { unsigned r; asm volatile("v_cvt_pk_bf16_f32 %0, %1, %2" : "=v"(r) : "v"(lo), "v"(hi)); return r; }
__device__ __forceinline__ float wave_sum(float v) {
#pragma unroll
    for (int o = 1; o < 64; o <<= 1) v += __shfl_xor(v, o);
    return v;
}
#define LDS_WAIT() asm volatile("s_waitcnt lgkmcnt(0)" ::: "memory")
__device__ __forceinline__ int tid_l() { int t = threadIdx.x; asm volatile("" : "+v"(t)); return t; }

#define XB_TMO      128
#define XB_XCNT(j)  (256  + 64 * (j))
#define XB_XSUB(j)  (1280 + 64 * (j))
#define XB_XGEN(j)  (2304 + 64 * (j))
#define XB_TOP      3328
#define XB_TOPGEN   3392
#define XCD_BAR_WORDS 3456
#define XB_SPIN_CAP (1u << 24)
__device__ __forceinline__ unsigned xb_ld(unsigned* p)              { return __hip_atomic_load(p, __ATOMIC_RELAXED, __HIP_MEMORY_SCOPE_AGENT); }
__device__ __forceinline__ unsigned xb_add(unsigned* p, unsigned v) { return __hip_atomic_fetch_add(p, v, __ATOMIC_RELAXED, __HIP_MEMORY_SCOPE_AGENT); }
__device__ __forceinline__ unsigned xb_xcc_id() { return (unsigned)__builtin_amdgcn_s_getreg((3 << 11) | 20) & 0xFu; }
#define XB_SPIN(cond, bar) do { unsigned _sp = 0; while (cond) { __builtin_amdgcn_s_sleep(1); \
    if ((++_sp & 255u) == 0u) { if (xb_ld(&(bar)[XB_TMO])) break; if (_sp > XB_SPIN_CAP) { atomicAdd(&(bar)[XB_TMO], 1u); break; } } } } while (0)
struct XcdBarrier { unsigned* bar; unsigned x; volatile LAS unsigned* st; };
__device__ __forceinline__ XcdBarrier xcd_barrier_post(unsigned* bar, volatile LAS unsigned* st) {
    XcdBarrier b; b.bar = bar; b.x = xb_xcc_id(); b.st = st;
    if (threadIdx.x == 0) (void)xb_add(&bar[XB_XCNT(b.x)], 1u);
    return b;
}
__device__ __forceinline__ void xcd_barrier_complete(unsigned* bar, unsigned x, unsigned& nloc, unsigned& nx) {
    const unsigned G = gridDim.x * gridDim.y * gridDim.z;
    unsigned sum, cnt, mine, sp = 0u;
    for (;;) {
        sum = 0u; cnt = 0u; mine = 0u;
#pragma unroll
        for (unsigned j = 0; j < 16; ++j) { const unsigned c = xb_ld(&bar[XB_XCNT(j)]); sum += c; cnt += (c > 0u) ? 1u : 0u; mine = (j == x) ? c : mine; }
        if (sum == G) break;
        __builtin_amdgcn_s_sleep(1);
        if ((++sp & 255u) == 0u) { if (xb_ld(&bar[XB_TMO])) break; if (sp > XB_SPIN_CAP) { atomicAdd(&bar[XB_TMO], 1u); break; } }
    }
    nloc = mine > 0u ? mine : 1u; nx = cnt > 0u ? cnt : 1u;
}
__device__ __forceinline__ void xcd_barrier(const XcdBarrier& b) {
    asm volatile("s_waitcnt vmcnt(0)" ::: "memory");
    __syncthreads();
    if (threadIdx.x == 0) {
        unsigned* bar = b.bar;
        __builtin_amdgcn_s_waitcnt(0);
        unsigned nloc = b.st[0], nx = b.st[1];
        if (nloc == 0u) { xcd_barrier_complete(bar, b.x, nloc, nx); b.st[0] = nloc; b.st[1] = nx; }
        const unsigned old = xb_add(&bar[XB_XSUB(b.x)], 1u);
        const unsigned gen = old / nloc;
        if (old + 1u == (gen + 1u) * nloc) {
            __builtin_amdgcn_fence(__ATOMIC_RELEASE, "agent");
            asm volatile("s_waitcnt vmcnt(0)" ::: "memory");
            const unsigned og = xb_add(&bar[XB_TOP], 1u);
            const unsigned tg = og / nx;
            if (og + 1u == (tg + 1u) * nx) xb_add(&bar[XB_TOPGEN], 1u);
            else XB_SPIN(xb_ld(&bar[XB_TOPGEN]) == tg, bar);
            __builtin_amdgcn_fence(__ATOMIC_ACQUIRE, "agent");
            xb_add(&bar[XB_XGEN(b.x)], 1u);
            asm volatile("s_waitcnt vmcnt(0)" ::: "memory");
        } else {
            XB_SPIN(xb_ld(&bar[XB_XGEN(b.x)]) == gen, bar);
            __builtin_amdgcn_fence(__ATOMIC_ACQUIRE, "agent");
            asm volatile("s_waitcnt vmcnt(0)" ::: "memory");
        }
    }
    __syncthreads();
}

namespace pg {
constexpr int BM = 256, BK = 64, HALF = 128, HTB = HALF * BK * 2  , STAGE_BYTES = 8 * HTB, NXCD = 8, WGM = 8;
constexpr int TPE_FULL = SLOTS_E / BM;
__host__ __device__ __forceinline__ int lds_byte(int r, int c) { const int st = (r >> 4) * 2 + (c >> 5), rr = r & 15, cc = c & 31, ob = rr * 64 + cc * 2; return st * 1024 + (ob ^ (((ob >> 9) & 1) << 5)); }
__host__ __device__ __forceinline__ void stage_rc(int b, int& R, int& C) { const int st = b / 1024, sb = b % 1024, swz = sb ^ (((sb >> 9) & 1) << 5); R = (st >> 1) * 16 + swz / 64; C = (st & 1) * 32 + (swz % 64) / 2; }
__host__ __device__ __forceinline__ int perm32(int rho) { const int n = rho >> 4, i = rho & 15; return 8 * (i >> 2) + 4 * n + (i & 3); }
struct Unit { int m0, pn, e; };
struct GemmD { const char* A; const int* rowidx; const char* Bt; size_t bstride; int K; };
struct Order {
    int nM, nN, nwg, G, c, tpe;
    __device__ void init(int nM_, int nN_, int G_, int c_, int tpe_) { nM = nM_; nN = nN_; nwg = nM * nN; G = G_; c = c_; tpe = tpe_; }
    __device__ bool next(int i, Unit& u) const {
        const long L = (long)i * G + c; if (L >= nwg) return false;
        int wgid = (int)L; { const int q = nwg / NXCD, r = nwg % NXCD, xcd = wgid % NXCD, off = wgid / NXCD; wgid = (xcd < r ? xcd * (q + 1) : r * (q + 1) + (xcd - r) * q) + off; }
        const int nig = WGM * nN, gid = wgid / nig, fm = gid * WGM, gsz = (nM - fm) < WGM ? (nM - fm) : WGM;
        const int pm = fm + ((wgid % nig) % gsz); u.pn = (wgid % nig) / gsz;
        if (tpe > 0) { u.e = pm / tpe; u.m0 = (u.e * TPE_FULL + pm % tpe) * BM; } else { u.e = 0; u.m0 = pm * BM; }
        return true;
    }
};
template <class Epi, bool GATHER>
__device__ __forceinline__ void gemm_phase(LAS unsigned char* lds, const GemmD g, const Order& S, const Epi& E) {
    const int tid = tid_l(), wid = __builtin_amdgcn_readfirstlane(tid >> 6), lane = tid & 63, wr = wid >> 2, wc = wid & 3, fr = lane & 15, fq = lane >> 4;
    const int K = g.K, nt = K / BK;
    int Rr[2], Cc[2]; unsigned voffB[2];
#pragma unroll
    for (int i = 0; i < 2; ++i) { int R, C; stage_rc(tid * 16 + i * 8192, R, C); Rr[i] = R; Cc[i] = C; const int Rb = Epi::PERM ? ((R & ~31) + perm32(R & 31)) : R; voffB[i] = (unsigned)(Rb * K + C) * 2u; }
    const unsigned kstep = (unsigned)(BK * 2);
    const size_t hstep = (size_t)HALF * K * 2;
    const unsigned ldsw = (unsigned)wid * 1024u;
    const int aoff = lds_byte(wr * 64 + fr, fq * 8), boff = lds_byte(wc * 32 + fr, fq * 8);
#define PG_SA(b, h) (((b) * 2 + (h)) * HTB)
#define PG_SB(b, h) ((4 + (b) * 2 + (h)) * HTB)
#define PG_STAGE_B(bufoff, gbase) do { _Pragma("unroll") for (int _i = 0; _i < 2; ++_i) \
        __builtin_amdgcn_global_load_lds((const unsigned*)((const char*)(gbase) + voffB[_i]), (LAS unsigned*)(lds + (bufoff) + ldsw + _i * 8192), 16, 0, 0); } while (0)
#define PG_STAGE_A(bufoff, OFFS, h, kb) do { _Pragma("unroll") for (int _i = 0; _i < 2; ++_i) \
        __builtin_amdgcn_global_load_lds((const unsigned*)(g.A + (size_t)(OFFS)[h][_i] + (kb)), (LAS unsigned*)(lds + (bufoff) + ldsw + _i * 8192), 16, 0, 0); } while (0)
#define PG_ROWOFF(DST, U) do { _Pragma("unroll") for (int _h = 0; _h < 2; ++_h) _Pragma("unroll") for (int _i = 0; _i < 2; ++_i) { int _r = (U).m0 + _h * HALF + Rr[_i]; if (GATHER) _r = g.rowidx[_r]; \
        (DST)[_h][_i] = (unsigned)(((size_t)_r * K + Cc[_i]) * 2); } } while (0)
#define PG_LDA(dst, b, h) do { _Pragma("unroll") for (int m = 0; m < 4; ++m) _Pragma("unroll") for (int k = 0; k < 2; ++k) dst[m][k] = *(const LAS bf16x8*)(lds + PG_SA(b, h) + aoff + m * 2048 + k * 1024); } while (0)
#define PG_LDB(dst, b, h) do { _Pragma("unroll") for (int n = 0; n < 2; ++n) _Pragma("unroll") for (int k = 0; k < 2; ++k) dst[n][k] = *(const LAS bf16x8*)(lds + PG_SB(b, h) + boff + n * 2048 + k * 1024); } while (0)
#define PG_MMA(ai, bj, At, Bt) do { __builtin_amdgcn_s_setprio(1); _Pragma("unroll") for (int m = 0; m < 4; ++m) _Pragma("unroll") for (int n = 0; n < 2; ++n) _Pragma("unroll") for (int k = 0; k < 2; ++k) \
        acc[ai][bj][m][n] = __builtin_amdgcn_mfma_f32_16x16x32_bf16(Bt[n][k], At[m][k], acc[ai][bj][m][n], 0, 0, 0); __builtin_amdgcn_s_setprio(0); } while (0)
#define PG_WAIT_V(n) asm volatile("s_waitcnt vmcnt(" #n ")" ::: "memory")
#define PG_WAIT_L(n) asm volatile("s_waitcnt lgkmcnt(" #n ")" ::: "memory")
#define PG_BAR __builtin_amdgcn_s_barrier()
#define PG_SCHED __builtin_amdgcn_sched_barrier(0)
    Unit cur, nxt; int ui = 0;
    if (!S.next(0, cur)) return;
    f32x4 acc[2][2][4][2];
#pragma unroll
    for (int a = 0; a < 2; ++a)
#pragma unroll
        for (int b = 0; b < 2; ++b)
#pragma unroll
            for (int m = 0; m < 4; ++m)
#pragma unroll
                for (int n = 0; n < 2; ++n) acc[a][b][m][n] = (f32x4){0.f, 0.f, 0.f, 0.f};
    bf16x8 At[4][2], B0[2][2], B1[2][2];
    unsigned offA[2][2], offN[2][2];
    PG_ROWOFF(offA, cur);
    if (GATHER) PG_WAIT_V(0);
    const char* cB = g.Bt + (size_t)cur.e * g.bstride + (size_t)cur.pn * BM * K * 2;
    PG_STAGE_B(PG_SB(0, 0), cB); PG_STAGE_B(PG_SB(0, 1), cB + hstep); PG_STAGE_A(PG_SA(0, 0), offA, 0, 0u); PG_STAGE_A(PG_SA(0, 1), offA, 1, 0u);
    if (wr == 1) PG_BAR;
    PG_WAIT_V(2); PG_BAR;
    PG_STAGE_B(PG_SB(1, 0), cB + kstep); PG_STAGE_A(PG_SA(1, 0), offA, 0, kstep); PG_STAGE_B(PG_SB(1, 1), cB + hstep + kstep);
    PG_WAIT_V(6); PG_BAR;
    for (;;) {
        const bool has_next = S.next(ui + 1, nxt);
        const char* nB = has_next ? g.Bt + (size_t)nxt.e * g.bstride + (size_t)nxt.pn * BM * K * 2 : cB;
        if (has_next) { PG_ROWOFF(offN, nxt); if (GATHER) PG_WAIT_V(0); }
        else {
#pragma unroll
            for (int h = 0; h < 2; ++h)
#pragma unroll
                for (int i = 0; i < 2; ++i) offN[h][i] = offA[h][i]; }
        for (int t = 0; t < nt; t += 2) {
            const bool last = (t == nt - 2);
            unsigned o2[2][2];
#pragma unroll
            for (int h = 0; h < 2; ++h)
#pragma unroll
                for (int i = 0; i < 2; ++i) o2[h][i] = last ? offN[h][i] : offA[h][i];
            const unsigned ka1 = (unsigned)(t + 1) * kstep, ka2 = last ? 0u : (unsigned)(t + 2) * kstep, ka3 = ka2 + kstep;
            const char* b2 = last ? nB : cB + (size_t)(t + 2) * kstep; const char* b3 = b2 + kstep;
            PG_LDB(B0, 0, 0); PG_LDB(B1, 0, 1); PG_SCHED; PG_LDA(At, 0, 0); PG_STAGE_A(PG_SA(1, 1), offA, 1, ka1);
            PG_WAIT_V(8); PG_WAIT_L(0); PG_BAR; PG_MMA(0, 0, At, B0); PG_MMA(0, 1, At, B1); PG_BAR; PG_SCHED;
            PG_LDA(At, 0, 1); PG_STAGE_B(PG_SB(0, 0), b2); PG_STAGE_B(PG_SB(0, 1), b2 + hstep); PG_STAGE_A(PG_SA(0, 0), o2, 0, ka2);
            PG_WAIT_V(8); PG_WAIT_L(0); PG_BAR; PG_MMA(1, 0, At, B0); PG_MMA(1, 1, At, B1); PG_BAR; PG_SCHED;
            PG_LDB(B0, 1, 0); PG_LDB(B1, 1, 1); PG_SCHED; PG_LDA(At, 1, 0); PG_STAGE_A(PG_SA(0, 1), o2, 1, ka2);
            PG_WAIT_V(8); PG_WAIT_L(0); PG_BAR; PG_MMA(0, 0, At, B0); PG_MMA(0, 1, At, B1); PG_BAR; PG_SCHED;
            PG_LDA(At, 1, 1); PG_STAGE_B(PG_SB(1, 0), b3); PG_STAGE_B(PG_SB(1, 1), b3 + hstep); PG_STAGE_A(PG_SA(1, 0), o2, 0, ka3);
            PG_WAIT_V(8); PG_WAIT_L(0); PG_BAR; PG_MMA(1, 0, At, B0); PG_MMA(1, 1, At, B1); PG_BAR; PG_SCHED;
        }
        if (wr == 0) PG_BAR;
        E(acc, cur, wr, wc, fr, fq);
        if (!has_next) break;
#pragma unroll
        for (int a = 0; a < 2; ++a)
#pragma unroll
            for (int b = 0; b < 2; ++b)
#pragma unroll
                for (int m = 0; m < 4; ++m)
#pragma unroll
                    for (int n = 0; n < 2; ++n) acc[a][b][m][n] = (f32x4){0.f, 0.f, 0.f, 0.f};
        cur = nxt; cB = nB; ++ui;
#pragma unroll
        for (int h = 0; h < 2; ++h)
#pragma unroll
            for (int i = 0; i < 2; ++i) offA[h][i] = offN[h][i];
        if (wr == 1) PG_BAR;
    }
    PG_WAIT_V(0);
    PG_BAR;
#undef PG_SA
#undef PG_SB
#undef PG_STAGE_A
#undef PG_STAGE_B
#undef PG_ROWOFF
#undef PG_LDA
#undef PG_LDB
#undef PG_MMA
#undef PG_WAIT_V
#undef PG_WAIT_L
#undef PG_BAR
#undef PG_SCHED
}
struct EpiP {
    static constexpr bool PERM = true;
    bf16_t* P; const float* tab;
    __device__ __forceinline__ void operator()(const f32x4 (&acc)[2][2][4][2], const Unit& u, int wr, int wc, int fr, int fq) const {
        const bool lat = u.m0 < RL;
#pragma unroll
        for (int bj = 0; bj < 2; ++bj) {
            const int ct = u.pn * BM + bj * HALF;
            const int c0 = ct + wc * 32 + 8 * fq;
            const int kind = ct < C_VA ? 1 : ((ct >= C_QD && ct < C_VD) ? 2 : 0);
            const float sc = ct < C_KA ? QSCALE_A : ((ct >= C_QD && ct < C_KD) ? QSCALE_D : 1.0f);
#pragma unroll
            for (int ai = 0; ai < 2; ++ai)
#pragma unroll
                for (int m = 0; m < 4; ++m) {
                    const int row = u.m0 + ai * HALF + wr * 64 + m * 16 + fr;
                    f32x4 v0 = acc[ai][bj][m][0], v1 = acc[ai][bj][m][1];
                    if (kind != 0 && lat) {
                        const int pos = row % SEQ, gr = pos / GRID_W, gc = pos % GRID_W; const float* t;
                        if (kind == 1) { const int p = c0 & 63, grp = p >> 5, i0 = (p & 31) >> 1; t = tab + (grp ? T_ACOL + gc * 32 : T_AROW + gr * 32) + i0 * 2; }
                        else { const int p = c0 & 31, grp = p >> 4, i0 = (p & 15) >> 1; t = tab + (grp ? T_DCOL + gc * 16 : T_DROW + gr * 16) + i0 * 2; }
                        const f32x4 t0 = *(const f32x4*)t, t1 = *(const f32x4*)(t + 4);
                        v0 = (f32x4){v0[0] * t0[0] - v0[1] * t0[1], v0[1] * t0[0] + v0[0] * t0[1], v0[2] * t0[2] - v0[3] * t0[3], v0[3] * t0[2] + v0[2] * t0[3]};
                        v1 = (f32x4){v1[0] * t1[0] - v1[1] * t1[1], v1[1] * t1[0] + v1[0] * t1[1], v1[2] * t1[2] - v1[3] * t1[3], v1[3] * t1[2] + v1[2] * t1[3]};
                    }
                    v0 = v0 * sc; v1 = v1 * sc;
                    u32x4 w; w.x = cvt_pk_bf16(v0[0], v0[1]); w.y = cvt_pk_bf16(v0[2], v0[3]); w.z = cvt_pk_bf16(v1[0], v1[1]); w.w = cvt_pk_bf16(v1[2], v1[3]);
                    *(u32x4*)(P + (size_t)row * PROJ + c0) = w;
                }
        }
    }
};
struct EpiX {
    static constexpr bool PERM = false;
    float* xl; float* xc; const float* modl;
    __device__ __forceinline__ void operator()(const f32x4 (&acc)[2][2][4][2], const Unit& u, int wr, int wc, int fr, int fq) const {
        const int b = u.m0 < RL ? u.m0 / SEQ : NB; const float* g1 = modl + (size_t)b * 6 * D + M_G1;
        f32x4 gv[2][2];
#pragma unroll
        for (int bj = 0; bj < 2; ++bj)
#pragma unroll
            for (int n = 0; n < 2; ++n) gv[bj][n] = *(const f32x4*)(g1 + u.pn * BM + bj * HALF + wc * 32 + n * 16 + 4 * fq);
#pragma unroll
        for (int ai = 0; ai < 2; ++ai)
#pragma unroll
            for (int m = 0; m < 4; ++m) {
                const int row = u.m0 + ai * HALF + wr * 64 + m * 16 + fr; float* xr = xrow_ptr(xl, xc, row) + u.pn * BM + wc * 32 + 4 * fq;
#pragma unroll
                for (int bj = 0; bj < 2; ++bj)
#pragma unroll
                    for (int n = 0; n < 2; ++n) { float* p = xr + bj * HALF + n * 16; const f32x4 xv = *(const f32x4*)p; *(f32x4*)p = xv + gv[bj][n] * acc[ai][bj][m][n]; }
                if (m & 1) asm volatile("" ::: "memory");
            }
    }
};
__device__ __forceinline__ float silu_fast(float v) { return v * __builtin_amdgcn_rcpf(1.0f + __builtin_amdgcn_exp2f(-LOG2E * v)); }
struct EpiH {
    static constexpr bool PERM = true;
    bf16_t* H;
    __device__ __forceinline__ void operator()(const f32x4 (&acc)[2][2][4][2], const Unit& u, int wr, int wc, int fr, int fq) const {
        const int hc = u.pn * HALF + wc * 32 + 8 * fq;
#pragma unroll
        for (int ai = 0; ai < 2; ++ai)
#pragma unroll
            for (int m = 0; m < 4; ++m) {
                const int row = u.m0 + ai * HALF + wr * 64 + m * 16 + fr;
                const f32x4 g0 = acc[ai][0][m][0], g1 = acc[ai][0][m][1], u0 = acc[ai][1][m][0], u1 = acc[ai][1][m][1];
                u32x4 w;
                w.x = cvt_pk_bf16(silu_fast(g0[0]) * u0[0], silu_fast(g0[1]) * u0[1]); w.y = cvt_pk_bf16(silu_fast(g0[2]) * u0[2], silu_fast(g0[3]) * u0[3]);
                w.z = cvt_pk_bf16(silu_fast(g1[0]) * u1[0], silu_fast(g1[1]) * u1[1]); w.w = cvt_pk_bf16(silu_fast(g1[2]) * u1[2], silu_fast(g1[3]) * u1[3]);
                *(u32x4*)(H + (size_t)row * FF + hc) = w;
            }
    }
};
struct EpiY {
    static constexpr bool PERM = true;
    bf16_t* Y; const float* gate;
    __device__ __forceinline__ void operator()(const f32x4 (&acc)[2][2][4][2], const Unit& u, int wr, int wc, int fr, int fq) const {
#pragma unroll
        for (int ai = 0; ai < 2; ++ai)
#pragma unroll
            for (int m = 0; m < 4; ++m) {
                const int row = u.m0 + ai * HALF + wr * 64 + m * 16 + fr; const float gt = gate[row];
#pragma unroll
                for (int bj = 0; bj < 2; ++bj) {
                    const f32x4 v0 = acc[ai][bj][m][0] * gt, v1 = acc[ai][bj][m][1] * gt;
                    u32x4 w; w.x = cvt_pk_bf16(v0[0], v0[1]); w.y = cvt_pk_bf16(v0[2], v0[3]); w.z = cvt_pk_bf16(v1[0], v1[1]); w.w = cvt_pk_bf16(v1[2], v1[3]);
                    *(u32x4*)(Y + (size_t)row * D + u.pn * BM + bj * HALF + wc * 32 + 8 * fq) = w;
                }
            }
    }
};
}

struct Args { const float* in[19]; float* out; unsigned char* ws; int ph_lo, ph_hi; };
struct Ctx {
    Ptrs p; LAS unsigned char* lds;
    float *tab, *mod, *aff, *gate, *xc, *xl; int *sel, *tokslot;
    bf16_t *win, *wout, *P, *H, *Y, *MIX, *HX2, *HX; float* TMP;
};
template <class Dest>
__device__ __forceinline__ void transpose_item(const float* W, int K, int N, bf16_t* WT, LAS float* scr, int item, int lane, Dest dest) {
    const int nblk = N / 32, kb = item / nblk, nb = item % nblk, k0 = 64 * kb, n0 = 32 * nb;
#pragma unroll 8
    for (int i = 0; i < 32; ++i) { const int kk = 2 * i + (lane >> 5); scr[kk * 33 + (lane & 31)] = W[(size_t)(k0 + kk) * N + n0 + (lane & 31)]; }
    LDS_WAIT(); asm volatile("" ::: "memory");
    const int c = lane & 7;
#pragma unroll
    for (int j = 0; j < 4; ++j) { const int n = (lane >> 3) + 8 * j; const LAS float* s = scr + (8 * c) * 33 + n;
        u32x4 o; o.x = cvt_pk_bf16(s[0 * 33], s[1 * 33]); o.y = cvt_pk_bf16(s[2 * 33], s[3 * 33]); o.z = cvt_pk_bf16(s[4 * 33], s[5 * 33]); o.w = cvt_pk_bf16(s[6 * 33], s[7 * 33]);
        *(u32x4*)(WT + (size_t)dest(n0 + n) * K + k0 + 8 * c) = o; }
    LDS_WAIT(); asm volatile("" ::: "memory");
}
HD int invA(int q) { const int g = q / 32, r = q % 32; return 32 * g + (r < 16 ? 2 * r : 2 * (r - 16) + 1); }
HD int invD(int q) { const int g = q / 16, r = q % 16; return 16 * g + (r < 8 ? 2 * r : 2 * (r - 8) + 1); }
HD int inproj_dst_row(int nl) {
    if (nl < C_VA) return (nl / 64) * 64 + invA(nl % 64);
    if (nl >= C_QD && nl < C_VD) return (nl / 32) * 32 + invD(nl % 32);
    return nl;
}
struct DestIn { __device__ int operator()(int n) const { return inproj_dst_row(n); } };
struct DestId { __device__ int operator()(int n) const { return n; } };
struct DestGU { int up; __device__ int operator()(int n) const { return (n / 128) * 256 + up * 128 + n % 128; } };

__device__ __forceinline__ void phase_prologue(const Ctx& C) {
    const int tid = tid_l(), lane = tid & 63, wave = __builtin_amdgcn_readfirstlane(tid >> 6), gw = blockIdx.x * NWV + wave, NGW = gridDim.x * NWV; (void)lane; (void)gw; (void)NGW;
    for (long g = (long)blockIdx.x * NT + tid; g < (long)(NROWS + 64) * 24; g += (long)gridDim.x * NT) {
        const int pos = (int)(g / 24), f = (int)(g % 24);
        const double inv = f < 16 ? pow(10000.0, -(2.0 * f) / 32.0) : pow(10000.0, -(2.0 * (f - 16)) / 16.0);
        const bool isrow = pos < NROWS; const int p = isrow ? pos : pos - NROWS;
        const double ang = (double)p * inv; const float cs = (float)cos(ang), sn = (float)sin(ang);
        const int idx = f < 16 ? (isrow ? T_AROW : T_ACOL) + (p * 16 + f) * 2 : (isrow ? T_DROW : T_DCOL) + (p * 8 + (f - 16)) * 2;
        C.tab[idx] = cs; C.tab[idx + 1] = sn;
    }
    LAS float* sl = (LAS float*)C.lds;
    for (int i = tid; i < (NB + 1) * D; i += NT) { const int b = i / D, k = i % D; sl[i] = silu_f(b < NB ? C.p.c[b * D + k] : C.p.c_ctx[k]); }
    __syncthreads();
    constexpr int BG = 11, NBG = (NB + 1) / BG; static_assert(NBG * BG == NB + 1, "adaLN rows split in groups of 11");
    for (int task = gw; task < (DEPTH * 6 * D / 64) * NBG; task += NGW) {
        const int chunk = task / NBG, bg = task % NBG, jg = chunk * 64 + lane, l = jg / (6 * D), j = jg % (6 * D);
        float acc[BG];
#pragma unroll
        for (int b = 0; b < BG; ++b) acc[b] = 0.f;
        const float* w = C.p.w_ada + (size_t)l * D * 6 * D + j; const LAS float* s0 = sl + bg * BG * D;
#pragma unroll 8
        for (int k = 0; k < D; ++k) { const float wv = w[(size_t)k * 6 * D];
#pragma unroll
            for (int b = 0; b < BG; ++b) acc[b] += s0[b * D + k] * wv; }
        const float bias = C.p.b_ada[l * 6 * D + j];
#pragma unroll
        for (int b = 0; b < BG; ++b) C.mod[((size_t)l * (NB + 1) + bg * BG + b) * 6 * D + j] = acc[b] + bias;
    }
    __syncthreads();
    LAS float* scr = (LAS float*)(C.lds + wave * 16384);
    constexpr int I_IN = (D / 64) * (PROJ / 32), I_OUT = (D / 64) * (D / 32);
    for (int it = gw; it < DEPTH * (I_IN + I_OUT); it += NGW) {
        const int l = it / (I_IN + I_OUT), r = it % (I_IN + I_OUT);
        if (r < I_IN) transpose_item(C.p.w_in + (size_t)l * D * PROJ, D, PROJ, C.win + (size_t)l * PROJ * D, scr, r, lane, DestIn{});
        else transpose_item(C.p.w_out + (size_t)l * D * D, D, D, C.wout + (size_t)l * D * D, scr, r - I_IN, lane, DestId{});
    }
    __syncthreads();
}
__device__ __forceinline__ void phase_cvt_experts(const Ctx& C, int l) {
    const int tid = tid_l(), lane = tid & 63, wave = __builtin_amdgcn_readfirstlane(tid >> 6), gw = blockIdx.x * NWV + wave, NGW = gridDim.x * NWV; (void)lane; (void)gw; (void)NGW;
    LAS float* scr = (LAS float*)(C.lds + wave * 16384);
    bf16_t* wgu = (bf16_t*)(C.p.ws + WS_WGU) + (size_t)(l & 1) * NE * 2 * FF * D; bf16_t* wd = (bf16_t*)(C.p.ws + WS_WD) + (size_t)(l & 1) * NE * D * FF;
    constexpr int I_E = (D / 64) * (FF / 32);
    for (int it = gw; it < 3 * NE * I_E; it += NGW) {
        const int mat = it / (NE * I_E), e = (it / I_E) % NE, r = it % I_E;
        const size_t wo = ((size_t)l * NE + e) * D * FF;
        if (mat == 0) transpose_item(C.p.w_gate + wo, D, FF, wgu + (size_t)e * 2 * FF * D, scr, r, lane, DestGU{0});
        else if (mat == 1) transpose_item(C.p.w_up + wo, D, FF, wgu + (size_t)e * 2 * FF * D, scr, r, lane, DestGU{1});
        else transpose_item(C.p.w_down + wo, FF, D, wd + (size_t)e * D * FF, scr, r, lane, DestId{});
    }
    __syncthreads();
}
template <bool FINAL>
__device__ __forceinline__ void phase_rowA(const Ctx& C, int l) {
    const int tid = tid_l(), lane = tid & 63, wave = __builtin_amdgcn_readfirstlane(tid >> 6), gw = blockIdx.x * NWV + wave, NGW = gridDim.x * NWV; (void)lane; (void)gw; (void)NGW;
    const int nrows = FINAL ? RL : RALL;
    for (int row = gw; row < nrows; row += NGW) {
        const float* src = (l == 0) ? (row < RL ? C.p.x + (size_t)row * D : C.p.ctx + (size_t)(row - RL) * D) : xrow_ptr(C.xl, C.xc, row);
        float* dst = xrow_ptr(C.xl, C.xc, row); const int b = row_batch(row);
        f32x4 v[4];
#pragma unroll
        for (int j = 0; j < 4; ++j) v[j] = *(const f32x4*)(src + 4 * lane + 256 * j);
        if (l > 0) {
            const int ts = lane < NE ? C.tokslot[(size_t)row * NE + lane] : -1;
            f32x4 a[4];
#pragma unroll
            for (int j = 0; j < 4; ++j) a[j] = (f32x4){0.f, 0.f, 0.f, 0.f};
            for (int e = 0; e < NE; ++e) { const int s = __shfl(ts, e); if (s < 0) continue;
                const bf16_t* yr = C.Y + (size_t)s * D + 4 * lane;
#pragma unroll
                for (int j = 0; j < 4; ++j) { const u32x2 w = *(const u32x2*)(yr + 256 * j);
                    a[j][0] += __builtin_bit_cast(float, w.x << 16); a[j][1] += __builtin_bit_cast(float, w.x & 0xffff0000u); a[j][2] += __builtin_bit_cast(float, w.y << 16); a[j][3] += __builtin_bit_cast(float, w.y & 0xffff0000u); } }
            const float* g2 = C.mod + ((size_t)(l - 1) * (NB + 1) + b) * 6 * D + M_G2 + 4 * lane;
#pragma unroll
            for (int j = 0; j < 4; ++j) v[j] = v[j] + *(const f32x4*)(g2 + 256 * j) * a[j];
        }
        float ss = 0.f;
#pragma unroll
        for (int j = 0; j < 4; ++j) ss += (v[j][0] * v[j][0] + v[j][1] * v[j][1]) + (v[j][2] * v[j][2] + v[j][3] * v[j][3]);
        const float rstd = 1.0f / sqrtf(wave_sum(ss) * (1.0f / D) + EPS);
        if (FINAL) {
#pragma unroll
            for (int j = 0; j < 4; ++j) *(f32x4*)(dst + 4 * lane + 256 * j) = v[j] * rstd * *(const f32x4*)(C.p.norm_final + 4 * lane + 256 * j);
        } else {
            if (l == 0 || l > 0) {
#pragma unroll
                for (int j = 0; j < 4; ++j) *(f32x4*)(dst + 4 * lane + 256 * j) = v[j];
            }
            const float* m = C.mod + ((size_t)l * (NB + 1) + b) * 6 * D + 4 * lane; const float* nw = C.p.norm1 + (size_t)l * D + 4 * lane;
            bf16_t* hr = C.HX + (size_t)row * D + 4 * lane;
#pragma unroll
            for (int j = 0; j < 4; ++j) { const f32x4 h = v[j] * rstd * *(const f32x4*)(nw + 256 * j) * (*(const f32x4*)(m + M_SC1 + 256 * j) + 1.0f) + *(const f32x4*)(m + M_SH1 + 256 * j);
                u32x2 w; w.x = cvt_pk_bf16(h[0], h[1]); w.y = cvt_pk_bf16(h[2], h[3]); *(u32x2*)(hr + 256 * j) = w; }
        }
    }
}
__device__ __forceinline__ void phase_rowB(const Ctx& C, int l, int nq) {
    const int tid = tid_l(), lane = tid & 63, wave = __builtin_amdgcn_readfirstlane(tid >> 6), gw = blockIdx.x * NWV + wave, NGW = gridDim.x * NWV; (void)lane; (void)gw; (void)NGW;
    LAS float* R = (LAS float*)C.lds;
    const float* rt = C.p.router + (size_t)l * D * NE;
    for (int i = tid; i < D * NE; i += NT) R[(i % NE) * D + i / NE] = rt[i];
    __syncthreads();
    for (int row = gw; row < nq; row += NGW) {
        const float* xr = xrow_ptr(C.xl, C.xc, row); const int b = row_batch(row);
        f32x4 v[4]; float ss = 0.f;
#pragma unroll
        for (int j = 0; j < 4; ++j) { v[j] = *(const f32x4*)(xr + 4 * lane + 256 * j); ss += (v[j][0] * v[j][0] + v[j][1] * v[j][1]) + (v[j][2] * v[j][2] + v[j][3] * v[j][3]); }
        const float rstd = 1.0f / sqrtf(wave_sum(ss) * (1.0f / D) + EPS);
        const float* m = C.mod + ((size_t)l * (NB + 1) + b) * 6 * D + 4 * lane; const float* nw = C.p.norm2 + (size_t)l * D + 4 * lane;
        bf16_t* hr = C.HX2 + (size_t)row * D + 4 * lane;
#pragma unroll
        for (int j = 0; j < 4; ++j) { v[j] = v[j] * rstd * *(const f32x4*)(nw + 256 * j) * (*(const f32x4*)(m + M_SC2 + 256 * j) + 1.0f) + *(const f32x4*)(m + M_SH2 + 256 * j);
            u32x2 w; w.x = cvt_pk_bf16(v[j][0], v[j][1]); w.y = cvt_pk_bf16(v[j][2], v[j][3]); *(u32x2*)(hr + 256 * j) = w; }
        float lg[NE]; float mx = -1e30f;
#pragma unroll
        for (int e = 0; e < NE; ++e) { float s = 0.f;
#pragma unroll
            for (int j = 0; j < 4; ++j) { const f32x4 r4 = *(const LAS f32x4*)(R + e * D + 4 * lane + 256 * j); s += (v[j][0] * r4[0] + v[j][1] * r4[1]) + (v[j][2] * r4[2] + v[j][3] * r4[3]); }
            lg[e] = wave_sum(s); mx = fmaxf(mx, lg[e]); }
        float se = 0.f;
#pragma unroll
        for (int e = 0; e < NE; ++e) { lg[e] = expf(lg[e] - mx); se += lg[e]; }
        float mine = 0.f;
#pragma unroll
        for (int e = 0; e < NE; ++e) mine = (lane == e) ? lg[e] / se : mine;
        if (lane < NE) C.aff[(size_t)row * NE + lane] = mine;
    }
    __syncthreads();
}
template <int NV>
__device__ __forceinline__ void select_task(const Ctx& C, int base_row, int cap, int e, int slot0, int lane) {
    unsigned v[NV];
#pragma unroll
    for (int i = 0; i < NV; ++i) v[i] = __builtin_bit_cast(unsigned, C.aff[(size_t)(base_row + i * 64 + lane) * NE + e]);
    unsigned T = 0u;
    for (int bit = 30; bit >= 0; --bit) { const unsigned cand = T | (1u << bit); int cnt = 0;
#pragma unroll
        for (int i = 0; i < NV; ++i) cnt += __builtin_popcountll(__ballot(v[i] >= cand));
        if (cnt >= cap) T = cand; }
    int ngt = 0;
#pragma unroll
    for (int i = 0; i < NV; ++i) ngt += __builtin_popcountll(__ballot(v[i] > T));
    const int need = cap - ngt;
    const unsigned long long lt = (1ull << lane) - 1ull; int nsel = 0, neq = 0;
#pragma unroll
    for (int i = 0; i < NV; ++i) {
        const bool gt = v[i] > T, eq = v[i] == T; const unsigned long long meq = __ballot(eq);
        const bool take = gt || (eq && (neq + __builtin_popcountll(meq & lt)) < need);
        const unsigned long long msel = __ballot(take);
        const int row = base_row + i * 64 + lane; int slot = -1;
        if (take) { slot = slot0 + nsel + __builtin_popcountll(msel & lt); C.sel[slot] = row; C.gate[slot] = __builtin_bit_cast(float, v[i]); }
        C.tokslot[(size_t)row * NE + e] = slot;
        nsel += __builtin_popcountll(msel); neq += __builtin_popcountll(meq);
    }
}
__device__ __forceinline__ void phase_select(const Ctx& C, bool need_ctx) {
    const int tid = tid_l(), lane = tid & 63, wave = __builtin_amdgcn_readfirstlane(tid >> 6), gw = blockIdx.x * NWV + wave, NGW = gridDim.x * NWV; (void)lane; (void)gw; (void)NGW;
    const int ntask = NB * NE * (need_ctx ? 2 : 1);
    for (int task = gw; task < ntask; task += NGW) {
        const int set = task / (NB * NE), b = (task / NE) % NB, e = task % NE;
        if (set == 0) select_task<SEQ / 64>(C, b * SEQ, CAPL, e, e * SLOTS_E + b * CAPL, lane);
        else select_task<CTX / 64>(C, RL + b * CTX, CAPC, e, e * SLOTS_E + SLOTS_L + b * CAPC, lane);
    }
}
__device__ __forceinline__ void phase_mix_naive(const Ctx& C, int l, int nq) {
    const int tid = tid_l(), lane = tid & 63, wave = __builtin_amdgcn_readfirstlane(tid >> 6), gw = blockIdx.x * NWV + wave, NGW = gridDim.x * NWV; (void)lane; (void)gw; (void)NGW;
    const long g0 = (long)blockIdx.x * NT + tid, gs = (long)gridDim.x * NT; const float lam_init = 0.8f - 0.6f * expf(-0.3f * (float)l);
    for (long g = g0; g < (long)nq * NHA; g += gs) b_attnA(g, C.P, C.p.attn_sink + l * NHA, C.MIX, nq);
    for (long g = g0; g < (long)nq * NHC * 2; g += gs) b_attnD(g, C.P, C.TMP, nq);
    for (long g = g0; g < (long)nq * CONV_CH; g += gs) b_conv(g, C.P, C.p.conv_w + l * 3 * CONV_CH, C.MIX, nq);
}
__device__ __forceinline__ void phase_diffpost_naive(const Ctx& C, int l, int nq) {
    const int tid = tid_l(), lane = tid & 63, wave = __builtin_amdgcn_readfirstlane(tid >> 6), gw = blockIdx.x * NWV + wave, NGW = gridDim.x * NWV; (void)lane; (void)gw; (void)NGW;
    const long g0 = (long)blockIdx.x * NT + tid, gs = (long)gridDim.x * NT; const float lam_init = 0.8f - 0.6f * expf(-0.3f * (float)l);
    for (long g = g0; g < (long)nq * NHC; g += gs) b_diffpost(g, C.TMP, C.p.diff_lambda + l * 4 * DD, C.p.diff_subln + l * 2 * DD, lam_init, C.MIX, nq);
}

constexpr int NPH = 9, PH_FINAL = 1 + DEPTH * NPH, PH_TOTAL = PH_FINAL + 1;
__global__ void __launch_bounds__(NT, 2) mega_fwd(Args args) {
    extern __shared__ __attribute__((aligned(16))) unsigned char lds_raw[];
    Ctx C;
    C.p.x = args.in[0]; C.p.c = args.in[1]; C.p.ctx = args.in[2]; C.p.c_ctx = args.in[3]; C.p.w_ada = args.in[4]; C.p.b_ada = args.in[5]; C.p.norm1 = args.in[6]; C.p.norm2 = args.in[7];
    C.p.w_in = args.in[8]; C.p.w_out = args.in[9]; C.p.attn_sink = args.in[10]; C.p.conv_w = args.in[11]; C.p.diff_lambda = args.in[12]; C.p.diff_subln = args.in[13]; C.p.router = args.in[14];
    C.p.w_gate = args.in[15]; C.p.w_up = args.in[16]; C.p.w_down = args.in[17]; C.p.norm_final = args.in[18];
    C.p.out = args.out; C.p.ws = args.ws;
    C.lds = (LAS unsigned char*)lds_raw;
    unsigned char* ws = args.ws;
    C.tab = (float*)(ws + WS_TAB); C.mod = (float*)(ws + WS_MOD); C.aff = (float*)(ws + WS_AFF); C.sel = (int*)(ws + WS_SEL); C.gate = (float*)(ws + WS_GATE); C.tokslot = (int*)(ws + WS_TOKSLOT);
    C.xc = (float*)(ws + WS_XC); C.xl = args.out; C.win = (bf16_t*)(ws + WS_WIN); C.wout = (bf16_t*)(ws + WS_WOUT);
    C.P = (bf16_t*)(ws + WS_R1); C.H = (bf16_t*)(ws + WS_R1); C.Y = (bf16_t*)(ws + WS_R2); C.MIX = (bf16_t*)(ws + WS_R2); C.HX2 = (bf16_t*)(ws + WS_R2 + (size_t)RALL * D * 2); C.TMP = (float*)C.HX2;
    C.HX = (bf16_t*)(ws + WS_R3);
    volatile LAS unsigned* misc = (volatile LAS unsigned*)(C.lds + LDS_MISC);
    if (threadIdx.x < 64) misc[threadIdx.x] = 0u;
    __syncthreads();
    const int lo = args.ph_lo, hi = args.ph_hi;
    XcdBarrier bar; bar.bar = (unsigned*)(ws + WS_CTL) + CW_BAR; bar.x = 0; bar.st = misc;
    if (hi - lo > 1) bar = xcd_barrier_post((unsigned*)(ws + WS_CTL) + CW_BAR, misc);
#define IN(k) (lo <= (k) && (k) < hi)
#define SEAM(k) do { if (IN(k) && IN((k) + 1)) xcd_barrier(bar); } while (0)
    const int G = (int)gridDim.x, bid = (int)blockIdx.x;
    if (IN(0)) phase_prologue(C);
    SEAM(0);
    for (int l = 0; l < DEPTH; ++l) {
        const int pb = 1 + l * NPH; const bool need_ctx = l < DEPTH - 1; const int nq = need_ctx ? RALL : RL;
        const float* modl = C.mod + (size_t)l * (NB + 1) * 6 * D;
        if (IN(pb + 0)) { phase_cvt_experts(C, l); phase_rowA<false>(C, l); }
        SEAM(pb + 0);
        if (IN(pb + 1)) { pg::GemmD g{(const char*)C.HX, nullptr, (const char*)(C.win + (size_t)l * PROJ * D), 0, D}; pg::Order S; S.init(RALL / 256, PROJ / 256, G, bid, 0);
            pg::EpiP E{C.P, C.tab}; pg::gemm_phase<pg::EpiP, false>(C.lds, g, S, E); }
        SEAM(pb + 1);
        if (IN(pb + 2)) phase_mix_naive(C, l, nq);
        SEAM(pb + 2);
        if (IN(pb + 3)) phase_diffpost_naive(C, l, nq);
        SEAM(pb + 3);
        if (IN(pb + 4)) { pg::GemmD g{(const char*)C.MIX, nullptr, (const char*)(C.wout + (size_t)l * D * D), 0, D}; pg::Order S; S.init(nq / 256, D / 256, G, bid, 0);
            pg::EpiX E{C.xl, C.xc, modl}; pg::gemm_phase<pg::EpiX, false>(C.lds, g, S, E); }
        SEAM(pb + 4);
        if (IN(pb + 5)) phase_rowB(C, l, nq);
        SEAM(pb + 5);
        if (IN(pb + 6)) phase_select(C, need_ctx);
        SEAM(pb + 6);
        const int tpe = need_ctx ? pg::TPE_FULL : SLOTS_L / 256;
        if (IN(pb + 7)) { pg::GemmD g{(const char*)C.HX2, C.sel, (const char*)((bf16_t*)(ws + WS_WGU) + (size_t)(l & 1) * NE * 2 * FF * D), (size_t)2 * FF * D * 2, D}; pg::Order S; S.init(NE * tpe, 2 * FF / 256, G, bid, tpe);
            pg::EpiH E{C.H}; pg::gemm_phase<pg::EpiH, true>(C.lds, g, S, E); }
        SEAM(pb + 7);
        if (IN(pb + 8)) { pg::GemmD g{(const char*)C.H, nullptr, (const char*)((bf16_t*)(ws + WS_WD) + (size_t)(l & 1) * NE * D * FF), (size_t)D * FF * 2, FF}; pg::Order S; S.init(NE * tpe, D / 256, G, bid, tpe);
            pg::EpiY E{C.Y, C.gate}; pg::gemm_phase<pg::EpiY, false>(C.lds, g, S, E); }
        SEAM(pb + 8);
    }
    if (IN(PH_FINAL)) phase_rowA<true>(C, DEPTH);
#undef IN
#undef SEAM
}
#endif

#ifndef HOST_TEST
#ifndef MODE
#define MODE 2
#endif
extern "C" void kernel_launch(void* const* d_in, const int* in_sizes, int n_in, void* d_out, int out_size, void* d_ws, size_t ws_size, hipStream_t stream) {
    if (n_in != 19 || out_size != RL * D || ws_size < WS_END) { fprintf(stderr, "kernel_launch: unexpected shapes (n_in %d out %d ws %zu need %zu)\n", n_in, out_size, ws_size, (size_t)WS_END); return; }
#if MODE == 0
    Ptrs p{};
    const float** f = (const float**)&p;
    for (int i = 0; i < 19; ++i) f[i] = (const float*)d_in[i];
    p.out = (float*)d_out; p.ws = (unsigned char*)d_ws;
    forward(p, stream);
#else
    static int grid = 0;
    if (grid == 0) {
        int dev = 0, cus = 0;
        if (hipGetDevice(&dev) != hipSuccess || hipDeviceGetAttribute(&cus, hipDeviceAttributeMultiprocessorCount, dev) != hipSuccess) { fprintf(stderr, "kernel_launch: device query failed\n"); grid = -1; return; }
        if (hipFuncSetAttribute((const void*)mega_fwd, hipFuncAttributeMaxDynamicSharedMemorySize, LDS_BYTES) != hipSuccess) { fprintf(stderr, "kernel_launch: hipFuncSetAttribute failed\n"); grid = -1; return; }
        int per_cu = 0;
        if (hipOccupancyMaxActiveBlocksPerMultiprocessor(&per_cu, (const void*)mega_fwd, NT, LDS_BYTES) != hipSuccess || per_cu < 1) fprintf(stderr, "kernel_launch: occupancy query reports %d blocks per CU\n", per_cu);
        (void)hipGetLastError();
        grid = cus;
    }
    if (grid < 0) return;
    if (hipMemsetAsync((char*)d_ws + WS_CTL, 0, CTL_BYTES, stream) != hipSuccess) { fprintf(stderr, "kernel_launch: memset failed\n"); return; }
    Args a{};
    for (int i = 0; i < 19; ++i) a.in[i] = (const float*)d_in[i];
    a.out = (float*)d_out; a.ws = (unsigned char*)d_ws;
#if MODE == 2
    a.ph_lo = 0; a.ph_hi = PH_TOTAL;
    hipLaunchKernelGGL(mega_fwd, dim3(grid), dim3(NT), LDS_BYTES, stream, a);
#else
    for (int ph = 0; ph < PH_TOTAL; ++ph) { a.ph_lo = ph; a.ph_hi = ph + 1; hipLaunchKernelGGL(mega_fwd, dim3(grid), dim3(NT), LDS_BYTES, stream, a); }
#endif
    const hipError_t le = hipPeekAtLastError();
    if (le != hipSuccess) fprintf(stderr, "kernel_launch: launch failed: %s\n", hipGetErrorName(le));
#endif
}
#else
#include <vector>
#include <string>
static std::vector<float> rd(const std::string& fn) { FILE* f = fopen(fn.c_str(), "rb"); if (!f) { perror(fn.c_str()); exit(1); } fseek(f, 0, SEEK_END); long n = ftell(f); fseek(f, 0, SEEK_SET); std::vector<float> v(n / 4); if (fread(v.data(), 1, n, f) != (size_t)n) exit(1); fclose(f); return v; }
int main(int argc, char** argv) {
    std::string dir = argv[1]; std::vector<std::vector<float>> in(19);
    for (int i = 0; i < 19; ++i) in[i] = rd(dir + "/in" + std::to_string(i) + ".bin");
    std::vector<float> out((size_t)RL * D); std::vector<unsigned char> ws(WS_END, 0xAA);
    Ptrs p{}; const float** f = (const float**)&p; for (int i = 0; i < 19; ++i) f[i] = in[i].data();
    p.out = out.data(); p.ws = ws.data();
    forward(p, 0);
    FILE* fo = fopen((dir + "/out.bin").c_str(), "wb"); fwrite(out.data(), 4, out.size(), fo); fclose(fo);
    printf("done, ws bytes %zu\n", (size_t)WS_END); return 0;
}
#endif
```

```cpp
#ifndef HOST_TEST
#include <hip/hip_runtime.h>
#endif
#include <cstdio>
#include <cstdint>
#include <cstring>
#include <cmath>

#ifndef CFG_B
#define CFG_B 32
#endif
#ifndef CFG_SEQ
#define CFG_SEQ 2048
#endif
#ifndef CFG_CTX
#define CFG_CTX 256
#endif
#ifndef CFG_DEPTH
#define CFG_DEPTH 4
#endif
constexpr int D = 1024, NB = CFG_B, SEQ = CFG_SEQ, CTX = CFG_CTX, DEPTH = CFG_DEPTH;
constexpr int GRID_W = 64, NROWS = SEQ / GRID_W, HDIM = 64, NHA = 8, NKVA = 2, GQA = 4, WINDOW = 128;
constexpr int CONV_CH = 256, DD = 32, NHC = 4, NE = 16, FF = 1024, PROJ = 2304;
constexpr int RL = NB * SEQ, RC = NB * CTX, RALL = RL + RC;
constexpr int CAPL = 2 * SEQ / NE, CAPC = 2 * CTX / NE;
constexpr int SLOTS_L = NB * CAPL, SLOTS_C = NB * CAPC, SLOTS_E = SLOTS_L + SLOTS_C;
constexpr int NSLOT = NE * SLOTS_E;
constexpr int C_QA = 0, C_KA = 512, C_VA = 640, C_CIN = 768, C_CB = 1024, C_CC = 1280, C_QD = 1536, C_KD = 1792, C_VD = 2048;
constexpr int M_SH1 = 0, M_SC1 = D, M_G1 = 2 * D, M_SH2 = 3 * D, M_SC2 = 4 * D, M_G2 = 5 * D;
constexpr float EPS = 1e-6f, LOG2E = 1.4426950408889634f;
constexpr float QSCALE_A = 0.125f * LOG2E, QSCALE_D = 0.17677669529663687f * LOG2E;

#ifdef HOST_TEST
#define HD
#define KERNEL static void
static thread_local long g_gid;
#define GID g_gid
#include <omp.h>
#define LAUNCH(kern, nthreads, ...) do { const long _n = (long)(nthreads); _Pragma("omp parallel for schedule(static)") for (long _g = 0; _g < _n; ++_g) { g_gid = _g; kern(__VA_ARGS__); } } while (0)
#else
#define HD __host__ __device__ __forceinline__
#define KERNEL __global__ void __launch_bounds__(256)
#define GID ((long)blockIdx.x * blockDim.x + threadIdx.x)
#define LAUNCH(kern, nthreads, ...) do { const long _n = (long)(nthreads); if (_n > 0) hipLaunchKernelGGL(kern, dim3((unsigned)((_n + 255) / 256)), dim3(256), 0, stream, __VA_ARGS__); } while (0)
#endif

typedef unsigned short bf16_t;
HD float bf2f(bf16_t v) { unsigned u = (unsigned)v << 16; return __builtin_bit_cast(float, u); }
HD bf16_t f2bf(float f) { unsigned u = __builtin_bit_cast(unsigned, f); return (bf16_t)((u + 0x7fffu + ((u >> 16) & 1u)) >> 16); }

constexpr size_t al256(size_t x) { return (x + 255) & ~(size_t)255; }
constexpr size_t WS_CTL = 0, CTL_BYTES = 1u << 20;
constexpr size_t WS_TAB = WS_CTL + CTL_BYTES;
constexpr int T_AROW = 0, T_ACOL = T_AROW + NROWS * 16 * 2, T_DROW = T_ACOL + 64 * 16 * 2, T_DCOL = T_DROW + NROWS * 8 * 2, T_END = T_DCOL + 64 * 8 * 2;
constexpr size_t WS_SILU = WS_TAB + al256((size_t)T_END * 4);
constexpr size_t WS_MOD = WS_SILU + al256((size_t)(NB + 1) * D * 4);
constexpr size_t WS_RSTD = WS_MOD + al256((size_t)DEPTH * (NB + 1) * 6 * D * 4);
constexpr size_t WS_AFF = WS_RSTD + al256((size_t)RALL * 4);
constexpr size_t WS_SEL = WS_AFF + al256((size_t)RALL * NE * 4);
constexpr size_t WS_GATE = WS_SEL + al256((size_t)NSLOT * 4);
constexpr size_t WS_TOKSLOT = WS_GATE + al256((size_t)NSLOT * 4);
constexpr size_t WS_XC = WS_TOKSLOT + al256((size_t)RALL * NE * 4);
constexpr size_t WS_WIN = WS_XC + al256((size_t)RC * D * 4);
constexpr size_t WS_WOUT = WS_WIN + al256((size_t)DEPTH * PROJ * D * 2);
constexpr size_t WS_WGU = WS_WOUT + al256((size_t)DEPTH * D * D * 2);
constexpr size_t WS_WD = WS_WGU + al256((size_t)2 * NE * 2 * FF * D * 2);
constexpr size_t WS_R1 = WS_WD + al256((size_t)2 * NE * D * FF * 2);
constexpr size_t R1_BYTES = al256(((size_t)RALL * PROJ * 2 > (size_t)NSLOT * FF * 2) ? (size_t)RALL * PROJ * 2 : (size_t)NSLOT * FF * 2);
constexpr size_t WS_R2 = WS_R1 + R1_BYTES;
constexpr size_t R2_BYTES = al256(((size_t)NSLOT * D * 2 > (size_t)2 * RALL * D * 2) ? (size_t)NSLOT * D * 2 : (size_t)2 * RALL * D * 2);
constexpr size_t WS_R3 = WS_R2 + R2_BYTES;
constexpr size_t WS_END = WS_R3 + al256((size_t)RALL * D * 2);

struct Ptrs {
    const float *x, *c, *ctx, *c_ctx, *w_ada, *b_ada, *norm1, *norm2, *w_in, *w_out, *attn_sink, *conv_w, *diff_lambda, *diff_subln, *router, *w_gate, *w_up, *w_down, *norm_final;
    float* out; unsigned char* ws;
};

HD float* xrow_ptr(float* xl, float* xc, int row) { return row < RL ? xl + (size_t)row * D : xc + (size_t)(row - RL) * D; }
HD int row_batch(int row) { return row < RL ? row / SEQ : NB; }
HD float silu_f(float v) { return v / (1.0f + expf(-v)); }

KERNEL k_tables(float* tab) {
    const long g = GID; if (g >= (long)(NROWS + 64) * 24) return;
    const int pos = (int)(g / 24), f = (int)(g % 24);
    const double inv = f < 16 ? pow(10000.0, -(2.0 * f) / 32.0) : pow(10000.0, -(2.0 * (f - 16)) / 16.0);
    const bool isrow = pos < NROWS; const int p = isrow ? pos : pos - NROWS;
    const double ang = (double)p * inv; const float cs = (float)cos(ang), sn = (float)sin(ang);
    int idx;
    if (f < 16) idx = (isrow ? T_AROW : T_ACOL) + (p * 16 + f) * 2; else idx = (isrow ? T_DROW : T_DCOL) + (p * 8 + (f - 16)) * 2;
    tab[idx] = cs; tab[idx + 1] = sn;
}
KERNEL k_silu(const float* c, const float* c_ctx, float* out) {
    const long g = GID; if (g >= (long)(NB + 1) * D) return;
    const int b = (int)(g / D), k = (int)(g % D); const float v = b < NB ? c[b * D + k] : c_ctx[k];
    out[g] = silu_f(v);
}
KERNEL k_mod(const float* silu, const float* w_ada, const float* b_ada, float* mod) {
    const long g = GID; if (g >= (long)DEPTH * 6 * D) return;
    const int l = (int)(g / (6 * D)), j = (int)(g % (6 * D));
    float acc[NB + 1];
#pragma unroll
    for (int b = 0; b <= NB; ++b) acc[b] = 0.f;
    const float* w = w_ada + (size_t)l * D * 6 * D + j;
    for (int k = 0; k < D; ++k) { const float wv = w[(size_t)k * 6 * D];
#pragma unroll
        for (int b = 0; b <= NB; ++b) acc[b] += silu[b * D + k] * wv; }
    const float bias = b_ada[l * 6 * D + j];
#pragma unroll
    for (int b = 0; b <= NB; ++b) mod[((size_t)l * (NB + 1) + b) * 6 * D + j] = acc[b] + bias;
}
HD int permA(int p) { return (p / 32) * 32 + (p % 32) / 2 + 16 * (p % 2); }
HD int permD(int p) { return (p / 16) * 16 + (p % 16) / 2 + 8 * (p % 2); }
HD int inproj_src_col(int n) {
    if (n < C_VA) return (n / 64) * 64 + permA(n % 64);
    if (n < C_QD) return n;
    if (n < C_VD) return (n / 32) * 32 + permD(n % 32);
    return n;
}
KERNEL k_cvt_win(const float* w_in, bf16_t* wt) {
    const long g = GID; if (g >= (long)DEPTH * PROJ * D) return;
    const int k = (int)(g % D); const int n = (int)((g / D) % PROJ); const int l = (int)(g / ((long)D * PROJ));
    wt[g] = f2bf(w_in[((size_t)l * D + k) * PROJ + inproj_src_col(n)]);
}
KERNEL k_cvt_t(const float* w, bf16_t* wt, int nmat, int K, int N) {
    const long g = GID; if (g >= (long)nmat * K * N) return;
    const int k = (int)(g % K); const int n = (int)((g / K) % N); const int m = (int)(g / ((long)K * N));
    wt[g] = f2bf(w[((size_t)m * K + k) * N + n]);
}
KERNEL k_cvt_gu(const float* wg, const float* wu, bf16_t* wt) {
    const long g = GID; if (g >= (long)NE * 2 * FF * D) return;
    const int k = (int)(g % D); const int n = (int)((g / D) % (2 * FF)); const int e = (int)(g / ((long)D * 2 * FF));
    const int blk = n / 256, bj = (n % 256) / 128, j = n % 128; const float* src = bj ? wu : wg;
    wt[g] = f2bf(src[((size_t)e * D + k) * FF + blk * 128 + j]);
}
KERNEL k_rowstat(const float* xl, const float* xc, float* rstd, int nrows) {
    const long g = GID; if (g >= nrows) return;
    const float* xr = xrow_ptr((float*)xl, (float*)xc, (int)g); float s = 0.f;
    for (int k = 0; k < D; ++k) s += xr[k] * xr[k];
    rstd[g] = 1.0f / sqrtf(s / D + EPS);
}
KERNEL k_rowapply(const float* xl, const float* xc, const float* rstd, const float* nw, const float* modl, int sh_off, int sc_off, bf16_t* hx, int nrows) {
    const long g = GID; if (g >= (long)nrows * D) return;
    const int row = (int)(g / D), k = (int)(g % D); const float* xr = xrow_ptr((float*)xl, (float*)xc, row);
    const float* m = modl + (size_t)row_batch(row) * 6 * D;
    const float v = xr[k] * rstd[row] * nw[k] * (1.0f + m[sc_off + k]) + m[sh_off + k];
    hx[g] = f2bf(v);
}
struct EpiInProj {
    bf16_t* P; const float* tab;
    HD void operator()(int row, int c0, const float* v, const float*) const {
        float o[4] = {v[0], v[1], v[2], v[3]};
        const bool lat = row < RL; const int pos = lat ? row % SEQ : 0; const int gr = pos / GRID_W, gc = pos % GRID_W;
        if (c0 < C_VA) {
            if (lat) { const int p = c0 % 64, grp = p / 32, i0 = (p % 32) / 2;
                const float* t = tab + (grp == 0 ? T_AROW + gr * 32 : T_ACOL + gc * 32) + i0 * 2;
                const float a0 = o[0], b0 = o[1], a1 = o[2], b1 = o[3];
                o[0] = a0 * t[0] - b0 * t[1]; o[1] = b0 * t[0] + a0 * t[1]; o[2] = a1 * t[2] - b1 * t[3]; o[3] = b1 * t[2] + a1 * t[3]; }
            if (c0 < C_KA) { for (int j = 0; j < 4; ++j) o[j] *= QSCALE_A; }
        } else if (c0 >= C_QD && c0 < C_VD) {
            if (lat) { const int p = c0 % 32, grp = p / 16, i0 = (p % 16) / 2;
                const float* t = tab + (grp == 0 ? T_DROW + gr * 16 : T_DCOL + gc * 16) + i0 * 2;
                const float a0 = o[0], b0 = o[1], a1 = o[2], b1 = o[3];
                o[0] = a0 * t[0] - b0 * t[1]; o[1] = b0 * t[0] + a0 * t[1]; o[2] = a1 * t[2] - b1 * t[3]; o[3] = b1 * t[2] + a1 * t[3]; }
            if (c0 < C_KD) { for (int j = 0; j < 4; ++j) o[j] *= QSCALE_D; }
        }
        bf16_t* d = P + (size_t)row * PROJ + c0;
        for (int j = 0; j < 4; ++j) d[j] = f2bf(o[j]);
    }
};
struct EpiOutProj {
    float* xl; float* xc; const float* modl;
    HD void operator()(int row, int c0, const float* v, const float*) const {
        float* xr = xrow_ptr(xl, xc, row) + c0; const float* g1 = modl + (size_t)row_batch(row) * 6 * D + M_G1 + c0;
        for (int j = 0; j < 4; ++j) xr[j] += g1[j] * v[j];
    }
};
struct EpiGateUp {
    bf16_t* H;
    HD void operator()(int row, int c0, const float* v, const float* u) const {
        bf16_t* d = H + (size_t)row * FF + c0;
        for (int j = 0; j < 4; ++j) d[j] = f2bf(silu_f(v[j]) * u[j]);
    }
};
struct EpiDown {
    bf16_t* Y; const float* gate;
    HD void operator()(int row, int c0, const float* v, const float*) const {
        const float g = gate[row]; bf16_t* d = Y + (size_t)row * D + c0;
        for (int j = 0; j < 4; ++j) d[j] = f2bf(v[j] * g);
    }
};
template <class Epi, bool DUAL>
KERNEL k_gemm_naive(const bf16_t* A, const int* rowidx, const bf16_t* Bt, int M, int N, int K, int group_rows, int valid_rows, long bstride, Epi epi) {
    const long g = GID; if (g >= (long)M * (N / 4)) return;
    const int row = (int)(g / (N / 4)), c0 = (int)(g % (N / 4)) * 4;
    if (row % group_rows >= valid_rows) return;
    const int arow = rowidx ? rowidx[row] : row;
    const bf16_t* a = A + (size_t)arow * K; const bf16_t* B = Bt + (size_t)(row / group_rows) * bstride;
    float v[4], u[4];
    for (int j = 0; j < 4; ++j) { const int c = c0 + j; const int br = DUAL ? (c / 128) * 256 + c % 128 : c;
        const bf16_t* b0 = B + (size_t)br * K; float s = 0.f, s2 = 0.f;
        for (int k = 0; k < K; ++k) s += bf2f(a[k]) * bf2f(b0[k]);
        if (DUAL) { const bf16_t* b1 = b0 + (size_t)128 * K; for (int k = 0; k < K; ++k) s2 += bf2f(a[k]) * bf2f(b1[k]); }
        v[j] = s; u[j] = s2; }
    epi(row, c0, v, u);
}
HD void b_attnA(const long g, const bf16_t* P, const float* sink, bf16_t* MIX, int nrows) {
    if (g >= (long)nrows * NHA) return;
    const int h = (int)(g / nrows), row = (int)(g % nrows), kvh = h / GQA;
    const bool lat = row < RL; const int b = lat ? row / SEQ : (row - RL) / CTX; const int t = lat ? row % SEQ : 0;
    float q[HDIM], o[HDIM];
    const bf16_t* qp = P + (size_t)row * PROJ + C_QA + h * HDIM;
#pragma unroll
    for (int d = 0; d < HDIM; ++d) { q[d] = bf2f(qp[d]); o[d] = 0.f; }
    float m = sink[h] * LOG2E, l = 1.0f;
    const int nctx = CTX, lo = lat ? (t - WINDOW < 0 ? 0 : t - WINDOW) : 0, hi = lat ? (t + WINDOW > SEQ - 1 ? SEQ - 1 : t + WINDOW) : -1;
    const int nkeys = nctx + (hi - lo + 1);
    for (int i = 0; i < nkeys; ++i) {
        const int krow = i < nctx ? RL + b * CTX + i : b * SEQ + lo + (i - nctx);
        const bf16_t* kp = P + (size_t)krow * PROJ + C_KA + kvh * HDIM; const bf16_t* vp = P + (size_t)krow * PROJ + C_VA + kvh * HDIM;
        float s = 0.f;
#pragma unroll
        for (int d = 0; d < HDIM; ++d) s += q[d] * bf2f(kp[d]);
        if (s > m) { const float sc = exp2f(m - s); l *= sc;
#pragma unroll
            for (int d = 0; d < HDIM; ++d) o[d] *= sc;
            m = s; }
        const float p = exp2f(s - m); l += p;
#pragma unroll
        for (int d = 0; d < HDIM; ++d) o[d] += p * bf2f(vp[d]);
    }
    const float inv = 1.0f / l; bf16_t* op = MIX + (size_t)row * D + h * HDIM;
#pragma unroll
    for (int d = 0; d < HDIM; ++d) op[d] = f2bf(o[d] * inv);
}
KERNEL k_attnA(const bf16_t* P, const float* sink, bf16_t* MIX, int nrows) { b_attnA(GID, P, sink, MIX, nrows); }
HD void b_attnD(const long g, const bf16_t* P, float* TMP, int nrows) {
    if (g >= (long)nrows * NHC * 2) return;
    const int hc = (int)(g / nrows), row = (int)(g % nrows), h = hc / 2, comp = hc % 2;
    const bool lat = row < RL; const int b = lat ? row / SEQ : (row - RL) / CTX;
    float q[DD], o[2 * DD];
    const bf16_t* qp = P + (size_t)row * PROJ + C_QD + h * 2 * DD + comp * DD;
#pragma unroll
    for (int d = 0; d < DD; ++d) q[d] = bf2f(qp[d]);
#pragma unroll
    for (int d = 0; d < 2 * DD; ++d) o[d] = 0.f;
    float m = -1e30f, l = 0.f;
    const int nkeys = CTX + (lat ? SEQ : 0);
    for (int i = 0; i < nkeys; ++i) {
        const int krow = i < CTX ? RL + b * CTX + i : b * SEQ + (i - CTX);
        const bf16_t* kp = P + (size_t)krow * PROJ + C_KD + h * 2 * DD + comp * DD; const bf16_t* vp = P + (size_t)krow * PROJ + C_VD + h * 2 * DD;
        float s = 0.f;
#pragma unroll
        for (int d = 0; d < DD; ++d) s += q[d] * bf2f(kp[d]);
        if (s > m) { const float sc = exp2f(m - s); l *= sc;
#pragma unroll
            for (int d = 0; d < 2 * DD; ++d) o[d] *= sc;
            m = s; }
        const float p = exp2f(s - m); l += p;
#pragma unroll
        for (int d = 0; d < 2 * DD; ++d) o[d] += p * bf2f(vp[d]);
    }
    const float inv = 1.0f / l; float* op = TMP + (((size_t)row * NHC + h) * 2 + comp) * 2 * DD;
#pragma unroll
    for (int d = 0; d < 2 * DD; ++d) op[d] = o[d] * inv;
}
KERNEL k_attnD(const bf16_t* P, float* TMP, int nrows) { b_attnD(GID, P, TMP, nrows); }
HD void b_diffpost(const long g, const float* TMP, const float* lam_p, const float* subln, float lam_init, bf16_t* MIX, int nrows) {
    if (g >= (long)nrows * NHC) return;
    const int row = (int)(g / NHC), h = (int)(g % NHC);
    float s01 = 0.f, s23 = 0.f;
    for (int d = 0; d < DD; ++d) { s01 += lam_p[d] * lam_p[DD + d]; s23 += lam_p[2 * DD + d] * lam_p[3 * DD + d]; }
    const float lam = expf(s01) - expf(s23) + lam_init;
    const float* t = TMP + ((size_t)row * NHC + h) * 2 * 2 * DD; float y[2 * DD]; float ss = 0.f;
#pragma unroll
    for (int d = 0; d < 2 * DD; ++d) { y[d] = t[d] - lam * t[2 * DD + d]; ss += y[d] * y[d]; }
    const float r = 1.0f / sqrtf(ss / (2 * DD) + EPS) * (1.0f - lam_init);
    bf16_t* op = MIX + (size_t)row * D + 768 + h * 2 * DD;
#pragma unroll
    for (int d = 0; d < 2 * DD; ++d) op[d] = f2bf(y[d] * r * subln[d]);
}
KERNEL k_diffpost(const float* TMP, const float* lam_p, const float* subln, float lam_init, bf16_t* MIX, int nrows) { b_diffpost(GID, TMP, lam_p, subln, lam_init, MIX, nrows); }
HD void b_conv(const long g, const bf16_t* P, const float* cw, bf16_t* MIX, int nrows) {
    if (g >= (long)nrows * CONV_CH) return;
    const int row = (int)(g / CONV_CH), ch = (int)(g % CONV_CH);
    const bool lat = row < RL; const int t = lat ? row % SEQ : (row - RL) % CTX, len = lat ? SEQ : CTX;
    float y = 0.f;
    for (int j = 0; j < 3; ++j) { const int tt = t + j - 1; if (tt < 0 || tt >= len) continue;
        const bf16_t* pr = P + (size_t)(row + j - 1) * PROJ; y += cw[j * CONV_CH + ch] * (bf2f(pr[C_CC + ch]) * bf2f(pr[C_CIN + ch])); }
    MIX[(size_t)row * D + 512 + ch] = f2bf(bf2f(P[(size_t)row * PROJ + C_CB + ch]) * y);
}
KERNEL k_conv(const bf16_t* P, const float* cw, bf16_t* MIX, int nrows) { b_conv(GID, P, cw, MIX, nrows); }
KERNEL k_router(const float* xl, const float* xc, const float* rstd, const float* nw, const float* modl, const float* router, float* logits, int nrows) {
    const long g = GID; if (g >= (long)nrows * NE) return;
    const int row = (int)(g / NE), e = (int)(g % NE); const float* xr = xrow_ptr((float*)xl, (float*)xc, row);
    const float* m = modl + (size_t)row_batch(row) * 6 * D; const float rs = rstd[row]; float s = 0.f;
    for (int k = 0; k < D; ++k) { const float v = xr[k] * rs * nw[k] * (1.0f + m[M_SC2 + k]) + m[M_SH2 + k]; s += v * router[k * NE + e]; }
    logits[g] = s;
}
KERNEL k_aff(float* aff, int nrows) {
    const long g = GID; if (g >= nrows) return;
    float* a = aff + (size_t)g * NE; float m = a[0];
    for (int e = 1; e < NE; ++e) m = a[e] > m ? a[e] : m;
    float s = 0.f; float ex[NE];
#pragma unroll
    for (int e = 0; e < NE; ++e) { ex[e] = expf(a[e] - m); s += ex[e]; }
#pragma unroll
    for (int e = 0; e < NE; ++e) a[e] = ex[e] / s;
}
KERNEL k_select(const float* aff, int* sel, float* gate, int* tokslot, int nrows) {
    const long g = GID; if (g >= (long)nrows * NE) return;
    const int row = (int)(g / NE), e = (int)(g % NE);
    const bool lat = row < RL; const int b = lat ? row / SEQ : (row - RL) / CTX; const int t = lat ? row % SEQ : (row - RL) % CTX;
    const int n = lat ? SEQ : CTX, cap = lat ? CAPL : CAPC, base = lat ? b * SEQ : RL + b * CTX;
    const float a = aff[(size_t)row * NE + e]; int rank = 0;
    for (int j = 0; j < n; ++j) { const float o = aff[(size_t)(base + j) * NE + e]; rank += (o > a || (o == a && j < t)) ? 1 : 0; }
    int slot = -1;
    if (rank < cap) { slot = e * SLOTS_E + (lat ? b * CAPL + rank : SLOTS_L + b * CAPC + rank); sel[slot] = row; gate[slot] = a; }
    tokslot[g] = slot;
}
KERNEL k_combine(float* xl, float* xc, const bf16_t* Y, const int* tokslot, const float* modl, int nrows) {
    const long g = GID; if (g >= (long)nrows * D) return;
    const int row = (int)(g / D), k = (int)(g % D); float s = 0.f;
    for (int e = 0; e < NE; ++e) { const int sl = tokslot[(size_t)row * NE + e]; if (sl >= 0) s += bf2f(Y[(size_t)sl * D + k]); }
    float* xr = xrow_ptr(xl, xc, row); xr[k] += modl[(size_t)row_batch(row) * 6 * D + M_G2 + k] * s;
}
KERNEL k_final(float* xl, const float* rstd, const float* nw) {
    const long g = GID; if (g >= (long)RL * D) return;
    const int row = (int)(g / D), k = (int)(g % D); xl[g] = xl[g] * rstd[row] * nw[k];
}

#ifndef HOST_TEST
typedef short bf16x8 __attribute__((ext_vector_type(8)));
typedef float f32x4 __attribute__((ext_vector_type(4)));
template <class Epi, bool DUAL>
__global__ void __launch_bounds__(256) k_gemm_mfma(const bf16_t* __restrict__ A, const int* __restrict__ rowidx, const bf16_t* __restrict__ Bt, int M, int N, int K, int group_rows, int valid_rows, long bstride, Epi epi) {
    const int tid = threadIdx.x, wid = tid >> 6, lane = tid & 63, fr = lane & 15, fq = lane >> 4, wr = wid >> 1, wc = wid & 1;
    const int row0 = blockIdx.y * 128 + wr * 64;
    if ((blockIdx.y * 128) % group_rows >= valid_rows) return;
    const bf16_t* B = Bt + (size_t)((blockIdx.y * 128) / group_rows) * bstride;
    int brow[4], ocol[4];
    if (!DUAL) { for (int i = 0; i < 4; ++i) { brow[i] = blockIdx.x * 128 + wc * 64 + i * 16; ocol[i] = brow[i]; } }
    else { const int hc0 = blockIdx.x * 64 + wc * 32;
        for (int i = 0; i < 2; ++i) { ocol[i] = hc0 + i * 16; brow[i] = (ocol[i] / 128) * 256 + ocol[i] % 128; brow[i + 2] = brow[i] + 128; ocol[i + 2] = ocol[i]; } }
    const bf16_t* ap[4]; const bf16_t* bp[4];
#pragma unroll
    for (int m = 0; m < 4; ++m) { const int r = row0 + m * 16 + fr; const int ar = rowidx ? rowidx[r] : r; ap[m] = A + (size_t)ar * K + fq * 8; }
#pragma unroll
    for (int i = 0; i < 4; ++i) bp[i] = B + (size_t)(brow[i] + fr) * K + fq * 8;
    f32x4 acc[4][4];
#pragma unroll
    for (int m = 0; m < 4; ++m)
#pragma unroll
        for (int i = 0; i < 4; ++i) acc[m][i] = (f32x4){0.f, 0.f, 0.f, 0.f};
    for (int k0 = 0; k0 < K; k0 += 32) {
        bf16x8 af[4], bfr[4];
#pragma unroll
        for (int m = 0; m < 4; ++m) af[m] = *(const bf16x8*)(ap[m] + k0);
#pragma unroll
        for (int i = 0; i < 4; ++i) bfr[i] = *(const bf16x8*)(bp[i] + k0);
#pragma unroll
        for (int m = 0; m < 4; ++m)
#pragma unroll
            for (int i = 0; i < 4; ++i) acc[m][i] = __builtin_amdgcn_mfma_f32_16x16x32_bf16(bfr[i], af[m], acc[m][i], 0, 0, 0);
    }
#pragma unroll
    for (int m = 0; m < 4; ++m) { const int r = row0 + m * 16 + fr;
#pragma unroll
        for (int i = 0; i < (DUAL ? 2 : 4); ++i) {
            float v[4] = {acc[m][i][0], acc[m][i][1], acc[m][i][2], acc[m][i][3]};
            float u[4] = {acc[m][DUAL ? i + 2 : i][0], acc[m][DUAL ? i + 2 : i][1], acc[m][DUAL ? i + 2 : i][2], acc[m][DUAL ? i + 2 : i][3]};
            epi(r, ocol[i] + 4 * fq, v, u); } }
}
template <class Epi, bool DUAL>
static void launch_gemm(hipStream_t stream, const bf16_t* A, const int* rowidx, const bf16_t* Bt, int M, int N, int K, int group_rows, int valid_rows, long bstride, Epi epi) {
    dim3 grid(DUAL ? N / 64 : N / 128, M / 128);
    hipLaunchKernelGGL((k_gemm_mfma<Epi, DUAL>), grid, dim3(256), 0, stream, A, rowidx, Bt, M, N, K, group_rows, valid_rows, bstride, epi);
}
#define GEMM(Epi, DUAL, ...) launch_gemm<Epi, DUAL>(stream, __VA_ARGS__)
#else
#define GEMM(Epi, DUAL, A, rowidx, Bt, M, N, K, gr, vr, bs, epi) LAUNCH((k_gemm_naive<Epi, DUAL>), (long)(M) * ((N) / 4), A, rowidx, Bt, M, N, K, gr, vr, bs, epi)
#endif

#ifdef HOST_TEST
typedef int hipStream_t;
#endif
static void forward(const Ptrs& p, hipStream_t stream) {
    (void)stream;
    unsigned char* ws = p.ws;
    float* tab = (float*)(ws + WS_TAB); float* silu = (float*)(ws + WS_SILU); float* mod = (float*)(ws + WS_MOD); float* rstd = (float*)(ws + WS_RSTD);
    float* aff = (float*)(ws + WS_AFF); int* sel = (int*)(ws + WS_SEL); float* gate = (float*)(ws + WS_GATE); int* tokslot = (int*)(ws + WS_TOKSLOT);
    float* xc = (float*)(ws + WS_XC); float* xl = p.out;
    bf16_t* win = (bf16_t*)(ws + WS_WIN); bf16_t* wout = (bf16_t*)(ws + WS_WOUT);
    bf16_t* P = (bf16_t*)(ws + WS_R1); bf16_t* H = (bf16_t*)(ws + WS_R1);
    bf16_t* Y = (bf16_t*)(ws + WS_R2); bf16_t* MIX = (bf16_t*)(ws + WS_R2); bf16_t* HX2 = (bf16_t*)(ws + WS_R2 + (size_t)RALL * D * 2); float* TMP = (float*)HX2;
    bf16_t* HX = (bf16_t*)(ws + WS_R3);
    LAUNCH(k_tables, (long)(NROWS + 64) * 24, tab);
    LAUNCH(k_silu, (long)(NB + 1) * D, p.c, p.c_ctx, silu);
    LAUNCH(k_mod, (long)DEPTH * 6 * D, silu, p.w_ada, p.b_ada, mod);
    LAUNCH(k_cvt_win, (long)DEPTH * PROJ * D, p.w_in, win);
    LAUNCH(k_cvt_t, (long)DEPTH * D * D, p.w_out, wout, DEPTH, D, D);
#ifdef HOST_TEST
    memcpy(xl, p.x, (size_t)RL * D * 4); memcpy(xc, p.ctx, (size_t)RC * D * 4);
#else
    (void)hipMemcpyAsync(xl, p.x, (size_t)RL * D * 4, hipMemcpyDeviceToDevice, stream);
    (void)hipMemcpyAsync(xc, p.ctx, (size_t)RC * D * 4, hipMemcpyDeviceToDevice, stream);
#endif
    for (int l = 0; l < DEPTH; ++l) {
        const bool need_ctx = l < DEPTH - 1; const int nq = need_ctx ? RALL : RL;
        const float* modl = mod + (size_t)l * (NB + 1) * 6 * D; const float lam_init = 0.8f - 0.6f * expf(-0.3f * (float)l);
        bf16_t* wgu = (bf16_t*)(ws + WS_WGU) + (size_t)(l & 1) * NE * 2 * FF * D; bf16_t* wd = (bf16_t*)(ws + WS_WD) + (size_t)(l & 1) * NE * D * FF;
        LAUNCH(k_cvt_gu, (long)NE * 2 * FF * D, p.w_gate + (size_t)l * NE * D * FF, p.w_up + (size_t)l * NE * D * FF, wgu);
        LAUNCH(k_cvt_t, (long)NE * FF * D, p.w_down + (size_t)l * NE * FF * D, wd, NE, FF, D);
        LAUNCH(k_rowstat, RALL, xl, xc, rstd, RALL);
        LAUNCH(k_rowapply, (long)RALL * D, xl, xc, rstd, p.norm1 + l * D, modl, M_SH1, M_SC1, HX, RALL);
        GEMM(EpiInProj, false, HX, (const int*)nullptr, win + (size_t)l * PROJ * D, RALL, PROJ, D, RALL, RALL, 0L, (EpiInProj{P, tab}));
        LAUNCH(k_attnA, (long)nq * NHA, P, p.attn_sink + l * NHA, MIX, nq);
        LAUNCH(k_attnD, (long)nq * NHC * 2, P, TMP, nq);
        LAUNCH(k_diffpost, (long)nq * NHC, TMP, p.diff_lambda + l * 4 * DD, p.diff_subln + l * 2 * DD, lam_init, MIX, nq);
        LAUNCH(k_conv, (long)nq * CONV_CH, P, p.conv_w + l * 3 * CONV_CH, MIX, nq);
        GEMM(EpiOutProj, false, MIX, (const int*)nullptr, wout + (size_t)l * D * D, nq, D, D, nq, nq, 0L, (EpiOutProj{xl, xc, modl}));
        LAUNCH(k_rowstat, nq, xl, xc, rstd, nq);
        LAUNCH(k_rowapply, (long)nq * D, xl, xc, rstd, p.norm2 + l * D, modl, M_SH2, M_SC2, HX2, nq);
        LAUNCH(k_router, (long)nq * NE, xl, xc, rstd, p.norm2 + l * D, modl, p.router + (size_t)l * D * NE, aff, nq);
        LAUNCH(k_aff, nq, aff, nq);
        LAUNCH(k_select, (long)nq * NE, aff, sel, gate, tokslot, nq);
        const int vr = need_ctx ? SLOTS_E : SLOTS_L;
        GEMM(EpiGateUp, true, HX2, sel, wgu, NSLOT, FF, D, SLOTS_E, vr, (long)2 * FF * D, (EpiGateUp{H}));
        GEMM(EpiDown, false, H, (const int*)nullptr, wd, NSLOT, D, FF, SLOTS_E, vr, (long)D * FF, (EpiDown{Y, gate}));
        LAUNCH(k_combine, (long)nq * D, xl, xc, Y, tokslot, modl, nq);
    }
    LAUNCH(k_rowstat, RL, xl, xc, rstd, RL);
    LAUNCH(k_final, (long)RL * D, xl, rstd, p.norm_final);
}

#ifndef HOST_TEST
#define LAS __attribute__((address_space(3)))
#define GAS __attribute__((address_space(1)))
typedef unsigned u32x4 __attribute__((ext_vector_type(4)));
typedef unsigned u32x2 __attribute__((ext_vector_type(2)));
constexpr int NT = 512, NWV = 8;
constexpr int LDS_BYTES = 147456;
constexpr int LDS_MISC = LDS_BYTES - 256;
constexpr int CW_BAR = 4096;

__device__ __forceinline__ unsigned cvt_pk_bf16(float lo, float hi) { unsigned r; asm volatile("v_cvt_pk_bf16_f32 %0, %1, %2" : "=v"(r) : "v"(lo), "v"(hi)); return r; }
__device__ __forceinline__ float wave_sum(float v) {
#pragma unroll
    for (int o = 1; o < 64; o <<= 1) v += __shfl_xor(v, o);
    return v;
}
#define LDS_WAIT() asm volatile("s_waitcnt lgkmcnt(0)" ::: "memory")
__device__ __forceinline__ int tid_l() { int t = threadIdx.x; asm volatile("" : "+v"(t)); return t; }

#define XB_TMO      128
#define XB_XCNT(j)  (256  + 64 * (j))
#define XB_XSUB(j)  (1280 + 64 * (j))
#define XB_XGEN(j)  (2304 + 64 * (j))
#define XB_TOP      3328
#define XB_TOPGEN   3392
#define XCD_BAR_WORDS 3456
#define XB_SPIN_CAP (1u << 24)
__device__ __forceinline__ unsigned xb_ld(unsigned* p)              { return __hip_atomic_load(p, __ATOMIC_RELAXED, __HIP_MEMORY_SCOPE_AGENT); }
__device__ __forceinline__ unsigned xb_add(unsigned* p, unsigned v) { return __hip_atomic_fetch_add(p, v, __ATOMIC_RELAXED, __HIP_MEMORY_SCOPE_AGENT); }
__device__ __forceinline__ unsigned xb_xcc_id() { return (unsigned)__builtin_amdgcn_s_getreg((3 << 11) | 20) & 0xFu; }
#define XB_SPIN(cond, bar) do { unsigned _sp = 0; while (cond) { __builtin_amdgcn_s_sleep(1); \
    if ((++_sp & 255u) == 0u) { if (xb_ld(&(bar)[XB_TMO])) break; if (_sp > XB_SPIN_CAP) { atomicAdd(&(bar)[XB_TMO], 1u); break; } } } } while (0)
struct XcdBarrier { unsigned* bar; unsigned x; volatile LAS unsigned* st; };
__device__ __forceinline__ XcdBarrier xcd_barrier_post(unsigned* bar, volatile LAS unsigned* st) {
    XcdBarrier b; b.bar = bar; b.x = xb_xcc_id(); b.st = st;
    if (threadIdx.x == 0) (void)xb_add(&bar[XB_XCNT(b.x)], 1u);
    return b;
}
__device__ __forceinline__ void xcd_barrier_complete(unsigned* bar, unsigned x, unsigned& nloc, unsigned& nx) {
    const unsigned G = gridDim.x * gridDim.y * gridDim.z;
    unsigned sum, cnt, mine, sp = 0u;
    for (;;) {
        sum = 0u; cnt = 0u; mine = 0u;
#pragma unroll
        for (unsigned j = 0; j < 16; ++j) { const unsigned c = xb_ld(&bar[XB_XCNT(j)]); sum += c; cnt += (c > 0u) ? 1u : 0u; mine = (j == x) ? c : mine; }
        if (sum == G) break;
        __builtin_amdgcn_s_sleep(1);
        if ((++sp & 255u) == 0u) { if (xb_ld(&bar[XB_TMO])) break; if (sp > XB_SPIN_CAP) { atomicAdd(&bar[XB_TMO], 1u); break; } }
    }
    nloc = mine > 0u ? mine : 1u; nx = cnt > 0u ? cnt : 1u;
}
__device__ __forceinline__ void xcd_barrier(const XcdBarrier& b) {
    asm volatile("s_waitcnt vmcnt(0)" ::: "memory");
    __syncthreads();
    if (threadIdx.x == 0) {
        unsigned* bar = b.bar;
        __builtin_amdgcn_s_waitcnt(0);
        unsigned nloc = b.st[0], nx = b.st[1];
        if (nloc == 0u) { xcd_barrier_complete(bar, b.x, nloc, nx); b.st[0] = nloc; b.st[1] = nx; }
        const unsigned old = xb_add(&bar[XB_XSUB(b.x)], 1u);
        const unsigned gen = old / nloc;
        if (old + 1u == (gen + 1u) * nloc) {
            __builtin_amdgcn_fence(__ATOMIC_RELEASE, "agent");
            asm volatile("s_waitcnt vmcnt(0)" ::: "memory");
            const unsigned og = xb_add(&bar[XB_TOP], 1u);
            const unsigned tg = og / nx;
            if (og + 1u == (tg + 1u) * nx) xb_add(&bar[XB_TOPGEN], 1u);
            else XB_SPIN(xb_ld(&bar[XB_TOPGEN]) == tg, bar);
            __builtin_amdgcn_fence(__ATOMIC_ACQUIRE, "agent");
            xb_add(&bar[XB_XGEN(b.x)], 1u);
            asm volatile("s_waitcnt vmcnt(0)" ::: "memory");
        } else {
            XB_SPIN(xb_ld(&bar[XB_XGEN(b.x)]) == gen, bar);
            __builtin_amdgcn_fence(__ATOMIC_ACQUIRE, "agent");
            asm volatile("s_waitcnt vmcnt(0)" ::: "memory");
        }
    }
    __syncthreads();
}

namespace pg {
constexpr int BM = 256, BK = 64, HALF = 128, HTB = HALF * BK * 2  , STAGE_BYTES = 8 * HTB, NXCD = 8, WGM = 8;
constexpr int TPE_FULL = SLOTS_E / BM;
__host__ __device__ __forceinline__ int lds_byte(int r, int c) { const int st = (r >> 4) * 2 + (c >> 5), rr = r & 15, cc = c & 31, ob = rr * 64 + cc * 2; return st * 1024 + (ob ^ (((ob >> 9) & 1) << 5)); }
__host__ __device__ __forceinline__ void stage_rc(int b, int& R, int& C) { const int st = b / 1024, sb = b % 1024, swz = sb ^ (((sb >> 9) & 1) << 5); R = (st >> 1) * 16 + swz / 64; C = (st & 1) * 32 + (swz % 64) / 2; }
__host__ __device__ __forceinline__ int perm32(int rho) { const int n = rho >> 4, i = rho & 15; return 8 * (i >> 2) + 4 * n + (i & 3); }
struct Unit { int m0, pn, e; };
struct GemmD { const char* A; const int* rowidx; const char* Bt; size_t bstride; int K; };
struct Order {
    int nM, nN, nwg, G, c, tpe;
    __device__ void init(int nM_, int nN_, int G_, int c_, int tpe_) { nM = nM_; nN = nN_; nwg = nM * nN; G = G_; c = c_; tpe = tpe_; }
    __device__ bool next(int i, Unit& u) const {
        const long L = (long)i * G + c; if (L >= nwg) return false;
        int wgid = (int)L; { const int q = nwg / NXCD, r = nwg % NXCD, xcd = wgid % NXCD, off = wgid / NXCD; wgid = (xcd < r ? xcd * (q + 1) : r * (q + 1) + (xcd - r) * q) + off; }
        const int nig = WGM * nN, gid = wgid / nig, fm = gid * WGM, gsz = (nM - fm) < WGM ? (nM - fm) : WGM;
        const int pm = fm + ((wgid % nig) % gsz); u.pn = (wgid % nig) / gsz;
        if (tpe > 0) { u.e = pm / tpe; u.m0 = (u.e * TPE_FULL + pm % tpe) * BM; } else { u.e = 0; u.m0 = pm * BM; }
        return true;
    }
};
template <class Epi, bool GATHER>
__device__ __forceinline__ void gemm_phase(LAS unsigned char* lds, const GemmD g, const Order& S, const Epi& E) {
    const int tid = tid_l(), wid = __builtin_amdgcn_readfirstlane(tid >> 6), lane = tid & 63, wr = wid >> 2, wc = wid & 3, fr = lane & 15, fq = lane >> 4;
    const int K = g.K, nt = K / BK;
    int Rr[2], Cc[2]; unsigned voffB[2];
#pragma unroll
    for (int i = 0; i < 2; ++i) { int R, C; stage_rc(tid * 16 + i * 8192, R, C); Rr[i] = R; Cc[i] = C; const int Rb = Epi::PERM ? ((R & ~31) + perm32(R & 31)) : R; voffB[i] = (unsigned)(Rb * K + C) * 2u; }
    const unsigned kstep = (unsigned)(BK * 2);
    const size_t hstep = (size_t)HALF * K * 2;
    const unsigned ldsw = (unsigned)wid * 1024u;
    const int aoff = lds_byte(wr * 64 + fr, fq * 8), boff = lds_byte(wc * 32 + fr, fq * 8);
#define PG_SA(b, h) (((b) * 2 + (h)) * HTB)
#define PG_SB(b, h) ((4 + (b) * 2 + (h)) * HTB)
#define PG_STAGE_B(bufoff, gbase) do { _Pragma("unroll") for (int _i = 0; _i < 2; ++_i) \
        __builtin_amdgcn_global_load_lds((const unsigned*)((const char*)(gbase) + voffB[_i]), (LAS unsigned*)(lds + (bufoff) + ldsw + _i * 8192), 16, 0, 0); } while (0)
#define PG_STAGE_A(bufoff, OFFS, h, kb) do { _Pragma("unroll") for (int _i = 0; _i < 2; ++_i) \
        __builtin_amdgcn_global_load_lds((const unsigned*)(g.A + (size_t)(OFFS)[h][_i] + (kb)), (LAS unsigned*)(lds + (bufoff) + ldsw + _i * 8192), 16, 0, 0); } while (0)
#define PG_ROWOFF(DST, U) do { _Pragma("unroll") for (int _h = 0; _h < 2; ++_h) _Pragma("unroll") for (int _i = 0; _i < 2; ++_i) { int _r = (U).m0 + _h * HALF + Rr[_i]; if (GATHER) _r = g.rowidx[_r]; \
        (DST)[_h][_i] = (unsigned)(((size_t)_r * K + Cc[_i]) * 2); } } while (0)
#define PG_LDA(dst, b, h) do { _Pragma("unroll") for (int m = 0; m < 4; ++m) _Pragma("unroll") for (int k = 0; k < 2; ++k) dst[m][k] = *(const LAS bf16x8*)(lds + PG_SA(b, h) + aoff + m * 2048 + k * 1024); } while (0)
#define PG_LDB(dst, b, h) do { _Pragma("unroll") for (int n = 0; n < 2; ++n) _Pragma("unroll") for (int k = 0; k < 2; ++k) dst[n][k] = *(const LAS bf16x8*)(lds + PG_SB(b, h) + boff + n * 2048 + k * 1024); } while (0)
#define PG_MMA(ai, bj, At, Bt) do { __builtin_amdgcn_s_setprio(1); _Pragma("unroll") for (int m = 0; m < 4; ++m) _Pragma("unroll") for (int n = 0; n < 2; ++n) _Pragma("unroll") for (int k = 0; k < 2; ++k) \
        acc[ai][bj][m][n] = __builtin_amdgcn_mfma_f32_16x16x32_bf16(Bt[n][k], At[m][k], acc[ai][bj][m][n], 0, 0, 0); __builtin_amdgcn_s_setprio(0); } while (0)
#define PG_WAIT_V(n) asm volatile("s_waitcnt vmcnt(" #n ")" ::: "memory")
#define PG_WAIT_L(n) asm volatile("s_waitcnt lgkmcnt(" #n ")" ::: "memory")
#define PG_BAR __builtin_amdgcn_s_barrier()
#define PG_SCHED __builtin_amdgcn_sched_barrier(0)
    Unit cur, nxt; int ui = 0;
    if (!S.next(0, cur)) return;
    f32x4 acc[2][2][4][2];
#pragma unroll
    for (int a = 0; a < 2; ++a)
#pragma unroll
        for (int b = 0; b < 2; ++b)
#pragma unroll
            for (int m = 0; m < 4; ++m)
#pragma unroll
                for (int n = 0; n < 2; ++n) acc[a][b][m][n] = (f32x4){0.f, 0.f, 0.f, 0.f};
    bf16x8 At[4][2], B0[2][2], B1[2][2];
    unsigned offA[2][2], offN[2][2];
    PG_ROWOFF(offA, cur);
    if (GATHER) PG_WAIT_V(0);
    const char* cB = g.Bt + (size_t)cur.e * g.bstride + (size_t)cur.pn * BM * K * 2;
    PG_STAGE_B(PG_SB(0, 0), cB); PG_STAGE_B(PG_SB(0, 1), cB + hstep); PG_STAGE_A(PG_SA(0, 0), offA, 0, 0u); PG_STAGE_A(PG_SA(0, 1), offA, 1, 0u);
    if (wr == 1) PG_BAR;
    PG_WAIT_V(2); PG_BAR;
    PG_STAGE_B(PG_SB(1, 0), cB + kstep); PG_STAGE_A(PG_SA(1, 0), offA, 0, kstep); PG_STAGE_B(PG_SB(1, 1), cB + hstep + kstep);
    PG_WAIT_V(6); PG_BAR;
    for (;;) {
        const bool has_next = S.next(ui + 1, nxt);
        const char* nB = has_next ? g.Bt + (size_t)nxt.e * g.bstride + (size_t)nxt.pn * BM * K * 2 : cB;
        if (has_next) { PG_ROWOFF(offN, nxt); if (GATHER) PG_WAIT_V(0); }
        else {
#pragma unroll
            for (int h = 0; h < 2; ++h)
#pragma unroll
                for (int i = 0; i < 2; ++i) offN[h][i] = offA[h][i]; }
        for (int t = 0; t < nt; t += 2) {
            const bool last = (t == nt - 2);
            unsigned o2[2][2];
#pragma unroll
            for (int h = 0; h < 2; ++h)
#pragma unroll
                for (int i = 0; i < 2; ++i) o2[h][i] = last ? offN[h][i] : offA[h][i];
            const unsigned ka1 = (unsigned)(t + 1) * kstep, ka2 = last ? 0u : (unsigned)(t + 2) * kstep, ka3 = ka2 + kstep;
            const char* b2 = last ? nB : cB + (size_t)(t + 2) * kstep; const char* b3 = b2 + kstep;
            PG_LDB(B0, 0, 0); PG_LDB(B1, 0, 1); PG_SCHED; PG_LDA(At, 0, 0); PG_STAGE_A(PG_SA(1, 1), offA, 1, ka1);
            PG_WAIT_V(8); PG_WAIT_L(0); PG_BAR; PG_MMA(0, 0, At, B0); PG_MMA(0, 1, At, B1); PG_BAR; PG_SCHED;
            PG_LDA(At, 0, 1); PG_STAGE_B(PG_SB(0, 0), b2); PG_STAGE_B(PG_SB(0, 1), b2 + hstep); PG_STAGE_A(PG_SA(0, 0), o2, 0, ka2);
            PG_WAIT_V(8); PG_WAIT_L(0); PG_BAR; PG_MMA(1, 0, At, B0); PG_MMA(1, 1, At, B1); PG_BAR; PG_SCHED;
            PG_LDB(B0, 1, 0); PG_LDB(B1, 1, 1); PG_SCHED; PG_LDA(At, 1, 0); PG_STAGE_A(PG_SA(0, 1), o2, 1, ka2);
            PG_WAIT_V(8); PG_WAIT_L(0); PG_BAR; PG_MMA(0, 0, At, B0); PG_MMA(0, 1, At, B1); PG_BAR; PG_SCHED;
            PG_LDA(At, 1, 1); PG_STAGE_B(PG_SB(1, 0), b3); PG_STAGE_B(PG_SB(1, 1), b3 + hstep); PG_STAGE_A(PG_SA(1, 0), o2, 0, ka3);
            PG_WAIT_V(8); PG_WAIT_L(0); PG_BAR; PG_MMA(1, 0, At, B0); PG_MMA(1, 1, At, B1); PG_BAR; PG_SCHED;
        }
        if (wr == 0) PG_BAR;
        E(acc, cur, wr, wc, fr, fq);
        if (!has_next) break;
#pragma unroll
        for (int a = 0; a < 2; ++a)
#pragma unroll
            for (int b = 0; b < 2; ++b)
#pragma unroll
                for (int m = 0; m < 4; ++m)
#pragma unroll
                    for (int n = 0; n < 2; ++n) acc[a][b][m][n] = (f32x4){0.f, 0.f, 0.f, 0.f};
        cur = nxt; cB = nB; ++ui;
#pragma unroll
        for (int h = 0; h < 2; ++h)
#pragma unroll
            for (int i = 0; i < 2; ++i) offA[h][i] = offN[h][i];
        if (wr == 1) PG_BAR;
    }
    PG_WAIT_V(0);
    PG_BAR;
#undef PG_SA
#undef PG_SB
#undef PG_STAGE_A
#undef PG_STAGE_B
#undef PG_ROWOFF
#undef PG_LDA
#undef PG_LDB
#undef PG_MMA
#undef PG_WAIT_V
#undef PG_WAIT_L
#undef PG_BAR
#undef PG_SCHED
}
struct EpiP {
    static constexpr bool PERM = true;
    bf16_t* P; const float* tab;
    __device__ __forceinline__ void operator()(const f32x4 (&acc)[2][2][4][2], const Unit& u, int wr, int wc, int fr, int fq) const {
        const bool lat = u.m0 < RL;
#pragma unroll
        for (int bj = 0; bj < 2; ++bj) {
            const int ct = u.pn * BM + bj * HALF;
            const int c0 = ct + wc * 32 + 8 * fq;
            const int kind = ct < C_VA ? 1 : ((ct >= C_QD && ct < C_VD) ? 2 : 0);
            const float sc = ct < C_KA ? QSCALE_A : ((ct >= C_QD && ct < C_KD) ? QSCALE_D : 1.0f);
#pragma unroll
            for (int ai = 0; ai < 2; ++ai)
#pragma unroll
                for (int m = 0; m < 4; ++m) {
                    const int row = u.m0 + ai * HALF + wr * 64 + m * 16 + fr;
                    f32x4 v0 = acc[ai][bj][m][0], v1 = acc[ai][bj][m][1];
                    if (kind != 0 && lat) {
                        const int pos = row % SEQ, gr = pos / GRID_W, gc = pos % GRID_W; const float* t;
                        if (kind == 1) { const int p = c0 & 63, grp = p >> 5, i0 = (p & 31) >> 1; t = tab + (grp ? T_ACOL + gc * 32 : T_AROW + gr * 32) + i0 * 2; }
                        else { const int p = c0 & 31, grp = p >> 4, i0 = (p & 15) >> 1; t = tab + (grp ? T_DCOL + gc * 16 : T_DROW + gr * 16) + i0 * 2; }
                        const f32x4 t0 = *(const f32x4*)t, t1 = *(const f32x4*)(t + 4);
                        v0 = (f32x4){v0[0] * t0[0] - v0[1] * t0[1], v0[1] * t0[0] + v0[0] * t0[1], v0[2] * t0[2] - v0[3] * t0[3], v0[3] * t0[2] + v0[2] * t0[3]};
                        v1 = (f32x4){v1[0] * t1[0] - v1[1] * t1[1], v1[1] * t1[0] + v1[0] * t1[1], v1[2] * t1[2] - v1[3] * t1[3], v1[3] * t1[2] + v1[2] * t1[3]};
                    }
                    v0 = v0 * sc; v1 = v1 * sc;
                    u32x4 w; w.x = cvt_pk_bf16(v0[0], v0[1]); w.y = cvt_pk_bf16(v0[2], v0[3]); w.z = cvt_pk_bf16(v1[0], v1[1]); w.w = cvt_pk_bf16(v1[2], v1[3]);
                    *(u32x4*)(P + (size_t)row * PROJ + c0) = w;
                }
        }
    }
};
struct EpiX {
    static constexpr bool PERM = false;
    float* xl; float* xc; const float* modl;
    __device__ __forceinline__ void operator()(const f32x4 (&acc)[2][2][4][2], const Unit& u, int wr, int wc, int fr, int fq) const {
        const int b = u.m0 < RL ? u.m0 / SEQ : NB; const float* g1 = modl + (size_t)b * 6 * D + M_G1;
        f32x4 gv[2][2];
#pragma unroll
        for (int bj = 0; bj < 2; ++bj)
#pragma unroll
            for (int n = 0; n < 2; ++n) gv[bj][n] = *(const f32x4*)(g1 + u.pn * BM + bj * HALF + wc * 32 + n * 16 + 4 * fq);
#pragma unroll
        for (int ai = 0; ai < 2; ++ai)
#pragma unroll
            for (int m = 0; m < 4; ++m) {
                const int row = u.m0 + ai * HALF + wr * 64 + m * 16 + fr; float* xr = xrow_ptr(xl, xc, row) + u.pn * BM + wc * 32 + 4 * fq;
#pragma unroll
                for (int bj = 0; bj < 2; ++bj)
#pragma unroll
                    for (int n = 0; n < 2; ++n) { float* p = xr + bj * HALF + n * 16; const f32x4 xv = *(const f32x4*)p; *(f32x4*)p = xv + gv[bj][n] * acc[ai][bj][m][n]; }
                if (m & 1) asm volatile("" ::: "memory");
            }
    }
};
__device__ __forceinline__ float silu_fast(float v) { return v * __builtin_amdgcn_rcpf(1.0f + __builtin_amdgcn_exp2f(-LOG2E * v)); }
struct EpiH {
    static constexpr bool PERM = true;
    bf16_t* H;
    __device__ __forceinline__ void operator()(const f32x4 (&acc)[2][2][4][2], const Unit& u, int wr, int wc, int fr, int fq) const {
        const int hc = u.pn * HALF + wc * 32 + 8 * fq;
#pragma unroll
        for (int ai = 0; ai < 2; ++ai)
#pragma unroll
            for (int m = 0; m < 4; ++m) {
                const int row = u.m0 + ai * HALF + wr * 64 + m * 16 + fr;
                const f32x4 g0 = acc[ai][0][m][0], g1 = acc[ai][0][m][1], u0 = acc[ai][1][m][0], u1 = acc[ai][1][m][1];
                u32x4 w;
                w.x = cvt_pk_bf16(silu_fast(g0[0]) * u0[0], silu_fast(g0[1]) * u0[1]); w.y = cvt_pk_bf16(silu_fast(g0[2]) * u0[2], silu_fast(g0[3]) * u0[3]);
                w.z = cvt_pk_bf16(silu_fast(g1[0]) * u1[0], silu_fast(g1[1]) * u1[1]); w.w = cvt_pk_bf16(silu_fast(g1[2]) * u1[2], silu_fast(g1[3]) * u1[3]);
                *(u32x4*)(H + (size_t)row * FF + hc) = w;
            }
    }
};
struct EpiY {
    static constexpr bool PERM = true;
    bf16_t* Y; const float* gate;
    __device__ __forceinline__ void operator()(const f32x4 (&acc)[2][2][4][2], const Unit& u, int wr, int wc, int fr, int fq) const {
#pragma unroll
        for (int ai = 0; ai < 2; ++ai)
#pragma unroll
            for (int m = 0; m < 4; ++m) {
                const int row = u.m0 + ai * HALF + wr * 64 + m * 16 + fr; const float gt = gate[row];
#pragma unroll
                for (int bj = 0; bj < 2; ++bj) {
                    const f32x4 v0 = acc[ai][bj][m][0] * gt, v1 = acc[ai][bj][m][1] * gt;
                    u32x4 w; w.x = cvt_pk_bf16(v0[0], v0[1]); w.y = cvt_pk_bf16(v0[2], v0[3]); w.z = cvt_pk_bf16(v1[0], v1[1]); w.w = cvt_pk_bf16(v1[2], v1[3]);
                    *(u32x4*)(Y + (size_t)row * D + u.pn * BM + bj * HALF + wc * 32 + 8 * fq) = w;
                }
            }
    }
};
}

struct Args { const float* in[19]; float* out; unsigned char* ws; int ph_lo, ph_hi; };
struct Ctx {
    Ptrs p; LAS unsigned char* lds;
    float *tab, *mod, *aff, *gate, *xc, *xl; int *sel, *tokslot;
    bf16_t *win, *wout, *P, *H, *Y, *MIX, *HX2, *HX; float* TMP;
};
template <class Dest>
__device__ __forceinline__ void transpose_item(const float* W, int K, int N, bf16_t* WT, LAS float* scr, int item, int lane, Dest dest) {
    const int nblk = N / 32, kb = item / nblk, nb = item % nblk, k0 = 64 * kb, n0 = 32 * nb;
#pragma unroll 8
    for (int i = 0; i < 32; ++i) { const int kk = 2 * i + (lane >> 5); scr[kk * 33 + (lane & 31)] = W[(size_t)(k0 + kk) * N + n0 + (lane & 31)]; }
    LDS_WAIT(); asm volatile("" ::: "memory");
    const int c = lane & 7;
#pragma unroll
    for (int j = 0; j < 4; ++j) { const int n = (lane >> 3) + 8 * j; const LAS float* s = scr + (8 * c) * 33 + n;
        u32x4 o; o.x = cvt_pk_bf16(s[0 * 33], s[1 * 33]); o.y = cvt_pk_bf16(s[2 * 33], s[3 * 33]); o.z = cvt_pk_bf16(s[4 * 33], s[5 * 33]); o.w = cvt_pk_bf16(s[6 * 33], s[7 * 33]);
        *(u32x4*)(WT + (size_t)dest(n0 + n) * K + k0 + 8 * c) = o; }
    LDS_WAIT(); asm volatile("" ::: "memory");
}
HD int invA(int q) { const int g = q / 32, r = q % 32; return 32 * g + (r < 16 ? 2 * r : 2 * (r - 16) + 1); }
HD int invD(int q) { const int g = q / 16, r = q % 16; return 16 * g + (r < 8 ? 2 * r : 2 * (r - 8) + 1); }
HD int inproj_dst_row(int nl) {
    if (nl < C_VA) return (nl / 64) * 64 + invA(nl % 64);
    if (nl >= C_QD && nl < C_VD) return (nl / 32) * 32 + invD(nl % 32);
    return nl;
}
struct DestIn { __device__ int operator()(int n) const { return inproj_dst_row(n); } };
struct DestId { __device__ int operator()(int n) const { return n; } };
struct DestGU { int up; __device__ int operator()(int n) const { return (n / 128) * 256 + up * 128 + n % 128; } };

__device__ __forceinline__ void phase_prologue(const Ctx& C) {
    const int tid = tid_l(), lane = tid & 63, wave = __builtin_amdgcn_readfirstlane(tid >> 6), gw = blockIdx.x * NWV + wave, NGW = gridDim.x * NWV; (void)lane; (void)gw; (void)NGW;
    for (long g = (long)blockIdx.x * NT + tid; g < (long)(NROWS + 64) * 24; g += (long)gridDim.x * NT) {
        const int pos = (int)(g / 24), f = (int)(g % 24);
        const double inv = f < 16 ? pow(10000.0, -(2.0 * f) / 32.0) : pow(10000.0, -(2.0 * (f - 16)) / 16.0);
        const bool isrow = pos < NROWS; const int p = isrow ? pos : pos - NROWS;
        const double ang = (double)p * inv; const float cs = (float)cos(ang), sn = (float)sin(ang);
        const int idx = f < 16 ? (isrow ? T_AROW : T_ACOL) + (p * 16 + f) * 2 : (isrow ? T_DROW : T_DCOL) + (p * 8 + (f - 16)) * 2;
        C.tab[idx] = cs; C.tab[idx + 1] = sn;
    }
    LAS float* sl = (LAS float*)C.lds;
    for (int i = tid; i < (NB + 1) * D; i += NT) { const int b = i / D, k = i % D; sl[i] = silu_f(b < NB ? C.p.c[b * D + k] : C.p.c_ctx[k]); }
    __syncthreads();
    constexpr int BG = 11, NBG = (NB + 1) / BG; static_assert(NBG * BG == NB + 1, "adaLN rows split in groups of 11");
    for (int task = gw; task < (DEPTH * 6 * D / 64) * NBG; task += NGW) {
        const int chunk = task / NBG, bg = task % NBG, jg = chunk * 64 + lane, l = jg / (6 * D), j = jg % (6 * D);
        float acc[BG];
#pragma unroll
        for (int b = 0; b < BG; ++b) acc[b] = 0.f;
        const float* w = C.p.w_ada + (size_t)l * D * 6 * D + j; const LAS float* s0 = sl + bg * BG * D;
#pragma unroll 8
        for (int k = 0; k < D; ++k) { const float wv = w[(size_t)k * 6 * D];
#pragma unroll
            for (int b = 0; b < BG; ++b) acc[b] += s0[b * D + k] * wv; }
        const float bias = C.p.b_ada[l * 6 * D + j];
#pragma unroll
        for (int b = 0; b < BG; ++b) C.mod[((size_t)l * (NB + 1) + bg * BG + b) * 6 * D + j] = acc[b] + bias;
    }
    __syncthreads();
    LAS float* scr = (LAS float*)(C.lds + wave * 16384);
    constexpr int I_IN = (D / 64) * (PROJ / 32), I_OUT = (D / 64) * (D / 32);
    for (int it = gw; it < DEPTH * (I_IN + I_OUT); it += NGW) {
        const int l = it / (I_IN + I_OUT), r = it % (I_IN + I_OUT);
        if (r < I_IN) transpose_item(C.p.w_in + (size_t)l * D * PROJ, D, PROJ, C.win + (size_t)l * PROJ * D, scr, r, lane, DestIn{});
        else transpose_item(C.p.w_out + (size_t)l * D * D, D, D, C.wout + (size_t)l * D * D, scr, r - I_IN, lane, DestId{});
    }
    __syncthreads();
}
__device__ __forceinline__ void phase_cvt_experts(const Ctx& C, int l) {
    const int tid = tid_l(), lane = tid & 63, wave = __builtin_amdgcn_readfirstlane(tid >> 6), gw = blockIdx.x * NWV + wave, NGW = gridDim.x * NWV; (void)lane; (void)gw; (void)NGW;
    LAS float* scr = (LAS float*)(C.lds + wave * 16384);
    bf16_t* wgu = (bf16_t*)(C.p.ws + WS_WGU) + (size_t)(l & 1) * NE * 2 * FF * D; bf16_t* wd = (bf16_t*)(C.p.ws + WS_WD) + (size_t)(l & 1) * NE * D * FF;
    constexpr int I_E = (D / 64) * (FF / 32);
    for (int it = gw; it < 3 * NE * I_E; it += NGW) {
        const int mat = it / (NE * I_E), e = (it / I_E) % NE, r = it % I_E;
        const size_t wo = ((size_t)l * NE + e) * D * FF;
        if (mat == 0) transpose_item(C.p.w_gate + wo, D, FF, wgu + (size_t)e * 2 * FF * D, scr, r, lane, DestGU{0});
        else if (mat == 1) transpose_item(C.p.w_up + wo, D, FF, wgu + (size_t)e * 2 * FF * D, scr, r, lane, DestGU{1});
        else transpose_item(C.p.w_down + wo, FF, D, wd + (size_t)e * D * FF, scr, r, lane, DestId{});
    }
    __syncthreads();
}
template <bool FINAL>
__device__ __forceinline__ void phase_rowA(const Ctx& C, int l) {
    const int tid = tid_l(), lane = tid & 63, wave = __builtin_amdgcn_readfirstlane(tid >> 6), gw = blockIdx.x * NWV + wave, NGW = gridDim.x * NWV; (void)lane; (void)gw; (void)NGW;
    const int nrows = FINAL ? RL : RALL;
    for (int row = gw; row < nrows; row += NGW) {
        const float* src = (l == 0) ? (row < RL ? C.p.x + (size_t)row * D : C.p.ctx + (size_t)(row - RL) * D) : xrow_ptr(C.xl, C.xc, row);
        float* dst = xrow_ptr(C.xl, C.xc, row); const int b = row_batch(row);
        f32x4 v[4];
#pragma unroll
        for (int j = 0; j < 4; ++j) v[j] = *(const f32x4*)(src + 4 * lane + 256 * j);
        if (l > 0) {
            const int ts = lane < NE ? C.tokslot[(size_t)row * NE + lane] : -1;
            f32x4 a[4];
#pragma unroll
            for (int j = 0; j < 4; ++j) a[j] = (f32x4){0.f, 0.f, 0.f, 0.f};
            for (int e = 0; e < NE; ++e) { const int s = __shfl(ts, e); if (s < 0) continue;
                const bf16_t* yr = C.Y + (size_t)s * D + 4 * lane;
#pragma unroll
                for (int j = 0; j < 4; ++j) { const u32x2 w = *(const u32x2*)(yr + 256 * j);
                    a[j][0] += __builtin_bit_cast(float, w.x << 16); a[j][1] += __builtin_bit_cast(float, w.x & 0xffff0000u); a[j][2] += __builtin_bit_cast(float, w.y << 16); a[j][3] += __builtin_bit_cast(float, w.y & 0xffff0000u); } }
            const float* g2 = C.mod + ((size_t)(l - 1) * (NB + 1) + b) * 6 * D + M_G2 + 4 * lane;
#pragma unroll
            for (int j = 0; j < 4; ++j) v[j] = v[j] + *(const f32x4*)(g2 + 256 * j) * a[j];
        }
        float ss = 0.f;
#pragma unroll
        for (int j = 0; j < 4; ++j) ss += (v[j][0] * v[j][0] + v[j][1] * v[j][1]) + (v[j][2] * v[j][2] + v[j][3] * v[j][3]);
        const float rstd = 1.0f / sqrtf(wave_sum(ss) * (1.0f / D) + EPS);
        if (FINAL) {
#pragma unroll
            for (int j = 0; j < 4; ++j) *(f32x4*)(dst + 4 * lane + 256 * j) = v[j] * rstd * *(const f32x4*)(C.p.norm_final + 4 * lane + 256 * j);
        } else {
            if (l == 0 || l > 0) {
#pragma unroll
                for (int j = 0; j < 4; ++j) *(f32x4*)(dst + 4 * lane + 256 * j) = v[j];
            }
            const float* m = C.mod + ((size_t)l * (NB + 1) + b) * 6 * D + 4 * lane; const float* nw = C.p.norm1 + (size_t)l * D + 4 * lane;
            bf16_t* hr = C.HX + (size_t)row * D + 4 * lane;
#pragma unroll
            for (int j = 0; j < 4; ++j) { const f32x4 h = v[j] * rstd * *(const f32x4*)(nw + 256 * j) * (*(const f32x4*)(m + M_SC1 + 256 * j) + 1.0f) + *(const f32x4*)(m + M_SH1 + 256 * j);
                u32x2 w; w.x = cvt_pk_bf16(h[0], h[1]); w.y = cvt_pk_bf16(h[2], h[3]); *(u32x2*)(hr + 256 * j) = w; }
        }
    }
}
__device__ __forceinline__ void phase_rowB(const Ctx& C, int l, int nq) {
    const int tid = tid_l(), lane = tid & 63, wave = __builtin_amdgcn_readfirstlane(tid >> 6), gw = blockIdx.x * NWV + wave, NGW = gridDim.x * NWV; (void)lane; (void)gw; (void)NGW;
    LAS float* R = (LAS float*)C.lds;
    const float* rt = C.p.router + (size_t)l * D * NE;
    for (int i = tid; i < D * NE; i += NT) R[(i % NE) * D + i / NE] = rt[i];
    __syncthreads();
    for (int row = gw; row < nq; row += NGW) {
        const float* xr = xrow_ptr(C.xl, C.xc, row); const int b = row_batch(row);
        f32x4 v[4]; float ss = 0.f;
#pragma unroll
        for (int j = 0; j < 4; ++j) { v[j] = *(const f32x4*)(xr + 4 * lane + 256 * j); ss += (v[j][0] * v[j][0] + v[j][1] * v[j][1]) + (v[j][2] * v[j][2] + v[j][3] * v[j][3]); }
        const float rstd = 1.0f / sqrtf(wave_sum(ss) * (1.0f / D) + EPS);
        const float* m = C.mod + ((size_t)l * (NB + 1) + b) * 6 * D + 4 * lane; const float* nw = C.p.norm2 + (size_t)l * D + 4 * lane;
        bf16_t* hr = C.HX2 + (size_t)row * D + 4 * lane;
#pragma unroll
        for (int j = 0; j < 4; ++j) { v[j] = v[j] * rstd * *(const f32x4*)(nw + 256 * j) * (*(const f32x4*)(m + M_SC2 + 256 * j) + 1.0f) + *(const f32x4*)(m + M_SH2 + 256 * j);
            u32x2 w; w.x = cvt_pk_bf16(v[j][0], v[j][1]); w.y = cvt_pk_bf16(v[j][2], v[j][3]); *(u32x2*)(hr + 256 * j) = w; }
        float lg[NE]; float mx = -1e30f;
#pragma unroll
        for (int e = 0; e < NE; ++e) { float s = 0.f;
#pragma unroll
            for (int j = 0; j < 4; ++j) { const f32x4 r4 = *(const LAS f32x4*)(R + e * D + 4 * lane + 256 * j); s += (v[j][0] * r4[0] + v[j][1] * r4[1]) + (v[j][2] * r4[2] + v[j][3] * r4[3]); }
            lg[e] = wave_sum(s); mx = fmaxf(mx, lg[e]); }
        float se = 0.f;
#pragma unroll
        for (int e = 0; e < NE; ++e) { lg[e] = expf(lg[e] - mx); se += lg[e]; }
        float mine = 0.f;
#pragma unroll
        for (int e = 0; e < NE; ++e) mine = (lane == e) ? lg[e] / se : mine;
        if (lane < NE) C.aff[(size_t)row * NE + lane] = mine;
    }
    __syncthreads();
}
template <int NV>
__device__ __forceinline__ void select_task(const Ctx& C, int base_row, int cap, int e, int slot0, int lane) {
    unsigned v[NV];
#pragma unroll
    for (int i = 0; i < NV; ++i) v[i] = __builtin_bit_cast(unsigned, C.aff[(size_t)(base_row + i * 64 + lane) * NE + e]);
    unsigned T = 0u;
    for (int bit = 30; bit >= 0; --bit) { const unsigned cand = T | (1u << bit); int cnt = 0;
#pragma unroll
        for (int i = 0; i < NV; ++i) cnt += __builtin_popcountll(__ballot(v[i] >= cand));
        if (cnt >= cap) T = cand; }
    int ngt = 0;
#pragma unroll
    for (int i = 0; i < NV; ++i) ngt += __builtin_popcountll(__ballot(v[i] > T));
    const int need = cap - ngt;
    const unsigned long long lt = (1ull << lane) - 1ull; int nsel = 0, neq = 0;
#pragma unroll
    for (int i = 0; i < NV; ++i) {
        const bool gt = v[i] > T, eq = v[i] == T; const unsigned long long meq = __ballot(eq);
        const bool take = gt || (eq && (neq + __builtin_popcountll(meq & lt)) < need);
        const unsigned long long msel = __ballot(take);
        const int row = base_row + i * 64 + lane; int slot = -1;
        if (take) { slot = slot0 + nsel + __builtin_popcountll(msel & lt); C.sel[slot] = row; C.gate[slot] = __builtin_bit_cast(float, v[i]); }
        C.tokslot[(size_t)row * NE + e] = slot;
        nsel += __builtin_popcountll(msel); neq += __builtin_popcountll(meq);
    }
}
__device__ __forceinline__ void phase_select(const Ctx& C, bool need_ctx) {
    const int tid = tid_l(), lane = tid & 63, wave = __builtin_amdgcn_readfirstlane(tid >> 6), gw = blockIdx.x * NWV + wave, NGW = gridDim.x * NWV; (void)lane; (void)gw; (void)NGW;
    const int ntask = NB * NE * (need_ctx ? 2 : 1);
    for (int task = gw; task < ntask; task += NGW) {
        const int set = task / (NB * NE), b = (task / NE) % NB, e = task % NE;
        if (set == 0) select_task<SEQ / 64>(C, b * SEQ, CAPL, e, e * SLOTS_E + b * CAPL, lane);
        else select_task<CTX / 64>(C, RL + b * CTX, CAPC, e, e * SLOTS_E + SLOTS_L + b * CAPC, lane);
    }
}
namespace att {
typedef float f32x16 __attribute__((ext_vector_type(16)));
typedef short v4i16_t __attribute__((ext_vector_type(4)));
typedef __bf16 bf16x2_t __attribute__((ext_vector_type(2)));
constexpr int KSTR = 144, TILE_B = 64 * KSTR, BUF_B = 2 * TILE_B;
constexpr float THR = 8.0f;
__device__ __forceinline__ unsigned pk2(float a, float b) { bf16x2_t v = {(__bf16)a, (__bf16)b}; return __builtin_bit_cast(unsigned, v); }
__device__ __forceinline__ float xmax32(float x) { auto rr = __builtin_amdgcn_permlane32_swap(__float_as_uint(x), __float_as_uint(x), false, false); return fmaxf(__uint_as_float(rr[0]), __uint_as_float(rr[1])); }
__device__ __forceinline__ float xsum32(float x) { auto rr = __builtin_amdgcn_permlane32_swap(__float_as_uint(x), __float_as_uint(x), false, false); return __uint_as_float(rr[0]) + __uint_as_float(rr[1]); }
__device__ __forceinline__ int crow(int reg, int h) { return (reg & 3) + 8 * (reg >> 2) + 4 * h; }
#define MFMA32(a, b, c) __builtin_amdgcn_mfma_f32_32x32x16_bf16((a), (b), (c), 0, 0, 0)

template <int NSUB, int DKS>
__device__ __forceinline__ void flash_tile(const LAS unsigned char* kb_, const LAS unsigned char* vb_, const bf16x8 (&Q)[NSUB][DKS], f32x16 (&O)[NSUB][2], float (&m)[NSUB], float (&l)[NSUB],
                                           int lane, bool masked, int dq) {
    const int r = lane & 31, h = lane >> 5;
    bf16x8 Pf[NSUB][4];
#pragma unroll
    for (int sub = 0; sub < NSUB; ++sub) {
        f32x16 S[2];
#pragma unroll
        for (int kb = 0; kb < 2; ++kb) {
#pragma unroll
            for (int i = 0; i < 16; ++i) S[kb][i] = 0.f;
#pragma unroll
            for (int s = 0; s < DKS; ++s) { const bf16x8 kf = *(const LAS bf16x8*)(kb_ + (32 * kb + r) * KSTR + (sub * DKS * 16 + 16 * s + 8 * h) * 2); S[kb] = MFMA32(kf, Q[sub][s], S[kb]); }
        }
        if (masked) {
#pragma unroll
            for (int kb = 0; kb < 2; ++kb)
#pragma unroll
                for (int i = 0; i < 16; ++i) { const int dl = dq - (32 * kb + crow(i, h)); S[kb][i] = (dl > WINDOW || dl < -WINDOW) ? -1e30f : S[kb][i]; }
        }
        float mx = S[0][0];
#pragma unroll
        for (int i = 1; i < 16; ++i) mx = fmaxf(mx, S[0][i]);
#pragma unroll
        for (int i = 0; i < 16; ++i) mx = fmaxf(mx, S[1][i]);
        mx = xmax32(mx);
        if (!__all(mx <= m[sub] + THR)) {
            const float mn = fmaxf(m[sub], mx), alpha = __builtin_amdgcn_exp2f(m[sub] - mn); m[sub] = mn; l[sub] *= alpha;
#pragma unroll
            for (int db = 0; db < 2; ++db)
#pragma unroll
                for (int i = 0; i < 16; ++i) O[sub][db][i] *= alpha;
        }
        const float mm = m[sub]; float ls = 0.f;
#pragma unroll
        for (int kb = 0; kb < 2; ++kb)
#pragma unroll
            for (int i = 0; i < 16; ++i) { S[kb][i] = __builtin_amdgcn_exp2f(S[kb][i] - mm); ls += S[kb][i]; }
        l[sub] += ls;
#pragma unroll
        for (int kb = 0; kb < 2; ++kb)
#pragma unroll
            for (int s = 0; s < 2; ++s) { u32x4 w; w.x = pk2(S[kb][8 * s + 0], S[kb][8 * s + 1]); w.y = pk2(S[kb][8 * s + 2], S[kb][8 * s + 3]); w.z = pk2(S[kb][8 * s + 4], S[kb][8 * s + 5]); w.w = pk2(S[kb][8 * s + 6], S[kb][8 * s + 7]);
                Pf[sub][2 * kb + s] = __builtin_bit_cast(bf16x8, w); }
    }
    const int i16 = lane & 15, q = i16 >> 2, p = i16 & 3, rblk = (lane >> 4) & 1;
    const LAS unsigned char* vbase = vb_ + (4 * h + q) * KSTR + (16 * rblk + 4 * p) * 2;
#pragma unroll
    for (int ks = 0; ks < 4; ++ks)
#pragma unroll
        for (int db = 0; db < 2; ++db) {
            const v4i16_t lo = __builtin_amdgcn_ds_read_tr16_b64_v4i16((LAS v4i16_t*)(vbase + (16 * ks) * KSTR + 64 * db));
            const v4i16_t hi = __builtin_amdgcn_ds_read_tr16_b64_v4i16((LAS v4i16_t*)(vbase + (16 * ks + 8) * KSTR + 64 * db));
            const bf16x8 vf = __builtin_shufflevector(lo, hi, 0, 1, 2, 3, 4, 5, 6, 7);
#pragma unroll
            for (int sub = 0; sub < NSUB; ++sub) O[sub][db] = MFMA32(vf, Pf[sub][ks], O[sub][db]);
        }
}
#define ATT_STG_LOAD(krow0) do { const bf16_t* _p = C.P + (size_t)((krow0) + skey) * PROJ + 8 * schunk; kreg = *(const u32x4*)(_p + kcol); vreg = *(const u32x4*)(_p + vcol); } while (0)
#define ATT_STG_STORE(buf) do { LAS unsigned char* _d = C.lds + (buf) * BUF_B + skey * KSTR + schunk * 16; *(LAS u32x4*)_d = kreg; *(LAS u32x4*)(_d + TILE_B) = vreg; } while (0)

__device__ __forceinline__ void phase_attnA(const Ctx& C, int l, bool need_ctx) {
    const int tid = tid_l(), lane = tid & 63, wave = __builtin_amdgcn_readfirstlane(tid >> 6), skey = tid >> 3, schunk = tid & 7;
    const int r = lane & 31, h = lane >> 5, hq = wave & 3, ph = wave >> 2;
    constexpr int NUL = NB * NKVA * (SEQ / 64), NUC = NB * NKVA * (CTX / 64);
    const int nu = NUL + (need_ctx ? NUC : 0);
    for (int u = blockIdx.x; u < nu; u += gridDim.x) {
        const bool lat = u < NUL; const int uu = lat ? u : u - NUL; const int nqb = lat ? SEQ / 64 : CTX / 64;
        const int b = uu / (NKVA * nqb), kvh = (uu / nqb) % NKVA, qb = uu % nqb, head = kvh * GQA + hq;
        const int kcol = C_KA + kvh * HDIM, vcol = C_VA + kvh * HDIM;
        const int q0 = 64 * qb + 32 * ph;
        const int qrow = (lat ? b * SEQ : RL + b * CTX) + q0 + r;
        const int jlo = lat ? (2 - qb > 0 ? 2 - qb : 0) : 0, jhi = lat ? (33 - qb < 4 ? 33 - qb : 4) : -1;
        const int nt = CTX / 64 + (jhi - jlo + 1);
        bf16x8 Q[1][4];
#pragma unroll
        for (int s = 0; s < 4; ++s) Q[0][s] = *(const bf16x8*)(C.P + (size_t)qrow * PROJ + C_QA + head * HDIM + 16 * s + 8 * h);
        f32x16 O[1][2]; float m[1], ls[1];
#pragma unroll
        for (int db = 0; db < 2; ++db)
#pragma unroll
            for (int i = 0; i < 16; ++i) O[0][db][i] = 0.f;
        m[0] = C.p.attn_sink[l * NHA + head] * LOG2E; ls[0] = (h == 0) ? 1.0f : 0.0f;
        u32x4 kreg, vreg;
#define ATT_TROW(i) ((i) < CTX / 64 ? RL + b * CTX + 64 * (i) : b * SEQ + 64 * qb - 128 + 64 * (jlo + (i) - CTX / 64))
        ATT_STG_LOAD(ATT_TROW(0)); ATT_STG_STORE(0); __syncthreads();
        for (int i = 0; i < nt; ++i) {
            if (i + 1 < nt) ATT_STG_LOAD(ATT_TROW(i + 1));
            const bool loc = i >= CTX / 64; const int d = loc ? q0 - (64 * qb - 128 + 64 * (jlo + i - CTX / 64)) : 0;
            const bool masked = loc && (d > 97 || d < -65);
            const LAS unsigned char* kb_ = C.lds + (i & 1) * BUF_B;
            flash_tile<1, 4>(kb_, kb_ + TILE_B, Q, O, m, ls, lane, masked, d + r);
            if (i + 1 < nt) ATT_STG_STORE((i + 1) & 1);
            __syncthreads();
        }
#undef ATT_TROW
        const float inv = 1.0f / xsum32(ls[0]);
        bf16_t* op = C.MIX + (size_t)qrow * D + head * HDIM + 4 * h;
#pragma unroll
        for (int db = 0; db < 2; ++db)
#pragma unroll
            for (int g = 0; g < 4; ++g) { u32x2 w; w.x = pk2(O[0][db][4 * g] * inv, O[0][db][4 * g + 1] * inv); w.y = pk2(O[0][db][4 * g + 2] * inv, O[0][db][4 * g + 3] * inv);
                *(u32x2*)(op + 32 * db + 8 * g) = w; }
    }
}
__device__ __forceinline__ void phase_attnD(const Ctx& C, int l, bool need_ctx) {
    const int tid = tid_l(), lane = tid & 63, wave = __builtin_amdgcn_readfirstlane(tid >> 6), skey = tid >> 3, schunk = tid & 7;
    const int r = lane & 31, h = lane >> 5;
    const float lam_init = 0.8f - 0.6f * expf(-0.3f * (float)l);
    float lam;
    { const float* lp = C.p.diff_lambda + l * 4 * DD; const float a = lane < DD ? lp[lane] * lp[DD + lane] : 0.f, b2 = lane < DD ? lp[2 * DD + lane] * lp[3 * DD + lane] : 0.f;
      lam = expf(wave_sum(a)) - expf(wave_sum(b2)) + lam_init; }
    constexpr int NUL = NB * NHC * (SEQ / 256), NUC = NB * NHC * (CTX / 256);
    const int nu = NUL + (need_ctx ? NUC : 0);
    for (int u = blockIdx.x; u < nu; u += gridDim.x) {
        const bool lat = u < NUL; const int uu = lat ? u : u - NUL; const int nqb = lat ? SEQ / 256 : CTX / 256;
        const int b = uu / (NHC * nqb), hd = (uu / nqb) % NHC, qb = uu % nqb;
        const int kcol = C_KD + hd * 2 * DD, vcol = C_VD + hd * 2 * DD;
        const int qrow = (lat ? b * SEQ : RL + b * CTX) + 256 * qb + 32 * wave + r;
        const int nt = CTX / 64 + (lat ? SEQ / 64 : 0);
        bf16x8 Q[2][2];
#pragma unroll
        for (int j = 0; j < 2; ++j)
#pragma unroll
            for (int s = 0; s < 2; ++s) Q[j][s] = *(const bf16x8*)(C.P + (size_t)qrow * PROJ + C_QD + hd * 2 * DD + j * DD + 16 * s + 8 * h);
        f32x16 O[2][2]; float m[2], ls[2];
#pragma unroll
        for (int j = 0; j < 2; ++j) { m[j] = -1e30f; ls[j] = 0.f;
#pragma unroll
            for (int db = 0; db < 2; ++db)
#pragma unroll
                for (int i = 0; i < 16; ++i) O[j][db][i] = 0.f; }
        u32x4 kreg, vreg;
#define ATT_TROW(i) ((i) < CTX / 64 ? RL + b * CTX + 64 * (i) : b * SEQ + 64 * ((i) - CTX / 64))
        ATT_STG_LOAD(ATT_TROW(0)); ATT_STG_STORE(0); __syncthreads();
        for (int i = 0; i < nt; ++i) {
            if (i + 1 < nt) ATT_STG_LOAD(ATT_TROW(i + 1));
            const LAS unsigned char* kb_ = C.lds + (i & 1) * BUF_B;
            flash_tile<2, 2>(kb_, kb_ + TILE_B, Q, O, m, ls, lane, false, 0);
            if (i + 1 < nt) ATT_STG_STORE((i + 1) & 1);
            __syncthreads();
        }
#undef ATT_TROW
        const float i0 = 1.0f / xsum32(ls[0]), i1 = lam / xsum32(ls[1]);
        float ss = 0.f;
#pragma unroll
        for (int db = 0; db < 2; ++db)
#pragma unroll
            for (int i = 0; i < 16; ++i) { const float y = O[0][db][i] * i0 - O[1][db][i] * i1; O[0][db][i] = y; ss += y * y; }
        const float rn = (1.0f - lam_init) / sqrtf(xsum32(ss) * (1.0f / (2 * DD)) + EPS);
        const float* sw = C.p.diff_subln + l * 2 * DD + 4 * h;
        bf16_t* op = C.MIX + (size_t)qrow * D + 768 + hd * 2 * DD + 4 * h;
#pragma unroll
        for (int db = 0; db < 2; ++db)
#pragma unroll
            for (int g = 0; g < 4; ++g) { const f32x4 s4 = *(const f32x4*)(sw + 32 * db + 8 * g);
                u32x2 w; w.x = pk2(O[0][db][4 * g] * rn * s4[0], O[0][db][4 * g + 1] * rn * s4[1]); w.y = pk2(O[0][db][4 * g + 2] * rn * s4[2], O[0][db][4 * g + 3] * rn * s4[3]);
                *(u32x2*)(op + 32 * db + 8 * g) = w; }
    }
}
#undef ATT_STG_LOAD
#undef ATT_STG_STORE
}
__device__ __forceinline__ void phase_conv(const Ctx& C, int l, int nq) {
    const int tid = tid_l();
    const float* cw = C.p.conv_w + l * 3 * CONV_CH;
    for (long g = (long)blockIdx.x * NT + tid; g < (long)nq * (CONV_CH / 8); g += (long)gridDim.x * NT) {
        const int row = (int)(g / (CONV_CH / 8)), c8 = (int)(g % (CONV_CH / 8)) * 8;
        const bool lat = row < RL; const int t = lat ? row % SEQ : (row - RL) % CTX, len = lat ? SEQ : CTX;
        float y[8];
#pragma unroll
        for (int k = 0; k < 8; ++k) y[k] = 0.f;
#pragma unroll
        for (int j = 0; j < 3; ++j) { const int tt = t + j - 1; if (tt < 0 || tt >= len) continue;
            const bf16_t* pr = C.P + (size_t)(row + j - 1) * PROJ + c8; const u32x4 a = *(const u32x4*)(pr + C_CIN), c = *(const u32x4*)(pr + C_CC);
            const f32x4 w0 = *(const f32x4*)(cw + j * CONV_CH + c8), w1 = *(const f32x4*)(cw + j * CONV_CH + c8 + 4);
#pragma unroll
            for (int k = 0; k < 4; ++k) { const unsigned av = a[k], cv = c[k];
                y[2 * k] += (k < 2 ? w0[2 * k] : w1[2 * k - 4]) * (__builtin_bit_cast(float, av << 16) * __builtin_bit_cast(float, cv << 16));
                y[2 * k + 1] += (k < 2 ? w0[2 * k + 1] : w1[2 * k - 3]) * (__builtin_bit_cast(float, av & 0xffff0000u) * __builtin_bit_cast(float, cv & 0xffff0000u)); } }
        const u32x4 gb = *(const u32x4*)(C.P + (size_t)row * PROJ + C_CB + c8);
        u32x4 o;
#pragma unroll
        for (int k = 0; k < 4; ++k) o[k] = att::pk2(__builtin_bit_cast(float, gb[k] << 16) * y[2 * k], __builtin_bit_cast(float, gb[k] & 0xffff0000u) * y[2 * k + 1]);
        *(u32x4*)(C.MIX + (size_t)row * D + 512 + c8) = o;
    }
}
#ifndef ATT_A
#define ATT_A 1
#endif
#ifndef ATT_D
#define ATT_D 1
#endif
__device__ __forceinline__ void phase_mix_naive(const Ctx& C, int l, int nq) {
    const int tid = tid_l(), lane = tid & 63, wave = __builtin_amdgcn_readfirstlane(tid >> 6), gw = blockIdx.x * NWV + wave, NGW = gridDim.x * NWV; (void)lane; (void)gw; (void)NGW;
    const long g0 = (long)blockIdx.x * NT + tid, gs = (long)gridDim.x * NT; const float lam_init = 0.8f - 0.6f * expf(-0.3f * (float)l);
#if !ATT_A
    for (long g = g0; g < (long)nq * NHA; g += gs) b_attnA(g, C.P, C.p.attn_sink + l * NHA, C.MIX, nq);
#endif
#if !ATT_D
    for (long g = g0; g < (long)nq * NHC * 2; g += gs) b_attnD(g, C.P, C.TMP, nq);
#endif
    (void)g0; (void)gs;
}
__device__ __forceinline__ void phase_diffpost_naive(const Ctx& C, int l, int nq) {
    const int tid = tid_l(), lane = tid & 63, wave = __builtin_amdgcn_readfirstlane(tid >> 6), gw = blockIdx.x * NWV + wave, NGW = gridDim.x * NWV; (void)lane; (void)gw; (void)NGW;
    const long g0 = (long)blockIdx.x * NT + tid, gs = (long)gridDim.x * NT; const float lam_init = 0.8f - 0.6f * expf(-0.3f * (float)l);
    for (long g = g0; g < (long)nq * NHC; g += gs) b_diffpost(g, C.TMP, C.p.diff_lambda + l * 4 * DD, C.p.diff_subln + l * 2 * DD, lam_init, C.MIX, nq);
}

constexpr int NPH = 9, PH_FINAL = 1 + DEPTH * NPH, PH_TOTAL = PH_FINAL + 1;
__global__ void __launch_bounds__(NT, 2) mega_fwd(Args args) {
    extern __shared__ __attribute__((aligned(16))) unsigned char lds_raw[];
    Ctx C;
    C.p.x = args.in[0]; C.p.c = args.in[1]; C.p.ctx = args.in[2]; C.p.c_ctx = args.in[3]; C.p.w_ada = args.in[4]; C.p.b_ada = args.in[5]; C.p.norm1 = args.in[6]; C.p.norm2 = args.in[7];
    C.p.w_in = args.in[8]; C.p.w_out = args.in[9]; C.p.attn_sink = args.in[10]; C.p.conv_w = args.in[11]; C.p.diff_lambda = args.in[12]; C.p.diff_subln = args.in[13]; C.p.router = args.in[14];
    C.p.w_gate = args.in[15]; C.p.w_up = args.in[16]; C.p.w_down = args.in[17]; C.p.norm_final = args.in[18];
    C.p.out = args.out; C.p.ws = args.ws;
    C.lds = (LAS unsigned char*)lds_raw;
    unsigned char* ws = args.ws;
    C.tab = (float*)(ws + WS_TAB); C.mod = (float*)(ws + WS_MOD); C.aff = (float*)(ws + WS_AFF); C.sel = (int*)(ws + WS_SEL); C.gate = (float*)(ws + WS_GATE); C.tokslot = (int*)(ws + WS_TOKSLOT);
    C.xc = (float*)(ws + WS_XC); C.xl = args.out; C.win = (bf16_t*)(ws + WS_WIN); C.wout = (bf16_t*)(ws + WS_WOUT);
    C.P = (bf16_t*)(ws + WS_R1); C.H = (bf16_t*)(ws + WS_R1); C.Y = (bf16_t*)(ws + WS_R2); C.MIX = (bf16_t*)(ws + WS_R2); C.HX2 = (bf16_t*)(ws + WS_R2 + (size_t)RALL * D * 2); C.TMP = (float*)C.HX2;
    C.HX = (bf16_t*)(ws + WS_R3);
    volatile LAS unsigned* misc = (volatile LAS unsigned*)(C.lds + LDS_MISC);
    if (threadIdx.x < 64) misc[threadIdx.x] = 0u;
    __syncthreads();
    const int lo = args.ph_lo, hi = args.ph_hi;
    XcdBarrier bar; bar.bar = (unsigned*)(ws + WS_CTL) + CW_BAR; bar.x = 0; bar.st = misc;
    if (hi - lo > 1) bar = xcd_barrier_post((unsigned*)(ws + WS_CTL) + CW_BAR, misc);
#define IN(k) (lo <= (k) && (k) < hi)
#define SEAM(k) do { if (IN(k) && IN((k) + 1)) xcd_barrier(bar); } while (0)
    const int G = (int)gridDim.x, bid = (int)blockIdx.x;
    if (IN(0)) phase_prologue(C);
    SEAM(0);
    for (int l = 0; l < DEPTH; ++l) {
        const int pb = 1 + l * NPH; const bool need_ctx = l < DEPTH - 1; const int nq = need_ctx ? RALL : RL;
        const float* modl = C.mod + (size_t)l * (NB + 1) * 6 * D;
        if (IN(pb + 0)) { phase_cvt_experts(C, l); phase_rowA<false>(C, l); }
        SEAM(pb + 0);
        if (IN(pb + 1)) { pg::GemmD g{(const char*)C.HX, nullptr, (const char*)(C.win + (size_t)l * PROJ * D), 0, D}; pg::Order S; S.init(RALL / 256, PROJ / 256, G, bid, 0);
            pg::EpiP E{C.P, C.tab}; pg::gemm_phase<pg::EpiP, false>(C.lds, g, S, E); }
        SEAM(pb + 1);
        if (IN(pb + 2)) {
#if ATT_A
            att::phase_attnA(C, l, need_ctx);
#endif
#if ATT_D
            att::phase_attnD(C, l, need_ctx);
#endif
            phase_mix_naive(C, l, nq); phase_conv(C, l, nq); }
        SEAM(pb + 2);
#if !ATT_D
        if (IN(pb + 3)) phase_diffpost_naive(C, l, nq);
#endif
        SEAM(pb + 3);
        if (IN(pb + 4)) { pg::GemmD g{(const char*)C.MIX, nullptr, (const char*)(C.wout + (size_t)l * D * D), 0, D}; pg::Order S; S.init(nq / 256, D / 256, G, bid, 0);
            pg::EpiX E{C.xl, C.xc, modl}; pg::gemm_phase<pg::EpiX, false>(C.lds, g, S, E); }
        SEAM(pb + 4);
        if (IN(pb + 5)) phase_rowB(C, l, nq);
        SEAM(pb + 5);
        if (IN(pb + 6)) phase_select(C, need_ctx);
        SEAM(pb + 6);
        const int tpe = need_ctx ? pg::TPE_FULL : SLOTS_L / 256;
        if (IN(pb + 7)) { pg::GemmD g{(const char*)C.HX2, C.sel, (const char*)((bf16_t*)(ws + WS_WGU) + (size_t)(l & 1) * NE * 2 * FF * D), (size_t)2 * FF * D * 2, D}; pg::Order S; S.init(NE * tpe, 2 * FF / 256, G, bid, tpe);
            pg::EpiH E{C.H}; pg::gemm_phase<pg::EpiH, true>(C.lds, g, S, E); }
        SEAM(pb + 7);
        if (IN(pb + 8)) { pg::GemmD g{(const char*)C.H, nullptr, (const char*)((bf16_t*)(ws + WS_WD) + (size_t)(l & 1) * NE * D * FF), (size_t)D * FF * 2, FF}; pg::Order S; S.init(NE * tpe, D / 256, G, bid, tpe);
            pg::EpiY E{C.Y, C.gate}; pg::gemm_phase<pg::EpiY, false>(C.lds, g, S, E); }
        SEAM(pb + 8);
    }
    if (IN(PH_FINAL)) phase_rowA<true>(C, DEPTH);
#undef IN
#undef SEAM
}
#endif

#ifndef HOST_TEST
#ifndef MODE
#define MODE 2
#endif
extern "C" void kernel_launch(void* const* d_in, const int* in_sizes, int n_in, void* d_out, int out_size, void* d_ws, size_t ws_size, hipStream_t stream) {
    if (n_in != 19 || out_size != RL * D || ws_size < WS_END) { fprintf(stderr, "kernel_launch: unexpected shapes (n_in %d out %d ws %zu need %zu)\n", n_in, out_size, ws_size, (size_t)WS_END); return; }
#if MODE == 0
    Ptrs p{};
    const float** f = (const float**)&p;
    for (int i = 0; i < 19; ++i) f[i] = (const float*)d_in[i];
    p.out = (float*)d_out; p.ws = (unsigned char*)d_ws;
    forward(p, stream);
#else
    static int grid = 0;
    if (grid == 0) {
        int dev = 0, cus = 0;
        if (hipGetDevice(&dev) != hipSuccess || hipDeviceGetAttribute(&cus, hipDeviceAttributeMultiprocessorCount, dev) != hipSuccess) { fprintf(stderr, "kernel_launch: device query failed\n"); grid = -1; return; }
        if (hipFuncSetAttribute((const void*)mega_fwd, hipFuncAttributeMaxDynamicSharedMemorySize, LDS_BYTES) != hipSuccess) { fprintf(stderr, "kernel_launch: hipFuncSetAttribute failed\n"); grid = -1; return; }
        int per_cu = 0;
        if (hipOccupancyMaxActiveBlocksPerMultiprocessor(&per_cu, (const void*)mega_fwd, NT, LDS_BYTES) != hipSuccess || per_cu < 1) fprintf(stderr, "kernel_launch: occupancy query reports %d blocks per CU\n", per_cu);
        (void)hipGetLastError();
        grid = cus;
    }
    if (grid < 0) return;
    if (hipMemsetAsync((char*)d_ws + WS_CTL, 0, CTL_BYTES, stream) != hipSuccess) { fprintf(stderr, "kernel_launch: memset failed\n"); return; }
    Args a{};
    for (int i = 0; i < 19; ++i) a.in[i] = (const float*)d_in[i];
    a.out = (float*)d_out; a.ws = (unsigned char*)d_ws;
#if MODE == 2
    a.ph_lo = 0; a.ph_hi = PH_TOTAL;
    hipLaunchKernelGGL(mega_fwd, dim3(grid), dim3(NT), LDS_BYTES, stream, a);
#else
    for (int ph = 0; ph < PH_TOTAL; ++ph) { a.ph_lo = ph; a.ph_hi = ph + 1; hipLaunchKernelGGL(mega_fwd, dim3(grid), dim3(NT), LDS_BYTES, stream, a); }
#endif
    const hipError_t le = hipPeekAtLastError();
    if (le != hipSuccess) fprintf(stderr, "kernel_launch: launch failed: %s\n", hipGetErrorName(le));
#endif
}
#else
#include <vector>
#include <string>
static std::vector<float> rd(const std::string& fn) { FILE* f = fopen(fn.c_str(), "rb"); if (!f) { perror(fn.c_str()); exit(1); } fseek(f, 0, SEEK_END); long n = ftell(f); fseek(f, 0, SEEK_SET); std::vector<float> v(n / 4); if (fread(v.data(), 1, n, f) != (size_t)n) exit(1); fclose(f); return v; }
int main(int argc, char** argv) {
    std::string dir = argv[1]; std::vector<std::vector<float>> in(19);
    for (int i = 0; i < 19; ++i) in[i] = rd(dir + "/in" + std::to_string(i) + ".bin");
    std::vector<float> out((size_t)RL * D); std::vector<unsigned char> ws(WS_END, 0xAA);
    Ptrs p{}; const float** f = (const float**)&p; for (int i = 0; i < 19; ++i) f[i] = in[i].data();
    p.out = out.data(); p.ws = ws.data();
    forward(p, 0);
    FILE* fo = fopen((dir + "/out.bin").c_str(), "wb"); fwrite(out.data(), 4, out.size(), fo); fclose(fo);
    printf("done, ws bytes %zu\n", (size_t)WS_END); return 0;
}
#endif
```

```cpp
#ifndef HOST_TEST
#include <hip/hip_runtime.h>
#endif
#include <cstdio>
#include <cstdint>
#include <cstring>
#include <cmath>

#ifndef CFG_B
#define CFG_B 32
#endif
#ifndef CFG_SEQ
#define CFG_SEQ 2048
#endif
#ifndef CFG_CTX
#define CFG_CTX 256
#endif
#ifndef CFG_DEPTH
#define CFG_DEPTH 4
#endif
constexpr int D = 1024, NB = CFG_B, SEQ = CFG_SEQ, CTX = CFG_CTX, DEPTH = CFG_DEPTH;
constexpr int GRID_W = 64, NROWS = SEQ / GRID_W, HDIM = 64, NHA = 8, NKVA = 2, GQA = 4, WINDOW = 128;
constexpr int CONV_CH = 256, DD = 32, NHC = 4, NE = 16, FF = 1024, PROJ = 2304;
constexpr int RL = NB * SEQ, RC = NB * CTX, RALL = RL + RC;
constexpr int CAPL = 2 * SEQ / NE, CAPC = 2 * CTX / NE;
constexpr int SLOTS_L = NB * CAPL, SLOTS_C = NB * CAPC, SLOTS_E = SLOTS_L + SLOTS_C;
constexpr int NSLOT = NE * SLOTS_E;
constexpr int C_QA = 0, C_KA = 512, C_VA = 640, C_CIN = 768, C_CB = 1024, C_CC = 1280, C_QD = 1536, C_KD = 1792, C_VD = 2048;
constexpr int M_SH1 = 0, M_SC1 = D, M_G1 = 2 * D, M_SH2 = 3 * D, M_SC2 = 4 * D, M_G2 = 5 * D;
constexpr float EPS = 1e-6f, LOG2E = 1.4426950408889634f;
constexpr float QSCALE_A = 0.125f * LOG2E, QSCALE_D = 0.17677669529663687f * LOG2E;

#ifdef HOST_TEST
#define HD
#define KERNEL static void
static thread_local long g_gid;
#define GID g_gid
#include <omp.h>
#define LAUNCH(kern, nthreads, ...) do { const long _n = (long)(nthreads); _Pragma("omp parallel for schedule(static)") for (long _g = 0; _g < _n; ++_g) { g_gid = _g; kern(__VA_ARGS__); } } while (0)
#else
#define HD __host__ __device__ __forceinline__
#define KERNEL __global__ void __launch_bounds__(256)
#define GID ((long)blockIdx.x * blockDim.x + threadIdx.x)
#define LAUNCH(kern, nthreads, ...) do { const long _n = (long)(nthreads); if (_n > 0) hipLaunchKernelGGL(kern, dim3((unsigned)((_n + 255) / 256)), dim3(256), 0, stream, __VA_ARGS__); } while (0)
#endif

typedef unsigned short bf16_t;
HD float bf2f(bf16_t v) { unsigned u = (unsigned)v << 16; return __builtin_bit_cast(float, u); }
HD bf16_t f2bf(float f) { unsigned u = __builtin_bit_cast(unsigned, f); return (bf16_t)((u + 0x7fffu + ((u >> 16) & 1u)) >> 16); }

constexpr size_t al256(size_t x) { return (x + 255) & ~(size_t)255; }
constexpr size_t WS_CTL = 0, CTL_BYTES = 1u << 20;
constexpr size_t WS_TAB = WS_CTL + CTL_BYTES;
constexpr int T_AROW = 0, T_ACOL = T_AROW + NROWS * 16 * 2, T_DROW = T_ACOL + 64 * 16 * 2, T_DCOL = T_DROW + NROWS * 8 * 2, T_END = T_DCOL + 64 * 8 * 2;
constexpr size_t WS_SILU = WS_TAB + al256((size_t)T_END * 4);
constexpr size_t WS_MOD = WS_SILU + al256((size_t)(NB + 1) * D * 4);
constexpr size_t WS_RSTD = WS_MOD + al256((size_t)DEPTH * (NB + 1) * 6 * D * 4);
constexpr size_t WS_AFF = WS_RSTD + al256((size_t)RALL * 4);
constexpr size_t WS_SEL = WS_AFF + al256((size_t)RALL * NE * 4);
constexpr size_t WS_GATE = WS_SEL + al256((size_t)NSLOT * 4);
constexpr size_t WS_TOKSLOT = WS_GATE + al256((size_t)NSLOT * 4);
constexpr size_t WS_XC = WS_TOKSLOT + al256((size_t)RALL * NE * 4);
constexpr size_t WS_WIN = WS_XC + al256((size_t)RC * D * 4);
constexpr size_t WS_WOUT = WS_WIN + al256((size_t)DEPTH * PROJ * D * 2);
constexpr size_t WS_WGU = WS_WOUT + al256((size_t)DEPTH * D * D * 2);
constexpr size_t WS_WD = WS_WGU + al256((size_t)2 * NE * 2 * FF * D * 2);
constexpr size_t WS_R1 = WS_WD + al256((size_t)2 * NE * D * FF * 2);
constexpr size_t R1_BYTES = al256(((size_t)RALL * PROJ * 2 > (size_t)NSLOT * FF * 2) ? (size_t)RALL * PROJ * 2 : (size_t)NSLOT * FF * 2);
constexpr size_t WS_R2 = WS_R1 + R1_BYTES;
constexpr size_t R2_BYTES = al256(((size_t)NSLOT * D * 2 > (size_t)2 * RALL * D * 2) ? (size_t)NSLOT * D * 2 : (size_t)2 * RALL * D * 2);
constexpr size_t WS_R3 = WS_R2 + R2_BYTES;
constexpr size_t WS_XB = WS_R3 + al256((size_t)RALL * D * 2);
constexpr size_t WS_END = WS_XB + al256((size_t)RALL * D * 2);

struct Ptrs {
    const float *x, *c, *ctx, *c_ctx, *w_ada, *b_ada, *norm1, *norm2, *w_in, *w_out, *attn_sink, *conv_w, *diff_lambda, *diff_subln, *router, *w_gate, *w_up, *w_down, *norm_final;
    float* out; unsigned char* ws;
};

HD float* xrow_ptr(float* xl, float* xc, int row) { return row < RL ? xl + (size_t)row * D : xc + (size_t)(row - RL) * D; }
HD int row_batch(int row) { return row < RL ? row / SEQ : NB; }
HD float silu_f(float v) { return v / (1.0f + expf(-v)); }

KERNEL k_tables(float* tab) {
    const long g = GID; if (g >= (long)(NROWS + 64) * 24) return;
    const int pos = (int)(g / 24), f = (int)(g % 24);
    const double inv = f < 16 ? pow(10000.0, -(2.0 * f) / 32.0) : pow(10000.0, -(2.0 * (f - 16)) / 16.0);
    const bool isrow = pos < NROWS; const int p = isrow ? pos : pos - NROWS;
    const double ang = (double)p * inv; const float cs = (float)cos(ang), sn = (float)sin(ang);
    int idx;
    if (f < 16) idx = (isrow ? T_AROW : T_ACOL) + (p * 16 + f) * 2; else idx = (isrow ? T_DROW : T_DCOL) + (p * 8 + (f - 16)) * 2;
    tab[idx] = cs; tab[idx + 1] = sn;
}
KERNEL k_silu(const float* c, const float* c_ctx, float* out) {
    const long g = GID; if (g >= (long)(NB + 1) * D) return;
    const int b = (int)(g / D), k = (int)(g % D); const float v = b < NB ? c[b * D + k] : c_ctx[k];
    out[g] = silu_f(v);
}
KERNEL k_mod(const float* silu, const float* w_ada, const float* b_ada, float* mod) {
    const long g = GID; if (g >= (long)DEPTH * 6 * D) return;
    const int l = (int)(g / (6 * D)), j = (int)(g % (6 * D));
    float acc[NB + 1];
#pragma unroll
    for (int b = 0; b <= NB; ++b) acc[b] = 0.f;
    const float* w = w_ada + (size_t)l * D * 6 * D + j;
    for (int k = 0; k < D; ++k) { const float wv = w[(size_t)k * 6 * D];
#pragma unroll
        for (int b = 0; b <= NB; ++b) acc[b] += silu[b * D + k] * wv; }
    const float bias = b_ada[l * 6 * D + j];
#pragma unroll
    for (int b = 0; b <= NB; ++b) mod[((size_t)l * (NB + 1) + b) * 6 * D + j] = acc[b] + bias;
}
HD int permA(int p) { return (p / 32) * 32 + (p % 32) / 2 + 16 * (p % 2); }
HD int permD(int p) { return (p / 16) * 16 + (p % 16) / 2 + 8 * (p % 2); }
HD int inproj_src_col(int n) {
    if (n < C_VA) return (n / 64) * 64 + permA(n % 64);
    if (n < C_QD) return n;
    if (n < C_VD) return (n / 32) * 32 + permD(n % 32);
    return n;
}
KERNEL k_cvt_win(const float* w_in, bf16_t* wt) {
    const long g = GID; if (g >= (long)DEPTH * PROJ * D) return;
    const int k = (int)(g % D); const int n = (int)((g / D) % PROJ); const int l = (int)(g / ((long)D * PROJ));
    wt[g] = f2bf(w_in[((size_t)l * D + k) * PROJ + inproj_src_col(n)]);
}
KERNEL k_cvt_t(const float* w, bf16_t* wt, int nmat, int K, int N) {
    const long g = GID; if (g >= (long)nmat * K * N) return;
    const int k = (int)(g % K); const int n = (int)((g / K) % N); const int m = (int)(g / ((long)K * N));
    wt[g] = f2bf(w[((size_t)m * K + k) * N + n]);
}
KERNEL k_cvt_gu(const float* wg, const float* wu, bf16_t* wt) {
    const long g = GID; if (g >= (long)NE * 2 * FF * D) return;
    const int k = (int)(g % D); const int n = (int)((g / D) % (2 * FF)); const int e = (int)(g / ((long)D * 2 * FF));
    const int blk = n / 256, bj = (n % 256) / 128, j = n % 128; const float* src = bj ? wu : wg;
    wt[g] = f2bf(src[((size_t)e * D + k) * FF + blk * 128 + j]);
}
KERNEL k_rowstat(const float* xl, const float* xc, float* rstd, int nrows) {
    const long g = GID; if (g >= nrows) return;
    const float* xr = xrow_ptr((float*)xl, (float*)xc, (int)g); float s = 0.f;
    for (int k = 0; k < D; ++k) s += xr[k] * xr[k];
    rstd[g] = 1.0f / sqrtf(s / D + EPS);
}
KERNEL k_rowapply(const float* xl, const float* xc, const float* rstd, const float* nw, const float* modl, int sh_off, int sc_off, bf16_t* hx, int nrows) {
    const long g = GID; if (g >= (long)nrows * D) return;
    const int row = (int)(g / D), k = (int)(g % D); const float* xr = xrow_ptr((float*)xl, (float*)xc, row);
    const float* m = modl + (size_t)row_batch(row) * 6 * D;
    const float v = xr[k] * rstd[row] * nw[k] * (1.0f + m[sc_off + k]) + m[sh_off + k];
    hx[g] = f2bf(v);
}
struct EpiInProj {
    bf16_t* P; const float* tab;
    HD void operator()(int row, int c0, const float* v, const float*) const {
        float o[4] = {v[0], v[1], v[2], v[3]};
        const bool lat = row < RL; const int pos = lat ? row % SEQ : 0; const int gr = pos / GRID_W, gc = pos % GRID_W;
        if (c0 < C_VA) {
            if (lat) { const int p = c0 % 64, grp = p / 32, i0 = (p % 32) / 2;
                const float* t = tab + (grp == 0 ? T_AROW + gr * 32 : T_ACOL + gc * 32) + i0 * 2;
                const float a0 = o[0], b0 = o[1], a1 = o[2], b1 = o[3];
                o[0] = a0 * t[0] - b0 * t[1]; o[1] = b0 * t[0] + a0 * t[1]; o[2] = a1 * t[2] - b1 * t[3]; o[3] = b1 * t[2] + a1 * t[3]; }
            if (c0 < C_KA) { for (int j = 0; j < 4; ++j) o[j] *= QSCALE_A; }
        } else if (c0 >= C_QD && c0 < C_VD) {
            if (lat) { const int p = c0 % 32, grp = p / 16, i0 = (p % 16) / 2;
                const float* t = tab + (grp == 0 ? T_DROW + gr * 16 : T_DCOL + gc * 16) + i0 * 2;
                const float a0 = o[0], b0 = o[1], a1 = o[2], b1 = o[3];
                o[0] = a0 * t[0] - b0 * t[1]; o[1] = b0 * t[0] + a0 * t[1]; o[2] = a1 * t[2] - b1 * t[3]; o[3] = b1 * t[2] + a1 * t[3]; }
            if (c0 < C_KD) { for (int j = 0; j < 4; ++j) o[j] *= QSCALE_D; }
        }
        bf16_t* d = P + (size_t)row * PROJ + c0;
        for (int j = 0; j < 4; ++j) d[j] = f2bf(o[j]);
    }
};
struct EpiOutProj {
    float* xl; float* xc; const float* modl;
    HD void operator()(int row, int c0, const float* v, const float*) const {
        float* xr = xrow_ptr(xl, xc, row) + c0; const float* g1 = modl + (size_t)row_batch(row) * 6 * D + M_G1 + c0;
        for (int j = 0; j < 4; ++j) xr[j] += g1[j] * v[j];
    }
};
struct EpiGateUp {
    bf16_t* H;
    HD void operator()(int row, int c0, const float* v, const float* u) const {
        bf16_t* d = H + (size_t)row * FF + c0;
        for (int j = 0; j < 4; ++j) d[j] = f2bf(silu_f(v[j]) * u[j]);
    }
};
struct EpiDown {
    bf16_t* Y; const float* gate;
    HD void operator()(int row, int c0, const float* v, const float*) const {
        const float g = gate[row]; bf16_t* d = Y + (size_t)row * D + c0;
        for (int j = 0; j < 4; ++j) d[j] = f2bf(v[j] * g);
    }
};
template <class Epi, bool DUAL>
KERNEL k_gemm_naive(const bf16_t* A, const int* rowidx, const bf16_t* Bt, int M, int N, int K, int group_rows, int valid_rows, long bstride, Epi epi) {
    const long g = GID; if (g >= (long)M * (N / 4)) return;
    const int row = (int)(g / (N / 4)), c0 = (int)(g % (N / 4)) * 4;
    if (row % group_rows >= valid_rows) return;
    const int arow = rowidx ? rowidx[row] : row;
    const bf16_t* a = A + (size_t)arow * K; const bf16_t* B = Bt + (size_t)(row / group_rows) * bstride;
    float v[4], u[4];
    for (int j = 0; j < 4; ++j) { const int c = c0 + j; const int br = DUAL ? (c / 128) * 256 + c % 128 : c;
        const bf16_t* b0 = B + (size_t)br * K; float s = 0.f, s2 = 0.f;
        for (int k = 0; k < K; ++k) s += bf2f(a[k]) * bf2f(b0[k]);
        if (DUAL) { const bf16_t* b1 = b0 + (size_t)128 * K; for (int k = 0; k < K; ++k) s2 += bf2f(a[k]) * bf2f(b1[k]); }
        v[j] = s; u[j] = s2; }
    epi(row, c0, v, u);
}
HD void b_attnA(const long g, const bf16_t* P, const float* sink, bf16_t* MIX, int nrows) {
    if (g >= (long)nrows * NHA) return;
    const int h = (int)(g / nrows), row = (int)(g % nrows), kvh = h / GQA;
    const bool lat = row < RL; const int b = lat ? row / SEQ : (row - RL) / CTX; const int t = lat ? row % SEQ : 0;
    float q[HDIM], o[HDIM];
    const bf16_t* qp = P + (size_t)row * PROJ + C_QA + h * HDIM;
#pragma unroll
    for (int d = 0; d < HDIM; ++d) { q[d] = bf2f(qp[d]); o[d] = 0.f; }
    float m = sink[h] * LOG2E, l = 1.0f;
    const int nctx = CTX, lo = lat ? (t - WINDOW < 0 ? 0 : t - WINDOW) : 0, hi = lat ? (t + WINDOW > SEQ - 1 ? SEQ - 1 : t + WINDOW) : -1;
    const int nkeys = nctx + (hi - lo + 1);
    for (int i = 0; i < nkeys; ++i) {
        const int krow = i < nctx ? RL + b * CTX + i : b * SEQ + lo + (i - nctx);
        const bf16_t* kp = P + (size_t)krow * PROJ + C_KA + kvh * HDIM; const bf16_t* vp = P + (size_t)krow * PROJ + C_VA + kvh * HDIM;
        float s = 0.f;
#pragma unroll
        for (int d = 0; d < HDIM; ++d) s += q[d] * bf2f(kp[d]);
        if (s > m) { const float sc = exp2f(m - s); l *= sc;
#pragma unroll
            for (int d = 0; d < HDIM; ++d) o[d] *= sc;
            m = s; }
        const float p = exp2f(s - m); l += p;
#pragma unroll
        for (int d = 0; d < HDIM; ++d) o[d] += p * bf2f(vp[d]);
    }
    const float inv = 1.0f / l; bf16_t* op = MIX + (size_t)row * D + h * HDIM;
#pragma unroll
    for (int d = 0; d < HDIM; ++d) op[d] = f2bf(o[d] * inv);
}
KERNEL k_attnA(const bf16_t* P, const float* sink, bf16_t* MIX, int nrows) { b_attnA(GID, P, sink, MIX, nrows); }
HD void b_attnD(const long g, const bf16_t* P, float* TMP, int nrows) {
    if (g >= (long)nrows * NHC * 2) return;
    const int hc = (int)(g / nrows), row = (int)(g % nrows), h = hc / 2, comp = hc % 2;
    const bool lat = row < RL; const int b = lat ? row / SEQ : (row - RL) / CTX;
    float q[DD], o[2 * DD];
    const bf16_t* qp = P + (size_t)row * PROJ + C_QD + h * 2 * DD + comp * DD;
#pragma unroll
    for (int d = 0; d < DD; ++d) q[d] = bf2f(qp[d]);
#pragma unroll
    for (int d = 0; d < 2 * DD; ++d) o[d] = 0.f;
    float m = -1e30f, l = 0.f;
    const int nkeys = CTX + (lat ? SEQ : 0);
    for (int i = 0; i < nkeys; ++i) {
        const int krow = i < CTX ? RL + b * CTX + i : b * SEQ + (i - CTX);
        const bf16_t* kp = P + (size_t)krow * PROJ + C_KD + h * 2 * DD + comp * DD; const bf16_t* vp = P + (size_t)krow * PROJ + C_VD + h * 2 * DD;
        float s = 0.f;
#pragma unroll
        for (int d = 0; d < DD; ++d) s += q[d] * bf2f(kp[d]);
        if (s > m) { const float sc = exp2f(m - s); l *= sc;
#pragma unroll
            for (int d = 0; d < 2 * DD; ++d) o[d] *= sc;
            m = s; }
        const float p = exp2f(s - m); l += p;
#pragma unroll
        for (int d = 0; d < 2 * DD; ++d) o[d] += p * bf2f(vp[d]);
    }
    const float inv = 1.0f / l; float* op = TMP + (((size_t)row * NHC + h) * 2 + comp) * 2 * DD;
#pragma unroll
    for (int d = 0; d < 2 * DD; ++d) op[d] = o[d] * inv;
}
KERNEL k_attnD(const bf16_t* P, float* TMP, int nrows) { b_attnD(GID, P, TMP, nrows); }
HD void b_diffpost(const long g, const float* TMP, const float* lam_p, const float* subln, float lam_init, bf16_t* MIX, int nrows) {
    if (g >= (long)nrows * NHC) return;
    const int row = (int)(g / NHC), h = (int)(g % NHC);
    float s01 = 0.f, s23 = 0.f;
    for (int d = 0; d < DD; ++d) { s01 += lam_p[d] * lam_p[DD + d]; s23 += lam_p[2 * DD + d] * lam_p[3 * DD + d]; }
    const float lam = expf(s01) - expf(s23) + lam_init;
    const float* t = TMP + ((size_t)row * NHC + h) * 2 * 2 * DD; float y[2 * DD]; float ss = 0.f;
#pragma unroll
    for (int d = 0; d < 2 * DD; ++d) { y[d] = t[d] - lam * t[2 * DD + d]; ss += y[d] * y[d]; }
    const float r = 1.0f / sqrtf(ss / (2 * DD) + EPS) * (1.0f - lam_init);
    bf16_t* op = MIX + (size_t)row * D + 768 + h * 2 * DD;
#pragma unroll
    for (int d = 0; d < 2 * DD; ++d) op[d] = f2bf(y[d] * r * subln[d]);
}
KERNEL k_diffpost(const float* TMP, const float* lam_p, const float* subln, float lam_init, bf16_t* MIX, int nrows) { b_diffpost(GID, TMP, lam_p, subln, lam_init, MIX, nrows); }
HD void b_conv(const long g, const bf16_t* P, const float* cw, bf16_t* MIX, int nrows) {
    if (g >= (long)nrows * CONV_CH) return;
    const int row = (int)(g / CONV_CH), ch = (int)(g % CONV_CH);
    const bool lat = row < RL; const int t = lat ? row % SEQ : (row - RL) % CTX, len = lat ? SEQ : CTX;
    float y = 0.f;
    for (int j = 0; j < 3; ++j) { const int tt = t + j - 1; if (tt < 0 || tt >= len) continue;
        const bf16_t* pr = P + (size_t)(row + j - 1) * PROJ; y += cw[j * CONV_CH + ch] * (bf2f(pr[C_CC + ch]) * bf2f(pr[C_CIN + ch])); }
    MIX[(size_t)row * D + 512 + ch] = f2bf(bf2f(P[(size_t)row * PROJ + C_CB + ch]) * y);
}
KERNEL k_conv(const bf16_t* P, const float* cw, bf16_t* MIX, int nrows) { b_conv(GID, P, cw, MIX, nrows); }
KERNEL k_router(const float* xl, const float* xc, const float* rstd, const float* nw, const float* modl, const float* router, float* logits, int nrows) {
    const long g = GID; if (g >= (long)nrows * NE) return;
    const int row = (int)(g / NE), e = (int)(g % NE); const float* xr = xrow_ptr((float*)xl, (float*)xc, row);
    const float* m = modl + (size_t)row_batch(row) * 6 * D; const float rs = rstd[row]; float s = 0.f;
    for (int k = 0; k < D; ++k) { const float v = xr[k] * rs * nw[k] * (1.0f + m[M_SC2 + k]) + m[M_SH2 + k]; s += v * router[k * NE + e]; }
    logits[g] = s;
}
KERNEL k_aff(float* aff, int nrows) {
    const long g = GID; if (g >= nrows) return;
    float* a = aff + (size_t)g * NE; float m = a[0];
    for (int e = 1; e < NE; ++e) m = a[e] > m ? a[e] : m;
    float s = 0.f; float ex[NE];
#pragma unroll
    for (int e = 0; e < NE; ++e) { ex[e] = expf(a[e] - m); s += ex[e]; }
#pragma unroll
    for (int e = 0; e < NE; ++e) a[e] = ex[e] / s;
}
KERNEL k_select(const float* aff, int* sel, float* gate, int* tokslot, int nrows) {
    const long g = GID; if (g >= (long)nrows * NE) return;
    const int row = (int)(g / NE), e = (int)(g % NE);
    const bool lat = row < RL; const int b = lat ? row / SEQ : (row - RL) / CTX; const int t = lat ? row % SEQ : (row - RL) % CTX;
    const int n = lat ? SEQ : CTX, cap = lat ? CAPL : CAPC, base = lat ? b * SEQ : RL + b * CTX;
    const float a = aff[(size_t)row * NE + e]; int rank = 0;
    for (int j = 0; j < n; ++j) { const float o = aff[(size_t)(base + j) * NE + e]; rank += (o > a || (o == a && j < t)) ? 1 : 0; }
    int slot = -1;
    if (rank < cap) { slot = e * SLOTS_E + (lat ? b * CAPL + rank : SLOTS_L + b * CAPC + rank); sel[slot] = row; gate[slot] = a; }
    tokslot[g] = slot;
}
KERNEL k_combine(float* xl, float* xc, const bf16_t* Y, const int* tokslot, const float* modl, int nrows) {
    const long g = GID; if (g >= (long)nrows * D) return;
    const int row = (int)(g / D), k = (int)(g % D); float s = 0.f;
    for (int e = 0; e < NE; ++e) { const int sl = tokslot[(size_t)row * NE + e]; if (sl >= 0) s += bf2f(Y[(size_t)sl * D + k]); }
    float* xr = xrow_ptr(xl, xc, row); xr[k] += modl[(size_t)row_batch(row) * 6 * D + M_G2 + k] * s;
}
KERNEL k_final(float* xl, const float* rstd, const float* nw) {
    const long g = GID; if (g >= (long)RL * D) return;
    const int row = (int)(g / D), k = (int)(g % D); xl[g] = xl[g] * rstd[row] * nw[k];
}

#ifndef HOST_TEST
typedef short bf16x8 __attribute__((ext_vector_type(8)));
typedef float f32x4 __attribute__((ext_vector_type(4)));
template <class Epi, bool DUAL>
__global__ void __launch_bounds__(256) k_gemm_mfma(const bf16_t* __restrict__ A, const int* __restrict__ rowidx, const bf16_t* __restrict__ Bt, int M, int N, int K, int group_rows, int valid_rows, long bstride, Epi epi) {
    const int tid = threadIdx.x, wid = tid >> 6, lane = tid & 63, fr = lane & 15, fq = lane >> 4, wr = wid >> 1, wc = wid & 1;
    const int row0 = blockIdx.y * 128 + wr * 64;
    if ((blockIdx.y * 128) % group_rows >= valid_rows) return;
    const bf16_t* B = Bt + (size_t)((blockIdx.y * 128) / group_rows) * bstride;
    int brow[4], ocol[4];
    if (!DUAL) { for (int i = 0; i < 4; ++i) { brow[i] = blockIdx.x * 128 + wc * 64 + i * 16; ocol[i] = brow[i]; } }
    else { const int hc0 = blockIdx.x * 64 + wc * 32;
        for (int i = 0; i < 2; ++i) { ocol[i] = hc0 + i * 16; brow[i] = (ocol[i] / 128) * 256 + ocol[i] % 128; brow[i + 2] = brow[i] + 128; ocol[i + 2] = ocol[i]; } }
    const bf16_t* ap[4]; const bf16_t* bp[4];
#pragma unroll
    for (int m = 0; m < 4; ++m) { const int r = row0 + m * 16 + fr; const int ar = rowidx ? rowidx[r] : r; ap[m] = A + (size_t)ar * K + fq * 8; }
#pragma unroll
    for (int i = 0; i < 4; ++i) bp[i] = B + (size_t)(brow[i] + fr) * K + fq * 8;
    f32x4 acc[4][4];
#pragma unroll
    for (int m = 0; m < 4; ++m)
#pragma unroll
        for (int i = 0; i < 4; ++i) acc[m][i] = (f32x4){0.f, 0.f, 0.f, 0.f};
    for (int k0 = 0; k0 < K; k0 += 32) {
        bf16x8 af[4], bfr[4];
#pragma unroll
        for (int m = 0; m < 4; ++m) af[m] = *(const bf16x8*)(ap[m] + k0);
#pragma unroll
        for (int i = 0; i < 4; ++i) bfr[i] = *(const bf16x8*)(bp[i] + k0);
#pragma unroll
        for (int m = 0; m < 4; ++m)
#pragma unroll
            for (int i = 0; i < 4; ++i) acc[m][i] = __builtin_amdgcn_mfma_f32_16x16x32_bf16(bfr[i], af[m], acc[m][i], 0, 0, 0);
    }
#pragma unroll
    for (int m = 0; m < 4; ++m) { const int r = row0 + m * 16 + fr;
#pragma unroll
        for (int i = 0; i < (DUAL ? 2 : 4); ++i) {
            float v[4] = {acc[m][i][0], acc[m][i][1], acc[m][i][2], acc[m][i][3]};
            float u[4] = {acc[m][DUAL ? i + 2 : i][0], acc[m][DUAL ? i + 2 : i][1], acc[m][DUAL ? i + 2 : i][2], acc[m][DUAL ? i + 2 : i][3]};
            epi(r, ocol[i] + 4 * fq, v, u); } }
}
template <class Epi, bool DUAL>
static void launch_gemm(hipStream_t stream, const bf16_t* A, const int* rowidx, const bf16_t* Bt, int M, int N, int K, int group_rows, int valid_rows, long bstride, Epi epi) {
    dim3 grid(DUAL ? N / 64 : N / 128, M / 128);
    hipLaunchKernelGGL((k_gemm_mfma<Epi, DUAL>), grid, dim3(256), 0, stream, A, rowidx, Bt, M, N, K, group_rows, valid_rows, bstride, epi);
}
#define GEMM(Epi, DUAL, ...) launch_gemm<Epi, DUAL>(stream, __VA_ARGS__)
#else
#define GEMM(Epi, DUAL, A, rowidx, Bt, M, N, K, gr, vr, bs, epi) LAUNCH((k_gemm_naive<Epi, DUAL>), (long)(M) * ((N) / 4), A, rowidx, Bt, M, N, K, gr, vr, bs, epi)
#endif

#ifdef HOST_TEST
typedef int hipStream_t;
#endif
static void forward(const Ptrs& p, hipStream_t stream) {
    (void)stream;
    unsigned char* ws = p.ws;
    float* tab = (float*)(ws + WS_TAB); float* silu = (float*)(ws + WS_SILU); float* mod = (float*)(ws + WS_MOD); float* rstd = (float*)(ws + WS_RSTD);
    float* aff = (float*)(ws + WS_AFF); int* sel = (int*)(ws + WS_SEL); float* gate = (float*)(ws + WS_GATE); int* tokslot = (int*)(ws + WS_TOKSLOT);
    float* xc = (float*)(ws + WS_XC); float* xl = p.out;
    bf16_t* win = (bf16_t*)(ws + WS_WIN); bf16_t* wout = (bf16_t*)(ws + WS_WOUT);
    bf16_t* P = (bf16_t*)(ws + WS_R1); bf16_t* H = (bf16_t*)(ws + WS_R1);
    bf16_t* Y = (bf16_t*)(ws + WS_R2); bf16_t* MIX = (bf16_t*)(ws + WS_R2); bf16_t* HX2 = (bf16_t*)(ws + WS_R2 + (size_t)RALL * D * 2); float* TMP = (float*)HX2;
    bf16_t* HX = (bf16_t*)(ws + WS_R3);
    LAUNCH(k_tables, (long)(NROWS + 64) * 24, tab);
    LAUNCH(k_silu, (long)(NB + 1) * D, p.c, p.c_ctx, silu);
    LAUNCH(k_mod, (long)DEPTH * 6 * D, silu, p.w_ada, p.b_ada, mod);
    LAUNCH(k_cvt_win, (long)DEPTH * PROJ * D, p.w_in, win);
    LAUNCH(k_cvt_t, (long)DEPTH * D * D, p.w_out, wout, DEPTH, D, D);
#ifdef HOST_TEST
    memcpy(xl, p.x, (size_t)RL * D * 4); memcpy(xc, p.ctx, (size_t)RC * D * 4);
#else
    (void)hipMemcpyAsync(xl, p.x, (size_t)RL * D * 4, hipMemcpyDeviceToDevice, stream);
    (void)hipMemcpyAsync(xc, p.ctx, (size_t)RC * D * 4, hipMemcpyDeviceToDevice, stream);
#endif
    for (int l = 0; l < DEPTH; ++l) {
        const bool need_ctx = l < DEPTH - 1; const int nq = need_ctx ? RALL : RL;
        const float* modl = mod + (size_t)l * (NB + 1) * 6 * D; const float lam_init = 0.8f - 0.6f * expf(-0.3f * (float)l);
        bf16_t* wgu = (bf16_t*)(ws + WS_WGU) + (size_t)(l & 1) * NE * 2 * FF * D; bf16_t* wd = (bf16_t*)(ws + WS_WD) + (size_t)(l & 1) * NE * D * FF;
        LAUNCH(k_cvt_gu, (long)NE * 2 * FF * D, p.w_gate + (size_t)l * NE * D * FF, p.w_up + (size_t)l * NE * D * FF, wgu);
        LAUNCH(k_cvt_t, (long)NE * FF * D, p.w_down + (size_t)l * NE * FF * D, wd, NE, FF, D);
        LAUNCH(k_rowstat, RALL, xl, xc, rstd, RALL);
        LAUNCH(k_rowapply, (long)RALL * D, xl, xc, rstd, p.norm1 + l * D, modl, M_SH1, M_SC1, HX, RALL);
        GEMM(EpiInProj, false, HX, (const int*)nullptr, win + (size_t)l * PROJ * D, RALL, PROJ, D, RALL, RALL, 0L, (EpiInProj{P, tab}));
        LAUNCH(k_attnA, (long)nq * NHA, P, p.attn_sink + l * NHA, MIX, nq);
        LAUNCH(k_attnD, (long)nq * NHC * 2, P, TMP, nq);
        LAUNCH(k_diffpost, (long)nq * NHC, TMP, p.diff_lambda + l * 4 * DD, p.diff_subln + l * 2 * DD, lam_init, MIX, nq);
        LAUNCH(k_conv, (long)nq * CONV_CH, P, p.conv_w + l * 3 * CONV_CH, MIX, nq);
        GEMM(EpiOutProj, false, MIX, (const int*)nullptr, wout + (size_t)l * D * D, nq, D, D, nq, nq, 0L, (EpiOutProj{xl, xc, modl}));
        LAUNCH(k_rowstat, nq, xl, xc, rstd, nq);
        LAUNCH(k_rowapply, (long)nq * D, xl, xc, rstd, p.norm2 + l * D, modl, M_SH2, M_SC2, HX2, nq);
        LAUNCH(k_router, (long)nq * NE, xl, xc, rstd, p.norm2 + l * D, modl, p.router + (size_t)l * D * NE, aff, nq);
        LAUNCH(k_aff, nq, aff, nq);
        LAUNCH(k_select, (long)nq * NE, aff, sel, gate, tokslot, nq);
        const int vr = need_ctx ? SLOTS_E : SLOTS_L;
        GEMM(EpiGateUp, true, HX2, sel, wgu, NSLOT, FF, D, SLOTS_E, vr, (long)2 * FF * D, (EpiGateUp{H}));
        GEMM(EpiDown, false, H, (const int*)nullptr, wd, NSLOT, D, FF, SLOTS_E, vr, (long)D * FF, (EpiDown{Y, gate}));
        LAUNCH(k_combine, (long)nq * D, xl, xc, Y, tokslot, modl, nq);
    }
    LAUNCH(k_rowstat, RL, xl, xc, rstd, RL);
    LAUNCH(k_final, (long)RL * D, xl, rstd, p.norm_final);
}

#ifndef HOST_TEST
#define LAS __attribute__((address_space(3)))
#define GAS __attribute__((address_space(1)))
typedef unsigned u32x4 __attribute__((ext_vector_type(4)));
typedef unsigned u32x2 __attribute__((ext_vector_type(2)));
constexpr int NT = 512, NWV = 8;
constexpr int LDS_BYTES = 163840;
constexpr int LDS_MISC = LDS_BYTES - 256;
constexpr int CW_BAR = 4096;

__device__ __forceinline__ unsigned cvt_pk_bf16(float lo, float hi) { unsigned r; asm volatile("v_cvt_pk_bf16_f32 %0, %1, %2" : "=v"(r) : "v"(lo), "v"(hi)); return r; }
__device__ __forceinline__ float wave_sum(float v) {
#pragma unroll
    for (int o = 1; o < 64; o <<= 1) v += __shfl_xor(v, o);
    return v;
}
#define LDS_WAIT() asm volatile("s_waitcnt lgkmcnt(0)" ::: "memory")

#define LDS_RD16_B128(r, addr, STRIDE) asm volatile( \
    "ds_read_b128 %0, %16\n\tds_read_b128 %1, %16 offset:%c17\n\tds_read_b128 %2, %16 offset:2*%c17\n\tds_read_b128 %3, %16 offset:3*%c17\n\t" \
    "ds_read_b128 %4, %16 offset:4*%c17\n\tds_read_b128 %5, %16 offset:5*%c17\n\tds_read_b128 %6, %16 offset:6*%c17\n\tds_read_b128 %7, %16 offset:7*%c17\n\t" \
    "ds_read_b128 %8, %16 offset:8*%c17\n\tds_read_b128 %9, %16 offset:9*%c17\n\tds_read_b128 %10, %16 offset:10*%c17\n\tds_read_b128 %11, %16 offset:11*%c17\n\t" \
    "ds_read_b128 %12, %16 offset:12*%c17\n\tds_read_b128 %13, %16 offset:13*%c17\n\tds_read_b128 %14, %16 offset:14*%c17\n\tds_read_b128 %15, %16 offset:15*%c17\n\ts_waitcnt lgkmcnt(0)" \
    : "=&v"(r[0]), "=&v"(r[1]), "=&v"(r[2]), "=&v"(r[3]), "=&v"(r[4]), "=&v"(r[5]), "=&v"(r[6]), "=&v"(r[7]), "=&v"(r[8]), "=&v"(r[9]), "=&v"(r[10]), "=&v"(r[11]), "=&v"(r[12]), "=&v"(r[13]), "=&v"(r[14]), "=&v"(r[15]) \
    : "v"(addr), "i"(STRIDE) : "memory")
#define LDS_RD11_B128(r, addr, STRIDE) asm volatile( \
    "ds_read_b128 %0, %11\n\tds_read_b128 %1, %11 offset:%c12\n\tds_read_b128 %2, %11 offset:2*%c12\n\tds_read_b128 %3, %11 offset:3*%c12\n\t" \
    "ds_read_b128 %4, %11 offset:4*%c12\n\tds_read_b128 %5, %11 offset:5*%c12\n\tds_read_b128 %6, %11 offset:6*%c12\n\tds_read_b128 %7, %11 offset:7*%c12\n\t" \
    "ds_read_b128 %8, %11 offset:8*%c12\n\tds_read_b128 %9, %11 offset:9*%c12\n\tds_read_b128 %10, %11 offset:10*%c12\n\ts_waitcnt lgkmcnt(0)" \
    : "=&v"(r[0]), "=&v"(r[1]), "=&v"(r[2]), "=&v"(r[3]), "=&v"(r[4]), "=&v"(r[5]), "=&v"(r[6]), "=&v"(r[7]), "=&v"(r[8]), "=&v"(r[9]), "=&v"(r[10]) \
    : "v"(addr), "i"(STRIDE) : "memory")
__device__ __forceinline__ int tid_l() { int t = threadIdx.x; asm volatile("" : "+v"(t)); return t; }

#define XB_TMO      128
#define XB_XCNT(j)  (256  + 64 * (j))
#define XB_XSUB(j)  (1280 + 64 * (j))
#define XB_XGEN(j)  (2304 + 64 * (j))
#define XB_TOP      3328
#define XB_TOPGEN   3392
#define XCD_BAR_WORDS 3456
#define XB_SPIN_CAP (1u << 24)
__device__ __forceinline__ unsigned xb_ld(unsigned* p)              { return __hip_atomic_load(p, __ATOMIC_RELAXED, __HIP_MEMORY_SCOPE_AGENT); }
__device__ __forceinline__ unsigned xb_add(unsigned* p, unsigned v) { return __hip_atomic_fetch_add(p, v, __ATOMIC_RELAXED, __HIP_MEMORY_SCOPE_AGENT); }
__device__ __forceinline__ unsigned xb_xcc_id() { return (unsigned)__builtin_amdgcn_s_getreg((3 << 11) | 20) & 0xFu; }
#define XB_SPIN(cond, bar) do { unsigned _sp = 0; while (cond) { __builtin_amdgcn_s_sleep(1); \
    if ((++_sp & 255u) == 0u) { if (xb_ld(&(bar)[XB_TMO])) break; if (_sp > XB_SPIN_CAP) { atomicAdd(&(bar)[XB_TMO], 1u); break; } } } } while (0)
struct XcdBarrier { unsigned* bar; unsigned x; volatile LAS unsigned* st; };
__device__ __forceinline__ XcdBarrier xcd_barrier_post(unsigned* bar, volatile LAS unsigned* st) {
    XcdBarrier b; b.bar = bar; b.x = xb_xcc_id(); b.st = st;
    if (threadIdx.x == 0) (void)xb_add(&bar[XB_XCNT(b.x)], 1u);
    return b;
}
__device__ __forceinline__ void xcd_barrier_complete(unsigned* bar, unsigned x, unsigned& nloc, unsigned& nx) {
    const unsigned G = gridDim.x * gridDim.y * gridDim.z;
    unsigned sum, cnt, mine, sp = 0u;
    for (;;) {
        sum = 0u; cnt = 0u; mine = 0u;
#pragma unroll
        for (unsigned j = 0; j < 16; ++j) { const unsigned c = xb_ld(&bar[XB_XCNT(j)]); sum += c; cnt += (c > 0u) ? 1u : 0u; mine = (j == x) ? c : mine; }
        if (sum == G) break;
        __builtin_amdgcn_s_sleep(1);
        if ((++sp & 255u) == 0u) { if (xb_ld(&bar[XB_TMO])) break; if (sp > XB_SPIN_CAP) { atomicAdd(&bar[XB_TMO], 1u); break; } }
    }
    nloc = mine > 0u ? mine : 1u; nx = cnt > 0u ? cnt : 1u;
}
__device__ __forceinline__ void xcd_barrier(const XcdBarrier& b) {
    asm volatile("s_waitcnt vmcnt(0)" ::: "memory");
    __syncthreads();
    if (threadIdx.x == 0) {
        unsigned* bar = b.bar;
        __builtin_amdgcn_s_waitcnt(0);
        unsigned nloc = b.st[0], nx = b.st[1];
        if (nloc == 0u) { xcd_barrier_complete(bar, b.x, nloc, nx); b.st[0] = nloc; b.st[1] = nx; }
        const unsigned old = xb_add(&bar[XB_XSUB(b.x)], 1u);
        const unsigned gen = old / nloc;
        if (old + 1u == (gen + 1u) * nloc) {
            __builtin_amdgcn_fence(__ATOMIC_RELEASE, "agent");
            asm volatile("s_waitcnt vmcnt(0)" ::: "memory");
            const unsigned og = xb_add(&bar[XB_TOP], 1u);
            const unsigned tg = og / nx;
            if (og + 1u == (tg + 1u) * nx) xb_add(&bar[XB_TOPGEN], 1u);
            else XB_SPIN(xb_ld(&bar[XB_TOPGEN]) == tg, bar);
            __builtin_amdgcn_fence(__ATOMIC_ACQUIRE, "agent");
            xb_add(&bar[XB_XGEN(b.x)], 1u);
            asm volatile("s_waitcnt vmcnt(0)" ::: "memory");
        } else {
            XB_SPIN(xb_ld(&bar[XB_XGEN(b.x)]) == gen, bar);
            __builtin_amdgcn_fence(__ATOMIC_ACQUIRE, "agent");
            asm volatile("s_waitcnt vmcnt(0)" ::: "memory");
        }
    }
    __syncthreads();
}

namespace pg {
constexpr int BM = 256, BK = 64, HALF = 128, HTB = HALF * BK * 2  , STAGE_BYTES = 8 * HTB, NXCD = 8, WGM = 8;
constexpr int TPE_FULL = SLOTS_E / BM;
__host__ __device__ __forceinline__ int lds_byte(int r, int c) { const int st = (r >> 4) * 2 + (c >> 5), rr = r & 15, cc = c & 31, ob = rr * 64 + cc * 2; return st * 1024 + (ob ^ (((ob >> 9) & 1) << 5)); }
__host__ __device__ __forceinline__ void stage_rc(int b, int& R, int& C) { const int st = b / 1024, sb = b % 1024, swz = sb ^ (((sb >> 9) & 1) << 5); R = (st >> 1) * 16 + swz / 64; C = (st & 1) * 32 + (swz % 64) / 2; }
__host__ __device__ __forceinline__ int perm32(int rho) { const int n = rho >> 4, i = rho & 15; return 8 * (i >> 2) + 4 * n + (i & 3); }
struct Unit { int m0, pn, e; };
struct GemmD { const char* A; const int* rowidx; const char* Bt; size_t bstride; int K; };
struct Order {
    int nM, nN, nwg, G, c, tpe;
    __device__ void init(int nM_, int nN_, int G_, int c_, int tpe_) { nM = nM_; nN = nN_; nwg = nM * nN; G = G_; c = c_; tpe = tpe_; }
    __device__ bool next(int i, Unit& u) const {
        const long L = (long)i * G + c; if (L >= nwg) return false;
        int wgid = (int)L; { const int q = nwg / NXCD, r = nwg % NXCD, xcd = wgid % NXCD, off = wgid / NXCD; wgid = (xcd < r ? xcd * (q + 1) : r * (q + 1) + (xcd - r) * q) + off; }
        const int nig = WGM * nN, gid = wgid / nig, fm = gid * WGM, gsz = (nM - fm) < WGM ? (nM - fm) : WGM;
        const int pm = fm + ((wgid % nig) % gsz); u.pn = (wgid % nig) / gsz;
        if (tpe > 0) { u.e = pm / tpe; u.m0 = (u.e * TPE_FULL + pm % tpe) * BM; } else { u.e = 0; u.m0 = pm * BM; }
        return true;
    }
};
template <class Epi, bool GATHER>
__device__ __forceinline__ void gemm_phase(LAS unsigned char* lds, const GemmD g, const Order& S, const Epi& E) {
    const int tid = tid_l(), wid = __builtin_amdgcn_readfirstlane(tid >> 6), lane = tid & 63, wr = wid >> 2, wc = wid & 3, fr = lane & 15, fq = lane >> 4;
    const int K = g.K, nt = K / BK;
    int Rr[2], Cc[2]; unsigned voffB[2];
#pragma unroll
    for (int i = 0; i < 2; ++i) { int R, C; stage_rc(tid * 16 + i * 8192, R, C); Rr[i] = R; Cc[i] = C; const int Rb = Epi::PERM ? ((R & ~31) + perm32(R & 31)) : R; voffB[i] = (unsigned)(Rb * K + C) * 2u; }
    const unsigned kstep = (unsigned)(BK * 2);
    const size_t hstep = (size_t)HALF * K * 2;
    const unsigned ldsw = (unsigned)wid * 1024u;
    const int aoff = lds_byte(wr * 64 + fr, fq * 8), boff = lds_byte(wc * 32 + fr, fq * 8);
#define PG_SA(b, h) (((b) * 2 + (h)) * HTB)
#define PG_SB(b, h) ((4 + (b) * 2 + (h)) * HTB)
#define PG_STAGE_B(bufoff, gbase) do { _Pragma("unroll") for (int _i = 0; _i < 2; ++_i) \
        __builtin_amdgcn_global_load_lds((const unsigned*)((const char*)(gbase) + voffB[_i]), (LAS unsigned*)(lds + (bufoff) + ldsw + _i * 8192), 16, 0, 0); } while (0)
#define PG_STAGE_A(bufoff, OFFS, h, kb) do { _Pragma("unroll") for (int _i = 0; _i < 2; ++_i) \
        __builtin_amdgcn_global_load_lds((const unsigned*)(g.A + (size_t)(OFFS)[h][_i] + (kb)), (LAS unsigned*)(lds + (bufoff) + ldsw + _i * 8192), 16, 0, 0); } while (0)
#define PG_ROWOFF(DST, U) do { _Pragma("unroll") for (int _h = 0; _h < 2; ++_h) _Pragma("unroll") for (int _i = 0; _i < 2; ++_i) { int _r = (U).m0 + _h * HALF + Rr[_i]; if (GATHER) _r = g.rowidx[_r]; \
        (DST)[_h][_i] = (unsigned)(((size_t)_r * K + Cc[_i]) * 2); } } while (0)
#define PG_LDA(dst, b, h) do { _Pragma("unroll") for (int m = 0; m < 4; ++m) _Pragma("unroll") for (int k = 0; k < 2; ++k) dst[m][k] = *(const LAS bf16x8*)(lds + PG_SA(b, h) + aoff + m * 2048 + k * 1024); } while (0)
#define PG_LDB(dst, b, h) do { _Pragma("unroll") for (int n = 0; n < 2; ++n) _Pragma("unroll") for (int k = 0; k < 2; ++k) dst[n][k] = *(const LAS bf16x8*)(lds + PG_SB(b, h) + boff + n * 2048 + k * 1024); } while (0)
#define PG_MMA(ai, bj, At, Bt) do { __builtin_amdgcn_s_setprio(1); _Pragma("unroll") for (int m = 0; m < 4; ++m) _Pragma("unroll") for (int n = 0; n < 2; ++n) _Pragma("unroll") for (int k = 0; k < 2; ++k) \
        acc[ai][bj][m][n] = __builtin_amdgcn_mfma_f32_16x16x32_bf16(Bt[n][k], At[m][k], acc[ai][bj][m][n], 0, 0, 0); __builtin_amdgcn_s_setprio(0); } while (0)
#define PG_WAIT_V(n) asm volatile("s_waitcnt vmcnt(" #n ")" ::: "memory")
#define PG_WAIT_L(n) asm volatile("s_waitcnt lgkmcnt(" #n ")" ::: "memory")
#define PG_BAR __builtin_amdgcn_s_barrier()
#define PG_SCHED __builtin_amdgcn_sched_barrier(0)
    Unit cur, nxt; int ui = 0;
    if (!S.next(0, cur)) return;
    f32x4 acc[2][2][4][2];
#pragma unroll
    for (int a = 0; a < 2; ++a)
#pragma unroll
        for (int b = 0; b < 2; ++b)
#pragma unroll
            for (int m = 0; m < 4; ++m)
#pragma unroll
                for (int n = 0; n < 2; ++n) acc[a][b][m][n] = (f32x4){0.f, 0.f, 0.f, 0.f};
    bf16x8 At[4][2], B0[2][2], B1[2][2];
    unsigned offA[2][2], offN[2][2];
    PG_ROWOFF(offA, cur);
    if (GATHER) PG_WAIT_V(0);
    const char* cB = g.Bt + (size_t)cur.e * g.bstride + (size_t)cur.pn * BM * K * 2;
    PG_STAGE_B(PG_SB(0, 0), cB); PG_STAGE_B(PG_SB(0, 1), cB + hstep); PG_STAGE_A(PG_SA(0, 0), offA, 0, 0u); PG_STAGE_A(PG_SA(0, 1), offA, 1, 0u);
    if (wr == 1) PG_BAR;
    PG_WAIT_V(2); PG_BAR;
    PG_STAGE_B(PG_SB(1, 0), cB + kstep); PG_STAGE_A(PG_SA(1, 0), offA, 0, kstep); PG_STAGE_B(PG_SB(1, 1), cB + hstep + kstep);
    PG_WAIT_V(6); PG_BAR;
    for (;;) {
        const bool has_next = S.next(ui + 1, nxt);
        const char* nB = has_next ? g.Bt + (size_t)nxt.e * g.bstride + (size_t)nxt.pn * BM * K * 2 : cB;
        if (has_next) { PG_ROWOFF(offN, nxt); if (GATHER) PG_WAIT_V(0); }
        else {
#pragma unroll
            for (int h = 0; h < 2; ++h)
#pragma unroll
                for (int i = 0; i < 2; ++i) offN[h][i] = offA[h][i]; }
        for (int t = 0; t < nt; t += 2) {
            const bool last = (t == nt - 2);
            unsigned o2[2][2];
#pragma unroll
            for (int h = 0; h < 2; ++h)
#pragma unroll
                for (int i = 0; i < 2; ++i) o2[h][i] = last ? offN[h][i] : offA[h][i];
            const unsigned ka1 = (unsigned)(t + 1) * kstep, ka2 = last ? 0u : (unsigned)(t + 2) * kstep, ka3 = ka2 + kstep;
            const char* b2 = last ? nB : cB + (size_t)(t + 2) * kstep; const char* b3 = b2 + kstep;
            PG_LDB(B0, 0, 0); PG_LDB(B1, 0, 1); PG_SCHED; PG_LDA(At, 0, 0); PG_STAGE_A(PG_SA(1, 1), offA, 1, ka1);
            PG_WAIT_V(8); PG_WAIT_L(0); PG_BAR; PG_MMA(0, 0, At, B0); PG_MMA(0, 1, At, B1); PG_BAR; PG_SCHED;
            PG_LDA(At, 0, 1); PG_STAGE_B(PG_SB(0, 0), b2); PG_STAGE_B(PG_SB(0, 1), b2 + hstep); PG_STAGE_A(PG_SA(0, 0), o2, 0, ka2);
            PG_WAIT_V(8); PG_WAIT_L(0); PG_BAR; PG_MMA(1, 0, At, B0); PG_MMA(1, 1, At, B1); PG_BAR; PG_SCHED;
            PG_LDB(B0, 1, 0); PG_LDB(B1, 1, 1); PG_SCHED; PG_LDA(At, 1, 0); PG_STAGE_A(PG_SA(0, 1), o2, 1, ka2);
            PG_WAIT_V(8); PG_WAIT_L(0); PG_BAR; PG_MMA(0, 0, At, B0); PG_MMA(0, 1, At, B1); PG_BAR; PG_SCHED;
            PG_LDA(At, 1, 1); PG_STAGE_B(PG_SB(1, 0), b3); PG_STAGE_B(PG_SB(1, 1), b3 + hstep); PG_STAGE_A(PG_SA(1, 0), o2, 0, ka3);
            PG_WAIT_V(8); PG_WAIT_L(0); PG_BAR; PG_MMA(1, 0, At, B0); PG_MMA(1, 1, At, B1); PG_BAR; PG_SCHED;
        }
        if (wr == 0) PG_BAR;
        E(acc, cur, wr, wc, fr, fq);
        if (!has_next) break;
#pragma unroll
        for (int a = 0; a < 2; ++a)
#pragma unroll
            for (int b = 0; b < 2; ++b)
#pragma unroll
                for (int m = 0; m < 4; ++m)
#pragma unroll
                    for (int n = 0; n < 2; ++n) acc[a][b][m][n] = (f32x4){0.f, 0.f, 0.f, 0.f};
        cur = nxt; cB = nB; ++ui;
#pragma unroll
        for (int h = 0; h < 2; ++h)
#pragma unroll
            for (int i = 0; i < 2; ++i) offA[h][i] = offN[h][i];
        if (wr == 1) PG_BAR;
    }
    PG_WAIT_V(0);
    PG_BAR;
#undef PG_SA
#undef PG_SB
#undef PG_STAGE_A
#undef PG_STAGE_B
#undef PG_ROWOFF
#undef PG_LDA
#undef PG_LDB
#undef PG_MMA
#undef PG_WAIT_V
#undef PG_WAIT_L
#undef PG_BAR
#undef PG_SCHED
}
struct EpiP {
    static constexpr bool PERM = true;
    bf16_t* P; const float* tab;
    __device__ __forceinline__ void operator()(const f32x4 (&acc)[2][2][4][2], const Unit& u, int wr, int wc, int fr, int fq) const {
        const bool lat = u.m0 < RL;
#pragma unroll
        for (int bj = 0; bj < 2; ++bj) {
            const int ct = u.pn * BM + bj * HALF;
            const int c0 = ct + wc * 32 + 8 * fq;
            const int kind = ct < C_VA ? 1 : ((ct >= C_QD && ct < C_VD) ? 2 : 0);
            const float sc = ct < C_KA ? QSCALE_A : ((ct >= C_QD && ct < C_KD) ? QSCALE_D : 1.0f);
#pragma unroll
            for (int ai = 0; ai < 2; ++ai)
#pragma unroll
                for (int m = 0; m < 4; ++m) {
                    const int row = u.m0 + ai * HALF + wr * 64 + m * 16 + fr;
                    f32x4 v0 = acc[ai][bj][m][0], v1 = acc[ai][bj][m][1];
                    if (kind != 0 && lat) {
                        const int pos = row % SEQ, gr = pos / GRID_W, gc = pos % GRID_W; const float* t;
                        if (kind == 1) { const int p = c0 & 63, grp = p >> 5, i0 = (p & 31) >> 1; t = tab + (grp ? T_ACOL + gc * 32 : T_AROW + gr * 32) + i0 * 2; }
                        else { const int p = c0 & 31, grp = p >> 4, i0 = (p & 15) >> 1; t = tab + (grp ? T_DCOL + gc * 16 : T_DROW + gr * 16) + i0 * 2; }
                        const f32x4 t0 = *(const f32x4*)t, t1 = *(const f32x4*)(t + 4);
                        v0 = (f32x4){v0[0] * t0[0] - v0[1] * t0[1], v0[1] * t0[0] + v0[0] * t0[1], v0[2] * t0[2] - v0[3] * t0[3], v0[3] * t0[2] + v0[2] * t0[3]};
                        v1 = (f32x4){v1[0] * t1[0] - v1[1] * t1[1], v1[1] * t1[0] + v1[0] * t1[1], v1[2] * t1[2] - v1[3] * t1[3], v1[3] * t1[2] + v1[2] * t1[3]};
                    }
                    v0 = v0 * sc; v1 = v1 * sc;
                    u32x4 w; w.x = cvt_pk_bf16(v0[0], v0[1]); w.y = cvt_pk_bf16(v0[2], v0[3]); w.z = cvt_pk_bf16(v1[0], v1[1]); w.w = cvt_pk_bf16(v1[2], v1[3]);
                    *(u32x4*)(P + (size_t)row * PROJ + c0) = w;
                }
        }
    }
};
struct EpiX {
    static constexpr bool PERM = true;
    bf16_t* XB; const float* modl; float gscale;
    __device__ __forceinline__ void operator()(const f32x4 (&acc)[2][2][4][2], const Unit& u, int wr, int wc, int fr, int fq) const {
        const int b = u.m0 < RL ? u.m0 / SEQ : NB; const float* g1 = modl + (size_t)b * 6 * D + M_G1 + u.pn * BM + wc * 32 + 8 * fq;
        f32x4 gv[2][2];
#pragma unroll
        for (int bj = 0; bj < 2; ++bj)
#pragma unroll
            for (int n = 0; n < 2; ++n) gv[bj][n] = *(const f32x4*)(g1 + bj * HALF + 4 * n) * gscale;
#pragma unroll
        for (int ai = 0; ai < 2; ++ai)
#pragma unroll
            for (int m = 0; m < 4; ++m) {
                const int row = u.m0 + ai * HALF + wr * 64 + m * 16 + fr; bf16_t* xr = XB + (size_t)row * D + u.pn * BM + wc * 32 + 8 * fq;
#pragma unroll
                for (int bj = 0; bj < 2; ++bj) { const u32x4 xv = *(const u32x4*)(xr + bj * HALF);
                    const f32x4 a0 = acc[ai][bj][m][0] * gv[bj][0], a1 = acc[ai][bj][m][1] * gv[bj][1]; u32x4 w;
                    w.x = cvt_pk_bf16(__builtin_bit_cast(float, xv.x << 16) + a0[0], __builtin_bit_cast(float, xv.x & 0xffff0000u) + a0[1]);
                    w.y = cvt_pk_bf16(__builtin_bit_cast(float, xv.y << 16) + a0[2], __builtin_bit_cast(float, xv.y & 0xffff0000u) + a0[3]);
                    w.z = cvt_pk_bf16(__builtin_bit_cast(float, xv.z << 16) + a1[0], __builtin_bit_cast(float, xv.z & 0xffff0000u) + a1[1]);
                    w.w = cvt_pk_bf16(__builtin_bit_cast(float, xv.w << 16) + a1[2], __builtin_bit_cast(float, xv.w & 0xffff0000u) + a1[3]);
                    *(u32x4*)(xr + bj * HALF) = w; }
                if (m & 1) asm volatile("" ::: "memory");
            }
    }
};
__device__ __forceinline__ float silu_fast(float v) { return v * __builtin_amdgcn_rcpf(1.0f + __builtin_amdgcn_exp2f(-LOG2E * v)); }
struct EpiH {
    static constexpr bool PERM = true;
    bf16_t* H;
    __device__ __forceinline__ void operator()(const f32x4 (&acc)[2][2][4][2], const Unit& u, int wr, int wc, int fr, int fq) const {
        const int hc = u.pn * HALF + wc * 32 + 8 * fq;
#pragma unroll
        for (int ai = 0; ai < 2; ++ai)
#pragma unroll
            for (int m = 0; m < 4; ++m) {
                const int row = u.m0 + ai * HALF + wr * 64 + m * 16 + fr;
                const f32x4 g0 = acc[ai][0][m][0], g1 = acc[ai][0][m][1], u0 = acc[ai][1][m][0], u1 = acc[ai][1][m][1];
                u32x4 w;
                w.x = cvt_pk_bf16(silu_fast(g0[0]) * u0[0], silu_fast(g0[1]) * u0[1]); w.y = cvt_pk_bf16(silu_fast(g0[2]) * u0[2], silu_fast(g0[3]) * u0[3]);
                w.z = cvt_pk_bf16(silu_fast(g1[0]) * u1[0], silu_fast(g1[1]) * u1[1]); w.w = cvt_pk_bf16(silu_fast(g1[2]) * u1[2], silu_fast(g1[3]) * u1[3]);
                *(u32x4*)(H + (size_t)row * FF + hc) = w;
            }
    }
};
struct EpiY {
    static constexpr bool PERM = true;
    bf16_t* Y; const float* gate;
    __device__ __forceinline__ void operator()(const f32x4 (&acc)[2][2][4][2], const Unit& u, int wr, int wc, int fr, int fq) const {
#pragma unroll
        for (int ai = 0; ai < 2; ++ai)
#pragma unroll
            for (int m = 0; m < 4; ++m) {
                const int row = u.m0 + ai * HALF + wr * 64 + m * 16 + fr; const float gt = gate[row];
#pragma unroll
                for (int bj = 0; bj < 2; ++bj) {
                    const f32x4 v0 = acc[ai][bj][m][0] * gt, v1 = acc[ai][bj][m][1] * gt;
                    u32x4 w; w.x = cvt_pk_bf16(v0[0], v0[1]); w.y = cvt_pk_bf16(v0[2], v0[3]); w.z = cvt_pk_bf16(v1[0], v1[1]); w.w = cvt_pk_bf16(v1[2], v1[3]);
                    *(u32x4*)(Y + (size_t)row * D + u.pn * BM + bj * HALF + wc * 32 + 8 * fq) = w;
                }
            }
    }
};
}

struct Args { const float* in[19]; float* out; unsigned char* ws; int ph_lo, ph_hi; };
struct Ctx {
    Ptrs p; LAS unsigned char* lds;
    float *tab, *mod, *aff, *gate, *xc, *xl; int *sel, *tokslot;
    bf16_t *win, *wout, *P, *H, *Y, *MIX, *HX2, *HX, *XB; float* TMP;
};
template <class Dest>
__device__ __forceinline__ void transpose_item(const float* W, int K, int N, bf16_t* WT, LAS float* scr, int item, int lane, Dest dest) {
    const int nblk = N / 32, kb = item / nblk, nb = item % nblk, k0 = 64 * kb, n0 = 32 * nb;
#pragma unroll 8
    for (int i = 0; i < 32; ++i) { const int kk = 2 * i + (lane >> 5); scr[kk * 33 + (lane & 31)] = W[(size_t)(k0 + kk) * N + n0 + (lane & 31)]; }
    LDS_WAIT(); asm volatile("" ::: "memory");
    const int c = lane & 7;
#pragma unroll
    for (int j = 0; j < 4; ++j) { const int n = (lane >> 3) + 8 * j; const LAS float* s = scr + (8 * c) * 33 + n;
        u32x4 o; o.x = cvt_pk_bf16(s[0 * 33], s[1 * 33]); o.y = cvt_pk_bf16(s[2 * 33], s[3 * 33]); o.z = cvt_pk_bf16(s[4 * 33], s[5 * 33]); o.w = cvt_pk_bf16(s[6 * 33], s[7 * 33]);
        *(u32x4*)(WT + (size_t)dest(n0 + n) * K + k0 + 8 * c) = o; }
    LDS_WAIT(); asm volatile("" ::: "memory");
}
HD int invA(int q) { const int g = q / 32, r = q % 32; return 32 * g + (r < 16 ? 2 * r : 2 * (r - 16) + 1); }
HD int invD(int q) { const int g = q / 16, r = q % 16; return 16 * g + (r < 8 ? 2 * r : 2 * (r - 8) + 1); }
HD int inproj_dst_row(int nl) {
    if (nl < C_VA) return (nl / 64) * 64 + invA(nl % 64);
    if (nl >= C_QD && nl < C_VD) return (nl / 32) * 32 + invD(nl % 32);
    return nl;
}
struct DestIn { __device__ int operator()(int n) const { return inproj_dst_row(n); } };
struct DestId { __device__ int operator()(int n) const { return n; } };
struct DestGU { int up; __device__ int operator()(int n) const { return (n / 128) * 256 + up * 128 + n % 128; } };

__device__ __forceinline__ void phase_prologue(const Ctx& C) {
    const int tid = tid_l(), lane = tid & 63, wave = __builtin_amdgcn_readfirstlane(tid >> 6), gw = blockIdx.x * NWV + wave, NGW = gridDim.x * NWV; (void)lane; (void)gw; (void)NGW;
    for (long g = (long)blockIdx.x * NT + tid; g < (long)(NROWS + 64) * 24; g += (long)gridDim.x * NT) {
        const int pos = (int)(g / 24), f = (int)(g % 24);
        const double inv = f < 16 ? pow(10000.0, -(2.0 * f) / 32.0) : pow(10000.0, -(2.0 * (f - 16)) / 16.0);
        const bool isrow = pos < NROWS; const int p = isrow ? pos : pos - NROWS;
        const double ang = (double)p * inv; const float cs = (float)cos(ang), sn = (float)sin(ang);
        const int idx = f < 16 ? (isrow ? T_AROW : T_ACOL) + (p * 16 + f) * 2 : (isrow ? T_DROW : T_DCOL) + (p * 8 + (f - 16)) * 2;
        C.tab[idx] = cs; C.tab[idx + 1] = sn;
    }
    LAS float* sl = (LAS float*)C.lds;
    for (int i = tid; i < (NB + 1) * D; i += NT) { const int b = i / D, k = i % D; sl[i] = silu_f(b < NB ? C.p.c[b * D + k] : C.p.c_ctx[k]); }
    __syncthreads();
    constexpr int NBR = NB + 1, BG = 11, NBG = NBR / BG; static_assert(NBG * BG == NBR, "adaLN rows reduced in groups of 11");
    LAS float* pbuf = (LAS float*)(C.lds + NBR * D * 4);
    static_assert(NBR * D * 4 + 16 * BG * 32 * 4 <= LDS_MISC, "prologue LDS");
    for (int task = blockIdx.x; task < DEPTH * 6 * D / 32; task += gridDim.x) {
        const int jg = task * 32, l = jg / (6 * D), j0 = jg % (6 * D), c = lane & 31, half = lane >> 5, kb = 128 * wave + 64 * half;
        float acc[NBR];
#pragma unroll
        for (int b = 0; b < NBR; ++b) acc[b] = 0.f;
        const float* w = C.p.w_ada + ((size_t)l * D + kb) * 6 * D + j0 + c; const LAS float* s0 = sl + kb;
        for (int kk = 0; kk < 64; kk += 4) {
            const float w0 = w[(size_t)kk * 6 * D], w1 = w[(size_t)(kk + 1) * 6 * D], w2 = w[(size_t)(kk + 2) * 6 * D], w3 = w[(size_t)(kk + 3) * 6 * D];
#pragma unroll
            for (int rr = 0; rr < NBG; ++rr) { f32x4 sv[BG]; const unsigned sa = (unsigned)(size_t)(s0 + rr * BG * D + kk);
                LDS_RD11_B128(sv, sa, D * 4);
#pragma unroll
                for (int bb = 0; bb < BG; ++bb) acc[rr * BG + bb] += (sv[bb][0] * w0 + sv[bb][1] * w1) + (sv[bb][2] * w2 + sv[bb][3] * w3); }
        }
#pragma unroll
        for (int rr = 0; rr < NBG; ++rr) {
#pragma unroll
            for (int bb = 0; bb < BG; ++bb) pbuf[((wave * 2 + half) * BG + bb) * 32 + c] = acc[rr * BG + bb];
            __syncthreads();
            if (tid < BG * 32) { const int bb = tid / 32, cc = tid % 32; float s = 0.f;
#pragma unroll
                for (int p = 0; p < 16; ++p) s += pbuf[(p * BG + bb) * 32 + cc];
                C.mod[((size_t)l * NBR + rr * BG + bb) * 6 * D + j0 + cc] = s + C.p.b_ada[l * 6 * D + j0 + cc]; }
            __syncthreads();
        }
    }
    __syncthreads();
    LAS float* scr = (LAS float*)(C.lds + wave * 16384);
    constexpr int I_IN = (D / 64) * (PROJ / 32), I_OUT = (D / 64) * (D / 32);
    for (int it = gw; it < DEPTH * (I_IN + I_OUT); it += NGW) {
        const int l = it / (I_IN + I_OUT), r = it % (I_IN + I_OUT);
        if (r < I_IN) transpose_item(C.p.w_in + (size_t)l * D * PROJ, D, PROJ, C.win + (size_t)l * PROJ * D, scr, r, lane, DestIn{});
        else transpose_item(C.p.w_out + (size_t)l * D * D, D, D, C.wout + (size_t)l * D * D, scr, r - I_IN, lane, DestId{});
    }
    __syncthreads();
}
__device__ __forceinline__ void phase_cvt_experts(const Ctx& C, int l) {
    const int tid = tid_l(), lane = tid & 63, wave = __builtin_amdgcn_readfirstlane(tid >> 6), gw = blockIdx.x * NWV + wave, NGW = gridDim.x * NWV; (void)lane; (void)gw; (void)NGW;
    LAS float* scr = (LAS float*)(C.lds + wave * 16384);
    bf16_t* wgu = (bf16_t*)(C.p.ws + WS_WGU) + (size_t)(l & 1) * NE * 2 * FF * D; bf16_t* wd = (bf16_t*)(C.p.ws + WS_WD) + (size_t)(l & 1) * NE * D * FF;
    constexpr int I_E = (D / 64) * (FF / 32);
    for (int it = gw; it < 3 * NE * I_E; it += NGW) {
        const int mat = it / (NE * I_E), e = (it / I_E) % NE, r = it % I_E;
        const size_t wo = ((size_t)l * NE + e) * D * FF;
        if (mat == 0) transpose_item(C.p.w_gate + wo, D, FF, wgu + (size_t)e * 2 * FF * D, scr, r, lane, DestGU{0});
        else if (mat == 1) transpose_item(C.p.w_up + wo, D, FF, wgu + (size_t)e * 2 * FF * D, scr, r, lane, DestGU{1});
        else transpose_item(C.p.w_down + wo, FF, D, wd + (size_t)e * D * FF, scr, r, lane, DestId{});
    }
    __syncthreads();
}
__device__ __forceinline__ void ybf_add(f32x4& a, const u32x2 w) {
    a[0] += __builtin_bit_cast(float, w.x << 16); a[1] += __builtin_bit_cast(float, w.x & 0xffff0000u); a[2] += __builtin_bit_cast(float, w.y << 16); a[3] += __builtin_bit_cast(float, w.y & 0xffff0000u);
}
template <bool FINAL, bool SRCF32>
__device__ __forceinline__ void phase_rowA(const Ctx& C, int l, float gscale = 1.0f) {
    const int tid = tid_l(), lane = tid & 63, wave = __builtin_amdgcn_readfirstlane(tid >> 6), gw = blockIdx.x * NWV + wave, NGW = gridDim.x * NWV;
    const int nrows = FINAL ? RL : RALL;
    const int per = (nrows + NGW - 1) / NGW, r0 = gw * per, r1 = (r0 + per < nrows) ? r0 + per : nrows;
#define RA_LOADX(dst, row) do { if (SRCF32) { const float* _s = ((row) < RL ? C.p.x + (size_t)(row) * D : C.p.ctx + (size_t)((row) - RL) * D); _Pragma("unroll") for (int j = 0; j < 4; ++j) dst[j] = __builtin_bit_cast(u32x4, *(const f32x4*)(_s + 4 * lane + 256 * j)); } \
        else { const bf16_t* _s = C.XB + (size_t)(row) * D + 4 * lane; _Pragma("unroll") for (int j = 0; j < 4; ++j) { const u32x2 _w = *(const u32x2*)(_s + 256 * j); dst[j] = (u32x4){_w.x, _w.y, 0u, 0u}; } } } while (0)
#define RA_LOADTS(dst, row) do { dst = (l > 0 && lane < NE) ? C.tokslot[(size_t)(row) * NE + lane] : -1; } while (0)
#define RA_ISSUEY(YY, WF, MSK, ts) do { unsigned _m = (unsigned)__ballot((ts) >= 0); int _s0 = 0, _s1, _s2, _s3; WF[0] = WF[1] = WF[2] = WF[3] = 0.f; \
        if (_m) { _s0 = __builtin_amdgcn_readlane((ts), __builtin_ctz(_m)); _m &= _m - 1; WF[0] = 1.f; } _s1 = _s2 = _s3 = _s0; \
        if (_m) { _s1 = __builtin_amdgcn_readlane((ts), __builtin_ctz(_m)); _m &= _m - 1; WF[1] = 1.f; } \
        if (_m) { _s2 = __builtin_amdgcn_readlane((ts), __builtin_ctz(_m)); _m &= _m - 1; WF[2] = 1.f; } \
        if (_m) { _s3 = __builtin_amdgcn_readlane((ts), __builtin_ctz(_m)); _m &= _m - 1; WF[3] = 1.f; } MSK = _m; \
        _Pragma("unroll") for (int j = 0; j < 4; ++j) { YY[0][j] = *(const u32x2*)(C.Y + (size_t)_s0 * D + 4 * lane + 256 * j); YY[1][j] = *(const u32x2*)(C.Y + (size_t)_s1 * D + 4 * lane + 256 * j); \
            YY[2][j] = *(const u32x2*)(C.Y + (size_t)_s2 * D + 4 * lane + 256 * j); YY[3][j] = *(const u32x2*)(C.Y + (size_t)_s3 * D + 4 * lane + 256 * j); } } while (0)
    u32x4 xc[4], xn[4], x2[4]; int tsc = -1, tsn = -1, ts2 = -1; u32x2 yc[4][4], yn[4][4]; float wc_[4], wn_[4]; unsigned mc = 0u, mn = 0u;
    f32x4 A[4], S[4], G[4]; int bcur = -1;
#pragma unroll
    for (int j = 0; j < 4; ++j) { xc[j] = xn[j] = x2[j] = (u32x4){0u, 0u, 0u, 0u}; A[j] = S[j] = G[j] = (f32x4){0.f, 0.f, 0.f, 0.f}; }
#pragma unroll
    for (int i = 0; i < 4; ++i) { wc_[i] = wn_[i] = 0.f;
#pragma unroll
        for (int j = 0; j < 4; ++j) yc[i][j] = yn[i][j] = (u32x2){0u, 0u}; }
    if (r0 < r1) { RA_LOADTS(tsc, r0); RA_LOADX(xc, r0); if (l > 0) RA_ISSUEY(yc, wc_, mc, tsc); }
    if (r0 + 1 < r1) { RA_LOADTS(tsn, r0 + 1); RA_LOADX(xn, r0 + 1); }
    for (int row = r0; row < r1; ++row) {
        if (l > 0 && row + 1 < r1) RA_ISSUEY(yn, wn_, mn, tsn);
        if (row + 2 < r1) { RA_LOADTS(ts2, row + 2); RA_LOADX(x2, row + 2); }
        const int b = row_batch(row);
        if (b != bcur) { bcur = b;
            if (FINAL) {
#pragma unroll
                for (int j = 0; j < 4; ++j) A[j] = *(const f32x4*)(C.p.norm_final + 4 * lane + 256 * j);
            } else { const float* m = C.mod + ((size_t)l * (NB + 1) + b) * 6 * D + 4 * lane; const float* nw = C.p.norm1 + (size_t)l * D + 4 * lane;
#pragma unroll
                for (int j = 0; j < 4; ++j) { A[j] = *(const f32x4*)(nw + 256 * j) * (*(const f32x4*)(m + M_SC1 + 256 * j) + 1.0f); S[j] = *(const f32x4*)(m + M_SH1 + 256 * j); } }
            if (l > 0) { const float* g2 = C.mod + ((size_t)(l - 1) * (NB + 1) + b) * 6 * D + M_G2 + 4 * lane;
#pragma unroll
                for (int j = 0; j < 4; ++j) G[j] = *(const f32x4*)(g2 + 256 * j) * gscale; } }
        f32x4 v[4];
#pragma unroll
        for (int j = 0; j < 4; ++j) { if (SRCF32) v[j] = __builtin_bit_cast(f32x4, xc[j]); else { const unsigned w0 = xc[j][0], w1 = xc[j][1];
            v[j] = (f32x4){__builtin_bit_cast(float, w0 << 16), __builtin_bit_cast(float, w0 & 0xffff0000u), __builtin_bit_cast(float, w1 << 16), __builtin_bit_cast(float, w1 & 0xffff0000u)}; } }
        if (l > 0) {
            f32x4 a[4];
#pragma unroll
            for (int j = 0; j < 4; ++j) { a[j] = (f32x4){0.f, 0.f, 0.f, 0.f};
#pragma unroll
                for (int i = 0; i < 4; ++i) { const u32x2 w = yc[i][j]; const float wf = wc_[i];
                    a[j][0] += wf * __builtin_bit_cast(float, w.x << 16); a[j][1] += wf * __builtin_bit_cast(float, w.x & 0xffff0000u); a[j][2] += wf * __builtin_bit_cast(float, w.y << 16); a[j][3] += wf * __builtin_bit_cast(float, w.y & 0xffff0000u); } }
            while (mc) { const int s = __builtin_amdgcn_readlane(tsc, __builtin_ctz(mc)); mc &= mc - 1;
#pragma unroll
                for (int j = 0; j < 4; ++j) ybf_add(a[j], *(const u32x2*)(C.Y + (size_t)s * D + 4 * lane + 256 * j)); }
#pragma unroll
            for (int j = 0; j < 4; ++j) v[j] = v[j] + G[j] * a[j];
        }
        float ss = 0.f;
#pragma unroll
        for (int j = 0; j < 4; ++j) ss += (v[j][0] * v[j][0] + v[j][1] * v[j][1]) + (v[j][2] * v[j][2] + v[j][3] * v[j][3]);
        const float rstd = 1.0f / sqrtf(wave_sum(ss) * (1.0f / D) + EPS);
        if (FINAL) {
            float* dst = C.p.out + (size_t)row * D;
#pragma unroll
            for (int j = 0; j < 4; ++j) *(f32x4*)(dst + 4 * lane + 256 * j) = v[j] * rstd * A[j];
        } else {
            bf16_t* xo = C.XB + (size_t)row * D + 4 * lane;
#pragma unroll
            for (int j = 0; j < 4; ++j) { u32x2 w; w.x = cvt_pk_bf16(v[j][0], v[j][1]); w.y = cvt_pk_bf16(v[j][2], v[j][3]); *(u32x2*)(xo + 256 * j) = w; }
            bf16_t* hr = C.HX + (size_t)row * D + 4 * lane;
#pragma unroll
            for (int j = 0; j < 4; ++j) { const f32x4 h = v[j] * rstd * A[j] + S[j]; u32x2 w; w.x = cvt_pk_bf16(h[0], h[1]); w.y = cvt_pk_bf16(h[2], h[3]); *(u32x2*)(hr + 256 * j) = w; }
        }
        tsc = tsn; tsn = ts2; mc = mn;
#pragma unroll
        for (int j = 0; j < 4; ++j) { xc[j] = xn[j]; xn[j] = x2[j]; }
#pragma unroll
        for (int i = 0; i < 4; ++i) { wc_[i] = wn_[i];
#pragma unroll
            for (int j = 0; j < 4; ++j) yc[i][j] = yn[i][j]; }
    }
#undef RA_LOADX
#undef RA_LOADTS
#undef RA_ISSUEY
}
__device__ __forceinline__ void phase_rowB(const Ctx& C, int l, int nq) {
    const int tid = tid_l(), lane = tid & 63, wave = __builtin_amdgcn_readfirstlane(tid >> 6), gw = blockIdx.x * NWV + wave, NGW = gridDim.x * NWV;
    LAS float* R = (LAS float*)C.lds;
    const float* rt = C.p.router + (size_t)l * D * NE;
    for (int i = tid; i < D * NE; i += NT) R[(i % NE) * D + i / NE] = rt[i];
    __syncthreads();
    const int per = (nq + NGW - 1) / NGW, r0 = gw * per, r1 = (r0 + per < nq) ? r0 + per : nq;
    f32x4 xn[4], A[4], S[4]; int bcur = -1; int row = r0;
    u32x2 xr_[4];
    if (row < r1) { const bf16_t* s = C.XB + (size_t)row * D + 4 * lane;
#pragma unroll
        for (int j = 0; j < 4; ++j) xr_[j] = *(const u32x2*)(s + 256 * j); }
    for (; row < r1; ++row) {
        f32x4 v[4]; float ss = 0.f;
#pragma unroll
        for (int j = 0; j < 4; ++j) xn[j] = (f32x4){__builtin_bit_cast(float, xr_[j].x << 16), __builtin_bit_cast(float, xr_[j].x & 0xffff0000u), __builtin_bit_cast(float, xr_[j].y << 16), __builtin_bit_cast(float, xr_[j].y & 0xffff0000u)};
        const int b = row_batch(row);
        if (b != bcur) { bcur = b; const float* m = C.mod + ((size_t)l * (NB + 1) + b) * 6 * D + 4 * lane; const float* nw = C.p.norm2 + (size_t)l * D + 4 * lane;
#pragma unroll
            for (int j = 0; j < 4; ++j) { A[j] = *(const f32x4*)(nw + 256 * j) * (*(const f32x4*)(m + M_SC2 + 256 * j) + 1.0f); S[j] = *(const f32x4*)(m + M_SH2 + 256 * j); } }
#pragma unroll
        for (int j = 0; j < 4; ++j) { v[j] = xn[j]; ss += (v[j][0] * v[j][0] + v[j][1] * v[j][1]) + (v[j][2] * v[j][2] + v[j][3] * v[j][3]); }
        if (row + 1 < r1) { const bf16_t* s = C.XB + (size_t)(row + 1) * D + 4 * lane;
#pragma unroll
            for (int j = 0; j < 4; ++j) xr_[j] = *(const u32x2*)(s + 256 * j); }
        const float rstd = 1.0f / sqrtf(wave_sum(ss) * (1.0f / D) + EPS);
        bf16_t* hr = C.HX2 + (size_t)row * D + 4 * lane;
#pragma unroll
        for (int j = 0; j < 4; ++j) { v[j] = v[j] * rstd * A[j] + S[j];
            u32x2 w; w.x = cvt_pk_bf16(v[j][0], v[j][1]); w.y = cvt_pk_bf16(v[j][2], v[j][3]); *(u32x2*)(hr + 256 * j) = w; }
        float p[NE];
#pragma unroll
        for (int e = 0; e < NE; ++e) p[e] = 0.f;
#pragma unroll
        for (int j = 0; j < 4; ++j) { f32x4 r4[NE]; const unsigned ra = (unsigned)(size_t)(R + 4 * lane + 256 * j);
            LDS_RD16_B128(r4, ra, D * 4);
#pragma unroll
            for (int e = 0; e < NE; ++e) p[e] += (v[j][0] * r4[e][0] + v[j][1] * r4[e][1]) + (v[j][2] * r4[e][2] + v[j][3] * r4[e][3]); }
#pragma unroll
        for (int j = 0; j < 8; ++j) { const bool up = (lane & 32) != 0; const float keep = up ? p[j + 8] : p[j], send = up ? p[j] : p[j + 8]; p[j] = keep + __shfl_xor(send, 32); }
#pragma unroll
        for (int j = 0; j < 4; ++j) { const bool up = (lane & 16) != 0; const float keep = up ? p[j + 4] : p[j], send = up ? p[j] : p[j + 4]; p[j] = keep + __shfl_xor(send, 16); }
#pragma unroll
        for (int j = 0; j < 2; ++j) { const bool up = (lane & 8) != 0; const float keep = up ? p[j + 2] : p[j], send = up ? p[j] : p[j + 2]; p[j] = keep + __shfl_xor(send, 8); }
        float lg; { const bool up = (lane & 4) != 0; const float keep = up ? p[1] : p[0], send = up ? p[0] : p[1]; lg = keep + __shfl_xor(send, 4); }
        lg += __shfl_xor(lg, 2); lg += __shfl_xor(lg, 1);
        float mx = lg;
#pragma unroll
        for (int o = 4; o < 64; o <<= 1) mx = fmaxf(mx, __shfl_xor(mx, o));
        const float ex = expf(lg - mx); float se = ex;
#pragma unroll
        for (int o = 4; o < 64; o <<= 1) se += __shfl_xor(se, o);
        const int e = ((lane >> 5) & 1) * 8 + ((lane >> 4) & 1) * 4 + ((lane >> 3) & 1) * 2 + ((lane >> 2) & 1);
        if ((lane & 3) == 0) C.aff[(size_t)row * NE + e] = ex / se;
    }
    __syncthreads();
}
template <int NV>
__device__ __forceinline__ void select_task(const Ctx& C, int base_row, int cap, int e, int slot0, int lane) {
    unsigned v[NV];
#pragma unroll
    for (int i = 0; i < NV; ++i) v[i] = __builtin_bit_cast(unsigned, C.aff[(size_t)(base_row + i * 64 + lane) * NE + e]);
    unsigned T = 0u;
    for (int bit = 30; bit >= 0; --bit) { const unsigned cand = T | (1u << bit); int cnt = 0;
#pragma unroll
        for (int i = 0; i < NV; ++i) cnt += __builtin_popcountll(__ballot(v[i] >= cand));
        if (cnt >= cap) T = cand; }
    int ngt = 0;
#pragma unroll
    for (int i = 0; i < NV; ++i) ngt += __builtin_popcountll(__ballot(v[i] > T));
    const int need = cap - ngt;
    const unsigned long long lt = (1ull << lane) - 1ull; int nsel = 0, neq = 0;
#pragma unroll
    for (int i = 0; i < NV; ++i) {
        const bool gt = v[i] > T, eq = v[i] == T; const unsigned long long meq = __ballot(eq);
        const bool take = gt || (eq && (neq + __builtin_popcountll(meq & lt)) < need);
        const unsigned long long msel = __ballot(take);
        const int row = base_row + i * 64 + lane; int slot = -1;
        if (take) { slot = slot0 + nsel + __builtin_popcountll(msel & lt); C.sel[slot] = row; C.gate[slot] = __builtin_bit_cast(float, v[i]); }
        C.tokslot[(size_t)row * NE + e] = slot;
        nsel += __builtin_popcountll(msel); neq += __builtin_popcountll(meq);
    }
}
__device__ __forceinline__ void phase_select(const Ctx& C, bool need_ctx) {
    const int tid = tid_l(), lane = tid & 63, wave = __builtin_amdgcn_readfirstlane(tid >> 6), gw = blockIdx.x * NWV + wave, NGW = gridDim.x * NWV; (void)lane; (void)gw; (void)NGW;
    const int ntask = NB * NE * (need_ctx ? 2 : 1);
    for (int task = gw; task < ntask; task += NGW) {
        const int set = task / (NB * NE), b = (task / NE) % NB, e = task % NE;
        if (set == 0) select_task<SEQ / 64>(C, b * SEQ, CAPL, e, e * SLOTS_E + b * CAPL, lane);
        else select_task<CTX / 64>(C, RL + b * CTX, CAPC, e, e * SLOTS_E + SLOTS_L + b * CAPC, lane);
    }
}
namespace att {
typedef float f32x16 __attribute__((ext_vector_type(16)));
typedef short v4i16_t __attribute__((ext_vector_type(4)));
typedef __bf16 bf16x2_t __attribute__((ext_vector_type(2)));
constexpr int KSTR = 144, TILE_B = 64 * KSTR, BUF_B = 2 * TILE_B;
constexpr float THR = 8.0f;
__device__ __forceinline__ unsigned pk2(float a, float b) { bf16x2_t v = {(__bf16)a, (__bf16)b}; return __builtin_bit_cast(unsigned, v); }
__device__ __forceinline__ float xmax32(float x) { auto rr = __builtin_amdgcn_permlane32_swap(__float_as_uint(x), __float_as_uint(x), false, false); return fmaxf(__uint_as_float(rr[0]), __uint_as_float(rr[1])); }
__device__ __forceinline__ float xsum32(float x) { auto rr = __builtin_amdgcn_permlane32_swap(__float_as_uint(x), __float_as_uint(x), false, false); return __uint_as_float(rr[0]) + __uint_as_float(rr[1]); }
__device__ __forceinline__ int crow(int reg, int h) { return (reg & 3) + 8 * (reg >> 2) + 4 * h; }
#define MFMA32(a, b, c) __builtin_amdgcn_mfma_f32_32x32x16_bf16((a), (b), (c), 0, 0, 0)

template <int NSUB, int DKS>
__device__ __forceinline__ void flash_tile(const LAS unsigned char* kb_, const LAS unsigned char* vb_, const bf16x8 (&Q)[NSUB][DKS], f32x16 (&O)[NSUB][2], float (&m)[NSUB], float (&l)[NSUB],
                                           int lane, bool masked, int dq) {
    const int r = lane & 31, h = lane >> 5;
    bf16x8 Pf[NSUB][4];
#pragma unroll
    for (int sub = 0; sub < NSUB; ++sub) {
        f32x16 S[2];
#pragma unroll
        for (int kb = 0; kb < 2; ++kb) {
#pragma unroll
            for (int i = 0; i < 16; ++i) S[kb][i] = 0.f;
#pragma unroll
            for (int s = 0; s < DKS; ++s) { const bf16x8 kf = *(const LAS bf16x8*)(kb_ + (32 * kb + r) * KSTR + (sub * DKS * 16 + 16 * s + 8 * h) * 2); S[kb] = MFMA32(kf, Q[sub][s], S[kb]); }
        }
        if (masked) {
#pragma unroll
            for (int kb = 0; kb < 2; ++kb)
#pragma unroll
                for (int i = 0; i < 16; ++i) { const int dl = dq - (32 * kb + crow(i, h)); S[kb][i] = (dl > WINDOW || dl < -WINDOW) ? -1e30f : S[kb][i]; }
        }
        float mx = S[0][0];
#pragma unroll
        for (int i = 1; i < 16; ++i) mx = fmaxf(mx, S[0][i]);
#pragma unroll
        for (int i = 0; i < 16; ++i) mx = fmaxf(mx, S[1][i]);
        mx = xmax32(mx);
        if (!__all(mx <= m[sub] + THR)) {
            const float mn = fmaxf(m[sub], mx), alpha = __builtin_amdgcn_exp2f(m[sub] - mn); m[sub] = mn; l[sub] *= alpha;
#pragma unroll
            for (int db = 0; db < 2; ++db)
#pragma unroll
                for (int i = 0; i < 16; ++i) O[sub][db][i] *= alpha;
        }
        const float mm = m[sub]; float ls = 0.f;
#pragma unroll
        for (int kb = 0; kb < 2; ++kb)
#pragma unroll
            for (int i = 0; i < 16; ++i) { S[kb][i] = __builtin_amdgcn_exp2f(S[kb][i] - mm); ls += S[kb][i]; }
        l[sub] += ls;
#pragma unroll
        for (int kb = 0; kb < 2; ++kb)
#pragma unroll
            for (int s = 0; s < 2; ++s) { u32x4 w; w.x = pk2(S[kb][8 * s + 0], S[kb][8 * s + 1]); w.y = pk2(S[kb][8 * s + 2], S[kb][8 * s + 3]); w.z = pk2(S[kb][8 * s + 4], S[kb][8 * s + 5]); w.w = pk2(S[kb][8 * s + 6], S[kb][8 * s + 7]);
                Pf[sub][2 * kb + s] = __builtin_bit_cast(bf16x8, w); }
    }
    const int i16 = lane & 15, q = i16 >> 2, p = i16 & 3, rblk = (lane >> 4) & 1;
    const LAS unsigned char* vbase = vb_ + (4 * h + q) * KSTR + (16 * rblk + 4 * p) * 2;
#pragma unroll
    for (int ks = 0; ks < 4; ++ks)
#pragma unroll
        for (int db = 0; db < 2; ++db) {
            const v4i16_t lo = __builtin_amdgcn_ds_read_tr16_b64_v4i16((LAS v4i16_t*)(vbase + (16 * ks) * KSTR + 64 * db));
            const v4i16_t hi = __builtin_amdgcn_ds_read_tr16_b64_v4i16((LAS v4i16_t*)(vbase + (16 * ks + 8) * KSTR + 64 * db));
            const bf16x8 vf = __builtin_shufflevector(lo, hi, 0, 1, 2, 3, 4, 5, 6, 7);
#pragma unroll
            for (int sub = 0; sub < NSUB; ++sub) O[sub][db] = MFMA32(vf, Pf[sub][ks], O[sub][db]);
        }
}
#define ATT_STG_LOAD(krow0) do { const bf16_t* _p = C.P + (size_t)((krow0) + skey) * PROJ + 8 * schunk; kreg = *(const u32x4*)(_p + kcol); vreg = *(const u32x4*)(_p + vcol); } while (0)
#define ATT_STG_STORE(buf) do { LAS unsigned char* _d = C.lds + (buf) * BUF_B + skey * KSTR + schunk * 16; *(LAS u32x4*)_d = kreg; *(LAS u32x4*)(_d + TILE_B) = vreg; } while (0)

__device__ __forceinline__ void phase_attnA(const Ctx& C, int l, bool need_ctx) {
    const int tid = tid_l(), lane = tid & 63, wave = __builtin_amdgcn_readfirstlane(tid >> 6), skey = tid >> 3, schunk = tid & 7;
    const int r = lane & 31, h = lane >> 5, hq = wave & 3, ph = wave >> 2;
    constexpr int NUL = NB * NKVA * (SEQ / 64), NUC = NB * NKVA * (CTX / 64);
    const int nu = NUL + (need_ctx ? NUC : 0);
    for (int u = blockIdx.x; u < nu; u += gridDim.x) {
        const bool lat = u < NUL; const int uu = lat ? u : u - NUL; const int nqb = lat ? SEQ / 64 : CTX / 64;
        const int b = uu / (NKVA * nqb), kvh = (uu / nqb) % NKVA, qb = uu % nqb, head = kvh * GQA + hq;
        const int kcol = C_KA + kvh * HDIM, vcol = C_VA + kvh * HDIM;
        const int q0 = 64 * qb + 32 * ph;
        const int qrow = (lat ? b * SEQ : RL + b * CTX) + q0 + r;
        const int jlo = lat ? (2 - qb > 0 ? 2 - qb : 0) : 0, jhi = lat ? (33 - qb < 4 ? 33 - qb : 4) : -1;
        const int nt = CTX / 64 + (jhi - jlo + 1);
        bf16x8 Q[1][4];
#pragma unroll
        for (int s = 0; s < 4; ++s) Q[0][s] = *(const bf16x8*)(C.P + (size_t)qrow * PROJ + C_QA + head * HDIM + 16 * s + 8 * h);
        f32x16 O[1][2]; float m[1], ls[1];
#pragma unroll
        for (int db = 0; db < 2; ++db)
#pragma unroll
            for (int i = 0; i < 16; ++i) O[0][db][i] = 0.f;
        m[0] = C.p.attn_sink[l * NHA + head] * LOG2E; ls[0] = (h == 0) ? 1.0f : 0.0f;
        u32x4 kreg, vreg;
#define ATT_TROW(i) ((i) < CTX / 64 ? RL + b * CTX + 64 * (i) : b * SEQ + 64 * qb - 128 + 64 * (jlo + (i) - CTX / 64))
        ATT_STG_LOAD(ATT_TROW(0)); ATT_STG_STORE(0); __syncthreads();
        for (int i = 0; i < nt; ++i) {
            if (i + 1 < nt) ATT_STG_LOAD(ATT_TROW(i + 1));
            const bool loc = i >= CTX / 64; const int d = loc ? q0 - (64 * qb - 128 + 64 * (jlo + i - CTX / 64)) : 0;
            const bool masked = loc && (d > 97 || d < -65);
            const LAS unsigned char* kb_ = C.lds + (i & 1) * BUF_B;
            flash_tile<1, 4>(kb_, kb_ + TILE_B, Q, O, m, ls, lane, masked, d + r);
            if (i + 1 < nt) ATT_STG_STORE((i + 1) & 1);
            __syncthreads();
        }
#undef ATT_TROW
        const float inv = 1.0f / xsum32(ls[0]);
        bf16_t* op = C.MIX + (size_t)qrow * D + head * HDIM + 4 * h;
#pragma unroll
        for (int db = 0; db < 2; ++db)
#pragma unroll
            for (int g = 0; g < 4; ++g) { u32x2 w; w.x = pk2(O[0][db][4 * g] * inv, O[0][db][4 * g + 1] * inv); w.y = pk2(O[0][db][4 * g + 2] * inv, O[0][db][4 * g + 3] * inv);
                *(u32x2*)(op + 32 * db + 8 * g) = w; }
    }
}
__device__ __forceinline__ void phase_attnD(const Ctx& C, int l, bool need_ctx) {
    const int tid = tid_l(), lane = tid & 63, wave = __builtin_amdgcn_readfirstlane(tid >> 6), skey = tid >> 3, schunk = tid & 7;
    const int r = lane & 31, h = lane >> 5;
    const float lam_init = 0.8f - 0.6f * expf(-0.3f * (float)l);
    float lam;
    { const float* lp = C.p.diff_lambda + l * 4 * DD; const float a = lane < DD ? lp[lane] * lp[DD + lane] : 0.f, b2 = lane < DD ? lp[2 * DD + lane] * lp[3 * DD + lane] : 0.f;
      lam = expf(wave_sum(a)) - expf(wave_sum(b2)) + lam_init; }
    constexpr int NUL = NB * NHC * (SEQ / 256), NUC = NB * NHC * (CTX / 256);
    const int nu = NUL + (need_ctx ? NUC : 0);
    for (int u = blockIdx.x; u < nu; u += gridDim.x) {
        const bool lat = u < NUL; const int uu = lat ? u : u - NUL; const int nqb = lat ? SEQ / 256 : CTX / 256;
        const int b = uu / (NHC * nqb), hd = (uu / nqb) % NHC, qb = uu % nqb;
        const int kcol = C_KD + hd * 2 * DD, vcol = C_VD + hd * 2 * DD;
        const int qrow = (lat ? b * SEQ : RL + b * CTX) + 256 * qb + 32 * wave + r;
        const int nt = CTX / 64 + (lat ? SEQ / 64 : 0);
        bf16x8 Q[2][2];
#pragma unroll
        for (int j = 0; j < 2; ++j)
#pragma unroll
            for (int s = 0; s < 2; ++s) Q[j][s] = *(const bf16x8*)(C.P + (size_t)qrow * PROJ + C_QD + hd * 2 * DD + j * DD + 16 * s + 8 * h);
        f32x16 O[2][2]; float m[2], ls[2];
#pragma unroll
        for (int j = 0; j < 2; ++j) { m[j] = -1e30f; ls[j] = 0.f;
#pragma unroll
            for (int db = 0; db < 2; ++db)
#pragma unroll
                for (int i = 0; i < 16; ++i) O[j][db][i] = 0.f; }
        u32x4 kreg, vreg;
#define ATT_TROW(i) ((i) < CTX / 64 ? RL + b * CTX + 64 * (i) : b * SEQ + 64 * ((i) - CTX / 64))
        ATT_STG_LOAD(ATT_TROW(0)); ATT_STG_STORE(0); __syncthreads();
        for (int i = 0; i < nt; ++i) {
            if (i + 1 < nt) ATT_STG_LOAD(ATT_TROW(i + 1));
            const LAS unsigned char* kb_ = C.lds + (i & 1) * BUF_B;
            flash_tile<2, 2>(kb_, kb_ + TILE_B, Q, O, m, ls, lane, false, 0);
            if (i + 1 < nt) ATT_STG_STORE((i + 1) & 1);
            __syncthreads();
        }
#undef ATT_TROW
        const float i0 = 1.0f / xsum32(ls[0]), i1 = lam / xsum32(ls[1]);
        float ss = 0.f;
#pragma unroll
        for (int db = 0; db < 2; ++db)
#pragma unroll
            for (int i = 0; i < 16; ++i) { const float y = O[0][db][i] * i0 - O[1][db][i] * i1; O[0][db][i] = y; ss += y * y; }
        const float rn = (1.0f - lam_init) / sqrtf(xsum32(ss) * (1.0f / (2 * DD)) + EPS);
        const float* sw = C.p.diff_subln + l * 2 * DD + 4 * h;
        bf16_t* op = C.MIX + (size_t)qrow * D + 768 + hd * 2 * DD + 4 * h;
#pragma unroll
        for (int db = 0; db < 2; ++db)
#pragma unroll
            for (int g = 0; g < 4; ++g) { const f32x4 s4 = *(const f32x4*)(sw + 32 * db + 8 * g);
                u32x2 w; w.x = pk2(O[0][db][4 * g] * rn * s4[0], O[0][db][4 * g + 1] * rn * s4[1]); w.y = pk2(O[0][db][4 * g + 2] * rn * s4[2], O[0][db][4 * g + 3] * rn * s4[3]);
                *(u32x2*)(op + 32 * db + 8 * g) = w; }
    }
}
#undef ATT_STG_LOAD
#undef ATT_STG_STORE
}
__device__ __forceinline__ void phase_conv(const Ctx& C, int l, int nq) {
    const int tid = tid_l();
    const float* cw = C.p.conv_w + l * 3 * CONV_CH;
    for (long g = (long)blockIdx.x * NT + tid; g < (long)(nq / 8) * (CONV_CH / 8); g += (long)gridDim.x * NT) {
        const int row0 = (int)(g / (CONV_CH / 8)) * 8, c8 = (int)(g % (CONV_CH / 8)) * 8;
        const bool lat = row0 < RL; const int t0 = lat ? row0 % SEQ : (row0 - RL) % CTX, len = lat ? SEQ : CTX;
        float u[10][8];
#pragma unroll
        for (int i = 0; i < 10; ++i) { const int tt = t0 + i - 1;
            if (tt >= 0 && tt < len) { const bf16_t* pr = C.P + (size_t)(row0 + i - 1) * PROJ + c8; const u32x4 a = *(const u32x4*)(pr + C_CIN), c = *(const u32x4*)(pr + C_CC);
#pragma unroll
                for (int k = 0; k < 4; ++k) { u[i][2 * k] = __builtin_bit_cast(float, a[k] << 16) * __builtin_bit_cast(float, c[k] << 16); u[i][2 * k + 1] = __builtin_bit_cast(float, a[k] & 0xffff0000u) * __builtin_bit_cast(float, c[k] & 0xffff0000u); } }
            else {
#pragma unroll
                for (int k = 0; k < 8; ++k) u[i][k] = 0.f; } }
        float w[3][8];
#pragma unroll
        for (int j = 0; j < 3; ++j) { const f32x4 w0 = *(const f32x4*)(cw + j * CONV_CH + c8), w1 = *(const f32x4*)(cw + j * CONV_CH + c8 + 4);
#pragma unroll
            for (int k = 0; k < 4; ++k) { w[j][k] = w0[k]; w[j][4 + k] = w1[k]; } }
#pragma unroll
        for (int i = 0; i < 8; ++i) { const u32x4 gb = *(const u32x4*)(C.P + (size_t)(row0 + i) * PROJ + C_CB + c8); u32x4 o;
#pragma unroll
            for (int k = 0; k < 4; ++k) { const float y0 = w[0][2 * k] * u[i][2 * k] + w[1][2 * k] * u[i + 1][2 * k] + w[2][2 * k] * u[i + 2][2 * k];
                const float y1 = w[0][2 * k + 1] * u[i][2 * k + 1] + w[1][2 * k + 1] * u[i + 1][2 * k + 1] + w[2][2 * k + 1] * u[i + 2][2 * k + 1];
                o[k] = att::pk2(__builtin_bit_cast(float, gb[k] << 16) * y0, __builtin_bit_cast(float, gb[k] & 0xffff0000u) * y1); }
            *(u32x4*)(C.MIX + (size_t)(row0 + i) * D + 512 + c8) = o; }
    }
}
#ifndef ATT_A
#define ATT_A 1
#endif
#ifndef ATT_D
#define ATT_D 1
#endif
__device__ __forceinline__ void phase_mix_naive(const Ctx& C, int l, int nq) {
    const int tid = tid_l(), lane = tid & 63, wave = __builtin_amdgcn_readfirstlane(tid >> 6), gw = blockIdx.x * NWV + wave, NGW = gridDim.x * NWV; (void)lane; (void)gw; (void)NGW;
    const long g0 = (long)blockIdx.x * NT + tid, gs = (long)gridDim.x * NT; const float lam_init = 0.8f - 0.6f * expf(-0.3f * (float)l);
#if !ATT_A
    for (long g = g0; g < (long)nq * NHA; g += gs) b_attnA(g, C.P, C.p.attn_sink + l * NHA, C.MIX, nq);
#endif
#if !ATT_D
    for (long g = g0; g < (long)nq * NHC * 2; g += gs) b_attnD(g, C.P, C.TMP, nq);
#endif
    (void)g0; (void)gs;
}
__device__ __forceinline__ void phase_diffpost_naive(const Ctx& C, int l, int nq) {
    const int tid = tid_l(), lane = tid & 63, wave = __builtin_amdgcn_readfirstlane(tid >> 6), gw = blockIdx.x * NWV + wave, NGW = gridDim.x * NWV; (void)lane; (void)gw; (void)NGW;
    const long g0 = (long)blockIdx.x * NT + tid, gs = (long)gridDim.x * NT; const float lam_init = 0.8f - 0.6f * expf(-0.3f * (float)l);
    for (long g = g0; g < (long)nq * NHC; g += gs) b_diffpost(g, C.TMP, C.p.diff_lambda + l * 4 * DD, C.p.diff_subln + l * 2 * DD, lam_init, C.MIX, nq);
}

#ifndef DBL
#define DBL 0
#endif
#define REP(bit) for (int _rep = 0; _rep < (((DBL) & (bit)) ? 2 : 1); ++_rep)
constexpr int NPH = 9, PH_FINAL = 1 + DEPTH * NPH, PH_TOTAL = PH_FINAL + 1;
__global__ void __launch_bounds__(NT, 2) mega_fwd(Args args) {
    extern __shared__ __attribute__((aligned(16))) unsigned char lds_raw[];
    Ctx C;
    C.p.x = args.in[0]; C.p.c = args.in[1]; C.p.ctx = args.in[2]; C.p.c_ctx = args.in[3]; C.p.w_ada = args.in[4]; C.p.b_ada = args.in[5]; C.p.norm1 = args.in[6]; C.p.norm2 = args.in[7];
    C.p.w_in = args.in[8]; C.p.w_out = args.in[9]; C.p.attn_sink = args.in[10]; C.p.conv_w = args.in[11]; C.p.diff_lambda = args.in[12]; C.p.diff_subln = args.in[13]; C.p.router = args.in[14];
    C.p.w_gate = args.in[15]; C.p.w_up = args.in[16]; C.p.w_down = args.in[17]; C.p.norm_final = args.in[18];
    C.p.out = args.out; C.p.ws = args.ws;
    C.lds = (LAS unsigned char*)lds_raw;
    unsigned char* ws = args.ws;
    C.tab = (float*)(ws + WS_TAB); C.mod = (float*)(ws + WS_MOD); C.aff = (float*)(ws + WS_AFF); C.sel = (int*)(ws + WS_SEL); C.gate = (float*)(ws + WS_GATE); C.tokslot = (int*)(ws + WS_TOKSLOT);
    C.xc = (float*)(ws + WS_XC); C.xl = args.out; C.win = (bf16_t*)(ws + WS_WIN); C.wout = (bf16_t*)(ws + WS_WOUT);
    C.P = (bf16_t*)(ws + WS_R1); C.H = (bf16_t*)(ws + WS_R1); C.Y = (bf16_t*)(ws + WS_R2); C.MIX = (bf16_t*)(ws + WS_R2); C.HX2 = (bf16_t*)(ws + WS_R2 + (size_t)RALL * D * 2); C.TMP = (float*)C.HX2;
    C.HX = (bf16_t*)(ws + WS_R3); C.XB = (bf16_t*)(ws + WS_XB);
    volatile LAS unsigned* misc = (volatile LAS unsigned*)(C.lds + LDS_MISC);
    if (threadIdx.x < 64) misc[threadIdx.x] = 0u;
    __syncthreads();
    const int lo = args.ph_lo, hi = args.ph_hi;
    XcdBarrier bar; bar.bar = (unsigned*)(ws + WS_CTL) + CW_BAR; bar.x = 0; bar.st = misc;
    if (hi - lo > 1) bar = xcd_barrier_post((unsigned*)(ws + WS_CTL) + CW_BAR, misc);
#define IN(k) (lo <= (k) && (k) < hi)
#define SEAM(k) do { if (IN(k) && IN((k) + 1)) xcd_barrier(bar); } while (0)
    const int G = (int)gridDim.x, bid = (int)blockIdx.x;
    if (IN(0)) REP(512) phase_prologue(C);
    SEAM(0);
    for (int l = 0; l < DEPTH; ++l) {
        const int pb = 1 + l * NPH; const bool need_ctx = l < DEPTH - 1; const int nq = need_ctx ? RALL : RL;
        const float* modl = C.mod + (size_t)l * (NB + 1) * 6 * D;
        if (IN(pb + 0)) { REP(256) phase_cvt_experts(C, l); if (l == 0) phase_rowA<false, true>(C, 0); else phase_rowA<false, false>(C, l); if ((DBL) & 1024) { if (l == 0) phase_rowA<false, true>(C, 0); else phase_rowA<false, false>(C, l, 0.0f); } }
        SEAM(pb + 0);
        if (IN(pb + 1)) { pg::GemmD g{(const char*)C.HX, nullptr, (const char*)(C.win + (size_t)l * PROJ * D), 0, D}; pg::Order S; S.init(RALL / 256, PROJ / 256, G, bid, 0);
            pg::EpiP E{C.P, C.tab}; REP(1) pg::gemm_phase<pg::EpiP, false>(C.lds, g, S, E); }
        SEAM(pb + 1);
        if (IN(pb + 2)) {
#if ATT_A
            REP(2) att::phase_attnA(C, l, need_ctx);
#endif
#if ATT_D
            REP(4) att::phase_attnD(C, l, need_ctx);
#endif
            phase_mix_naive(C, l, nq); REP(128) phase_conv(C, l, nq); }
        SEAM(pb + 2);
#if !ATT_D
        if (IN(pb + 3)) phase_diffpost_naive(C, l, nq);
#endif
        SEAM(pb + 3);
        if (IN(pb + 4)) { pg::GemmD g{(const char*)C.MIX, nullptr, (const char*)(C.wout + (size_t)l * D * D), 0, D}; pg::Order S; S.init(nq / 256, D / 256, G, bid, 0);
            pg::EpiX E{C.XB, modl, 1.0f}; pg::gemm_phase<pg::EpiX, false>(C.lds, g, S, E);
            if ((DBL) & 2048) { pg::EpiX E0{C.XB, modl, 0.0f}; pg::gemm_phase<pg::EpiX, false>(C.lds, g, S, E0); } }
        SEAM(pb + 4);
        if (IN(pb + 5)) REP(8) phase_rowB(C, l, nq);
        SEAM(pb + 5);
        if (IN(pb + 6)) REP(16) phase_select(C, need_ctx);
        SEAM(pb + 6);
        const int tpe = need_ctx ? pg::TPE_FULL : SLOTS_L / 256;
        if (IN(pb + 7)) { pg::GemmD g{(const char*)C.HX2, C.sel, (const char*)((bf16_t*)(ws + WS_WGU) + (size_t)(l & 1) * NE * 2 * FF * D), (size_t)2 * FF * D * 2, D}; pg::Order S; S.init(NE * tpe, 2 * FF / 256, G, bid, tpe);
            pg::EpiH E{C.H}; REP(32) pg::gemm_phase<pg::EpiH, true>(C.lds, g, S, E); }
        SEAM(pb + 7);
        if (IN(pb + 8)) { pg::GemmD g{(const char*)C.H, nullptr, (const char*)((bf16_t*)(ws + WS_WD) + (size_t)(l & 1) * NE * D * FF), (size_t)D * FF * 2, FF}; pg::Order S; S.init(NE * tpe, D / 256, G, bid, tpe);
            pg::EpiY E{C.Y, C.gate}; REP(64) pg::gemm_phase<pg::EpiY, false>(C.lds, g, S, E); }
        SEAM(pb + 8);
    }
    if (IN(PH_FINAL)) phase_rowA<true, false>(C, DEPTH);
#undef IN
#undef SEAM
}
#endif

#ifndef HOST_TEST
#ifndef MODE
#define MODE 2
#endif
extern "C" void kernel_launch(void* const* d_in, const int* in_sizes, int n_in, void* d_out, int out_size, void* d_ws, size_t ws_size, hipStream_t stream) {
    if (n_in != 19 || out_size != RL * D || ws_size < WS_END) { fprintf(stderr, "kernel_launch: unexpected shapes (n_in %d out %d ws %zu need %zu)\n", n_in, out_size, ws_size, (size_t)WS_END); return; }
#if MODE == 0
    Ptrs p{};
    const float** f = (const float**)&p;
    for (int i = 0; i < 19; ++i) f[i] = (const float*)d_in[i];
    p.out = (float*)d_out; p.ws = (unsigned char*)d_ws;
    forward(p, stream);
#else
    static int grid = 0;
    if (grid == 0) {
        int dev = 0, cus = 0;
        if (hipGetDevice(&dev) != hipSuccess || hipDeviceGetAttribute(&cus, hipDeviceAttributeMultiprocessorCount, dev) != hipSuccess) { fprintf(stderr, "kernel_launch: device query failed\n"); grid = -1; return; }
        if (hipFuncSetAttribute((const void*)mega_fwd, hipFuncAttributeMaxDynamicSharedMemorySize, LDS_BYTES) != hipSuccess) { fprintf(stderr, "kernel_launch: hipFuncSetAttribute failed\n"); grid = -1; return; }
        int per_cu = 0;
        if (hipOccupancyMaxActiveBlocksPerMultiprocessor(&per_cu, (const void*)mega_fwd, NT, LDS_BYTES) != hipSuccess || per_cu < 1) fprintf(stderr, "kernel_launch: occupancy query reports %d blocks per CU\n", per_cu);
        (void)hipGetLastError();
        grid = cus;
    }
    if (grid < 0) return;
    if (hipMemsetAsync((char*)d_ws + WS_CTL, 0, CTL_BYTES, stream) != hipSuccess) { fprintf(stderr, "kernel_launch: memset failed\n"); return; }
    Args a{};
    for (int i = 0; i < 19; ++i) a.in[i] = (const float*)d_in[i];
    a.out = (float*)d_out; a.ws = (unsigned char*)d_ws;
#if MODE == 2
    a.ph_lo = 0; a.ph_hi = PH_TOTAL;
    hipLaunchKernelGGL(mega_fwd, dim3(grid), dim3(NT), LDS_BYTES, stream, a);
#else
    for (int ph = 0; ph < PH_TOTAL; ++ph) { a.ph_lo = ph; a.ph_hi = ph + 1; hipLaunchKernelGGL(mega_fwd, dim3(grid), dim3(NT), LDS_BYTES, stream, a); }
#endif
    const hipError_t le = hipPeekAtLastError();
    if (le != hipSuccess) fprintf(stderr, "kernel_launch: launch failed: %s\n", hipGetErrorName(le));
#endif
}
#else
#include <vector>
#include <string>
static std::vector<float> rd(const std::string& fn) { FILE* f = fopen(fn.c_str(), "rb"); if (!f) { perror(fn.c_str()); exit(1); } fseek(f, 0, SEEK_END); long n = ftell(f); fseek(f, 0, SEEK_SET); std::vector<float> v(n / 4); if (fread(v.data(), 1, n, f) != (size_t)n) exit(1); fclose(f); return v; }
int main(int argc, char** argv) {
    std::string dir = argv[1]; std::vector<std::vector<float>> in(19);
    for (int i = 0; i < 19; ++i) in[i] = rd(dir + "/in" + std::to_string(i) + ".bin");
    std::vector<float> out((size_t)RL * D); std::vector<unsigned char> ws(WS_END, 0xAA);
    Ptrs p{}; const float** f = (const float**)&p; for (int i = 0; i < 19; ++i) f[i] = in[i].data();
    p.out = out.data(); p.ws = ws.data();
    forward(p, 0);
    FILE* fo = fopen((dir + "/out.bin").c_str(), "wb"); fwrite(out.data(), 4, out.size(), fo); fclose(fo);
    printf("done, ws bytes %zu\n", (size_t)WS_END); return 0;
}
#endif
```

```cpp
#ifndef HOST_TEST
#include <hip/hip_runtime.h>
#endif
#include <cstdio>
#include <cstdint>
#include <cstring>
#include <cmath>

#ifndef CFG_B
#define CFG_B 32
#endif
#ifndef CFG_SEQ
#define CFG_SEQ 2048
#endif
#ifndef CFG_CTX
#define CFG_CTX 256
#endif
#ifndef CFG_DEPTH
#define CFG_DEPTH 4
#endif
constexpr int D = 1024, NB = CFG_B, SEQ = CFG_SEQ, CTX = CFG_CTX, DEPTH = CFG_DEPTH;
constexpr int GRID_W = 64, NROWS = SEQ / GRID_W, HDIM = 64, NHA = 8, NKVA = 2, GQA = 4, WINDOW = 128;
constexpr int CONV_CH = 256, DD = 32, NHC = 4, NE = 16, FF = 1024, PROJ = 2304;
constexpr int RL = NB * SEQ, RC = NB * CTX, RALL = RL + RC;
constexpr int CAPL = 2 * SEQ / NE, CAPC = 2 * CTX / NE;
constexpr int SLOTS_L = NB * CAPL, SLOTS_C = NB * CAPC, SLOTS_E = SLOTS_L + SLOTS_C;
constexpr int NSLOT = NE * SLOTS_E;
constexpr int C_QA = 0, C_KA = 512, C_VA = 640, C_CIN = 768, C_CB = 1024, C_CC = 1280, C_QD = 1536, C_KD = 1792, C_VD = 2048;
constexpr int M_SH1 = 0, M_SC1 = D, M_G1 = 2 * D, M_SH2 = 3 * D, M_SC2 = 4 * D, M_G2 = 5 * D;
constexpr float EPS = 1e-6f, LOG2E = 1.4426950408889634f;
constexpr float QSCALE_A = 0.125f * LOG2E, QSCALE_D = 0.17677669529663687f * LOG2E;

#ifdef HOST_TEST
#define HD
#define KERNEL static void
static thread_local long g_gid;
#define GID g_gid
#include <omp.h>
#define LAUNCH(kern, nthreads, ...) do { const long _n = (long)(nthreads); _Pragma("omp parallel for schedule(static)") for (long _g = 0; _g < _n; ++_g) { g_gid = _g; kern(__VA_ARGS__); } } while (0)
#else
#define HD __host__ __device__ __forceinline__
#define KERNEL __global__ void __launch_bounds__(256)
#define GID ((long)blockIdx.x * blockDim.x + threadIdx.x)
#define LAUNCH(kern, nthreads, ...) do { const long _n = (long)(nthreads); if (_n > 0) hipLaunchKernelGGL(kern, dim3((unsigned)((_n + 255) / 256)), dim3(256), 0, stream, __VA_ARGS__); } while (0)
#endif

typedef unsigned short bf16_t;
HD float bf2f(bf16_t v) { unsigned u = (unsigned)v << 16; return __builtin_bit_cast(float, u); }
HD bf16_t f2bf(float f) { unsigned u = __builtin_bit_cast(unsigned, f); return (bf16_t)((u + 0x7fffu + ((u >> 16) & 1u)) >> 16); }

constexpr size_t al256(size_t x) { return (x + 255) & ~(size_t)255; }
constexpr size_t WS_CTL = 0, CTL_BYTES = 1u << 20;
constexpr size_t WS_TAB = WS_CTL + CTL_BYTES;
constexpr int T_AROW = 0, T_ACOL = T_AROW + NROWS * 16 * 2, T_DROW = T_ACOL + 64 * 16 * 2, T_DCOL = T_DROW + NROWS * 8 * 2, T_END = T_DCOL + 64 * 8 * 2;
constexpr size_t WS_SILU = WS_TAB + al256((size_t)T_END * 4);
constexpr size_t WS_MOD = WS_SILU + al256((size_t)(NB + 1) * D * 4);
constexpr size_t WS_RSTD = WS_MOD + al256((size_t)DEPTH * (NB + 1) * 6 * D * 4);
constexpr size_t WS_AFF = WS_RSTD + al256((size_t)RALL * 4);
constexpr size_t WS_SEL = WS_AFF + al256((size_t)RALL * NE * 4);
constexpr size_t WS_GATE = WS_SEL + al256((size_t)NSLOT * 4);
constexpr size_t WS_TOKSLOT = WS_GATE + al256((size_t)NSLOT * 4);
constexpr size_t WS_XC = WS_TOKSLOT + al256((size_t)RALL * NE * 4);
constexpr size_t WS_WIN = WS_XC + al256((size_t)RC * D * 4);
constexpr size_t WS_WOUT = WS_WIN + al256((size_t)DEPTH * PROJ * D * 2);
constexpr size_t WS_WGU = WS_WOUT + al256((size_t)DEPTH * D * D * 2);
constexpr size_t WS_WD = WS_WGU + al256((size_t)2 * NE * 2 * FF * D * 2);
constexpr size_t WS_R1 = WS_WD + al256((size_t)2 * NE * D * FF * 2);
constexpr size_t R1_BYTES = al256(((size_t)RALL * PROJ * 2 > (size_t)NSLOT * FF * 2) ? (size_t)RALL * PROJ * 2 : (size_t)NSLOT * FF * 2);
constexpr size_t WS_R2 = WS_R1 + R1_BYTES;
constexpr size_t R2_BYTES = al256(((size_t)NSLOT * D * 2 > (size_t)2 * RALL * D * 2) ? (size_t)NSLOT * D * 2 : (size_t)2 * RALL * D * 2);
constexpr size_t WS_R3 = WS_R2 + R2_BYTES;
constexpr size_t WS_XB = WS_R3 + al256((size_t)RALL * D * 2);
constexpr size_t WS_HXS = WS_XB + al256((size_t)RALL * D * 2);
constexpr size_t WS_END = WS_HXS + al256((size_t)RALL * 4);
constexpr size_t CTL_WINMAX = 262144;

struct Ptrs {
    const float *x, *c, *ctx, *c_ctx, *w_ada, *b_ada, *norm1, *norm2, *w_in, *w_out, *attn_sink, *conv_w, *diff_lambda, *diff_subln, *router, *w_gate, *w_up, *w_down, *norm_final;
    float* out; unsigned char* ws;
};

HD float* xrow_ptr(float* xl, float* xc, int row) { return row < RL ? xl + (size_t)row * D : xc + (size_t)(row - RL) * D; }
HD int row_batch(int row) { return row < RL ? row / SEQ : NB; }
HD float silu_f(float v) { return v / (1.0f + expf(-v)); }

KERNEL k_tables(float* tab) {
    const long g = GID; if (g >= (long)(NROWS + 64) * 24) return;
    const int pos = (int)(g / 24), f = (int)(g % 24);
    const double inv = f < 16 ? pow(10000.0, -(2.0 * f) / 32.0) : pow(10000.0, -(2.0 * (f - 16)) / 16.0);
    const bool isrow = pos < NROWS; const int p = isrow ? pos : pos - NROWS;
    const double ang = (double)p * inv; const float cs = (float)cos(ang), sn = (float)sin(ang);
    int idx;
    if (f < 16) idx = (isrow ? T_AROW : T_ACOL) + (p * 16 + f) * 2; else idx = (isrow ? T_DROW : T_DCOL) + (p * 8 + (f - 16)) * 2;
    tab[idx] = cs; tab[idx + 1] = sn;
}
KERNEL k_silu(const float* c, const float* c_ctx, float* out) {
    const long g = GID; if (g >= (long)(NB + 1) * D) return;
    const int b = (int)(g / D), k = (int)(g % D); const float v = b < NB ? c[b * D + k] : c_ctx[k];
    out[g] = silu_f(v);
}
KERNEL k_mod(const float* silu, const float* w_ada, const float* b_ada, float* mod) {
    const long g = GID; if (g >= (long)DEPTH * 6 * D) return;
    const int l = (int)(g / (6 * D)), j = (int)(g % (6 * D));
    float acc[NB + 1];
#pragma unroll
    for (int b = 0; b <= NB; ++b) acc[b] = 0.f;
    const float* w = w_ada + (size_t)l * D * 6 * D + j;
    for (int k = 0; k < D; ++k) { const float wv = w[(size_t)k * 6 * D];
#pragma unroll
        for (int b = 0; b <= NB; ++b) acc[b] += silu[b * D + k] * wv; }
    const float bias = b_ada[l * 6 * D + j];
#pragma unroll
    for (int b = 0; b <= NB; ++b) mod[((size_t)l * (NB + 1) + b) * 6 * D + j] = acc[b] + bias;
}
HD int permA(int p) { return (p / 32) * 32 + (p % 32) / 2 + 16 * (p % 2); }
HD int permD(int p) { return (p / 16) * 16 + (p % 16) / 2 + 8 * (p % 2); }
HD int inproj_src_col(int n) {
    if (n < C_VA) return (n / 64) * 64 + permA(n % 64);
    if (n < C_QD) return n;
    if (n < C_VD) return (n / 32) * 32 + permD(n % 32);
    return n;
}
KERNEL k_cvt_win(const float* w_in, bf16_t* wt) {
    const long g = GID; if (g >= (long)DEPTH * PROJ * D) return;
    const int k = (int)(g % D); const int n = (int)((g / D) % PROJ); const int l = (int)(g / ((long)D * PROJ));
    wt[g] = f2bf(w_in[((size_t)l * D + k) * PROJ + inproj_src_col(n)]);
}
KERNEL k_cvt_t(const float* w, bf16_t* wt, int nmat, int K, int N) {
    const long g = GID; if (g >= (long)nmat * K * N) return;
    const int k = (int)(g % K); const int n = (int)((g / K) % N); const int m = (int)(g / ((long)K * N));
    wt[g] = f2bf(w[((size_t)m * K + k) * N + n]);
}
KERNEL k_cvt_gu(const float* wg, const float* wu, bf16_t* wt) {
    const long g = GID; if (g >= (long)NE * 2 * FF * D) return;
    const int k = (int)(g % D); const int n = (int)((g / D) % (2 * FF)); const int e = (int)(g / ((long)D * 2 * FF));
    const int blk = n / 256, bj = (n % 256) / 128, j = n % 128; const float* src = bj ? wu : wg;
    wt[g] = f2bf(src[((size_t)e * D + k) * FF + blk * 128 + j]);
}
KERNEL k_rowstat(const float* xl, const float* xc, float* rstd, int nrows) {
    const long g = GID; if (g >= nrows) return;
    const float* xr = xrow_ptr((float*)xl, (float*)xc, (int)g); float s = 0.f;
    for (int k = 0; k < D; ++k) s += xr[k] * xr[k];
    rstd[g] = 1.0f / sqrtf(s / D + EPS);
}
KERNEL k_rowapply(const float* xl, const float* xc, const float* rstd, const float* nw, const float* modl, int sh_off, int sc_off, bf16_t* hx, int nrows) {
    const long g = GID; if (g >= (long)nrows * D) return;
    const int row = (int)(g / D), k = (int)(g % D); const float* xr = xrow_ptr((float*)xl, (float*)xc, row);
    const float* m = modl + (size_t)row_batch(row) * 6 * D;
    const float v = xr[k] * rstd[row] * nw[k] * (1.0f + m[sc_off + k]) + m[sh_off + k];
    hx[g] = f2bf(v);
}
struct EpiInProj {
    bf16_t* P; const float* tab;
    HD void operator()(int row, int c0, const float* v, const float*) const {
        float o[4] = {v[0], v[1], v[2], v[3]};
        const bool lat = row < RL; const int pos = lat ? row % SEQ : 0; const int gr = pos / GRID_W, gc = pos % GRID_W;
        if (c0 < C_VA) {
            if (lat) { const int p = c0 % 64, grp = p / 32, i0 = (p % 32) / 2;
                const float* t = tab + (grp == 0 ? T_AROW + gr * 32 : T_ACOL + gc * 32) + i0 * 2;
                const float a0 = o[0], b0 = o[1], a1 = o[2], b1 = o[3];
                o[0] = a0 * t[0] - b0 * t[1]; o[1] = b0 * t[0] + a0 * t[1]; o[2] = a1 * t[2] - b1 * t[3]; o[3] = b1 * t[2] + a1 * t[3]; }
            if (c0 < C_KA) { for (int j = 0; j < 4; ++j) o[j] *= QSCALE_A; }
        } else if (c0 >= C_QD && c0 < C_VD) {
            if (lat) { const int p = c0 % 32, grp = p / 16, i0 = (p % 16) / 2;
                const float* t = tab + (grp == 0 ? T_DROW + gr * 16 : T_DCOL + gc * 16) + i0 * 2;
                const float a0 = o[0], b0 = o[1], a1 = o[2], b1 = o[3];
                o[0] = a0 * t[0] - b0 * t[1]; o[1] = b0 * t[0] + a0 * t[1]; o[2] = a1 * t[2] - b1 * t[3]; o[3] = b1 * t[2] + a1 * t[3]; }
            if (c0 < C_KD) { for (int j = 0; j < 4; ++j) o[j] *= QSCALE_D; }
        }
        bf16_t* d = P + (size_t)row * PROJ + c0;
        for (int j = 0; j < 4; ++j) d[j] = f2bf(o[j]);
    }
};
struct EpiOutProj {
    float* xl; float* xc; const float* modl;
    HD void operator()(int row, int c0, const float* v, const float*) const {
        float* xr = xrow_ptr(xl, xc, row) + c0; const float* g1 = modl + (size_t)row_batch(row) * 6 * D + M_G1 + c0;
        for (int j = 0; j < 4; ++j) xr[j] += g1[j] * v[j];
    }
};
struct EpiGateUp {
    bf16_t* H;
    HD void operator()(int row, int c0, const float* v, const float* u) const {
        bf16_t* d = H + (size_t)row * FF + c0;
        for (int j = 0; j < 4; ++j) d[j] = f2bf(silu_f(v[j]) * u[j]);
    }
};
struct EpiDown {
    bf16_t* Y; const float* gate;
    HD void operator()(int row, int c0, const float* v, const float*) const {
        const float g = gate[row]; bf16_t* d = Y + (size_t)row * D + c0;
        for (int j = 0; j < 4; ++j) d[j] = f2bf(v[j] * g);
    }
};
template <class Epi, bool DUAL>
KERNEL k_gemm_naive(const bf16_t* A, const int* rowidx, const bf16_t* Bt, int M, int N, int K, int group_rows, int valid_rows, long bstride, Epi epi) {
    const long g = GID; if (g >= (long)M * (N / 4)) return;
    const int row = (int)(g / (N / 4)), c0 = (int)(g % (N / 4)) * 4;
    if (row % group_rows >= valid_rows) return;
    const int arow = rowidx ? rowidx[row] : row;
    const bf16_t* a = A + (size_t)arow * K; const bf16_t* B = Bt + (size_t)(row / group_rows) * bstride;
    float v[4], u[4];
    for (int j = 0; j < 4; ++j) { const int c = c0 + j; const int br = DUAL ? (c / 128) * 256 + c % 128 : c;
        const bf16_t* b0 = B + (size_t)br * K; float s = 0.f, s2 = 0.f;
        for (int k = 0; k < K; ++k) s += bf2f(a[k]) * bf2f(b0[k]);
        if (DUAL) { const bf16_t* b1 = b0 + (size_t)128 * K; for (int k = 0; k < K; ++k) s2 += bf2f(a[k]) * bf2f(b1[k]); }
        v[j] = s; u[j] = s2; }
    epi(row, c0, v, u);
}
HD void b_attnA(const long g, const bf16_t* P, const float* sink, bf16_t* MIX, int nrows) {
    if (g >= (long)nrows * NHA) return;
    const int h = (int)(g / nrows), row = (int)(g % nrows), kvh = h / GQA;
    const bool lat = row < RL; const int b = lat ? row / SEQ : (row - RL) / CTX; const int t = lat ? row % SEQ : 0;
    float q[HDIM], o[HDIM];
    const bf16_t* qp = P + (size_t)row * PROJ + C_QA + h * HDIM;
#pragma unroll
    for (int d = 0; d < HDIM; ++d) { q[d] = bf2f(qp[d]); o[d] = 0.f; }
    float m = sink[h] * LOG2E, l = 1.0f;
    const int nctx = CTX, lo = lat ? (t - WINDOW < 0 ? 0 : t - WINDOW) : 0, hi = lat ? (t + WINDOW > SEQ - 1 ? SEQ - 1 : t + WINDOW) : -1;
    const int nkeys = nctx + (hi - lo + 1);
    for (int i = 0; i < nkeys; ++i) {
        const int krow = i < nctx ? RL + b * CTX + i : b * SEQ + lo + (i - nctx);
        const bf16_t* kp = P + (size_t)krow * PROJ + C_KA + kvh * HDIM; const bf16_t* vp = P + (size_t)krow * PROJ + C_VA + kvh * HDIM;
        float s = 0.f;
#pragma unroll
        for (int d = 0; d < HDIM; ++d) s += q[d] * bf2f(kp[d]);
        if (s > m) { const float sc = exp2f(m - s); l *= sc;
#pragma unroll
            for (int d = 0; d < HDIM; ++d) o[d] *= sc;
            m = s; }
        const float p = exp2f(s - m); l += p;
#pragma unroll
        for (int d = 0; d < HDIM; ++d) o[d] += p * bf2f(vp[d]);
    }
    const float inv = 1.0f / l; bf16_t* op = MIX + (size_t)row * D + h * HDIM;
#pragma unroll
    for (int d = 0; d < HDIM; ++d) op[d] = f2bf(o[d] * inv);
}
KERNEL k_attnA(const bf16_t* P, const float* sink, bf16_t* MIX, int nrows) { b_attnA(GID, P, sink, MIX, nrows); }
HD void b_attnD(const long g, const bf16_t* P, float* TMP, int nrows) {
    if (g >= (long)nrows * NHC * 2) return;
    const int hc = (int)(g / nrows), row = (int)(g % nrows), h = hc / 2, comp = hc % 2;
    const bool lat = row < RL; const int b = lat ? row / SEQ : (row - RL) / CTX;
    float q[DD], o[2 * DD];
    const bf16_t* qp = P + (size_t)row * PROJ + C_QD + h * 2 * DD + comp * DD;
#pragma unroll
    for (int d = 0; d < DD; ++d) q[d] = bf2f(qp[d]);
#pragma unroll
    for (int d = 0; d < 2 * DD; ++d) o[d] = 0.f;
    float m = -1e30f, l = 0.f;
    const int nkeys = CTX + (lat ? SEQ : 0);
    for (int i = 0; i < nkeys; ++i) {
        const int krow = i < CTX ? RL + b * CTX + i : b * SEQ + (i - CTX);
        const bf16_t* kp = P + (size_t)krow * PROJ + C_KD + h * 2 * DD + comp * DD; const bf16_t* vp = P + (size_t)krow * PROJ + C_VD + h * 2 * DD;
        float s = 0.f;
#pragma unroll
        for (int d = 0; d < DD; ++d) s += q[d] * bf2f(kp[d]);
        if (s > m) { const float sc = exp2f(m - s); l *= sc;
#pragma unroll
            for (int d = 0; d < 2 * DD; ++d) o[d] *= sc;
            m = s; }
        const float p = exp2f(s - m); l += p;
#pragma unroll
        for (int d = 0; d < 2 * DD; ++d) o[d] += p * bf2f(vp[d]);
    }
    const float inv = 1.0f / l; float* op = TMP + (((size_t)row * NHC + h) * 2 + comp) * 2 * DD;
#pragma unroll
    for (int d = 0; d < 2 * DD; ++d) op[d] = o[d] * inv;
}
KERNEL k_attnD(const bf16_t* P, float* TMP, int nrows) { b_attnD(GID, P, TMP, nrows); }
HD void b_diffpost(const long g, const float* TMP, const float* lam_p, const float* subln, float lam_init, bf16_t* MIX, int nrows) {
    if (g >= (long)nrows * NHC) return;
    const int row = (int)(g / NHC), h = (int)(g % NHC);
    float s01 = 0.f, s23 = 0.f;
    for (int d = 0; d < DD; ++d) { s01 += lam_p[d] * lam_p[DD + d]; s23 += lam_p[2 * DD + d] * lam_p[3 * DD + d]; }
    const float lam = expf(s01) - expf(s23) + lam_init;
    const float* t = TMP + ((size_t)row * NHC + h) * 2 * 2 * DD; float y[2 * DD]; float ss = 0.f;
#pragma unroll
    for (int d = 0; d < 2 * DD; ++d) { y[d] = t[d] - lam * t[2 * DD + d]; ss += y[d] * y[d]; }
    const float r = 1.0f / sqrtf(ss / (2 * DD) + EPS) * (1.0f - lam_init);
    bf16_t* op = MIX + (size_t)row * D + 768 + h * 2 * DD;
#pragma unroll
    for (int d = 0; d < 2 * DD; ++d) op[d] = f2bf(y[d] * r * subln[d]);
}
KERNEL k_diffpost(const float* TMP, const float* lam_p, const float* subln, float lam_init, bf16_t* MIX, int nrows) { b_diffpost(GID, TMP, lam_p, subln, lam_init, MIX, nrows); }
HD void b_conv(const long g, const bf16_t* P, const float* cw, bf16_t* MIX, int nrows) {
    if (g >= (long)nrows * CONV_CH) return;
    const int row = (int)(g / CONV_CH), ch = (int)(g % CONV_CH);
    const bool lat = row < RL; const int t = lat ? row % SEQ : (row - RL) % CTX, len = lat ? SEQ : CTX;
    float y = 0.f;
    for (int j = 0; j < 3; ++j) { const int tt = t + j - 1; if (tt < 0 || tt >= len) continue;
        const bf16_t* pr = P + (size_t)(row + j - 1) * PROJ; y += cw[j * CONV_CH + ch] * (bf2f(pr[C_CC + ch]) * bf2f(pr[C_CIN + ch])); }
    MIX[(size_t)row * D + 512 + ch] = f2bf(bf2f(P[(size_t)row * PROJ + C_CB + ch]) * y);
}
KERNEL k_conv(const bf16_t* P, const float* cw, bf16_t* MIX, int nrows) { b_conv(GID, P, cw, MIX, nrows); }
KERNEL k_router(const float* xl, const float* xc, const float* rstd, const float* nw, const float* modl, const float* router, float* logits, int nrows) {
    const long g = GID; if (g >= (long)nrows * NE) return;
    const int row = (int)(g / NE), e = (int)(g % NE); const float* xr = xrow_ptr((float*)xl, (float*)xc, row);
    const float* m = modl + (size_t)row_batch(row) * 6 * D; const float rs = rstd[row]; float s = 0.f;
    for (int k = 0; k < D; ++k) { const float v = xr[k] * rs * nw[k] * (1.0f + m[M_SC2 + k]) + m[M_SH2 + k]; s += v * router[k * NE + e]; }
    logits[g] = s;
}
KERNEL k_aff(float* aff, int nrows) {
    const long g = GID; if (g >= nrows) return;
    float* a = aff + (size_t)g * NE; float m = a[0];
    for (int e = 1; e < NE; ++e) m = a[e] > m ? a[e] : m;
    float s = 0.f; float ex[NE];
#pragma unroll
    for (int e = 0; e < NE; ++e) { ex[e] = expf(a[e] - m); s += ex[e]; }
#pragma unroll
    for (int e = 0; e < NE; ++e) a[e] = ex[e] / s;
}
KERNEL k_select(const float* aff, int* sel, float* gate, int* tokslot, int nrows) {
    const long g = GID; if (g >= (long)nrows * NE) return;
    const int row = (int)(g / NE), e = (int)(g % NE);
    const bool lat = row < RL; const int b = lat ? row / SEQ : (row - RL) / CTX; const int t = lat ? row % SEQ : (row - RL) % CTX;
    const int n = lat ? SEQ : CTX, cap = lat ? CAPL : CAPC, base = lat ? b * SEQ : RL + b * CTX;
    const float a = aff[(size_t)row * NE + e]; int rank = 0;
    for (int j = 0; j < n; ++j) { const float o = aff[(size_t)(base + j) * NE + e]; rank += (o > a || (o == a && j < t)) ? 1 : 0; }
    int slot = -1;
    if (rank < cap) { slot = e * SLOTS_E + (lat ? b * CAPL + rank : SLOTS_L + b * CAPC + rank); sel[slot] = row; gate[slot] = a; }
    tokslot[g] = slot;
}
KERNEL k_combine(float* xl, float* xc, const bf16_t* Y, const int* tokslot, const float* modl, int nrows) {
    const long g = GID; if (g >= (long)nrows * D) return;
    const int row = (int)(g / D), k = (int)(g % D); float s = 0.f;
    for (int e = 0; e < NE; ++e) { const int sl = tokslot[(size_t)row * NE + e]; if (sl >= 0) s += bf2f(Y[(size_t)sl * D + k]); }
    float* xr = xrow_ptr(xl, xc, row); xr[k] += modl[(size_t)row_batch(row) * 6 * D + M_G2 + k] * s;
}
KERNEL k_final(float* xl, const float* rstd, const float* nw) {
    const long g = GID; if (g >= (long)RL * D) return;
    const int row = (int)(g / D), k = (int)(g % D); xl[g] = xl[g] * rstd[row] * nw[k];
}

#ifndef HOST_TEST
typedef short bf16x8 __attribute__((ext_vector_type(8)));
typedef float f32x4 __attribute__((ext_vector_type(4)));
template <class Epi, bool DUAL>
__global__ void __launch_bounds__(256) k_gemm_mfma(const bf16_t* __restrict__ A, const int* __restrict__ rowidx, const bf16_t* __restrict__ Bt, int M, int N, int K, int group_rows, int valid_rows, long bstride, Epi epi) {
    const int tid = threadIdx.x, wid = tid >> 6, lane = tid & 63, fr = lane & 15, fq = lane >> 4, wr = wid >> 1, wc = wid & 1;
    const int row0 = blockIdx.y * 128 + wr * 64;
    if ((blockIdx.y * 128) % group_rows >= valid_rows) return;
    const bf16_t* B = Bt + (size_t)((blockIdx.y * 128) / group_rows) * bstride;
    int brow[4], ocol[4];
    if (!DUAL) { for (int i = 0; i < 4; ++i) { brow[i] = blockIdx.x * 128 + wc * 64 + i * 16; ocol[i] = brow[i]; } }
    else { const int hc0 = blockIdx.x * 64 + wc * 32;
        for (int i = 0; i < 2; ++i) { ocol[i] = hc0 + i * 16; brow[i] = (ocol[i] / 128) * 256 + ocol[i] % 128; brow[i + 2] = brow[i] + 128; ocol[i + 2] = ocol[i]; } }
    const bf16_t* ap[4]; const bf16_t* bp[4];
#pragma unroll
    for (int m = 0; m < 4; ++m) { const int r = row0 + m * 16 + fr; const int ar = rowidx ? rowidx[r] : r; ap[m] = A + (size_t)ar * K + fq * 8; }
#pragma unroll
    for (int i = 0; i < 4; ++i) bp[i] = B + (size_t)(brow[i] + fr) * K + fq * 8;
    f32x4 acc[4][4];
#pragma unroll
    for (int m = 0; m < 4; ++m)
#pragma unroll
        for (int i = 0; i < 4; ++i) acc[m][i] = (f32x4){0.f, 0.f, 0.f, 0.f};
    for (int k0 = 0; k0 < K; k0 += 32) {
        bf16x8 af[4], bfr[4];
#pragma unroll
        for (int m = 0; m < 4; ++m) af[m] = *(const bf16x8*)(ap[m] + k0);
#pragma unroll
        for (int i = 0; i < 4; ++i) bfr[i] = *(const bf16x8*)(bp[i] + k0);
#pragma unroll
        for (int m = 0; m < 4; ++m)
#pragma unroll
            for (int i = 0; i < 4; ++i) acc[m][i] = __builtin_amdgcn_mfma_f32_16x16x32_bf16(bfr[i], af[m], acc[m][i], 0, 0, 0);
    }
#pragma unroll
    for (int m = 0; m < 4; ++m) { const int r = row0 + m * 16 + fr;
#pragma unroll
        for (int i = 0; i < (DUAL ? 2 : 4); ++i) {
            float v[4] = {acc[m][i][0], acc[m][i][1], acc[m][i][2], acc[m][i][3]};
            float u[4] = {acc[m][DUAL ? i + 2 : i][0], acc[m][DUAL ? i + 2 : i][1], acc[m][DUAL ? i + 2 : i][2], acc[m][DUAL ? i + 2 : i][3]};
            epi(r, ocol[i] + 4 * fq, v, u); } }
}
template <class Epi, bool DUAL>
static void launch_gemm(hipStream_t stream, const bf16_t* A, const int* rowidx, const bf16_t* Bt, int M, int N, int K, int group_rows, int valid_rows, long bstride, Epi epi) {
    dim3 grid(DUAL ? N / 64 : N / 128, M / 128);
    hipLaunchKernelGGL((k_gemm_mfma<Epi, DUAL>), grid, dim3(256), 0, stream, A, rowidx, Bt, M, N, K, group_rows, valid_rows, bstride, epi);
}
#define GEMM(Epi, DUAL, ...) launch_gemm<Epi, DUAL>(stream, __VA_ARGS__)
#else
#define GEMM(Epi, DUAL, A, rowidx, Bt, M, N, K, gr, vr, bs, epi) LAUNCH((k_gemm_naive<Epi, DUAL>), (long)(M) * ((N) / 4), A, rowidx, Bt, M, N, K, gr, vr, bs, epi)
#endif

#ifdef HOST_TEST
typedef int hipStream_t;
#endif
static void forward(const Ptrs& p, hipStream_t stream) {
    (void)stream;
    unsigned char* ws = p.ws;
    float* tab = (float*)(ws + WS_TAB); float* silu = (float*)(ws + WS_SILU); float* mod = (float*)(ws + WS_MOD); float* rstd = (float*)(ws + WS_RSTD);
    float* aff = (float*)(ws + WS_AFF); int* sel = (int*)(ws + WS_SEL); float* gate = (float*)(ws + WS_GATE); int* tokslot = (int*)(ws + WS_TOKSLOT);
    float* xc = (float*)(ws + WS_XC); float* xl = p.out;
    bf16_t* win = (bf16_t*)(ws + WS_WIN); bf16_t* wout = (bf16_t*)(ws + WS_WOUT);
    bf16_t* P = (bf16_t*)(ws + WS_R1); bf16_t* H = (bf16_t*)(ws + WS_R1);
    bf16_t* Y = (bf16_t*)(ws + WS_R2); bf16_t* MIX = (bf16_t*)(ws + WS_R2); bf16_t* HX2 = (bf16_t*)(ws + WS_R2 + (size_t)RALL * D * 2); float* TMP = (float*)HX2;
    bf16_t* HX = (bf16_t*)(ws + WS_R3);
    LAUNCH(k_tables, (long)(NROWS + 64) * 24, tab);
    LAUNCH(k_silu, (long)(NB + 1) * D, p.c, p.c_ctx, silu);
    LAUNCH(k_mod, (long)DEPTH * 6 * D, silu, p.w_ada, p.b_ada, mod);
    LAUNCH(k_cvt_win, (long)DEPTH * PROJ * D, p.w_in, win);
    LAUNCH(k_cvt_t, (long)DEPTH * D * D, p.w_out, wout, DEPTH, D, D);
#ifdef HOST_TEST
    memcpy(xl, p.x, (size_t)RL * D * 4); memcpy(xc, p.ctx, (size_t)RC * D * 4);
#else
    (void)hipMemcpyAsync(xl, p.x, (size_t)RL * D * 4, hipMemcpyDeviceToDevice, stream);
    (void)hipMemcpyAsync(xc, p.ctx, (size_t)RC * D * 4, hipMemcpyDeviceToDevice, stream);
#endif
    for (int l = 0; l < DEPTH; ++l) {
        const bool need_ctx = l < DEPTH - 1; const int nq = need_ctx ? RALL : RL;
        const float* modl = mod + (size_t)l * (NB + 1) * 6 * D; const float lam_init = 0.8f - 0.6f * expf(-0.3f * (float)l);
        bf16_t* wgu = (bf16_t*)(ws + WS_WGU) + (size_t)(l & 1) * NE * 2 * FF * D; bf16_t* wd = (bf16_t*)(ws + WS_WD) + (size_t)(l & 1) * NE * D * FF;
        LAUNCH(k_cvt_gu, (long)NE * 2 * FF * D, p.w_gate + (size_t)l * NE * D * FF, p.w_up + (size_t)l * NE * D * FF, wgu);
        LAUNCH(k_cvt_t, (long)NE * FF * D, p.w_down + (size_t)l * NE * FF * D, wd, NE, FF, D);
        LAUNCH(k_rowstat, RALL, xl, xc, rstd, RALL);
        LAUNCH(k_rowapply, (long)RALL * D, xl, xc, rstd, p.norm1 + l * D, modl, M_SH1, M_SC1, HX, RALL);
        GEMM(EpiInProj, false, HX, (const int*)nullptr, win + (size_t)l * PROJ * D, RALL, PROJ, D, RALL, RALL, 0L, (EpiInProj{P, tab}));
        LAUNCH(k_attnA, (long)nq * NHA, P, p.attn_sink + l * NHA, MIX, nq);
        LAUNCH(k_attnD, (long)nq * NHC * 2, P, TMP, nq);
        LAUNCH(k_diffpost, (long)nq * NHC, TMP, p.diff_lambda + l * 4 * DD, p.diff_subln + l * 2 * DD, lam_init, MIX, nq);
        LAUNCH(k_conv, (long)nq * CONV_CH, P, p.conv_w + l * 3 * CONV_CH, MIX, nq);
        GEMM(EpiOutProj, false, MIX, (const int*)nullptr, wout + (size_t)l * D * D, nq, D, D, nq, nq, 0L, (EpiOutProj{xl, xc, modl}));
        LAUNCH(k_rowstat, nq, xl, xc, rstd, nq);
        LAUNCH(k_rowapply, (long)nq * D, xl, xc, rstd, p.norm2 + l * D, modl, M_SH2, M_SC2, HX2, nq);
        LAUNCH(k_router, (long)nq * NE, xl, xc, rstd, p.norm2 + l * D, modl, p.router + (size_t)l * D * NE, aff, nq);
        LAUNCH(k_aff, nq, aff, nq);
        LAUNCH(k_select, (long)nq * NE, aff, sel, gate, tokslot, nq);
        const int vr = need_ctx ? SLOTS_E : SLOTS_L;
        GEMM(EpiGateUp, true, HX2, sel, wgu, NSLOT, FF, D, SLOTS_E, vr, (long)2 * FF * D, (EpiGateUp{H}));
        GEMM(EpiDown, false, H, (const int*)nullptr, wd, NSLOT, D, FF, SLOTS_E, vr, (long)D * FF, (EpiDown{Y, gate}));
        LAUNCH(k_combine, (long)nq * D, xl, xc, Y, tokslot, modl, nq);
    }
    LAUNCH(k_rowstat, RL, xl, xc, rstd, RL);
    LAUNCH(k_final, (long)RL * D, xl, rstd, p.norm_final);
}

#ifndef HOST_TEST
#define LAS __attribute__((address_space(3)))
#define GAS __attribute__((address_space(1)))
typedef unsigned u32x4 __attribute__((ext_vector_type(4)));
typedef unsigned u32x2 __attribute__((ext_vector_type(2)));
typedef float f32x2_t __attribute__((ext_vector_type(2)));
constexpr int NT = 512, NWV = 8;
constexpr int LDS_BYTES = 163840;
constexpr int LDS_MISC = LDS_BYTES - 256;
constexpr int CW_BAR = 4096;

__device__ __forceinline__ unsigned cvt_pk_bf16(float lo, float hi) { unsigned r; asm volatile("v_cvt_pk_bf16_f32 %0, %1, %2" : "=v"(r) : "v"(lo), "v"(hi)); return r; }
__device__ __forceinline__ float dpp_f(float v, const int ctrl_tag) {
    int r;
    switch (ctrl_tag) {
        case 0: r = __builtin_amdgcn_update_dpp(0, __builtin_bit_cast(int, v), 0xB1, 0xF, 0xF, true); break;
        case 1: r = __builtin_amdgcn_update_dpp(0, __builtin_bit_cast(int, v), 0x4E, 0xF, 0xF, true); break;
        case 2: r = __builtin_amdgcn_update_dpp(0, __builtin_bit_cast(int, v), 0x141, 0xF, 0xF, true); break;
        default: r = __builtin_amdgcn_update_dpp(0, __builtin_bit_cast(int, v), 0x140, 0xF, 0xF, true); break;
    }
    return __builtin_bit_cast(float, r);
}
__device__ __forceinline__ float wave_sum(float v) {
    v += dpp_f(v, 0); v += dpp_f(v, 1); v += dpp_f(v, 2); v += dpp_f(v, 3);
    const int b = __builtin_bit_cast(int, v);
    return (__builtin_bit_cast(float, __builtin_amdgcn_readlane(b, 0)) + __builtin_bit_cast(float, __builtin_amdgcn_readlane(b, 16)))
         + (__builtin_bit_cast(float, __builtin_amdgcn_readlane(b, 32)) + __builtin_bit_cast(float, __builtin_amdgcn_readlane(b, 48)));
}
#define LDS_WAIT() asm volatile("s_waitcnt lgkmcnt(0)" ::: "memory")
__device__ __forceinline__ float wave_max(float v) {
    v = fmaxf(v, dpp_f(v, 0)); v = fmaxf(v, dpp_f(v, 1)); v = fmaxf(v, dpp_f(v, 2)); v = fmaxf(v, dpp_f(v, 3));
    const int b = __builtin_bit_cast(int, v);
    return fmaxf(fmaxf(__builtin_bit_cast(float, __builtin_amdgcn_readlane(b, 0)), __builtin_bit_cast(float, __builtin_amdgcn_readlane(b, 16))),
                 fmaxf(__builtin_bit_cast(float, __builtin_amdgcn_readlane(b, 32)), __builtin_bit_cast(float, __builtin_amdgcn_readlane(b, 48))));
}

#define LDS_RD16_B128(r, addr, STRIDE) asm volatile( \
    "ds_read_b128 %0, %16\n\tds_read_b128 %1, %16 offset:%c17\n\tds_read_b128 %2, %16 offset:2*%c17\n\tds_read_b128 %3, %16 offset:3*%c17\n\t" \
    "ds_read_b128 %4, %16 offset:4*%c17\n\tds_read_b128 %5, %16 offset:5*%c17\n\tds_read_b128 %6, %16 offset:6*%c17\n\tds_read_b128 %7, %16 offset:7*%c17\n\t" \
    "ds_read_b128 %8, %16 offset:8*%c17\n\tds_read_b128 %9, %16 offset:9*%c17\n\tds_read_b128 %10, %16 offset:10*%c17\n\tds_read_b128 %11, %16 offset:11*%c17\n\t" \
    "ds_read_b128 %12, %16 offset:12*%c17\n\tds_read_b128 %13, %16 offset:13*%c17\n\tds_read_b128 %14, %16 offset:14*%c17\n\tds_read_b128 %15, %16 offset:15*%c17\n\ts_waitcnt lgkmcnt(0)" \
    : "=&v"(r[0]), "=&v"(r[1]), "=&v"(r[2]), "=&v"(r[3]), "=&v"(r[4]), "=&v"(r[5]), "=&v"(r[6]), "=&v"(r[7]), "=&v"(r[8]), "=&v"(r[9]), "=&v"(r[10]), "=&v"(r[11]), "=&v"(r[12]), "=&v"(r[13]), "=&v"(r[14]), "=&v"(r[15]) \
    : "v"(addr), "i"(STRIDE) : "memory")
#define LDS_ISSUE8_B128(r, addr, STRIDE) asm volatile( \
    "ds_read_b128 %0, %8\n\tds_read_b128 %1, %8 offset:%c9\n\tds_read_b128 %2, %8 offset:2*%c9\n\tds_read_b128 %3, %8 offset:3*%c9\n\t" \
    "ds_read_b128 %4, %8 offset:4*%c9\n\tds_read_b128 %5, %8 offset:5*%c9\n\tds_read_b128 %6, %8 offset:6*%c9\n\tds_read_b128 %7, %8 offset:7*%c9" \
    : "=&v"(r[0]), "=&v"(r[1]), "=&v"(r[2]), "=&v"(r[3]), "=&v"(r[4]), "=&v"(r[5]), "=&v"(r[6]), "=&v"(r[7]) \
    : "v"(addr), "i"(STRIDE) : "memory")
#define LDS_WAIT8(r, N) asm volatile("s_waitcnt lgkmcnt(" #N ")" : "+v"(r[0]), "+v"(r[1]), "+v"(r[2]), "+v"(r[3]), "+v"(r[4]), "+v"(r[5]), "+v"(r[6]), "+v"(r[7]) :: "memory")
#define LDS_RD11_B128(r, addr, STRIDE) asm volatile( \
    "ds_read_b128 %0, %11\n\tds_read_b128 %1, %11 offset:%c12\n\tds_read_b128 %2, %11 offset:2*%c12\n\tds_read_b128 %3, %11 offset:3*%c12\n\t" \
    "ds_read_b128 %4, %11 offset:4*%c12\n\tds_read_b128 %5, %11 offset:5*%c12\n\tds_read_b128 %6, %11 offset:6*%c12\n\tds_read_b128 %7, %11 offset:7*%c12\n\t" \
    "ds_read_b128 %8, %11 offset:8*%c12\n\tds_read_b128 %9, %11 offset:9*%c12\n\tds_read_b128 %10, %11 offset:10*%c12\n\ts_waitcnt lgkmcnt(0)" \
    : "=&v"(r[0]), "=&v"(r[1]), "=&v"(r[2]), "=&v"(r[3]), "=&v"(r[4]), "=&v"(r[5]), "=&v"(r[6]), "=&v"(r[7]), "=&v"(r[8]), "=&v"(r[9]), "=&v"(r[10]) \
    : "v"(addr), "i"(STRIDE) : "memory")
__device__ __forceinline__ int lane_id_asm() { int l; asm volatile("v_mbcnt_lo_u32_b32 %0, -1, 0\n\tv_mbcnt_hi_u32_b32 %0, -1, %0" : "=v"(l)); return l; }
__device__ __forceinline__ int tid_w(int wv) { return wv * 64 + lane_id_asm(); }
#define tid_l() tid_w(C.wv)

#define XB_TMO      128
#define XB_XCNT(j)  (256  + 64 * (j))
#define XB_XSUB(j)  (1280 + 64 * (j))
#define XB_XGEN(j)  (2304 + 64 * (j))
#define XB_TOP      3328
#define XB_TOPGEN   3392
#define XCD_BAR_WORDS 3456
#define XB_SPIN_CAP (1u << 24)
__device__ __forceinline__ unsigned xb_ld(unsigned* p)              { return __hip_atomic_load(p, __ATOMIC_RELAXED, __HIP_MEMORY_SCOPE_AGENT); }
__device__ __forceinline__ unsigned xb_add(unsigned* p, unsigned v) { return __hip_atomic_fetch_add(p, v, __ATOMIC_RELAXED, __HIP_MEMORY_SCOPE_AGENT); }
__device__ __forceinline__ unsigned xb_xcc_id() { return (unsigned)__builtin_amdgcn_s_getreg((3 << 11) | 20) & 0xFu; }
#define XB_SPIN(cond, bar) do { unsigned _sp = 0; while (cond) { __builtin_amdgcn_s_sleep(1); \
    if ((++_sp & 255u) == 0u) { if (xb_ld(&(bar)[XB_TMO])) break; if (_sp > XB_SPIN_CAP) { atomicAdd(&(bar)[XB_TMO], 1u); break; } } } } while (0)
struct XcdBarrier { unsigned* bar; unsigned x; volatile LAS unsigned* st; int wv; };
__device__ __forceinline__ XcdBarrier xcd_barrier_post(unsigned* bar, volatile LAS unsigned* st, int wv) {
    XcdBarrier b; b.bar = bar; b.x = xb_xcc_id(); b.st = st; b.wv = wv;
    if (tid_w(wv) == 0) (void)xb_add(&bar[XB_XCNT(b.x)], 1u);
    return b;
}
__device__ __forceinline__ void xcd_barrier_complete(unsigned* bar, unsigned x, unsigned& nloc, unsigned& nx) {
    const unsigned G = gridDim.x * gridDim.y * gridDim.z;
    unsigned sum, cnt, mine, sp = 0u;
    for (;;) {
        sum = 0u; cnt = 0u; mine = 0u;
#pragma unroll
        for (unsigned j = 0; j < 16; ++j) { const unsigned c = xb_ld(&bar[XB_XCNT(j)]); sum += c; cnt += (c > 0u) ? 1u : 0u; mine = (j == x) ? c : mine; }
        if (sum == G) break;
        __builtin_amdgcn_s_sleep(1);
        if ((++sp & 255u) == 0u) { if (xb_ld(&bar[XB_TMO])) break; if (sp > XB_SPIN_CAP) { atomicAdd(&bar[XB_TMO], 1u); break; } }
    }
    nloc = mine > 0u ? mine : 1u; nx = cnt > 0u ? cnt : 1u;
}
__device__ __forceinline__ void xcd_barrier(const XcdBarrier& b) {
    asm volatile("s_waitcnt vmcnt(0)" ::: "memory");
    __syncthreads();
    if (tid_w(b.wv) == 0) {
        unsigned* bar = b.bar;
        __builtin_amdgcn_s_waitcnt(0);
        unsigned nloc = b.st[0], nx = b.st[1];
        if (nloc == 0u) { xcd_barrier_complete(bar, b.x, nloc, nx); b.st[0] = nloc; b.st[1] = nx; }
        const unsigned old = xb_add(&bar[XB_XSUB(b.x)], 1u);
        const unsigned gen = old / nloc;
        if (old + 1u == (gen + 1u) * nloc) {
            __builtin_amdgcn_fence(__ATOMIC_RELEASE, "agent");
            asm volatile("s_waitcnt vmcnt(0)" ::: "memory");
            const unsigned og = xb_add(&bar[XB_TOP], 1u);
            const unsigned tg = og / nx;
            if (og + 1u == (tg + 1u) * nx) xb_add(&bar[XB_TOPGEN], 1u);
            else XB_SPIN(xb_ld(&bar[XB_TOPGEN]) == tg, bar);
            __builtin_amdgcn_fence(__ATOMIC_ACQUIRE, "agent");
            xb_add(&bar[XB_XGEN(b.x)], 1u);
            asm volatile("s_waitcnt vmcnt(0)" ::: "memory");
        } else {
            XB_SPIN(xb_ld(&bar[XB_XGEN(b.x)]) == gen, bar);
            __builtin_amdgcn_fence(__ATOMIC_ACQUIRE, "agent");
            asm volatile("s_waitcnt vmcnt(0)" ::: "memory");
        }
    }
    __syncthreads();
}

namespace pg {
constexpr int BM = 256, BK = 64, HALF = 128, HTB = HALF * BK * 2  , STAGE_BYTES = 8 * HTB, NXCD = 8, WGM = 8;
constexpr int TPE_FULL = SLOTS_E / BM;
__host__ __device__ __forceinline__ int lds_byte(int r, int c) { const int st = (r >> 4) * 2 + (c >> 5), rr = r & 15, cc = c & 31, ob = rr * 64 + cc * 2; return st * 1024 + (ob ^ (((ob >> 9) & 1) << 5)); }
__host__ __device__ __forceinline__ void stage_rc(int b, int& R, int& C) { const int st = b / 1024, sb = b % 1024, swz = sb ^ (((sb >> 9) & 1) << 5); R = (st >> 1) * 16 + swz / 64; C = (st & 1) * 32 + (swz % 64) / 2; }
__host__ __device__ __forceinline__ int perm32(int rho) { const int n = rho >> 4, i = rho & 15; return 8 * (i >> 2) + 4 * n + (i & 3); }
struct Unit { int m0, pn, e; };
struct GemmD { const char* A; const int* rowidx; const char* Bt; size_t bstride; int K; };
struct Order {
    int nM, nN, nwg, G, c, tpe;
    __device__ void init(int nM_, int nN_, int G_, int c_, int tpe_) { nM = nM_; nN = nN_; nwg = nM * nN; G = G_; c = c_; tpe = tpe_; }
    __device__ bool next(int i, Unit& u) const {
        const long L = (long)i * G + c; if (L >= nwg) return false;
        int wgid = (int)L; { const int q = nwg / NXCD, r = nwg % NXCD, xcd = wgid % NXCD, off = wgid / NXCD; wgid = (xcd < r ? xcd * (q + 1) : r * (q + 1) + (xcd - r) * q) + off; }
        const int nig = WGM * nN, gid = wgid / nig, fm = gid * WGM, gsz = (nM - fm) < WGM ? (nM - fm) : WGM;
        const int pm = fm + ((wgid % nig) % gsz); u.pn = (wgid % nig) / gsz;
        if (tpe > 0) { u.e = pm / tpe; u.m0 = (u.e * TPE_FULL + pm % tpe) * BM; } else { u.e = 0; u.m0 = pm * BM; }
        return true;
    }
};
template <class T> struct has_pre { template <class U> static constexpr bool test(decltype(U::HAS_PRE)*) { return U::HAS_PRE; } template <class U> static constexpr bool test(...) { return false; } static constexpr bool value = test<T>(nullptr); };
typedef int v4i32_t __attribute__((ext_vector_type(4)));
typedef int v8i32_t __attribute__((ext_vector_type(8)));
__device__ __forceinline__ v8i32_t cat8(const bf16x8 a, const bf16x8 b) { return __builtin_shufflevector(__builtin_bit_cast(v4i32_t, a), __builtin_bit_cast(v4i32_t, b), 0, 1, 2, 3, 4, 5, 6, 7); }
constexpr int SCALE_ONE = 0x7F7F7F7F, SCALE_W = 0x79797979;
template <bool I> struct acc_sel { typedef f32x4 type; };
template <> struct acc_sel<true> { typedef v4i32_t type; };
template <class Epi, bool GATHER, int QM = 0>
__device__ __forceinline__ void gemm_phase(LAS unsigned char* lds, const GemmD g, const Order& S, const Epi& E, int wv) {
    const int tid = tid_w(wv), wid = __builtin_amdgcn_readfirstlane(tid >> 6), lane = tid & 63, wr = wid >> 2, wc = wid & 3, fr = lane & 15, fq = lane >> 4;
    constexpr bool FP8 = (QM == 1), I8 = (QM == 2);
    typedef typename acc_sel<QM == 2>::type acc_t;
    const int K = g.K, nt = K / BK;
    int Rr[2], Cc[2]; unsigned voffB[2];
#pragma unroll
    for (int i = 0; i < 2; ++i) { int R, C; stage_rc(tid * 16 + i * 8192, R, C); Rr[i] = R; Cc[i] = C; const int Rb = Epi::PERM ? ((R & ~31) + perm32(R & 31)) : R; voffB[i] = (unsigned)(Rb * K + C) * 2u; }
    const unsigned kstep = (unsigned)(BK * 2);
    const size_t hstep = (size_t)HALF * K * 2;
    const unsigned ldsw = (unsigned)wid * 1024u;
    const int aoff = lds_byte(wr * 64 + fr, fq * 8), boff = lds_byte(wc * 32 + fr, fq * 8);
#define PG_SA(b, h) (((b) * 2 + (h)) * HTB)
#define PG_SB(b, h) ((4 + (b) * 2 + (h)) * HTB)
#define PG_STAGE_B(bufoff, gbase) do { _Pragma("unroll") for (int _i = 0; _i < 2; ++_i) \
        __builtin_amdgcn_global_load_lds((const unsigned*)((const char*)(gbase) + voffB[_i]), (LAS unsigned*)(lds + (bufoff) + ldsw + _i * 8192), 16, 0, 0); } while (0)
#define PG_STAGE_A(bufoff, OFFS, h, kb) do { _Pragma("unroll") for (int _i = 0; _i < 2; ++_i) \
        __builtin_amdgcn_global_load_lds((const unsigned*)(g.A + (size_t)(OFFS)[h][_i] + (kb)), (LAS unsigned*)(lds + (bufoff) + ldsw + _i * 8192), 16, 0, 0); } while (0)
#define PG_ROWOFF(DST, U) do { _Pragma("unroll") for (int _h = 0; _h < 2; ++_h) _Pragma("unroll") for (int _i = 0; _i < 2; ++_i) { int _r = (U).m0 + _h * HALF + Rr[_i]; if (GATHER) _r = g.rowidx[_r]; \
        (DST)[_h][_i] = (unsigned)(((size_t)_r * K + Cc[_i]) * 2); } } while (0)
#define PG_LDA(dst, b, h) do { _Pragma("unroll") for (int m = 0; m < 4; ++m) { if constexpr (FP8) { const v4i32_t _x0 = *(const LAS v4i32_t*)(lds + PG_SA(b, h) + aoff + m * 2048), _x1 = *(const LAS v4i32_t*)(lds + PG_SA(b, h) + aoff + m * 2048 + 1024); \
        dst##8[m] = __builtin_shufflevector(_x0, _x1, 0, 1, 2, 3, 4, 5, 6, 7); } else { _Pragma("unroll") for (int k = 0; k < 2; ++k) dst[m][k] = *(const LAS bf16x8*)(lds + PG_SA(b, h) + aoff + m * 2048 + k * 1024); } } } while (0)
#define PG_LDB(dst, b, h) do { _Pragma("unroll") for (int n = 0; n < 2; ++n) { if constexpr (FP8) { const v4i32_t _x0 = *(const LAS v4i32_t*)(lds + PG_SB(b, h) + boff + n * 2048), _x1 = *(const LAS v4i32_t*)(lds + PG_SB(b, h) + boff + n * 2048 + 1024); \
        dst##8[n] = __builtin_shufflevector(_x0, _x1, 0, 1, 2, 3, 4, 5, 6, 7); } else { _Pragma("unroll") for (int k = 0; k < 2; ++k) dst[n][k] = *(const LAS bf16x8*)(lds + PG_SB(b, h) + boff + n * 2048 + k * 1024); } } } while (0)
#define PG_MMA(ai, bj, At, Bt) do { __builtin_amdgcn_s_setprio(1); _Pragma("unroll") for (int m = 0; m < 4; ++m) _Pragma("unroll") for (int n = 0; n < 2; ++n) { \
        if constexpr (FP8) asm volatile("s_nop 1\n\tv_mfma_scale_f32_16x16x128_f8f6f4 %0, %1, %2, %0, %3, %4 op_sel_hi:[0,0,0]" : "+v"(acc[ai][bj][m][n]) : "v"(Bt##8[n]), "v"(At##8[m]), "v"(sc_w), "v"(sc_a)); \
        else if constexpr (I8) { _Pragma("unroll") for (int k = 0; k < 2; ++k) acc[ai][bj][m][n] = __builtin_amdgcn_mfma_i32_16x16x64_i8(__builtin_bit_cast(v4i32_t, Bt[n][k]), __builtin_bit_cast(v4i32_t, At[m][k]), acc[ai][bj][m][n], 0, 0, 0); } \
        else if constexpr (!I8 && !FP8) { _Pragma("unroll") for (int k = 0; k < 2; ++k) acc[ai][bj][m][n] = __builtin_amdgcn_mfma_f32_16x16x32_bf16(Bt[n][k], At[m][k], acc[ai][bj][m][n], 0, 0, 0); } } \
        __builtin_amdgcn_s_setprio(0); } while (0)
#define PG_WAIT_V(n) asm volatile("s_waitcnt vmcnt(" #n ")" ::: "memory")
#define PG_WAIT_L(n) asm volatile("s_waitcnt lgkmcnt(" #n ")" ::: "memory")
#define PG_BAR __builtin_amdgcn_s_barrier()
#define PG_SCHED __builtin_amdgcn_sched_barrier(0)
    Unit cur, nxt; int ui = 0;
    if (!S.next(0, cur)) return;
    acc_t acc[2][2][4][2];
#pragma unroll
    for (int a = 0; a < 2; ++a)
#pragma unroll
        for (int b = 0; b < 2; ++b)
#pragma unroll
            for (int m = 0; m < 4; ++m)
#pragma unroll
                for (int n = 0; n < 2; ++n) { acc[a][b][m][n] = acc_t{}; if constexpr (FP8) asm volatile("" : "+v"(acc[a][b][m][n])); }
    bf16x8 At[4][2], B0[2][2], B1[2][2]; v8i32_t At8[4], B08[2], B18[2];
    int sc_w = SCALE_W, sc_a = SCALE_ONE; if constexpr (FP8) { asm volatile("" : "+v"(sc_w), "+v"(sc_a)); }
    unsigned offA[2][2], offN[2][2];
    float epre[8] = {0.f, 0.f, 0.f, 0.f, 0.f, 0.f, 0.f, 0.f};
    if constexpr (has_pre<Epi>::value) E.pre(epre, cur, wr, fr);
    PG_ROWOFF(offA, cur);
    if (GATHER) PG_WAIT_V(0);
    const char* cB = g.Bt + (size_t)cur.e * g.bstride + (size_t)cur.pn * BM * K * 2;
    PG_STAGE_B(PG_SB(0, 0), cB); PG_STAGE_B(PG_SB(0, 1), cB + hstep); PG_STAGE_A(PG_SA(0, 0), offA, 0, 0u); PG_STAGE_A(PG_SA(0, 1), offA, 1, 0u);
    if (wr == 1) PG_BAR;
    PG_WAIT_V(2); PG_BAR;
    PG_STAGE_B(PG_SB(1, 0), cB + kstep); PG_STAGE_A(PG_SA(1, 0), offA, 0, kstep); PG_STAGE_B(PG_SB(1, 1), cB + hstep + kstep);
    PG_WAIT_V(6); PG_BAR;
    for (;;) {
        const bool has_next = S.next(ui + 1, nxt);
        const char* nB = has_next ? g.Bt + (size_t)nxt.e * g.bstride + (size_t)nxt.pn * BM * K * 2 : cB;
        if (has_next) { PG_ROWOFF(offN, nxt); if (GATHER) PG_WAIT_V(0); }
        else {
#pragma unroll
            for (int h = 0; h < 2; ++h)
#pragma unroll
                for (int i = 0; i < 2; ++i) offN[h][i] = offA[h][i]; }
        for (int t = 0; t < nt; t += 2) {
            const bool last = (t == nt - 2);
            unsigned o2[2][2];
#pragma unroll
            for (int h = 0; h < 2; ++h)
#pragma unroll
                for (int i = 0; i < 2; ++i) o2[h][i] = last ? offN[h][i] : offA[h][i];
            const unsigned ka1 = (unsigned)(t + 1) * kstep, ka2 = last ? 0u : (unsigned)(t + 2) * kstep, ka3 = ka2 + kstep;
            const char* b2 = last ? nB : cB + (size_t)(t + 2) * kstep; const char* b3 = b2 + kstep;
            PG_LDB(B0, 0, 0); PG_LDB(B1, 0, 1); PG_SCHED; PG_LDA(At, 0, 0); PG_STAGE_A(PG_SA(1, 1), offA, 1, ka1);
            PG_WAIT_V(8); PG_WAIT_L(0); PG_BAR; PG_MMA(0, 0, At, B0); PG_MMA(0, 1, At, B1); PG_BAR; PG_SCHED;
            PG_LDA(At, 0, 1); PG_STAGE_B(PG_SB(0, 0), b2); PG_STAGE_B(PG_SB(0, 1), b2 + hstep); PG_STAGE_A(PG_SA(0, 0), o2, 0, ka2);
            PG_WAIT_V(8); PG_WAIT_L(0); PG_BAR; PG_MMA(1, 0, At, B0); PG_MMA(1, 1, At, B1); PG_BAR; PG_SCHED;
            PG_LDB(B0, 1, 0); PG_LDB(B1, 1, 1); PG_SCHED; PG_LDA(At, 1, 0); PG_STAGE_A(PG_SA(0, 1), o2, 1, ka2);
            PG_WAIT_V(8); PG_WAIT_L(0); PG_BAR; PG_MMA(0, 0, At, B0); PG_MMA(0, 1, At, B1); PG_BAR; PG_SCHED;
            PG_LDA(At, 1, 1); PG_STAGE_B(PG_SB(1, 0), b3); PG_STAGE_B(PG_SB(1, 1), b3 + hstep); PG_STAGE_A(PG_SA(1, 0), o2, 0, ka3);
            PG_WAIT_V(8); PG_WAIT_L(0); PG_BAR; PG_MMA(1, 0, At, B0); PG_MMA(1, 1, At, B1); PG_BAR; PG_SCHED;
        }
        if (wr == 0) PG_BAR;
        if constexpr (FP8) asm volatile("s_nop 15\n\ts_nop 7" ::: "memory");
        if constexpr (has_pre<Epi>::value) { E(acc, cur, wr, wc, fr, fq, epre); if (has_next) E.pre(epre, nxt, wr, fr); }
        else E(acc, cur, wr, wc, fr, fq);
        if (!has_next) break;
#pragma unroll
        for (int a = 0; a < 2; ++a)
#pragma unroll
            for (int b = 0; b < 2; ++b)
#pragma unroll
                for (int m = 0; m < 4; ++m)
#pragma unroll
                    for (int n = 0; n < 2; ++n) { acc[a][b][m][n] = acc_t{}; if constexpr (FP8) asm volatile("" : "+v"(acc[a][b][m][n])); }
        cur = nxt; cB = nB; ++ui;
#pragma unroll
        for (int h = 0; h < 2; ++h)
#pragma unroll
            for (int i = 0; i < 2; ++i) offA[h][i] = offN[h][i];
        if (wr == 1) PG_BAR;
    }
    PG_WAIT_V(0);
    PG_BAR;
#undef PG_SA
#undef PG_SB
#undef PG_STAGE_A
#undef PG_STAGE_B
#undef PG_ROWOFF
#undef PG_LDA
#undef PG_LDB
#undef PG_MMA
#undef PG_WAIT_V
#undef PG_WAIT_L
#undef PG_BAR
#undef PG_SCHED
}
struct EpiP {
    static constexpr bool PERM = true;
    bf16_t* P; const float* tab; const float* hxs; const float* wss;
    __device__ __forceinline__ void operator()(const v4i32_t (&acc)[2][2][4][2], const Unit& u, int wr, int wc, int fr, int fq) const {
        const bool lat = u.m0 < RL;
        float rs[8];
#pragma unroll
        for (int ai = 0; ai < 2; ++ai)
#pragma unroll
            for (int m = 0; m < 4; ++m) rs[ai * 4 + m] = hxs[u.m0 + ai * HALF + wr * 64 + m * 16 + fr];
        float cs; { const int ln = fr + 16 * fq; cs = 4.0f * sqrtf(wave_sum((wss[ln] + wss[ln + 64]) + (wss[ln + 128] + wss[ln + 192])) * (1.0f / ((float)D * (float)PROJ))) * (1.0f / 127.0f); }
#pragma unroll
        for (int bj = 0; bj < 2; ++bj) {
            const int ct = u.pn * BM + bj * HALF;
            const int c0 = ct + wc * 32 + 8 * fq;
            const int kind = ct < C_VA ? 1 : ((ct >= C_QD && ct < C_VD) ? 2 : 0);
            const float sc = ct < C_KA ? QSCALE_A : ((ct >= C_QD && ct < C_KD) ? QSCALE_D : 1.0f);
#pragma unroll
            for (int ai = 0; ai < 2; ++ai)
#pragma unroll
                for (int m = 0; m < 4; ++m) {
                    const int row = u.m0 + ai * HALF + wr * 64 + m * 16 + fr;
                    f32x4 v0, v1; { const v4i32_t i0 = acc[ai][bj][m][0], i1 = acc[ai][bj][m][1]; const float r_ = rs[ai * 4 + m];
#pragma unroll
                      for (int k = 0; k < 4; ++k) { v0[k] = (float)i0[k] * (r_ * cs); v1[k] = (float)i1[k] * (r_ * cs); } }
                    if (kind != 0 && lat) {
                        const int pos = row % SEQ, gr = pos / GRID_W, gc = pos % GRID_W; const float* t;
                        if (kind == 1) { const int p = c0 & 63, grp = p >> 5, i0 = (p & 31) >> 1; t = tab + (grp ? T_ACOL + gc * 32 : T_AROW + gr * 32) + i0 * 2; }
                        else { const int p = c0 & 31, grp = p >> 4, i0 = (p & 15) >> 1; t = tab + (grp ? T_DCOL + gc * 16 : T_DROW + gr * 16) + i0 * 2; }
                        const f32x4 t0 = *(const f32x4*)t, t1 = *(const f32x4*)(t + 4);
                        v0 = (f32x4){v0[0] * t0[0] - v0[1] * t0[1], v0[1] * t0[0] + v0[0] * t0[1], v0[2] * t0[2] - v0[3] * t0[3], v0[3] * t0[2] + v0[2] * t0[3]};
                        v1 = (f32x4){v1[0] * t1[0] - v1[1] * t1[1], v1[1] * t1[0] + v1[0] * t1[1], v1[2] * t1[2] - v1[3] * t1[3], v1[3] * t1[2] + v1[2] * t1[3]};
                    }
                    v0 = v0 * sc; v1 = v1 * sc;
                    u32x4 w; w.x = cvt_pk_bf16(v0[0], v0[1]); w.y = cvt_pk_bf16(v0[2], v0[3]); w.z = cvt_pk_bf16(v1[0], v1[1]); w.w = cvt_pk_bf16(v1[2], v1[3]);
                    *(u32x4*)(P + (size_t)row * PROJ + c0) = w;
                }
        }
    }
};
struct EpiX {
    static constexpr bool PERM = true;
    bf16_t* XB; const float* modl; float gscale;
    __device__ __forceinline__ void operator()(const f32x4 (&acc)[2][2][4][2], const Unit& u, int wr, int wc, int fr, int fq) const {
        const int b = u.m0 < RL ? u.m0 / SEQ : NB; const float* g1 = modl + (size_t)b * 6 * D + M_G1 + u.pn * BM + wc * 32 + 8 * fq;
        bf16_t* x0 = XB + (size_t)(u.m0 + wr * 64 + fr) * D + u.pn * BM + wc * 32 + 8 * fq;
        u32x4 xv[2][4][2];
#pragma unroll
        for (int ai = 0; ai < 2; ++ai)
#pragma unroll
            for (int m = 0; m < 4; ++m)
#pragma unroll
                for (int bj = 0; bj < 2; ++bj) xv[ai][m][bj] = *(const u32x4*)(x0 + (size_t)(ai * HALF + m * 16) * D + bj * HALF);
        f32x4 gv[2][2];
#pragma unroll
        for (int bj = 0; bj < 2; ++bj)
#pragma unroll
            for (int n = 0; n < 2; ++n) gv[bj][n] = *(const f32x4*)(g1 + bj * HALF + 4 * n) * gscale;
#pragma unroll
        for (int ai = 0; ai < 2; ++ai)
#pragma unroll
            for (int m = 0; m < 4; ++m)
#pragma unroll
                for (int bj = 0; bj < 2; ++bj) { const u32x4 x = xv[ai][m][bj];
                    const f32x4 a0 = acc[ai][bj][m][0] * gv[bj][0], a1 = acc[ai][bj][m][1] * gv[bj][1]; u32x4 w;
                    w.x = cvt_pk_bf16(__builtin_bit_cast(float, x.x << 16) + a0[0], __builtin_bit_cast(float, x.x & 0xffff0000u) + a0[1]);
                    w.y = cvt_pk_bf16(__builtin_bit_cast(float, x.y << 16) + a0[2], __builtin_bit_cast(float, x.y & 0xffff0000u) + a0[3]);
                    w.z = cvt_pk_bf16(__builtin_bit_cast(float, x.z << 16) + a1[0], __builtin_bit_cast(float, x.z & 0xffff0000u) + a1[1]);
                    w.w = cvt_pk_bf16(__builtin_bit_cast(float, x.w << 16) + a1[2], __builtin_bit_cast(float, x.w & 0xffff0000u) + a1[3]);
                    *(u32x4*)(x0 + (size_t)(ai * HALF + m * 16) * D + bj * HALF) = w; }
    }
};
__device__ __forceinline__ float silu_fast(float v) { return v * __builtin_amdgcn_rcpf(1.0f + __builtin_amdgcn_exp2f(-LOG2E * v)); }
__device__ __forceinline__ unsigned pk4_fp8(float a, float b, float c, float d) { int w = 0; w = __builtin_amdgcn_cvt_pk_fp8_f32(a, b, w, false); w = __builtin_amdgcn_cvt_pk_fp8_f32(c, d, w, true); return (unsigned)w; }
struct EpiH {
    static constexpr bool PERM = true;
    unsigned char* H;
    __device__ __forceinline__ void operator()(const f32x4 (&acc)[2][2][4][2], const Unit& u, int wr, int wc, int fr, int fq) const {
        const int hc = u.pn * HALF + wc * 32 + 8 * fq;
#pragma unroll
        for (int ai = 0; ai < 2; ++ai)
#pragma unroll
            for (int m = 0; m < 4; ++m) {
                const int row = u.m0 + ai * HALF + wr * 64 + m * 16 + fr;
                const f32x4 g0 = acc[ai][0][m][0], g1 = acc[ai][0][m][1], u0 = acc[ai][1][m][0], u1 = acc[ai][1][m][1];
                u32x2 w;
                w.x = pk4_fp8(silu_fast(g0[0]) * u0[0], silu_fast(g0[1]) * u0[1], silu_fast(g0[2]) * u0[2], silu_fast(g0[3]) * u0[3]);
                w.y = pk4_fp8(silu_fast(g1[0]) * u1[0], silu_fast(g1[1]) * u1[1], silu_fast(g1[2]) * u1[2], silu_fast(g1[3]) * u1[3]);
                *(u32x2*)(H + (size_t)row * FF + hc) = w;
            }
    }
};
struct EpiY {
    static constexpr bool PERM = true, HAS_PRE = true;
    unsigned char* Y; const float* gate;
    __device__ __forceinline__ void pre(float (&gv)[8], const Unit& u, int wr, int fr) const {
#pragma unroll
        for (int ai = 0; ai < 2; ++ai)
#pragma unroll
            for (int m = 0; m < 4; ++m) gv[ai * 4 + m] = gate[u.m0 + ai * HALF + wr * 64 + m * 16 + fr];
    }
    __device__ __forceinline__ void operator()(const f32x4 (&acc)[2][2][4][2], const Unit& u, int wr, int wc, int fr, int fq, const float (&gv)[8]) const {
#pragma unroll
        for (int ai = 0; ai < 2; ++ai)
#pragma unroll
            for (int m = 0; m < 4; ++m) {
                const int row = u.m0 + ai * HALF + wr * 64 + m * 16 + fr; const float gt = gv[ai * 4 + m] * 64.0f;
#pragma unroll
                for (int bj = 0; bj < 2; ++bj) {
                    const f32x4 v0 = acc[ai][bj][m][0] * gt, v1 = acc[ai][bj][m][1] * gt;
                    u32x2 w; w.x = pk4_fp8(v0[0], v0[1], v0[2], v0[3]); w.y = pk4_fp8(v1[0], v1[1], v1[2], v1[3]);
                    *(u32x2*)(Y + (size_t)row * D + u.pn * BM + bj * HALF + wc * 32 + 8 * fq) = w;
                }
            }
    }
};
}

struct Args { const float* in[19]; float* out; unsigned char* ws; int ph_lo, ph_hi; };
struct Ctx {
    Ptrs p; LAS unsigned char* lds;
    float *tab, *mod, *aff, *gate, *xc, *xl; int *sel, *tokslot;
    bf16_t *win, *wout, *P, *H, *Y, *MIX, *HX2, *HX, *XB; float* TMP; int wv;
};
template <class Dest>
__device__ __forceinline__ void transpose_item_fp8(const float* W, int K, int N, unsigned char* WT, LAS float* scr, int item, int lane, Dest dest) {
    const int nblk = N / 32, kb = item / nblk, nb = item % nblk, k0 = 64 * kb, n0 = 32 * nb;
    float wv[32];
#pragma unroll
    for (int i = 0; i < 32; ++i) wv[i] = W[(size_t)(k0 + 2 * i + (lane >> 5)) * N + n0 + (lane & 31)];
#pragma unroll
    for (int i = 0; i < 32; ++i) { const int kk = 2 * i + (lane >> 5); scr[kk * 33 + (lane & 31)] = wv[i] * 64.0f; }
    LDS_WAIT(); asm volatile("" ::: "memory");
    const int c = lane & 7;
#pragma unroll
    for (int j = 0; j < 4; ++j) { const int n = (lane >> 3) + 8 * j; const LAS float* s = scr + (8 * c) * 33 + n;
        u32x2 o; o.x = pg::pk4_fp8(s[0 * 33], s[1 * 33], s[2 * 33], s[3 * 33]); o.y = pg::pk4_fp8(s[4 * 33], s[5 * 33], s[6 * 33], s[7 * 33]);
        *(u32x2*)(WT + (size_t)dest(n0 + n) * K + k0 + 8 * c) = o; }
    LDS_WAIT(); asm volatile("" ::: "memory");
}
template <class Dest>
__device__ __forceinline__ void transpose_item(const float* W, int K, int N, bf16_t* WT, LAS float* scr, int item, int lane, Dest dest) {
    const int nblk = N / 32, kb = item / nblk, nb = item % nblk, k0 = 64 * kb, n0 = 32 * nb;
#pragma unroll 8
    for (int i = 0; i < 32; ++i) { const int kk = 2 * i + (lane >> 5); scr[kk * 33 + (lane & 31)] = W[(size_t)(k0 + kk) * N + n0 + (lane & 31)]; }
    LDS_WAIT(); asm volatile("" ::: "memory");
    const int c = lane & 7;
#pragma unroll
    for (int j = 0; j < 4; ++j) { const int n = (lane >> 3) + 8 * j; const LAS float* s = scr + (8 * c) * 33 + n;
        u32x4 o; o.x = cvt_pk_bf16(s[0 * 33], s[1 * 33]); o.y = cvt_pk_bf16(s[2 * 33], s[3 * 33]); o.z = cvt_pk_bf16(s[4 * 33], s[5 * 33]); o.w = cvt_pk_bf16(s[6 * 33], s[7 * 33]);
        *(u32x4*)(WT + (size_t)dest(n0 + n) * K + k0 + 8 * c) = o; }
    LDS_WAIT(); asm volatile("" ::: "memory");
}
HD int invA(int q) { const int g = q / 32, r = q % 32; return 32 * g + (r < 16 ? 2 * r : 2 * (r - 16) + 1); }
HD int invD(int q) { const int g = q / 16, r = q % 16; return 16 * g + (r < 8 ? 2 * r : 2 * (r - 8) + 1); }
HD int inproj_dst_row(int nl) {
    if (nl < C_VA) return (nl / 64) * 64 + invA(nl % 64);
    if (nl >= C_QD && nl < C_VD) return (nl / 32) * 32 + invD(nl % 32);
    return nl;
}
struct DestIn { __device__ int operator()(int n) const { return inproj_dst_row(n); } };
struct DestId { __device__ int operator()(int n) const { return n; } };
struct DestGU { int up; __device__ int operator()(int n) const { return (n / 128) * 256 + up * 128 + n % 128; } };

__device__ __forceinline__ void phase_prologue(const Ctx& C) {
    const int tid = tid_l(), lane = tid & 63, wave = __builtin_amdgcn_readfirstlane(tid >> 6), gw = blockIdx.x * NWV + wave, NGW = gridDim.x * NWV; (void)lane; (void)gw; (void)NGW;
    for (long g = (long)tid * gridDim.x + blockIdx.x; g < (long)(NROWS + 64) * 24; g += (long)gridDim.x * NT) {
        const int pos = (int)(g / 24), f = (int)(g % 24);
        const float inv = f < 16 ? exp2f(-(float)f * (13.287712379549449f / 16.0f)) : exp2f(-(float)(f - 16) * (13.287712379549449f / 8.0f));
        const bool isrow = pos < NROWS; const int p = isrow ? pos : pos - NROWS;
        const float ang = (float)p * inv; float sn, cs; sincosf(ang, &sn, &cs);
        const int idx = f < 16 ? (isrow ? T_AROW : T_ACOL) + (p * 16 + f) * 2 : (isrow ? T_DROW : T_DCOL) + (p * 8 + (f - 16)) * 2;
        C.tab[idx] = cs; C.tab[idx + 1] = sn;
    }
    LAS float* sl = (LAS float*)C.lds;
    for (int i = tid; i < (NB + 1) * D; i += NT) { const int b = i / D, k = i % D; sl[i] = silu_f(b < NB ? C.p.c[b * D + k] : C.p.c_ctx[k]); }
    __syncthreads();
    constexpr int NBR = NB + 1, BG = 11, NBG = NBR / BG; static_assert(NBG * BG == NBR, "adaLN rows reduced in groups of 11");
    LAS float* pbuf = (LAS float*)(C.lds + NBR * D * 4);
    static_assert(NBR * D * 4 + 16 * BG * 32 * 4 <= LDS_MISC, "prologue LDS");
    for (int task = blockIdx.x; task < DEPTH * 6 * D / 32; task += gridDim.x) {
        const int jg = task * 32, l = jg / (6 * D), j0 = jg % (6 * D), c = lane & 31, half = lane >> 5, kb = 128 * wave + 64 * half;
        f32x2_t acc2[NBR];
#pragma unroll
        for (int b = 0; b < NBR; ++b) acc2[b] = (f32x2_t){0.f, 0.f};
        const float* w = C.p.w_ada + ((size_t)l * D + kb) * 6 * D + j0 + c; const LAS float* s0 = sl + kb;
        for (int kk = 0; kk < 64; kk += 4) {
            const f32x2_t w01 = (f32x2_t){w[(size_t)kk * 6 * D], w[(size_t)(kk + 1) * 6 * D]}, w23 = (f32x2_t){w[(size_t)(kk + 2) * 6 * D], w[(size_t)(kk + 3) * 6 * D]};
#pragma unroll
            for (int rr = 0; rr < NBG; ++rr) { f32x4 sv[BG]; const unsigned sa = (unsigned)(size_t)(s0 + rr * BG * D + kk);
                LDS_RD11_B128(sv, sa, D * 4);
#pragma unroll
                for (int bb = 0; bb < BG; ++bb) { acc2[rr * BG + bb] = __builtin_elementwise_fma((f32x2_t){sv[bb][0], sv[bb][1]}, w01, acc2[rr * BG + bb]);
                    acc2[rr * BG + bb] = __builtin_elementwise_fma((f32x2_t){sv[bb][2], sv[bb][3]}, w23, acc2[rr * BG + bb]); } }
        }
        float acc[NBR];
#pragma unroll
        for (int b = 0; b < NBR; ++b) acc[b] = acc2[b][0] + acc2[b][1];
#pragma unroll
        for (int rr = 0; rr < NBG; ++rr) {
#pragma unroll
            for (int bb = 0; bb < BG; ++bb) pbuf[((wave * 2 + half) * BG + bb) * 32 + c] = acc[rr * BG + bb];
            __syncthreads();
            if (tid < BG * 32) { const int bb = tid / 32, cc = tid % 32; float s = 0.f;
#pragma unroll
                for (int p = 0; p < 16; ++p) s += pbuf[(p * BG + bb) * 32 + cc];
                C.mod[((size_t)l * NBR + rr * BG + bb) * 6 * D + j0 + cc] = s + C.p.b_ada[l * 6 * D + j0 + cc]; }
            __syncthreads();
        }
    }
    __syncthreads();
    LAS float* scr = (LAS float*)(C.lds + wave * 16384);
    constexpr int I_OUT = (D / 64) * (D / 32);
    for (int it = gw; it < DEPTH * I_OUT; it += NGW) { const int l = it / I_OUT, r = it % I_OUT;
        transpose_item(C.p.w_out + (size_t)l * D * D, D, D, C.wout + (size_t)l * D * D, scr, r, lane, DestId{}); }
    float* wss = (float*)(C.p.ws + WS_CTL + CTL_WINMAX);
    LAS float* pm = (LAS float*)(C.lds + 8 * 16384);
    __syncthreads();
    for (int slot = blockIdx.x; slot < DEPTH * 256; slot += gridDim.x) {
        const int l = slot / 256, s = slot % 256; constexpr int PER = D * PROJ / 256;
        const float* w = C.p.w_in + (size_t)l * D * PROJ + (size_t)s * PER; float acc = 0.f;
        for (int i = tid; i < PER / 4; i += NT) { const f32x4 v = *(const f32x4*)(w + 4 * i); acc += (v[0] * v[0] + v[1] * v[1]) + (v[2] * v[2] + v[3] * v[3]); }
        acc = wave_sum(acc); if (lane == 0) pm[wave] = acc;
        __syncthreads();
        if (tid == 0) { float t = 0.f; for (int q = 0; q < NWV; ++q) t += pm[q]; wss[slot] = t; }
        __syncthreads();
    }
    __syncthreads();
}
__device__ __forceinline__ float win_amax(const unsigned char* ws, int l, int lane) {
    const float* wss = (const float*)(ws + WS_CTL + CTL_WINMAX) + l * 256;
    const float t = wave_sum((wss[lane] + wss[lane + 64]) + (wss[lane + 128] + wss[lane + 192]));
    return 4.0f * sqrtf(t * (1.0f / ((float)D * (float)PROJ)));
}
__device__ __forceinline__ void phase_prologue_b(const Ctx& C) {
    const int tid = tid_l(), lane = tid & 63, wave = __builtin_amdgcn_readfirstlane(tid >> 6), gw = blockIdx.x * NWV + wave, NGW = gridDim.x * NWV;
    LAS float* scr = (LAS float*)(C.lds + wave * 16384);
    constexpr int I_IN = (D / 64) * (PROJ / 32);
    for (int it = gw; it < DEPTH * I_IN; it += NGW) {
        const int l = it / I_IN, item = it % I_IN, nblk = PROJ / 32, kb = item / nblk, nb = item % nblk, k0 = 64 * kb, n0 = 32 * nb;
        const float* W = C.p.w_in + (size_t)l * D * PROJ; signed char* WT = (signed char*)C.win + (size_t)l * PROJ * D;
        { const int nl = n0 + (lane & 31); const float am = win_amax(C.p.ws, l, lane); const float inv = am > 0.f ? 127.0f / am : 0.f;
#pragma unroll 8
          for (int i = 0; i < 32; ++i) { const int kk = 2 * i + (lane >> 5); scr[kk * 33 + (lane & 31)] = W[(size_t)(k0 + kk) * PROJ + nl] * inv; } }
        LDS_WAIT(); asm volatile("" ::: "memory");
        const int c = lane & 7;
#pragma unroll
        for (int j = 0; j < 4; ++j) { const int n = (lane >> 3) + 8 * j; const LAS float* s = scr + (8 * c) * 33 + n; unsigned lo = 0u, hi = 0u;
#pragma unroll
            for (int q = 0; q < 4; ++q) { lo |= ((unsigned)__float2int_rn(fminf(fmaxf(s[q * 33], -127.f), 127.f)) & 0xffu) << (8 * q); hi |= ((unsigned)__float2int_rn(fminf(fmaxf(s[(4 + q) * 33], -127.f), 127.f)) & 0xffu) << (8 * q); }
            *(u32x2*)(WT + (size_t)inproj_dst_row(n0 + n) * D + k0 + 8 * c) = (u32x2){lo, hi}; }
        LDS_WAIT(); asm volatile("" ::: "memory");
    }
    __syncthreads();
}
constexpr int CVT_ITEMS = 3 * NE * (D / 64) * (FF / 32);
struct CvtItem { const float* src; unsigned char* dst; int mat, n0; };
__device__ __forceinline__ CvtItem cvt_decode(const Ctx& C, int l, int it, int lane) {
    constexpr int I_E = (D / 64) * (FF / 32), NBLK = FF / 32;
    const int mat = it / (NE * I_E), e = (it / I_E) % NE, r = it % I_E, kb = r / NBLK, nb = r % NBLK, k0 = 64 * kb, n0 = 32 * nb;
    const size_t wo = ((size_t)l * NE + e) * D * FF;
    const float* W = mat == 0 ? C.p.w_gate + wo : mat == 1 ? C.p.w_up + wo : C.p.w_down + wo;
    unsigned char* wgu = C.p.ws + WS_WGU + (size_t)(l & 1) * NE * 2 * FF * D; unsigned char* wd = C.p.ws + WS_WD + (size_t)(l & 1) * NE * D * FF;
    CvtItem c; c.src = W + (size_t)(k0 + (lane >> 5)) * FF + n0 + (lane & 31); c.dst = (mat == 2 ? wd + (size_t)e * D * FF : wgu + (size_t)e * 2 * FF * D) + k0; c.mat = mat; c.n0 = n0;
    return c;
}
__device__ __forceinline__ void phase_cvt_experts(const Ctx& C, int l, int it0, int it1, int w, int nw) {
    static_assert(D == FF, "expert matrices are square");
    const int tid = tid_l(), lane = tid & 63, wave = __builtin_amdgcn_readfirstlane(tid >> 6);
    LAS float* scr = (LAS float*)(C.lds + wave * 16384);
    float ra[32], rb[32];
    auto issue = [&](float (&r)[32], const CvtItem& c) {
#pragma unroll
        for (int i = 0; i < 32; ++i) r[i] = c.src[(size_t)(2 * i) * FF]; };
    auto process = [&](float (&r)[32], const CvtItem& cur) {
#pragma unroll
        for (int i = 0; i < 32; ++i) { const int kk = 2 * i + (lane >> 5); scr[kk * 33 + (lane & 31)] = r[i] * 64.0f; }
        LDS_WAIT(); asm volatile("" ::: "memory");
        const int c = lane & 7;
#pragma unroll
        for (int j = 0; j < 4; ++j) { const int n = cur.n0 + (lane >> 3) + 8 * j; const LAS float* sp = scr + (8 * c) * 33 + (lane >> 3) + 8 * j;
            u32x2 o; o.x = pg::pk4_fp8(sp[0 * 33], sp[1 * 33], sp[2 * 33], sp[3 * 33]); o.y = pg::pk4_fp8(sp[4 * 33], sp[5 * 33], sp[6 * 33], sp[7 * 33]);
            const int drow = cur.mat == 2 ? n : (n / 128) * 256 + cur.mat * 128 + n % 128;
            *(u32x2*)(cur.dst + (size_t)drow * D + 8 * c) = o; }
        LDS_WAIT(); asm volatile("" ::: "memory"); };
    int it = it0 + w;
    CvtItem ca{}, cb{};
    if (it < it1) { ca = cvt_decode(C, l, it, lane); issue(ra, ca); }
    while (it < it1) {
        cb = cvt_decode(C, l, it + nw < it1 ? it + nw : it, lane); issue(rb, cb);
        process(ra, ca);
        it += nw; if (it >= it1) break;
        ca = cvt_decode(C, l, it + nw < it1 ? it + nw : it, lane); issue(ra, ca);
        process(rb, cb);
        it += nw;
    }
    __syncthreads();
}
__device__ __forceinline__ void yf8_add(f32x4& a, const unsigned w, const float wf) {
    const f32x2_t lo = __builtin_amdgcn_cvt_pk_f32_fp8((int)w, false), hi = __builtin_amdgcn_cvt_pk_f32_fp8((int)w, true);
    a[0] += wf * lo[0]; a[1] += wf * lo[1]; a[2] += wf * hi[0]; a[3] += wf * hi[1];
}
template <bool FINAL, bool SRCF32>
__device__ __forceinline__ void phase_rowA(const Ctx& C, int l, float gscale = 1.0f) {
    const int tid = tid_l(), lane = tid & 63, wave = __builtin_amdgcn_readfirstlane(tid >> 6), gw = blockIdx.x * NWV + wave, NGW = gridDim.x * NWV;
    const int nrows = FINAL ? RL : RALL;
    const int per = (nrows + NGW - 1) / NGW, r0 = gw * per, r1 = (r0 + per < nrows) ? r0 + per : nrows;
#define RA_LOADX(dst, row) do { if (SRCF32) { const float* _s = ((row) < RL ? C.p.x + (size_t)(row) * D : C.p.ctx + (size_t)((row) - RL) * D); _Pragma("unroll") for (int j = 0; j < 4; ++j) dst[j] = __builtin_bit_cast(u32x4, *(const f32x4*)(_s + 4 * lane + 256 * j)); } \
        else { const bf16_t* _s = C.XB + (size_t)(row) * D + 4 * lane; _Pragma("unroll") for (int j = 0; j < 4; ++j) { const u32x2 _w = *(const u32x2*)(_s + 256 * j); dst[j] = (u32x4){_w.x, _w.y, 0u, 0u}; } } } while (0)
#define RA_LOADTS(dst, row) do { dst = (l > 0 && lane < NE) ? C.tokslot[(size_t)(row) * NE + lane] : -1; } while (0)
#define RA_ISSUEY(YY, WF, MSK, ts) do { unsigned _m = (unsigned)__ballot((ts) >= 0); int _s0 = 0, _s1, _s2, _s3; WF[0] = WF[1] = WF[2] = WF[3] = 0.f; \
        if (_m) { _s0 = __builtin_amdgcn_readlane((ts), __builtin_ctz(_m)); _m &= _m - 1; WF[0] = 1.f; } _s1 = _s2 = _s3 = _s0; \
        if (_m) { _s1 = __builtin_amdgcn_readlane((ts), __builtin_ctz(_m)); _m &= _m - 1; WF[1] = 1.f; } \
        if (_m) { _s2 = __builtin_amdgcn_readlane((ts), __builtin_ctz(_m)); _m &= _m - 1; WF[2] = 1.f; } \
        if (_m) { _s3 = __builtin_amdgcn_readlane((ts), __builtin_ctz(_m)); _m &= _m - 1; WF[3] = 1.f; } MSK = _m; \
        _Pragma("unroll") for (int j = 0; j < 4; ++j) { YY[0][j] = *(const unsigned*)(Yb + (size_t)_s0 * D + 4 * lane + 256 * j); YY[1][j] = *(const unsigned*)(Yb + (size_t)_s1 * D + 4 * lane + 256 * j); \
            YY[2][j] = *(const unsigned*)(Yb + (size_t)_s2 * D + 4 * lane + 256 * j); YY[3][j] = *(const unsigned*)(Yb + (size_t)_s3 * D + 4 * lane + 256 * j); } } while (0)
    const unsigned char* Yb = (const unsigned char*)C.Y;
    u32x4 xc[4], xn[4], x2[4]; int tsc = -1, tsn = -1, ts2 = -1; unsigned yc[4][4], yn[4][4]; float wc_[4], wn_[4]; unsigned mc = 0u, mn = 0u;
    f32x4 A[4], S[4], G[4]; int bcur = -1;
#pragma unroll
    for (int j = 0; j < 4; ++j) { xc[j] = xn[j] = x2[j] = (u32x4){0u, 0u, 0u, 0u}; A[j] = S[j] = G[j] = (f32x4){0.f, 0.f, 0.f, 0.f}; }
#pragma unroll
    for (int i = 0; i < 4; ++i) { wc_[i] = wn_[i] = 0.f;
#pragma unroll
        for (int j = 0; j < 4; ++j) yc[i][j] = yn[i][j] = 0u; }
    if (r0 < r1) { RA_LOADTS(tsc, r0); RA_LOADX(xc, r0); if (l > 0) RA_ISSUEY(yc, wc_, mc, tsc); }
    if (r0 + 1 < r1) { RA_LOADTS(tsn, r0 + 1); RA_LOADX(xn, r0 + 1); }
    for (int row = r0; row < r1; ++row) {
        if (l > 0 && row + 1 < r1) RA_ISSUEY(yn, wn_, mn, tsn);
        if (row + 2 < r1) { RA_LOADTS(ts2, row + 2); RA_LOADX(x2, row + 2); }
        const int b = row_batch(row);
        if (b != bcur) { bcur = b;
            if (FINAL) {
#pragma unroll
                for (int j = 0; j < 4; ++j) A[j] = *(const f32x4*)(C.p.norm_final + 4 * lane + 256 * j);
            } else { const float* m = C.mod + ((size_t)l * (NB + 1) + b) * 6 * D + 4 * lane; const float* nw = C.p.norm1 + (size_t)l * D + 4 * lane;
#pragma unroll
                for (int j = 0; j < 4; ++j) { A[j] = *(const f32x4*)(nw + 256 * j) * (*(const f32x4*)(m + M_SC1 + 256 * j) + 1.0f); S[j] = *(const f32x4*)(m + M_SH1 + 256 * j); } }
            if (l > 0) { const float* g2 = C.mod + ((size_t)(l - 1) * (NB + 1) + b) * 6 * D + M_G2 + 4 * lane;
#pragma unroll
                for (int j = 0; j < 4; ++j) G[j] = *(const f32x4*)(g2 + 256 * j) * (gscale * (1.0f / 64.0f)); } }
        f32x4 v[4];
#pragma unroll
        for (int j = 0; j < 4; ++j) { if (SRCF32) v[j] = __builtin_bit_cast(f32x4, xc[j]); else { const unsigned w0 = xc[j][0], w1 = xc[j][1];
            v[j] = (f32x4){__builtin_bit_cast(float, w0 << 16), __builtin_bit_cast(float, w0 & 0xffff0000u), __builtin_bit_cast(float, w1 << 16), __builtin_bit_cast(float, w1 & 0xffff0000u)}; } }
        if (l > 0) {
            f32x4 a[4];
#pragma unroll
            for (int j = 0; j < 4; ++j) { a[j] = (f32x4){0.f, 0.f, 0.f, 0.f};
#pragma unroll
                for (int i = 0; i < 4; ++i) yf8_add(a[j], yc[i][j], wc_[i]); }
            while (mc) { const int s = __builtin_amdgcn_readlane(tsc, __builtin_ctz(mc)); mc &= mc - 1;
#pragma unroll
                for (int j = 0; j < 4; ++j) yf8_add(a[j], *(const unsigned*)(Yb + (size_t)s * D + 4 * lane + 256 * j), 1.0f); }
#pragma unroll
            for (int j = 0; j < 4; ++j) v[j] = v[j] + G[j] * a[j];
        }
        float ss = 0.f;
#pragma unroll
        for (int j = 0; j < 4; ++j) ss += (v[j][0] * v[j][0] + v[j][1] * v[j][1]) + (v[j][2] * v[j][2] + v[j][3] * v[j][3]);
        const float rstd = 1.0f / sqrtf(wave_sum(ss) * (1.0f / D) + EPS);
        if (FINAL) {
            float* dst = C.p.out + (size_t)row * D;
#pragma unroll
            for (int j = 0; j < 4; ++j) *(f32x4*)(dst + 4 * lane + 256 * j) = v[j] * rstd * A[j];
        } else {
            bf16_t* xo = C.XB + (size_t)row * D + 4 * lane;
#pragma unroll
            for (int j = 0; j < 4; ++j) { u32x2 w; w.x = cvt_pk_bf16(v[j][0], v[j][1]); w.y = cvt_pk_bf16(v[j][2], v[j][3]); *(u32x2*)(xo + 256 * j) = w; }
            f32x4 hq[4]; float am = 0.f;
#pragma unroll
            for (int j = 0; j < 4; ++j) { hq[j] = v[j] * rstd * A[j] + S[j]; am = fmaxf(fmaxf(am, fmaxf(fabsf(hq[j][0]), fabsf(hq[j][1]))), fmaxf(fabsf(hq[j][2]), fabsf(hq[j][3]))); }
            am = wave_max(am); const float inv = am > 0.f ? 127.0f / am : 0.f;
            if (lane == 0) ((float*)(C.p.ws + WS_HXS))[row] = am * (1.0f / 127.0f);
            unsigned char* hr = (unsigned char*)C.HX + (size_t)row * D + 4 * lane;
#pragma unroll
            for (int j = 0; j < 4; ++j) { const unsigned w = ((unsigned)__float2int_rn(fminf(fmaxf(hq[j][0] * inv, -127.f), 127.f)) & 0xffu) | (((unsigned)__float2int_rn(fminf(fmaxf(hq[j][1] * inv, -127.f), 127.f)) & 0xffu) << 8) | (((unsigned)__float2int_rn(fminf(fmaxf(hq[j][2] * inv, -127.f), 127.f)) & 0xffu) << 16) | (((unsigned)__float2int_rn(fminf(fmaxf(hq[j][3] * inv, -127.f), 127.f)) & 0xffu) << 24);
                *(unsigned*)(hr + 256 * j) = w; }
        }
        tsc = tsn; tsn = ts2; mc = mn;
#pragma unroll
        for (int j = 0; j < 4; ++j) { xc[j] = xn[j]; xn[j] = x2[j]; }
#pragma unroll
        for (int i = 0; i < 4; ++i) { wc_[i] = wn_[i];
#pragma unroll
            for (int j = 0; j < 4; ++j) yc[i][j] = yn[i][j]; }
    }
#undef RA_LOADX
#undef RA_LOADTS
#undef RA_ISSUEY
}
__device__ __forceinline__ void phase_rowB(const Ctx& C, int l, int nq) {
    const int tid = tid_l(), lane = tid & 63, wave = __builtin_amdgcn_readfirstlane(tid >> 6), gw = blockIdx.x * NWV + wave, NGW = gridDim.x * NWV;
    LAS float* R = (LAS float*)C.lds;
    const float* rt = C.p.router + (size_t)l * D * NE;
    for (int i = tid; i < D * NE; i += NT) R[(i % NE) * D + i / NE] = rt[i];
    __syncthreads();
    const int per = (nq + NGW - 1) / NGW, r0 = gw * per, r1 = (r0 + per < nq) ? r0 + per : nq;
    f32x4 xn[4], A[4], S[4]; int bcur = -1; int row = r0;
    u32x2 xr_[4];
    if (row < r1) { const bf16_t* s = C.XB + (size_t)row * D + 4 * lane;
#pragma unroll
        for (int j = 0; j < 4; ++j) xr_[j] = *(const u32x2*)(s + 256 * j); }
    for (; row < r1; ++row) {
        f32x4 v[4]; float ss = 0.f;
#pragma unroll
        for (int j = 0; j < 4; ++j) xn[j] = (f32x4){__builtin_bit_cast(float, xr_[j].x << 16), __builtin_bit_cast(float, xr_[j].x & 0xffff0000u), __builtin_bit_cast(float, xr_[j].y << 16), __builtin_bit_cast(float, xr_[j].y & 0xffff0000u)};
        const int b = row_batch(row);
        if (b != bcur) { bcur = b; const float* m = C.mod + ((size_t)l * (NB + 1) + b) * 6 * D + 4 * lane; const float* nw = C.p.norm2 + (size_t)l * D + 4 * lane;
#pragma unroll
            for (int j = 0; j < 4; ++j) { A[j] = *(const f32x4*)(nw + 256 * j) * (*(const f32x4*)(m + M_SC2 + 256 * j) + 1.0f); S[j] = *(const f32x4*)(m + M_SH2 + 256 * j); } }
#pragma unroll
        for (int j = 0; j < 4; ++j) { v[j] = xn[j]; ss += (v[j][0] * v[j][0] + v[j][1] * v[j][1]) + (v[j][2] * v[j][2] + v[j][3] * v[j][3]); }
        if (row + 1 < r1) { const bf16_t* s = C.XB + (size_t)(row + 1) * D + 4 * lane;
#pragma unroll
            for (int j = 0; j < 4; ++j) xr_[j] = *(const u32x2*)(s + 256 * j); }
        const float rstd = 1.0f / sqrtf(wave_sum(ss) * (1.0f / D) + EPS);
        unsigned char* hr = (unsigned char*)C.HX2 + (size_t)row * D + 4 * lane;
#pragma unroll
        for (int j = 0; j < 4; ++j) { v[j] = v[j] * rstd * A[j] + S[j]; *(unsigned*)(hr + 256 * j) = pg::pk4_fp8(v[j][0], v[j][1], v[j][2], v[j][3]); }
        float p[NE];
        { f32x2_t q[NE];
#pragma unroll
          for (int e = 0; e < NE; ++e) q[e] = (f32x2_t){0.f, 0.f};
          f32x4 ra_[8], rb_[8]; const unsigned rbase = (unsigned)(size_t)(R + 4 * lane);
          LDS_ISSUE8_B128(ra_, rbase, D * 4);
#pragma unroll
          for (int k = 0; k < 8; k += 2) {
              const f32x2_t vlo = (f32x2_t){v[k >> 1][0], v[k >> 1][1]}, vhi = (f32x2_t){v[k >> 1][2], v[k >> 1][3]};
              LDS_ISSUE8_B128(rb_, rbase + (unsigned)((8 * D + 256 * (k >> 1)) * 4), D * 4); LDS_WAIT8(ra_, 8);
#pragma unroll
              for (int e = 0; e < 8; ++e) { q[e] = __builtin_elementwise_fma(vlo, (f32x2_t){ra_[e][0], ra_[e][1]}, q[e]); q[e] = __builtin_elementwise_fma(vhi, (f32x2_t){ra_[e][2], ra_[e][3]}, q[e]); }
              if (k + 2 < 8) { LDS_ISSUE8_B128(ra_, rbase + (unsigned)(256 * ((k >> 1) + 1) * 4), D * 4); LDS_WAIT8(rb_, 8); } else { LDS_WAIT8(rb_, 0); }
#pragma unroll
              for (int e = 0; e < 8; ++e) { q[8 + e] = __builtin_elementwise_fma(vlo, (f32x2_t){rb_[e][0], rb_[e][1]}, q[8 + e]); q[8 + e] = __builtin_elementwise_fma(vhi, (f32x2_t){rb_[e][2], rb_[e][3]}, q[8 + e]); }
          }
#pragma unroll
          for (int e = 0; e < NE; ++e) p[e] = q[e][0] + q[e][1]; }
#pragma unroll
        for (int j = 0; j < 8; ++j) { auto rr = __builtin_amdgcn_permlane32_swap(__float_as_uint(p[j]), __float_as_uint(p[j + 8]), false, false); p[j] = __uint_as_float(rr[0]) + __uint_as_float(rr[1]); }
#pragma unroll
        for (int j = 0; j < 4; ++j) { auto rr = __builtin_amdgcn_permlane16_swap(__float_as_uint(p[j]), __float_as_uint(p[j + 4]), false, false); p[j] = __uint_as_float(rr[0]) + __uint_as_float(rr[1]); }
#pragma unroll
        for (int j = 0; j < 2; ++j) { const float a = p[j] + dpp_f(p[j], 3), b2 = p[j + 2] + dpp_f(p[j + 2], 3); p[j] = (lane & 8) ? b2 : a; }
        float lg; { const float a = p[0] + dpp_f(p[0], 2), b2 = p[1] + dpp_f(p[1], 2); lg = (lane & 4) ? b2 : a; }
        lg += dpp_f(lg, 1); lg += dpp_f(lg, 0);
        const float mx = wave_max(lg);
        const float ex = expf(lg - mx); const float se = wave_sum(ex) * 0.25f;
        const int e = ((lane >> 5) & 1) * 8 + ((lane >> 4) & 1) * 4 + ((lane >> 3) & 1) * 2 + ((lane >> 2) & 1);
        if ((lane & 3) == 0) C.aff[(size_t)row * NE + e] = ex / se;
    }
    __syncthreads();
}
template <int NV>
__device__ __forceinline__ void select_task(const Ctx& C, int base_row, int cap, int e, int slot0, int lane) {
    unsigned v[NV];
#pragma unroll
    for (int i = 0; i < NV; ++i) v[i] = __builtin_bit_cast(unsigned, C.aff[(size_t)(base_row + i * 64 + lane) * NE + e]);
    unsigned T = 0u;
    for (int bit = 30; bit >= 0; --bit) { const unsigned cand = T | (1u << bit); int cnt = 0;
#pragma unroll
        for (int i = 0; i < NV; ++i) cnt += __builtin_popcountll(__ballot(v[i] >= cand));
        if (cnt >= cap) T = cand; }
    int ngt = 0;
#pragma unroll
    for (int i = 0; i < NV; ++i) ngt += __builtin_popcountll(__ballot(v[i] > T));
    const int need = cap - ngt;
    const unsigned long long lt = (1ull << lane) - 1ull; int nsel = 0, neq = 0;
#pragma unroll
    for (int i = 0; i < NV; ++i) {
        const bool gt = v[i] > T, eq = v[i] == T; const unsigned long long meq = __ballot(eq);
        const bool take = gt || (eq && (neq + __builtin_popcountll(meq & lt)) < need);
        const unsigned long long msel = __ballot(take);
        const int row = base_row + i * 64 + lane; int slot = -1;
        if (take) { slot = slot0 + nsel + __builtin_popcountll(msel & lt); C.sel[slot] = row; C.gate[slot] = __builtin_bit_cast(float, v[i]); }
        C.tokslot[(size_t)row * NE + e] = slot;
        nsel += __builtin_popcountll(msel); neq += __builtin_popcountll(meq);
    }
}
__device__ __forceinline__ void phase_select(const Ctx& C, bool need_ctx) {
    const int tid = tid_l(), lane = tid & 63, wave = __builtin_amdgcn_readfirstlane(tid >> 6), gw = blockIdx.x * NWV + wave, NGW = gridDim.x * NWV; (void)lane; (void)gw; (void)NGW;
    const int ntask = NB * NE * (need_ctx ? 2 : 1);
    for (int task = wave * (int)gridDim.x + (int)blockIdx.x; task < ntask; task += NGW) {
        const int set = task / (NB * NE), b = (task / NE) % NB, e = task % NE;
        if (set == 0) select_task<SEQ / 64>(C, b * SEQ, CAPL, e, e * SLOTS_E + b * CAPL, lane);
        else select_task<CTX / 64>(C, RL + b * CTX, CAPC, e, e * SLOTS_E + SLOTS_L + b * CAPC, lane);
    }
}
namespace att {
typedef float f32x16 __attribute__((ext_vector_type(16)));
typedef short v4i16_t __attribute__((ext_vector_type(4)));
typedef __bf16 bf16x2_t __attribute__((ext_vector_type(2)));
constexpr int KSTR = 144, VSTR = 192, TILE_B = 64 * KSTR, BUF_B = TILE_B + 64 * VSTR;
constexpr float THR = 8.0f, THR_LO = 32.0f;
__device__ __forceinline__ unsigned pk2(float a, float b) { bf16x2_t v = {(__bf16)a, (__bf16)b}; return __builtin_bit_cast(unsigned, v); }
__device__ __forceinline__ float xmax32(float x) { auto rr = __builtin_amdgcn_permlane32_swap(__float_as_uint(x), __float_as_uint(x), false, false); return fmaxf(__uint_as_float(rr[0]), __uint_as_float(rr[1])); }
__device__ __forceinline__ float xsum32(float x) { auto rr = __builtin_amdgcn_permlane32_swap(__float_as_uint(x), __float_as_uint(x), false, false); return __uint_as_float(rr[0]) + __uint_as_float(rr[1]); }
__device__ __forceinline__ int crow(int reg, int h) { return (reg & 3) + 8 * (reg >> 2) + 4 * h; }
#ifndef PROBE_ATT
#define PROBE_ATT 0
#endif
#define MFMA32(a, b, c) __builtin_amdgcn_mfma_f32_32x32x16_bf16((a), (b), (c), 0, 0, 0)
__device__ __forceinline__ bf16x8 ones_rows(int lane) { const unsigned v = (lane == 0 || lane == 32 || lane == 17 || lane == 49) ? 0x3F803F80u : 0u; u32x4 w; w.x = v; w.y = v; w.z = v; w.w = v; return __builtin_bit_cast(bf16x8, w); }
__device__ __forceinline__ float rowsum(const f32x4& L, int lane) { const float a = __shfl(L[0], lane & 15), b = __shfl(L[1], lane & 15); return (lane & 16) ? b : a; }

#define ATT_VTR(n, ks, hi, db) "ds_read_b64_tr_b16 %" #n ", %16 offset:" #ks "*3072+" #hi "*1536+" #db "*64\n\t"
template <int DKS, bool WAIT>
__device__ __forceinline__ void katt_read(unsigned kb_, bf16x8 (&Kf)[8], int lane) {
    const int r = lane & 31, h = lane >> 5;
    const unsigned ka = kb_ + r * KSTR + 16 * h;
    constexpr int o1 = 32, o2 = (DKS == 4) ? 64 : 32 * KSTR, o3 = (DKS == 4) ? 96 : 32 * KSTR + 32, o4 = (DKS == 4) ? 32 * KSTR : 64, o5 = (DKS == 4) ? 32 * KSTR + 32 : 96,
                  o6 = 32 * KSTR + 64, o7 = 32 * KSTR + 96;
    if constexpr (WAIT)
        asm volatile("ds_read_b128 %0, %8\n\tds_read_b128 %1, %8 offset:%c9\n\tds_read_b128 %2, %8 offset:%c10\n\tds_read_b128 %3, %8 offset:%c11\n\t"
                     "ds_read_b128 %4, %8 offset:%c12\n\tds_read_b128 %5, %8 offset:%c13\n\tds_read_b128 %6, %8 offset:%c14\n\tds_read_b128 %7, %8 offset:%c15\n\ts_waitcnt lgkmcnt(0)"
                     : "=&v"(Kf[0]), "=&v"(Kf[1]), "=&v"(Kf[2]), "=&v"(Kf[3]), "=&v"(Kf[4]), "=&v"(Kf[5]), "=&v"(Kf[6]), "=&v"(Kf[7])
                     : "v"(ka), "i"(o1), "i"(o2), "i"(o3), "i"(o4), "i"(o5), "i"(o6), "i"(o7) : "memory");
    else
        asm volatile("ds_read_b128 %0, %8\n\tds_read_b128 %1, %8 offset:%c9\n\tds_read_b128 %2, %8 offset:%c10\n\tds_read_b128 %3, %8 offset:%c11\n\t"
                     "ds_read_b128 %4, %8 offset:%c12\n\tds_read_b128 %5, %8 offset:%c13\n\tds_read_b128 %6, %8 offset:%c14\n\tds_read_b128 %7, %8 offset:%c15"
                     : "=&v"(Kf[0]), "=&v"(Kf[1]), "=&v"(Kf[2]), "=&v"(Kf[3]), "=&v"(Kf[4]), "=&v"(Kf[5]), "=&v"(Kf[6]), "=&v"(Kf[7])
                     : "v"(ka), "i"(o1), "i"(o2), "i"(o3), "i"(o4), "i"(o5), "i"(o6), "i"(o7) : "memory");
}
__device__ __forceinline__ void katt_wait(bf16x8 (&Kf)[8]) {
    asm volatile("s_waitcnt lgkmcnt(0)" : "+v"(Kf[0]), "+v"(Kf[1]), "+v"(Kf[2]), "+v"(Kf[3]), "+v"(Kf[4]), "+v"(Kf[5]), "+v"(Kf[6]), "+v"(Kf[7]) :: "memory");
}
template <int NSUB, int DKS>
__device__ __forceinline__ void flash_tile(unsigned vb_, unsigned kn_, bool has_next, const bf16x8 (&Q)[NSUB][DKS], f32x16 (&O)[NSUB][2], float (&m)[NSUB], f32x4 (&L)[NSUB], const bf16x8& onesA,
                                           bf16x8 (&Kf)[8], int lane, bool masked, int dq, bool first) {
    static_assert(NSUB * DKS == 4, "eight K fragments per tile");
    const int r = lane & 31, h = lane >> 5; (void)r;
    f32x16 S[NSUB][2];
    bool allz = true;
#pragma unroll
    for (int sub = 0; sub < NSUB; ++sub) allz = allz && __all(m[sub] == 0.f);
    if (allz) {
#pragma unroll
        for (int sub = 0; sub < NSUB; ++sub)
#pragma unroll
            for (int kb = 0; kb < 2; ++kb) {
                const f32x16 zero = {0.f, 0.f, 0.f, 0.f, 0.f, 0.f, 0.f, 0.f, 0.f, 0.f, 0.f, 0.f, 0.f, 0.f, 0.f, 0.f};
                S[sub][kb] = MFMA32(Kf[(DKS == 4) ? (kb * 4) : (kb * 2 + 4 * sub)], Q[sub][0], zero);
#pragma unroll
                for (int s = 1; s < DKS; ++s) S[sub][kb] = MFMA32(Kf[(DKS == 4) ? (kb * 4 + s) : (kb * 2 + s + 4 * sub)], Q[sub][s], S[sub][kb]);
            }
    } else {
#pragma unroll
        for (int sub = 0; sub < NSUB; ++sub)
#pragma unroll
            for (int kb = 0; kb < 2; ++kb) {
#pragma unroll
                for (int i = 0; i < 16; ++i) S[sub][kb][i] = -m[sub];
#pragma unroll
                for (int s = 0; s < DKS; ++s) S[sub][kb] = MFMA32(Kf[(DKS == 4) ? (kb * 4 + s) : (kb * 2 + s + 4 * sub)], Q[sub][s], S[sub][kb]);
            }
    }
#pragma unroll
    for (int sub = 0; sub < NSUB; ++sub) asm volatile("" : "+v"(S[sub][0]), "+v"(S[sub][1]));
    v4i16_t Vr[16];
    { const int i16 = lane & 15, q = i16 >> 2, p = i16 & 3, rblk = (lane >> 4) & 1; const unsigned va = vb_ + (4 * h + q) * VSTR + (16 * rblk + 4 * p) * 2;
      asm volatile(ATT_VTR(0, 0, 0, 0) ATT_VTR(1, 0, 1, 0) ATT_VTR(2, 0, 0, 1) ATT_VTR(3, 0, 1, 1) ATT_VTR(4, 1, 0, 0) ATT_VTR(5, 1, 1, 0) ATT_VTR(6, 1, 0, 1) ATT_VTR(7, 1, 1, 1)
                   ATT_VTR(8, 2, 0, 0) ATT_VTR(9, 2, 1, 0) ATT_VTR(10, 2, 0, 1) ATT_VTR(11, 2, 1, 1) ATT_VTR(12, 3, 0, 0) ATT_VTR(13, 3, 1, 0) ATT_VTR(14, 3, 0, 1) ATT_VTR(15, 3, 1, 1)
                   : "=&v"(Vr[0]), "=&v"(Vr[1]), "=&v"(Vr[2]), "=&v"(Vr[3]), "=&v"(Vr[4]), "=&v"(Vr[5]), "=&v"(Vr[6]), "=&v"(Vr[7]),
                     "=&v"(Vr[8]), "=&v"(Vr[9]), "=&v"(Vr[10]), "=&v"(Vr[11]), "=&v"(Vr[12]), "=&v"(Vr[13]), "=&v"(Vr[14]), "=&v"(Vr[15])
                   : "v"(va) : "memory"); }
#pragma unroll
    for (int sub = 0; sub < NSUB; ++sub) {
        if (masked) {
#pragma unroll
            for (int kb = 0; kb < 2; ++kb)
#pragma unroll
                for (int i = 0; i < 16; ++i) { const int dl = dq - (32 * kb + crow(i, h)); S[sub][kb][i] = (dl > WINDOW || dl < -WINDOW) ? -1e30f : S[sub][kb][i]; }
        }
        float mx = S[sub][0][0];
#pragma unroll
        for (int i = 1; i < 16; ++i) mx = fmaxf(mx, S[sub][0][i]);
#pragma unroll
        for (int i = 0; i < 16; ++i) mx = fmaxf(mx, S[sub][1][i]);
        mx = xmax32(mx);
        if (!__all(mx <= THR) || (first && !__all(mx >= -THR_LO))) {
            const float up = first ? mx : fmaxf(mx, 0.f), alpha = first ? 1.0f : __builtin_amdgcn_exp2f(-up); m[sub] += up;
            L[sub][0] *= alpha; L[sub][1] *= __shfl(alpha, (lane & 15) + 16);
#pragma unroll
            for (int kb = 0; kb < 2; ++kb)
#pragma unroll
                for (int i = 0; i < 16; ++i) S[sub][kb][i] -= up;
#pragma unroll
            for (int db = 0; db < 2; ++db)
#pragma unroll
                for (int i = 0; i < 16; ++i) O[sub][db][i] *= alpha;
        }
#pragma unroll
        for (int kb = 0; kb < 2; ++kb)
#pragma unroll
            for (int i = 0; i < 16; ++i) S[sub][kb][i] = __builtin_amdgcn_exp2f(S[sub][kb][i]);
        bf16x8 Pf[4];
#pragma unroll
        for (int kb = 0; kb < 2; ++kb)
#pragma unroll
            for (int s = 0; s < 2; ++s) { u32x4 w; w.x = pk2(S[sub][kb][8 * s + 0], S[sub][kb][8 * s + 1]); w.y = pk2(S[sub][kb][8 * s + 2], S[sub][kb][8 * s + 3]);
                w.z = pk2(S[sub][kb][8 * s + 4], S[sub][kb][8 * s + 5]); w.w = pk2(S[sub][kb][8 * s + 6], S[sub][kb][8 * s + 7]); Pf[2 * kb + s] = __builtin_bit_cast(bf16x8, w); }
        if (sub == 0) {
            asm volatile("s_waitcnt lgkmcnt(0)" : "+v"(Vr[0]), "+v"(Vr[1]), "+v"(Vr[2]), "+v"(Vr[3]), "+v"(Vr[4]), "+v"(Vr[5]), "+v"(Vr[6]), "+v"(Vr[7]) :: "memory");
            asm volatile("" : "+v"(Vr[8]), "+v"(Vr[9]), "+v"(Vr[10]), "+v"(Vr[11]), "+v"(Vr[12]), "+v"(Vr[13]), "+v"(Vr[14]), "+v"(Vr[15]) :: "memory");
        }
        if (sub == NSUB - 1 && has_next) katt_read<DKS, false>(kn_, Kf, lane);
#pragma unroll
        for (int ks = 0; ks < 4; ++ks) {
#pragma unroll
            for (int db = 0; db < 2; ++db) {
                const bf16x8 vf = __builtin_shufflevector(Vr[(ks * 2 + db) * 2], Vr[(ks * 2 + db) * 2 + 1], 0, 1, 2, 3, 4, 5, 6, 7);
                O[sub][db] = MFMA32(vf, Pf[ks], O[sub][db]);
            }
            L[sub] = __builtin_amdgcn_mfma_f32_16x16x32_bf16(onesA, Pf[ks], L[sub], 0, 0, 0);
        }
#pragma unroll
        for (int db = 0; db < 2; ++db) asm volatile("" : "+v"(O[sub][db]));
    }
    if (has_next) katt_wait(Kf);
}
#define ATT_STG_LOAD2(krow0, KR, VR) do { const bf16_t* _p = C.P + (size_t)((krow0) + skey) * PROJ + 8 * schunk; KR = *(const u32x4*)(_p + kcol); VR = *(const u32x4*)(_p + vcol); } while (0)
#define ATT_STG_STORE2(buf, KR, VR) do { LAS unsigned char* _d = C.lds + (buf) * BUF_B + skey * KSTR + schunk * 16; *(LAS u32x4*)_d = KR; *(LAS u32x4*)(_d + TILE_B + skey * (VSTR - KSTR)) = VR; } while (0)
#define ATT_STG_LOAD(krow0) ATT_STG_LOAD2(krow0, kreg, vreg)
#define ATT_STG_STORE(buf) ATT_STG_STORE2(buf, kreg, vreg)
#define ATT_STG_STOREB(off) do { LAS unsigned char* _d = C.lds + (off) + skey * KSTR + schunk * 16; *(LAS u32x4*)_d = kreg; *(LAS u32x4*)(_d + TILE_B + skey * (VSTR - KSTR)) = vreg; } while (0)
#define ATT_PROLOGUE(DKS_) do { { u32x4 kreg2, vreg2; ATT_STG_LOAD(ATT_TROW(0)); ATT_STG_LOAD2(ATT_TROW(1), kreg2, vreg2); ATT_STG_STORE(0); ATT_STG_STORE2(1, kreg2, vreg2); } \
    if (nt > 2) ATT_STG_LOAD(ATT_TROW(2)); __syncthreads(); katt_read<DKS_, true>((unsigned)(size_t)C.lds, Kf, lane); } while (0)

__device__ __forceinline__ void phase_attnA(const Ctx& C, int l, bool need_ctx) {
    const int tid = tid_l(), lane = tid & 63, wave = __builtin_amdgcn_readfirstlane(tid >> 6), skey = tid >> 3, schunk = tid & 7;
    const int r = lane & 31, h = lane >> 5, hq = wave & 3, ph = wave >> 2;
    const bf16x8 onesA = ones_rows(lane);
    constexpr int NUL = NB * NKVA * (SEQ / 64), NUC = NB * NKVA * (CTX / 64);
    const int nu = NUL + (need_ctx ? NUC : 0);
    for (int u = blockIdx.x; u < nu; u += gridDim.x) {
        const bool lat = u < NUL; const int uu = lat ? u : u - NUL; const int nqb = lat ? SEQ / 64 : CTX / 64;
        const int b = uu / (NKVA * nqb), kvh = (uu / nqb) % NKVA, qb = uu % nqb, head = kvh * GQA + hq;
        const int kcol = C_KA + kvh * HDIM, vcol = C_VA + kvh * HDIM;
        const int q0 = 64 * qb + 32 * ph;
        const int qrow = (lat ? b * SEQ : RL + b * CTX) + q0 + r;
        const int jlo = lat ? (2 - qb > 0 ? 2 - qb : 0) : 0, jhi = lat ? (33 - qb < 4 ? 33 - qb : 4) : -1;
        const int nt = CTX / 64 + (jhi - jlo + 1);
        bf16x8 Q[1][4];
#pragma unroll
        for (int s = 0; s < 4; ++s) Q[0][s] = *(const bf16x8*)(C.P + (size_t)qrow * PROJ + C_QA + head * HDIM + 16 * s + 8 * h);
        f32x16 O[1][2]; float m[1]; f32x4 L[1];
#pragma unroll
        for (int db = 0; db < 2; ++db)
#pragma unroll
            for (int i = 0; i < 16; ++i) O[0][db][i] = 0.f;
        m[0] = 0.f; L[0] = f32x4{0.f, 0.f, 0.f, 0.f};
        u32x4 kreg, vreg;
#define ATT_TROW(i) ((i) < CTX / 64 ? RL + b * CTX + 64 * (i) : b * SEQ + 64 * qb - 128 + 64 * (jlo + (i) - CTX / 64))
        bf16x8 Kf[8];
        ATT_PROLOGUE(4);
        int s0 = 0, s1 = BUF_B, s2 = 2 * BUF_B;
        for (int i = 0; i < nt; ++i) {
            if (i + 2 < nt) ATT_STG_STOREB(s2);
            if (i + 3 < nt) ATT_STG_LOAD(ATT_TROW(i + 3));
            const bool loc = i >= CTX / 64; const int d = loc ? q0 - (64 * qb - 128 + 64 * (jlo + i - CTX / 64)) : 0;
            const bool masked = loc && (d > 97 || d < -65);
            const unsigned lb = (unsigned)(size_t)C.lds;
            flash_tile<1, 4>(lb + s0 + TILE_B, lb + s1, i + 1 < nt, Q, O, m, L, onesA, Kf, lane, masked, d + r, i == 0);
            __syncthreads();
            { const int t = s0; s0 = s1; s1 = s2; s2 = t; }
        }
#undef ATT_TROW
        const float inv = 1.0f / (rowsum(L[0], lane) + __builtin_amdgcn_exp2f(C.p.attn_sink[l * NHA + head] * LOG2E - m[0]));
        bf16_t* op = C.MIX + (size_t)qrow * D + head * HDIM + 4 * h;
#pragma unroll
        for (int db = 0; db < 2; ++db)
#pragma unroll
            for (int g = 0; g < 4; ++g) { u32x2 w; w.x = pk2(O[0][db][4 * g] * inv, O[0][db][4 * g + 1] * inv); w.y = pk2(O[0][db][4 * g + 2] * inv, O[0][db][4 * g + 3] * inv);
                *(u32x2*)(op + 32 * db + 8 * g) = w; }
    }
}
__device__ __forceinline__ void phase_attnD(const Ctx& C, int l, bool need_ctx) {
    const int tid = tid_l(), lane = tid & 63, wave = __builtin_amdgcn_readfirstlane(tid >> 6), skey = tid >> 3, schunk = tid & 7;
    const int r = lane & 31, h = lane >> 5;
    const bf16x8 onesA = ones_rows(lane);
    const float lam_init = 0.8f - 0.6f * expf(-0.3f * (float)l);
    float lam;
    { const float* lp = C.p.diff_lambda + l * 4 * DD; const float a = lane < DD ? lp[lane] * lp[DD + lane] : 0.f, b2 = lane < DD ? lp[2 * DD + lane] * lp[3 * DD + lane] : 0.f;
      lam = expf(wave_sum(a)) - expf(wave_sum(b2)) + lam_init; }
    constexpr int NUL = NB * NHC * (SEQ / 256), NUC = NB * NHC * (CTX / 256);
    const int nu = NUL + (need_ctx ? NUC : 0);
    for (int u = blockIdx.x; u < nu; u += gridDim.x) {
        const bool lat = u < NUL; const int uu = lat ? u : u - NUL; const int nqb = lat ? SEQ / 256 : CTX / 256;
        const int b = uu / (NHC * nqb), hd = (uu / nqb) % NHC, qb = uu % nqb;
        const int kcol = C_KD + hd * 2 * DD, vcol = C_VD + hd * 2 * DD;
        const int qrow = (lat ? b * SEQ : RL + b * CTX) + 256 * qb + 32 * wave + r;
        const int nt = CTX / 64 + (lat ? SEQ / 64 : 0);
        bf16x8 Q[2][2];
#pragma unroll
        for (int j = 0; j < 2; ++j)
#pragma unroll
            for (int s = 0; s < 2; ++s) Q[j][s] = *(const bf16x8*)(C.P + (size_t)qrow * PROJ + C_QD + hd * 2 * DD + j * DD + 16 * s + 8 * h);
        f32x16 O[2][2]; float m[2]; f32x4 L[2];
#pragma unroll
        for (int j = 0; j < 2; ++j) { m[j] = 0.f; L[j] = f32x4{0.f, 0.f, 0.f, 0.f};
#pragma unroll
            for (int db = 0; db < 2; ++db)
#pragma unroll
                for (int i = 0; i < 16; ++i) O[j][db][i] = 0.f; }
        u32x4 kreg, vreg;
#define ATT_TROW(i) ((i) < CTX / 64 ? RL + b * CTX + 64 * (i) : b * SEQ + 64 * ((i) - CTX / 64))
        bf16x8 Kf[8];
        ATT_PROLOGUE(2);
        int s0 = 0, s1 = BUF_B, s2 = 2 * BUF_B;
#if PROBE_ATT
        unsigned long long pT0 = __builtin_readcyclecounter(), ptw = 0, ptb = 0;
#endif
        for (int i = 0; i < nt; ++i) {
#if PROBE_ATT
            { const unsigned long long t1 = __builtin_readcyclecounter(); asm volatile("s_waitcnt vmcnt(0)" ::: "memory"); ptw += __builtin_readcyclecounter() - t1; }
#endif
            if (i + 2 < nt) ATT_STG_STOREB(s2);
            if (i + 3 < nt) ATT_STG_LOAD(ATT_TROW(i + 3));
            const unsigned lb = (unsigned)(size_t)C.lds;
            flash_tile<2, 2>(lb + s0 + TILE_B, lb + s1, i + 1 < nt, Q, O, m, L, onesA, Kf, lane, false, 0, i == 0);
#if PROBE_ATT
            { const unsigned long long t1 = __builtin_readcyclecounter(); __syncthreads(); ptb += __builtin_readcyclecounter() - t1; }
#else
            __syncthreads();
#endif
            { const int t = s0; s0 = s1; s1 = s2; s2 = t; }
        }
#if PROBE_ATT
        if (l == 1 && u == 100 && tid == 64 * 3) { const float T = (float)(__builtin_readcyclecounter() - pT0);
            ((float*)(C.p.ws + WS_CTL))[8] = PROBE_ATT == 1 ? 1.0e4f * (float)ptw / T : PROBE_ATT == 2 ? 1.0e4f * (float)ptb / T : T / (float)nt; }
#endif
#undef ATT_TROW
        const float i0 = 1.0f / rowsum(L[0], lane), i1 = lam / rowsum(L[1], lane);
        float ss = 0.f;
#pragma unroll
        for (int db = 0; db < 2; ++db)
#pragma unroll
            for (int i = 0; i < 16; ++i) { const float y = O[0][db][i] * i0 - O[1][db][i] * i1; O[0][db][i] = y; ss += y * y; }
        const float rn = (1.0f - lam_init) / sqrtf(xsum32(ss) * (1.0f / (2 * DD)) + EPS);
        const float* sw = C.p.diff_subln + l * 2 * DD + 4 * h;
        bf16_t* op = C.MIX + (size_t)qrow * D + 768 + hd * 2 * DD + 4 * h;
#pragma unroll
        for (int db = 0; db < 2; ++db)
#pragma unroll
            for (int g = 0; g < 4; ++g) { const f32x4 s4 = *(const f32x4*)(sw + 32 * db + 8 * g);
                u32x2 w; w.x = pk2(O[0][db][4 * g] * rn * s4[0], O[0][db][4 * g + 1] * rn * s4[1]); w.y = pk2(O[0][db][4 * g + 2] * rn * s4[2], O[0][db][4 * g + 3] * rn * s4[3]);
                *(u32x2*)(op + 32 * db + 8 * g) = w; }
    }
}
#undef ATT_STG_LOAD
#undef ATT_STG_STORE
#undef ATT_STG_LOAD2
#undef ATT_STG_STORE2
#undef ATT_STG_STOREB
#undef ATT_PROLOGUE
}
__device__ __forceinline__ void phase_conv(const Ctx& C, int l, int nq) {
    const int tid = tid_l();
    const float* cw = C.p.conv_w + l * 3 * CONV_CH;
    for (long g = (long)blockIdx.x * NT + tid; g < (long)(nq / 8) * (CONV_CH / 8); g += (long)gridDim.x * NT) {
        const int row0 = (int)(g / (CONV_CH / 8)) * 8, c8 = (int)(g % (CONV_CH / 8)) * 8;
        const bool lat = row0 < RL; const int t0 = lat ? row0 % SEQ : (row0 - RL) % CTX, len = lat ? SEQ : CTX;
        float u[10][8];
#pragma unroll
        for (int i = 0; i < 10; ++i) { const int tt = t0 + i - 1;
            if (tt >= 0 && tt < len) { const bf16_t* pr = C.P + (size_t)(row0 + i - 1) * PROJ + c8; const u32x4 a = *(const u32x4*)(pr + C_CIN), c = *(const u32x4*)(pr + C_CC);
#pragma unroll
                for (int k = 0; k < 4; ++k) { u[i][2 * k] = __builtin_bit_cast(float, a[k] << 16) * __builtin_bit_cast(float, c[k] << 16); u[i][2 * k + 1] = __builtin_bit_cast(float, a[k] & 0xffff0000u) * __builtin_bit_cast(float, c[k] & 0xffff0000u); } }
            else {
#pragma unroll
                for (int k = 0; k < 8; ++k) u[i][k] = 0.f; } }
        float w[3][8];
#pragma unroll
        for (int j = 0; j < 3; ++j) { const f32x4 w0 = *(const f32x4*)(cw + j * CONV_CH + c8), w1 = *(const f32x4*)(cw + j * CONV_CH + c8 + 4);
#pragma unroll
            for (int k = 0; k < 4; ++k) { w[j][k] = w0[k]; w[j][4 + k] = w1[k]; } }
#pragma unroll
        for (int i = 0; i < 8; ++i) { const u32x4 gb = *(const u32x4*)(C.P + (size_t)(row0 + i) * PROJ + C_CB + c8); u32x4 o;
#pragma unroll
            for (int k = 0; k < 4; ++k) { const float y0 = w[0][2 * k] * u[i][2 * k] + w[1][2 * k] * u[i + 1][2 * k] + w[2][2 * k] * u[i + 2][2 * k];
                const float y1 = w[0][2 * k + 1] * u[i][2 * k + 1] + w[1][2 * k + 1] * u[i + 1][2 * k + 1] + w[2][2 * k + 1] * u[i + 2][2 * k + 1];
                o[k] = att::pk2(__builtin_bit_cast(float, gb[k] << 16) * y0, __builtin_bit_cast(float, gb[k] & 0xffff0000u) * y1); }
            *(u32x4*)(C.MIX + (size_t)(row0 + i) * D + 512 + c8) = o; }
    }
}
#ifndef ATT_A
#define ATT_A 1
#endif
#ifndef ATT_D
#define ATT_D 1
#endif
__device__ __forceinline__ void phase_mix_naive(const Ctx& C, int l, int nq) {
    const int tid = tid_l(), lane = tid & 63, wave = __builtin_amdgcn_readfirstlane(tid >> 6), gw = blockIdx.x * NWV + wave, NGW = gridDim.x * NWV; (void)lane; (void)gw; (void)NGW;
    const long g0 = (long)blockIdx.x * NT + tid, gs = (long)gridDim.x * NT; const float lam_init = 0.8f - 0.6f * expf(-0.3f * (float)l);
#if !ATT_A
    for (long g = g0; g < (long)nq * NHA; g += gs) b_attnA(g, C.P, C.p.attn_sink + l * NHA, C.MIX, nq);
#endif
#if !ATT_D
    for (long g = g0; g < (long)nq * NHC * 2; g += gs) b_attnD(g, C.P, C.TMP, nq);
#endif
    (void)g0; (void)gs;
}
__device__ __forceinline__ void phase_diffpost_naive(const Ctx& C, int l, int nq) {
    const int tid = tid_l(), lane = tid & 63, wave = __builtin_amdgcn_readfirstlane(tid >> 6), gw = blockIdx.x * NWV + wave, NGW = gridDim.x * NWV; (void)lane; (void)gw; (void)NGW;
    const long g0 = (long)blockIdx.x * NT + tid, gs = (long)gridDim.x * NT; const float lam_init = 0.8f - 0.6f * expf(-0.3f * (float)l);
    for (long g = g0; g < (long)nq * NHC; g += gs) b_diffpost(g, C.TMP, C.p.diff_lambda + l * 4 * DD, C.p.diff_subln + l * 2 * DD, lam_init, C.MIX, nq);
}

#ifndef DBL
#define DBL 0
#endif
#define REP(bit) for (int _rep = 0; _rep < (((DBL) & (bit)) ? 2 : 1); ++_rep)
constexpr int CVT_PER_WAVE = 60;
constexpr int NPH = 9, PH_L0 = 2, PH_FINAL = PH_L0 + DEPTH * NPH, PH_TOTAL = PH_FINAL + 1;
__global__ void __launch_bounds__(NT, 2) mega_fwd(Args args) {
    extern __shared__ __attribute__((aligned(16))) unsigned char lds_raw[];
    Ctx C;
    { int w = __builtin_amdgcn_readfirstlane(threadIdx.x >> 6); asm volatile("" : "+s"(w)); C.wv = w; }
    C.p.x = args.in[0]; C.p.c = args.in[1]; C.p.ctx = args.in[2]; C.p.c_ctx = args.in[3]; C.p.w_ada = args.in[4]; C.p.b_ada = args.in[5]; C.p.norm1 = args.in[6]; C.p.norm2 = args.in[7];
    C.p.w_in = args.in[8]; C.p.w_out = args.in[9]; C.p.attn_sink = args.in[10]; C.p.conv_w = args.in[11]; C.p.diff_lambda = args.in[12]; C.p.diff_subln = args.in[13]; C.p.router = args.in[14];
    C.p.w_gate = args.in[15]; C.p.w_up = args.in[16]; C.p.w_down = args.in[17]; C.p.norm_final = args.in[18];
    C.p.out = args.out; C.p.ws = args.ws;
    C.lds = (LAS unsigned char*)lds_raw;
    unsigned char* ws = args.ws;
    C.tab = (float*)(ws + WS_TAB); C.mod = (float*)(ws + WS_MOD); C.aff = (float*)(ws + WS_AFF); C.sel = (int*)(ws + WS_SEL); C.gate = (float*)(ws + WS_GATE); C.tokslot = (int*)(ws + WS_TOKSLOT);
    C.xc = (float*)(ws + WS_XC); C.xl = args.out; C.win = (bf16_t*)(ws + WS_WIN); C.wout = (bf16_t*)(ws + WS_WOUT);
    C.P = (bf16_t*)(ws + WS_R1); C.H = (bf16_t*)(ws + WS_R1); C.Y = (bf16_t*)(ws + WS_R2); C.MIX = (bf16_t*)(ws + WS_R2); C.HX2 = (bf16_t*)(ws + WS_R2 + (size_t)RALL * D * 2); C.TMP = (float*)C.HX2;
    C.HX = (bf16_t*)(ws + WS_R3); C.XB = (bf16_t*)(ws + WS_XB);
    volatile LAS unsigned* misc = (volatile LAS unsigned*)(C.lds + LDS_MISC);
    { const int t0 = tid_l(); if (t0 < 64) misc[t0] = 0u; }
    __syncthreads();
    const int lo = args.ph_lo, hi = args.ph_hi;
    XcdBarrier bar; bar.bar = (unsigned*)(ws + WS_CTL) + CW_BAR; bar.x = 0; bar.st = misc; bar.wv = C.wv;
    if (hi - lo > 1) bar = xcd_barrier_post((unsigned*)(ws + WS_CTL) + CW_BAR, misc, C.wv);
#define IN(k) (lo <= (k) && (k) < hi)
#define SEAM(k) do { if (IN(k) && IN((k) + 1)) xcd_barrier(bar); } while (0)
    const int G = (int)gridDim.x, bid = (int)blockIdx.x;
    if (IN(0)) REP(512) phase_prologue(C);
    SEAM(0);
    if (IN(1)) phase_prologue_b(C);
    SEAM(1);
    for (int l = 0; l < DEPTH; ++l) {
        const int pb = PH_L0 + l * NPH; const bool need_ctx = l < DEPTH - 1; const int nq = need_ctx ? RALL : RL;
        const float* modl = C.mod + (size_t)l * (NB + 1) * 6 * D;
        const int nu1 = (RALL / 256) * (PROJ / 256), G1 = (nu1 + (nu1 + G - 1) / G - 1) / ((nu1 + G - 1) / G);
        const int nu4 = (nq / 256) * (D / 256), G4 = (nu4 + (nu4 + G - 1) / G - 1) / ((nu4 + G - 1) / G);
        const int cn1 = (G - G1) * NWV * CVT_PER_WAVE < CVT_ITEMS ? (G - G1) * NWV * CVT_PER_WAVE : CVT_ITEMS;
        const int cn4 = cn1 + (G - G4) * NWV * CVT_PER_WAVE < CVT_ITEMS ? cn1 + (G - G4) * NWV * CVT_PER_WAVE : CVT_ITEMS;
        if (IN(pb + 0)) { { const int wv_ = C.wv; REP(256) phase_cvt_experts(C, l, cn4, CVT_ITEMS, bid * NWV + wv_, G * NWV); } if (l == 0) phase_rowA<false, true>(C, 0); else phase_rowA<false, false>(C, l); if ((DBL) & 1024) { if (l == 0) phase_rowA<false, true>(C, 0); else phase_rowA<false, false>(C, l, 0.0f); } }
        SEAM(pb + 0);
        if (IN(pb + 1)) { if (bid < G1) { pg::GemmD g{(const char*)C.HX, nullptr, (const char*)C.win + (size_t)l * PROJ * D, 0, D / 2}; pg::Order S; S.init(RALL / 256, PROJ / 256, G1, bid, 0);
            pg::EpiP E{C.P, C.tab, (const float*)(ws + WS_HXS), (const float*)(ws + WS_CTL + CTL_WINMAX) + l * 256}; REP(1) pg::gemm_phase<pg::EpiP, false, 2>(C.lds, g, S, E, C.wv); }
            else phase_cvt_experts(C, l, 0, cn1, (bid - G1) * NWV + C.wv, (G - G1) * NWV); }
        SEAM(pb + 1);
        if (IN(pb + 2)) {
#if ATT_A
            REP(2) att::phase_attnA(C, l, need_ctx);
#endif
#if ATT_D
            REP(4) att::phase_attnD(C, l, need_ctx);
#endif
            phase_mix_naive(C, l, nq); REP(128) phase_conv(C, l, nq); }
        SEAM(pb + 2);
#if !ATT_D
        if (IN(pb + 3)) phase_diffpost_naive(C, l, nq);
        SEAM(pb + 3);
#endif
        if (IN(pb + 4)) { if (bid < G4) { pg::GemmD g{(const char*)C.MIX, nullptr, (const char*)(C.wout + (size_t)l * D * D), 0, D}; pg::Order S; S.init(nq / 256, D / 256, G4, bid, 0);
            pg::EpiX E{C.XB, modl, 1.0f}; pg::gemm_phase<pg::EpiX, false>(C.lds, g, S, E, C.wv);
            if ((DBL) & 2048) { pg::EpiX E0{C.XB, modl, 0.0f}; pg::gemm_phase<pg::EpiX, false>(C.lds, g, S, E0, C.wv); } }
            else phase_cvt_experts(C, l, cn1, cn4, (bid - G4) * NWV + C.wv, (G - G4) * NWV); }
        SEAM(pb + 4);
        if (IN(pb + 5)) REP(8) phase_rowB(C, l, nq);
        SEAM(pb + 5);
        if (IN(pb + 6)) REP(16) phase_select(C, need_ctx);
        SEAM(pb + 6);
        const int tpe = need_ctx ? pg::TPE_FULL : SLOTS_L / 256;
        if (IN(pb + 7)) { pg::GemmD g{(const char*)C.HX2, C.sel, (const char*)(ws + WS_WGU + (size_t)(l & 1) * NE * 2 * FF * D), (size_t)2 * FF * D, D / 2}; pg::Order S; S.init(NE * tpe, 2 * FF / 256, G, bid, tpe);
            pg::EpiH E{(unsigned char*)C.H}; REP(32) pg::gemm_phase<pg::EpiH, true, 1>(C.lds, g, S, E, C.wv); }
        SEAM(pb + 7);
        if (IN(pb + 8)) { pg::GemmD g{(const char*)C.H, nullptr, (const char*)(ws + WS_WD + (size_t)(l & 1) * NE * D * FF), (size_t)D * FF, FF / 2}; pg::Order S; S.init(NE * tpe, D / 256, G, bid, tpe);
            pg::EpiY E{(unsigned char*)C.Y, C.gate}; REP(64) pg::gemm_phase<pg::EpiY, false, 1>(C.lds, g, S, E, C.wv); }
        SEAM(pb + 8);
    }
    if (IN(PH_FINAL)) phase_rowA<true, false>(C, DEPTH);
#if PROBE_ATT
    if (hi - lo > 1) xcd_barrier(bar);
    if (bid == 100 && tid_l() == 0) { asm volatile("s_waitcnt vmcnt(0)" ::: "memory"); C.p.out[0] = ((const float*)(C.p.ws + WS_CTL))[8]; }
#endif
#undef IN
#undef SEAM
}
#endif

#ifndef HOST_TEST
#ifndef MODE
#define MODE 2
#endif
extern "C" void kernel_launch(void* const* d_in, const int* in_sizes, int n_in, void* d_out, int out_size, void* d_ws, size_t ws_size, hipStream_t stream) {
    if (n_in != 19 || out_size != RL * D || ws_size < WS_END) { fprintf(stderr, "kernel_launch: unexpected shapes (n_in %d out %d ws %zu need %zu)\n", n_in, out_size, ws_size, (size_t)WS_END); return; }
#if MODE == 0
    Ptrs p{};
    const float** f = (const float**)&p;
    for (int i = 0; i < 19; ++i) f[i] = (const float*)d_in[i];
    p.out = (float*)d_out; p.ws = (unsigned char*)d_ws;
    forward(p, stream);
#else
    static int grid = 0;
    if (grid == 0) {
        int dev = 0, cus = 0;
        if (hipGetDevice(&dev) != hipSuccess || hipDeviceGetAttribute(&cus, hipDeviceAttributeMultiprocessorCount, dev) != hipSuccess) { fprintf(stderr, "kernel_launch: device query failed\n"); grid = -1; return; }
        if (hipFuncSetAttribute((const void*)mega_fwd, hipFuncAttributeMaxDynamicSharedMemorySize, LDS_BYTES) != hipSuccess) { fprintf(stderr, "kernel_launch: hipFuncSetAttribute failed\n"); grid = -1; return; }
        int per_cu = 0;
        if (hipOccupancyMaxActiveBlocksPerMultiprocessor(&per_cu, (const void*)mega_fwd, NT, LDS_BYTES) != hipSuccess || per_cu < 1) fprintf(stderr, "kernel_launch: occupancy query reports %d blocks per CU\n", per_cu);
        (void)hipGetLastError();
        grid = cus;
    }
    if (grid < 0) return;
    if (hipMemsetAsync((char*)d_ws + WS_CTL, 0, CTL_BYTES, stream) != hipSuccess) { fprintf(stderr, "kernel_launch: memset failed\n"); return; }
    Args a{};
    for (int i = 0; i < 19; ++i) a.in[i] = (const float*)d_in[i];
    a.out = (float*)d_out; a.ws = (unsigned char*)d_ws;
#if MODE == 2
    a.ph_lo = 0; a.ph_hi = PH_TOTAL;
    hipLaunchKernelGGL(mega_fwd, dim3(grid), dim3(NT), LDS_BYTES, stream, a);
#else
    for (int ph = 0; ph < PH_TOTAL; ++ph) { a.ph_lo = ph; a.ph_hi = ph + 1; hipLaunchKernelGGL(mega_fwd, dim3(grid), dim3(NT), LDS_BYTES, stream, a); }
#endif
    const hipError_t le = hipPeekAtLastError();
    if (le != hipSuccess) fprintf(stderr, "kernel_launch: launch failed: %s\n", hipGetErrorName(le));
#endif
}
#else
#include <vector>
#include <string>
static std::vector<float> rd(const std::string& fn) { FILE* f = fopen(fn.c_str(), "rb"); if (!f) { perror(fn.c_str()); exit(1); } fseek(f, 0, SEEK_END); long n = ftell(f); fseek(f, 0, SEEK_SET); std::vector<float> v(n / 4); if (fread(v.data(), 1, n, f) != (size_t)n) exit(1); fclose(f); return v; }
int main(int argc, char** argv) {
    std::string dir = argv[1]; std::vector<std::vector<float>> in(19);
    for (int i = 0; i < 19; ++i) in[i] = rd(dir + "/in" + std::to_string(i) + ".bin");
    std::vector<float> out((size_t)RL * D); std::vector<unsigned char> ws(WS_END, 0xAA);
    Ptrs p{}; const float** f = (const float**)&p; for (int i = 0; i < 19; ++i) f[i] = in[i].data();
    p.out = out.data(); p.ws = ws.data();
    forward(p, 0);
    FILE* fo = fopen((dir + "/out.bin").c_str(), "wb"); fwrite(out.data(), 4, out.size(), fo); fclose(fo);
    printf("done, ws bytes %zu\n", (size_t)WS_END); return 0;
}
#endif
```

```cpp
#ifndef HOST_TEST
#include <hip/hip_runtime.h>
#endif
#include <cstdio>
#include <cstdint>
#include <cstring>
#include <cmath>

#ifndef CFG_B
#define CFG_B 32
#endif
#ifndef CFG_SEQ
#define CFG_SEQ 2048
#endif
#ifndef CFG_CTX
#define CFG_CTX 256
#endif
#ifndef CFG_DEPTH
#define CFG_DEPTH 4
#endif
constexpr int D = 1024, NB = CFG_B, SEQ = CFG_SEQ, CTX = CFG_CTX, DEPTH = CFG_DEPTH;
constexpr int GRID_W = 64, NROWS = SEQ / GRID_W, HDIM = 64, NHA = 8, NKVA = 2, GQA = 4, WINDOW = 128;
constexpr int CONV_CH = 256, DD = 32, NHC = 4, NE = 16, FF = 1024, PROJ = 2304;
constexpr int RL = NB * SEQ, RC = NB * CTX, RALL = RL + RC;
constexpr int CAPL = 2 * SEQ / NE, CAPC = 2 * CTX / NE;
constexpr int SLOTS_L = NB * CAPL, SLOTS_C = NB * CAPC, SLOTS_E = SLOTS_L + SLOTS_C;
constexpr int NSLOT = NE * SLOTS_E;
constexpr int C_QA = 0, C_KA = 512, C_VA = 640, C_CIN = 768, C_CB = 1024, C_CC = 1280, C_QD = 1536, C_KD = 1792, C_VD = 2048;
constexpr int M_SH1 = 0, M_SC1 = D, M_G1 = 2 * D, M_SH2 = 3 * D, M_SC2 = 4 * D, M_G2 = 5 * D;
constexpr float EPS = 1e-6f, LOG2E = 1.4426950408889634f;
constexpr float QSCALE_A = 0.125f * LOG2E, QSCALE_D = 0.17677669529663687f * LOG2E;

#ifdef HOST_TEST
#define HD
#define KERNEL static void
static thread_local long g_gid;
#define GID g_gid
#include <omp.h>
#define LAUNCH(kern, nthreads, ...) do { const long _n = (long)(nthreads); _Pragma("omp parallel for schedule(static)") for (long _g = 0; _g < _n; ++_g) { g_gid = _g; kern(__VA_ARGS__); } } while (0)
#else
#define HD __host__ __device__ __forceinline__
#define KERNEL __global__ void __launch_bounds__(256)
#define GID ((long)blockIdx.x * blockDim.x + threadIdx.x)
#define LAUNCH(kern, nthreads, ...) do { const long _n = (long)(nthreads); if (_n > 0) hipLaunchKernelGGL(kern, dim3((unsigned)((_n + 255) / 256)), dim3(256), 0, stream, __VA_ARGS__); } while (0)
#endif

typedef unsigned short bf16_t;
HD float bf2f(bf16_t v) { unsigned u = (unsigned)v << 16; return __builtin_bit_cast(float, u); }
HD bf16_t f2bf(float f) { unsigned u = __builtin_bit_cast(unsigned, f); return (bf16_t)((u + 0x7fffu + ((u >> 16) & 1u)) >> 16); }

constexpr size_t al256(size_t x) { return (x + 255) & ~(size_t)255; }
constexpr size_t WS_CTL = 0, CTL_BYTES = 1u << 20;
constexpr size_t WS_TAB = WS_CTL + CTL_BYTES;
constexpr int T_AROW = 0, T_ACOL = T_AROW + NROWS * 16 * 2, T_DROW = T_ACOL + 64 * 16 * 2, T_DCOL = T_DROW + NROWS * 8 * 2, T_END = T_DCOL + 64 * 8 * 2;
constexpr size_t WS_SILU = WS_TAB + al256((size_t)T_END * 4);
constexpr size_t WS_MOD = WS_SILU + al256((size_t)(NB + 1) * D * 4);
constexpr size_t WS_RSTD = WS_MOD + al256((size_t)DEPTH * (NB + 1) * 6 * D * 4);
constexpr size_t WS_AFF = WS_RSTD + al256((size_t)RALL * 4);
constexpr size_t WS_SEL = WS_AFF + al256((size_t)RALL * NE * 4);
constexpr size_t WS_GATE = WS_SEL + al256((size_t)NSLOT * 4);
constexpr size_t WS_TOKSLOT = WS_GATE + al256((size_t)NSLOT * 4);
constexpr size_t WS_XC = WS_TOKSLOT + al256((size_t)RALL * NE * 4);
constexpr size_t WS_WIN = WS_XC + al256((size_t)RC * D * 4);
constexpr size_t WS_WOUT = WS_WIN + al256((size_t)DEPTH * PROJ * D * 2);
constexpr size_t WS_WGU = WS_WOUT + al256((size_t)DEPTH * D * D * 2);
constexpr size_t WS_WD = WS_WGU + al256((size_t)2 * NE * 2 * FF * D * 2);
constexpr size_t WS_R1 = WS_WD + al256((size_t)2 * NE * D * FF * 2);
constexpr size_t R1_BYTES = al256(((size_t)RALL * PROJ * 2 > (size_t)NSLOT * FF * 2) ? (size_t)RALL * PROJ * 2 : (size_t)NSLOT * FF * 2);
constexpr size_t WS_R2 = WS_R1 + R1_BYTES;
constexpr size_t R2_BYTES = al256(((size_t)NSLOT * D * 2 > (size_t)2 * RALL * D * 2) ? (size_t)NSLOT * D * 2 : (size_t)2 * RALL * D * 2);
constexpr size_t WS_R3 = WS_R2 + R2_BYTES;
constexpr size_t WS_XB = WS_R3 + al256((size_t)RALL * D * 2);
constexpr size_t WS_HXS = WS_XB + al256((size_t)RALL * D * 2);
constexpr size_t WS_END = WS_HXS + al256((size_t)RALL * 4);
constexpr size_t CTL_WINMAX = 262144;

struct Ptrs {
    const float *x, *c, *ctx, *c_ctx, *w_ada, *b_ada, *norm1, *norm2, *w_in, *w_out, *attn_sink, *conv_w, *diff_lambda, *diff_subln, *router, *w_gate, *w_up, *w_down, *norm_final;
    float* out; unsigned char* ws;
};

HD float* xrow_ptr(float* xl, float* xc, int row) { return row < RL ? xl + (size_t)row * D : xc + (size_t)(row - RL) * D; }
HD int row_batch(int row) { return row < RL ? row / SEQ : NB; }
HD float silu_f(float v) { return v / (1.0f + expf(-v)); }

KERNEL k_tables(float* tab) {
    const long g = GID; if (g >= (long)(NROWS + 64) * 24) return;
    const int pos = (int)(g / 24), f = (int)(g % 24);
    const double inv = f < 16 ? pow(10000.0, -(2.0 * f) / 32.0) : pow(10000.0, -(2.0 * (f - 16)) / 16.0);
    const bool isrow = pos < NROWS; const int p = isrow ? pos : pos - NROWS;
    const double ang = (double)p * inv; const float cs = (float)cos(ang), sn = (float)sin(ang);
    int idx;
    if (f < 16) idx = (isrow ? T_AROW : T_ACOL) + (p * 16 + f) * 2; else idx = (isrow ? T_DROW : T_DCOL) + (p * 8 + (f - 16)) * 2;
    tab[idx] = cs; tab[idx + 1] = sn;
}
KERNEL k_silu(const float* c, const float* c_ctx, float* out) {
    const long g = GID; if (g >= (long)(NB + 1) * D) return;
    const int b = (int)(g / D), k = (int)(g % D); const float v = b < NB ? c[b * D + k] : c_ctx[k];
    out[g] = silu_f(v);
}
KERNEL k_mod(const float* silu, const float* w_ada, const float* b_ada, float* mod) {
    const long g = GID; if (g >= (long)DEPTH * 6 * D) return;
    const int l = (int)(g / (6 * D)), j = (int)(g % (6 * D));
    float acc[NB + 1];
#pragma unroll
    for (int b = 0; b <= NB; ++b) acc[b] = 0.f;
    const float* w = w_ada + (size_t)l * D * 6 * D + j;
    for (int k = 0; k < D; ++k) { const float wv = w[(size_t)k * 6 * D];
#pragma unroll
        for (int b = 0; b <= NB; ++b) acc[b] += silu[b * D + k] * wv; }
    const float bias = b_ada[l * 6 * D + j];
#pragma unroll
    for (int b = 0; b <= NB; ++b) mod[((size_t)l * (NB + 1) + b) * 6 * D + j] = acc[b] + bias;
}
HD int permA(int p) { return (p / 32) * 32 + (p % 32) / 2 + 16 * (p % 2); }
HD int permD(int p) { return (p / 16) * 16 + (p % 16) / 2 + 8 * (p % 2); }
HD int inproj_src_col(int n) {
    if (n < C_VA) return (n / 64) * 64 + permA(n % 64);
    if (n < C_QD) return n;
    if (n < C_VD) return (n / 32) * 32 + permD(n % 32);
    return n;
}
KERNEL k_cvt_win(const float* w_in, bf16_t* wt) {
    const long g = GID; if (g >= (long)DEPTH * PROJ * D) return;
    const int k = (int)(g % D); const int n = (int)((g / D) % PROJ); const int l = (int)(g / ((long)D * PROJ));
    wt[g] = f2bf(w_in[((size_t)l * D + k) * PROJ + inproj_src_col(n)]);
}
KERNEL k_cvt_t(const float* w, bf16_t* wt, int nmat, int K, int N) {
    const long g = GID; if (g >= (long)nmat * K * N) return;
    const int k = (int)(g % K); const int n = (int)((g / K) % N); const int m = (int)(g / ((long)K * N));
    wt[g] = f2bf(w[((size_t)m * K + k) * N + n]);
}
KERNEL k_cvt_gu(const float* wg, const float* wu, bf16_t* wt) {
    const long g = GID; if (g >= (long)NE * 2 * FF * D) return;
    const int k = (int)(g % D); const int n = (int)((g / D) % (2 * FF)); const int e = (int)(g / ((long)D * 2 * FF));
    const int blk = n / 256, bj = (n % 256) / 128, j = n % 128; const float* src = bj ? wu : wg;
    wt[g] = f2bf(src[((size_t)e * D + k) * FF + blk * 128 + j]);
}
KERNEL k_rowstat(const float* xl, const float* xc, float* rstd, int nrows) {
    const long g = GID; if (g >= nrows) return;
    const float* xr = xrow_ptr((float*)xl, (float*)xc, (int)g); float s = 0.f;
    for (int k = 0; k < D; ++k) s += xr[k] * xr[k];
    rstd[g] = 1.0f / sqrtf(s / D + EPS);
}
KERNEL k_rowapply(const float* xl, const float* xc, const float* rstd, const float* nw, const float* modl, int sh_off, int sc_off, bf16_t* hx, int nrows) {
    const long g = GID; if (g >= (long)nrows * D) return;
    const int row = (int)(g / D), k = (int)(g % D); const float* xr = xrow_ptr((float*)xl, (float*)xc, row);
    const float* m = modl + (size_t)row_batch(row) * 6 * D;
    const float v = xr[k] * rstd[row] * nw[k] * (1.0f + m[sc_off + k]) + m[sh_off + k];
    hx[g] = f2bf(v);
}
struct EpiInProj {
    bf16_t* P; const float* tab;
    HD void operator()(int row, int c0, const float* v, const float*) const {
        float o[4] = {v[0], v[1], v[2], v[3]};
        const bool lat = row < RL; const int pos = lat ? row % SEQ : 0; const int gr = pos / GRID_W, gc = pos % GRID_W;
        if (c0 < C_VA) {
            if (lat) { const int p = c0 % 64, grp = p / 32, i0 = (p % 32) / 2;
                const float* t = tab + (grp == 0 ? T_AROW + gr * 32 : T_ACOL + gc * 32) + i0 * 2;
                const float a0 = o[0], b0 = o[1], a1 = o[2], b1 = o[3];
                o[0] = a0 * t[0] - b0 * t[1]; o[1] = b0 * t[0] + a0 * t[1]; o[2] = a1 * t[2] - b1 * t[3]; o[3] = b1 * t[2] + a1 * t[3]; }
            if (c0 < C_KA) { for (int j = 0; j < 4; ++j) o[j] *= QSCALE_A; }
        } else if (c0 >= C_QD && c0 < C_VD) {
            if (lat) { const int p = c0 % 32, grp = p / 16, i0 = (p % 16) / 2;
                const float* t = tab + (grp == 0 ? T_DROW + gr * 16 : T_DCOL + gc * 16) + i0 * 2;
                const float a0 = o[0], b0 = o[1], a1 = o[2], b1 = o[3];
                o[0] = a0 * t[0] - b0 * t[1]; o[1] = b0 * t[0] + a0 * t[1]; o[2] = a1 * t[2] - b1 * t[3]; o[3] = b1 * t[2] + a1 * t[3]; }
            if (c0 < C_KD) { for (int j = 0; j < 4; ++j) o[j] *= QSCALE_D; }
        }
        bf16_t* d = P + (size_t)row * PROJ + c0;
        for (int j = 0; j < 4; ++j) d[j] = f2bf(o[j]);
    }
};
struct EpiOutProj {
    float* xl; float* xc; const float* modl;
    HD void operator()(int row, int c0, const float* v, const float*) const {
        float* xr = xrow_ptr(xl, xc, row) + c0; const float* g1 = modl + (size_t)row_batch(row) * 6 * D + M_G1 + c0;
        for (int j = 0; j < 4; ++j) xr[j] += g1[j] * v[j];
    }
};
struct EpiGateUp {
    bf16_t* H;
    HD void operator()(int row, int c0, const float* v, const float* u) const {
        bf16_t* d = H + (size_t)row * FF + c0;
        for (int j = 0; j < 4; ++j) d[j] = f2bf(silu_f(v[j]) * u[j]);
    }
};
struct EpiDown {
    bf16_t* Y; const float* gate;
    HD void operator()(int row, int c0, const float* v, const float*) const {
        const float g = gate[row]; bf16_t* d = Y + (size_t)row * D + c0;
        for (int j = 0; j < 4; ++j) d[j] = f2bf(v[j] * g);
    }
};
template <class Epi, bool DUAL>
KERNEL k_gemm_naive(const bf16_t* A, const int* rowidx, const bf16_t* Bt, int M, int N, int K, int group_rows, int valid_rows, long bstride, Epi epi) {
    const long g = GID; if (g >= (long)M * (N / 4)) return;
    const int row = (int)(g / (N / 4)), c0 = (int)(g % (N / 4)) * 4;
    if (row % group_rows >= valid_rows) return;
    const int arow = rowidx ? rowidx[row] : row;
    const bf16_t* a = A + (size_t)arow * K; const bf16_t* B = Bt + (size_t)(row / group_rows) * bstride;
    float v[4], u[4];
    for (int j = 0; j < 4; ++j) { const int c = c0 + j; const int br = DUAL ? (c / 128) * 256 + c % 128 : c;
        const bf16_t* b0 = B + (size_t)br * K; float s = 0.f, s2 = 0.f;
        for (int k = 0; k < K; ++k) s += bf2f(a[k]) * bf2f(b0[k]);
        if (DUAL) { const bf16_t* b1 = b0 + (size_t)128 * K; for (int k = 0; k < K; ++k) s2 += bf2f(a[k]) * bf2f(b1[k]); }
        v[j] = s; u[j] = s2; }
    epi(row, c0, v, u);
}
HD void b_attnA(const long g, const bf16_t* P, const float* sink, bf16_t* MIX, int nrows) {
    if (g >= (long)nrows * NHA) return;
    const int h = (int)(g / nrows), row = (int)(g % nrows), kvh = h / GQA;
    const bool lat = row < RL; const int b = lat ? row / SEQ : (row - RL) / CTX; const int t = lat ? row % SEQ : 0;
    float q[HDIM], o[HDIM];
    const bf16_t* qp = P + (size_t)row * PROJ + C_QA + h * HDIM;
#pragma unroll
    for (int d = 0; d < HDIM; ++d) { q[d] = bf2f(qp[d]); o[d] = 0.f; }
    float m = sink[h] * LOG2E, l = 1.0f;
    const int nctx = CTX, lo = lat ? (t - WINDOW < 0 ? 0 : t - WINDOW) : 0, hi = lat ? (t + WINDOW > SEQ - 1 ? SEQ - 1 : t + WINDOW) : -1;
    const int nkeys = nctx + (hi - lo + 1);
    for (int i = 0; i < nkeys; ++i) {
        const int krow = i < nctx ? RL + b * CTX + i : b * SEQ + lo + (i - nctx);
        const bf16_t* kp = P + (size_t)krow * PROJ + C_KA + kvh * HDIM; const bf16_t* vp = P + (size_t)krow * PROJ + C_VA + kvh * HDIM;
        float s = 0.f;
#pragma unroll
        for (int d = 0; d < HDIM; ++d) s += q[d] * bf2f(kp[d]);
        if (s > m) { const float sc = exp2f(m - s); l *= sc;
#pragma unroll
            for (int d = 0; d < HDIM; ++d) o[d] *= sc;
            m = s; }
        const float p = exp2f(s - m); l += p;
#pragma unroll
        for (int d = 0; d < HDIM; ++d) o[d] += p * bf2f(vp[d]);
    }
    const float inv = 1.0f / l; bf16_t* op = MIX + (size_t)row * D + h * HDIM;
#pragma unroll
    for (int d = 0; d < HDIM; ++d) op[d] = f2bf(o[d] * inv);
}
KERNEL k_attnA(const bf16_t* P, const float* sink, bf16_t* MIX, int nrows) { b_attnA(GID, P, sink, MIX, nrows); }
HD void b_attnD(const long g, const bf16_t* P, float* TMP, int nrows) {
    if (g >= (long)nrows * NHC * 2) return;
    const int hc = (int)(g / nrows), row = (int)(g % nrows), h = hc / 2, comp = hc % 2;
    const bool lat = row < RL; const int b = lat ? row / SEQ : (row - RL) / CTX;
    float q[DD], o[2 * DD];
    const bf16_t* qp = P + (size_t)row * PROJ + C_QD + h * 2 * DD + comp * DD;
#pragma unroll
    for (int d = 0; d < DD; ++d) q[d] = bf2f(qp[d]);
#pragma unroll
    for (int d = 0; d < 2 * DD; ++d) o[d] = 0.f;
    float m = -1e30f, l = 0.f;
    const int nkeys = CTX + (lat ? SEQ : 0);
    for (int i = 0; i < nkeys; ++i) {
        const int krow = i < CTX ? RL + b * CTX + i : b * SEQ + (i - CTX);
        const bf16_t* kp = P + (size_t)krow * PROJ + C_KD + h * 2 * DD + comp * DD; const bf16_t* vp = P + (size_t)krow * PROJ + C_VD + h * 2 * DD;
        float s = 0.f;
#pragma unroll
        for (int d = 0; d < DD; ++d) s += q[d] * bf2f(kp[d]);
        if (s > m) { const float sc = exp2f(m - s); l *= sc;
#pragma unroll
            for (int d = 0; d < 2 * DD; ++d) o[d] *= sc;
            m = s; }
        const float p = exp2f(s - m); l += p;
#pragma unroll
        for (int d = 0; d < 2 * DD; ++d) o[d] += p * bf2f(vp[d]);
    }
    const float inv = 1.0f / l; float* op = TMP + (((size_t)row * NHC + h) * 2 + comp) * 2 * DD;
#pragma unroll
    for (int d = 0; d < 2 * DD; ++d) op[d] = o[d] * inv;
}
KERNEL k_attnD(const bf16_t* P, float* TMP, int nrows) { b_attnD(GID, P, TMP, nrows); }
HD void b_diffpost(const long g, const float* TMP, const float* lam_p, const float* subln, float lam_init, bf16_t* MIX, int nrows) {
    if (g >= (long)nrows * NHC) return;
    const int row = (int)(g / NHC), h = (int)(g % NHC);
    float s01 = 0.f, s23 = 0.f;
    for (int d = 0; d < DD; ++d) { s01 += lam_p[d] * lam_p[DD + d]; s23 += lam_p[2 * DD + d] * lam_p[3 * DD + d]; }
    const float lam = expf(s01) - expf(s23) + lam_init;
    const float* t = TMP + ((size_t)row * NHC + h) * 2 * 2 * DD; float y[2 * DD]; float ss = 0.f;
#pragma unroll
    for (int d = 0; d < 2 * DD; ++d) { y[d] = t[d] - lam * t[2 * DD + d]; ss += y[d] * y[d]; }
    const float r = 1.0f / sqrtf(ss / (2 * DD) + EPS) * (1.0f - lam_init);
    bf16_t* op = MIX + (size_t)row * D + 768 + h * 2 * DD;
#pragma unroll
    for (int d = 0; d < 2 * DD; ++d) op[d] = f2bf(y[d] * r * subln[d]);
}
KERNEL k_diffpost(const float* TMP, const float* lam_p, const float* subln, float lam_init, bf16_t* MIX, int nrows) { b_diffpost(GID, TMP, lam_p, subln, lam_init, MIX, nrows); }
HD void b_conv(const long g, const bf16_t* P, const float* cw, bf16_t* MIX, int nrows) {
    if (g >= (long)nrows * CONV_CH) return;
    const int row = (int)(g / CONV_CH), ch = (int)(g % CONV_CH);
    const bool lat = row < RL; const int t = lat ? row % SEQ : (row - RL) % CTX, len = lat ? SEQ : CTX;
    float y = 0.f;
    for (int j = 0; j < 3; ++j) { const int tt = t + j - 1; if (tt < 0 || tt >= len) continue;
        const bf16_t* pr = P + (size_t)(row + j - 1) * PROJ; y += cw[j * CONV_CH + ch] * (bf2f(pr[C_CC + ch]) * bf2f(pr[C_CIN + ch])); }
    MIX[(size_t)row * D + 512 + ch] = f2bf(bf2f(P[(size_t)row * PROJ + C_CB + ch]) * y);
}
KERNEL k_conv(const bf16_t* P, const float* cw, bf16_t* MIX, int nrows) { b_conv(GID, P, cw, MIX, nrows); }
KERNEL k_router(const float* xl, const float* xc, const float* rstd, const float* nw, const float* modl, const float* router, float* logits, int nrows) {
    const long g = GID; if (g >= (long)nrows * NE) return;
    const int row = (int)(g / NE), e = (int)(g % NE); const float* xr = xrow_ptr((float*)xl, (float*)xc, row);
    const float* m = modl + (size_t)row_batch(row) * 6 * D; const float rs = rstd[row]; float s = 0.f;
    for (int k = 0; k < D; ++k) { const float v = xr[k] * rs * nw[k] * (1.0f + m[M_SC2 + k]) + m[M_SH2 + k]; s += v * router[k * NE + e]; }
    logits[g] = s;
}
KERNEL k_aff(float* aff, int nrows) {
    const long g = GID; if (g >= nrows) return;
    float* a = aff + (size_t)g * NE; float m = a[0];
    for (int e = 1; e < NE; ++e) m = a[e] > m ? a[e] : m;
    float s = 0.f; float ex[NE];
#pragma unroll
    for (int e = 0; e < NE; ++e) { ex[e] = expf(a[e] - m); s += ex[e]; }
#pragma unroll
    for (int e = 0; e < NE; ++e) a[e] = ex[e] / s;
}
KERNEL k_select(const float* aff, int* sel, float* gate, int* tokslot, int nrows) {
    const long g = GID; if (g >= (long)nrows * NE) return;
    const int row = (int)(g / NE), e = (int)(g % NE);
    const bool lat = row < RL; const int b = lat ? row / SEQ : (row - RL) / CTX; const int t = lat ? row % SEQ : (row - RL) % CTX;
    const int n = lat ? SEQ : CTX, cap = lat ? CAPL : CAPC, base = lat ? b * SEQ : RL + b * CTX;
    const float a = aff[(size_t)row * NE + e]; int rank = 0;
    for (int j = 0; j < n; ++j) { const float o = aff[(size_t)(base + j) * NE + e]; rank += (o > a || (o == a && j < t)) ? 1 : 0; }
    int slot = -1;
    if (rank < cap) { slot = e * SLOTS_E + (lat ? b * CAPL + rank : SLOTS_L + b * CAPC + rank); sel[slot] = row; gate[slot] = a; }
    tokslot[g] = slot;
}
KERNEL k_combine(float* xl, float* xc, const bf16_t* Y, const int* tokslot, const float* modl, int nrows) {
    const long g = GID; if (g >= (long)nrows * D) return;
    const int row = (int)(g / D), k = (int)(g % D); float s = 0.f;
    for (int e = 0; e < NE; ++e) { const int sl = tokslot[(size_t)row * NE + e]; if (sl >= 0) s += bf2f(Y[(size_t)sl * D + k]); }
    float* xr = xrow_ptr(xl, xc, row); xr[k] += modl[(size_t)row_batch(row) * 6 * D + M_G2 + k] * s;
}
KERNEL k_final(float* xl, const float* rstd, const float* nw) {
    const long g = GID; if (g >= (long)RL * D) return;
    const int row = (int)(g / D), k = (int)(g % D); xl[g] = xl[g] * rstd[row] * nw[k];
}

#ifndef HOST_TEST
typedef short bf16x8 __attribute__((ext_vector_type(8)));
typedef float f32x4 __attribute__((ext_vector_type(4)));
template <class Epi, bool DUAL>
__global__ void __launch_bounds__(256) k_gemm_mfma(const bf16_t* __restrict__ A, const int* __restrict__ rowidx, const bf16_t* __restrict__ Bt, int M, int N, int K, int group_rows, int valid_rows, long bstride, Epi epi) {
    const int tid = threadIdx.x, wid = tid >> 6, lane = tid & 63, fr = lane & 15, fq = lane >> 4, wr = wid >> 1, wc = wid & 1;
    const int row0 = blockIdx.y * 128 + wr * 64;
    if ((blockIdx.y * 128) % group_rows >= valid_rows) return;
    const bf16_t* B = Bt + (size_t)((blockIdx.y * 128) / group_rows) * bstride;
    int brow[4], ocol[4];
    if (!DUAL) { for (int i = 0; i < 4; ++i) { brow[i] = blockIdx.x * 128 + wc * 64 + i * 16; ocol[i] = brow[i]; } }
    else { const int hc0 = blockIdx.x * 64 + wc * 32;
        for (int i = 0; i < 2; ++i) { ocol[i] = hc0 + i * 16; brow[i] = (ocol[i] / 128) * 256 + ocol[i] % 128; brow[i + 2] = brow[i] + 128; ocol[i + 2] = ocol[i]; } }
    const bf16_t* ap[4]; const bf16_t* bp[4];
#pragma unroll
    for (int m = 0; m < 4; ++m) { const int r = row0 + m * 16 + fr; const int ar = rowidx ? rowidx[r] : r; ap[m] = A + (size_t)ar * K + fq * 8; }
#pragma unroll
    for (int i = 0; i < 4; ++i) bp[i] = B + (size_t)(brow[i] + fr) * K + fq * 8;
    f32x4 acc[4][4];
#pragma unroll
    for (int m = 0; m < 4; ++m)
#pragma unroll
        for (int i = 0; i < 4; ++i) acc[m][i] = (f32x4){0.f, 0.f, 0.f, 0.f};
    for (int k0 = 0; k0 < K; k0 += 32) {
        bf16x8 af[4], bfr[4];
#pragma unroll
        for (int m = 0; m < 4; ++m) af[m] = *(const bf16x8*)(ap[m] + k0);
#pragma unroll
        for (int i = 0; i < 4; ++i) bfr[i] = *(const bf16x8*)(bp[i] + k0);
#pragma unroll
        for (int m = 0; m < 4; ++m)
#pragma unroll
            for (int i = 0; i < 4; ++i) acc[m][i] = __builtin_amdgcn_mfma_f32_16x16x32_bf16(bfr[i], af[m], acc[m][i], 0, 0, 0);
    }
#pragma unroll
    for (int m = 0; m < 4; ++m) { const int r = row0 + m * 16 + fr;
#pragma unroll
        for (int i = 0; i < (DUAL ? 2 : 4); ++i) {
            float v[4] = {acc[m][i][0], acc[m][i][1], acc[m][i][2], acc[m][i][3]};
            float u[4] = {acc[m][DUAL ? i + 2 : i][0], acc[m][DUAL ? i + 2 : i][1], acc[m][DUAL ? i + 2 : i][2], acc[m][DUAL ? i + 2 : i][3]};
            epi(r, ocol[i] + 4 * fq, v, u); } }
}
template <class Epi, bool DUAL>
static void launch_gemm(hipStream_t stream, const bf16_t* A, const int* rowidx, const bf16_t* Bt, int M, int N, int K, int group_rows, int valid_rows, long bstride, Epi epi) {
    dim3 grid(DUAL ? N / 64 : N / 128, M / 128);
    hipLaunchKernelGGL((k_gemm_mfma<Epi, DUAL>), grid, dim3(256), 0, stream, A, rowidx, Bt, M, N, K, group_rows, valid_rows, bstride, epi);
}
#define GEMM(Epi, DUAL, ...) launch_gemm<Epi, DUAL>(stream, __VA_ARGS__)
#else
#define GEMM(Epi, DUAL, A, rowidx, Bt, M, N, K, gr, vr, bs, epi) LAUNCH((k_gemm_naive<Epi, DUAL>), (long)(M) * ((N) / 4), A, rowidx, Bt, M, N, K, gr, vr, bs, epi)
#endif

#ifdef HOST_TEST
typedef int hipStream_t;
#endif
static void forward(const Ptrs& p, hipStream_t stream) {
    (void)stream;
    unsigned char* ws = p.ws;
    float* tab = (float*)(ws + WS_TAB); float* silu = (float*)(ws + WS_SILU); float* mod = (float*)(ws + WS_MOD); float* rstd = (float*)(ws + WS_RSTD);
    float* aff = (float*)(ws + WS_AFF); int* sel = (int*)(ws + WS_SEL); float* gate = (float*)(ws + WS_GATE); int* tokslot = (int*)(ws + WS_TOKSLOT);
    float* xc = (float*)(ws + WS_XC); float* xl = p.out;
    bf16_t* win = (bf16_t*)(ws + WS_WIN); bf16_t* wout = (bf16_t*)(ws + WS_WOUT);
    bf16_t* P = (bf16_t*)(ws + WS_R1); bf16_t* H = (bf16_t*)(ws + WS_R1);
    bf16_t* Y = (bf16_t*)(ws + WS_R2); bf16_t* MIX = (bf16_t*)(ws + WS_R2); bf16_t* HX2 = (bf16_t*)(ws + WS_R2 + (size_t)RALL * D * 2); float* TMP = (float*)HX2;
    bf16_t* HX = (bf16_t*)(ws + WS_R3);
    LAUNCH(k_tables, (long)(NROWS + 64) * 24, tab);
    LAUNCH(k_silu, (long)(NB + 1) * D, p.c, p.c_ctx, silu);
    LAUNCH(k_mod, (long)DEPTH * 6 * D, silu, p.w_ada, p.b_ada, mod);
    LAUNCH(k_cvt_win, (long)DEPTH * PROJ * D, p.w_in, win);
    LAUNCH(k_cvt_t, (long)DEPTH * D * D, p.w_out, wout, DEPTH, D, D);
#ifdef HOST_TEST
    memcpy(xl, p.x, (size_t)RL * D * 4); memcpy(xc, p.ctx, (size_t)RC * D * 4);
#else
    (void)hipMemcpyAsync(xl, p.x, (size_t)RL * D * 4, hipMemcpyDeviceToDevice, stream);
    (void)hipMemcpyAsync(xc, p.ctx, (size_t)RC * D * 4, hipMemcpyDeviceToDevice, stream);
#endif
    for (int l = 0; l < DEPTH; ++l) {
        const bool need_ctx = l < DEPTH - 1; const int nq = need_ctx ? RALL : RL;
        const float* modl = mod + (size_t)l * (NB + 1) * 6 * D; const float lam_init = 0.8f - 0.6f * expf(-0.3f * (float)l);
        bf16_t* wgu = (bf16_t*)(ws + WS_WGU) + (size_t)(l & 1) * NE * 2 * FF * D; bf16_t* wd = (bf16_t*)(ws + WS_WD) + (size_t)(l & 1) * NE * D * FF;
        LAUNCH(k_cvt_gu, (long)NE * 2 * FF * D, p.w_gate + (size_t)l * NE * D * FF, p.w_up + (size_t)l * NE * D * FF, wgu);
        LAUNCH(k_cvt_t, (long)NE * FF * D, p.w_down + (size_t)l * NE * FF * D, wd, NE, FF, D);
        LAUNCH(k_rowstat, RALL, xl, xc, rstd, RALL);
        LAUNCH(k_rowapply, (long)RALL * D, xl, xc, rstd, p.norm1 + l * D, modl, M_SH1, M_SC1, HX, RALL);
        GEMM(EpiInProj, false, HX, (const int*)nullptr, win + (size_t)l * PROJ * D, RALL, PROJ, D, RALL, RALL, 0L, (EpiInProj{P, tab}));
        LAUNCH(k_attnA, (long)nq * NHA, P, p.attn_sink + l * NHA, MIX, nq);
        LAUNCH(k_attnD, (long)nq * NHC * 2, P, TMP, nq);
        LAUNCH(k_diffpost, (long)nq * NHC, TMP, p.diff_lambda + l * 4 * DD, p.diff_subln + l * 2 * DD, lam_init, MIX, nq);
        LAUNCH(k_conv, (long)nq * CONV_CH, P, p.conv_w + l * 3 * CONV_CH, MIX, nq);
        GEMM(EpiOutProj, false, MIX, (const int*)nullptr, wout + (size_t)l * D * D, nq, D, D, nq, nq, 0L, (EpiOutProj{xl, xc, modl}));
        LAUNCH(k_rowstat, nq, xl, xc, rstd, nq);
        LAUNCH(k_rowapply, (long)nq * D, xl, xc, rstd, p.norm2 + l * D, modl, M_SH2, M_SC2, HX2, nq);
        LAUNCH(k_router, (long)nq * NE, xl, xc, rstd, p.norm2 + l * D, modl, p.router + (size_t)l * D * NE, aff, nq);
        LAUNCH(k_aff, nq, aff, nq);
        LAUNCH(k_select, (long)nq * NE, aff, sel, gate, tokslot, nq);
        const int vr = need_ctx ? SLOTS_E : SLOTS_L;
        GEMM(EpiGateUp, true, HX2, sel, wgu, NSLOT, FF, D, SLOTS_E, vr, (long)2 * FF * D, (EpiGateUp{H}));
        GEMM(EpiDown, false, H, (const int*)nullptr, wd, NSLOT, D, FF, SLOTS_E, vr, (long)D * FF, (EpiDown{Y, gate}));
        LAUNCH(k_combine, (long)nq * D, xl, xc, Y, tokslot, modl, nq);
    }
    LAUNCH(k_rowstat, RL, xl, xc, rstd, RL);
    LAUNCH(k_final, (long)RL * D, xl, rstd, p.norm_final);
}

#ifndef HOST_TEST
#define LAS __attribute__((address_space(3)))
#define GAS __attribute__((address_space(1)))
typedef unsigned u32x4 __attribute__((ext_vector_type(4)));
typedef unsigned u32x2 __attribute__((ext_vector_type(2)));
typedef float f32x2_t __attribute__((ext_vector_type(2)));
constexpr int NT = 512, NWV = 8;
constexpr int LDS_BYTES = 163840;
constexpr int LDS_MISC = LDS_BYTES - 256;
constexpr int CW_BAR = 4096;

__device__ __forceinline__ unsigned cvt_pk_bf16(float lo, float hi) { unsigned r; asm volatile("v_cvt_pk_bf16_f32 %0, %1, %2" : "=v"(r) : "v"(lo), "v"(hi)); return r; }
__device__ __forceinline__ float dpp_f(float v, const int ctrl_tag) {
    int r;
    switch (ctrl_tag) {
        case 0: r = __builtin_amdgcn_update_dpp(0, __builtin_bit_cast(int, v), 0xB1, 0xF, 0xF, true); break;
        case 1: r = __builtin_amdgcn_update_dpp(0, __builtin_bit_cast(int, v), 0x4E, 0xF, 0xF, true); break;
        case 2: r = __builtin_amdgcn_update_dpp(0, __builtin_bit_cast(int, v), 0x141, 0xF, 0xF, true); break;
        default: r = __builtin_amdgcn_update_dpp(0, __builtin_bit_cast(int, v), 0x140, 0xF, 0xF, true); break;
    }
    return __builtin_bit_cast(float, r);
}
__device__ __forceinline__ float wave_sum(float v) {
    v += dpp_f(v, 0); v += dpp_f(v, 1); v += dpp_f(v, 2); v += dpp_f(v, 3);
    const int b = __builtin_bit_cast(int, v);
    return (__builtin_bit_cast(float, __builtin_amdgcn_readlane(b, 0)) + __builtin_bit_cast(float, __builtin_amdgcn_readlane(b, 16)))
         + (__builtin_bit_cast(float, __builtin_amdgcn_readlane(b, 32)) + __builtin_bit_cast(float, __builtin_amdgcn_readlane(b, 48)));
}
#define LDS_WAIT() asm volatile("s_waitcnt lgkmcnt(0)" ::: "memory")
__device__ __forceinline__ float wave_max(float v) {
    v = fmaxf(v, dpp_f(v, 0)); v = fmaxf(v, dpp_f(v, 1)); v = fmaxf(v, dpp_f(v, 2)); v = fmaxf(v, dpp_f(v, 3));
    const int b = __builtin_bit_cast(int, v);
    return fmaxf(fmaxf(__builtin_bit_cast(float, __builtin_amdgcn_readlane(b, 0)), __builtin_bit_cast(float, __builtin_amdgcn_readlane(b, 16))),
                 fmaxf(__builtin_bit_cast(float, __builtin_amdgcn_readlane(b, 32)), __builtin_bit_cast(float, __builtin_amdgcn_readlane(b, 48))));
}

#define LDS_RD16_B128(r, addr, STRIDE) asm volatile( \
    "ds_read_b128 %0, %16\n\tds_read_b128 %1, %16 offset:%c17\n\tds_read_b128 %2, %16 offset:2*%c17\n\tds_read_b128 %3, %16 offset:3*%c17\n\t" \
    "ds_read_b128 %4, %16 offset:4*%c17\n\tds_read_b128 %5, %16 offset:5*%c17\n\tds_read_b128 %6, %16 offset:6*%c17\n\tds_read_b128 %7, %16 offset:7*%c17\n\t" \
    "ds_read_b128 %8, %16 offset:8*%c17\n\tds_read_b128 %9, %16 offset:9*%c17\n\tds_read_b128 %10, %16 offset:10*%c17\n\tds_read_b128 %11, %16 offset:11*%c17\n\t" \
    "ds_read_b128 %12, %16 offset:12*%c17\n\tds_read_b128 %13, %16 offset:13*%c17\n\tds_read_b128 %14, %16 offset:14*%c17\n\tds_read_b128 %15, %16 offset:15*%c17\n\ts_waitcnt lgkmcnt(0)" \
    : "=&v"(r[0]), "=&v"(r[1]), "=&v"(r[2]), "=&v"(r[3]), "=&v"(r[4]), "=&v"(r[5]), "=&v"(r[6]), "=&v"(r[7]), "=&v"(r[8]), "=&v"(r[9]), "=&v"(r[10]), "=&v"(r[11]), "=&v"(r[12]), "=&v"(r[13]), "=&v"(r[14]), "=&v"(r[15]) \
    : "v"(addr), "i"(STRIDE) : "memory")
#define LDS_ISSUE8_B128(r, addr, STRIDE) asm volatile( \
    "ds_read_b128 %0, %8\n\tds_read_b128 %1, %8 offset:%c9\n\tds_read_b128 %2, %8 offset:2*%c9\n\tds_read_b128 %3, %8 offset:3*%c9\n\t" \
    "ds_read_b128 %4, %8 offset:4*%c9\n\tds_read_b128 %5, %8 offset:5*%c9\n\tds_read_b128 %6, %8 offset:6*%c9\n\tds_read_b128 %7, %8 offset:7*%c9" \
    : "=&v"(r[0]), "=&v"(r[1]), "=&v"(r[2]), "=&v"(r[3]), "=&v"(r[4]), "=&v"(r[5]), "=&v"(r[6]), "=&v"(r[7]) \
    : "v"(addr), "i"(STRIDE) : "memory")
#define LDS_WAIT8(r, N) asm volatile("s_waitcnt lgkmcnt(" #N ")" : "+v"(r[0]), "+v"(r[1]), "+v"(r[2]), "+v"(r[3]), "+v"(r[4]), "+v"(r[5]), "+v"(r[6]), "+v"(r[7]) :: "memory")
#define LDS_RD11_B128(r, addr, STRIDE) asm volatile( \
    "ds_read_b128 %0, %11\n\tds_read_b128 %1, %11 offset:%c12\n\tds_read_b128 %2, %11 offset:2*%c12\n\tds_read_b128 %3, %11 offset:3*%c12\n\t" \
    "ds_read_b128 %4, %11 offset:4*%c12\n\tds_read_b128 %5, %11 offset:5*%c12\n\tds_read_b128 %6, %11 offset:6*%c12\n\tds_read_b128 %7, %11 offset:7*%c12\n\t" \
    "ds_read_b128 %8, %11 offset:8*%c12\n\tds_read_b128 %9, %11 offset:9*%c12\n\tds_read_b128 %10, %11 offset:10*%c12\n\ts_waitcnt lgkmcnt(0)" \
    : "=&v"(r[0]), "=&v"(r[1]), "=&v"(r[2]), "=&v"(r[3]), "=&v"(r[4]), "=&v"(r[5]), "=&v"(r[6]), "=&v"(r[7]), "=&v"(r[8]), "=&v"(r[9]), "=&v"(r[10]) \
    : "v"(addr), "i"(STRIDE) : "memory")
__device__ __forceinline__ int lane_id_asm() { int l; asm volatile("v_mbcnt_lo_u32_b32 %0, -1, 0\n\tv_mbcnt_hi_u32_b32 %0, -1, %0" : "=v"(l)); return l; }
__device__ __forceinline__ int tid_w(int wv) { return wv * 64 + lane_id_asm(); }
#define tid_l() tid_w(C.wv)

#define XB_TMO      128
#define XB_XCNT(j)  (256  + 64 * (j))
#define XB_XSUB(j)  (1280 + 64 * (j))
#define XB_XGEN(j)  (2304 + 64 * (j))
#define XB_TOP      3328
#define XB_TOPGEN   3392
#define XCD_BAR_WORDS 3456
#define XB_SPIN_CAP (1u << 24)
__device__ __forceinline__ unsigned xb_ld(unsigned* p)              { return __hip_atomic_load(p, __ATOMIC_RELAXED, __HIP_MEMORY_SCOPE_AGENT); }
__device__ __forceinline__ unsigned xb_add(unsigned* p, unsigned v) { return __hip_atomic_fetch_add(p, v, __ATOMIC_RELAXED, __HIP_MEMORY_SCOPE_AGENT); }
__device__ __forceinline__ unsigned xb_xcc_id() { return (unsigned)__builtin_amdgcn_s_getreg((3 << 11) | 20) & 0xFu; }
#define XB_SPIN(cond, bar) do { unsigned _sp = 0; while (cond) { __builtin_amdgcn_s_sleep(1); \
    if ((++_sp & 255u) == 0u) { if (xb_ld(&(bar)[XB_TMO])) break; if (_sp > XB_SPIN_CAP) { atomicAdd(&(bar)[XB_TMO], 1u); break; } } } } while (0)
struct XcdBarrier { unsigned* bar; unsigned x; volatile LAS unsigned* st; int wv; };
__device__ __forceinline__ XcdBarrier xcd_barrier_post(unsigned* bar, volatile LAS unsigned* st, int wv) {
    XcdBarrier b; b.bar = bar; b.x = xb_xcc_id(); b.st = st; b.wv = wv;
    if (tid_w(wv) == 0) (void)xb_add(&bar[XB_XCNT(b.x)], 1u);
    return b;
}
__device__ __forceinline__ void xcd_barrier_complete(unsigned* bar, unsigned x, unsigned& nloc, unsigned& nx) {
    const unsigned G = gridDim.x * gridDim.y * gridDim.z;
    unsigned sum, cnt, mine, sp = 0u;
    for (;;) {
        sum = 0u; cnt = 0u; mine = 0u;
#pragma unroll
        for (unsigned j = 0; j < 16; ++j) { const unsigned c = xb_ld(&bar[XB_XCNT(j)]); sum += c; cnt += (c > 0u) ? 1u : 0u; mine = (j == x) ? c : mine; }
        if (sum == G) break;
        __builtin_amdgcn_s_sleep(1);
        if ((++sp & 255u) == 0u) { if (xb_ld(&bar[XB_TMO])) break; if (sp > XB_SPIN_CAP) { atomicAdd(&bar[XB_TMO], 1u); break; } }
    }
    nloc = mine > 0u ? mine : 1u; nx = cnt > 0u ? cnt : 1u;
}
__device__ __forceinline__ void xcd_barrier(const XcdBarrier& b) {
    asm volatile("s_waitcnt vmcnt(0)" ::: "memory");
    __syncthreads();
    if (tid_w(b.wv) == 0) {
        unsigned* bar = b.bar;
        __builtin_amdgcn_s_waitcnt(0);
        unsigned nloc = b.st[0], nx = b.st[1];
        if (nloc == 0u) { xcd_barrier_complete(bar, b.x, nloc, nx); b.st[0] = nloc; b.st[1] = nx; }
        const unsigned old = xb_add(&bar[XB_XSUB(b.x)], 1u);
        const unsigned gen = old / nloc;
        if (old + 1u == (gen + 1u) * nloc) {
            __builtin_amdgcn_fence(__ATOMIC_RELEASE, "agent");
            asm volatile("s_waitcnt vmcnt(0)" ::: "memory");
            const unsigned og = xb_add(&bar[XB_TOP], 1u);
            const unsigned tg = og / nx;
            if (og + 1u == (tg + 1u) * nx) xb_add(&bar[XB_TOPGEN], 1u);
            else XB_SPIN(xb_ld(&bar[XB_TOPGEN]) == tg, bar);
            __builtin_amdgcn_fence(__ATOMIC_ACQUIRE, "agent");
            xb_add(&bar[XB_XGEN(b.x)], 1u);
            asm volatile("s_waitcnt vmcnt(0)" ::: "memory");
        } else {
            XB_SPIN(xb_ld(&bar[XB_XGEN(b.x)]) == gen, bar);
            __builtin_amdgcn_fence(__ATOMIC_ACQUIRE, "agent");
            asm volatile("s_waitcnt vmcnt(0)" ::: "memory");
        }
    }
    __syncthreads();
}

namespace pg {
constexpr int BM = 256, BK = 64, HALF = 128, HTB = HALF * BK * 2  , STAGE_BYTES = 8 * HTB, NXCD = 8, WGM = 8;
constexpr int TPE_FULL = SLOTS_E / BM;
__host__ __device__ __forceinline__ int lds_byte(int r, int c) { const int st = (r >> 4) * 2 + (c >> 5), rr = r & 15, cc = c & 31, ob = rr * 64 + cc * 2; return st * 1024 + (ob ^ (((ob >> 9) & 1) << 5)); }
__host__ __device__ __forceinline__ void stage_rc(int b, int& R, int& C) { const int st = b / 1024, sb = b % 1024, swz = sb ^ (((sb >> 9) & 1) << 5); R = (st >> 1) * 16 + swz / 64; C = (st & 1) * 32 + (swz % 64) / 2; }
__host__ __device__ __forceinline__ int perm32(int rho) { const int n = rho >> 4, i = rho & 15; return 8 * (i >> 2) + 4 * n + (i & 3); }
struct Unit { int m0, pn, e; };
struct GemmD { const char* A; const int* rowidx; const char* Bt; size_t bstride; int K; };
struct Order {
    int nM, nN, nwg, G, c, tpe;
    __device__ void init(int nM_, int nN_, int G_, int c_, int tpe_) { nM = nM_; nN = nN_; nwg = nM * nN; G = G_; c = c_; tpe = tpe_; }
    __device__ bool next(int i, Unit& u) const {
        const long L = (long)i * G + c; if (L >= nwg) return false;
        int wgid = (int)L; { const int q = nwg / NXCD, r = nwg % NXCD, xcd = wgid % NXCD, off = wgid / NXCD; wgid = (xcd < r ? xcd * (q + 1) : r * (q + 1) + (xcd - r) * q) + off; }
        const int nig = WGM * nN, gid = wgid / nig, fm = gid * WGM, gsz = (nM - fm) < WGM ? (nM - fm) : WGM;
        const int pm = fm + ((wgid % nig) % gsz); u.pn = (wgid % nig) / gsz;
        if (tpe > 0) { u.e = pm / tpe; u.m0 = (u.e * TPE_FULL + pm % tpe) * BM; } else { u.e = 0; u.m0 = pm * BM; }
        return true;
    }
};
template <class T> struct has_pre { template <class U> static constexpr bool test(decltype(U::HAS_PRE)*) { return U::HAS_PRE; } template <class U> static constexpr bool test(...) { return false; } static constexpr bool value = test<T>(nullptr); };
typedef int v4i32_t __attribute__((ext_vector_type(4)));
typedef int v8i32_t __attribute__((ext_vector_type(8)));
__device__ __forceinline__ v8i32_t cat8(const bf16x8 a, const bf16x8 b) { return __builtin_shufflevector(__builtin_bit_cast(v4i32_t, a), __builtin_bit_cast(v4i32_t, b), 0, 1, 2, 3, 4, 5, 6, 7); }
constexpr int SCALE_ONE = 0x7F7F7F7F, SCALE_W = 0x79797979;
template <bool I> struct acc_sel { typedef f32x4 type; };
template <> struct acc_sel<true> { typedef v4i32_t type; };
template <class Epi, bool GATHER, int QM = 0>
__device__ __forceinline__ void gemm_phase(LAS unsigned char* lds, const GemmD g, const Order& S, const Epi& E, int wv) {
    const int tid = tid_w(wv), wid = __builtin_amdgcn_readfirstlane(tid >> 6), lane = tid & 63, wr = wid >> 2, wc = wid & 3, fr = lane & 15, fq = lane >> 4;
    constexpr bool FP8 = (QM == 1), I8 = (QM == 2);
    typedef typename acc_sel<QM == 2>::type acc_t;
    const int K = g.K, nt = K / BK;
    int Rr[2], Cc[2]; unsigned voffB[2];
#pragma unroll
    for (int i = 0; i < 2; ++i) { int R, C; stage_rc(tid * 16 + i * 8192, R, C); Rr[i] = R; Cc[i] = C; const int Rb = Epi::PERM ? ((R & ~31) + perm32(R & 31)) : R; voffB[i] = (unsigned)(Rb * K + C) * 2u; }
    const unsigned kstep = (unsigned)(BK * 2);
    const size_t hstep = (size_t)HALF * K * 2;
    const unsigned ldsw = (unsigned)wid * 1024u;
    const int aoff = lds_byte(wr * 64 + fr, fq * 8), boff = lds_byte(wc * 32 + fr, fq * 8);
#define PG_SA(b, h) (((b) * 2 + (h)) * HTB)
#define PG_SB(b, h) ((4 + (b) * 2 + (h)) * HTB)
#define PG_STAGE_B(bufoff, gbase) do { _Pragma("unroll") for (int _i = 0; _i < 2; ++_i) \
        __builtin_amdgcn_global_load_lds((const unsigned*)((const char*)(gbase) + voffB[_i]), (LAS unsigned*)(lds + (bufoff) + ldsw + _i * 8192), 16, 0, 0); } while (0)
#define PG_STAGE_A(bufoff, OFFS, h, kb) do { _Pragma("unroll") for (int _i = 0; _i < 2; ++_i) \
        __builtin_amdgcn_global_load_lds((const unsigned*)(g.A + (size_t)(OFFS)[h][_i] + (kb)), (LAS unsigned*)(lds + (bufoff) + ldsw + _i * 8192), 16, 0, 0); } while (0)
#define PG_ROWOFF(DST, U) do { _Pragma("unroll") for (int _h = 0; _h < 2; ++_h) _Pragma("unroll") for (int _i = 0; _i < 2; ++_i) { int _r = (U).m0 + _h * HALF + Rr[_i]; if (GATHER) _r = g.rowidx[_r]; \
        (DST)[_h][_i] = (unsigned)(((size_t)_r * K + Cc[_i]) * 2); } } while (0)
#define PG_LDA(dst, b, h) do { _Pragma("unroll") for (int m = 0; m < 4; ++m) { if constexpr (FP8) { const v4i32_t _x0 = *(const LAS v4i32_t*)(lds + PG_SA(b, h) + aoff + m * 2048), _x1 = *(const LAS v4i32_t*)(lds + PG_SA(b, h) + aoff + m * 2048 + 1024); \
        dst##8[m] = __builtin_shufflevector(_x0, _x1, 0, 1, 2, 3, 4, 5, 6, 7); } else { _Pragma("unroll") for (int k = 0; k < 2; ++k) dst[m][k] = *(const LAS bf16x8*)(lds + PG_SA(b, h) + aoff + m * 2048 + k * 1024); } } } while (0)
#define PG_LDB(dst, b, h) do { _Pragma("unroll") for (int n = 0; n < 2; ++n) { if constexpr (FP8) { const v4i32_t _x0 = *(const LAS v4i32_t*)(lds + PG_SB(b, h) + boff + n * 2048), _x1 = *(const LAS v4i32_t*)(lds + PG_SB(b, h) + boff + n * 2048 + 1024); \
        dst##8[n] = __builtin_shufflevector(_x0, _x1, 0, 1, 2, 3, 4, 5, 6, 7); } else { _Pragma("unroll") for (int k = 0; k < 2; ++k) dst[n][k] = *(const LAS bf16x8*)(lds + PG_SB(b, h) + boff + n * 2048 + k * 1024); } } } while (0)
#define PG_MMA(ai, bj, At, Bt) do { __builtin_amdgcn_s_setprio(1); _Pragma("unroll") for (int m = 0; m < 4; ++m) _Pragma("unroll") for (int n = 0; n < 2; ++n) { \
        if constexpr (FP8) asm volatile("s_nop 1\n\tv_mfma_scale_f32_16x16x128_f8f6f4 %0, %1, %2, %0, %3, %4 op_sel_hi:[0,0,0]" : "+v"(acc[ai][bj][m][n]) : "v"(Bt##8[n]), "v"(At##8[m]), "v"(sc_w), "v"(sc_a)); \
        else if constexpr (I8) { _Pragma("unroll") for (int k = 0; k < 2; ++k) acc[ai][bj][m][n] = __builtin_amdgcn_mfma_i32_16x16x64_i8(__builtin_bit_cast(v4i32_t, Bt[n][k]), __builtin_bit_cast(v4i32_t, At[m][k]), acc[ai][bj][m][n], 0, 0, 0); } \
        else if constexpr (!I8 && !FP8) { _Pragma("unroll") for (int k = 0; k < 2; ++k) acc[ai][bj][m][n] = __builtin_amdgcn_mfma_f32_16x16x32_bf16(Bt[n][k], At[m][k], acc[ai][bj][m][n], 0, 0, 0); } } \
        __builtin_amdgcn_s_setprio(0); } while (0)
#define PG_WAIT_V(n) asm volatile("s_waitcnt vmcnt(" #n ")" ::: "memory")
#define PG_WAIT_L(n) asm volatile("s_waitcnt lgkmcnt(" #n ")" ::: "memory")
#define PG_BAR __builtin_amdgcn_s_barrier()
#define PG_SCHED __builtin_amdgcn_sched_barrier(0)
    Unit cur, nxt; int ui = 0;
    if (!S.next(0, cur)) return;
    acc_t acc[2][2][4][2];
#pragma unroll
    for (int a = 0; a < 2; ++a)
#pragma unroll
        for (int b = 0; b < 2; ++b)
#pragma unroll
            for (int m = 0; m < 4; ++m)
#pragma unroll
                for (int n = 0; n < 2; ++n) { acc[a][b][m][n] = acc_t{}; if constexpr (FP8) asm volatile("" : "+v"(acc[a][b][m][n])); }
    bf16x8 At[4][2], B0[2][2], B1[2][2]; v8i32_t At8[4], B08[2], B18[2];
    int sc_w = SCALE_W, sc_a = SCALE_ONE; if constexpr (FP8) { asm volatile("" : "+v"(sc_w), "+v"(sc_a)); }
    unsigned offA[2][2], offN[2][2];
    float epre[8] = {0.f, 0.f, 0.f, 0.f, 0.f, 0.f, 0.f, 0.f};
    if constexpr (has_pre<Epi>::value) E.pre(epre, cur, wr, fr);
    PG_ROWOFF(offA, cur);
    if (GATHER) PG_WAIT_V(0);
    const char* cB = g.Bt + (size_t)cur.e * g.bstride + (size_t)cur.pn * BM * K * 2;
    PG_STAGE_B(PG_SB(0, 0), cB); PG_STAGE_B(PG_SB(0, 1), cB + hstep); PG_STAGE_A(PG_SA(0, 0), offA, 0, 0u); PG_STAGE_A(PG_SA(0, 1), offA, 1, 0u);
    if (wr == 1) PG_BAR;
    PG_WAIT_V(2); PG_BAR;
    PG_STAGE_B(PG_SB(1, 0), cB + kstep); PG_STAGE_A(PG_SA(1, 0), offA, 0, kstep); PG_STAGE_B(PG_SB(1, 1), cB + hstep + kstep);
    PG_WAIT_V(6); PG_BAR;
    for (;;) {
        const bool has_next = S.next(ui + 1, nxt);
        const char* nB = has_next ? g.Bt + (size_t)nxt.e * g.bstride + (size_t)nxt.pn * BM * K * 2 : cB;
        if (has_next) { PG_ROWOFF(offN, nxt); if (GATHER) PG_WAIT_V(0); }
        else {
#pragma unroll
            for (int h = 0; h < 2; ++h)
#pragma unroll
                for (int i = 0; i < 2; ++i) offN[h][i] = offA[h][i]; }
        for (int t = 0; t < nt; t += 2) {
            const bool last = (t == nt - 2);
            unsigned o2[2][2];
#pragma unroll
            for (int h = 0; h < 2; ++h)
#pragma unroll
                for (int i = 0; i < 2; ++i) o2[h][i] = last ? offN[h][i] : offA[h][i];
            const unsigned ka1 = (unsigned)(t + 1) * kstep, ka2 = last ? 0u : (unsigned)(t + 2) * kstep, ka3 = ka2 + kstep;
            const char* b2 = last ? nB : cB + (size_t)(t + 2) * kstep; const char* b3 = b2 + kstep;
            PG_LDB(B0, 0, 0); PG_LDB(B1, 0, 1); PG_SCHED; PG_LDA(At, 0, 0); PG_STAGE_A(PG_SA(1, 1), offA, 1, ka1);
            PG_WAIT_V(8); PG_WAIT_L(0); PG_BAR; PG_MMA(0, 0, At, B0); PG_MMA(0, 1, At, B1); PG_BAR; PG_SCHED;
            PG_LDA(At, 0, 1); PG_STAGE_B(PG_SB(0, 0), b2); PG_STAGE_B(PG_SB(0, 1), b2 + hstep); PG_STAGE_A(PG_SA(0, 0), o2, 0, ka2);
            PG_WAIT_V(8); PG_WAIT_L(0); PG_BAR; PG_MMA(1, 0, At, B0); PG_MMA(1, 1, At, B1); PG_BAR; PG_SCHED;
            PG_LDB(B0, 1, 0); PG_LDB(B1, 1, 1); PG_SCHED; PG_LDA(At, 1, 0); PG_STAGE_A(PG_SA(0, 1), o2, 1, ka2);
            PG_WAIT_V(8); PG_WAIT_L(0); PG_BAR; PG_MMA(0, 0, At, B0); PG_MMA(0, 1, At, B1); PG_BAR; PG_SCHED;
            PG_LDA(At, 1, 1); PG_STAGE_B(PG_SB(1, 0), b3); PG_STAGE_B(PG_SB(1, 1), b3 + hstep); PG_STAGE_A(PG_SA(1, 0), o2, 0, ka3);
            PG_WAIT_V(8); PG_WAIT_L(0); PG_BAR; PG_MMA(1, 0, At, B0); PG_MMA(1, 1, At, B1); PG_BAR; PG_SCHED;
        }
        if (wr == 0) PG_BAR;
        if constexpr (FP8) asm volatile("s_nop 15\n\ts_nop 7" ::: "memory");
        if constexpr (has_pre<Epi>::value) { E(acc, cur, wr, wc, fr, fq, epre); if (has_next) E.pre(epre, nxt, wr, fr); }
        else E(acc, cur, wr, wc, fr, fq);
        if (!has_next) break;
#pragma unroll
        for (int a = 0; a < 2; ++a)
#pragma unroll
            for (int b = 0; b < 2; ++b)
#pragma unroll
                for (int m = 0; m < 4; ++m)
#pragma unroll
                    for (int n = 0; n < 2; ++n) { acc[a][b][m][n] = acc_t{}; if constexpr (FP8) asm volatile("" : "+v"(acc[a][b][m][n])); }
        cur = nxt; cB = nB; ++ui;
#pragma unroll
        for (int h = 0; h < 2; ++h)
#pragma unroll
            for (int i = 0; i < 2; ++i) offA[h][i] = offN[h][i];
        if (wr == 1) PG_BAR;
    }
    PG_WAIT_V(0);
    PG_BAR;
#undef PG_SA
#undef PG_SB
#undef PG_STAGE_A
#undef PG_STAGE_B
#undef PG_ROWOFF
#undef PG_LDA
#undef PG_LDB
#undef PG_MMA
#undef PG_WAIT_V
#undef PG_WAIT_L
#undef PG_BAR
#undef PG_SCHED
}
struct EpiP {
    static constexpr bool PERM = true;
    bf16_t* P; const float* tab; const float* hxs; const float* wss;
    __device__ __forceinline__ void operator()(const v4i32_t (&acc)[2][2][4][2], const Unit& u, int wr, int wc, int fr, int fq) const {
        const bool lat = u.m0 < RL;
        float rs[8];
#pragma unroll
        for (int ai = 0; ai < 2; ++ai)
#pragma unroll
            for (int m = 0; m < 4; ++m) rs[ai * 4 + m] = hxs[u.m0 + ai * HALF + wr * 64 + m * 16 + fr];
        float cs; { const int ln = fr + 16 * fq; cs = 4.0f * sqrtf(wave_sum((wss[ln] + wss[ln + 64]) + (wss[ln + 128] + wss[ln + 192])) * (1.0f / ((float)D * (float)PROJ))) * (1.0f / 127.0f); }
#pragma unroll
        for (int bj = 0; bj < 2; ++bj) {
            const int ct = u.pn * BM + bj * HALF;
            const int c0 = ct + wc * 32 + 8 * fq;
            const int kind = ct < C_VA ? 1 : ((ct >= C_QD && ct < C_VD) ? 2 : 0);
            const float sc = ct < C_KA ? QSCALE_A : ((ct >= C_QD && ct < C_KD) ? QSCALE_D : 1.0f);
#pragma unroll
            for (int ai = 0; ai < 2; ++ai)
#pragma unroll
                for (int m = 0; m < 4; ++m) {
                    const int row = u.m0 + ai * HALF + wr * 64 + m * 16 + fr;
                    f32x4 v0, v1; { const v4i32_t i0 = acc[ai][bj][m][0], i1 = acc[ai][bj][m][1]; const float r_ = rs[ai * 4 + m];
#pragma unroll
                      for (int k = 0; k < 4; ++k) { v0[k] = (float)i0[k] * (r_ * cs); v1[k] = (float)i1[k] * (r_ * cs); } }
                    if (kind != 0 && lat) {
                        const int pos = row % SEQ, gr = pos / GRID_W, gc = pos % GRID_W; const float* t;
                        if (kind == 1) { const int p = c0 & 63, grp = p >> 5, i0 = (p & 31) >> 1; t = tab + (grp ? T_ACOL + gc * 32 : T_AROW + gr * 32) + i0 * 2; }
                        else { const int p = c0 & 31, grp = p >> 4, i0 = (p & 15) >> 1; t = tab + (grp ? T_DCOL + gc * 16 : T_DROW + gr * 16) + i0 * 2; }
                        const f32x4 t0 = *(const f32x4*)t, t1 = *(const f32x4*)(t + 4);
                        v0 = (f32x4){v0[0] * t0[0] - v0[1] * t0[1], v0[1] * t0[0] + v0[0] * t0[1], v0[2] * t0[2] - v0[3] * t0[3], v0[3] * t0[2] + v0[2] * t0[3]};
                        v1 = (f32x4){v1[0] * t1[0] - v1[1] * t1[1], v1[1] * t1[0] + v1[0] * t1[1], v1[2] * t1[2] - v1[3] * t1[3], v1[3] * t1[2] + v1[2] * t1[3]};
                    }
                    v0 = v0 * sc; v1 = v1 * sc;
                    u32x4 w; w.x = cvt_pk_bf16(v0[0], v0[1]); w.y = cvt_pk_bf16(v0[2], v0[3]); w.z = cvt_pk_bf16(v1[0], v1[1]); w.w = cvt_pk_bf16(v1[2], v1[3]);
                    *(u32x4*)(P + (size_t)row * PROJ + c0) = w;
                }
        }
    }
};
struct EpiX {
    static constexpr bool PERM = true;
    bf16_t* XB; const float* modl; float gscale;
    __device__ __forceinline__ void operator()(const f32x4 (&acc)[2][2][4][2], const Unit& u, int wr, int wc, int fr, int fq) const {
        const int b = u.m0 < RL ? u.m0 / SEQ : NB; const float* g1 = modl + (size_t)b * 6 * D + M_G1 + u.pn * BM + wc * 32 + 8 * fq;
        bf16_t* x0 = XB + (size_t)(u.m0 + wr * 64 + fr) * D + u.pn * BM + wc * 32 + 8 * fq;
        u32x4 xv[2][4][2];
#pragma unroll
        for (int ai = 0; ai < 2; ++ai)
#pragma unroll
            for (int m = 0; m < 4; ++m)
#pragma unroll
                for (int bj = 0; bj < 2; ++bj) xv[ai][m][bj] = *(const u32x4*)(x0 + (size_t)(ai * HALF + m * 16) * D + bj * HALF);
        f32x4 gv[2][2];
#pragma unroll
        for (int bj = 0; bj < 2; ++bj)
#pragma unroll
            for (int n = 0; n < 2; ++n) gv[bj][n] = *(const f32x4*)(g1 + bj * HALF + 4 * n) * gscale;
#pragma unroll
        for (int ai = 0; ai < 2; ++ai)
#pragma unroll
            for (int m = 0; m < 4; ++m)
#pragma unroll
                for (int bj = 0; bj < 2; ++bj) { const u32x4 x = xv[ai][m][bj];
                    const f32x4 a0 = acc[ai][bj][m][0] * gv[bj][0], a1 = acc[ai][bj][m][1] * gv[bj][1]; u32x4 w;
                    w.x = cvt_pk_bf16(__builtin_bit_cast(float, x.x << 16) + a0[0], __builtin_bit_cast(float, x.x & 0xffff0000u) + a0[1]);
                    w.y = cvt_pk_bf16(__builtin_bit_cast(float, x.y << 16) + a0[2], __builtin_bit_cast(float, x.y & 0xffff0000u) + a0[3]);
                    w.z = cvt_pk_bf16(__builtin_bit_cast(float, x.z << 16) + a1[0], __builtin_bit_cast(float, x.z & 0xffff0000u) + a1[1]);
                    w.w = cvt_pk_bf16(__builtin_bit_cast(float, x.w << 16) + a1[2], __builtin_bit_cast(float, x.w & 0xffff0000u) + a1[3]);
                    *(u32x4*)(x0 + (size_t)(ai * HALF + m * 16) * D + bj * HALF) = w; }
    }
};
__device__ __forceinline__ float silu_fast(float v) { return v * __builtin_amdgcn_rcpf(1.0f + __builtin_amdgcn_exp2f(-LOG2E * v)); }
__device__ __forceinline__ unsigned pk4_fp8(float a, float b, float c, float d) { int w = 0; w = __builtin_amdgcn_cvt_pk_fp8_f32(a, b, w, false); w = __builtin_amdgcn_cvt_pk_fp8_f32(c, d, w, true); return (unsigned)w; }
struct EpiH {
    static constexpr bool PERM = true;
    unsigned char* H;
    __device__ __forceinline__ void operator()(const f32x4 (&acc)[2][2][4][2], const Unit& u, int wr, int wc, int fr, int fq) const {
        const int hc = u.pn * HALF + wc * 32 + 8 * fq;
#pragma unroll
        for (int ai = 0; ai < 2; ++ai)
#pragma unroll
            for (int m = 0; m < 4; ++m) {
                const int row = u.m0 + ai * HALF + wr * 64 + m * 16 + fr;
                const f32x4 g0 = acc[ai][0][m][0], g1 = acc[ai][0][m][1], u0 = acc[ai][1][m][0], u1 = acc[ai][1][m][1];
                u32x2 w;
                w.x = pk4_fp8(silu_fast(g0[0]) * u0[0], silu_fast(g0[1]) * u0[1], silu_fast(g0[2]) * u0[2], silu_fast(g0[3]) * u0[3]);
                w.y = pk4_fp8(silu_fast(g1[0]) * u1[0], silu_fast(g1[1]) * u1[1], silu_fast(g1[2]) * u1[2], silu_fast(g1[3]) * u1[3]);
                *(u32x2*)(H + (size_t)row * FF + hc) = w;
            }
    }
};
struct EpiY {
    static constexpr bool PERM = true, HAS_PRE = true;
    unsigned char* Y; const float* gate;
    __device__ __forceinline__ void pre(float (&gv)[8], const Unit& u, int wr, int fr) const {
#pragma unroll
        for (int ai = 0; ai < 2; ++ai)
#pragma unroll
            for (int m = 0; m < 4; ++m) gv[ai * 4 + m] = gate[u.m0 + ai * HALF + wr * 64 + m * 16 + fr];
    }
    __device__ __forceinline__ void operator()(const f32x4 (&acc)[2][2][4][2], const Unit& u, int wr, int wc, int fr, int fq, const float (&gv)[8]) const {
#pragma unroll
        for (int ai = 0; ai < 2; ++ai)
#pragma unroll
            for (int m = 0; m < 4; ++m) {
                const int row = u.m0 + ai * HALF + wr * 64 + m * 16 + fr; const float gt = gv[ai * 4 + m] * 64.0f;
#pragma unroll
                for (int bj = 0; bj < 2; ++bj) {
                    const f32x4 v0 = acc[ai][bj][m][0] * gt, v1 = acc[ai][bj][m][1] * gt;
                    u32x2 w; w.x = pk4_fp8(v0[0], v0[1], v0[2], v0[3]); w.y = pk4_fp8(v1[0], v1[1], v1[2], v1[3]);
                    *(u32x2*)(Y + (size_t)row * D + u.pn * BM + bj * HALF + wc * 32 + 8 * fq) = w;
                }
            }
    }
};
}

struct Args { const float* in[19]; float* out; unsigned char* ws; int ph_lo, ph_hi; };
struct Ctx {
    Ptrs p; LAS unsigned char* lds;
    float *tab, *mod, *aff, *gate, *xc, *xl; int *sel, *tokslot;
    bf16_t *win, *wout, *P, *H, *Y, *MIX, *HX2, *HX, *XB; float* TMP; int wv;
};
template <class Dest>
__device__ __forceinline__ void transpose_item_fp8(const float* W, int K, int N, unsigned char* WT, LAS float* scr, int item, int lane, Dest dest) {
    const int nblk = N / 32, kb = item / nblk, nb = item % nblk, k0 = 64 * kb, n0 = 32 * nb;
    float wv[32];
#pragma unroll
    for (int i = 0; i < 32; ++i) wv[i] = W[(size_t)(k0 + 2 * i + (lane >> 5)) * N + n0 + (lane & 31)];
#pragma unroll
    for (int i = 0; i < 32; ++i) { const int kk = 2 * i + (lane >> 5); scr[kk * 33 + (lane & 31)] = wv[i] * 64.0f; }
    LDS_WAIT(); asm volatile("" ::: "memory");
    const int c = lane & 7;
#pragma unroll
    for (int j = 0; j < 4; ++j) { const int n = (lane >> 3) + 8 * j; const LAS float* s = scr + (8 * c) * 33 + n;
        u32x2 o; o.x = pg::pk4_fp8(s[0 * 33], s[1 * 33], s[2 * 33], s[3 * 33]); o.y = pg::pk4_fp8(s[4 * 33], s[5 * 33], s[6 * 33], s[7 * 33]);
        *(u32x2*)(WT + (size_t)dest(n0 + n) * K + k0 + 8 * c) = o; }
    LDS_WAIT(); asm volatile("" ::: "memory");
}
template <class Dest>
__device__ __forceinline__ void transpose_item(const float* W, int K, int N, bf16_t* WT, LAS float* scr, int item, int lane, Dest dest) {
    const int nblk = N / 32, kb = item / nblk, nb = item % nblk, k0 = 64 * kb, n0 = 32 * nb;
#pragma unroll 8
    for (int i = 0; i < 32; ++i) { const int kk = 2 * i + (lane >> 5); scr[kk * 33 + (lane & 31)] = W[(size_t)(k0 + kk) * N + n0 + (lane & 31)]; }
    LDS_WAIT(); asm volatile("" ::: "memory");
    const int c = lane & 7;
#pragma unroll
    for (int j = 0; j < 4; ++j) { const int n = (lane >> 3) + 8 * j; const LAS float* s = scr + (8 * c) * 33 + n;
        u32x4 o; o.x = cvt_pk_bf16(s[0 * 33], s[1 * 33]); o.y = cvt_pk_bf16(s[2 * 33], s[3 * 33]); o.z = cvt_pk_bf16(s[4 * 33], s[5 * 33]); o.w = cvt_pk_bf16(s[6 * 33], s[7 * 33]);
        *(u32x4*)(WT + (size_t)dest(n0 + n) * K + k0 + 8 * c) = o; }
    LDS_WAIT(); asm volatile("" ::: "memory");
}
HD int invA(int q) { const int g = q / 32, r = q % 32; return 32 * g + (r < 16 ? 2 * r : 2 * (r - 16) + 1); }
HD int invD(int q) { const int g = q / 16, r = q % 16; return 16 * g + (r < 8 ? 2 * r : 2 * (r - 8) + 1); }
HD int inproj_dst_row(int nl) {
    if (nl < C_VA) return (nl / 64) * 64 + invA(nl % 64);
    if (nl >= C_QD && nl < C_VD) return (nl / 32) * 32 + invD(nl % 32);
    return nl;
}
struct DestIn { __device__ int operator()(int n) const { return inproj_dst_row(n); } };
struct DestId { __device__ int operator()(int n) const { return n; } };
struct DestGU { int up; __device__ int operator()(int n) const { return (n / 128) * 256 + up * 128 + n % 128; } };

__device__ __forceinline__ void phase_prologue(const Ctx& C) {
    const int tid = tid_l(), lane = tid & 63, wave = __builtin_amdgcn_readfirstlane(tid >> 6), gw = blockIdx.x * NWV + wave, NGW = gridDim.x * NWV; (void)lane; (void)gw; (void)NGW;
    for (long g = (long)tid * gridDim.x + blockIdx.x; g < (long)(NROWS + 64) * 24; g += (long)gridDim.x * NT) {
        const int pos = (int)(g / 24), f = (int)(g % 24);
        const float inv = f < 16 ? exp2f(-(float)f * (13.287712379549449f / 16.0f)) : exp2f(-(float)(f - 16) * (13.287712379549449f / 8.0f));
        const bool isrow = pos < NROWS; const int p = isrow ? pos : pos - NROWS;
        const float ang = (float)p * inv; float sn, cs; sincosf(ang, &sn, &cs);
        const int idx = f < 16 ? (isrow ? T_AROW : T_ACOL) + (p * 16 + f) * 2 : (isrow ? T_DROW : T_DCOL) + (p * 8 + (f - 16)) * 2;
        C.tab[idx] = cs; C.tab[idx + 1] = sn;
    }
    LAS float* sl = (LAS float*)C.lds;
    for (int i = tid; i < (NB + 1) * D; i += NT) { const int b = i / D, k = i % D; sl[i] = silu_f(b < NB ? C.p.c[b * D + k] : C.p.c_ctx[k]); }
    __syncthreads();
    constexpr int NBR = NB + 1, BG = 11, NBG = NBR / BG; static_assert(NBG * BG == NBR, "adaLN rows reduced in groups of 11");
    LAS float* pbuf = (LAS float*)(C.lds + NBR * D * 4);
    static_assert(NBR * D * 4 + 16 * BG * 32 * 4 <= LDS_MISC, "prologue LDS");
    for (int task = blockIdx.x; task < DEPTH * 6 * D / 32; task += gridDim.x) {
        const int jg = task * 32, l = jg / (6 * D), j0 = jg % (6 * D), c = lane & 31, half = lane >> 5, kb = 128 * wave + 64 * half;
        f32x2_t acc2[NBR];
#pragma unroll
        for (int b = 0; b < NBR; ++b) acc2[b] = (f32x2_t){0.f, 0.f};
        const float* w = C.p.w_ada + ((size_t)l * D + kb) * 6 * D + j0 + c; const LAS float* s0 = sl + kb;
        for (int kk = 0; kk < 64; kk += 4) {
            const f32x2_t w01 = (f32x2_t){w[(size_t)kk * 6 * D], w[(size_t)(kk + 1) * 6 * D]}, w23 = (f32x2_t){w[(size_t)(kk + 2) * 6 * D], w[(size_t)(kk + 3) * 6 * D]};
#pragma unroll
            for (int rr = 0; rr < NBG; ++rr) { f32x4 sv[BG]; const unsigned sa = (unsigned)(size_t)(s0 + rr * BG * D + kk);
                LDS_RD11_B128(sv, sa, D * 4);
#pragma unroll
                for (int bb = 0; bb < BG; ++bb) { acc2[rr * BG + bb] = __builtin_elementwise_fma((f32x2_t){sv[bb][0], sv[bb][1]}, w01, acc2[rr * BG + bb]);
                    acc2[rr * BG + bb] = __builtin_elementwise_fma((f32x2_t){sv[bb][2], sv[bb][3]}, w23, acc2[rr * BG + bb]); } }
        }
        float acc[NBR];
#pragma unroll
        for (int b = 0; b < NBR; ++b) acc[b] = acc2[b][0] + acc2[b][1];
#pragma unroll
        for (int rr = 0; rr < NBG; ++rr) {
#pragma unroll
            for (int bb = 0; bb < BG; ++bb) pbuf[((wave * 2 + half) * BG + bb) * 32 + c] = acc[rr * BG + bb];
            __syncthreads();
            if (tid < BG * 32) { const int bb = tid / 32, cc = tid % 32; float s = 0.f;
#pragma unroll
                for (int p = 0; p < 16; ++p) s += pbuf[(p * BG + bb) * 32 + cc];
                C.mod[((size_t)l * NBR + rr * BG + bb) * 6 * D + j0 + cc] = s + C.p.b_ada[l * 6 * D + j0 + cc]; }
            __syncthreads();
        }
    }
    __syncthreads();
    LAS float* scr = (LAS float*)(C.lds + wave * 16384);
    constexpr int I_OUT = (D / 64) * (D / 32);
    for (int it = gw; it < DEPTH * I_OUT; it += NGW) { const int l = it / I_OUT, r = it % I_OUT;
        transpose_item(C.p.w_out + (size_t)l * D * D, D, D, C.wout + (size_t)l * D * D, scr, r, lane, DestId{}); }
    float* wss = (float*)(C.p.ws + WS_CTL + CTL_WINMAX);
    LAS float* pm = (LAS float*)(C.lds + 8 * 16384);
    __syncthreads();
    for (int slot = blockIdx.x; slot < DEPTH * 256; slot += gridDim.x) {
        const int l = slot / 256, s = slot % 256; constexpr int PER = D * PROJ / 256;
        const float* w = C.p.w_in + (size_t)l * D * PROJ + (size_t)s * PER; float acc = 0.f;
        for (int i = tid; i < PER / 4; i += NT) { const f32x4 v = *(const f32x4*)(w + 4 * i); acc += (v[0] * v[0] + v[1] * v[1]) + (v[2] * v[2] + v[3] * v[3]); }
        acc = wave_sum(acc); if (lane == 0) pm[wave] = acc;
        __syncthreads();
        if (tid == 0) { float t = 0.f; for (int q = 0; q < NWV; ++q) t += pm[q]; wss[slot] = t; }
        __syncthreads();
    }
    __syncthreads();
}
__device__ __forceinline__ float win_amax(const unsigned char* ws, int l, int lane) {
    const float* wss = (const float*)(ws + WS_CTL + CTL_WINMAX) + l * 256;
    const float t = wave_sum((wss[lane] + wss[lane + 64]) + (wss[lane + 128] + wss[lane + 192]));
    return 4.0f * sqrtf(t * (1.0f / ((float)D * (float)PROJ)));
}
__device__ __forceinline__ void phase_prologue_b(const Ctx& C) {
    const int tid = tid_l(), lane = tid & 63, wave = __builtin_amdgcn_readfirstlane(tid >> 6), gw = blockIdx.x * NWV + wave, NGW = gridDim.x * NWV;
    LAS float* scr = (LAS float*)(C.lds + wave * 16384);
    constexpr int I_IN = (D / 64) * (PROJ / 32);
    for (int it = gw; it < DEPTH * I_IN; it += NGW) {
        const int l = it / I_IN, item = it % I_IN, nblk = PROJ / 32, kb = item / nblk, nb = item % nblk, k0 = 64 * kb, n0 = 32 * nb;
        const float* W = C.p.w_in + (size_t)l * D * PROJ; signed char* WT = (signed char*)C.win + (size_t)l * PROJ * D;
        { const int nl = n0 + (lane & 31); const float am = win_amax(C.p.ws, l, lane); const float inv = am > 0.f ? 127.0f / am : 0.f;
#pragma unroll 8
          for (int i = 0; i < 32; ++i) { const int kk = 2 * i + (lane >> 5); scr[kk * 33 + (lane & 31)] = W[(size_t)(k0 + kk) * PROJ + nl] * inv; } }
        LDS_WAIT(); asm volatile("" ::: "memory");
        const int c = lane & 7;
#pragma unroll
        for (int j = 0; j < 4; ++j) { const int n = (lane >> 3) + 8 * j; const LAS float* s = scr + (8 * c) * 33 + n; unsigned lo = 0u, hi = 0u;
#pragma unroll
            for (int q = 0; q < 4; ++q) { lo |= ((unsigned)__float2int_rn(fminf(fmaxf(s[q * 33], -127.f), 127.f)) & 0xffu) << (8 * q); hi |= ((unsigned)__float2int_rn(fminf(fmaxf(s[(4 + q) * 33], -127.f), 127.f)) & 0xffu) << (8 * q); }
            *(u32x2*)(WT + (size_t)inproj_dst_row(n0 + n) * D + k0 + 8 * c) = (u32x2){lo, hi}; }
        LDS_WAIT(); asm volatile("" ::: "memory");
    }
    __syncthreads();
}
constexpr int CVT_ITEMS = 3 * NE * (D / 64) * (FF / 32);
struct CvtItem { const float* src; unsigned char* dst; int mat, n0; };
__device__ __forceinline__ CvtItem cvt_decode(const Ctx& C, int l, int it, int lane) {
    constexpr int I_E = (D / 64) * (FF / 32), NBLK = FF / 32;
    const int mat = it / (NE * I_E), e = (it / I_E) % NE, r = it % I_E, kb = r / NBLK, nb = r % NBLK, k0 = 64 * kb, n0 = 32 * nb;
    const size_t wo = ((size_t)l * NE + e) * D * FF;
    const float* W = mat == 0 ? C.p.w_gate + wo : mat == 1 ? C.p.w_up + wo : C.p.w_down + wo;
    unsigned char* wgu = C.p.ws + WS_WGU + (size_t)(l & 1) * NE * 2 * FF * D; unsigned char* wd = C.p.ws + WS_WD + (size_t)(l & 1) * NE * D * FF;
    CvtItem c; c.src = W + (size_t)(k0 + (lane >> 5)) * FF + n0 + (lane & 31); c.dst = (mat == 2 ? wd + (size_t)e * D * FF : wgu + (size_t)e * 2 * FF * D) + k0; c.mat = mat; c.n0 = n0;
    return c;
}
__device__ __forceinline__ void phase_cvt_experts(const Ctx& C, int l, int it0, int it1, int w, int nw) {
    static_assert(D == FF, "expert matrices are square");
    const int tid = tid_l(), lane = tid & 63, wave = __builtin_amdgcn_readfirstlane(tid >> 6);
    LAS float* scr = (LAS float*)(C.lds + wave * 16384);
    float ra[32], rb[32];
    auto issue = [&](float (&r)[32], const CvtItem& c) {
#pragma unroll
        for (int i = 0; i < 32; ++i) r[i] = c.src[(size_t)(2 * i) * FF]; };
    auto process = [&](float (&r)[32], const CvtItem& cur) {
#pragma unroll
        for (int i = 0; i < 32; ++i) { const int kk = 2 * i + (lane >> 5); scr[kk * 33 + (lane & 31)] = r[i] * 64.0f; }
        LDS_WAIT(); asm volatile("" ::: "memory");
        const int c = lane & 7;
#pragma unroll
        for (int j = 0; j < 4; ++j) { const int n = cur.n0 + (lane >> 3) + 8 * j; const LAS float* sp = scr + (8 * c) * 33 + (lane >> 3) + 8 * j;
            u32x2 o; o.x = pg::pk4_fp8(sp[0 * 33], sp[1 * 33], sp[2 * 33], sp[3 * 33]); o.y = pg::pk4_fp8(sp[4 * 33], sp[5 * 33], sp[6 * 33], sp[7 * 33]);
            const int drow = cur.mat == 2 ? n : (n / 128) * 256 + cur.mat * 128 + n % 128;
            *(u32x2*)(cur.dst + (size_t)drow * D + 8 * c) = o; }
        LDS_WAIT(); asm volatile("" ::: "memory"); };
    int it = it0 + w;
    CvtItem ca{}, cb{};
    if (it < it1) { ca = cvt_decode(C, l, it, lane); issue(ra, ca); }
    while (it < it1) {
        cb = cvt_decode(C, l, it + nw < it1 ? it + nw : it, lane); issue(rb, cb);
        process(ra, ca);
        it += nw; if (it >= it1) break;
        ca = cvt_decode(C, l, it + nw < it1 ? it + nw : it, lane); issue(ra, ca);
        process(rb, cb);
        it += nw;
    }
    __syncthreads();
}
__device__ __forceinline__ void yf8_add(f32x4& a, const unsigned w, const float wf) {
    const f32x2_t lo = __builtin_amdgcn_cvt_pk_f32_fp8((int)w, false), hi = __builtin_amdgcn_cvt_pk_f32_fp8((int)w, true);
    a[0] += wf * lo[0]; a[1] += wf * lo[1]; a[2] += wf * hi[0]; a[3] += wf * hi[1];
}
template <bool FINAL, bool SRCF32>
__device__ __forceinline__ void phase_rowA(const Ctx& C, int l, float gscale = 1.0f) {
    const int tid = tid_l(), lane = tid & 63, wave = __builtin_amdgcn_readfirstlane(tid >> 6), gw = blockIdx.x * NWV + wave, NGW = gridDim.x * NWV;
    const int nrows = FINAL ? RL : RALL;
    const int per = (nrows + NGW - 1) / NGW, r0 = gw * per, r1 = (r0 + per < nrows) ? r0 + per : nrows;
#define RA_LOADX(dst, row) do { if (SRCF32) { const float* _s = ((row) < RL ? C.p.x + (size_t)(row) * D : C.p.ctx + (size_t)((row) - RL) * D); _Pragma("unroll") for (int j = 0; j < 4; ++j) dst[j] = __builtin_bit_cast(u32x4, *(const f32x4*)(_s + 4 * lane + 256 * j)); } \
        else { const bf16_t* _s = C.XB + (size_t)(row) * D + 4 * lane; _Pragma("unroll") for (int j = 0; j < 4; ++j) { const u32x2 _w = *(const u32x2*)(_s + 256 * j); dst[j] = (u32x4){_w.x, _w.y, 0u, 0u}; } } } while (0)
#define RA_LOADTS(dst, row) do { dst = (l > 0 && lane < NE) ? C.tokslot[(size_t)(row) * NE + lane] : -1; } while (0)
#define RA_ISSUEY(YY, WF, MSK, ts) do { unsigned _m = (unsigned)__ballot((ts) >= 0); int _s0 = 0, _s1, _s2, _s3; WF[0] = WF[1] = WF[2] = WF[3] = 0.f; \
        if (_m) { _s0 = __builtin_amdgcn_readlane((ts), __builtin_ctz(_m)); _m &= _m - 1; WF[0] = 1.f; } _s1 = _s2 = _s3 = _s0; \
        if (_m) { _s1 = __builtin_amdgcn_readlane((ts), __builtin_ctz(_m)); _m &= _m - 1; WF[1] = 1.f; } \
        if (_m) { _s2 = __builtin_amdgcn_readlane((ts), __builtin_ctz(_m)); _m &= _m - 1; WF[2] = 1.f; } \
        if (_m) { _s3 = __builtin_amdgcn_readlane((ts), __builtin_ctz(_m)); _m &= _m - 1; WF[3] = 1.f; } MSK = _m; \
        _Pragma("unroll") for (int j = 0; j < 4; ++j) { YY[0][j] = *(const unsigned*)(Yb + (size_t)_s0 * D + 4 * lane + 256 * j); YY[1][j] = *(const unsigned*)(Yb + (size_t)_s1 * D + 4 * lane + 256 * j); \
            YY[2][j] = *(const unsigned*)(Yb + (size_t)_s2 * D + 4 * lane + 256 * j); YY[3][j] = *(const unsigned*)(Yb + (size_t)_s3 * D + 4 * lane + 256 * j); } } while (0)
    const unsigned char* Yb = (const unsigned char*)C.Y;
    u32x4 xc[4], xn[4], x2[4]; int tsc = -1, tsn = -1, ts2 = -1; unsigned yc[4][4], yn[4][4]; float wc_[4], wn_[4]; unsigned mc = 0u, mn = 0u;
    f32x4 A[4], S[4], G[4]; int bcur = -1;
#pragma unroll
    for (int j = 0; j < 4; ++j) { xc[j] = xn[j] = x2[j] = (u32x4){0u, 0u, 0u, 0u}; A[j] = S[j] = G[j] = (f32x4){0.f, 0.f, 0.f, 0.f}; }
#pragma unroll
    for (int i = 0; i < 4; ++i) { wc_[i] = wn_[i] = 0.f;
#pragma unroll
        for (int j = 0; j < 4; ++j) yc[i][j] = yn[i][j] = 0u; }
    if (r0 < r1) { RA_LOADTS(tsc, r0); RA_LOADX(xc, r0); if (l > 0) RA_ISSUEY(yc, wc_, mc, tsc); }
    if (r0 + 1 < r1) { RA_LOADTS(tsn, r0 + 1); RA_LOADX(xn, r0 + 1); }
    for (int row = r0; row < r1; ++row) {
        if (l > 0 && row + 1 < r1) RA_ISSUEY(yn, wn_, mn, tsn);
        if (row + 2 < r1) { RA_LOADTS(ts2, row + 2); RA_LOADX(x2, row + 2); }
        const int b = row_batch(row);
        if (b != bcur) { bcur = b;
            if (FINAL) {
#pragma unroll
                for (int j = 0; j < 4; ++j) A[j] = *(const f32x4*)(C.p.norm_final + 4 * lane + 256 * j);
            } else { const float* m = C.mod + ((size_t)l * (NB + 1) + b) * 6 * D + 4 * lane; const float* nw = C.p.norm1 + (size_t)l * D + 4 * lane;
#pragma unroll
                for (int j = 0; j < 4; ++j) { A[j] = *(const f32x4*)(nw + 256 * j) * (*(const f32x4*)(m + M_SC1 + 256 * j) + 1.0f); S[j] = *(const f32x4*)(m + M_SH1 + 256 * j); } }
            if (l > 0) { const float* g2 = C.mod + ((size_t)(l - 1) * (NB + 1) + b) * 6 * D + M_G2 + 4 * lane;
#pragma unroll
                for (int j = 0; j < 4; ++j) G[j] = *(const f32x4*)(g2 + 256 * j) * (gscale * (1.0f / 64.0f)); } }
        f32x4 v[4];
#pragma unroll
        for (int j = 0; j < 4; ++j) { if (SRCF32) v[j] = __builtin_bit_cast(f32x4, xc[j]); else { const unsigned w0 = xc[j][0], w1 = xc[j][1];
            v[j] = (f32x4){__builtin_bit_cast(float, w0 << 16), __builtin_bit_cast(float, w0 & 0xffff0000u), __builtin_bit_cast(float, w1 << 16), __builtin_bit_cast(float, w1 & 0xffff0000u)}; } }
        if (l > 0) {
            f32x4 a[4];
#pragma unroll
            for (int j = 0; j < 4; ++j) { a[j] = (f32x4){0.f, 0.f, 0.f, 0.f};
#pragma unroll
                for (int i = 0; i < 4; ++i) yf8_add(a[j], yc[i][j], wc_[i]); }
            while (mc) { const int s = __builtin_amdgcn_readlane(tsc, __builtin_ctz(mc)); mc &= mc - 1;
#pragma unroll
                for (int j = 0; j < 4; ++j) yf8_add(a[j], *(const unsigned*)(Yb + (size_t)s * D + 4 * lane + 256 * j), 1.0f); }
#pragma unroll
            for (int j = 0; j < 4; ++j) v[j] = v[j] + G[j] * a[j];
        }
        float ss = 0.f;
#pragma unroll
        for (int j = 0; j < 4; ++j) ss += (v[j][0] * v[j][0] + v[j][1] * v[j][1]) + (v[j][2] * v[j][2] + v[j][3] * v[j][3]);
        const float rstd = 1.0f / sqrtf(wave_sum(ss) * (1.0f / D) + EPS);
        if (FINAL) {
            float* dst = C.p.out + (size_t)row * D;
#pragma unroll
            for (int j = 0; j < 4; ++j) *(f32x4*)(dst + 4 * lane + 256 * j) = v[j] * rstd * A[j];
        } else {
            bf16_t* xo = C.XB + (size_t)row * D + 4 * lane;
#pragma unroll
            for (int j = 0; j < 4; ++j) { u32x2 w; w.x = cvt_pk_bf16(v[j][0], v[j][1]); w.y = cvt_pk_bf16(v[j][2], v[j][3]); *(u32x2*)(xo + 256 * j) = w; }
            f32x4 hq[4]; float am = 0.f;
#pragma unroll
            for (int j = 0; j < 4; ++j) { hq[j] = v[j] * rstd * A[j] + S[j]; am = fmaxf(fmaxf(am, fmaxf(fabsf(hq[j][0]), fabsf(hq[j][1]))), fmaxf(fabsf(hq[j][2]), fabsf(hq[j][3]))); }
            am = wave_max(am); const float inv = am > 0.f ? 127.0f / am : 0.f;
            if (lane == 0) ((float*)(C.p.ws + WS_HXS))[row] = am * (1.0f / 127.0f);
            unsigned char* hr = (unsigned char*)C.HX + (size_t)row * D + 4 * lane;
#pragma unroll
            for (int j = 0; j < 4; ++j) { const unsigned w = ((unsigned)__float2int_rn(fminf(fmaxf(hq[j][0] * inv, -127.f), 127.f)) & 0xffu) | (((unsigned)__float2int_rn(fminf(fmaxf(hq[j][1] * inv, -127.f), 127.f)) & 0xffu) << 8) | (((unsigned)__float2int_rn(fminf(fmaxf(hq[j][2] * inv, -127.f), 127.f)) & 0xffu) << 16) | (((unsigned)__float2int_rn(fminf(fmaxf(hq[j][3] * inv, -127.f), 127.f)) & 0xffu) << 24);
                *(unsigned*)(hr + 256 * j) = w; }
        }
        tsc = tsn; tsn = ts2; mc = mn;
#pragma unroll
        for (int j = 0; j < 4; ++j) { xc[j] = xn[j]; xn[j] = x2[j]; }
#pragma unroll
        for (int i = 0; i < 4; ++i) { wc_[i] = wn_[i];
#pragma unroll
            for (int j = 0; j < 4; ++j) yc[i][j] = yn[i][j]; }
    }
#undef RA_LOADX
#undef RA_LOADTS
#undef RA_ISSUEY
}
__device__ __forceinline__ void phase_rowB(const Ctx& C, int l, int nq) {
    const int tid = tid_l(), lane = tid & 63, wave = __builtin_amdgcn_readfirstlane(tid >> 6), gw = blockIdx.x * NWV + wave, NGW = gridDim.x * NWV;
    LAS float* R = (LAS float*)C.lds;
    const float* rt = C.p.router + (size_t)l * D * NE;
    for (int i = tid; i < D * NE; i += NT) R[(i % NE) * D + i / NE] = rt[i];
    __syncthreads();
    const int per = (nq + NGW - 1) / NGW, r0 = gw * per, r1 = (r0 + per < nq) ? r0 + per : nq;
    f32x4 xn[4], A[4], S[4]; int bcur = -1; int row = r0;
    u32x2 xr_[4];
    if (row < r1) { const bf16_t* s = C.XB + (size_t)row * D + 4 * lane;
#pragma unroll
        for (int j = 0; j < 4; ++j) xr_[j] = *(const u32x2*)(s + 256 * j); }
    for (; row < r1; ++row) {
        f32x4 v[4]; float ss = 0.f;
#pragma unroll
        for (int j = 0; j < 4; ++j) xn[j] = (f32x4){__builtin_bit_cast(float, xr_[j].x << 16), __builtin_bit_cast(float, xr_[j].x & 0xffff0000u), __builtin_bit_cast(float, xr_[j].y << 16), __builtin_bit_cast(float, xr_[j].y & 0xffff0000u)};
        const int b = row_batch(row);
        if (b != bcur) { bcur = b; const float* m = C.mod + ((size_t)l * (NB + 1) + b) * 6 * D + 4 * lane; const float* nw = C.p.norm2 + (size_t)l * D + 4 * lane;
#pragma unroll
            for (int j = 0; j < 4; ++j) { A[j] = *(const f32x4*)(nw + 256 * j) * (*(const f32x4*)(m + M_SC2 + 256 * j) + 1.0f); S[j] = *(const f32x4*)(m + M_SH2 + 256 * j); } }
#pragma unroll
        for (int j = 0; j < 4; ++j) { v[j] = xn[j]; ss += (v[j][0] * v[j][0] + v[j][1] * v[j][1]) + (v[j][2] * v[j][2] + v[j][3] * v[j][3]); }
        if (row + 1 < r1) { const bf16_t* s = C.XB + (size_t)(row + 1) * D + 4 * lane;
#pragma unroll
            for (int j = 0; j < 4; ++j) xr_[j] = *(const u32x2*)(s + 256 * j); }
        const float rstd = 1.0f / sqrtf(wave_sum(ss) * (1.0f / D) + EPS);
        unsigned char* hr = (unsigned char*)C.HX2 + (size_t)row * D + 4 * lane;
#pragma unroll
        for (int j = 0; j < 4; ++j) { v[j] = v[j] * rstd * A[j] + S[j]; *(unsigned*)(hr + 256 * j) = pg::pk4_fp8(v[j][0], v[j][1], v[j][2], v[j][3]); }
        float p[NE];
        { f32x2_t q[NE];
#pragma unroll
          for (int e = 0; e < NE; ++e) q[e] = (f32x2_t){0.f, 0.f};
          f32x4 ra_[8], rb_[8]; const unsigned rbase = (unsigned)(size_t)(R + 4 * lane);
          LDS_ISSUE8_B128(ra_, rbase, D * 4);
#pragma unroll
          for (int k = 0; k < 8; k += 2) {
              const f32x2_t vlo = (f32x2_t){v[k >> 1][0], v[k >> 1][1]}, vhi = (f32x2_t){v[k >> 1][2], v[k >> 1][3]};
              LDS_ISSUE8_B128(rb_, rbase + (unsigned)((8 * D + 256 * (k >> 1)) * 4), D * 4); LDS_WAIT8(ra_, 8);
#pragma unroll
              for (int e = 0; e < 8; ++e) { q[e] = __builtin_elementwise_fma(vlo, (f32x2_t){ra_[e][0], ra_[e][1]}, q[e]); q[e] = __builtin_elementwise_fma(vhi, (f32x2_t){ra_[e][2], ra_[e][3]}, q[e]); }
              if (k + 2 < 8) { LDS_ISSUE8_B128(ra_, rbase + (unsigned)(256 * ((k >> 1) + 1) * 4), D * 4); LDS_WAIT8(rb_, 8); } else { LDS_WAIT8(rb_, 0); }
#pragma unroll
              for (int e = 0; e < 8; ++e) { q[8 + e] = __builtin_elementwise_fma(vlo, (f32x2_t){rb_[e][0], rb_[e][1]}, q[8 + e]); q[8 + e] = __builtin_elementwise_fma(vhi, (f32x2_t){rb_[e][2], rb_[e][3]}, q[8 + e]); }
          }
#pragma unroll
          for (int e = 0; e < NE; ++e) p[e] = q[e][0] + q[e][1]; }
#pragma unroll
        for (int j = 0; j < 8; ++j) { auto rr = __builtin_amdgcn_permlane32_swap(__float_as_uint(p[j]), __float_as_uint(p[j + 8]), false, false); p[j] = __uint_as_float(rr[0]) + __uint_as_float(rr[1]); }
#pragma unroll
        for (int j = 0; j < 4; ++j) { auto rr = __builtin_amdgcn_permlane16_swap(__float_as_uint(p[j]), __float_as_uint(p[j + 4]), false, false); p[j] = __uint_as_float(rr[0]) + __uint_as_float(rr[1]); }
#pragma unroll
        for (int j = 0; j < 2; ++j) { const float a = p[j] + dpp_f(p[j], 3), b2 = p[j + 2] + dpp_f(p[j + 2], 3); p[j] = (lane & 8) ? b2 : a; }
        float lg; { const float a = p[0] + dpp_f(p[0], 2), b2 = p[1] + dpp_f(p[1], 2); lg = (lane & 4) ? b2 : a; }
        lg += dpp_f(lg, 1); lg += dpp_f(lg, 0);
        const float mx = wave_max(lg);
        const float ex = expf(lg - mx); const float se = wave_sum(ex) * 0.25f;
        const int e = ((lane >> 5) & 1) * 8 + ((lane >> 4) & 1) * 4 + ((lane >> 3) & 1) * 2 + ((lane >> 2) & 1);
        if ((lane & 3) == 0) C.aff[(size_t)row * NE + e] = ex / se;
    }
    __syncthreads();
}
template <int NV>
__device__ __forceinline__ void select_task(const Ctx& C, int base_row, int cap, int e, int slot0, int lane) {
    unsigned v[NV];
#pragma unroll
    for (int i = 0; i < NV; ++i) v[i] = __builtin_bit_cast(unsigned, C.aff[(size_t)(base_row + i * 64 + lane) * NE + e]);
    unsigned T = 0u;
    for (int bit = 30; bit >= 0; --bit) { const unsigned cand = T | (1u << bit); int cnt = 0;
#pragma unroll
        for (int i = 0; i < NV; ++i) cnt += __builtin_popcountll(__ballot(v[i] >= cand));
        if (cnt >= cap) T = cand; }
    int ngt = 0;
#pragma unroll
    for (int i = 0; i < NV; ++i) ngt += __builtin_popcountll(__ballot(v[i] > T));
    const int need = cap - ngt;
    const unsigned long long lt = (1ull << lane) - 1ull; int nsel = 0, neq = 0;
#pragma unroll
    for (int i = 0; i < NV; ++i) {
        const bool gt = v[i] > T, eq = v[i] == T; const unsigned long long meq = __ballot(eq);
        const bool take = gt || (eq && (neq + __builtin_popcountll(meq & lt)) < need);
        const unsigned long long msel = __ballot(take);
        const int row = base_row + i * 64 + lane; int slot = -1;
        if (take) { slot = slot0 + nsel + __builtin_popcountll(msel & lt); C.sel[slot] = row; C.gate[slot] = __builtin_bit_cast(float, v[i]); }
        C.tokslot[(size_t)row * NE + e] = slot;
        nsel += __builtin_popcountll(msel); neq += __builtin_popcountll(meq);
    }
}
__device__ __forceinline__ void phase_select(const Ctx& C, bool need_ctx) {
    const int tid = tid_l(), lane = tid & 63, wave = __builtin_amdgcn_readfirstlane(tid >> 6), gw = blockIdx.x * NWV + wave, NGW = gridDim.x * NWV; (void)lane; (void)gw; (void)NGW;
    const int ntask = NB * NE * (need_ctx ? 2 : 1);
    for (int task = wave * (int)gridDim.x + (int)blockIdx.x; task < ntask; task += NGW) {
        const int set = task / (NB * NE), b = (task / NE) % NB, e = task % NE;
        if (set == 0) select_task<SEQ / 64>(C, b * SEQ, CAPL, e, e * SLOTS_E + b * CAPL, lane);
        else select_task<CTX / 64>(C, RL + b * CTX, CAPC, e, e * SLOTS_E + SLOTS_L + b * CAPC, lane);
    }
}
namespace att {
typedef float f32x16 __attribute__((ext_vector_type(16)));
typedef short v4i16_t __attribute__((ext_vector_type(4)));
typedef __bf16 bf16x2_t __attribute__((ext_vector_type(2)));
constexpr int KSTR = 144, VSTR = 192, TILE_B = 64 * KSTR, BUF_B = TILE_B + 64 * VSTR;
constexpr float THR = 8.0f, THR_LO = 32.0f;
__device__ __forceinline__ unsigned pk2(float a, float b) { bf16x2_t v = {(__bf16)a, (__bf16)b}; return __builtin_bit_cast(unsigned, v); }
__device__ __forceinline__ float xmax32(float x) { auto rr = __builtin_amdgcn_permlane32_swap(__float_as_uint(x), __float_as_uint(x), false, false); return fmaxf(__uint_as_float(rr[0]), __uint_as_float(rr[1])); }
__device__ __forceinline__ float xsum32(float x) { auto rr = __builtin_amdgcn_permlane32_swap(__float_as_uint(x), __float_as_uint(x), false, false); return __uint_as_float(rr[0]) + __uint_as_float(rr[1]); }
__device__ __forceinline__ int crow(int reg, int h) { return (reg & 3) + 8 * (reg >> 2) + 4 * h; }
#ifndef PROBE_ATT
#define PROBE_ATT 0
#endif
#define MFMA32(a, b, c) __builtin_amdgcn_mfma_f32_32x32x16_bf16((a), (b), (c), 0, 0, 0)
__device__ __forceinline__ void store_pair16(bf16_t* rowp, u32x2 a, u32x2 b, int h) {
    auto rx = __builtin_amdgcn_permlane32_swap(a.x, b.x, false, false); auto ry = __builtin_amdgcn_permlane32_swap(a.y, b.y, false, false);
    u32x4 w; w.x = rx[0]; w.y = ry[0]; w.z = rx[1]; w.w = ry[1];
    *(u32x4*)(rowp + 8 * h) = w;
}
__device__ __forceinline__ bf16x8 ones_rows(int lane) { const unsigned v = (lane == 0 || lane == 32 || lane == 17 || lane == 49) ? 0x3F803F80u : 0u; u32x4 w; w.x = v; w.y = v; w.z = v; w.w = v; return __builtin_bit_cast(bf16x8, w); }
__device__ __forceinline__ float rowsum(const f32x4& L, int lane) { const float a = __shfl(L[0], lane & 15), b = __shfl(L[1], lane & 15); return (lane & 16) ? b : a; }

#define ATT_VTR(n, ks, hi, db) "ds_read_b64_tr_b16 %" #n ", %16 offset:" #ks "*3072+" #hi "*1536+" #db "*64\n\t"
template <int DKS, bool WAIT>
__device__ __forceinline__ void katt_read(unsigned kb_, bf16x8 (&Kf)[8], int lane) {
    const int r = lane & 31, h = lane >> 5;
    const unsigned ka = kb_ + r * KSTR + 16 * h;
    constexpr int o1 = 32, o2 = (DKS == 4) ? 64 : 32 * KSTR, o3 = (DKS == 4) ? 96 : 32 * KSTR + 32, o4 = (DKS == 4) ? 32 * KSTR : 64, o5 = (DKS == 4) ? 32 * KSTR + 32 : 96,
                  o6 = 32 * KSTR + 64, o7 = 32 * KSTR + 96;
    if constexpr (WAIT)
        asm volatile("ds_read_b128 %0, %8\n\tds_read_b128 %1, %8 offset:%c9\n\tds_read_b128 %2, %8 offset:%c10\n\tds_read_b128 %3, %8 offset:%c11\n\t"
                     "ds_read_b128 %4, %8 offset:%c12\n\tds_read_b128 %5, %8 offset:%c13\n\tds_read_b128 %6, %8 offset:%c14\n\tds_read_b128 %7, %8 offset:%c15\n\ts_waitcnt lgkmcnt(0)"
                     : "=&v"(Kf[0]), "=&v"(Kf[1]), "=&v"(Kf[2]), "=&v"(Kf[3]), "=&v"(Kf[4]), "=&v"(Kf[5]), "=&v"(Kf[6]), "=&v"(Kf[7])
                     : "v"(ka), "i"(o1), "i"(o2), "i"(o3), "i"(o4), "i"(o5), "i"(o6), "i"(o7) : "memory");
    else
        asm volatile("ds_read_b128 %0, %8\n\tds_read_b128 %1, %8 offset:%c9\n\tds_read_b128 %2, %8 offset:%c10\n\tds_read_b128 %3, %8 offset:%c11\n\t"
                     "ds_read_b128 %4, %8 offset:%c12\n\tds_read_b128 %5, %8 offset:%c13\n\tds_read_b128 %6, %8 offset:%c14\n\tds_read_b128 %7, %8 offset:%c15"
                     : "=&v"(Kf[0]), "=&v"(Kf[1]), "=&v"(Kf[2]), "=&v"(Kf[3]), "=&v"(Kf[4]), "=&v"(Kf[5]), "=&v"(Kf[6]), "=&v"(Kf[7])
                     : "v"(ka), "i"(o1), "i"(o2), "i"(o3), "i"(o4), "i"(o5), "i"(o6), "i"(o7) : "memory");
}
__device__ __forceinline__ void katt_wait(bf16x8 (&Kf)[8]) {
    asm volatile("s_waitcnt lgkmcnt(0)" : "+v"(Kf[0]), "+v"(Kf[1]), "+v"(Kf[2]), "+v"(Kf[3]), "+v"(Kf[4]), "+v"(Kf[5]), "+v"(Kf[6]), "+v"(Kf[7]) :: "memory");
}
template <int NSUB, int DKS>
__device__ __forceinline__ void flash_tile(unsigned vb_, unsigned kn_, bool has_next, const bf16x8 (&Q)[NSUB][DKS], f32x16 (&O)[NSUB][2], float (&m)[NSUB], f32x4 (&L)[NSUB], const bf16x8& onesA,
                                           bf16x8 (&Kf)[8], int lane, bool masked, int dq, bool first) {
    static_assert(NSUB * DKS == 4, "eight K fragments per tile");
    const int r = lane & 31, h = lane >> 5; (void)r;
    f32x16 S[NSUB][2];
    bool allz = true;
#pragma unroll
    for (int sub = 0; sub < NSUB; ++sub) allz = allz && __all(m[sub] == 0.f);
    if (allz) {
#pragma unroll
        for (int sub = 0; sub < NSUB; ++sub)
#pragma unroll
            for (int kb = 0; kb < 2; ++kb) {
                const f32x16 zero = {0.f, 0.f, 0.f, 0.f, 0.f, 0.f, 0.f, 0.f, 0.f, 0.f, 0.f, 0.f, 0.f, 0.f, 0.f, 0.f};
                S[sub][kb] = MFMA32(Kf[(DKS == 4) ? (kb * 4) : (kb * 2 + 4 * sub)], Q[sub][0], zero);
#pragma unroll
                for (int s = 1; s < DKS; ++s) S[sub][kb] = MFMA32(Kf[(DKS == 4) ? (kb * 4 + s) : (kb * 2 + s + 4 * sub)], Q[sub][s], S[sub][kb]);
            }
    } else {
#pragma unroll
        for (int sub = 0; sub < NSUB; ++sub)
#pragma unroll
            for (int kb = 0; kb < 2; ++kb) {
#pragma unroll
                for (int i = 0; i < 16; ++i) S[sub][kb][i] = -m[sub];
#pragma unroll
                for (int s = 0; s < DKS; ++s) S[sub][kb] = MFMA32(Kf[(DKS == 4) ? (kb * 4 + s) : (kb * 2 + s + 4 * sub)], Q[sub][s], S[sub][kb]);
            }
    }
#pragma unroll
    for (int sub = 0; sub < NSUB; ++sub) asm volatile("" : "+v"(S[sub][0]), "+v"(S[sub][1]));
    v4i16_t Vr[16];
    { const int i16 = lane & 15, q = i16 >> 2, p = i16 & 3, rblk = (lane >> 4) & 1; const unsigned va = vb_ + (4 * h + q) * VSTR + (16 * rblk + 4 * p) * 2;
      asm volatile(ATT_VTR(0, 0, 0, 0) ATT_VTR(1, 0, 1, 0) ATT_VTR(2, 0, 0, 1) ATT_VTR(3, 0, 1, 1) ATT_VTR(4, 1, 0, 0) ATT_VTR(5, 1, 1, 0) ATT_VTR(6, 1, 0, 1) ATT_VTR(7, 1, 1, 1)
                   ATT_VTR(8, 2, 0, 0) ATT_VTR(9, 2, 1, 0) ATT_VTR(10, 2, 0, 1) ATT_VTR(11, 2, 1, 1) ATT_VTR(12, 3, 0, 0) ATT_VTR(13, 3, 1, 0) ATT_VTR(14, 3, 0, 1) ATT_VTR(15, 3, 1, 1)
                   : "=&v"(Vr[0]), "=&v"(Vr[1]), "=&v"(Vr[2]), "=&v"(Vr[3]), "=&v"(Vr[4]), "=&v"(Vr[5]), "=&v"(Vr[6]), "=&v"(Vr[7]),
                     "=&v"(Vr[8]), "=&v"(Vr[9]), "=&v"(Vr[10]), "=&v"(Vr[11]), "=&v"(Vr[12]), "=&v"(Vr[13]), "=&v"(Vr[14]), "=&v"(Vr[15])
                   : "v"(va) : "memory"); }
#pragma unroll
    for (int sub = 0; sub < NSUB; ++sub) {
        if (masked) {
#pragma unroll
            for (int kb = 0; kb < 2; ++kb)
#pragma unroll
                for (int i = 0; i < 16; ++i) { const int dl = dq - (32 * kb + crow(i, h)); S[sub][kb][i] = (dl > WINDOW || dl < -WINDOW) ? -1e30f : S[sub][kb][i]; }
        }
        float mx = S[sub][0][0];
#pragma unroll
        for (int i = 1; i < 16; ++i) mx = fmaxf(mx, S[sub][0][i]);
#pragma unroll
        for (int i = 0; i < 16; ++i) mx = fmaxf(mx, S[sub][1][i]);
        mx = xmax32(mx);
        if (!__all(mx <= THR) || (first && !__all(mx >= -THR_LO))) {
            const float up = first ? mx : fmaxf(mx, 0.f), alpha = first ? 1.0f : __builtin_amdgcn_exp2f(-up); m[sub] += up;
            L[sub][0] *= alpha; L[sub][1] *= __shfl(alpha, (lane & 15) + 16);
#pragma unroll
            for (int kb = 0; kb < 2; ++kb)
#pragma unroll
                for (int i = 0; i < 16; ++i) S[sub][kb][i] -= up;
#pragma unroll
            for (int db = 0; db < 2; ++db)
#pragma unroll
                for (int i = 0; i < 16; ++i) O[sub][db][i] *= alpha;
        }
#pragma unroll
        for (int kb = 0; kb < 2; ++kb)
#pragma unroll
            for (int i = 0; i < 16; ++i) S[sub][kb][i] = __builtin_amdgcn_exp2f(S[sub][kb][i]);
        bf16x8 Pf[4];
#pragma unroll
        for (int kb = 0; kb < 2; ++kb)
#pragma unroll
            for (int s = 0; s < 2; ++s) { u32x4 w; w.x = pk2(S[sub][kb][8 * s + 0], S[sub][kb][8 * s + 1]); w.y = pk2(S[sub][kb][8 * s + 2], S[sub][kb][8 * s + 3]);
                w.z = pk2(S[sub][kb][8 * s + 4], S[sub][kb][8 * s + 5]); w.w = pk2(S[sub][kb][8 * s + 6], S[sub][kb][8 * s + 7]); Pf[2 * kb + s] = __builtin_bit_cast(bf16x8, w); }
        if (sub == 0) {
            asm volatile("s_waitcnt lgkmcnt(0)" : "+v"(Vr[0]), "+v"(Vr[1]), "+v"(Vr[2]), "+v"(Vr[3]), "+v"(Vr[4]), "+v"(Vr[5]), "+v"(Vr[6]), "+v"(Vr[7]) :: "memory");
            asm volatile("" : "+v"(Vr[8]), "+v"(Vr[9]), "+v"(Vr[10]), "+v"(Vr[11]), "+v"(Vr[12]), "+v"(Vr[13]), "+v"(Vr[14]), "+v"(Vr[15]) :: "memory");
        }
        if (sub == NSUB - 1 && has_next) katt_read<DKS, false>(kn_, Kf, lane);
#pragma unroll
        for (int ks = 0; ks < 4; ++ks) {
#pragma unroll
            for (int db = 0; db < 2; ++db) {
                const bf16x8 vf = __builtin_shufflevector(Vr[(ks * 2 + db) * 2], Vr[(ks * 2 + db) * 2 + 1], 0, 1, 2, 3, 4, 5, 6, 7);
                O[sub][db] = MFMA32(vf, Pf[ks], O[sub][db]);
            }
            L[sub] = __builtin_amdgcn_mfma_f32_16x16x32_bf16(onesA, Pf[ks], L[sub], 0, 0, 0);
        }
#pragma unroll
        for (int db = 0; db < 2; ++db) asm volatile("" : "+v"(O[sub][db]));
    }
    if (has_next) katt_wait(Kf);
}
#define ATT_STG_LOAD2(krow0, KR, VR) do { const bf16_t* _p = C.P + (size_t)((krow0) + skey) * PROJ + 8 * schunk; KR = *(const u32x4*)(_p + kcol); VR = *(const u32x4*)(_p + vcol); } while (0)
#define ATT_STG_STORE2(buf, KR, VR) do { LAS unsigned char* _d = C.lds + (buf) * BUF_B + skey * KSTR + schunk * 16; *(LAS u32x4*)_d = KR; *(LAS u32x4*)(_d + TILE_B + skey * (VSTR - KSTR)) = VR; } while (0)
#define ATT_STG_LOAD(krow0) ATT_STG_LOAD2(krow0, kreg, vreg)
#define ATT_STG_STORE(buf) ATT_STG_STORE2(buf, kreg, vreg)
#define ATT_STG_STOREB(off) do { LAS unsigned char* _d = C.lds + (off) + skey * KSTR + schunk * 16; *(LAS u32x4*)_d = kreg; *(LAS u32x4*)(_d + TILE_B + skey * (VSTR - KSTR)) = vreg; } while (0)
#define ATT_PROLOGUE(DKS_) do { { u32x4 kreg2, vreg2; ATT_STG_LOAD(ATT_TROW(0)); ATT_STG_LOAD2(ATT_TROW(1), kreg2, vreg2); ATT_STG_STORE(0); ATT_STG_STORE2(1, kreg2, vreg2); } \
    if (nt > 2) ATT_STG_LOAD(ATT_TROW(2)); __syncthreads(); katt_read<DKS_, true>((unsigned)(size_t)C.lds, Kf, lane); } while (0)

__device__ __forceinline__ void phase_attnA(const Ctx& C, int l, bool need_ctx) {
    const int tid = tid_l(), lane = tid & 63, wave = __builtin_amdgcn_readfirstlane(tid >> 6), skey = tid >> 3, schunk = tid & 7;
    const int r = lane & 31, h = lane >> 5, hq = wave & 3, ph = wave >> 2;
    const bf16x8 onesA = ones_rows(lane);
    constexpr int NUL = NB * NKVA * (SEQ / 64), NUC = NB * NKVA * (CTX / 64);
    const int nu = NUL + (need_ctx ? NUC : 0);
    for (int u = blockIdx.x; u < nu; u += gridDim.x) {
        const bool lat = u < NUL; const int uu = lat ? u : u - NUL; const int nqb = lat ? SEQ / 64 : CTX / 64;
        const int b = uu / (NKVA * nqb), kvh = (uu / nqb) % NKVA, qb = uu % nqb, head = kvh * GQA + hq;
        const int kcol = C_KA + kvh * HDIM, vcol = C_VA + kvh * HDIM;
        const int q0 = 64 * qb + 32 * ph;
        const int qrow = (lat ? b * SEQ : RL + b * CTX) + q0 + r;
        const int jlo = lat ? (2 - qb > 0 ? 2 - qb : 0) : 0, jhi = lat ? (33 - qb < 4 ? 33 - qb : 4) : -1;
        const int nt = CTX / 64 + (jhi - jlo + 1);
        bf16x8 Q[1][4];
#pragma unroll
        for (int s = 0; s < 4; ++s) Q[0][s] = *(const bf16x8*)(C.P + (size_t)qrow * PROJ + C_QA + head * HDIM + 16 * s + 8 * h);
        f32x16 O[1][2]; float m[1]; f32x4 L[1];
#pragma unroll
        for (int db = 0; db < 2; ++db)
#pragma unroll
            for (int i = 0; i < 16; ++i) O[0][db][i] = 0.f;
        m[0] = 0.f; L[0] = f32x4{0.f, 0.f, 0.f, 0.f};
        u32x4 kreg, vreg;
#define ATT_TROW(i) ((i) < CTX / 64 ? RL + b * CTX + 64 * (i) : b * SEQ + 64 * qb - 128 + 64 * (jlo + (i) - CTX / 64))
        bf16x8 Kf[8];
        ATT_PROLOGUE(4);
        int s0 = 0, s1 = BUF_B, s2 = 2 * BUF_B;
        for (int i = 0; i < nt; ++i) {
            if (i + 2 < nt) ATT_STG_STOREB(s2);
            if (i + 3 < nt) ATT_STG_LOAD(ATT_TROW(i + 3));
            const bool loc = i >= CTX / 64; const int d = loc ? q0 - (64 * qb - 128 + 64 * (jlo + i - CTX / 64)) : 0;
            const bool masked = loc && (d > 97 || d < -65);
            const unsigned lb = (unsigned)(size_t)C.lds;
            flash_tile<1, 4>(lb + s0 + TILE_B, lb + s1, i + 1 < nt, Q, O, m, L, onesA, Kf, lane, masked, d + r, i == 0);
            __syncthreads();
            { const int t = s0; s0 = s1; s1 = s2; s2 = t; }
        }
#undef ATT_TROW
        const float inv = 1.0f / (rowsum(L[0], lane) + __builtin_amdgcn_exp2f(C.p.attn_sink[l * NHA + head] * LOG2E - m[0]));
        bf16_t* op = C.MIX + (size_t)qrow * D + head * HDIM;
#pragma unroll
        for (int db = 0; db < 2; ++db)
#pragma unroll
            for (int g = 0; g < 4; g += 2) { u32x2 w[2];
#pragma unroll
                for (int q = 0; q < 2; ++q) { w[q].x = pk2(O[0][db][4 * (g + q)] * inv, O[0][db][4 * (g + q) + 1] * inv); w[q].y = pk2(O[0][db][4 * (g + q) + 2] * inv, O[0][db][4 * (g + q) + 3] * inv); }
                store_pair16(op + 32 * db + 8 * g, w[0], w[1], h); }
    }
}
__device__ __forceinline__ void phase_attnD(const Ctx& C, int l, bool need_ctx) {
    const int tid = tid_l(), lane = tid & 63, wave = __builtin_amdgcn_readfirstlane(tid >> 6), skey = tid >> 3, schunk = tid & 7;
    const int r = lane & 31, h = lane >> 5;
    const bf16x8 onesA = ones_rows(lane);
    const float lam_init = 0.8f - 0.6f * expf(-0.3f * (float)l);
    float lam;
    { const float* lp = C.p.diff_lambda + l * 4 * DD; const float a = lane < DD ? lp[lane] * lp[DD + lane] : 0.f, b2 = lane < DD ? lp[2 * DD + lane] * lp[3 * DD + lane] : 0.f;
      lam = expf(wave_sum(a)) - expf(wave_sum(b2)) + lam_init; }
    constexpr int NUL = NB * NHC * (SEQ / 256), NUC = NB * NHC * (CTX / 256);
    const int nu = NUL + (need_ctx ? NUC : 0);
    for (int u = blockIdx.x; u < nu; u += gridDim.x) {
        const bool lat = u < NUL; const int uu = lat ? u : u - NUL; const int nqb = lat ? SEQ / 256 : CTX / 256;
        const int b = uu / (NHC * nqb), hd = (uu / nqb) % NHC, qb = uu % nqb;
        const int kcol = C_KD + hd * 2 * DD, vcol = C_VD + hd * 2 * DD;
        const int qrow = (lat ? b * SEQ : RL + b * CTX) + 256 * qb + 32 * wave + r;
        const int nt = CTX / 64 + (lat ? SEQ / 64 : 0);
        bf16x8 Q[2][2];
#pragma unroll
        for (int j = 0; j < 2; ++j)
#pragma unroll
            for (int s = 0; s < 2; ++s) Q[j][s] = *(const bf16x8*)(C.P + (size_t)qrow * PROJ + C_QD + hd * 2 * DD + j * DD + 16 * s + 8 * h);
        f32x16 O[2][2]; float m[2]; f32x4 L[2];
#pragma unroll
        for (int j = 0; j < 2; ++j) { m[j] = 0.f; L[j] = f32x4{0.f, 0.f, 0.f, 0.f};
#pragma unroll
            for (int db = 0; db < 2; ++db)
#pragma unroll
                for (int i = 0; i < 16; ++i) O[j][db][i] = 0.f; }
        u32x4 kreg, vreg;
#define ATT_TROW(i) ((i) < CTX / 64 ? RL + b * CTX + 64 * (i) : b * SEQ + 64 * ((i) - CTX / 64))
        bf16x8 Kf[8];
        ATT_PROLOGUE(2);
        int s0 = 0, s1 = BUF_B, s2 = 2 * BUF_B;
#if PROBE_ATT
        unsigned long long pT0 = __builtin_readcyclecounter(), ptw = 0, ptb = 0;
#endif
        for (int i = 0; i < nt; ++i) {
#if PROBE_ATT
            { const unsigned long long t1 = __builtin_readcyclecounter(); asm volatile("s_waitcnt vmcnt(0)" ::: "memory"); ptw += __builtin_readcyclecounter() - t1; }
#endif
            if (i + 2 < nt) ATT_STG_STOREB(s2);
            if (i + 3 < nt) ATT_STG_LOAD(ATT_TROW(i + 3));
            const unsigned lb = (unsigned)(size_t)C.lds;
            flash_tile<2, 2>(lb + s0 + TILE_B, lb + s1, i + 1 < nt, Q, O, m, L, onesA, Kf, lane, false, 0, i == 0);
#if PROBE_ATT
            { const unsigned long long t1 = __builtin_readcyclecounter(); __syncthreads(); ptb += __builtin_readcyclecounter() - t1; }
#else
            __syncthreads();
#endif
            { const int t = s0; s0 = s1; s1 = s2; s2 = t; }
        }
#if PROBE_ATT
        if (l == 1 && u == 100 && tid == 64 * 3) { const float T = (float)(__builtin_readcyclecounter() - pT0);
            ((float*)(C.p.ws + WS_CTL))[8] = PROBE_ATT == 1 ? 1.0e4f * (float)ptw / T : PROBE_ATT == 2 ? 1.0e4f * (float)ptb / T : T / (float)nt; }
#endif
#undef ATT_TROW
        const float i0 = 1.0f / rowsum(L[0], lane), i1 = lam / rowsum(L[1], lane);
        float ss = 0.f;
#pragma unroll
        for (int db = 0; db < 2; ++db)
#pragma unroll
            for (int i = 0; i < 16; ++i) { const float y = O[0][db][i] * i0 - O[1][db][i] * i1; O[0][db][i] = y; ss += y * y; }
        const float rn = (1.0f - lam_init) / sqrtf(xsum32(ss) * (1.0f / (2 * DD)) + EPS);
        const float* sw = C.p.diff_subln + l * 2 * DD + 4 * h;
        bf16_t* op = C.MIX + (size_t)qrow * D + 768 + hd * 2 * DD;
#pragma unroll
        for (int db = 0; db < 2; ++db)
#pragma unroll
            for (int g = 0; g < 4; g += 2) { u32x2 w[2];
#pragma unroll
                for (int q = 0; q < 2; ++q) { const f32x4 s4 = *(const f32x4*)(sw + 32 * db + 8 * (g + q));
                    w[q].x = pk2(O[0][db][4 * (g + q)] * rn * s4[0], O[0][db][4 * (g + q) + 1] * rn * s4[1]); w[q].y = pk2(O[0][db][4 * (g + q) + 2] * rn * s4[2], O[0][db][4 * (g + q) + 3] * rn * s4[3]); }
                store_pair16(op + 32 * db + 8 * g, w[0], w[1], h); }
    }
}
#undef ATT_STG_LOAD
#undef ATT_STG_STORE
#undef ATT_STG_LOAD2
#undef ATT_STG_STORE2
#undef ATT_STG_STOREB
#undef ATT_PROLOGUE
}
__device__ __forceinline__ void phase_conv(const Ctx& C, int l, int nq) {
    const int tid = tid_l();
    const float* cw = C.p.conv_w + l * 3 * CONV_CH;
    for (long g = (long)blockIdx.x * NT + tid; g < (long)(nq / 8) * (CONV_CH / 8); g += (long)gridDim.x * NT) {
        const int row0 = (int)(g / (CONV_CH / 8)) * 8, c8 = (int)(g % (CONV_CH / 8)) * 8;
        const bool lat = row0 < RL; const int t0 = lat ? row0 % SEQ : (row0 - RL) % CTX, len = lat ? SEQ : CTX;
        float u[10][8];
#pragma unroll
        for (int i = 0; i < 10; ++i) { const int tt = t0 + i - 1;
            if (tt >= 0 && tt < len) { const bf16_t* pr = C.P + (size_t)(row0 + i - 1) * PROJ + c8; const u32x4 a = *(const u32x4*)(pr + C_CIN), c = *(const u32x4*)(pr + C_CC);
#pragma unroll
                for (int k = 0; k < 4; ++k) { u[i][2 * k] = __builtin_bit_cast(float, a[k] << 16) * __builtin_bit_cast(float, c[k] << 16); u[i][2 * k + 1] = __builtin_bit_cast(float, a[k] & 0xffff0000u) * __builtin_bit_cast(float, c[k] & 0xffff0000u); } }
            else {
#pragma unroll
                for (int k = 0; k < 8; ++k) u[i][k] = 0.f; } }
        float w[3][8];
#pragma unroll
        for (int j = 0; j < 3; ++j) { const f32x4 w0 = *(const f32x4*)(cw + j * CONV_CH + c8), w1 = *(const f32x4*)(cw + j * CONV_CH + c8 + 4);
#pragma unroll
            for (int k = 0; k < 4; ++k) { w[j][k] = w0[k]; w[j][4 + k] = w1[k]; } }
#pragma unroll
        for (int i = 0; i < 8; ++i) { const u32x4 gb = *(const u32x4*)(C.P + (size_t)(row0 + i) * PROJ + C_CB + c8); u32x4 o;
#pragma unroll
            for (int k = 0; k < 4; ++k) { const float y0 = w[0][2 * k] * u[i][2 * k] + w[1][2 * k] * u[i + 1][2 * k] + w[2][2 * k] * u[i + 2][2 * k];
                const float y1 = w[0][2 * k + 1] * u[i][2 * k + 1] + w[1][2 * k + 1] * u[i + 1][2 * k + 1] + w[2][2 * k + 1] * u[i + 2][2 * k + 1];
                o[k] = att::pk2(__builtin_bit_cast(float, gb[k] << 16) * y0, __builtin_bit_cast(float, gb[k] & 0xffff0000u) * y1); }
            *(u32x4*)(C.MIX + (size_t)(row0 + i) * D + 512 + c8) = o; }
    }
}
#ifndef ATT_A
#define ATT_A 1
#endif
#ifndef ATT_D
#define ATT_D 1
#endif
__device__ __forceinline__ void phase_mix_naive(const Ctx& C, int l, int nq) {
    const int tid = tid_l(), lane = tid & 63, wave = __builtin_amdgcn_readfirstlane(tid >> 6), gw = blockIdx.x * NWV + wave, NGW = gridDim.x * NWV; (void)lane; (void)gw; (void)NGW;
    const long g0 = (long)blockIdx.x * NT + tid, gs = (long)gridDim.x * NT; const float lam_init = 0.8f - 0.6f * expf(-0.3f * (float)l);
#if !ATT_A
    for (long g = g0; g < (long)nq * NHA; g += gs) b_attnA(g, C.P, C.p.attn_sink + l * NHA, C.MIX, nq);
#endif
#if !ATT_D
    for (long g = g0; g < (long)nq * NHC * 2; g += gs) b_attnD(g, C.P, C.TMP, nq);
#endif
    (void)g0; (void)gs;
}
__device__ __forceinline__ void phase_diffpost_naive(const Ctx& C, int l, int nq) {
    const int tid = tid_l(), lane = tid & 63, wave = __builtin_amdgcn_readfirstlane(tid >> 6), gw = blockIdx.x * NWV + wave, NGW = gridDim.x * NWV; (void)lane; (void)gw; (void)NGW;
    const long g0 = (long)blockIdx.x * NT + tid, gs = (long)gridDim.x * NT; const float lam_init = 0.8f - 0.6f * expf(-0.3f * (float)l);
    for (long g = g0; g < (long)nq * NHC; g += gs) b_diffpost(g, C.TMP, C.p.diff_lambda + l * 4 * DD, C.p.diff_subln + l * 2 * DD, lam_init, C.MIX, nq);
}

#ifndef DBL
#define DBL 0
#endif
#define REP(bit) for (int _rep = 0; _rep < (((DBL) & (bit)) ? 2 : 1); ++_rep)
constexpr int CVT_PER_WAVE = 60;
constexpr int NPH = 9, PH_L0 = 2, PH_FINAL = PH_L0 + DEPTH * NPH, PH_TOTAL = PH_FINAL + 1;
__global__ void __launch_bounds__(NT, 2) mega_fwd(Args args) {
    extern __shared__ __attribute__((aligned(16))) unsigned char lds_raw[];
    Ctx C;
    { int w = __builtin_amdgcn_readfirstlane(threadIdx.x >> 6); asm volatile("" : "+s"(w)); C.wv = w; }
    C.p.x = args.in[0]; C.p.c = args.in[1]; C.p.ctx = args.in[2]; C.p.c_ctx = args.in[3]; C.p.w_ada = args.in[4]; C.p.b_ada = args.in[5]; C.p.norm1 = args.in[6]; C.p.norm2 = args.in[7];
    C.p.w_in = args.in[8]; C.p.w_out = args.in[9]; C.p.attn_sink = args.in[10]; C.p.conv_w = args.in[11]; C.p.diff_lambda = args.in[12]; C.p.diff_subln = args.in[13]; C.p.router = args.in[14];
    C.p.w_gate = args.in[15]; C.p.w_up = args.in[16]; C.p.w_down = args.in[17]; C.p.norm_final = args.in[18];
    C.p.out = args.out; C.p.ws = args.ws;
    C.lds = (LAS unsigned char*)lds_raw;
    unsigned char* ws = args.ws;
    C.tab = (float*)(ws + WS_TAB); C.mod = (float*)(ws + WS_MOD); C.aff = (float*)(ws + WS_AFF); C.sel = (int*)(ws + WS_SEL); C.gate = (float*)(ws + WS_GATE); C.tokslot = (int*)(ws + WS_TOKSLOT);
    C.xc = (float*)(ws + WS_XC); C.xl = args.out; C.win = (bf16_t*)(ws + WS_WIN); C.wout = (bf16_t*)(ws + WS_WOUT);
    C.P = (bf16_t*)(ws + WS_R1); C.H = (bf16_t*)(ws + WS_R1); C.Y = (bf16_t*)(ws + WS_R2); C.MIX = (bf16_t*)(ws + WS_R2); C.HX2 = (bf16_t*)(ws + WS_R2 + (size_t)RALL * D * 2); C.TMP = (float*)C.HX2;
    C.HX = (bf16_t*)(ws + WS_R3); C.XB = (bf16_t*)(ws + WS_XB);
    volatile LAS unsigned* misc = (volatile LAS unsigned*)(C.lds + LDS_MISC);
    { const int t0 = tid_l(); if (t0 < 64) misc[t0] = 0u; }
    __syncthreads();
    const int lo = args.ph_lo, hi = args.ph_hi;
    XcdBarrier bar; bar.bar = (unsigned*)(ws + WS_CTL) + CW_BAR; bar.x = 0; bar.st = misc; bar.wv = C.wv;
    if (hi - lo > 1) bar = xcd_barrier_post((unsigned*)(ws + WS_CTL) + CW_BAR, misc, C.wv);
#define IN(k) (lo <= (k) && (k) < hi)
#define SEAM(k) do { if (IN(k) && IN((k) + 1)) xcd_barrier(bar); } while (0)
    const int G = (int)gridDim.x, bid = (int)blockIdx.x;
    if (IN(0)) REP(512) phase_prologue(C);
    SEAM(0);
    if (IN(1)) phase_prologue_b(C);
    SEAM(1);
    for (int l = 0; l < DEPTH; ++l) {
        const int pb = PH_L0 + l * NPH; const bool need_ctx = l < DEPTH - 1; const int nq = need_ctx ? RALL : RL;
        const float* modl = C.mod + (size_t)l * (NB + 1) * 6 * D;
        const int nu1 = (RALL / 256) * (PROJ / 256), G1 = (nu1 + (nu1 + G - 1) / G - 1) / ((nu1 + G - 1) / G);
        const int nu4 = (nq / 256) * (D / 256), G4 = (nu4 + (nu4 + G - 1) / G - 1) / ((nu4 + G - 1) / G);
        const int cn1 = (G - G1) * NWV * CVT_PER_WAVE < CVT_ITEMS ? (G - G1) * NWV * CVT_PER_WAVE : CVT_ITEMS;
        const int cn4 = cn1 + (G - G4) * NWV * CVT_PER_WAVE < CVT_ITEMS ? cn1 + (G - G4) * NWV * CVT_PER_WAVE : CVT_ITEMS;
        if (IN(pb + 0)) { { const int wv_ = C.wv; REP(256) phase_cvt_experts(C, l, cn4, CVT_ITEMS, bid * NWV + wv_, G * NWV); } if (l == 0) phase_rowA<false, true>(C, 0); else phase_rowA<false, false>(C, l); if ((DBL) & 1024) { if (l == 0) phase_rowA<false, true>(C, 0); else phase_rowA<false, false>(C, l, 0.0f); } }
        SEAM(pb + 0);
        if (IN(pb + 1)) { if (bid < G1) { pg::GemmD g{(const char*)C.HX, nullptr, (const char*)C.win + (size_t)l * PROJ * D, 0, D / 2}; pg::Order S; S.init(RALL / 256, PROJ / 256, G1, bid, 0);
            pg::EpiP E{C.P, C.tab, (const float*)(ws + WS_HXS), (const float*)(ws + WS_CTL + CTL_WINMAX) + l * 256}; REP(1) pg::gemm_phase<pg::EpiP, false, 2>(C.lds, g, S, E, C.wv); }
            else phase_cvt_experts(C, l, 0, cn1, (bid - G1) * NWV + C.wv, (G - G1) * NWV); }
        SEAM(pb + 1);
        if (IN(pb + 2)) {
#if ATT_A
            REP(2) att::phase_attnA(C, l, need_ctx);
#endif
#if ATT_D
            REP(4) att::phase_attnD(C, l, need_ctx);
#endif
            phase_mix_naive(C, l, nq); REP(128) phase_conv(C, l, nq); }
        SEAM(pb + 2);
#if !ATT_D
        if (IN(pb + 3)) phase_diffpost_naive(C, l, nq);
        SEAM(pb + 3);
#endif
        if (IN(pb + 4)) { if (bid < G4) { pg::GemmD g{(const char*)C.MIX, nullptr, (const char*)(C.wout + (size_t)l * D * D), 0, D}; pg::Order S; S.init(nq / 256, D / 256, G4, bid, 0);
            pg::EpiX E{C.XB, modl, 1.0f}; pg::gemm_phase<pg::EpiX, false>(C.lds, g, S, E, C.wv);
            if ((DBL) & 2048) { pg::EpiX E0{C.XB, modl, 0.0f}; pg::gemm_phase<pg::EpiX, false>(C.lds, g, S, E0, C.wv); } }
            else phase_cvt_experts(C, l, cn1, cn4, (bid - G4) * NWV + C.wv, (G - G4) * NWV); }
        SEAM(pb + 4);
        if (IN(pb + 5)) REP(8) phase_rowB(C, l, nq);
        SEAM(pb + 5);
        if (IN(pb + 6)) REP(16) phase_select(C, need_ctx);
        SEAM(pb + 6);
        const int tpe = need_ctx ? pg::TPE_FULL : SLOTS_L / 256;
        if (IN(pb + 7)) { pg::GemmD g{(const char*)C.HX2, C.sel, (const char*)(ws + WS_WGU + (size_t)(l & 1) * NE * 2 * FF * D), (size_t)2 * FF * D, D / 2}; pg::Order S; S.init(NE * tpe, 2 * FF / 256, G, bid, tpe);
            pg::EpiH E{(unsigned char*)C.H}; REP(32) pg::gemm_phase<pg::EpiH, true, 1>(C.lds, g, S, E, C.wv); }
        SEAM(pb + 7);
        if (IN(pb + 8)) { pg::GemmD g{(const char*)C.H, nullptr, (const char*)(ws + WS_WD + (size_t)(l & 1) * NE * D * FF), (size_t)D * FF, FF / 2}; pg::Order S; S.init(NE * tpe, D / 256, G, bid, tpe);
            pg::EpiY E{(unsigned char*)C.Y, C.gate}; REP(64) pg::gemm_phase<pg::EpiY, false, 1>(C.lds, g, S, E, C.wv); }
        SEAM(pb + 8);
    }
    if (IN(PH_FINAL)) phase_rowA<true, false>(C, DEPTH);
#if PROBE_ATT
    if (hi - lo > 1) xcd_barrier(bar);
    if (bid == 100 && tid_l() == 0) { asm volatile("s_waitcnt vmcnt(0)" ::: "memory"); C.p.out[0] = ((const float*)(C.p.ws + WS_CTL))[8]; }
#endif
#undef IN
#undef SEAM
}
#endif

#ifndef HOST_TEST
#ifndef MODE
#define MODE 2
#endif
extern "C" void kernel_launch(void* const* d_in, const int* in_sizes, int n_in, void* d_out, int out_size, void* d_ws, size_t ws_size, hipStream_t stream) {
    if (n_in != 19 || out_size != RL * D || ws_size < WS_END) { fprintf(stderr, "kernel_launch: unexpected shapes (n_in %d out %d ws %zu need %zu)\n", n_in, out_size, ws_size, (size_t)WS_END); return; }
#if MODE == 0
    Ptrs p{};
    const float** f = (const float**)&p;
    for (int i = 0; i < 19; ++i) f[i] = (const float*)d_in[i];
    p.out = (float*)d_out; p.ws = (unsigned char*)d_ws;
    forward(p, stream);
#else
    static int grid = 0;
    if (grid == 0) {
        int dev = 0, cus = 0;
        if (hipGetDevice(&dev) != hipSuccess || hipDeviceGetAttribute(&cus, hipDeviceAttributeMultiprocessorCount, dev) != hipSuccess) { fprintf(stderr, "kernel_launch: device query failed\n"); grid = -1; return; }
        if (hipFuncSetAttribute((const void*)mega_fwd, hipFuncAttributeMaxDynamicSharedMemorySize, LDS_BYTES) != hipSuccess) { fprintf(stderr, "kernel_launch: hipFuncSetAttribute failed\n"); grid = -1; return; }
        int per_cu = 0;
        if (hipOccupancyMaxActiveBlocksPerMultiprocessor(&per_cu, (const void*)mega_fwd, NT, LDS_BYTES) != hipSuccess || per_cu < 1) fprintf(stderr, "kernel_launch: occupancy query reports %d blocks per CU\n", per_cu);
        (void)hipGetLastError();
        grid = cus;
    }
    if (grid < 0) return;
    if (hipMemsetAsync((char*)d_ws + WS_CTL, 0, CTL_BYTES, stream) != hipSuccess) { fprintf(stderr, "kernel_launch: memset failed\n"); return; }
    Args a{};
    for (int i = 0; i < 19; ++i) a.in[i] = (const float*)d_in[i];
    a.out = (float*)d_out; a.ws = (unsigned char*)d_ws;
#if MODE == 2
    a.ph_lo = 0; a.ph_hi = PH_TOTAL;
    hipLaunchKernelGGL(mega_fwd, dim3(grid), dim3(NT), LDS_BYTES, stream, a);
#else
    for (int ph = 0; ph < PH_TOTAL; ++ph) { a.ph_lo = ph; a.ph_hi = ph + 1; hipLaunchKernelGGL(mega_fwd, dim3(grid), dim3(NT), LDS_BYTES, stream, a); }
#endif
    const hipError_t le = hipPeekAtLastError();
    if (le != hipSuccess) fprintf(stderr, "kernel_launch: launch failed: %s\n", hipGetErrorName(le));
#endif
}
#else
#include <vector>
#include <string>
static std::vector<float> rd(const std::string& fn) { FILE* f = fopen(fn.c_str(), "rb"); if (!f) { perror(fn.c_str()); exit(1); } fseek(f, 0, SEEK_END); long n = ftell(f); fseek(f, 0, SEEK_SET); std::vector<float> v(n / 4); if (fread(v.data(), 1, n, f) != (size_t)n) exit(1); fclose(f); return v; }
int main(int argc, char** argv) {
    std::string dir = argv[1]; std::vector<std::vector<float>> in(19);
    for (int i = 0; i < 19; ++i) in[i] = rd(dir + "/in" + std::to_string(i) + ".bin");
    std::vector<float> out((size_t)RL * D); std::vector<unsigned char> ws(WS_END, 0xAA);
    Ptrs p{}; const float** f = (const float**)&p; for (int i = 0; i < 19; ++i) f[i] = in[i].data();
    p.out = out.data(); p.ws = ws.data();
    forward(p, 0);
    FILE* fo = fopen((dir + "/out.bin").c_str(), "wb"); fwrite(out.data(), 4, out.size(), fo); fclose(fo);
    printf("done, ws bytes %zu\n", (size_t)WS_END); return 0;
}
#endif
```

```cpp
#ifndef HOST_TEST
#include <hip/hip_runtime.h>
#endif
#include <cstdio>
#include <cstdint>
#include <cstring>
#include <cmath>

#ifndef CFG_B
#define CFG_B 32
#endif
#ifndef CFG_SEQ
#define CFG_SEQ 2048
#endif
#ifndef CFG_CTX
#define CFG_CTX 256
#endif
#ifndef CFG_DEPTH
#define CFG_DEPTH 4
#endif
constexpr int D = 1024, NB = CFG_B, SEQ = CFG_SEQ, CTX = CFG_CTX, DEPTH = CFG_DEPTH;
constexpr int GRID_W = 64, NROWS = SEQ / GRID_W, HDIM = 64, NHA = 8, NKVA = 2, GQA = 4, WINDOW = 128;
constexpr int CONV_CH = 256, DD = 32, NHC = 4, NE = 16, FF = 1024, PROJ = 2304;
constexpr int RL = NB * SEQ, RC = NB * CTX, RALL = RL + RC;
constexpr int CAPL = 2 * SEQ / NE, CAPC = 2 * CTX / NE;
constexpr int SLOTS_L = NB * CAPL, SLOTS_C = NB * CAPC, SLOTS_E = SLOTS_L + SLOTS_C;
constexpr int NSLOT = NE * SLOTS_E;
constexpr int C_QA = 0, C_KA = 512, C_VA = 640, C_CIN = 768, C_CB = 1024, C_CC = 1280, C_QD = 1536, C_KD = 1792, C_VD = 2048;
constexpr int M_SH1 = 0, M_SC1 = D, M_G1 = 2 * D, M_SH2 = 3 * D, M_SC2 = 4 * D, M_G2 = 5 * D;
constexpr float EPS = 1e-6f, LOG2E = 1.4426950408889634f;
constexpr float QSCALE_A = 0.125f * LOG2E, QSCALE_D = 0.17677669529663687f * LOG2E;

#ifdef HOST_TEST
#define HD
#define KERNEL static void
static thread_local long g_gid;
#define GID g_gid
#include <omp.h>
#define LAUNCH(kern, nthreads, ...) do { const long _n = (long)(nthreads); _Pragma("omp parallel for schedule(static)") for (long _g = 0; _g < _n; ++_g) { g_gid = _g; kern(__VA_ARGS__); } } while (0)
#else
#define HD __host__ __device__ __forceinline__
#define KERNEL __global__ void __launch_bounds__(256)
#define GID ((long)blockIdx.x * blockDim.x + threadIdx.x)
#define LAUNCH(kern, nthreads, ...) do { const long _n = (long)(nthreads); if (_n > 0) hipLaunchKernelGGL(kern, dim3((unsigned)((_n + 255) / 256)), dim3(256), 0, stream, __VA_ARGS__); } while (0)
#endif

typedef unsigned short bf16_t;
HD float bf2f(bf16_t v) { unsigned u = (unsigned)v << 16; return __builtin_bit_cast(float, u); }
HD bf16_t f2bf(float f) { unsigned u = __builtin_bit_cast(unsigned, f); return (bf16_t)((u + 0x7fffu + ((u >> 16) & 1u)) >> 16); }

constexpr size_t al256(size_t x) { return (x + 255) & ~(size_t)255; }
constexpr size_t WS_CTL = 0, CTL_BYTES = 1u << 20;
constexpr size_t WS_TAB = WS_CTL + CTL_BYTES;
constexpr int T_AROW = 0, T_ACOL = T_AROW + NROWS * 16 * 2, T_DROW = T_ACOL + 64 * 16 * 2, T_DCOL = T_DROW + NROWS * 8 * 2, T_END = T_DCOL + 64 * 8 * 2;
constexpr size_t WS_SILU = WS_TAB + al256((size_t)T_END * 4);
constexpr size_t WS_MOD = WS_SILU + al256((size_t)(NB + 1) * D * 4);
constexpr size_t WS_RSTD = WS_MOD + al256((size_t)DEPTH * (NB + 1) * 6 * D * 4);
constexpr size_t WS_AFF = WS_RSTD + al256((size_t)RALL * 4);
constexpr size_t WS_SEL = WS_AFF + al256((size_t)RALL * NE * 4);
constexpr size_t WS_GATE = WS_SEL + al256((size_t)NSLOT * 4);
constexpr size_t WS_TOKSLOT = WS_GATE + al256((size_t)NSLOT * 4);
constexpr size_t WS_XC = WS_TOKSLOT + al256((size_t)RALL * NE * 4);
constexpr size_t WS_WIN = WS_XC + al256((size_t)RC * D * 4);
constexpr size_t WS_WOUT = WS_WIN + al256((size_t)DEPTH * PROJ * D * 2);
constexpr size_t WS_WGU = WS_WOUT + al256((size_t)DEPTH * D * D * 2);
constexpr size_t WS_WD = WS_WGU + al256((size_t)2 * NE * 2 * FF * D * 2);
constexpr size_t WS_R1 = WS_WD + al256((size_t)2 * NE * D * FF * 2);
constexpr size_t R1_BYTES = al256(((size_t)RALL * PROJ * 2 > (size_t)NSLOT * FF * 2) ? (size_t)RALL * PROJ * 2 : (size_t)NSLOT * FF * 2);
constexpr size_t WS_R2 = WS_R1 + R1_BYTES;
constexpr size_t R2_BYTES = al256(((size_t)NSLOT * D * 2 > (size_t)2 * RALL * D * 2) ? (size_t)NSLOT * D * 2 : (size_t)2 * RALL * D * 2);
constexpr size_t WS_R3 = WS_R2 + R2_BYTES;
constexpr size_t WS_XB = WS_R3 + al256((size_t)RALL * D * 2);
constexpr size_t WS_HXS = WS_XB + al256((size_t)RALL * D * 2);
constexpr size_t WS_END = WS_HXS + al256((size_t)RALL * 4);
constexpr size_t CTL_WINMAX = 262144;

struct Ptrs {
    const float *x, *c, *ctx, *c_ctx, *w_ada, *b_ada, *norm1, *norm2, *w_in, *w_out, *attn_sink, *conv_w, *diff_lambda, *diff_subln, *router, *w_gate, *w_up, *w_down, *norm_final;
    float* out; unsigned char* ws;
};

HD float* xrow_ptr(float* xl, float* xc, int row) { return row < RL ? xl + (size_t)row * D : xc + (size_t)(row - RL) * D; }
HD int row_batch(int row) { return row < RL ? row / SEQ : NB; }
HD float silu_f(float v) { return v / (1.0f + expf(-v)); }

KERNEL k_tables(float* tab) {
    const long g = GID; if (g >= (long)(NROWS + 64) * 24) return;
    const int pos = (int)(g / 24), f = (int)(g % 24);
    const double inv = f < 16 ? pow(10000.0, -(2.0 * f) / 32.0) : pow(10000.0, -(2.0 * (f - 16)) / 16.0);
    const bool isrow = pos < NROWS; const int p = isrow ? pos : pos - NROWS;
    const double ang = (double)p * inv; const float cs = (float)cos(ang), sn = (float)sin(ang);
    int idx;
    if (f < 16) idx = (isrow ? T_AROW : T_ACOL) + (p * 16 + f) * 2; else idx = (isrow ? T_DROW : T_DCOL) + (p * 8 + (f - 16)) * 2;
    tab[idx] = cs; tab[idx + 1] = sn;
}
KERNEL k_silu(const float* c, const float* c_ctx, float* out) {
    const long g = GID; if (g >= (long)(NB + 1) * D) return;
    const int b = (int)(g / D), k = (int)(g % D); const float v = b < NB ? c[b * D + k] : c_ctx[k];
    out[g] = silu_f(v);
}
KERNEL k_mod(const float* silu, const float* w_ada, const float* b_ada, float* mod) {
    const long g = GID; if (g >= (long)DEPTH * 6 * D) return;
    const int l = (int)(g / (6 * D)), j = (int)(g % (6 * D));
    float acc[NB + 1];
#pragma unroll
    for (int b = 0; b <= NB; ++b) acc[b] = 0.f;
    const float* w = w_ada + (size_t)l * D * 6 * D + j;
    for (int k = 0; k < D; ++k) { const float wv = w[(size_t)k * 6 * D];
#pragma unroll
        for (int b = 0; b <= NB; ++b) acc[b] += silu[b * D + k] * wv; }
    const float bias = b_ada[l * 6 * D + j];
#pragma unroll
    for (int b = 0; b <= NB; ++b) mod[((size_t)l * (NB + 1) + b) * 6 * D + j] = acc[b] + bias;
}
HD int permA(int p) { return (p / 32) * 32 + (p % 32) / 2 + 16 * (p % 2); }
HD int permD(int p) { return (p / 16) * 16 + (p % 16) / 2 + 8 * (p % 2); }
HD int inproj_src_col(int n) {
    if (n < C_VA) return (n / 64) * 64 + permA(n % 64);
    if (n < C_QD) return n;
    if (n < C_VD) return (n / 32) * 32 + permD(n % 32);
    return n;
}
KERNEL k_cvt_win(const float* w_in, bf16_t* wt) {
    const long g = GID; if (g >= (long)DEPTH * PROJ * D) return;
    const int k = (int)(g % D); const int n = (int)((g / D) % PROJ); const int l = (int)(g / ((long)D * PROJ));
    wt[g] = f2bf(w_in[((size_t)l * D + k) * PROJ + inproj_src_col(n)]);
}
KERNEL k_cvt_t(const float* w, bf16_t* wt, int nmat, int K, int N) {
    const long g = GID; if (g >= (long)nmat * K * N) return;
    const int k = (int)(g % K); const int n = (int)((g / K) % N); const int m = (int)(g / ((long)K * N));
    wt[g] = f2bf(w[((size_t)m * K + k) * N + n]);
}
KERNEL k_cvt_gu(const float* wg, const float* wu, bf16_t* wt) {
    const long g = GID; if (g >= (long)NE * 2 * FF * D) return;
    const int k = (int)(g % D); const int n = (int)((g / D) % (2 * FF)); const int e = (int)(g / ((long)D * 2 * FF));
    const int blk = n / 256, bj = (n % 256) / 128, j = n % 128; const float* src = bj ? wu : wg;
    wt[g] = f2bf(src[((size_t)e * D + k) * FF + blk * 128 + j]);
}
KERNEL k_rowstat(const float* xl, const float* xc, float* rstd, int nrows) {
    const long g = GID; if (g >= nrows) return;
    const float* xr = xrow_ptr((float*)xl, (float*)xc, (int)g); float s = 0.f;
    for (int k = 0; k < D; ++k) s += xr[k] * xr[k];
    rstd[g] = 1.0f / sqrtf(s / D + EPS);
}
KERNEL k_rowapply(const float* xl, const float* xc, const float* rstd, const float* nw, const float* modl, int sh_off, int sc_off, bf16_t* hx, int nrows) {
    const long g = GID; if (g >= (long)nrows * D) return;
    const int row = (int)(g / D), k = (int)(g % D); const float* xr = xrow_ptr((float*)xl, (float*)xc, row);
    const float* m = modl + (size_t)row_batch(row) * 6 * D;
    const float v = xr[k] * rstd[row] * nw[k] * (1.0f + m[sc_off + k]) + m[sh_off + k];
    hx[g] = f2bf(v);
}
struct EpiInProj {
    bf16_t* P; const float* tab;
    HD void operator()(int row, int c0, const float* v, const float*) const {
        float o[4] = {v[0], v[1], v[2], v[3]};
        const bool lat = row < RL; const int pos = lat ? row % SEQ : 0; const int gr = pos / GRID_W, gc = pos % GRID_W;
        if (c0 < C_VA) {
            if (lat) { const int p = c0 % 64, grp = p / 32, i0 = (p % 32) / 2;
                const float* t = tab + (grp == 0 ? T_AROW + gr * 32 : T_ACOL + gc * 32) + i0 * 2;
                const float a0 = o[0], b0 = o[1], a1 = o[2], b1 = o[3];
                o[0] = a0 * t[0] - b0 * t[1]; o[1] = b0 * t[0] + a0 * t[1]; o[2] = a1 * t[2] - b1 * t[3]; o[3] = b1 * t[2] + a1 * t[3]; }
            if (c0 < C_KA) { for (int j = 0; j < 4; ++j) o[j] *= QSCALE_A; }
        } else if (c0 >= C_QD && c0 < C_VD) {
            if (lat) { const int p = c0 % 32, grp = p / 16, i0 = (p % 16) / 2;
                const float* t = tab + (grp == 0 ? T_DROW + gr * 16 : T_DCOL + gc * 16) + i0 * 2;
                const float a0 = o[0], b0 = o[1], a1 = o[2], b1 = o[3];
                o[0] = a0 * t[0] - b0 * t[1]; o[1] = b0 * t[0] + a0 * t[1]; o[2] = a1 * t[2] - b1 * t[3]; o[3] = b1 * t[2] + a1 * t[3]; }
            if (c0 < C_KD) { for (int j = 0; j < 4; ++j) o[j] *= QSCALE_D; }
        }
        bf16_t* d = P + (size_t)row * PROJ + c0;
        for (int j = 0; j < 4; ++j) d[j] = f2bf(o[j]);
    }
};
struct EpiOutProj {
    float* xl; float* xc; const float* modl;
    HD void operator()(int row, int c0, const float* v, const float*) const {
        float* xr = xrow_ptr(xl, xc, row) + c0; const float* g1 = modl + (size_t)row_batch(row) * 6 * D + M_G1 + c0;
        for (int j = 0; j < 4; ++j) xr[j] += g1[j] * v[j];
    }
};
struct EpiGateUp {
    bf16_t* H;
    HD void operator()(int row, int c0, const float* v, const float* u) const {
        bf16_t* d = H + (size_t)row * FF + c0;
        for (int j = 0; j < 4; ++j) d[j] = f2bf(silu_f(v[j]) * u[j]);
    }
};
struct EpiDown {
    bf16_t* Y; const float* gate;
    HD void operator()(int row, int c0, const float* v, const float*) const {
        const float g = gate[row]; bf16_t* d = Y + (size_t)row * D + c0;
        for (int j = 0; j < 4; ++j) d[j] = f2bf(v[j] * g);
    }
};
template <class Epi, bool DUAL>
KERNEL k_gemm_naive(const bf16_t* A, const int* rowidx, const bf16_t* Bt, int M, int N, int K, int group_rows, int valid_rows, long bstride, Epi epi) {
    const long g = GID; if (g >= (long)M * (N / 4)) return;
    const int row = (int)(g / (N / 4)), c0 = (int)(g % (N / 4)) * 4;
    if (row % group_rows >= valid_rows) return;
    const int arow = rowidx ? rowidx[row] : row;
    const bf16_t* a = A + (size_t)arow * K; const bf16_t* B = Bt + (size_t)(row / group_rows) * bstride;
    float v[4], u[4];
    for (int j = 0; j < 4; ++j) { const int c = c0 + j; const int br = DUAL ? (c / 128) * 256 + c % 128 : c;
        const bf16_t* b0 = B + (size_t)br * K; float s = 0.f, s2 = 0.f;
        for (int k = 0; k < K; ++k) s += bf2f(a[k]) * bf2f(b0[k]);
        if (DUAL) { const bf16_t* b1 = b0 + (size_t)128 * K; for (int k = 0; k < K; ++k) s2 += bf2f(a[k]) * bf2f(b1[k]); }
        v[j] = s; u[j] = s2; }
    epi(row, c0, v, u);
}
HD void b_attnA(const long g, const bf16_t* P, const float* sink, bf16_t* MIX, int nrows) {
    if (g >= (long)nrows * NHA) return;
    const int h = (int)(g / nrows), row = (int)(g % nrows), kvh = h / GQA;
    const bool lat = row < RL; const int b = lat ? row / SEQ : (row - RL) / CTX; const int t = lat ? row % SEQ : 0;
    float q[HDIM], o[HDIM];
    const bf16_t* qp = P + (size_t)row * PROJ + C_QA + h * HDIM;
#pragma unroll
    for (int d = 0; d < HDIM; ++d) { q[d] = bf2f(qp[d]); o[d] = 0.f; }
    float m = sink[h] * LOG2E, l = 1.0f;
    const int nctx = CTX, lo = lat ? (t - WINDOW < 0 ? 0 : t - WINDOW) : 0, hi = lat ? (t + WINDOW > SEQ - 1 ? SEQ - 1 : t + WINDOW) : -1;
    const int nkeys = nctx + (hi - lo + 1);
    for (int i = 0; i < nkeys; ++i) {
        const int krow = i < nctx ? RL + b * CTX + i : b * SEQ + lo + (i - nctx);
        const bf16_t* kp = P + (size_t)krow * PROJ + C_KA + kvh * HDIM; const bf16_t* vp = P + (size_t)krow * PROJ + C_VA + kvh * HDIM;
        float s = 0.f;
#pragma unroll
        for (int d = 0; d < HDIM; ++d) s += q[d] * bf2f(kp[d]);
        if (s > m) { const float sc = exp2f(m - s); l *= sc;
#pragma unroll
            for (int d = 0; d < HDIM; ++d) o[d] *= sc;
            m = s; }
        const float p = exp2f(s - m); l += p;
#pragma unroll
        for (int d = 0; d < HDIM; ++d) o[d] += p * bf2f(vp[d]);
    }
    const float inv = 1.0f / l; bf16_t* op = MIX + (size_t)row * D + h * HDIM;
#pragma unroll
    for (int d = 0; d < HDIM; ++d) op[d] = f2bf(o[d] * inv);
}
KERNEL k_attnA(const bf16_t* P, const float* sink, bf16_t* MIX, int nrows) { b_attnA(GID, P, sink, MIX, nrows); }
HD void b_attnD(const long g, const bf16_t* P, float* TMP, int nrows) {
    if (g >= (long)nrows * NHC * 2) return;
    const int hc = (int)(g / nrows), row = (int)(g % nrows), h = hc / 2, comp = hc % 2;
    const bool lat = row < RL; const int b = lat ? row / SEQ : (row - RL) / CTX;
    float q[DD], o[2 * DD];
    const bf16_t* qp = P + (size_t)row * PROJ + C_QD + h * 2 * DD + comp * DD;
#pragma unroll
    for (int d = 0; d < DD; ++d) q[d] = bf2f(qp[d]);
#pragma unroll
    for (int d = 0; d < 2 * DD; ++d) o[d] = 0.f;
    float m = -1e30f, l = 0.f;
    const int nkeys = CTX + (lat ? SEQ : 0);
    for (int i = 0; i < nkeys; ++i) {
        const int krow = i < CTX ? RL + b * CTX + i : b * SEQ + (i - CTX);
        const bf16_t* kp = P + (size_t)krow * PROJ + C_KD + h * 2 * DD + comp * DD; const bf16_t* vp = P + (size_t)krow * PROJ + C_VD + h * 2 * DD;
        float s = 0.f;
#pragma unroll
        for (int d = 0; d < DD; ++d) s += q[d] * bf2f(kp[d]);
        if (s > m) { const float sc = exp2f(m - s); l *= sc;
#pragma unroll
            for (int d = 0; d < 2 * DD; ++d) o[d] *= sc;
            m = s; }
        const float p = exp2f(s - m); l += p;
#pragma unroll
        for (int d = 0; d < 2 * DD; ++d) o[d] += p * bf2f(vp[d]);
    }
    const float inv = 1.0f / l; float* op = TMP + (((size_t)row * NHC + h) * 2 + comp) * 2 * DD;
#pragma unroll
    for (int d = 0; d < 2 * DD; ++d) op[d] = o[d] * inv;
}
KERNEL k_attnD(const bf16_t* P, float* TMP, int nrows) { b_attnD(GID, P, TMP, nrows); }
HD void b_diffpost(const long g, const float* TMP, const float* lam_p, const float* subln, float lam_init, bf16_t* MIX, int nrows) {
    if (g >= (long)nrows * NHC) return;
    const int row = (int)(g / NHC), h = (int)(g % NHC);
    float s01 = 0.f, s23 = 0.f;
    for (int d = 0; d < DD; ++d) { s01 += lam_p[d] * lam_p[DD + d]; s23 += lam_p[2 * DD + d] * lam_p[3 * DD + d]; }
    const float lam = expf(s01) - expf(s23) + lam_init;
    const float* t = TMP + ((size_t)row * NHC + h) * 2 * 2 * DD; float y[2 * DD]; float ss = 0.f;
#pragma unroll
    for (int d = 0; d < 2 * DD; ++d) { y[d] = t[d] - lam * t[2 * DD + d]; ss += y[d] * y[d]; }
    const float r = 1.0f / sqrtf(ss / (2 * DD) + EPS) * (1.0f - lam_init);
    bf16_t* op = MIX + (size_t)row * D + 768 + h * 2 * DD;
#pragma unroll
    for (int d = 0; d < 2 * DD; ++d) op[d] = f2bf(y[d] * r * subln[d]);
}
KERNEL k_diffpost(const float* TMP, const float* lam_p, const float* subln, float lam_init, bf16_t* MIX, int nrows) { b_diffpost(GID, TMP, lam_p, subln, lam_init, MIX, nrows); }
HD void b_conv(const long g, const bf16_t* P, const float* cw, bf16_t* MIX, int nrows) {
    if (g >= (long)nrows * CONV_CH) return;
    const int row = (int)(g / CONV_CH), ch = (int)(g % CONV_CH);
    const bool lat = row < RL; const int t = lat ? row % SEQ : (row - RL) % CTX, len = lat ? SEQ : CTX;
    float y = 0.f;
    for (int j = 0; j < 3; ++j) { const int tt = t + j - 1; if (tt < 0 || tt >= len) continue;
        const bf16_t* pr = P + (size_t)(row + j - 1) * PROJ; y += cw[j * CONV_CH + ch] * (bf2f(pr[C_CC + ch]) * bf2f(pr[C_CIN + ch])); }
    MIX[(size_t)row * D + 512 + ch] = f2bf(bf2f(P[(size_t)row * PROJ + C_CB + ch]) * y);
}
KERNEL k_conv(const bf16_t* P, const float* cw, bf16_t* MIX, int nrows) { b_conv(GID, P, cw, MIX, nrows); }
KERNEL k_router(const float* xl, const float* xc, const float* rstd, const float* nw, const float* modl, const float* router, float* logits, int nrows) {
    const long g = GID; if (g >= (long)nrows * NE) return;
    const int row = (int)(g / NE), e = (int)(g % NE); const float* xr = xrow_ptr((float*)xl, (float*)xc, row);
    const float* m = modl + (size_t)row_batch(row) * 6 * D; const float rs = rstd[row]; float s = 0.f;
    for (int k = 0; k < D; ++k) { const float v = xr[k] * rs * nw[k] * (1.0f + m[M_SC2 + k]) + m[M_SH2 + k]; s += v * router[k * NE + e]; }
    logits[g] = s;
}
KERNEL k_aff(float* aff, int nrows) {
    const long g = GID; if (g >= nrows) return;
    float* a = aff + (size_t)g * NE; float m = a[0];
    for (int e = 1; e < NE; ++e) m = a[e] > m ? a[e] : m;
    float s = 0.f; float ex[NE];
#pragma unroll
    for (int e = 0; e < NE; ++e) { ex[e] = expf(a[e] - m); s += ex[e]; }
#pragma unroll
    for (int e = 0; e < NE; ++e) a[e] = ex[e] / s;
}
KERNEL k_select(const float* aff, int* sel, float* gate, int* tokslot, int nrows) {
    const long g = GID; if (g >= (long)nrows * NE) return;
    const int row = (int)(g / NE), e = (int)(g % NE);
    const bool lat = row < RL; const int b = lat ? row / SEQ : (row - RL) / CTX; const int t = lat ? row % SEQ : (row - RL) % CTX;
    const int n = lat ? SEQ : CTX, cap = lat ? CAPL : CAPC, base = lat ? b * SEQ : RL + b * CTX;
    const float a = aff[(size_t)row * NE + e]; int rank = 0;
    for (int j = 0; j < n; ++j) { const float o = aff[(size_t)(base + j) * NE + e]; rank += (o > a || (o == a && j < t)) ? 1 : 0; }
    int slot = -1;
    if (rank < cap) { slot = e * SLOTS_E + (lat ? b * CAPL + rank : SLOTS_L + b * CAPC + rank); sel[slot] = row; gate[slot] = a; }
    tokslot[g] = slot;
}
KERNEL k_combine(float* xl, float* xc, const bf16_t* Y, const int* tokslot, const float* modl, int nrows) {
    const long g = GID; if (g >= (long)nrows * D) return;
    const int row = (int)(g / D), k = (int)(g % D); float s = 0.f;
    for (int e = 0; e < NE; ++e) { const int sl = tokslot[(size_t)row * NE + e]; if (sl >= 0) s += bf2f(Y[(size_t)sl * D + k]); }
    float* xr = xrow_ptr(xl, xc, row); xr[k] += modl[(size_t)row_batch(row) * 6 * D + M_G2 + k] * s;
}
KERNEL k_final(float* xl, const float* rstd, const float* nw) {
    const long g = GID; if (g >= (long)RL * D) return;
    const int row = (int)(g / D), k = (int)(g % D); xl[g] = xl[g] * rstd[row] * nw[k];
}

#ifndef HOST_TEST
typedef short bf16x8 __attribute__((ext_vector_type(8)));
typedef float f32x4 __attribute__((ext_vector_type(4)));
template <class Epi, bool DUAL>
__global__ void __launch_bounds__(256) k_gemm_mfma(const bf16_t* __restrict__ A, const int* __restrict__ rowidx, const bf16_t* __restrict__ Bt, int M, int N, int K, int group_rows, int valid_rows, long bstride, Epi epi) {
    const int tid = threadIdx.x, wid = tid >> 6, lane = tid & 63, fr = lane & 15, fq = lane >> 4, wr = wid >> 1, wc = wid & 1;
    const int row0 = blockIdx.y * 128 + wr * 64;
    if ((blockIdx.y * 128) % group_rows >= valid_rows) return;
    const bf16_t* B = Bt + (size_t)((blockIdx.y * 128) / group_rows) * bstride;
    int brow[4], ocol[4];
    if (!DUAL) { for (int i = 0; i < 4; ++i) { brow[i] = blockIdx.x * 128 + wc * 64 + i * 16; ocol[i] = brow[i]; } }
    else { const int hc0 = blockIdx.x * 64 + wc * 32;
        for (int i = 0; i < 2; ++i) { ocol[i] = hc0 + i * 16; brow[i] = (ocol[i] / 128) * 256 + ocol[i] % 128; brow[i + 2] = brow[i] + 128; ocol[i + 2] = ocol[i]; } }
    const bf16_t* ap[4]; const bf16_t* bp[4];
#pragma unroll
    for (int m = 0; m < 4; ++m) { const int r = row0 + m * 16 + fr; const int ar = rowidx ? rowidx[r] : r; ap[m] = A + (size_t)ar * K + fq * 8; }
#pragma unroll
    for (int i = 0; i < 4; ++i) bp[i] = B + (size_t)(brow[i] + fr) * K + fq * 8;
    f32x4 acc[4][4];
#pragma unroll
    for (int m = 0; m < 4; ++m)
#pragma unroll
        for (int i = 0; i < 4; ++i) acc[m][i] = (f32x4){0.f, 0.f, 0.f, 0.f};
    for (int k0 = 0; k0 < K; k0 += 32) {
        bf16x8 af[4], bfr[4];
#pragma unroll
        for (int m = 0; m < 4; ++m) af[m] = *(const bf16x8*)(ap[m] + k0);
#pragma unroll
        for (int i = 0; i < 4; ++i) bfr[i] = *(const bf16x8*)(bp[i] + k0);
#pragma unroll
        for (int m = 0; m < 4; ++m)
#pragma unroll
            for (int i = 0; i < 4; ++i) acc[m][i] = __builtin_amdgcn_mfma_f32_16x16x32_bf16(bfr[i], af[m], acc[m][i], 0, 0, 0);
    }
#pragma unroll
    for (int m = 0; m < 4; ++m) { const int r = row0 + m * 16 + fr;
#pragma unroll
        for (int i = 0; i < (DUAL ? 2 : 4); ++i) {
            float v[4] = {acc[m][i][0], acc[m][i][1], acc[m][i][2], acc[m][i][3]};
            float u[4] = {acc[m][DUAL ? i + 2 : i][0], acc[m][DUAL ? i + 2 : i][1], acc[m][DUAL ? i + 2 : i][2], acc[m][DUAL ? i + 2 : i][3]};
            epi(r, ocol[i] + 4 * fq, v, u); } }
}
template <class Epi, bool DUAL>
static void launch_gemm(hipStream_t stream, const bf16_t* A, const int* rowidx, const bf16_t* Bt, int M, int N, int K, int group_rows, int valid_rows, long bstride, Epi epi) {
    dim3 grid(DUAL ? N / 64 : N / 128, M / 128);
    hipLaunchKernelGGL((k_gemm_mfma<Epi, DUAL>), grid, dim3(256), 0, stream, A, rowidx, Bt, M, N, K, group_rows, valid_rows, bstride, epi);
}
#define GEMM(Epi, DUAL, ...) launch_gemm<Epi, DUAL>(stream, __VA_ARGS__)
#else
#define GEMM(Epi, DUAL, A, rowidx, Bt, M, N, K, gr, vr, bs, epi) LAUNCH((k_gemm_naive<Epi, DUAL>), (long)(M) * ((N) / 4), A, rowidx, Bt, M, N, K, gr, vr, bs, epi)
#endif

#ifdef HOST_TEST
typedef int hipStream_t;
#endif
static void forward(const Ptrs& p, hipStream_t stream) {
    (void)stream;
    unsigned char* ws = p.ws;
    float* tab = (float*)(ws + WS_TAB); float* silu = (float*)(ws + WS_SILU); float* mod = (float*)(ws + WS_MOD); float* rstd = (float*)(ws + WS_RSTD);
    float* aff = (float*)(ws + WS_AFF); int* sel = (int*)(ws + WS_SEL); float* gate = (float*)(ws + WS_GATE); int* tokslot = (int*)(ws + WS_TOKSLOT);
    float* xc = (float*)(ws + WS_XC); float* xl = p.out;
    bf16_t* win = (bf16_t*)(ws + WS_WIN); bf16_t* wout = (bf16_t*)(ws + WS_WOUT);
    bf16_t* P = (bf16_t*)(ws + WS_R1); bf16_t* H = (bf16_t*)(ws + WS_R1);
    bf16_t* Y = (bf16_t*)(ws + WS_R2); bf16_t* MIX = (bf16_t*)(ws + WS_R2); bf16_t* HX2 = (bf16_t*)(ws + WS_R2 + (size_t)RALL * D * 2); float* TMP = (float*)HX2;
    bf16_t* HX = (bf16_t*)(ws + WS_R3);
    LAUNCH(k_tables, (long)(NROWS + 64) * 24, tab);
    LAUNCH(k_silu, (long)(NB + 1) * D, p.c, p.c_ctx, silu);
    LAUNCH(k_mod, (long)DEPTH * 6 * D, silu, p.w_ada, p.b_ada, mod);
    LAUNCH(k_cvt_win, (long)DEPTH * PROJ * D, p.w_in, win);
    LAUNCH(k_cvt_t, (long)DEPTH * D * D, p.w_out, wout, DEPTH, D, D);
#ifdef HOST_TEST
    memcpy(xl, p.x, (size_t)RL * D * 4); memcpy(xc, p.ctx, (size_t)RC * D * 4);
#else
    (void)hipMemcpyAsync(xl, p.x, (size_t)RL * D * 4, hipMemcpyDeviceToDevice, stream);
    (void)hipMemcpyAsync(xc, p.ctx, (size_t)RC * D * 4, hipMemcpyDeviceToDevice, stream);
#endif
    for (int l = 0; l < DEPTH; ++l) {
        const bool need_ctx = l < DEPTH - 1; const int nq = need_ctx ? RALL : RL;
        const float* modl = mod + (size_t)l * (NB + 1) * 6 * D; const float lam_init = 0.8f - 0.6f * expf(-0.3f * (float)l);
        bf16_t* wgu = (bf16_t*)(ws + WS_WGU) + (size_t)(l & 1) * NE * 2 * FF * D; bf16_t* wd = (bf16_t*)(ws + WS_WD) + (size_t)(l & 1) * NE * D * FF;
        LAUNCH(k_cvt_gu, (long)NE * 2 * FF * D, p.w_gate + (size_t)l * NE * D * FF, p.w_up + (size_t)l * NE * D * FF, wgu);
        LAUNCH(k_cvt_t, (long)NE * FF * D, p.w_down + (size_t)l * NE * FF * D, wd, NE, FF, D);
        LAUNCH(k_rowstat, RALL, xl, xc, rstd, RALL);
        LAUNCH(k_rowapply, (long)RALL * D, xl, xc, rstd, p.norm1 + l * D, modl, M_SH1, M_SC1, HX, RALL);
        GEMM(EpiInProj, false, HX, (const int*)nullptr, win + (size_t)l * PROJ * D, RALL, PROJ, D, RALL, RALL, 0L, (EpiInProj{P, tab}));
        LAUNCH(k_attnA, (long)nq * NHA, P, p.attn_sink + l * NHA, MIX, nq);
        LAUNCH(k_attnD, (long)nq * NHC * 2, P, TMP, nq);
        LAUNCH(k_diffpost, (long)nq * NHC, TMP, p.diff_lambda + l * 4 * DD, p.diff_subln + l * 2 * DD, lam_init, MIX, nq);
        LAUNCH(k_conv, (long)nq * CONV_CH, P, p.conv_w + l * 3 * CONV_CH, MIX, nq);
        GEMM(EpiOutProj, false, MIX, (const int*)nullptr, wout + (size_t)l * D * D, nq, D, D, nq, nq, 0L, (EpiOutProj{xl, xc, modl}));
        LAUNCH(k_rowstat, nq, xl, xc, rstd, nq);
        LAUNCH(k_rowapply, (long)nq * D, xl, xc, rstd, p.norm2 + l * D, modl, M_SH2, M_SC2, HX2, nq);
        LAUNCH(k_router, (long)nq * NE, xl, xc, rstd, p.norm2 + l * D, modl, p.router + (size_t)l * D * NE, aff, nq);
        LAUNCH(k_aff, nq, aff, nq);
        LAUNCH(k_select, (long)nq * NE, aff, sel, gate, tokslot, nq);
        const int vr = need_ctx ? SLOTS_E : SLOTS_L;
        GEMM(EpiGateUp, true, HX2, sel, wgu, NSLOT, FF, D, SLOTS_E, vr, (long)2 * FF * D, (EpiGateUp{H}));
        GEMM(EpiDown, false, H, (const int*)nullptr, wd, NSLOT, D, FF, SLOTS_E, vr, (long)D * FF, (EpiDown{Y, gate}));
        LAUNCH(k_combine, (long)nq * D, xl, xc, Y, tokslot, modl, nq);
    }
    LAUNCH(k_rowstat, RL, xl, xc, rstd, RL);
    LAUNCH(k_final, (long)RL * D, xl, rstd, p.norm_final);
}

#ifndef HOST_TEST
#define LAS __attribute__((address_space(3)))
#define GAS __attribute__((address_space(1)))
typedef unsigned u32x4 __attribute__((ext_vector_type(4)));
typedef unsigned u32x2 __attribute__((ext_vector_type(2)));
typedef float f32x2_t __attribute__((ext_vector_type(2)));
constexpr int NT = 512, NWV = 8;
constexpr int LDS_BYTES = 163840;
constexpr int LDS_MISC = LDS_BYTES - 256;
constexpr int CW_BAR = 4096;

__device__ __forceinline__ unsigned cvt_pk_bf16(float lo, float hi) { unsigned r; asm volatile("v_cvt_pk_bf16_f32 %0, %1, %2" : "=v"(r) : "v"(lo), "v"(hi)); return r; }
__device__ __forceinline__ float dpp_f(float v, const int ctrl_tag) {
    int r;
    switch (ctrl_tag) {
        case 0: r = __builtin_amdgcn_update_dpp(0, __builtin_bit_cast(int, v), 0xB1, 0xF, 0xF, true); break;
        case 1: r = __builtin_amdgcn_update_dpp(0, __builtin_bit_cast(int, v), 0x4E, 0xF, 0xF, true); break;
        case 2: r = __builtin_amdgcn_update_dpp(0, __builtin_bit_cast(int, v), 0x141, 0xF, 0xF, true); break;
        default: r = __builtin_amdgcn_update_dpp(0, __builtin_bit_cast(int, v), 0x140, 0xF, 0xF, true); break;
    }
    return __builtin_bit_cast(float, r);
}
__device__ __forceinline__ float wave_sum(float v) {
    v += dpp_f(v, 0); v += dpp_f(v, 1); v += dpp_f(v, 2); v += dpp_f(v, 3);
    const int b = __builtin_bit_cast(int, v);
    return (__builtin_bit_cast(float, __builtin_amdgcn_readlane(b, 0)) + __builtin_bit_cast(float, __builtin_amdgcn_readlane(b, 16)))
         + (__builtin_bit_cast(float, __builtin_amdgcn_readlane(b, 32)) + __builtin_bit_cast(float, __builtin_amdgcn_readlane(b, 48)));
}
#define LDS_WAIT() asm volatile("s_waitcnt lgkmcnt(0)" ::: "memory")
__device__ __forceinline__ float wave_max(float v) {
    v = fmaxf(v, dpp_f(v, 0)); v = fmaxf(v, dpp_f(v, 1)); v = fmaxf(v, dpp_f(v, 2)); v = fmaxf(v, dpp_f(v, 3));
    const int b = __builtin_bit_cast(int, v);
    return fmaxf(fmaxf(__builtin_bit_cast(float, __builtin_amdgcn_readlane(b, 0)), __builtin_bit_cast(float, __builtin_amdgcn_readlane(b, 16))),
                 fmaxf(__builtin_bit_cast(float, __builtin_amdgcn_readlane(b, 32)), __builtin_bit_cast(float, __builtin_amdgcn_readlane(b, 48))));
}

#define LDS_RD16_B128(r, addr, STRIDE) asm volatile( \
    "ds_read_b128 %0, %16\n\tds_read_b128 %1, %16 offset:%c17\n\tds_read_b128 %2, %16 offset:2*%c17\n\tds_read_b128 %3, %16 offset:3*%c17\n\t" \
    "ds_read_b128 %4, %16 offset:4*%c17\n\tds_read_b128 %5, %16 offset:5*%c17\n\tds_read_b128 %6, %16 offset:6*%c17\n\tds_read_b128 %7, %16 offset:7*%c17\n\t" \
    "ds_read_b128 %8, %16 offset:8*%c17\n\tds_read_b128 %9, %16 offset:9*%c17\n\tds_read_b128 %10, %16 offset:10*%c17\n\tds_read_b128 %11, %16 offset:11*%c17\n\t" \
    "ds_read_b128 %12, %16 offset:12*%c17\n\tds_read_b128 %13, %16 offset:13*%c17\n\tds_read_b128 %14, %16 offset:14*%c17\n\tds_read_b128 %15, %16 offset:15*%c17\n\ts_waitcnt lgkmcnt(0)" \
    : "=&v"(r[0]), "=&v"(r[1]), "=&v"(r[2]), "=&v"(r[3]), "=&v"(r[4]), "=&v"(r[5]), "=&v"(r[6]), "=&v"(r[7]), "=&v"(r[8]), "=&v"(r[9]), "=&v"(r[10]), "=&v"(r[11]), "=&v"(r[12]), "=&v"(r[13]), "=&v"(r[14]), "=&v"(r[15]) \
    : "v"(addr), "i"(STRIDE) : "memory")
#define LDS_ISSUE8_B128(r, addr, STRIDE) asm volatile( \
    "ds_read_b128 %0, %8\n\tds_read_b128 %1, %8 offset:%c9\n\tds_read_b128 %2, %8 offset:2*%c9\n\tds_read_b128 %3, %8 offset:3*%c9\n\t" \
    "ds_read_b128 %4, %8 offset:4*%c9\n\tds_read_b128 %5, %8 offset:5*%c9\n\tds_read_b128 %6, %8 offset:6*%c9\n\tds_read_b128 %7, %8 offset:7*%c9" \
    : "=&v"(r[0]), "=&v"(r[1]), "=&v"(r[2]), "=&v"(r[3]), "=&v"(r[4]), "=&v"(r[5]), "=&v"(r[6]), "=&v"(r[7]) \
    : "v"(addr), "i"(STRIDE) : "memory")
#define LDS_WAIT8(r, N) asm volatile("s_waitcnt lgkmcnt(" #N ")" : "+v"(r[0]), "+v"(r[1]), "+v"(r[2]), "+v"(r[3]), "+v"(r[4]), "+v"(r[5]), "+v"(r[6]), "+v"(r[7]) :: "memory")
#define LDS_RD11_B128(r, addr, STRIDE) asm volatile( \
    "ds_read_b128 %0, %11\n\tds_read_b128 %1, %11 offset:%c12\n\tds_read_b128 %2, %11 offset:2*%c12\n\tds_read_b128 %3, %11 offset:3*%c12\n\t" \
    "ds_read_b128 %4, %11 offset:4*%c12\n\tds_read_b128 %5, %11 offset:5*%c12\n\tds_read_b128 %6, %11 offset:6*%c12\n\tds_read_b128 %7, %11 offset:7*%c12\n\t" \
    "ds_read_b128 %8, %11 offset:8*%c12\n\tds_read_b128 %9, %11 offset:9*%c12\n\tds_read_b128 %10, %11 offset:10*%c12\n\ts_waitcnt lgkmcnt(0)" \
    : "=&v"(r[0]), "=&v"(r[1]), "=&v"(r[2]), "=&v"(r[3]), "=&v"(r[4]), "=&v"(r[5]), "=&v"(r[6]), "=&v"(r[7]), "=&v"(r[8]), "=&v"(r[9]), "=&v"(r[10]) \
    : "v"(addr), "i"(STRIDE) : "memory")
__device__ __forceinline__ int lane_id_asm() { int l; asm volatile("v_mbcnt_lo_u32_b32 %0, -1, 0\n\tv_mbcnt_hi_u32_b32 %0, -1, %0" : "=v"(l)); return l; }
__device__ __forceinline__ int tid_w(int wv) { return wv * 64 + lane_id_asm(); }
#define tid_l() tid_w(C.wv)

#define XB_TMO      128
#define XB_XCNT(j)  (256  + 64 * (j))
#define XB_XSUB(j)  (1280 + 64 * (j))
#define XB_XGEN(j)  (2304 + 64 * (j))
#define XB_TOP      3328
#define XB_TOPGEN   3392
#define XCD_BAR_WORDS 3456
#define XB_SPIN_CAP (1u << 24)
__device__ __forceinline__ unsigned xb_ld(unsigned* p)              { return __hip_atomic_load(p, __ATOMIC_RELAXED, __HIP_MEMORY_SCOPE_AGENT); }
__device__ __forceinline__ unsigned xb_add(unsigned* p, unsigned v) { return __hip_atomic_fetch_add(p, v, __ATOMIC_RELAXED, __HIP_MEMORY_SCOPE_AGENT); }
__device__ __forceinline__ unsigned xb_xcc_id() { return (unsigned)__builtin_amdgcn_s_getreg((3 << 11) | 20) & 0xFu; }
#define XB_SPIN(cond, bar) do { unsigned _sp = 0; while (cond) { __builtin_amdgcn_s_sleep(1); \
    if ((++_sp & 255u) == 0u) { if (xb_ld(&(bar)[XB_TMO])) break; if (_sp > XB_SPIN_CAP) { atomicAdd(&(bar)[XB_TMO], 1u); break; } } } } while (0)
struct XcdBarrier { unsigned* bar; unsigned x; volatile LAS unsigned* st; int wv; };
__device__ __forceinline__ XcdBarrier xcd_barrier_post(unsigned* bar, volatile LAS unsigned* st, int wv) {
    XcdBarrier b; b.bar = bar; b.x = xb_xcc_id(); b.st = st; b.wv = wv;
    if (tid_w(wv) == 0) (void)xb_add(&bar[XB_XCNT(b.x)], 1u);
    return b;
}
__device__ __forceinline__ void xcd_barrier_complete(unsigned* bar, unsigned x, unsigned& nloc, unsigned& nx) {
    const unsigned G = gridDim.x * gridDim.y * gridDim.z;
    unsigned sum, cnt, mine, sp = 0u;
    for (;;) {
        sum = 0u; cnt = 0u; mine = 0u;
#pragma unroll
        for (unsigned j = 0; j < 16; ++j) { const unsigned c = xb_ld(&bar[XB_XCNT(j)]); sum += c; cnt += (c > 0u) ? 1u : 0u; mine = (j == x) ? c : mine; }
        if (sum == G) break;
        __builtin_amdgcn_s_sleep(1);
        if ((++sp & 255u) == 0u) { if (xb_ld(&bar[XB_TMO])) break; if (sp > XB_SPIN_CAP) { atomicAdd(&bar[XB_TMO], 1u); break; } }
    }
    nloc = mine > 0u ? mine : 1u; nx = cnt > 0u ? cnt : 1u;
}
__device__ __forceinline__ void xcd_barrier(const XcdBarrier& b) {
    asm volatile("s_waitcnt vmcnt(0)" ::: "memory");
    __syncthreads();
    if (tid_w(b.wv) == 0) {
        unsigned* bar = b.bar;
        __builtin_amdgcn_s_waitcnt(0);
        unsigned nloc = b.st[0], nx = b.st[1];
        if (nloc == 0u) { xcd_barrier_complete(bar, b.x, nloc, nx); b.st[0] = nloc; b.st[1] = nx; }
        const unsigned old = xb_add(&bar[XB_XSUB(b.x)], 1u);
        const unsigned gen = old / nloc;
        if (old + 1u == (gen + 1u) * nloc) {
            __builtin_amdgcn_fence(__ATOMIC_RELEASE, "agent");
            asm volatile("s_waitcnt vmcnt(0)" ::: "memory");
            const unsigned og = xb_add(&bar[XB_TOP], 1u);
            const unsigned tg = og / nx;
            if (og + 1u == (tg + 1u) * nx) xb_add(&bar[XB_TOPGEN], 1u);
            else XB_SPIN(xb_ld(&bar[XB_TOPGEN]) == tg, bar);
            __builtin_amdgcn_fence(__ATOMIC_ACQUIRE, "agent");
            xb_add(&bar[XB_XGEN(b.x)], 1u);
            asm volatile("s_waitcnt vmcnt(0)" ::: "memory");
        } else {
            XB_SPIN(xb_ld(&bar[XB_XGEN(b.x)]) == gen, bar);
            __builtin_amdgcn_fence(__ATOMIC_ACQUIRE, "agent");
            asm volatile("s_waitcnt vmcnt(0)" ::: "memory");
        }
    }
    __syncthreads();
}

namespace pg {
constexpr int BM = 256, BK = 64, HALF = 128, HTB = HALF * BK * 2  , STAGE_BYTES = 8 * HTB, NXCD = 8, WGM = 8;
constexpr int TPE_FULL = SLOTS_E / BM;
__host__ __device__ __forceinline__ int lds_byte(int r, int c) { const int st = (r >> 4) * 2 + (c >> 5), rr = r & 15, cc = c & 31, ob = rr * 64 + cc * 2; return st * 1024 + (ob ^ (((ob >> 9) & 1) << 5)); }
__host__ __device__ __forceinline__ void stage_rc(int b, int& R, int& C) { const int st = b / 1024, sb = b % 1024, swz = sb ^ (((sb >> 9) & 1) << 5); R = (st >> 1) * 16 + swz / 64; C = (st & 1) * 32 + (swz % 64) / 2; }
__host__ __device__ __forceinline__ int perm32(int rho) { const int n = rho >> 4, i = rho & 15; return 8 * (i >> 2) + 4 * n + (i & 3); }
struct Unit { int m0, pn, e; };
struct GemmD { const char* A; const int* rowidx; const char* Bt; size_t bstride; int K; };
struct Order {
    int nM, nN, nwg, G, c, tpe;
    __device__ void init(int nM_, int nN_, int G_, int c_, int tpe_) { nM = nM_; nN = nN_; nwg = nM * nN; G = G_; c = c_; tpe = tpe_; }
    __device__ bool next(int i, Unit& u) const {
        const long L = (long)i * G + c; if (L >= nwg) return false;
        int wgid = (int)L; { const int q = nwg / NXCD, r = nwg % NXCD, xcd = wgid % NXCD, off = wgid / NXCD; wgid = (xcd < r ? xcd * (q + 1) : r * (q + 1) + (xcd - r) * q) + off; }
        const int nig = WGM * nN, gid = wgid / nig, fm = gid * WGM, gsz = (nM - fm) < WGM ? (nM - fm) : WGM;
        const int pm = fm + ((wgid % nig) % gsz); u.pn = (wgid % nig) / gsz;
        if (tpe > 0) { u.e = pm / tpe; u.m0 = (u.e * TPE_FULL + pm % tpe) * BM; } else { u.e = 0; u.m0 = pm * BM; }
        return true;
    }
};
template <class T> struct has_pre { template <class U> static constexpr bool test(decltype(U::HAS_PRE)*) { return U::HAS_PRE; } template <class U> static constexpr bool test(...) { return false; } static constexpr bool value = test<T>(nullptr); };
typedef int v4i32_t __attribute__((ext_vector_type(4)));
typedef int v8i32_t __attribute__((ext_vector_type(8)));
__device__ __forceinline__ v8i32_t cat8(const bf16x8 a, const bf16x8 b) { return __builtin_shufflevector(__builtin_bit_cast(v4i32_t, a), __builtin_bit_cast(v4i32_t, b), 0, 1, 2, 3, 4, 5, 6, 7); }
constexpr int SCALE_ONE = 0x7F7F7F7F, SCALE_W = 0x79797979;
template <bool I> struct acc_sel { typedef f32x4 type; };
template <> struct acc_sel<true> { typedef v4i32_t type; };
template <class Epi, bool GATHER, int QM = 0>
__device__ __forceinline__ void gemm_phase(LAS unsigned char* lds, const GemmD g, const Order& S, const Epi& E, int wv) {
    const int tid = tid_w(wv), wid = __builtin_amdgcn_readfirstlane(tid >> 6), lane = tid & 63, wr = wid >> 2, wc = wid & 3, fr = lane & 15, fq = lane >> 4;
    constexpr bool FP8 = (QM == 1), I8 = (QM == 2);
    typedef typename acc_sel<QM == 2>::type acc_t;
    const int K = g.K, nt = K / BK;
    int Rr[2], Cc[2]; unsigned voffB[2];
#pragma unroll
    for (int i = 0; i < 2; ++i) { int R, C; stage_rc(tid * 16 + i * 8192, R, C); Rr[i] = R; Cc[i] = C; const int Rb = Epi::PERM ? ((R & ~31) + perm32(R & 31)) : R; voffB[i] = (unsigned)(Rb * K + C) * 2u; }
    const unsigned kstep = (unsigned)(BK * 2);
    const size_t hstep = (size_t)HALF * K * 2;
    const unsigned ldsw = (unsigned)wid * 1024u;
    const int aoff = lds_byte(wr * 64 + fr, fq * 8), boff = lds_byte(wc * 32 + fr, fq * 8);
#define PG_SA(b, h) (((b) * 2 + (h)) * HTB)
#define PG_SB(b, h) ((4 + (b) * 2 + (h)) * HTB)
#define PG_STAGE_B(bufoff, gbase) do { _Pragma("unroll") for (int _i = 0; _i < 2; ++_i) \
        __builtin_amdgcn_global_load_lds((const unsigned*)((const char*)(gbase) + voffB[_i]), (LAS unsigned*)(lds + (bufoff) + ldsw + _i * 8192), 16, 0, 0); } while (0)
#define PG_STAGE_A(bufoff, OFFS, h, kb) do { _Pragma("unroll") for (int _i = 0; _i < 2; ++_i) \
        __builtin_amdgcn_global_load_lds((const unsigned*)(g.A + (size_t)(OFFS)[h][_i] + (kb)), (LAS unsigned*)(lds + (bufoff) + ldsw + _i * 8192), 16, 0, 0); } while (0)
#define PG_ROWOFF(DST, U) do { _Pragma("unroll") for (int _h = 0; _h < 2; ++_h) _Pragma("unroll") for (int _i = 0; _i < 2; ++_i) { int _r = (U).m0 + _h * HALF + Rr[_i]; if (GATHER) _r = g.rowidx[_r]; \
        (DST)[_h][_i] = (unsigned)(((size_t)_r * K + Cc[_i]) * 2); } } while (0)
#define PG_LDA(dst, b, h) do { _Pragma("unroll") for (int m = 0; m < 4; ++m) { if constexpr (FP8) { const v4i32_t _x0 = *(const LAS v4i32_t*)(lds + PG_SA(b, h) + aoff + m * 2048), _x1 = *(const LAS v4i32_t*)(lds + PG_SA(b, h) + aoff + m * 2048 + 1024); \
        dst##8[m] = __builtin_shufflevector(_x0, _x1, 0, 1, 2, 3, 4, 5, 6, 7); } else { _Pragma("unroll") for (int k = 0; k < 2; ++k) dst[m][k] = *(const LAS bf16x8*)(lds + PG_SA(b, h) + aoff + m * 2048 + k * 1024); } } } while (0)
#define PG_LDB(dst, b, h) do { _Pragma("unroll") for (int n = 0; n < 2; ++n) { if constexpr (FP8) { const v4i32_t _x0 = *(const LAS v4i32_t*)(lds + PG_SB(b, h) + boff + n * 2048), _x1 = *(const LAS v4i32_t*)(lds + PG_SB(b, h) + boff + n * 2048 + 1024); \
        dst##8[n] = __builtin_shufflevector(_x0, _x1, 0, 1, 2, 3, 4, 5, 6, 7); } else { _Pragma("unroll") for (int k = 0; k < 2; ++k) dst[n][k] = *(const LAS bf16x8*)(lds + PG_SB(b, h) + boff + n * 2048 + k * 1024); } } } while (0)
#define PG_MMA(ai, bj, At, Bt) do { __builtin_amdgcn_s_setprio(1); _Pragma("unroll") for (int m = 0; m < 4; ++m) _Pragma("unroll") for (int n = 0; n < 2; ++n) { \
        if constexpr (FP8) asm volatile("s_nop 1\n\tv_mfma_scale_f32_16x16x128_f8f6f4 %0, %1, %2, %0, %3, %4 op_sel_hi:[0,0,0]" : "+v"(acc[ai][bj][m][n]) : "v"(Bt##8[n]), "v"(At##8[m]), "v"(sc_w), "v"(sc_a)); \
        else if constexpr (I8) { _Pragma("unroll") for (int k = 0; k < 2; ++k) acc[ai][bj][m][n] = __builtin_amdgcn_mfma_i32_16x16x64_i8(__builtin_bit_cast(v4i32_t, Bt[n][k]), __builtin_bit_cast(v4i32_t, At[m][k]), acc[ai][bj][m][n], 0, 0, 0); } \
        else if constexpr (!I8 && !FP8) { _Pragma("unroll") for (int k = 0; k < 2; ++k) acc[ai][bj][m][n] = __builtin_amdgcn_mfma_f32_16x16x32_bf16(Bt[n][k], At[m][k], acc[ai][bj][m][n], 0, 0, 0); } } \
        __builtin_amdgcn_s_setprio(0); } while (0)
#define PG_WAIT_V(n) asm volatile("s_waitcnt vmcnt(" #n ")" ::: "memory")
#define PG_WAIT_L(n) asm volatile("s_waitcnt lgkmcnt(" #n ")" ::: "memory")
#define PG_BAR __builtin_amdgcn_s_barrier()
#define PG_SCHED __builtin_amdgcn_sched_barrier(0)
    Unit cur, nxt; int ui = 0;
    if (!S.next(0, cur)) return;
    acc_t acc[2][2][4][2];
#pragma unroll
    for (int a = 0; a < 2; ++a)
#pragma unroll
        for (int b = 0; b < 2; ++b)
#pragma unroll
            for (int m = 0; m < 4; ++m)
#pragma unroll
                for (int n = 0; n < 2; ++n) { acc[a][b][m][n] = acc_t{}; if constexpr (FP8) asm volatile("" : "+v"(acc[a][b][m][n])); }
    bf16x8 At[4][2], B0[2][2], B1[2][2]; v8i32_t At8[4], B08[2], B18[2];
    int sc_w = SCALE_W, sc_a = SCALE_ONE; if constexpr (FP8) { asm volatile("" : "+v"(sc_w), "+v"(sc_a)); }
    unsigned offA[2][2], offN[2][2];
    float epre[8] = {0.f, 0.f, 0.f, 0.f, 0.f, 0.f, 0.f, 0.f};
    if constexpr (has_pre<Epi>::value) E.pre(epre, cur, wr, fr);
    PG_ROWOFF(offA, cur);
    if (GATHER) PG_WAIT_V(0);
    const char* cB = g.Bt + (size_t)cur.e * g.bstride + (size_t)cur.pn * BM * K * 2;
    PG_STAGE_B(PG_SB(0, 0), cB); PG_STAGE_B(PG_SB(0, 1), cB + hstep); PG_STAGE_A(PG_SA(0, 0), offA, 0, 0u); PG_STAGE_A(PG_SA(0, 1), offA, 1, 0u);
    if (wr == 1) PG_BAR;
    PG_WAIT_V(2); PG_BAR;
    PG_STAGE_B(PG_SB(1, 0), cB + kstep); PG_STAGE_A(PG_SA(1, 0), offA, 0, kstep); PG_STAGE_B(PG_SB(1, 1), cB + hstep + kstep);
    PG_WAIT_V(6); PG_BAR;
    for (;;) {
        const bool has_next = S.next(ui + 1, nxt);
        const char* nB = has_next ? g.Bt + (size_t)nxt.e * g.bstride + (size_t)nxt.pn * BM * K * 2 : cB;
        if (has_next) { PG_ROWOFF(offN, nxt); if (GATHER) PG_WAIT_V(0); }
        else {
#pragma unroll
            for (int h = 0; h < 2; ++h)
#pragma unroll
                for (int i = 0; i < 2; ++i) offN[h][i] = offA[h][i]; }
        for (int t = 0; t < nt; t += 2) {
            const bool last = (t == nt - 2);
            unsigned o2[2][2];
#pragma unroll
            for (int h = 0; h < 2; ++h)
#pragma unroll
                for (int i = 0; i < 2; ++i) o2[h][i] = last ? offN[h][i] : offA[h][i];
            const unsigned ka1 = (unsigned)(t + 1) * kstep, ka2 = last ? 0u : (unsigned)(t + 2) * kstep, ka3 = ka2 + kstep;
            const char* b2 = last ? nB : cB + (size_t)(t + 2) * kstep; const char* b3 = b2 + kstep;
            PG_LDB(B0, 0, 0); PG_LDB(B1, 0, 1); PG_SCHED; PG_LDA(At, 0, 0); PG_STAGE_A(PG_SA(1, 1), offA, 1, ka1);
            PG_WAIT_V(8); PG_WAIT_L(0); PG_BAR; PG_MMA(0, 0, At, B0); PG_MMA(0, 1, At, B1); PG_BAR; PG_SCHED;
            PG_LDA(At, 0, 1); PG_STAGE_B(PG_SB(0, 0), b2); PG_STAGE_B(PG_SB(0, 1), b2 + hstep); PG_STAGE_A(PG_SA(0, 0), o2, 0, ka2);
            PG_WAIT_V(8); PG_WAIT_L(0); PG_BAR; PG_MMA(1, 0, At, B0); PG_MMA(1, 1, At, B1); PG_BAR; PG_SCHED;
            PG_LDB(B0, 1, 0); PG_LDB(B1, 1, 1); PG_SCHED; PG_LDA(At, 1, 0); PG_STAGE_A(PG_SA(0, 1), o2, 1, ka2);
            PG_WAIT_V(8); PG_WAIT_L(0); PG_BAR; PG_MMA(0, 0, At, B0); PG_MMA(0, 1, At, B1); PG_BAR; PG_SCHED;
            PG_LDA(At, 1, 1); PG_STAGE_B(PG_SB(1, 0), b3); PG_STAGE_B(PG_SB(1, 1), b3 + hstep); PG_STAGE_A(PG_SA(1, 0), o2, 0, ka3);
            PG_WAIT_V(8); PG_WAIT_L(0); PG_BAR; PG_MMA(1, 0, At, B0); PG_MMA(1, 1, At, B1); PG_BAR; PG_SCHED;
        }
        if (wr == 0) PG_BAR;
        if constexpr (FP8) asm volatile("s_nop 15\n\ts_nop 7" ::: "memory");
        if constexpr (has_pre<Epi>::value) { E(acc, cur, wr, wc, fr, fq, epre); if (has_next) E.pre(epre, nxt, wr, fr); }
        else E(acc, cur, wr, wc, fr, fq);
        if (!has_next) break;
#pragma unroll
        for (int a = 0; a < 2; ++a)
#pragma unroll
            for (int b = 0; b < 2; ++b)
#pragma unroll
                for (int m = 0; m < 4; ++m)
#pragma unroll
                    for (int n = 0; n < 2; ++n) { acc[a][b][m][n] = acc_t{}; if constexpr (FP8) asm volatile("" : "+v"(acc[a][b][m][n])); }
        cur = nxt; cB = nB; ++ui;
#pragma unroll
        for (int h = 0; h < 2; ++h)
#pragma unroll
            for (int i = 0; i < 2; ++i) offA[h][i] = offN[h][i];
        if (wr == 1) PG_BAR;
    }
    PG_WAIT_V(0);
    PG_BAR;
#undef PG_SA
#undef PG_SB
#undef PG_STAGE_A
#undef PG_STAGE_B
#undef PG_ROWOFF
#undef PG_LDA
#undef PG_LDB
#undef PG_MMA
#undef PG_WAIT_V
#undef PG_WAIT_L
#undef PG_BAR
#undef PG_SCHED
}
struct EpiP {
    static constexpr bool PERM = true;
    bf16_t* P; const float* tab; const float* hxs; const float* wss;
    __device__ __forceinline__ void operator()(const v4i32_t (&acc)[2][2][4][2], const Unit& u, int wr, int wc, int fr, int fq) const {
        const bool lat = u.m0 < RL;
        float rs[8];
#pragma unroll
        for (int ai = 0; ai < 2; ++ai)
#pragma unroll
            for (int m = 0; m < 4; ++m) rs[ai * 4 + m] = hxs[u.m0 + ai * HALF + wr * 64 + m * 16 + fr];
        float cs; { const int ln = fr + 16 * fq; cs = 4.0f * sqrtf(wave_sum((wss[ln] + wss[ln + 64]) + (wss[ln + 128] + wss[ln + 192])) * (1.0f / ((float)D * (float)PROJ))) * (1.0f / 127.0f); }
#pragma unroll
        for (int bj = 0; bj < 2; ++bj) {
            const int ct = u.pn * BM + bj * HALF;
            const int c0 = ct + wc * 32 + 8 * fq;
            const int kind = ct < C_VA ? 1 : ((ct >= C_QD && ct < C_VD) ? 2 : 0);
            const float sc = ct < C_KA ? QSCALE_A : ((ct >= C_QD && ct < C_KD) ? QSCALE_D : 1.0f);
#pragma unroll
            for (int ai = 0; ai < 2; ++ai)
#pragma unroll
                for (int m = 0; m < 4; ++m) {
                    const int row = u.m0 + ai * HALF + wr * 64 + m * 16 + fr;
                    f32x4 v0, v1; { const v4i32_t i0 = acc[ai][bj][m][0], i1 = acc[ai][bj][m][1]; const float r_ = rs[ai * 4 + m];
#pragma unroll
                      for (int k = 0; k < 4; ++k) { v0[k] = (float)i0[k] * (r_ * cs); v1[k] = (float)i1[k] * (r_ * cs); } }
                    if (kind != 0 && lat) {
                        const int pos = row % SEQ, gr = pos / GRID_W, gc = pos % GRID_W; const float* t;
                        if (kind == 1) { const int p = c0 & 63, grp = p >> 5, i0 = (p & 31) >> 1; t = tab + (grp ? T_ACOL + gc * 32 : T_AROW + gr * 32) + i0 * 2; }
                        else { const int p = c0 & 31, grp = p >> 4, i0 = (p & 15) >> 1; t = tab + (grp ? T_DCOL + gc * 16 : T_DROW + gr * 16) + i0 * 2; }
                        const f32x4 t0 = *(const f32x4*)t, t1 = *(const f32x4*)(t + 4);
                        v0 = (f32x4){v0[0] * t0[0] - v0[1] * t0[1], v0[1] * t0[0] + v0[0] * t0[1], v0[2] * t0[2] - v0[3] * t0[3], v0[3] * t0[2] + v0[2] * t0[3]};
                        v1 = (f32x4){v1[0] * t1[0] - v1[1] * t1[1], v1[1] * t1[0] + v1[0] * t1[1], v1[2] * t1[2] - v1[3] * t1[3], v1[3] * t1[2] + v1[2] * t1[3]};
                    }
                    v0 = v0 * sc; v1 = v1 * sc;
                    u32x4 w; w.x = cvt_pk_bf16(v0[0], v0[1]); w.y = cvt_pk_bf16(v0[2], v0[3]); w.z = cvt_pk_bf16(v1[0], v1[1]); w.w = cvt_pk_bf16(v1[2], v1[3]);
                    *(u32x4*)(P + (size_t)row * PROJ + c0) = w;
                }
        }
    }
};
struct EpiX {
    static constexpr bool PERM = true;
    bf16_t* XB; const float* modl; float gscale;
    __device__ __forceinline__ void operator()(const f32x4 (&acc)[2][2][4][2], const Unit& u, int wr, int wc, int fr, int fq) const {
        const int b = u.m0 < RL ? u.m0 / SEQ : NB; const float* g1 = modl + (size_t)b * 6 * D + M_G1 + u.pn * BM + wc * 32 + 8 * fq;
        bf16_t* x0 = XB + (size_t)(u.m0 + wr * 64 + fr) * D + u.pn * BM + wc * 32 + 8 * fq;
        u32x4 xv[2][4][2];
#pragma unroll
        for (int ai = 0; ai < 2; ++ai)
#pragma unroll
            for (int m = 0; m < 4; ++m)
#pragma unroll
                for (int bj = 0; bj < 2; ++bj) xv[ai][m][bj] = *(const u32x4*)(x0 + (size_t)(ai * HALF + m * 16) * D + bj * HALF);
        f32x4 gv[2][2];
#pragma unroll
        for (int bj = 0; bj < 2; ++bj)
#pragma unroll
            for (int n = 0; n < 2; ++n) gv[bj][n] = *(const f32x4*)(g1 + bj * HALF + 4 * n) * gscale;
#pragma unroll
        for (int ai = 0; ai < 2; ++ai)
#pragma unroll
            for (int m = 0; m < 4; ++m)
#pragma unroll
                for (int bj = 0; bj < 2; ++bj) { const u32x4 x = xv[ai][m][bj];
                    const f32x4 a0 = acc[ai][bj][m][0] * gv[bj][0], a1 = acc[ai][bj][m][1] * gv[bj][1]; u32x4 w;
                    w.x = cvt_pk_bf16(__builtin_bit_cast(float, x.x << 16) + a0[0], __builtin_bit_cast(float, x.x & 0xffff0000u) + a0[1]);
                    w.y = cvt_pk_bf16(__builtin_bit_cast(float, x.y << 16) + a0[2], __builtin_bit_cast(float, x.y & 0xffff0000u) + a0[3]);
                    w.z = cvt_pk_bf16(__builtin_bit_cast(float, x.z << 16) + a1[0], __builtin_bit_cast(float, x.z & 0xffff0000u) + a1[1]);
                    w.w = cvt_pk_bf16(__builtin_bit_cast(float, x.w << 16) + a1[2], __builtin_bit_cast(float, x.w & 0xffff0000u) + a1[3]);
                    *(u32x4*)(x0 + (size_t)(ai * HALF + m * 16) * D + bj * HALF) = w; }
    }
};
__device__ __forceinline__ float silu_fast(float v) { return v * __builtin_amdgcn_rcpf(1.0f + __builtin_amdgcn_exp2f(-LOG2E * v)); }
__device__ __forceinline__ unsigned pk4_fp8(float a, float b, float c, float d) { int w = 0; w = __builtin_amdgcn_cvt_pk_fp8_f32(a, b, w, false); w = __builtin_amdgcn_cvt_pk_fp8_f32(c, d, w, true); return (unsigned)w; }
__device__ __forceinline__ void store_pair16_fq(unsigned char* p0, unsigned char* p1, u32x2 a, u32x2 b, int fq) {
    auto rx = __builtin_amdgcn_permlane16_swap(a.x, b.x, false, false); auto ry = __builtin_amdgcn_permlane16_swap(a.y, b.y, false, false);
    u32x4 w; w.x = rx[0]; w.y = ry[0]; w.z = rx[1]; w.w = ry[1];
    *(u32x4*)((fq & 1) ? p1 - 8 : p0) = w;
}
struct EpiH {
    static constexpr bool PERM = true;
    unsigned char* H;
    __device__ __forceinline__ void operator()(const f32x4 (&acc)[2][2][4][2], const Unit& u, int wr, int wc, int fr, int fq) const {
        const int hc = u.pn * HALF + wc * 32 + 8 * fq;
#pragma unroll
        for (int ai = 0; ai < 2; ++ai)
#pragma unroll
            for (int m = 0; m < 4; m += 2) {
                const int row = u.m0 + ai * HALF + wr * 64 + m * 16 + fr;
                u32x2 w[2];
#pragma unroll
                for (int q = 0; q < 2; ++q) {
                    const f32x4 g0 = acc[ai][0][m + q][0], g1 = acc[ai][0][m + q][1], u0 = acc[ai][1][m + q][0], u1 = acc[ai][1][m + q][1];
                    w[q].x = pk4_fp8(silu_fast(g0[0]) * u0[0], silu_fast(g0[1]) * u0[1], silu_fast(g0[2]) * u0[2], silu_fast(g0[3]) * u0[3]);
                    w[q].y = pk4_fp8(silu_fast(g1[0]) * u1[0], silu_fast(g1[1]) * u1[1], silu_fast(g1[2]) * u1[2], silu_fast(g1[3]) * u1[3]);
                }
                store_pair16_fq(H + (size_t)row * FF + hc, H + (size_t)(row + 16) * FF + hc, w[0], w[1], fq);
            }
    }
};
struct EpiY {
    static constexpr bool PERM = true, HAS_PRE = true;
    unsigned char* Y; const float* gate;
    __device__ __forceinline__ void pre(float (&gv)[8], const Unit& u, int wr, int fr) const {
#pragma unroll
        for (int ai = 0; ai < 2; ++ai)
#pragma unroll
            for (int m = 0; m < 4; ++m) gv[ai * 4 + m] = gate[u.m0 + ai * HALF + wr * 64 + m * 16 + fr];
    }
    __device__ __forceinline__ void operator()(const f32x4 (&acc)[2][2][4][2], const Unit& u, int wr, int wc, int fr, int fq, const float (&gv)[8]) const {
#pragma unroll
        for (int ai = 0; ai < 2; ++ai)
#pragma unroll
            for (int m = 0; m < 4; m += 2) {
                const int row = u.m0 + ai * HALF + wr * 64 + m * 16 + fr;
#pragma unroll
                for (int bj = 0; bj < 2; ++bj) {
                    u32x2 w[2];
#pragma unroll
                    for (int q = 0; q < 2; ++q) { const float gt = gv[ai * 4 + m + q] * 64.0f;
                        const f32x4 v0 = acc[ai][bj][m + q][0] * gt, v1 = acc[ai][bj][m + q][1] * gt;
                        w[q].x = pk4_fp8(v0[0], v0[1], v0[2], v0[3]); w[q].y = pk4_fp8(v1[0], v1[1], v1[2], v1[3]); }
                    unsigned char* p0 = Y + (size_t)row * D + u.pn * BM + bj * HALF + wc * 32 + 8 * fq;
                    store_pair16_fq(p0, p0 + (size_t)16 * D, w[0], w[1], fq);
                }
            }
    }
};
}

struct Args { const float* in[19]; float* out; unsigned char* ws; int ph_lo, ph_hi; };
struct Ctx {
    Ptrs p; LAS unsigned char* lds;
    float *tab, *mod, *aff, *gate, *xc, *xl; int *sel, *tokslot;
    bf16_t *win, *wout, *P, *H, *Y, *MIX, *HX2, *HX, *XB; float* TMP; int wv;
};
template <class Dest>
__device__ __forceinline__ void transpose_item_fp8(const float* W, int K, int N, unsigned char* WT, LAS float* scr, int item, int lane, Dest dest) {
    const int nblk = N / 32, kb = item / nblk, nb = item % nblk, k0 = 64 * kb, n0 = 32 * nb;
    float wv[32];
#pragma unroll
    for (int i = 0; i < 32; ++i) wv[i] = W[(size_t)(k0 + 2 * i + (lane >> 5)) * N + n0 + (lane & 31)];
#pragma unroll
    for (int i = 0; i < 32; ++i) { const int kk = 2 * i + (lane >> 5); scr[kk * 33 + (lane & 31)] = wv[i] * 64.0f; }
    LDS_WAIT(); asm volatile("" ::: "memory");
    const int c = lane & 7;
#pragma unroll
    for (int j = 0; j < 4; ++j) { const int n = (lane >> 3) + 8 * j; const LAS float* s = scr + (8 * c) * 33 + n;
        u32x2 o; o.x = pg::pk4_fp8(s[0 * 33], s[1 * 33], s[2 * 33], s[3 * 33]); o.y = pg::pk4_fp8(s[4 * 33], s[5 * 33], s[6 * 33], s[7 * 33]);
        *(u32x2*)(WT + (size_t)dest(n0 + n) * K + k0 + 8 * c) = o; }
    LDS_WAIT(); asm volatile("" ::: "memory");
}
template <class Dest>
__device__ __forceinline__ void transpose_item(const float* W, int K, int N, bf16_t* WT, LAS float* scr, int item, int lane, Dest dest) {
    const int nblk = N / 32, kb = item / nblk, nb = item % nblk, k0 = 64 * kb, n0 = 32 * nb;
#pragma unroll 8
    for (int i = 0; i < 32; ++i) { const int kk = 2 * i + (lane >> 5); scr[kk * 33 + (lane & 31)] = W[(size_t)(k0 + kk) * N + n0 + (lane & 31)]; }
    LDS_WAIT(); asm volatile("" ::: "memory");
    const int c = lane & 7;
#pragma unroll
    for (int j = 0; j < 4; ++j) { const int n = (lane >> 3) + 8 * j; const LAS float* s = scr + (8 * c) * 33 + n;
        u32x4 o; o.x = cvt_pk_bf16(s[0 * 33], s[1 * 33]); o.y = cvt_pk_bf16(s[2 * 33], s[3 * 33]); o.z = cvt_pk_bf16(s[4 * 33], s[5 * 33]); o.w = cvt_pk_bf16(s[6 * 33], s[7 * 33]);
        *(u32x4*)(WT + (size_t)dest(n0 + n) * K + k0 + 8 * c) = o; }
    LDS_WAIT(); asm volatile("" ::: "memory");
}
HD int invA(int q) { const int g = q / 32, r = q % 32; return 32 * g + (r < 16 ? 2 * r : 2 * (r - 16) + 1); }
HD int invD(int q) { const int g = q / 16, r = q % 16; return 16 * g + (r < 8 ? 2 * r : 2 * (r - 8) + 1); }
HD int inproj_dst_row(int nl) {
    if (nl < C_VA) return (nl / 64) * 64 + invA(nl % 64);
    if (nl >= C_QD && nl < C_VD) return (nl / 32) * 32 + invD(nl % 32);
    return nl;
}
struct DestIn { __device__ int operator()(int n) const { return inproj_dst_row(n); } };
struct DestId { __device__ int operator()(int n) const { return n; } };
struct DestGU { int up; __device__ int operator()(int n) const { return (n / 128) * 256 + up * 128 + n % 128; } };

__device__ __forceinline__ void phase_prologue(const Ctx& C) {
    const int tid = tid_l(), lane = tid & 63, wave = __builtin_amdgcn_readfirstlane(tid >> 6), gw = blockIdx.x * NWV + wave, NGW = gridDim.x * NWV; (void)lane; (void)gw; (void)NGW;
    for (long g = (long)tid * gridDim.x + blockIdx.x; g < (long)(NROWS + 64) * 24; g += (long)gridDim.x * NT) {
        const int pos = (int)(g / 24), f = (int)(g % 24);
        const float inv = f < 16 ? exp2f(-(float)f * (13.287712379549449f / 16.0f)) : exp2f(-(float)(f - 16) * (13.287712379549449f / 8.0f));
        const bool isrow = pos < NROWS; const int p = isrow ? pos : pos - NROWS;
        const float ang = (float)p * inv; float sn, cs; sincosf(ang, &sn, &cs);
        const int idx = f < 16 ? (isrow ? T_AROW : T_ACOL) + (p * 16 + f) * 2 : (isrow ? T_DROW : T_DCOL) + (p * 8 + (f - 16)) * 2;
        C.tab[idx] = cs; C.tab[idx + 1] = sn;
    }
    LAS float* sl = (LAS float*)C.lds;
    for (int i = tid; i < (NB + 1) * D; i += NT) { const int b = i / D, k = i % D; sl[i] = silu_f(b < NB ? C.p.c[b * D + k] : C.p.c_ctx[k]); }
    __syncthreads();
    constexpr int NBR = NB + 1, BG = 11, NBG = NBR / BG; static_assert(NBG * BG == NBR, "adaLN rows reduced in groups of 11");
    LAS float* pbuf = (LAS float*)(C.lds + NBR * D * 4);
    static_assert(NBR * D * 4 + 16 * BG * 32 * 4 <= LDS_MISC, "prologue LDS");
    for (int task = blockIdx.x; task < DEPTH * 6 * D / 32; task += gridDim.x) {
        const int jg = task * 32, l = jg / (6 * D), j0 = jg % (6 * D), c = lane & 31, half = lane >> 5, kb = 128 * wave + 64 * half;
        f32x2_t acc2[NBR];
#pragma unroll
        for (int b = 0; b < NBR; ++b) acc2[b] = (f32x2_t){0.f, 0.f};
        const float* w = C.p.w_ada + ((size_t)l * D + kb) * 6 * D + j0 + c; const LAS float* s0 = sl + kb;
        for (int kk = 0; kk < 64; kk += 4) {
            const f32x2_t w01 = (f32x2_t){w[(size_t)kk * 6 * D], w[(size_t)(kk + 1) * 6 * D]}, w23 = (f32x2_t){w[(size_t)(kk + 2) * 6 * D], w[(size_t)(kk + 3) * 6 * D]};
#pragma unroll
            for (int rr = 0; rr < NBG; ++rr) { f32x4 sv[BG]; const unsigned sa = (unsigned)(size_t)(s0 + rr * BG * D + kk);
                LDS_RD11_B128(sv, sa, D * 4);
#pragma unroll
                for (int bb = 0; bb < BG; ++bb) { acc2[rr * BG + bb] = __builtin_elementwise_fma((f32x2_t){sv[bb][0], sv[bb][1]}, w01, acc2[rr * BG + bb]);
                    acc2[rr * BG + bb] = __builtin_elementwise_fma((f32x2_t){sv[bb][2], sv[bb][3]}, w23, acc2[rr * BG + bb]); } }
        }
        float acc[NBR];
#pragma unroll
        for (int b = 0; b < NBR; ++b) acc[b] = acc2[b][0] + acc2[b][1];
#pragma unroll
        for (int rr = 0; rr < NBG; ++rr) {
#pragma unroll
            for (int bb = 0; bb < BG; ++bb) pbuf[((wave * 2 + half) * BG + bb) * 32 + c] = acc[rr * BG + bb];
            __syncthreads();
            if (tid < BG * 32) { const int bb = tid / 32, cc = tid % 32; float s = 0.f;
#pragma unroll
                for (int p = 0; p < 16; ++p) s += pbuf[(p * BG + bb) * 32 + cc];
                C.mod[((size_t)l * NBR + rr * BG + bb) * 6 * D + j0 + cc] = s + C.p.b_ada[l * 6 * D + j0 + cc]; }
            __syncthreads();
        }
    }
    __syncthreads();
    LAS float* scr = (LAS float*)(C.lds + wave * 16384);
    constexpr int I_OUT = (D / 64) * (D / 32);
    for (int it = gw; it < DEPTH * I_OUT; it += NGW) { const int l = it / I_OUT, r = it % I_OUT;
        transpose_item(C.p.w_out + (size_t)l * D * D, D, D, C.wout + (size_t)l * D * D, scr, r, lane, DestId{}); }
    float* wss = (float*)(C.p.ws + WS_CTL + CTL_WINMAX);
    LAS float* pm = (LAS float*)(C.lds + 8 * 16384);
    __syncthreads();
    for (int slot = blockIdx.x; slot < DEPTH * 256; slot += gridDim.x) {
        const int l = slot / 256, s = slot % 256; constexpr int PER = D * PROJ / 256;
        const float* w = C.p.w_in + (size_t)l * D * PROJ + (size_t)s * PER; float acc = 0.f;
        for (int i = tid; i < PER / 4; i += NT) { const f32x4 v = *(const f32x4*)(w + 4 * i); acc += (v[0] * v[0] + v[1] * v[1]) + (v[2] * v[2] + v[3] * v[3]); }
        acc = wave_sum(acc); if (lane == 0) pm[wave] = acc;
        __syncthreads();
        if (tid == 0) { float t = 0.f; for (int q = 0; q < NWV; ++q) t += pm[q]; wss[slot] = t; }
        __syncthreads();
    }
    __syncthreads();
}
__device__ __forceinline__ float win_amax(const unsigned char* ws, int l, int lane) {
    const float* wss = (const float*)(ws + WS_CTL + CTL_WINMAX) + l * 256;
    const float t = wave_sum((wss[lane] + wss[lane + 64]) + (wss[lane + 128] + wss[lane + 192]));
    return 4.0f * sqrtf(t * (1.0f / ((float)D * (float)PROJ)));
}
__device__ __forceinline__ void phase_prologue_b(const Ctx& C) {
    const int tid = tid_l(), lane = tid & 63, wave = __builtin_amdgcn_readfirstlane(tid >> 6), gw = blockIdx.x * NWV + wave, NGW = gridDim.x * NWV;
    LAS float* scr = (LAS float*)(C.lds + wave * 16384);
    constexpr int I_IN = (D / 64) * (PROJ / 32);
    for (int it = gw; it < DEPTH * I_IN; it += NGW) {
        const int l = it / I_IN, item = it % I_IN, nblk = PROJ / 32, kb = item / nblk, nb = item % nblk, k0 = 64 * kb, n0 = 32 * nb;
        const float* W = C.p.w_in + (size_t)l * D * PROJ; signed char* WT = (signed char*)C.win + (size_t)l * PROJ * D;
        { const int nl = n0 + (lane & 31); const float am = win_amax(C.p.ws, l, lane); const float inv = am > 0.f ? 127.0f / am : 0.f;
#pragma unroll 8
          for (int i = 0; i < 32; ++i) { const int kk = 2 * i + (lane >> 5); scr[kk * 33 + (lane & 31)] = W[(size_t)(k0 + kk) * PROJ + nl] * inv; } }
        LDS_WAIT(); asm volatile("" ::: "memory");
        const int c = lane & 7;
#pragma unroll
        for (int j = 0; j < 4; ++j) { const int n = (lane >> 3) + 8 * j; const LAS float* s = scr + (8 * c) * 33 + n; unsigned lo = 0u, hi = 0u;
#pragma unroll
            for (int q = 0; q < 4; ++q) { lo |= ((unsigned)__float2int_rn(fminf(fmaxf(s[q * 33], -127.f), 127.f)) & 0xffu) << (8 * q); hi |= ((unsigned)__float2int_rn(fminf(fmaxf(s[(4 + q) * 33], -127.f), 127.f)) & 0xffu) << (8 * q); }
            *(u32x2*)(WT + (size_t)inproj_dst_row(n0 + n) * D + k0 + 8 * c) = (u32x2){lo, hi}; }
        LDS_WAIT(); asm volatile("" ::: "memory");
    }
    __syncthreads();
}
constexpr int CVT_ITEMS = 3 * NE * (D / 64) * (FF / 32);
struct CvtItem { const float* src; unsigned char* dst; int mat, n0; };
__device__ __forceinline__ CvtItem cvt_decode(const Ctx& C, int l, int it, int lane) {
    constexpr int I_E = (D / 64) * (FF / 32), NBLK = FF / 32;
    const int mat = it / (NE * I_E), e = (it / I_E) % NE, r = it % I_E, kb = r / NBLK, nb = r % NBLK, k0 = 64 * kb, n0 = 32 * nb;
    const size_t wo = ((size_t)l * NE + e) * D * FF;
    const float* W = mat == 0 ? C.p.w_gate + wo : mat == 1 ? C.p.w_up + wo : C.p.w_down + wo;
    unsigned char* wgu = C.p.ws + WS_WGU + (size_t)(l & 1) * NE * 2 * FF * D; unsigned char* wd = C.p.ws + WS_WD + (size_t)(l & 1) * NE * D * FF;
    CvtItem c; c.src = W + (size_t)(k0 + (lane >> 5)) * FF + n0 + (lane & 31); c.dst = (mat == 2 ? wd + (size_t)e * D * FF : wgu + (size_t)e * 2 * FF * D) + k0; c.mat = mat; c.n0 = n0;
    return c;
}
__device__ __forceinline__ void phase_cvt_experts(const Ctx& C, int l, int it0, int it1, int w, int nw) {
    static_assert(D == FF, "expert matrices are square");
    const int tid = tid_l(), lane = tid & 63, wave = __builtin_amdgcn_readfirstlane(tid >> 6);
    LAS float* scr = (LAS float*)(C.lds + wave * 16384);
    float ra[32], rb[32];
    auto issue = [&](float (&r)[32], const CvtItem& c) {
#pragma unroll
        for (int i = 0; i < 32; ++i) r[i] = c.src[(size_t)(2 * i) * FF]; };
    auto process = [&](float (&r)[32], const CvtItem& cur) {
#pragma unroll
        for (int i = 0; i < 32; ++i) { const int kk = 2 * i + (lane >> 5); scr[kk * 33 + (lane & 31)] = r[i] * 64.0f; }
        LDS_WAIT(); asm volatile("" ::: "memory");
        const int c = lane & 7;
#pragma unroll
        for (int j = 0; j < 4; ++j) { const int n = cur.n0 + (lane >> 3) + 8 * j; const LAS float* sp = scr + (8 * c) * 33 + (lane >> 3) + 8 * j;
            u32x2 o; o.x = pg::pk4_fp8(sp[0 * 33], sp[1 * 33], sp[2 * 33], sp[3 * 33]); o.y = pg::pk4_fp8(sp[4 * 33], sp[5 * 33], sp[6 * 33], sp[7 * 33]);
            const int drow = cur.mat == 2 ? n : (n / 128) * 256 + cur.mat * 128 + n % 128;
            *(u32x2*)(cur.dst + (size_t)drow * D + 8 * c) = o; }
        LDS_WAIT(); asm volatile("" ::: "memory"); };
    int it = it0 + w;
    CvtItem ca{}, cb{};
    if (it < it1) { ca = cvt_decode(C, l, it, lane); issue(ra, ca); }
    while (it < it1) {
        cb = cvt_decode(C, l, it + nw < it1 ? it + nw : it, lane); issue(rb, cb);
        process(ra, ca);
        it += nw; if (it >= it1) break;
        ca = cvt_decode(C, l, it + nw < it1 ? it + nw : it, lane); issue(ra, ca);
        process(rb, cb);
        it += nw;
    }
    __syncthreads();
}
__device__ __forceinline__ void yf8_add(f32x4& a, const unsigned w, const float wf) {
    const f32x2_t lo = __builtin_amdgcn_cvt_pk_f32_fp8((int)w, false), hi = __builtin_amdgcn_cvt_pk_f32_fp8((int)w, true);
    a[0] += wf * lo[0]; a[1] += wf * lo[1]; a[2] += wf * hi[0]; a[3] += wf * hi[1];
}
template <bool FINAL, bool SRCF32>
__device__ __forceinline__ void phase_rowA(const Ctx& C, int l, float gscale = 1.0f) {
    const int tid = tid_l(), lane = tid & 63, wave = __builtin_amdgcn_readfirstlane(tid >> 6), gw = blockIdx.x * NWV + wave, NGW = gridDim.x * NWV;
    const int nrows = FINAL ? RL : RALL;
    const int per = (nrows + NGW - 1) / NGW, r0 = gw * per, r1 = (r0 + per < nrows) ? r0 + per : nrows;
#define RA_LOADX(dst, row) do { if (SRCF32) { const float* _s = ((row) < RL ? C.p.x + (size_t)(row) * D : C.p.ctx + (size_t)((row) - RL) * D); _Pragma("unroll") for (int j = 0; j < 4; ++j) dst[j] = __builtin_bit_cast(u32x4, *(const f32x4*)(_s + 4 * lane + 256 * j)); } \
        else { const bf16_t* _s = C.XB + (size_t)(row) * D + 4 * lane; _Pragma("unroll") for (int j = 0; j < 4; ++j) { const u32x2 _w = *(const u32x2*)(_s + 256 * j); dst[j] = (u32x4){_w.x, _w.y, 0u, 0u}; } } } while (0)
#define RA_LOADTS(dst, row) do { dst = (l > 0 && lane < NE) ? C.tokslot[(size_t)(row) * NE + lane] : -1; } while (0)
#define RA_ISSUEY(YY, WF, MSK, ts) do { unsigned _m = (unsigned)__ballot((ts) >= 0); int _s0 = 0, _s1, _s2, _s3; WF[0] = WF[1] = WF[2] = WF[3] = 0.f; \
        if (_m) { _s0 = __builtin_amdgcn_readlane((ts), __builtin_ctz(_m)); _m &= _m - 1; WF[0] = 1.f; } _s1 = _s2 = _s3 = _s0; \
        if (_m) { _s1 = __builtin_amdgcn_readlane((ts), __builtin_ctz(_m)); _m &= _m - 1; WF[1] = 1.f; } \
        if (_m) { _s2 = __builtin_amdgcn_readlane((ts), __builtin_ctz(_m)); _m &= _m - 1; WF[2] = 1.f; } \
        if (_m) { _s3 = __builtin_amdgcn_readlane((ts), __builtin_ctz(_m)); _m &= _m - 1; WF[3] = 1.f; } MSK = _m; \
        _Pragma("unroll") for (int j = 0; j < 4; ++j) { YY[0][j] = *(const unsigned*)(Yb + (size_t)_s0 * D + 4 * lane + 256 * j); YY[1][j] = *(const unsigned*)(Yb + (size_t)_s1 * D + 4 * lane + 256 * j); \
            YY[2][j] = *(const unsigned*)(Yb + (size_t)_s2 * D + 4 * lane + 256 * j); YY[3][j] = *(const unsigned*)(Yb + (size_t)_s3 * D + 4 * lane + 256 * j); } } while (0)
    const unsigned char* Yb = (const unsigned char*)C.Y;
    u32x4 xc[4], xn[4], x2[4]; int tsc = -1, tsn = -1, ts2 = -1; unsigned yc[4][4], yn[4][4]; float wc_[4], wn_[4]; unsigned mc = 0u, mn = 0u;
    f32x4 A[4], S[4], G[4]; int bcur = -1;
#pragma unroll
    for (int j = 0; j < 4; ++j) { xc[j] = xn[j] = x2[j] = (u32x4){0u, 0u, 0u, 0u}; A[j] = S[j] = G[j] = (f32x4){0.f, 0.f, 0.f, 0.f}; }
#pragma unroll
    for (int i = 0; i < 4; ++i) { wc_[i] = wn_[i] = 0.f;
#pragma unroll
        for (int j = 0; j < 4; ++j) yc[i][j] = yn[i][j] = 0u; }
    if (r0 < r1) { RA_LOADTS(tsc, r0); RA_LOADX(xc, r0); if (l > 0) RA_ISSUEY(yc, wc_, mc, tsc); }
    if (r0 + 1 < r1) { RA_LOADTS(tsn, r0 + 1); RA_LOADX(xn, r0 + 1); }
    for (int row = r0; row < r1; ++row) {
        if (l > 0 && row + 1 < r1) RA_ISSUEY(yn, wn_, mn, tsn);
        if (row + 2 < r1) { RA_LOADTS(ts2, row + 2); RA_LOADX(x2, row + 2); }
        const int b = row_batch(row);
        if (b != bcur) { bcur = b;
            if (FINAL) {
#pragma unroll
                for (int j = 0; j < 4; ++j) A[j] = *(const f32x4*)(C.p.norm_final + 4 * lane + 256 * j);
            } else { const float* m = C.mod + ((size_t)l * (NB + 1) + b) * 6 * D + 4 * lane; const float* nw = C.p.norm1 + (size_t)l * D + 4 * lane;
#pragma unroll
                for (int j = 0; j < 4; ++j) { A[j] = *(const f32x4*)(nw + 256 * j) * (*(const f32x4*)(m + M_SC1 + 256 * j) + 1.0f); S[j] = *(const f32x4*)(m + M_SH1 + 256 * j); } }
            if (l > 0) { const float* g2 = C.mod + ((size_t)(l - 1) * (NB + 1) + b) * 6 * D + M_G2 + 4 * lane;
#pragma unroll
                for (int j = 0; j < 4; ++j) G[j] = *(const f32x4*)(g2 + 256 * j) * (gscale * (1.0f / 64.0f)); } }
        f32x4 v[4];
#pragma unroll
        for (int j = 0; j < 4; ++j) { if (SRCF32) v[j] = __builtin_bit_cast(f32x4, xc[j]); else { const unsigned w0 = xc[j][0], w1 = xc[j][1];
            v[j] = (f32x4){__builtin_bit_cast(float, w0 << 16), __builtin_bit_cast(float, w0 & 0xffff0000u), __builtin_bit_cast(float, w1 << 16), __builtin_bit_cast(float, w1 & 0xffff0000u)}; } }
        if (l > 0) {
            f32x4 a[4];
#pragma unroll
            for (int j = 0; j < 4; ++j) { a[j] = (f32x4){0.f, 0.f, 0.f, 0.f};
#pragma unroll
                for (int i = 0; i < 4; ++i) yf8_add(a[j], yc[i][j], wc_[i]); }
            while (mc) { const int s = __builtin_amdgcn_readlane(tsc, __builtin_ctz(mc)); mc &= mc - 1;
#pragma unroll
                for (int j = 0; j < 4; ++j) yf8_add(a[j], *(const unsigned*)(Yb + (size_t)s * D + 4 * lane + 256 * j), 1.0f); }
#pragma unroll
            for (int j = 0; j < 4; ++j) v[j] = v[j] + G[j] * a[j];
        }
        float ss = 0.f;
#pragma unroll
        for (int j = 0; j < 4; ++j) ss += (v[j][0] * v[j][0] + v[j][1] * v[j][1]) + (v[j][2] * v[j][2] + v[j][3] * v[j][3]);
        const float rstd = 1.0f / sqrtf(wave_sum(ss) * (1.0f / D) + EPS);
        if (FINAL) {
            float* dst = C.p.out + (size_t)row * D;
#pragma unroll
            for (int j = 0; j < 4; ++j) *(f32x4*)(dst + 4 * lane + 256 * j) = v[j] * rstd * A[j];
        } else {
            bf16_t* xo = C.XB + (size_t)row * D + 4 * lane;
#pragma unroll
            for (int j = 0; j < 4; ++j) { u32x2 w; w.x = cvt_pk_bf16(v[j][0], v[j][1]); w.y = cvt_pk_bf16(v[j][2], v[j][3]); *(u32x2*)(xo + 256 * j) = w; }
            f32x4 hq[4]; float am = 0.f;
#pragma unroll
            for (int j = 0; j < 4; ++j) { hq[j] = v[j] * rstd * A[j] + S[j]; am = fmaxf(fmaxf(am, fmaxf(fabsf(hq[j][0]), fabsf(hq[j][1]))), fmaxf(fabsf(hq[j][2]), fabsf(hq[j][3]))); }
            am = wave_max(am); const float inv = am > 0.f ? 127.0f / am : 0.f;
            if (lane == 0) ((float*)(C.p.ws + WS_HXS))[row] = am * (1.0f / 127.0f);
            unsigned char* hr = (unsigned char*)C.HX + (size_t)row * D + 4 * lane;
#pragma unroll
            for (int j = 0; j < 4; ++j) { const unsigned w = ((unsigned)__float2int_rn(fminf(fmaxf(hq[j][0] * inv, -127.f), 127.f)) & 0xffu) | (((unsigned)__float2int_rn(fminf(fmaxf(hq[j][1] * inv, -127.f), 127.f)) & 0xffu) << 8) | (((unsigned)__float2int_rn(fminf(fmaxf(hq[j][2] * inv, -127.f), 127.f)) & 0xffu) << 16) | (((unsigned)__float2int_rn(fminf(fmaxf(hq[j][3] * inv, -127.f), 127.f)) & 0xffu) << 24);
                *(unsigned*)(hr + 256 * j) = w; }
        }
        tsc = tsn; tsn = ts2; mc = mn;
#pragma unroll
        for (int j = 0; j < 4; ++j) { xc[j] = xn[j]; xn[j] = x2[j]; }
#pragma unroll
        for (int i = 0; i < 4; ++i) { wc_[i] = wn_[i];
#pragma unroll
            for (int j = 0; j < 4; ++j) yc[i][j] = yn[i][j]; }
    }
#undef RA_LOADX
#undef RA_LOADTS
#undef RA_ISSUEY
}
__device__ __forceinline__ void phase_rowB(const Ctx& C, int l, int nq) {
    const int tid = tid_l(), lane = tid & 63, wave = __builtin_amdgcn_readfirstlane(tid >> 6), gw = blockIdx.x * NWV + wave, NGW = gridDim.x * NWV;
    LAS float* R = (LAS float*)C.lds;
    const float* rt = C.p.router + (size_t)l * D * NE;
    for (int i = tid; i < D * NE; i += NT) R[(i % NE) * D + i / NE] = rt[i];
    __syncthreads();
    const int per = (nq + NGW - 1) / NGW, r0 = gw * per, r1 = (r0 + per < nq) ? r0 + per : nq;
    f32x4 xn[4], A[4], S[4]; int bcur = -1; int row = r0;
    u32x2 xr_[4];
    if (row < r1) { const bf16_t* s = C.XB + (size_t)row * D + 4 * lane;
#pragma unroll
        for (int j = 0; j < 4; ++j) xr_[j] = *(const u32x2*)(s + 256 * j); }
    for (; row < r1; ++row) {
        f32x4 v[4]; float ss = 0.f;
#pragma unroll
        for (int j = 0; j < 4; ++j) xn[j] = (f32x4){__builtin_bit_cast(float, xr_[j].x << 16), __builtin_bit_cast(float, xr_[j].x & 0xffff0000u), __builtin_bit_cast(float, xr_[j].y << 16), __builtin_bit_cast(float, xr_[j].y & 0xffff0000u)};
        const int b = row_batch(row);
        if (b != bcur) { bcur = b; const float* m = C.mod + ((size_t)l * (NB + 1) + b) * 6 * D + 4 * lane; const float* nw = C.p.norm2 + (size_t)l * D + 4 * lane;
#pragma unroll
            for (int j = 0; j < 4; ++j) { A[j] = *(const f32x4*)(nw + 256 * j) * (*(const f32x4*)(m + M_SC2 + 256 * j) + 1.0f); S[j] = *(const f32x4*)(m + M_SH2 + 256 * j); } }
#pragma unroll
        for (int j = 0; j < 4; ++j) { v[j] = xn[j]; ss += (v[j][0] * v[j][0] + v[j][1] * v[j][1]) + (v[j][2] * v[j][2] + v[j][3] * v[j][3]); }
        if (row + 1 < r1) { const bf16_t* s = C.XB + (size_t)(row + 1) * D + 4 * lane;
#pragma unroll
            for (int j = 0; j < 4; ++j) xr_[j] = *(const u32x2*)(s + 256 * j); }
        const float rstd = 1.0f / sqrtf(wave_sum(ss) * (1.0f / D) + EPS);
        unsigned char* hr = (unsigned char*)C.HX2 + (size_t)row * D + 4 * lane;
#pragma unroll
        for (int j = 0; j < 4; ++j) { v[j] = v[j] * rstd * A[j] + S[j]; *(unsigned*)(hr + 256 * j) = pg::pk4_fp8(v[j][0], v[j][1], v[j][2], v[j][3]); }
        float p[NE];
        { f32x2_t q[NE];
#pragma unroll
          for (int e = 0; e < NE; ++e) q[e] = (f32x2_t){0.f, 0.f};
          f32x4 ra_[8], rb_[8]; const unsigned rbase = (unsigned)(size_t)(R + 4 * lane);
          LDS_ISSUE8_B128(ra_, rbase, D * 4);
#pragma unroll
          for (int k = 0; k < 8; k += 2) {
              const f32x2_t vlo = (f32x2_t){v[k >> 1][0], v[k >> 1][1]}, vhi = (f32x2_t){v[k >> 1][2], v[k >> 1][3]};
              LDS_ISSUE8_B128(rb_, rbase + (unsigned)((8 * D + 256 * (k >> 1)) * 4), D * 4); LDS_WAIT8(ra_, 8);
#pragma unroll
              for (int e = 0; e < 8; ++e) { q[e] = __builtin_elementwise_fma(vlo, (f32x2_t){ra_[e][0], ra_[e][1]}, q[e]); q[e] = __builtin_elementwise_fma(vhi, (f32x2_t){ra_[e][2], ra_[e][3]}, q[e]); }
              if (k + 2 < 8) { LDS_ISSUE8_B128(ra_, rbase + (unsigned)(256 * ((k >> 1) + 1) * 4), D * 4); LDS_WAIT8(rb_, 8); } else { LDS_WAIT8(rb_, 0); }
#pragma unroll
              for (int e = 0; e < 8; ++e) { q[8 + e] = __builtin_elementwise_fma(vlo, (f32x2_t){rb_[e][0], rb_[e][1]}, q[8 + e]); q[8 + e] = __builtin_elementwise_fma(vhi, (f32x2_t){rb_[e][2], rb_[e][3]}, q[8 + e]); }
          }
#pragma unroll
          for (int e = 0; e < NE; ++e) p[e] = q[e][0] + q[e][1]; }
#pragma unroll
        for (int j = 0; j < 8; ++j) { auto rr = __builtin_amdgcn_permlane32_swap(__float_as_uint(p[j]), __float_as_uint(p[j + 8]), false, false); p[j] = __uint_as_float(rr[0]) + __uint_as_float(rr[1]); }
#pragma unroll
        for (int j = 0; j < 4; ++j) { auto rr = __builtin_amdgcn_permlane16_swap(__float_as_uint(p[j]), __float_as_uint(p[j + 4]), false, false); p[j] = __uint_as_float(rr[0]) + __uint_as_float(rr[1]); }
#pragma unroll
        for (int j = 0; j < 2; ++j) { const float a = p[j] + dpp_f(p[j], 3), b2 = p[j + 2] + dpp_f(p[j + 2], 3); p[j] = (lane & 8) ? b2 : a; }
        float lg; { const float a = p[0] + dpp_f(p[0], 2), b2 = p[1] + dpp_f(p[1], 2); lg = (lane & 4) ? b2 : a; }
        lg += dpp_f(lg, 1); lg += dpp_f(lg, 0);
        const float mx = wave_max(lg);
        const float ex = expf(lg - mx); const float se = wave_sum(ex) * 0.25f;
        const int e = ((lane >> 5) & 1) * 8 + ((lane >> 4) & 1) * 4 + ((lane >> 3) & 1) * 2 + ((lane >> 2) & 1);
        if ((lane & 3) == 0) C.aff[(size_t)row * NE + e] = ex / se;
    }
    __syncthreads();
}
template <int NV>
__device__ __forceinline__ void select_task(const Ctx& C, int base_row, int cap, int e, int slot0, int lane) {
    unsigned v[NV];
#pragma unroll
    for (int i = 0; i < NV; ++i) v[i] = __builtin_bit_cast(unsigned, C.aff[(size_t)(base_row + i * 64 + lane) * NE + e]);
    unsigned T = 0u;
    for (int bit = 30; bit >= 0; --bit) { const unsigned cand = T | (1u << bit); int cnt = 0;
#pragma unroll
        for (int i = 0; i < NV; ++i) cnt += __builtin_popcountll(__ballot(v[i] >= cand));
        if (cnt >= cap) T = cand; }
    int ngt = 0;
#pragma unroll
    for (int i = 0; i < NV; ++i) ngt += __builtin_popcountll(__ballot(v[i] > T));
    const int need = cap - ngt;
    const unsigned long long lt = (1ull << lane) - 1ull; int nsel = 0, neq = 0;
#pragma unroll
    for (int i = 0; i < NV; ++i) {
        const bool gt = v[i] > T, eq = v[i] == T; const unsigned long long meq = __ballot(eq);
        const bool take = gt || (eq && (neq + __builtin_popcountll(meq & lt)) < need);
        const unsigned long long msel = __ballot(take);
        const int row = base_row + i * 64 + lane; int slot = -1;
        if (take) { slot = slot0 + nsel + __builtin_popcountll(msel & lt); C.sel[slot] = row; C.gate[slot] = __builtin_bit_cast(float, v[i]); }
        C.tokslot[(size_t)row * NE + e] = slot;
        nsel += __builtin_popcountll(msel); neq += __builtin_popcountll(meq);
    }
}
__device__ __forceinline__ void phase_select(const Ctx& C, bool need_ctx) {
    const int tid = tid_l(), lane = tid & 63, wave = __builtin_amdgcn_readfirstlane(tid >> 6), gw = blockIdx.x * NWV + wave, NGW = gridDim.x * NWV; (void)lane; (void)gw; (void)NGW;
    const int ntask = NB * NE * (need_ctx ? 2 : 1);
    for (int task = wave * (int)gridDim.x + (int)blockIdx.x; task < ntask; task += NGW) {
        const int set = task / (NB * NE), b = (task / NE) % NB, e = task % NE;
        if (set == 0) select_task<SEQ / 64>(C, b * SEQ, CAPL, e, e * SLOTS_E + b * CAPL, lane);
        else select_task<CTX / 64>(C, RL + b * CTX, CAPC, e, e * SLOTS_E + SLOTS_L + b * CAPC, lane);
    }
}
namespace att {
typedef float f32x16 __attribute__((ext_vector_type(16)));
typedef short v4i16_t __attribute__((ext_vector_type(4)));
typedef __bf16 bf16x2_t __attribute__((ext_vector_type(2)));
constexpr int KSTR = 144, VSTR = 192, TILE_B = 64 * KSTR, BUF_B = TILE_B + 64 * VSTR;
constexpr float THR = 8.0f, THR_LO = 32.0f;
__device__ __forceinline__ unsigned pk2(float a, float b) { bf16x2_t v = {(__bf16)a, (__bf16)b}; return __builtin_bit_cast(unsigned, v); }
__device__ __forceinline__ float xmax32(float x) { auto rr = __builtin_amdgcn_permlane32_swap(__float_as_uint(x), __float_as_uint(x), false, false); return fmaxf(__uint_as_float(rr[0]), __uint_as_float(rr[1])); }
__device__ __forceinline__ float xsum32(float x) { auto rr = __builtin_amdgcn_permlane32_swap(__float_as_uint(x), __float_as_uint(x), false, false); return __uint_as_float(rr[0]) + __uint_as_float(rr[1]); }
__device__ __forceinline__ int crow(int reg, int h) { return (reg & 3) + 8 * (reg >> 2) + 4 * h; }
#ifndef PROBE_ATT
#define PROBE_ATT 0
#endif
#define MFMA32(a, b, c) __builtin_amdgcn_mfma_f32_32x32x16_bf16((a), (b), (c), 0, 0, 0)
__device__ __forceinline__ void store_pair16(bf16_t* rowp, u32x2 a, u32x2 b, int h) {
    auto rx = __builtin_amdgcn_permlane32_swap(a.x, b.x, false, false); auto ry = __builtin_amdgcn_permlane32_swap(a.y, b.y, false, false);
    u32x4 w; w.x = rx[0]; w.y = ry[0]; w.z = rx[1]; w.w = ry[1];
    *(u32x4*)(rowp + 8 * h) = w;
}
__device__ __forceinline__ bf16x8 ones_rows(int lane) { const unsigned v = (lane == 0 || lane == 32 || lane == 17 || lane == 49) ? 0x3F803F80u : 0u; u32x4 w; w.x = v; w.y = v; w.z = v; w.w = v; return __builtin_bit_cast(bf16x8, w); }
__device__ __forceinline__ float rowsum(const f32x4& L, int lane) { const float a = __shfl(L[0], lane & 15), b = __shfl(L[1], lane & 15); return (lane & 16) ? b : a; }

#define ATT_VTR(n, ks, hi, db) "ds_read_b64_tr_b16 %" #n ", %16 offset:" #ks "*3072+" #hi "*1536+" #db "*64\n\t"
template <int DKS, bool WAIT>
__device__ __forceinline__ void katt_read(unsigned kb_, bf16x8 (&Kf)[8], int lane) {
    const int r = lane & 31, h = lane >> 5;
    const unsigned ka = kb_ + r * KSTR + 16 * h;
    constexpr int o1 = 32, o2 = (DKS == 4) ? 64 : 32 * KSTR, o3 = (DKS == 4) ? 96 : 32 * KSTR + 32, o4 = (DKS == 4) ? 32 * KSTR : 64, o5 = (DKS == 4) ? 32 * KSTR + 32 : 96,
                  o6 = 32 * KSTR + 64, o7 = 32 * KSTR + 96;
    if constexpr (WAIT)
        asm volatile("ds_read_b128 %0, %8\n\tds_read_b128 %1, %8 offset:%c9\n\tds_read_b128 %2, %8 offset:%c10\n\tds_read_b128 %3, %8 offset:%c11\n\t"
                     "ds_read_b128 %4, %8 offset:%c12\n\tds_read_b128 %5, %8 offset:%c13\n\tds_read_b128 %6, %8 offset:%c14\n\tds_read_b128 %7, %8 offset:%c15\n\ts_waitcnt lgkmcnt(0)"
                     : "=&v"(Kf[0]), "=&v"(Kf[1]), "=&v"(Kf[2]), "=&v"(Kf[3]), "=&v"(Kf[4]), "=&v"(Kf[5]), "=&v"(Kf[6]), "=&v"(Kf[7])
                     : "v"(ka), "i"(o1), "i"(o2), "i"(o3), "i"(o4), "i"(o5), "i"(o6), "i"(o7) : "memory");
    else
        asm volatile("ds_read_b128 %0, %8\n\tds_read_b128 %1, %8 offset:%c9\n\tds_read_b128 %2, %8 offset:%c10\n\tds_read_b128 %3, %8 offset:%c11\n\t"
                     "ds_read_b128 %4, %8 offset:%c12\n\tds_read_b128 %5, %8 offset:%c13\n\tds_read_b128 %6, %8 offset:%c14\n\tds_read_b128 %7, %8 offset:%c15"
                     : "=&v"(Kf[0]), "=&v"(Kf[1]), "=&v"(Kf[2]), "=&v"(Kf[3]), "=&v"(Kf[4]), "=&v"(Kf[5]), "=&v"(Kf[6]), "=&v"(Kf[7])
                     : "v"(ka), "i"(o1), "i"(o2), "i"(o3), "i"(o4), "i"(o5), "i"(o6), "i"(o7) : "memory");
}
__device__ __forceinline__ void katt_wait(bf16x8 (&Kf)[8]) {
    asm volatile("s_waitcnt lgkmcnt(0)" : "+v"(Kf[0]), "+v"(Kf[1]), "+v"(Kf[2]), "+v"(Kf[3]), "+v"(Kf[4]), "+v"(Kf[5]), "+v"(Kf[6]), "+v"(Kf[7]) :: "memory");
}
template <int NSUB, int DKS>
__device__ __forceinline__ void flash_tile(unsigned vb_, unsigned kn_, bool has_next, const bf16x8 (&Q)[NSUB][DKS], f32x16 (&O)[NSUB][2], float (&m)[NSUB], f32x4 (&L)[NSUB], const bf16x8& onesA,
                                           bf16x8 (&Kf)[8], int lane, bool masked, int dq, bool first) {
    static_assert(NSUB * DKS == 4, "eight K fragments per tile");
    const int r = lane & 31, h = lane >> 5; (void)r;
    f32x16 S[NSUB][2];
    bool allz = true;
#pragma unroll
    for (int sub = 0; sub < NSUB; ++sub) allz = allz && __all(m[sub] == 0.f);
    if (allz) {
#pragma unroll
        for (int sub = 0; sub < NSUB; ++sub)
#pragma unroll
            for (int kb = 0; kb < 2; ++kb) {
                const f32x16 zero = {0.f, 0.f, 0.f, 0.f, 0.f, 0.f, 0.f, 0.f, 0.f, 0.f, 0.f, 0.f, 0.f, 0.f, 0.f, 0.f};
                S[sub][kb] = MFMA32(Kf[(DKS == 4) ? (kb * 4) : (kb * 2 + 4 * sub)], Q[sub][0], zero);
#pragma unroll
                for (int s = 1; s < DKS; ++s) S[sub][kb] = MFMA32(Kf[(DKS == 4) ? (kb * 4 + s) : (kb * 2 + s + 4 * sub)], Q[sub][s], S[sub][kb]);
            }
    } else {
#pragma unroll
        for (int sub = 0; sub < NSUB; ++sub)
#pragma unroll
            for (int kb = 0; kb < 2; ++kb) {
#pragma unroll
                for (int i = 0; i < 16; ++i) S[sub][kb][i] = -m[sub];
#pragma unroll
                for (int s = 0; s < DKS; ++s) S[sub][kb] = MFMA32(Kf[(DKS == 4) ? (kb * 4 + s) : (kb * 2 + s + 4 * sub)], Q[sub][s], S[sub][kb]);
            }
    }
#pragma unroll
    for (int sub = 0; sub < NSUB; ++sub) asm volatile("" : "+v"(S[sub][0]), "+v"(S[sub][1]));
    v4i16_t Vr[16];
    { const int i16 = lane & 15, q = i16 >> 2, p = i16 & 3, rblk = (lane >> 4) & 1; const unsigned va = vb_ + (4 * h + q) * VSTR + (16 * rblk + 4 * p) * 2;
      asm volatile(ATT_VTR(0, 0, 0, 0) ATT_VTR(1, 0, 1, 0) ATT_VTR(2, 0, 0, 1) ATT_VTR(3, 0, 1, 1) ATT_VTR(4, 1, 0, 0) ATT_VTR(5, 1, 1, 0) ATT_VTR(6, 1, 0, 1) ATT_VTR(7, 1, 1, 1)
                   ATT_VTR(8, 2, 0, 0) ATT_VTR(9, 2, 1, 0) ATT_VTR(10, 2, 0, 1) ATT_VTR(11, 2, 1, 1) ATT_VTR(12, 3, 0, 0) ATT_VTR(13, 3, 1, 0) ATT_VTR(14, 3, 0, 1) ATT_VTR(15, 3, 1, 1)
                   : "=&v"(Vr[0]), "=&v"(Vr[1]), "=&v"(Vr[2]), "=&v"(Vr[3]), "=&v"(Vr[4]), "=&v"(Vr[5]), "=&v"(Vr[6]), "=&v"(Vr[7]),
                     "=&v"(Vr[8]), "=&v"(Vr[9]), "=&v"(Vr[10]), "=&v"(Vr[11]), "=&v"(Vr[12]), "=&v"(Vr[13]), "=&v"(Vr[14]), "=&v"(Vr[15])
                   : "v"(va) : "memory"); }
#pragma unroll
    for (int sub = 0; sub < NSUB; ++sub) {
        if (masked) {
#pragma unroll
            for (int kb = 0; kb < 2; ++kb)
#pragma unroll
                for (int i = 0; i < 16; ++i) { const int dl = dq - (32 * kb + crow(i, h)); S[sub][kb][i] = (dl > WINDOW || dl < -WINDOW) ? -1e30f : S[sub][kb][i]; }
        }
        float mx = S[sub][0][0];
#pragma unroll
        for (int i = 1; i < 16; ++i) mx = fmaxf(mx, S[sub][0][i]);
#pragma unroll
        for (int i = 0; i < 16; ++i) mx = fmaxf(mx, S[sub][1][i]);
        mx = xmax32(mx);
        if (!__all(mx <= THR) || (first && !__all(mx >= -THR_LO))) {
            const float up = first ? mx : fmaxf(mx, 0.f), alpha = first ? 1.0f : __builtin_amdgcn_exp2f(-up); m[sub] += up;
            L[sub][0] *= alpha; L[sub][1] *= __shfl(alpha, (lane & 15) + 16);
#pragma unroll
            for (int kb = 0; kb < 2; ++kb)
#pragma unroll
                for (int i = 0; i < 16; ++i) S[sub][kb][i] -= up;
#pragma unroll
            for (int db = 0; db < 2; ++db)
#pragma unroll
                for (int i = 0; i < 16; ++i) O[sub][db][i] *= alpha;
        }
#pragma unroll
        for (int kb = 0; kb < 2; ++kb)
#pragma unroll
            for (int i = 0; i < 16; ++i) S[sub][kb][i] = __builtin_amdgcn_exp2f(S[sub][kb][i]);
        bf16x8 Pf[4];
#pragma unroll
        for (int kb = 0; kb < 2; ++kb)
#pragma unroll
            for (int s = 0; s < 2; ++s) { u32x4 w; w.x = pk2(S[sub][kb][8 * s + 0], S[sub][kb][8 * s + 1]); w.y = pk2(S[sub][kb][8 * s + 2], S[sub][kb][8 * s + 3]);
                w.z = pk2(S[sub][kb][8 * s + 4], S[sub][kb][8 * s + 5]); w.w = pk2(S[sub][kb][8 * s + 6], S[sub][kb][8 * s + 7]); Pf[2 * kb + s] = __builtin_bit_cast(bf16x8, w); }
        if (sub == 0) {
            asm volatile("s_waitcnt lgkmcnt(0)" : "+v"(Vr[0]), "+v"(Vr[1]), "+v"(Vr[2]), "+v"(Vr[3]), "+v"(Vr[4]), "+v"(Vr[5]), "+v"(Vr[6]), "+v"(Vr[7]) :: "memory");
            asm volatile("" : "+v"(Vr[8]), "+v"(Vr[9]), "+v"(Vr[10]), "+v"(Vr[11]), "+v"(Vr[12]), "+v"(Vr[13]), "+v"(Vr[14]), "+v"(Vr[15]) :: "memory");
        }
        if (sub == NSUB - 1 && has_next) katt_read<DKS, false>(kn_, Kf, lane);
#pragma unroll
        for (int ks = 0; ks < 4; ++ks) {
#pragma unroll
            for (int db = 0; db < 2; ++db) {
                const bf16x8 vf = __builtin_shufflevector(Vr[(ks * 2 + db) * 2], Vr[(ks * 2 + db) * 2 + 1], 0, 1, 2, 3, 4, 5, 6, 7);
                O[sub][db] = MFMA32(vf, Pf[ks], O[sub][db]);
            }
            L[sub] = __builtin_amdgcn_mfma_f32_16x16x32_bf16(onesA, Pf[ks], L[sub], 0, 0, 0);
        }
#pragma unroll
        for (int db = 0; db < 2; ++db) asm volatile("" : "+v"(O[sub][db]));
    }
    if (has_next) katt_wait(Kf);
}
#define ATT_STG_LOAD2(krow0, KR, VR) do { const bf16_t* _p = C.P + (size_t)((krow0) + skey) * PROJ + 8 * schunk; KR = *(const u32x4*)(_p + kcol); VR = *(const u32x4*)(_p + vcol); } while (0)
#define ATT_STG_STORE2(buf, KR, VR) do { LAS unsigned char* _d = C.lds + (buf) * BUF_B + skey * KSTR + schunk * 16; *(LAS u32x4*)_d = KR; *(LAS u32x4*)(_d + TILE_B + skey * (VSTR - KSTR)) = VR; } while (0)
#define ATT_STG_LOAD(krow0) ATT_STG_LOAD2(krow0, kreg, vreg)
#define ATT_STG_STORE(buf) ATT_STG_STORE2(buf, kreg, vreg)
#define ATT_STG_STOREB(off) do { LAS unsigned char* _d = C.lds + (off) + skey * KSTR + schunk * 16; *(LAS u32x4*)_d = kreg; *(LAS u32x4*)(_d + TILE_B + skey * (VSTR - KSTR)) = vreg; } while (0)
#define ATT_PROLOGUE(DKS_) do { { u32x4 kreg2, vreg2; ATT_STG_LOAD(ATT_TROW(0)); ATT_STG_LOAD2(ATT_TROW(1), kreg2, vreg2); ATT_STG_STORE(0); ATT_STG_STORE2(1, kreg2, vreg2); } \
    if (nt > 2) ATT_STG_LOAD(ATT_TROW(2)); __syncthreads(); katt_read<DKS_, true>((unsigned)(size_t)C.lds, Kf, lane); } while (0)

__device__ __forceinline__ void phase_attnA(const Ctx& C, int l, bool need_ctx) {
    const int tid = tid_l(), lane = tid & 63, wave = __builtin_amdgcn_readfirstlane(tid >> 6), skey = tid >> 3, schunk = tid & 7;
    const int r = lane & 31, h = lane >> 5, hq = wave & 3, ph = wave >> 2;
    const bf16x8 onesA = ones_rows(lane);
    constexpr int NUL = NB * NKVA * (SEQ / 64), NUC = NB * NKVA * (CTX / 64);
    const int nu = NUL + (need_ctx ? NUC : 0);
    for (int u = blockIdx.x; u < nu; u += gridDim.x) {
        const bool lat = u < NUL; const int uu = lat ? u : u - NUL; const int nqb = lat ? SEQ / 64 : CTX / 64;
        const int b = uu / (NKVA * nqb), kvh = (uu / nqb) % NKVA, qb = uu % nqb, head = kvh * GQA + hq;
        const int kcol = C_KA + kvh * HDIM, vcol = C_VA + kvh * HDIM;
        const int q0 = 64 * qb + 32 * ph;
        const int qrow = (lat ? b * SEQ : RL + b * CTX) + q0 + r;
        const int jlo = lat ? (2 - qb > 0 ? 2 - qb : 0) : 0, jhi = lat ? (33 - qb < 4 ? 33 - qb : 4) : -1;
        const int nt = CTX / 64 + (jhi - jlo + 1);
        bf16x8 Q[1][4];
#pragma unroll
        for (int s = 0; s < 4; ++s) Q[0][s] = *(const bf16x8*)(C.P + (size_t)qrow * PROJ + C_QA + head * HDIM + 16 * s + 8 * h);
        f32x16 O[1][2]; float m[1]; f32x4 L[1];
#pragma unroll
        for (int db = 0; db < 2; ++db)
#pragma unroll
            for (int i = 0; i < 16; ++i) O[0][db][i] = 0.f;
        m[0] = 0.f; L[0] = f32x4{0.f, 0.f, 0.f, 0.f};
        u32x4 kreg, vreg;
#define ATT_TROW(i) ((i) < CTX / 64 ? RL + b * CTX + 64 * (i) : b * SEQ + 64 * qb - 128 + 64 * (jlo + (i) - CTX / 64))
        bf16x8 Kf[8];
        ATT_PROLOGUE(4);
        int s0 = 0, s1 = BUF_B, s2 = 2 * BUF_B;
        for (int i = 0; i < nt; ++i) {
            if (i + 2 < nt) ATT_STG_STOREB(s2);
            if (i + 3 < nt) ATT_STG_LOAD(ATT_TROW(i + 3));
            const bool loc = i >= CTX / 64; const int d = loc ? q0 - (64 * qb - 128 + 64 * (jlo + i - CTX / 64)) : 0;
            const bool masked = loc && (d > 97 || d < -65);
            const unsigned lb = (unsigned)(size_t)C.lds;
            flash_tile<1, 4>(lb + s0 + TILE_B, lb + s1, i + 1 < nt, Q, O, m, L, onesA, Kf, lane, masked, d + r, i == 0);
            __syncthreads();
            { const int t = s0; s0 = s1; s1 = s2; s2 = t; }
        }
#undef ATT_TROW
        const float inv = 1.0f / (rowsum(L[0], lane) + __builtin_amdgcn_exp2f(C.p.attn_sink[l * NHA + head] * LOG2E - m[0]));
        bf16_t* op = C.MIX + (size_t)qrow * D + head * HDIM;
#pragma unroll
        for (int db = 0; db < 2; ++db)
#pragma unroll
            for (int g = 0; g < 4; g += 2) { u32x2 w[2];
#pragma unroll
                for (int q = 0; q < 2; ++q) { w[q].x = pk2(O[0][db][4 * (g + q)] * inv, O[0][db][4 * (g + q) + 1] * inv); w[q].y = pk2(O[0][db][4 * (g + q) + 2] * inv, O[0][db][4 * (g + q) + 3] * inv); }
                store_pair16(op + 32 * db + 8 * g, w[0], w[1], h); }
    }
}
__device__ __forceinline__ void phase_attnD(const Ctx& C, int l, bool need_ctx) {
    const int tid = tid_l(), lane = tid & 63, wave = __builtin_amdgcn_readfirstlane(tid >> 6), skey = tid >> 3, schunk = tid & 7;
    const int r = lane & 31, h = lane >> 5;
    const bf16x8 onesA = ones_rows(lane);
    const float lam_init = 0.8f - 0.6f * expf(-0.3f * (float)l);
    float lam;
    { const float* lp = C.p.diff_lambda + l * 4 * DD; const float a = lane < DD ? lp[lane] * lp[DD + lane] : 0.f, b2 = lane < DD ? lp[2 * DD + lane] * lp[3 * DD + lane] : 0.f;
      lam = expf(wave_sum(a)) - expf(wave_sum(b2)) + lam_init; }
    constexpr int NUL = NB * NHC * (SEQ / 256), NUC = NB * NHC * (CTX / 256);
    const int nu = NUL + (need_ctx ? NUC : 0);
    for (int u = blockIdx.x; u < nu; u += gridDim.x) {
        const bool lat = u < NUL; const int uu = lat ? u : u - NUL; const int nqb = lat ? SEQ / 256 : CTX / 256;
        const int b = uu / (NHC * nqb), hd = (uu / nqb) % NHC, qb = uu % nqb;
        const int kcol = C_KD + hd * 2 * DD, vcol = C_VD + hd * 2 * DD;
        const int qrow = (lat ? b * SEQ : RL + b * CTX) + 256 * qb + 32 * wave + r;
        const int nt = CTX / 64 + (lat ? SEQ / 64 : 0);
        bf16x8 Q[2][2];
#pragma unroll
        for (int j = 0; j < 2; ++j)
#pragma unroll
            for (int s = 0; s < 2; ++s) Q[j][s] = *(const bf16x8*)(C.P + (size_t)qrow * PROJ + C_QD + hd * 2 * DD + j * DD + 16 * s + 8 * h);
        f32x16 O[2][2]; float m[2]; f32x4 L[2];
#pragma unroll
        for (int j = 0; j < 2; ++j) { m[j] = 0.f; L[j] = f32x4{0.f, 0.f, 0.f, 0.f};
#pragma unroll
            for (int db = 0; db < 2; ++db)
#pragma unroll
                for (int i = 0; i < 16; ++i) O[j][db][i] = 0.f; }
        u32x4 kreg, vreg;
#define ATT_TROW(i) ((i) < CTX / 64 ? RL + b * CTX + 64 * (i) : b * SEQ + 64 * ((i) - CTX / 64))
        bf16x8 Kf[8];
        ATT_PROLOGUE(2);
        int s0 = 0, s1 = BUF_B, s2 = 2 * BUF_B;
#if PROBE_ATT
        unsigned long long pT0 = __builtin_readcyclecounter(), ptw = 0, ptb = 0;
#endif
        for (int i = 0; i < nt; ++i) {
#if PROBE_ATT
            { const unsigned long long t1 = __builtin_readcyclecounter(); asm volatile("s_waitcnt vmcnt(0)" ::: "memory"); ptw += __builtin_readcyclecounter() - t1; }
#endif
            if (i + 2 < nt) ATT_STG_STOREB(s2);
            if (i + 3 < nt) ATT_STG_LOAD(ATT_TROW(i + 3));
            const unsigned lb = (unsigned)(size_t)C.lds;
            flash_tile<2, 2>(lb + s0 + TILE_B, lb + s1, i + 1 < nt, Q, O, m, L, onesA, Kf, lane, false, 0, i == 0);
#if PROBE_ATT
            { const unsigned long long t1 = __builtin_readcyclecounter(); __syncthreads(); ptb += __builtin_readcyclecounter() - t1; }
#else
            __syncthreads();
#endif
            { const int t = s0; s0 = s1; s1 = s2; s2 = t; }
        }
#if PROBE_ATT
        if (l == 1 && u == 100 && tid == 64 * 3) { const float T = (float)(__builtin_readcyclecounter() - pT0);
            ((float*)(C.p.ws + WS_CTL))[8] = PROBE_ATT == 1 ? 1.0e4f * (float)ptw / T : PROBE_ATT == 2 ? 1.0e4f * (float)ptb / T : T / (float)nt; }
#endif
#undef ATT_TROW
        const float i0 = 1.0f / rowsum(L[0], lane), i1 = lam / rowsum(L[1], lane);
        float ss = 0.f;
#pragma unroll
        for (int db = 0; db < 2; ++db)
#pragma unroll
            for (int i = 0; i < 16; ++i) { const float y = O[0][db][i] * i0 - O[1][db][i] * i1; O[0][db][i] = y; ss += y * y; }
        const float rn = (1.0f - lam_init) / sqrtf(xsum32(ss) * (1.0f / (2 * DD)) + EPS);
        const float* sw = C.p.diff_subln + l * 2 * DD + 4 * h;
        bf16_t* op = C.MIX + (size_t)qrow * D + 768 + hd * 2 * DD;
#pragma unroll
        for (int db = 0; db < 2; ++db)
#pragma unroll
            for (int g = 0; g < 4; g += 2) { u32x2 w[2];
#pragma unroll
                for (int q = 0; q < 2; ++q) { const f32x4 s4 = *(const f32x4*)(sw + 32 * db + 8 * (g + q));
                    w[q].x = pk2(O[0][db][4 * (g + q)] * rn * s4[0], O[0][db][4 * (g + q) + 1] * rn * s4[1]); w[q].y = pk2(O[0][db][4 * (g + q) + 2] * rn * s4[2], O[0][db][4 * (g + q) + 3] * rn * s4[3]); }
                store_pair16(op + 32 * db + 8 * g, w[0], w[1], h); }
    }
}
#undef ATT_STG_LOAD
#undef ATT_STG_STORE
#undef ATT_STG_LOAD2
#undef ATT_STG_STORE2
#undef ATT_STG_STOREB
#undef ATT_PROLOGUE
}
__device__ __forceinline__ void phase_conv(const Ctx& C, int l, int nq) {
    const int tid = tid_l();
    const float* cw = C.p.conv_w + l * 3 * CONV_CH;
    for (long g = (long)blockIdx.x * NT + tid; g < (long)(nq / 8) * (CONV_CH / 8); g += (long)gridDim.x * NT) {
        const int row0 = (int)(g / (CONV_CH / 8)) * 8, c8 = (int)(g % (CONV_CH / 8)) * 8;
        const bool lat = row0 < RL; const int t0 = lat ? row0 % SEQ : (row0 - RL) % CTX, len = lat ? SEQ : CTX;
        float u[10][8];
#pragma unroll
        for (int i = 0; i < 10; ++i) { const int tt = t0 + i - 1;
            if (tt >= 0 && tt < len) { const bf16_t* pr = C.P + (size_t)(row0 + i - 1) * PROJ + c8; const u32x4 a = *(const u32x4*)(pr + C_CIN), c = *(const u32x4*)(pr + C_CC);
#pragma unroll
                for (int k = 0; k < 4; ++k) { u[i][2 * k] = __builtin_bit_cast(float, a[k] << 16) * __builtin_bit_cast(float, c[k] << 16); u[i][2 * k + 1] = __builtin_bit_cast(float, a[k] & 0xffff0000u) * __builtin_bit_cast(float, c[k] & 0xffff0000u); } }
            else {
#pragma unroll
                for (int k = 0; k < 8; ++k) u[i][k] = 0.f; } }
        float w[3][8];
#pragma unroll
        for (int j = 0; j < 3; ++j) { const f32x4 w0 = *(const f32x4*)(cw + j * CONV_CH + c8), w1 = *(const f32x4*)(cw + j * CONV_CH + c8 + 4);
#pragma unroll
            for (int k = 0; k < 4; ++k) { w[j][k] = w0[k]; w[j][4 + k] = w1[k]; } }
#pragma unroll
        for (int i = 0; i < 8; ++i) { const u32x4 gb = *(const u32x4*)(C.P + (size_t)(row0 + i) * PROJ + C_CB + c8); u32x4 o;
#pragma unroll
            for (int k = 0; k < 4; ++k) { const float y0 = w[0][2 * k] * u[i][2 * k] + w[1][2 * k] * u[i + 1][2 * k] + w[2][2 * k] * u[i + 2][2 * k];
                const float y1 = w[0][2 * k + 1] * u[i][2 * k + 1] + w[1][2 * k + 1] * u[i + 1][2 * k + 1] + w[2][2 * k + 1] * u[i + 2][2 * k + 1];
                o[k] = att::pk2(__builtin_bit_cast(float, gb[k] << 16) * y0, __builtin_bit_cast(float, gb[k] & 0xffff0000u) * y1); }
            *(u32x4*)(C.MIX + (size_t)(row0 + i) * D + 512 + c8) = o; }
    }
}
#ifndef ATT_A
#define ATT_A 1
#endif
#ifndef ATT_D
#define ATT_D 1
#endif
__device__ __forceinline__ void phase_mix_naive(const Ctx& C, int l, int nq) {
    const int tid = tid_l(), lane = tid & 63, wave = __builtin_amdgcn_readfirstlane(tid >> 6), gw = blockIdx.x * NWV + wave, NGW = gridDim.x * NWV; (void)lane; (void)gw; (void)NGW;
    const long g0 = (long)blockIdx.x * NT + tid, gs = (long)gridDim.x * NT; const float lam_init = 0.8f - 0.6f * expf(-0.3f * (float)l);
#if !ATT_A
    for (long g = g0; g < (long)nq * NHA; g += gs) b_attnA(g, C.P, C.p.attn_sink + l * NHA, C.MIX, nq);
#endif
#if !ATT_D
    for (long g = g0; g < (long)nq * NHC * 2; g += gs) b_attnD(g, C.P, C.TMP, nq);
#endif
    (void)g0; (void)gs;
}
__device__ __forceinline__ void phase_diffpost_naive(const Ctx& C, int l, int nq) {
    const int tid = tid_l(), lane = tid & 63, wave = __builtin_amdgcn_readfirstlane(tid >> 6), gw = blockIdx.x * NWV + wave, NGW = gridDim.x * NWV; (void)lane; (void)gw; (void)NGW;
    const long g0 = (long)blockIdx.x * NT + tid, gs = (long)gridDim.x * NT; const float lam_init = 0.8f - 0.6f * expf(-0.3f * (float)l);
    for (long g = g0; g < (long)nq * NHC; g += gs) b_diffpost(g, C.TMP, C.p.diff_lambda + l * 4 * DD, C.p.diff_subln + l * 2 * DD, lam_init, C.MIX, nq);
}

#ifndef DBL
#define DBL 0
#endif
#define REP(bit) for (int _rep = 0; _rep < (((DBL) & (bit)) ? 2 : 1); ++_rep)
constexpr int CVT_PER_WAVE = 60;
constexpr int NPH = 9, PH_L0 = 2, PH_FINAL = PH_L0 + DEPTH * NPH, PH_TOTAL = PH_FINAL + 1;
__global__ void __launch_bounds__(NT, 2) mega_fwd(Args args) {
    extern __shared__ __attribute__((aligned(16))) unsigned char lds_raw[];
    Ctx C;
    { int w = __builtin_amdgcn_readfirstlane(threadIdx.x >> 6); asm volatile("" : "+s"(w)); C.wv = w; }
    C.p.x = args.in[0]; C.p.c = args.in[1]; C.p.ctx = args.in[2]; C.p.c_ctx = args.in[3]; C.p.w_ada = args.in[4]; C.p.b_ada = args.in[5]; C.p.norm1 = args.in[6]; C.p.norm2 = args.in[7];
    C.p.w_in = args.in[8]; C.p.w_out = args.in[9]; C.p.attn_sink = args.in[10]; C.p.conv_w = args.in[11]; C.p.diff_lambda = args.in[12]; C.p.diff_subln = args.in[13]; C.p.router = args.in[14];
    C.p.w_gate = args.in[15]; C.p.w_up = args.in[16]; C.p.w_down = args.in[17]; C.p.norm_final = args.in[18];
    C.p.out = args.out; C.p.ws = args.ws;
    C.lds = (LAS unsigned char*)lds_raw;
    unsigned char* ws = args.ws;
    C.tab = (float*)(ws + WS_TAB); C.mod = (float*)(ws + WS_MOD); C.aff = (float*)(ws + WS_AFF); C.sel = (int*)(ws + WS_SEL); C.gate = (float*)(ws + WS_GATE); C.tokslot = (int*)(ws + WS_TOKSLOT);
    C.xc = (float*)(ws + WS_XC); C.xl = args.out; C.win = (bf16_t*)(ws + WS_WIN); C.wout = (bf16_t*)(ws + WS_WOUT);
    C.P = (bf16_t*)(ws + WS_R1); C.H = (bf16_t*)(ws + WS_R1); C.Y = (bf16_t*)(ws + WS_R2); C.MIX = (bf16_t*)(ws + WS_R2); C.HX2 = (bf16_t*)(ws + WS_R2 + (size_t)RALL * D * 2); C.TMP = (float*)C.HX2;
    C.HX = (bf16_t*)(ws + WS_R3); C.XB = (bf16_t*)(ws + WS_XB);
    volatile LAS unsigned* misc = (volatile LAS unsigned*)(C.lds + LDS_MISC);
    { const int t0 = tid_l(); if (t0 < 64) misc[t0] = 0u; }
    __syncthreads();
    const int lo = args.ph_lo, hi = args.ph_hi;
    XcdBarrier bar; bar.bar = (unsigned*)(ws + WS_CTL) + CW_BAR; bar.x = 0; bar.st = misc; bar.wv = C.wv;
    if (hi - lo > 1) bar = xcd_barrier_post((unsigned*)(ws + WS_CTL) + CW_BAR, misc, C.wv);
#define IN(k) (lo <= (k) && (k) < hi)
#define SEAM(k) do { if (IN(k) && IN((k) + 1)) xcd_barrier(bar); } while (0)
    const int G = (int)gridDim.x, bid = (int)blockIdx.x;
    if (IN(0)) REP(512) phase_prologue(C);
    SEAM(0);
    if (IN(1)) phase_prologue_b(C);
    SEAM(1);
    for (int l = 0; l < DEPTH; ++l) {
        const int pb = PH_L0 + l * NPH; const bool need_ctx = l < DEPTH - 1; const int nq = need_ctx ? RALL : RL;
        const float* modl = C.mod + (size_t)l * (NB + 1) * 6 * D;
        const int nu1 = (RALL / 256) * (PROJ / 256), G1 = (nu1 + (nu1 + G - 1) / G - 1) / ((nu1 + G - 1) / G);
        const int nu4 = (nq / 256) * (D / 256), G4 = (nu4 + (nu4 + G - 1) / G - 1) / ((nu4 + G - 1) / G);
        const int cn1 = (G - G1) * NWV * CVT_PER_WAVE < CVT_ITEMS ? (G - G1) * NWV * CVT_PER_WAVE : CVT_ITEMS;
        const int cn4 = cn1 + (G - G4) * NWV * CVT_PER_WAVE < CVT_ITEMS ? cn1 + (G - G4) * NWV * CVT_PER_WAVE : CVT_ITEMS;
        if (IN(pb + 0)) { { const int wv_ = C.wv; REP(256) phase_cvt_experts(C, l, cn4, CVT_ITEMS, bid * NWV + wv_, G * NWV); } if (l == 0) phase_rowA<false, true>(C, 0); else phase_rowA<false, false>(C, l); if ((DBL) & 1024) { if (l == 0) phase_rowA<false, true>(C, 0); else phase_rowA<false, false>(C, l, 0.0f); } }
        SEAM(pb + 0);
        if (IN(pb + 1)) { if (bid < G1) { pg::GemmD g{(const char*)C.HX, nullptr, (const char*)C.win + (size_t)l * PROJ * D, 0, D / 2}; pg::Order S; S.init(RALL / 256, PROJ / 256, G1, bid, 0);
            pg::EpiP E{C.P, C.tab, (const float*)(ws + WS_HXS), (const float*)(ws + WS_CTL + CTL_WINMAX) + l * 256}; REP(1) pg::gemm_phase<pg::EpiP, false, 2>(C.lds, g, S, E, C.wv); }
            else phase_cvt_experts(C, l, 0, cn1, (bid - G1) * NWV + C.wv, (G - G1) * NWV); }
        SEAM(pb + 1);
        if (IN(pb + 2)) {
#if ATT_A
            REP(2) att::phase_attnA(C, l, need_ctx);
#endif
#if ATT_D
            REP(4) att::phase_attnD(C, l, need_ctx);
#endif
            phase_mix_naive(C, l, nq); REP(128) phase_conv(C, l, nq); }
        SEAM(pb + 2);
#if !ATT_D
        if (IN(pb + 3)) phase_diffpost_naive(C, l, nq);
        SEAM(pb + 3);
#endif
        if (IN(pb + 4)) { if (bid < G4) { pg::GemmD g{(const char*)C.MIX, nullptr, (const char*)(C.wout + (size_t)l * D * D), 0, D}; pg::Order S; S.init(nq / 256, D / 256, G4, bid, 0);
            pg::EpiX E{C.XB, modl, 1.0f}; pg::gemm_phase<pg::EpiX, false>(C.lds, g, S, E, C.wv);
            if ((DBL) & 2048) { pg::EpiX E0{C.XB, modl, 0.0f}; pg::gemm_phase<pg::EpiX, false>(C.lds, g, S, E0, C.wv); } }
            else phase_cvt_experts(C, l, cn1, cn4, (bid - G4) * NWV + C.wv, (G - G4) * NWV); }
        SEAM(pb + 4);
        if (IN(pb + 5)) REP(8) phase_rowB(C, l, nq);
        SEAM(pb + 5);
        if (IN(pb + 6)) REP(16) phase_select(C, need_ctx);
        SEAM(pb + 6);
        const int tpe = need_ctx ? pg::TPE_FULL : SLOTS_L / 256;
        if (IN(pb + 7)) { pg::GemmD g{(const char*)C.HX2, C.sel, (const char*)(ws + WS_WGU + (size_t)(l & 1) * NE * 2 * FF * D), (size_t)2 * FF * D, D / 2}; pg::Order S; S.init(NE * tpe, 2 * FF / 256, G, bid, tpe);
            pg::EpiH E{(unsigned char*)C.H}; REP(32) pg::gemm_phase<pg::EpiH, true, 1>(C.lds, g, S, E, C.wv); }
        SEAM(pb + 7);
        if (IN(pb + 8)) { pg::GemmD g{(const char*)C.H, nullptr, (const char*)(ws + WS_WD + (size_t)(l & 1) * NE * D * FF), (size_t)D * FF, FF / 2}; pg::Order S; S.init(NE * tpe, D / 256, G, bid, tpe);
            pg::EpiY E{(unsigned char*)C.Y, C.gate}; REP(64) pg::gemm_phase<pg::EpiY, false, 1>(C.lds, g, S, E, C.wv); }
        SEAM(pb + 8);
    }
    if (IN(PH_FINAL)) phase_rowA<true, false>(C, DEPTH);
#if PROBE_ATT
    if (hi - lo > 1) xcd_barrier(bar);
    if (bid == 100 && tid_l() == 0) { asm volatile("s_waitcnt vmcnt(0)" ::: "memory"); C.p.out[0] = ((const float*)(C.p.ws + WS_CTL))[8]; }
#endif
#undef IN
#undef SEAM
}
#endif

#ifndef HOST_TEST
#ifndef MODE
#define MODE 2
#endif
extern "C" void kernel_launch(void* const* d_in, const int* in_sizes, int n_in, void* d_out, int out_size, void* d_ws, size_t ws_size, hipStream_t stream) {
    if (n_in != 19 || out_size != RL * D || ws_size < WS_END) { fprintf(stderr, "kernel_launch: unexpected shapes (n_in %d out %d ws %zu need %zu)\n", n_in, out_size, ws_size, (size_t)WS_END); return; }
#if MODE == 0
    Ptrs p{};
    const float** f = (const float**)&p;
    for (int i = 0; i < 19; ++i) f[i] = (const float*)d_in[i];
    p.out = (float*)d_out; p.ws = (unsigned char*)d_ws;
    forward(p, stream);
#else
    static int grid = 0;
    if (grid == 0) {
        int dev = 0, cus = 0;
        if (hipGetDevice(&dev) != hipSuccess || hipDeviceGetAttribute(&cus, hipDeviceAttributeMultiprocessorCount, dev) != hipSuccess) { fprintf(stderr, "kernel_launch: device query failed\n"); grid = -1; return; }
        if (hipFuncSetAttribute((const void*)mega_fwd, hipFuncAttributeMaxDynamicSharedMemorySize, LDS_BYTES) != hipSuccess) { fprintf(stderr, "kernel_launch: hipFuncSetAttribute failed\n"); grid = -1; return; }
        int per_cu = 0;
        if (hipOccupancyMaxActiveBlocksPerMultiprocessor(&per_cu, (const void*)mega_fwd, NT, LDS_BYTES) != hipSuccess || per_cu < 1) fprintf(stderr, "kernel_launch: occupancy query reports %d blocks per CU\n", per_cu);
        (void)hipGetLastError();
        grid = cus;
    }
    if (grid < 0) return;
    if (hipMemsetAsync((char*)d_ws + WS_CTL, 0, CTL_BYTES, stream) != hipSuccess) { fprintf(stderr, "kernel_launch: memset failed\n"); return; }
    Args a{};
    for (int i = 0; i < 19; ++i) a.in[i] = (const float*)d_in[i];
    a.out = (float*)d_out; a.ws = (unsigned char*)d_ws;
#if MODE == 2
    a.ph_lo = 0; a.ph_hi = PH_TOTAL;
    hipLaunchKernelGGL(mega_fwd, dim3(grid), dim3(NT), LDS_BYTES, stream, a);
#else
    for (int ph = 0; ph < PH_TOTAL; ++ph) { a.ph_lo = ph; a.ph_hi = ph + 1; hipLaunchKernelGGL(mega_fwd, dim3(grid), dim3(NT), LDS_BYTES, stream, a); }
#endif
    const hipError_t le = hipPeekAtLastError();
    if (le != hipSuccess) fprintf(stderr, "kernel_launch: launch failed: %s\n", hipGetErrorName(le));
#endif
}
#else
#include <vector>
#include <string>
static std::vector<float> rd(const std::string& fn) { FILE* f = fopen(fn.c_str(), "rb"); if (!f) { perror(fn.c_str()); exit(1); } fseek(f, 0, SEEK_END); long n = ftell(f); fseek(f, 0, SEEK_SET); std::vector<float> v(n / 4); if (fread(v.data(), 1, n, f) != (size_t)n) exit(1); fclose(f); return v; }
int main(int argc, char** argv) {
    std::string dir = argv[1]; std::vector<std::vector<float>> in(19);
    for (int i = 0; i < 19; ++i) in[i] = rd(dir + "/in" + std::to_string(i) + ".bin");
    std::vector<float> out((size_t)RL * D); std::vector<unsigned char> ws(WS_END, 0xAA);
    Ptrs p{}; const float** f = (const float**)&p; for (int i = 0; i < 19; ++i) f[i] = in[i].data();
    p.out = out.data(); p.ws = ws.data();
    forward(p, 0);
    FILE* fo = fopen((dir + "/out.bin").c_str(), "wb"); fwrite(out.data(), 4, out.size(), fo); fclose(fo);
    printf("done, ws bytes %zu\n", (size_t)WS_END); return 0;
}
#endif
```

```cpp
#ifndef HOST_TEST
#include <hip/hip_runtime.h>
#endif
#include <cstdio>
#include <cstdint>
#include <cstring>
#include <cmath>

#ifndef CFG_B
#define CFG_B 32
#endif
#ifndef CFG_SEQ
#define CFG_SEQ 2048
#endif
#ifndef CFG_CTX
#define CFG_CTX 256
#endif
#ifndef CFG_DEPTH
#define CFG_DEPTH 4
#endif
constexpr int D = 1024, NB = CFG_B, SEQ = CFG_SEQ, CTX = CFG_CTX, DEPTH = CFG_DEPTH;
constexpr int GRID_W = 64, NROWS = SEQ / GRID_W, HDIM = 64, NHA = 8, NKVA = 2, GQA = 4, WINDOW = 128;
constexpr int CONV_CH = 256, DD = 32, NHC = 4, NE = 16, FF = 1024, PROJ = 2304;
constexpr int RL = NB * SEQ, RC = NB * CTX, RALL = RL + RC;
constexpr int CAPL = 2 * SEQ / NE, CAPC = 2 * CTX / NE;
constexpr int SLOTS_L = NB * CAPL, SLOTS_C = NB * CAPC, SLOTS_E = SLOTS_L + SLOTS_C;
constexpr int NSLOT = NE * SLOTS_E;
constexpr int C_QA = 0, C_KA = 512, C_VA = 640, C_CIN = 768, C_CB = 1024, C_CC = 1280, C_QD = 1536, C_KD = 1792, C_VD = 2048;
constexpr int M_SH1 = 0, M_SC1 = D, M_G1 = 2 * D, M_SH2 = 3 * D, M_SC2 = 4 * D, M_G2 = 5 * D;
constexpr float EPS = 1e-6f, LOG2E = 1.4426950408889634f;
constexpr float QSCALE_A = 0.125f * LOG2E, QSCALE_D = 0.17677669529663687f * LOG2E;

#ifdef HOST_TEST
#define HD
#define KERNEL static void
static thread_local long g_gid;
#define GID g_gid
#include <omp.h>
#define LAUNCH(kern, nthreads, ...) do { const long _n = (long)(nthreads); _Pragma("omp parallel for schedule(static)") for (long _g = 0; _g < _n; ++_g) { g_gid = _g; kern(__VA_ARGS__); } } while (0)
#else
#define HD __host__ __device__ __forceinline__
#define KERNEL __global__ void __launch_bounds__(256)
#define GID ((long)blockIdx.x * blockDim.x + threadIdx.x)
#define LAUNCH(kern, nthreads, ...) do { const long _n = (long)(nthreads); if (_n > 0) hipLaunchKernelGGL(kern, dim3((unsigned)((_n + 255) / 256)), dim3(256), 0, stream, __VA_ARGS__); } while (0)
#endif

typedef unsigned short bf16_t;
HD float bf2f(bf16_t v) { unsigned u = (unsigned)v << 16; return __builtin_bit_cast(float, u); }
HD bf16_t f2bf(float f) { unsigned u = __builtin_bit_cast(unsigned, f); return (bf16_t)((u + 0x7fffu + ((u >> 16) & 1u)) >> 16); }

constexpr size_t al256(size_t x) { return (x + 255) & ~(size_t)255; }
constexpr size_t WS_CTL = 0, CTL_BYTES = 1u << 20;
constexpr size_t WS_TAB = WS_CTL + CTL_BYTES;
constexpr int T_AROW = 0, T_ACOL = T_AROW + NROWS * 16 * 2, T_DROW = T_ACOL + 64 * 16 * 2, T_DCOL = T_DROW + NROWS * 8 * 2, T_END = T_DCOL + 64 * 8 * 2;
constexpr size_t WS_SILU = WS_TAB + al256((size_t)T_END * 4);
constexpr size_t WS_MOD = WS_SILU + al256((size_t)(NB + 1) * D * 4);
constexpr size_t WS_RSTD = WS_MOD + al256((size_t)DEPTH * (NB + 1) * 6 * D * 4);
constexpr size_t WS_AFF = WS_RSTD + al256((size_t)RALL * 4);
constexpr size_t WS_SEL = WS_AFF + al256((size_t)RALL * NE * 4);
constexpr size_t WS_GATE = WS_SEL + al256((size_t)NSLOT * 4);
constexpr size_t WS_TOKSLOT = WS_GATE + al256((size_t)NSLOT * 4);
constexpr size_t WS_XC = WS_TOKSLOT + al256((size_t)RALL * NE * 4);
constexpr size_t WS_WIN = WS_XC + al256((size_t)RC * D * 4);
constexpr size_t WS_WOUT = WS_WIN + al256((size_t)DEPTH * PROJ * D * 2);
constexpr size_t WS_WGU = WS_WOUT + al256((size_t)DEPTH * D * D * 2);
constexpr size_t WS_WD = WS_WGU + al256((size_t)2 * NE * 2 * FF * D * 2);
constexpr size_t WS_R1 = WS_WD + al256((size_t)2 * NE * D * FF * 2);
constexpr size_t R1_BYTES = al256(((size_t)RALL * PROJ * 2 > (size_t)NSLOT * FF * 2) ? (size_t)RALL * PROJ * 2 : (size_t)NSLOT * FF * 2);
constexpr size_t WS_R2 = WS_R1 + R1_BYTES;
constexpr size_t R2_BYTES = al256(((size_t)NSLOT * D * 2 > (size_t)2 * RALL * D * 2) ? (size_t)NSLOT * D * 2 : (size_t)2 * RALL * D * 2);
constexpr size_t WS_R3 = WS_R2 + R2_BYTES;
constexpr size_t WS_XB = WS_R3 + al256((size_t)RALL * D * 2);
constexpr size_t WS_HXS = WS_XB + al256((size_t)RALL * D * 2);
constexpr size_t WS_END = WS_HXS + al256((size_t)RALL * 4);
constexpr size_t CTL_WINMAX = 262144;

struct Ptrs {
    const float *x, *c, *ctx, *c_ctx, *w_ada, *b_ada, *norm1, *norm2, *w_in, *w_out, *attn_sink, *conv_w, *diff_lambda, *diff_subln, *router, *w_gate, *w_up, *w_down, *norm_final;
    float* out; unsigned char* ws;
};

HD float* xrow_ptr(float* xl, float* xc, int row) { return row < RL ? xl + (size_t)row * D : xc + (size_t)(row - RL) * D; }
HD int row_batch(int row) { return row < RL ? row / SEQ : NB; }
HD float silu_f(float v) { return v / (1.0f + expf(-v)); }

KERNEL k_tables(float* tab) {
    const long g = GID; if (g >= (long)(NROWS + 64) * 24) return;
    const int pos = (int)(g / 24), f = (int)(g % 24);
    const double inv = f < 16 ? pow(10000.0, -(2.0 * f) / 32.0) : pow(10000.0, -(2.0 * (f - 16)) / 16.0);
    const bool isrow = pos < NROWS; const int p = isrow ? pos : pos - NROWS;
    const double ang = (double)p * inv; const float cs = (float)cos(ang), sn = (float)sin(ang);
    int idx;
    if (f < 16) idx = (isrow ? T_AROW : T_ACOL) + (p * 16 + f) * 2; else idx = (isrow ? T_DROW : T_DCOL) + (p * 8 + (f - 16)) * 2;
    tab[idx] = cs; tab[idx + 1] = sn;
}
KERNEL k_silu(const float* c, const float* c_ctx, float* out) {
    const long g = GID; if (g >= (long)(NB + 1) * D) return;
    const int b = (int)(g / D), k = (int)(g % D); const float v = b < NB ? c[b * D + k] : c_ctx[k];
    out[g] = silu_f(v);
}
KERNEL k_mod(const float* silu, const float* w_ada, const float* b_ada, float* mod) {
    const long g = GID; if (g >= (long)DEPTH * 6 * D) return;
    const int l = (int)(g / (6 * D)), j = (int)(g % (6 * D));
    float acc[NB + 1];
#pragma unroll
    for (int b = 0; b <= NB; ++b) acc[b] = 0.f;
    const float* w = w_ada + (size_t)l * D * 6 * D + j;
    for (int k = 0; k < D; ++k) { const float wv = w[(size_t)k * 6 * D];
#pragma unroll
        for (int b = 0; b <= NB; ++b) acc[b] += silu[b * D + k] * wv; }
    const float bias = b_ada[l * 6 * D + j];
#pragma unroll
    for (int b = 0; b <= NB; ++b) mod[((size_t)l * (NB + 1) + b) * 6 * D + j] = acc[b] + bias;
}
HD int permA(int p) { return (p / 32) * 32 + (p % 32) / 2 + 16 * (p % 2); }
HD int permD(int p) { return (p / 16) * 16 + (p % 16) / 2 + 8 * (p % 2); }
HD int inproj_src_col(int n) {
    if (n < C_VA) return (n / 64) * 64 + permA(n % 64);
    if (n < C_QD) return n;
    if (n < C_VD) return (n / 32) * 32 + permD(n % 32);
    return n;
}
KERNEL k_cvt_win(const float* w_in, bf16_t* wt) {
    const long g = GID; if (g >= (long)DEPTH * PROJ * D) return;
    const int k = (int)(g % D); const int n = (int)((g / D) % PROJ); const int l = (int)(g / ((long)D * PROJ));
    wt[g] = f2bf(w_in[((size_t)l * D + k) * PROJ + inproj_src_col(n)]);
}
KERNEL k_cvt_t(const float* w, bf16_t* wt, int nmat, int K, int N) {
    const long g = GID; if (g >= (long)nmat * K * N) return;
    const int k = (int)(g % K); const int n = (int)((g / K) % N); const int m = (int)(g / ((long)K * N));
    wt[g] = f2bf(w[((size_t)m * K + k) * N + n]);
}
KERNEL k_cvt_gu(const float* wg, const float* wu, bf16_t* wt) {
    const long g = GID; if (g >= (long)NE * 2 * FF * D) return;
    const int k = (int)(g % D); const int n = (int)((g / D) % (2 * FF)); const int e = (int)(g / ((long)D * 2 * FF));
    const int blk = n / 256, bj = (n % 256) / 128, j = n % 128; const float* src = bj ? wu : wg;
    wt[g] = f2bf(src[((size_t)e * D + k) * FF + blk * 128 + j]);
}
KERNEL k_rowstat(const float* xl, const float* xc, float* rstd, int nrows) {
    const long g = GID; if (g >= nrows) return;
    const float* xr = xrow_ptr((float*)xl, (float*)xc, (int)g); float s = 0.f;
    for (int k = 0; k < D; ++k) s += xr[k] * xr[k];
    rstd[g] = 1.0f / sqrtf(s / D + EPS);
}
KERNEL k_rowapply(const float* xl, const float* xc, const float* rstd, const float* nw, const float* modl, int sh_off, int sc_off, bf16_t* hx, int nrows) {
    const long g = GID; if (g >= (long)nrows * D) return;
    const int row = (int)(g / D), k = (int)(g % D); const float* xr = xrow_ptr((float*)xl, (float*)xc, row);
    const float* m = modl + (size_t)row_batch(row) * 6 * D;
    const float v = xr[k] * rstd[row] * nw[k] * (1.0f + m[sc_off + k]) + m[sh_off + k];
    hx[g] = f2bf(v);
}
struct EpiInProj {
    bf16_t* P; const float* tab;
    HD void operator()(int row, int c0, const float* v, const float*) const {
        float o[4] = {v[0], v[1], v[2], v[3]};
        const bool lat = row < RL; const int pos = lat ? row % SEQ : 0; const int gr = pos / GRID_W, gc = pos % GRID_W;
        if (c0 < C_VA) {
            if (lat) { const int p = c0 % 64, grp = p / 32, i0 = (p % 32) / 2;
                const float* t = tab + (grp == 0 ? T_AROW + gr * 32 : T_ACOL + gc * 32) + i0 * 2;
                const float a0 = o[0], b0 = o[1], a1 = o[2], b1 = o[3];
                o[0] = a0 * t[0] - b0 * t[1]; o[1] = b0 * t[0] + a0 * t[1]; o[2] = a1 * t[2] - b1 * t[3]; o[3] = b1 * t[2] + a1 * t[3]; }
            if (c0 < C_KA) { for (int j = 0; j < 4; ++j) o[j] *= QSCALE_A; }
        } else if (c0 >= C_QD && c0 < C_VD) {
            if (lat) { const int p = c0 % 32, grp = p / 16, i0 = (p % 16) / 2;
                const float* t = tab + (grp == 0 ? T_DROW + gr * 16 : T_DCOL + gc * 16) + i0 * 2;
                const float a0 = o[0], b0 = o[1], a1 = o[2], b1 = o[3];
                o[0] = a0 * t[0] - b0 * t[1]; o[1] = b0 * t[0] + a0 * t[1]; o[2] = a1 * t[2] - b1 * t[3]; o[3] = b1 * t[2] + a1 * t[3]; }
            if (c0 < C_KD) { for (int j = 0; j < 4; ++j) o[j] *= QSCALE_D; }
        }
        bf16_t* d = P + (size_t)row * PROJ + c0;
        for (int j = 0; j < 4; ++j) d[j] = f2bf(o[j]);
    }
};
struct EpiOutProj {
    float* xl; float* xc; const float* modl;
    HD void operator()(int row, int c0, const float* v, const float*) const {
        float* xr = xrow_ptr(xl, xc, row) + c0; const float* g1 = modl + (size_t)row_batch(row) * 6 * D + M_G1 + c0;
        for (int j = 0; j < 4; ++j) xr[j] += g1[j] * v[j];
    }
};
struct EpiGateUp {
    bf16_t* H;
    HD void operator()(int row, int c0, const float* v, const float* u) const {
        bf16_t* d = H + (size_t)row * FF + c0;
        for (int j = 0; j < 4; ++j) d[j] = f2bf(silu_f(v[j]) * u[j]);
    }
};
struct EpiDown {
    bf16_t* Y; const float* gate;
    HD void operator()(int row, int c0, const float* v, const float*) const {
        const float g = gate[row]; bf16_t* d = Y + (size_t)row * D + c0;
        for (int j = 0; j < 4; ++j) d[j] = f2bf(v[j] * g);
    }
};
template <class Epi, bool DUAL>
KERNEL k_gemm_naive(const bf16_t* A, const int* rowidx, const bf16_t* Bt, int M, int N, int K, int group_rows, int valid_rows, long bstride, Epi epi) {
    const long g = GID; if (g >= (long)M * (N / 4)) return;
    const int row = (int)(g / (N / 4)), c0 = (int)(g % (N / 4)) * 4;
    if (row % group_rows >= valid_rows) return;
    const int arow = rowidx ? rowidx[row] : row;
    const bf16_t* a = A + (size_t)arow * K; const bf16_t* B = Bt + (size_t)(row / group_rows) * bstride;
    float v[4], u[4];
    for (int j = 0; j < 4; ++j) { const int c = c0 + j; const int br = DUAL ? (c / 128) * 256 + c % 128 : c;
        const bf16_t* b0 = B + (size_t)br * K; float s = 0.f, s2 = 0.f;
        for (int k = 0; k < K; ++k) s += bf2f(a[k]) * bf2f(b0[k]);
        if (DUAL) { const bf16_t* b1 = b0 + (size_t)128 * K; for (int k = 0; k < K; ++k) s2 += bf2f(a[k]) * bf2f(b1[k]); }
        v[j] = s; u[j] = s2; }
    epi(row, c0, v, u);
}
HD void b_attnA(const long g, const bf16_t* P, const float* sink, bf16_t* MIX, int nrows) {
    if (g >= (long)nrows * NHA) return;
    const int h = (int)(g / nrows), row = (int)(g % nrows), kvh = h / GQA;
    const bool lat = row < RL; const int b = lat ? row / SEQ : (row - RL) / CTX; const int t = lat ? row % SEQ : 0;
    float q[HDIM], o[HDIM];
    const bf16_t* qp = P + (size_t)row * PROJ + C_QA + h * HDIM;
#pragma unroll
    for (int d = 0; d < HDIM; ++d) { q[d] = bf2f(qp[d]); o[d] = 0.f; }
    float m = sink[h] * LOG2E, l = 1.0f;
    const int nctx = CTX, lo = lat ? (t - WINDOW < 0 ? 0 : t - WINDOW) : 0, hi = lat ? (t + WINDOW > SEQ - 1 ? SEQ - 1 : t + WINDOW) : -1;
    const int nkeys = nctx + (hi - lo + 1);
    for (int i = 0; i < nkeys; ++i) {
        const int krow = i < nctx ? RL + b * CTX + i : b * SEQ + lo + (i - nctx);
        const bf16_t* kp = P + (size_t)krow * PROJ + C_KA + kvh * HDIM; const bf16_t* vp = P + (size_t)krow * PROJ + C_VA + kvh * HDIM;
        float s = 0.f;
#pragma unroll
        for (int d = 0; d < HDIM; ++d) s += q[d] * bf2f(kp[d]);
        if (s > m) { const float sc = exp2f(m - s); l *= sc;
#pragma unroll
            for (int d = 0; d < HDIM; ++d) o[d] *= sc;
            m = s; }
        const float p = exp2f(s - m); l += p;
#pragma unroll
        for (int d = 0; d < HDIM; ++d) o[d] += p * bf2f(vp[d]);
    }
    const float inv = 1.0f / l; bf16_t* op = MIX + (size_t)row * D + h * HDIM;
#pragma unroll
    for (int d = 0; d < HDIM; ++d) op[d] = f2bf(o[d] * inv);
}
KERNEL k_attnA(const bf16_t* P, const float* sink, bf16_t* MIX, int nrows) { b_attnA(GID, P, sink, MIX, nrows); }
HD void b_attnD(const long g, const bf16_t* P, float* TMP, int nrows) {
    if (g >= (long)nrows * NHC * 2) return;
    const int hc = (int)(g / nrows), row = (int)(g % nrows), h = hc / 2, comp = hc % 2;
    const bool lat = row < RL; const int b = lat ? row / SEQ : (row - RL) / CTX;
    float q[DD], o[2 * DD];
    const bf16_t* qp = P + (size_t)row * PROJ + C_QD + h * 2 * DD + comp * DD;
#pragma unroll
    for (int d = 0; d < DD; ++d) q[d] = bf2f(qp[d]);
#pragma unroll
    for (int d = 0; d < 2 * DD; ++d) o[d] = 0.f;
    float m = -1e30f, l = 0.f;
    const int nkeys = CTX + (lat ? SEQ : 0);
    for (int i = 0; i < nkeys; ++i) {
        const int krow = i < CTX ? RL + b * CTX + i : b * SEQ + (i - CTX);
        const bf16_t* kp = P + (size_t)krow * PROJ + C_KD + h * 2 * DD + comp * DD; const bf16_t* vp = P + (size_t)krow * PROJ + C_VD + h * 2 * DD;
        float s = 0.f;
#pragma unroll
        for (int d = 0; d < DD; ++d) s += q[d] * bf2f(kp[d]);
        if (s > m) { const float sc = exp2f(m - s); l *= sc;
#pragma unroll
            for (int d = 0; d < 2 * DD; ++d) o[d] *= sc;
            m = s; }
        const float p = exp2f(s - m); l += p;
#pragma unroll
        for (int d = 0; d < 2 * DD; ++d) o[d] += p * bf2f(vp[d]);
    }
    const float inv = 1.0f / l; float* op = TMP + (((size_t)row * NHC + h) * 2 + comp) * 2 * DD;
#pragma unroll
    for (int d = 0; d < 2 * DD; ++d) op[d] = o[d] * inv;
}
KERNEL k_attnD(const bf16_t* P, float* TMP, int nrows) { b_attnD(GID, P, TMP, nrows); }
HD void b_diffpost(const long g, const float* TMP, const float* lam_p, const float* subln, float lam_init, bf16_t* MIX, int nrows) {
    if (g >= (long)nrows * NHC) return;
    const int row = (int)(g / NHC), h = (int)(g % NHC);
    float s01 = 0.f, s23 = 0.f;
    for (int d = 0; d < DD; ++d) { s01 += lam_p[d] * lam_p[DD + d]; s23 += lam_p[2 * DD + d] * lam_p[3 * DD + d]; }
    const float lam = expf(s01) - expf(s23) + lam_init;
    const float* t = TMP + ((size_t)row * NHC + h) * 2 * 2 * DD; float y[2 * DD]; float ss = 0.f;
#pragma unroll
    for (int d = 0; d < 2 * DD; ++d) { y[d] = t[d] - lam * t[2 * DD + d]; ss += y[d] * y[d]; }
    const float r = 1.0f / sqrtf(ss / (2 * DD) + EPS) * (1.0f - lam_init);
    bf16_t* op = MIX + (size_t)row * D + 768 + h * 2 * DD;
#pragma unroll
    for (int d = 0; d < 2 * DD; ++d) op[d] = f2bf(y[d] * r * subln[d]);
}
KERNEL k_diffpost(const float* TMP, const float* lam_p, const float* subln, float lam_init, bf16_t* MIX, int nrows) { b_diffpost(GID, TMP, lam_p, subln, lam_init, MIX, nrows); }
HD void b_conv(const long g, const bf16_t* P, const float* cw, bf16_t* MIX, int nrows) {
    if (g >= (long)nrows * CONV_CH) return;
    const int row = (int)(g / CONV_CH), ch = (int)(g % CONV_CH);
    const bool lat = row < RL; const int t = lat ? row % SEQ : (row - RL) % CTX, len = lat ? SEQ : CTX;
    float y = 0.f;
    for (int j = 0; j < 3; ++j) { const int tt = t + j - 1; if (tt < 0 || tt >= len) continue;
        const bf16_t* pr = P + (size_t)(row + j - 1) * PROJ; y += cw[j * CONV_CH + ch] * (bf2f(pr[C_CC + ch]) * bf2f(pr[C_CIN + ch])); }
    MIX[(size_t)row * D + 512 + ch] = f2bf(bf2f(P[(size_t)row * PROJ + C_CB + ch]) * y);
}
KERNEL k_conv(const bf16_t* P, const float* cw, bf16_t* MIX, int nrows) { b_conv(GID, P, cw, MIX, nrows); }
KERNEL k_router(const float* xl, const float* xc, const float* rstd, const float* nw, const float* modl, const float* router, float* logits, int nrows) {
    const long g = GID; if (g >= (long)nrows * NE) return;
    const int row = (int)(g / NE), e = (int)(g % NE); const float* xr = xrow_ptr((float*)xl, (float*)xc, row);
    const float* m = modl + (size_t)row_batch(row) * 6 * D; const float rs = rstd[row]; float s = 0.f;
    for (int k = 0; k < D; ++k) { const float v = xr[k] * rs * nw[k] * (1.0f + m[M_SC2 + k]) + m[M_SH2 + k]; s += v * router[k * NE + e]; }
    logits[g] = s;
}
KERNEL k_aff(float* aff, int nrows) {
    const long g = GID; if (g >= nrows) return;
    float* a = aff + (size_t)g * NE; float m = a[0];
    for (int e = 1; e < NE; ++e) m = a[e] > m ? a[e] : m;
    float s = 0.f; float ex[NE];
#pragma unroll
    for (int e = 0; e < NE; ++e) { ex[e] = expf(a[e] - m); s += ex[e]; }
#pragma unroll
    for (int e = 0; e < NE; ++e) a[e] = ex[e] / s;
}
KERNEL k_select(const float* aff, int* sel, float* gate, int* tokslot, int nrows) {
    const long g = GID; if (g >= (long)nrows * NE) return;
    const int row = (int)(g / NE), e = (int)(g % NE);
    const bool lat = row < RL; const int b = lat ? row / SEQ : (row - RL) / CTX; const int t = lat ? row % SEQ : (row - RL) % CTX;
    const int n = lat ? SEQ : CTX, cap = lat ? CAPL : CAPC, base = lat ? b * SEQ : RL + b * CTX;
    const float a = aff[(size_t)row * NE + e]; int rank = 0;
    for (int j = 0; j < n; ++j) { const float o = aff[(size_t)(base + j) * NE + e]; rank += (o > a || (o == a && j < t)) ? 1 : 0; }
    int slot = -1;
    if (rank < cap) { slot = e * SLOTS_E + (lat ? b * CAPL + rank : SLOTS_L + b * CAPC + rank); sel[slot] = row; gate[slot] = a; }
    tokslot[g] = slot;
}
KERNEL k_combine(float* xl, float* xc, const bf16_t* Y, const int* tokslot, const float* modl, int nrows) {
    const long g = GID; if (g >= (long)nrows * D) return;
    const int row = (int)(g / D), k = (int)(g % D); float s = 0.f;
    for (int e = 0; e < NE; ++e) { const int sl = tokslot[(size_t)row * NE + e]; if (sl >= 0) s += bf2f(Y[(size_t)sl * D + k]); }
    float* xr = xrow_ptr(xl, xc, row); xr[k] += modl[(size_t)row_batch(row) * 6 * D + M_G2 + k] * s;
}
KERNEL k_final(float* xl, const float* rstd, const float* nw) {
    const long g = GID; if (g >= (long)RL * D) return;
    const int row = (int)(g / D), k = (int)(g % D); xl[g] = xl[g] * rstd[row] * nw[k];
}

#ifndef HOST_TEST
typedef short bf16x8 __attribute__((ext_vector_type(8)));
typedef float f32x4 __attribute__((ext_vector_type(4)));
template <class Epi, bool DUAL>
__global__ void __launch_bounds__(256) k_gemm_mfma(const bf16_t* __restrict__ A, const int* __restrict__ rowidx, const bf16_t* __restrict__ Bt, int M, int N, int K, int group_rows, int valid_rows, long bstride, Epi epi) {
    const int tid = threadIdx.x, wid = tid >> 6, lane = tid & 63, fr = lane & 15, fq = lane >> 4, wr = wid >> 1, wc = wid & 1;
    const int row0 = blockIdx.y * 128 + wr * 64;
    if ((blockIdx.y * 128) % group_rows >= valid_rows) return;
    const bf16_t* B = Bt + (size_t)((blockIdx.y * 128) / group_rows) * bstride;
    int brow[4], ocol[4];
    if (!DUAL) { for (int i = 0; i < 4; ++i) { brow[i] = blockIdx.x * 128 + wc * 64 + i * 16; ocol[i] = brow[i]; } }
    else { const int hc0 = blockIdx.x * 64 + wc * 32;
        for (int i = 0; i < 2; ++i) { ocol[i] = hc0 + i * 16; brow[i] = (ocol[i] / 128) * 256 + ocol[i] % 128; brow[i + 2] = brow[i] + 128; ocol[i + 2] = ocol[i]; } }
    const bf16_t* ap[4]; const bf16_t* bp[4];
#pragma unroll
    for (int m = 0; m < 4; ++m) { const int r = row0 + m * 16 + fr; const int ar = rowidx ? rowidx[r] : r; ap[m] = A + (size_t)ar * K + fq * 8; }
#pragma unroll
    for (int i = 0; i < 4; ++i) bp[i] = B + (size_t)(brow[i] + fr) * K + fq * 8;
    f32x4 acc[4][4];
#pragma unroll
    for (int m = 0; m < 4; ++m)
#pragma unroll
        for (int i = 0; i < 4; ++i) acc[m][i] = (f32x4){0.f, 0.f, 0.f, 0.f};
    for (int k0 = 0; k0 < K; k0 += 32) {
        bf16x8 af[4], bfr[4];
#pragma unroll
        for (int m = 0; m < 4; ++m) af[m] = *(const bf16x8*)(ap[m] + k0);
#pragma unroll
        for (int i = 0; i < 4; ++i) bfr[i] = *(const bf16x8*)(bp[i] + k0);
#pragma unroll
        for (int m = 0; m < 4; ++m)
#pragma unroll
            for (int i = 0; i < 4; ++i) acc[m][i] = __builtin_amdgcn_mfma_f32_16x16x32_bf16(bfr[i], af[m], acc[m][i], 0, 0, 0);
    }
#pragma unroll
    for (int m = 0; m < 4; ++m) { const int r = row0 + m * 16 + fr;
#pragma unroll
        for (int i = 0; i < (DUAL ? 2 : 4); ++i) {
            float v[4] = {acc[m][i][0], acc[m][i][1], acc[m][i][2], acc[m][i][3]};
            float u[4] = {acc[m][DUAL ? i + 2 : i][0], acc[m][DUAL ? i + 2 : i][1], acc[m][DUAL ? i + 2 : i][2], acc[m][DUAL ? i + 2 : i][3]};
            epi(r, ocol[i] + 4 * fq, v, u); } }
}
template <class Epi, bool DUAL>
static void launch_gemm(hipStream_t stream, const bf16_t* A, const int* rowidx, const bf16_t* Bt, int M, int N, int K, int group_rows, int valid_rows, long bstride, Epi epi) {
    dim3 grid(DUAL ? N / 64 : N / 128, M / 128);
    hipLaunchKernelGGL((k_gemm_mfma<Epi, DUAL>), grid, dim3(256), 0, stream, A, rowidx, Bt, M, N, K, group_rows, valid_rows, bstride, epi);
}
#define GEMM(Epi, DUAL, ...) launch_gemm<Epi, DUAL>(stream, __VA_ARGS__)
#else
#define GEMM(Epi, DUAL, A, rowidx, Bt, M, N, K, gr, vr, bs, epi) LAUNCH((k_gemm_naive<Epi, DUAL>), (long)(M) * ((N) / 4), A, rowidx, Bt, M, N, K, gr, vr, bs, epi)
#endif

#ifdef HOST_TEST
typedef int hipStream_t;
#endif
static void forward(const Ptrs& p, hipStream_t stream) {
    (void)stream;
    unsigned char* ws = p.ws;
    float* tab = (float*)(ws + WS_TAB); float* silu = (float*)(ws + WS_SILU); float* mod = (float*)(ws + WS_MOD); float* rstd = (float*)(ws + WS_RSTD);
    float* aff = (float*)(ws + WS_AFF); int* sel = (int*)(ws + WS_SEL); float* gate = (float*)(ws + WS_GATE); int* tokslot = (int*)(ws + WS_TOKSLOT);
    float* xc = (float*)(ws + WS_XC); float* xl = p.out;
    bf16_t* win = (bf16_t*)(ws + WS_WIN); bf16_t* wout = (bf16_t*)(ws + WS_WOUT);
    bf16_t* P = (bf16_t*)(ws + WS_R1); bf16_t* H = (bf16_t*)(ws + WS_R1);
    bf16_t* Y = (bf16_t*)(ws + WS_R2); bf16_t* MIX = (bf16_t*)(ws + WS_R2); bf16_t* HX2 = (bf16_t*)(ws + WS_R2 + (size_t)RALL * D * 2); float* TMP = (float*)HX2;
    bf16_t* HX = (bf16_t*)(ws + WS_R3);
    LAUNCH(k_tables, (long)(NROWS + 64) * 24, tab);
    LAUNCH(k_silu, (long)(NB + 1) * D, p.c, p.c_ctx, silu);
    LAUNCH(k_mod, (long)DEPTH * 6 * D, silu, p.w_ada, p.b_ada, mod);
    LAUNCH(k_cvt_win, (long)DEPTH * PROJ * D, p.w_in, win);
    LAUNCH(k_cvt_t, (long)DEPTH * D * D, p.w_out, wout, DEPTH, D, D);
#ifdef HOST_TEST
    memcpy(xl, p.x, (size_t)RL * D * 4); memcpy(xc, p.ctx, (size_t)RC * D * 4);
#else
    (void)hipMemcpyAsync(xl, p.x, (size_t)RL * D * 4, hipMemcpyDeviceToDevice, stream);
    (void)hipMemcpyAsync(xc, p.ctx, (size_t)RC * D * 4, hipMemcpyDeviceToDevice, stream);
#endif
    for (int l = 0; l < DEPTH; ++l) {
        const bool need_ctx = l < DEPTH - 1; const int nq = need_ctx ? RALL : RL;
        const float* modl = mod + (size_t)l * (NB + 1) * 6 * D; const float lam_init = 0.8f - 0.6f * expf(-0.3f * (float)l);
        bf16_t* wgu = (bf16_t*)(ws + WS_WGU) + (size_t)(l & 1) * NE * 2 * FF * D; bf16_t* wd = (bf16_t*)(ws + WS_WD) + (size_t)(l & 1) * NE * D * FF;
        LAUNCH(k_cvt_gu, (long)NE * 2 * FF * D, p.w_gate + (size_t)l * NE * D * FF, p.w_up + (size_t)l * NE * D * FF, wgu);
        LAUNCH(k_cvt_t, (long)NE * FF * D, p.w_down + (size_t)l * NE * FF * D, wd, NE, FF, D);
        LAUNCH(k_rowstat, RALL, xl, xc, rstd, RALL);
        LAUNCH(k_rowapply, (long)RALL * D, xl, xc, rstd, p.norm1 + l * D, modl, M_SH1, M_SC1, HX, RALL);
        GEMM(EpiInProj, false, HX, (const int*)nullptr, win + (size_t)l * PROJ * D, RALL, PROJ, D, RALL, RALL, 0L, (EpiInProj{P, tab}));
        LAUNCH(k_attnA, (long)nq * NHA, P, p.attn_sink + l * NHA, MIX, nq);
        LAUNCH(k_attnD, (long)nq * NHC * 2, P, TMP, nq);
        LAUNCH(k_diffpost, (long)nq * NHC, TMP, p.diff_lambda + l * 4 * DD, p.diff_subln + l * 2 * DD, lam_init, MIX, nq);
        LAUNCH(k_conv, (long)nq * CONV_CH, P, p.conv_w + l * 3 * CONV_CH, MIX, nq);
        GEMM(EpiOutProj, false, MIX, (const int*)nullptr, wout + (size_t)l * D * D, nq, D, D, nq, nq, 0L, (EpiOutProj{xl, xc, modl}));
        LAUNCH(k_rowstat, nq, xl, xc, rstd, nq);
        LAUNCH(k_rowapply, (long)nq * D, xl, xc, rstd, p.norm2 + l * D, modl, M_SH2, M_SC2, HX2, nq);
        LAUNCH(k_router, (long)nq * NE, xl, xc, rstd, p.norm2 + l * D, modl, p.router + (size_t)l * D * NE, aff, nq);
        LAUNCH(k_aff, nq, aff, nq);
        LAUNCH(k_select, (long)nq * NE, aff, sel, gate, tokslot, nq);
        const int vr = need_ctx ? SLOTS_E : SLOTS_L;
        GEMM(EpiGateUp, true, HX2, sel, wgu, NSLOT, FF, D, SLOTS_E, vr, (long)2 * FF * D, (EpiGateUp{H}));
        GEMM(EpiDown, false, H, (const int*)nullptr, wd, NSLOT, D, FF, SLOTS_E, vr, (long)D * FF, (EpiDown{Y, gate}));
        LAUNCH(k_combine, (long)nq * D, xl, xc, Y, tokslot, modl, nq);
    }
    LAUNCH(k_rowstat, RL, xl, xc, rstd, RL);
    LAUNCH(k_final, (long)RL * D, xl, rstd, p.norm_final);
}

#ifndef HOST_TEST
#define LAS __attribute__((address_space(3)))
#define GAS __attribute__((address_space(1)))
typedef unsigned u32x4 __attribute__((ext_vector_type(4)));
typedef unsigned u32x2 __attribute__((ext_vector_type(2)));
typedef float f32x2_t __attribute__((ext_vector_type(2)));
constexpr int NT = 512, NWV = 8;
constexpr int LDS_BYTES = 163840;
constexpr int LDS_MISC = LDS_BYTES - 256;
constexpr int CW_BAR = 4096;

__device__ __forceinline__ unsigned cvt_pk_bf16(float lo, float hi) { unsigned r; asm volatile("v_cvt_pk_bf16_f32 %0, %1, %2" : "=v"(r) : "v"(lo), "v"(hi)); return r; }
__device__ __forceinline__ float dpp_f(float v, const int ctrl_tag) {
    int r;
    switch (ctrl_tag) {
        case 0: r = __builtin_amdgcn_update_dpp(0, __builtin_bit_cast(int, v), 0xB1, 0xF, 0xF, true); break;
        case 1: r = __builtin_amdgcn_update_dpp(0, __builtin_bit_cast(int, v), 0x4E, 0xF, 0xF, true); break;
        case 2: r = __builtin_amdgcn_update_dpp(0, __builtin_bit_cast(int, v), 0x141, 0xF, 0xF, true); break;
        default: r = __builtin_amdgcn_update_dpp(0, __builtin_bit_cast(int, v), 0x140, 0xF, 0xF, true); break;
    }
    return __builtin_bit_cast(float, r);
}
__device__ __forceinline__ float wave_sum(float v) {
    v += dpp_f(v, 0); v += dpp_f(v, 1); v += dpp_f(v, 2); v += dpp_f(v, 3);
    const int b = __builtin_bit_cast(int, v);
    return (__builtin_bit_cast(float, __builtin_amdgcn_readlane(b, 0)) + __builtin_bit_cast(float, __builtin_amdgcn_readlane(b, 16)))
         + (__builtin_bit_cast(float, __builtin_amdgcn_readlane(b, 32)) + __builtin_bit_cast(float, __builtin_amdgcn_readlane(b, 48)));
}
#define LDS_WAIT() asm volatile("s_waitcnt lgkmcnt(0)" ::: "memory")
__device__ __forceinline__ float wave_max(float v) {
    v = fmaxf(v, dpp_f(v, 0)); v = fmaxf(v, dpp_f(v, 1)); v = fmaxf(v, dpp_f(v, 2)); v = fmaxf(v, dpp_f(v, 3));
    const int b = __builtin_bit_cast(int, v);
    return fmaxf(fmaxf(__builtin_bit_cast(float, __builtin_amdgcn_readlane(b, 0)), __builtin_bit_cast(float, __builtin_amdgcn_readlane(b, 16))),
                 fmaxf(__builtin_bit_cast(float, __builtin_amdgcn_readlane(b, 32)), __builtin_bit_cast(float, __builtin_amdgcn_readlane(b, 48))));
}

#define LDS_RD16_B128(r, addr, STRIDE) asm volatile( \
    "ds_read_b128 %0, %16\n\tds_read_b128 %1, %16 offset:%c17\n\tds_read_b128 %2, %16 offset:2*%c17\n\tds_read_b128 %3, %16 offset:3*%c17\n\t" \
    "ds_read_b128 %4, %16 offset:4*%c17\n\tds_read_b128 %5, %16 offset:5*%c17\n\tds_read_b128 %6, %16 offset:6*%c17\n\tds_read_b128 %7, %16 offset:7*%c17\n\t" \
    "ds_read_b128 %8, %16 offset:8*%c17\n\tds_read_b128 %9, %16 offset:9*%c17\n\tds_read_b128 %10, %16 offset:10*%c17\n\tds_read_b128 %11, %16 offset:11*%c17\n\t" \
    "ds_read_b128 %12, %16 offset:12*%c17\n\tds_read_b128 %13, %16 offset:13*%c17\n\tds_read_b128 %14, %16 offset:14*%c17\n\tds_read_b128 %15, %16 offset:15*%c17\n\ts_waitcnt lgkmcnt(0)" \
    : "=&v"(r[0]), "=&v"(r[1]), "=&v"(r[2]), "=&v"(r[3]), "=&v"(r[4]), "=&v"(r[5]), "=&v"(r[6]), "=&v"(r[7]), "=&v"(r[8]), "=&v"(r[9]), "=&v"(r[10]), "=&v"(r[11]), "=&v"(r[12]), "=&v"(r[13]), "=&v"(r[14]), "=&v"(r[15]) \
    : "v"(addr), "i"(STRIDE) : "memory")
#define LDS_ISSUE8_B128(r, addr, STRIDE) asm volatile( \
    "ds_read_b128 %0, %8\n\tds_read_b128 %1, %8 offset:%c9\n\tds_read_b128 %2, %8 offset:2*%c9\n\tds_read_b128 %3, %8 offset:3*%c9\n\t" \
    "ds_read_b128 %4, %8 offset:4*%c9\n\tds_read_b128 %5, %8 offset:5*%c9\n\tds_read_b128 %6, %8 offset:6*%c9\n\tds_read_b128 %7, %8 offset:7*%c9" \
    : "=&v"(r[0]), "=&v"(r[1]), "=&v"(r[2]), "=&v"(r[3]), "=&v"(r[4]), "=&v"(r[5]), "=&v"(r[6]), "=&v"(r[7]) \
    : "v"(addr), "i"(STRIDE) : "memory")
#define LDS_WAIT8(r, N) asm volatile("s_waitcnt lgkmcnt(" #N ")" : "+v"(r[0]), "+v"(r[1]), "+v"(r[2]), "+v"(r[3]), "+v"(r[4]), "+v"(r[5]), "+v"(r[6]), "+v"(r[7]) :: "memory")
#define LDS_RD11_B128(r, addr, STRIDE) asm volatile( \
    "ds_read_b128 %0, %11\n\tds_read_b128 %1, %11 offset:%c12\n\tds_read_b128 %2, %11 offset:2*%c12\n\tds_read_b128 %3, %11 offset:3*%c12\n\t" \
    "ds_read_b128 %4, %11 offset:4*%c12\n\tds_read_b128 %5, %11 offset:5*%c12\n\tds_read_b128 %6, %11 offset:6*%c12\n\tds_read_b128 %7, %11 offset:7*%c12\n\t" \
    "ds_read_b128 %8, %11 offset:8*%c12\n\tds_read_b128 %9, %11 offset:9*%c12\n\tds_read_b128 %10, %11 offset:10*%c12\n\ts_waitcnt lgkmcnt(0)" \
    : "=&v"(r[0]), "=&v"(r[1]), "=&v"(r[2]), "=&v"(r[3]), "=&v"(r[4]), "=&v"(r[5]), "=&v"(r[6]), "=&v"(r[7]), "=&v"(r[8]), "=&v"(r[9]), "=&v"(r[10]) \
    : "v"(addr), "i"(STRIDE) : "memory")
__device__ __forceinline__ int lane_id_asm() { int l; asm volatile("v_mbcnt_lo_u32_b32 %0, -1, 0\n\tv_mbcnt_hi_u32_b32 %0, -1, %0" : "=v"(l)); return l; }
__device__ __forceinline__ int tid_w(int wv) { return wv * 64 + lane_id_asm(); }
#define tid_l() tid_w(C.wv)

#define XB_TMO      128
#define XB_XCNT(j)  (256  + 64 * (j))
#define XB_XSUB(j)  (1280 + 64 * (j))
#define XB_XGEN(j)  (2304 + 64 * (j))
#define XB_TOP      3328
#define XB_TOPGEN   3392
#define XCD_BAR_WORDS 3456
#define XB_SPIN_CAP (1u << 24)
__device__ __forceinline__ unsigned xb_ld(unsigned* p)              { return __hip_atomic_load(p, __ATOMIC_RELAXED, __HIP_MEMORY_SCOPE_AGENT); }
__device__ __forceinline__ unsigned xb_add(unsigned* p, unsigned v) { return __hip_atomic_fetch_add(p, v, __ATOMIC_RELAXED, __HIP_MEMORY_SCOPE_AGENT); }
__device__ __forceinline__ unsigned xb_xcc_id() { return (unsigned)__builtin_amdgcn_s_getreg((3 << 11) | 20) & 0xFu; }
#define XB_SPIN(cond, bar) do { unsigned _sp = 0; while (cond) { __builtin_amdgcn_s_sleep(1); \
    if ((++_sp & 255u) == 0u) { if (xb_ld(&(bar)[XB_TMO])) break; if (_sp > XB_SPIN_CAP) { atomicAdd(&(bar)[XB_TMO], 1u); break; } } } } while (0)
struct XcdBarrier { unsigned* bar; unsigned x; volatile LAS unsigned* st; int wv; };
__device__ __forceinline__ XcdBarrier xcd_barrier_post(unsigned* bar, volatile LAS unsigned* st, int wv) {
    XcdBarrier b; b.bar = bar; b.x = xb_xcc_id(); b.st = st; b.wv = wv;
    if (tid_w(wv) == 0) (void)xb_add(&bar[XB_XCNT(b.x)], 1u);
    return b;
}
__device__ __forceinline__ void xcd_barrier_complete(unsigned* bar, unsigned x, unsigned& nloc, unsigned& nx) {
    const unsigned G = gridDim.x * gridDim.y * gridDim.z;
    unsigned sum, cnt, mine, sp = 0u;
    for (;;) {
        sum = 0u; cnt = 0u; mine = 0u;
#pragma unroll
        for (unsigned j = 0; j < 16; ++j) { const unsigned c = xb_ld(&bar[XB_XCNT(j)]); sum += c; cnt += (c > 0u) ? 1u : 0u; mine = (j == x) ? c : mine; }
        if (sum == G) break;
        __builtin_amdgcn_s_sleep(1);
        if ((++sp & 255u) == 0u) { if (xb_ld(&bar[XB_TMO])) break; if (sp > XB_SPIN_CAP) { atomicAdd(&bar[XB_TMO], 1u); break; } }
    }
    nloc = mine > 0u ? mine : 1u; nx = cnt > 0u ? cnt : 1u;
}
__device__ __forceinline__ void xcd_barrier(const XcdBarrier& b) {
    asm volatile("s_waitcnt vmcnt(0)" ::: "memory");
    __syncthreads();
    if (tid_w(b.wv) == 0) {
        unsigned* bar = b.bar;
        __builtin_amdgcn_s_waitcnt(0);
        unsigned nloc = b.st[0], nx = b.st[1];
        if (nloc == 0u) { xcd_barrier_complete(bar, b.x, nloc, nx); b.st[0] = nloc; b.st[1] = nx; }
        const unsigned old = xb_add(&bar[XB_XSUB(b.x)], 1u);
        const unsigned gen = old / nloc;
        if (old + 1u == (gen + 1u) * nloc) {
            __builtin_amdgcn_fence(__ATOMIC_RELEASE, "agent");
            asm volatile("s_waitcnt vmcnt(0)" ::: "memory");
            const unsigned og = xb_add(&bar[XB_TOP], 1u);
            const unsigned tg = og / nx;
            if (og + 1u == (tg + 1u) * nx) xb_add(&bar[XB_TOPGEN], 1u);
            else XB_SPIN(xb_ld(&bar[XB_TOPGEN]) == tg, bar);
            __builtin_amdgcn_fence(__ATOMIC_ACQUIRE, "agent");
            xb_add(&bar[XB_XGEN(b.x)], 1u);
            asm volatile("s_waitcnt vmcnt(0)" ::: "memory");
        } else {
            XB_SPIN(xb_ld(&bar[XB_XGEN(b.x)]) == gen, bar);
            __builtin_amdgcn_fence(__ATOMIC_ACQUIRE, "agent");
            asm volatile("s_waitcnt vmcnt(0)" ::: "memory");
        }
    }
    __syncthreads();
}

namespace pg {
constexpr int BM = 256, BK = 64, HALF = 128, HTB = HALF * BK * 2  , STAGE_BYTES = 8 * HTB, NXCD = 8, WGM = 8;
constexpr int TPE_FULL = SLOTS_E / BM;
__host__ __device__ __forceinline__ int lds_byte(int r, int c) { const int st = (r >> 4) * 2 + (c >> 5), rr = r & 15, cc = c & 31, ob = rr * 64 + cc * 2; return st * 1024 + (ob ^ (((ob >> 9) & 1) << 5)); }
__host__ __device__ __forceinline__ void stage_rc(int b, int& R, int& C) { const int st = b / 1024, sb = b % 1024, swz = sb ^ (((sb >> 9) & 1) << 5); R = (st >> 1) * 16 + swz / 64; C = (st & 1) * 32 + (swz % 64) / 2; }
__host__ __device__ __forceinline__ int perm32(int rho) { const int n = rho >> 4, i = rho & 15; return 8 * (i >> 2) + 4 * n + (i & 3); }
struct Unit { int m0, pn, e; };
struct GemmD { const char* A; const int* rowidx; const char* Bt; size_t bstride; int K; };
struct Order {
    int nM, nN, nwg, G, c, tpe;
    __device__ void init(int nM_, int nN_, int G_, int c_, int tpe_) { nM = nM_; nN = nN_; nwg = nM * nN; G = G_; c = c_; tpe = tpe_; }
    __device__ bool next(int i, Unit& u) const {
        const long L = (long)i * G + c; if (L >= nwg) return false;
        int wgid = (int)L; { const int q = nwg / NXCD, r = nwg % NXCD, xcd = wgid % NXCD, off = wgid / NXCD; wgid = (xcd < r ? xcd * (q + 1) : r * (q + 1) + (xcd - r) * q) + off; }
        const int nig = WGM * nN, gid = wgid / nig, fm = gid * WGM, gsz = (nM - fm) < WGM ? (nM - fm) : WGM;
        const int pm = fm + ((wgid % nig) % gsz); u.pn = (wgid % nig) / gsz;
        if (tpe > 0) { u.e = pm / tpe; u.m0 = (u.e * TPE_FULL + pm % tpe) * BM; } else { u.e = 0; u.m0 = pm * BM; }
        return true;
    }
};
template <class T> struct has_pre { template <class U> static constexpr bool test(decltype(U::HAS_PRE)*) { return U::HAS_PRE; } template <class U> static constexpr bool test(...) { return false; } static constexpr bool value = test<T>(nullptr); };
typedef int v4i32_t __attribute__((ext_vector_type(4)));
typedef int v8i32_t __attribute__((ext_vector_type(8)));
__device__ __forceinline__ v8i32_t cat8(const bf16x8 a, const bf16x8 b) { return __builtin_shufflevector(__builtin_bit_cast(v4i32_t, a), __builtin_bit_cast(v4i32_t, b), 0, 1, 2, 3, 4, 5, 6, 7); }
constexpr int SCALE_ONE = 0x7F7F7F7F, SCALE_W = 0x79797979;
template <bool I> struct acc_sel { typedef f32x4 type; };
template <> struct acc_sel<true> { typedef v4i32_t type; };
template <class Epi, bool GATHER, int QM = 0>
__device__ __forceinline__ void gemm_phase(LAS unsigned char* lds, const GemmD g, const Order& S, const Epi& E, int wv) {
    const int tid = tid_w(wv), wid = __builtin_amdgcn_readfirstlane(tid >> 6), lane = tid & 63, wr = wid >> 2, wc = wid & 3, fr = lane & 15, fq = lane >> 4;
    constexpr bool FP8 = (QM == 1), I8 = (QM == 2);
    typedef typename acc_sel<QM == 2>::type acc_t;
    const int K = g.K, nt = K / BK;
    int Rr[2], Cc[2]; unsigned voffB[2];
#pragma unroll
    for (int i = 0; i < 2; ++i) { int R, C; stage_rc(tid * 16 + i * 8192, R, C); Rr[i] = R; Cc[i] = C; const int Rb = Epi::PERM ? ((R & ~31) + perm32(R & 31)) : R; voffB[i] = (unsigned)(Rb * K + C) * 2u; }
    const unsigned kstep = (unsigned)(BK * 2);
    const size_t hstep = (size_t)HALF * K * 2;
    const unsigned ldsw = (unsigned)wid * 1024u;
    const int aoff = lds_byte(wr * 64 + fr, fq * 8), boff = lds_byte(wc * 32 + fr, fq * 8);
#define PG_SA(b, h) (((b) * 2 + (h)) * HTB)
#define PG_SB(b, h) ((4 + (b) * 2 + (h)) * HTB)
#define PG_STAGE_B(bufoff, gbase) do { _Pragma("unroll") for (int _i = 0; _i < 2; ++_i) \
        __builtin_amdgcn_global_load_lds((const unsigned*)((const char*)(gbase) + voffB[_i]), (LAS unsigned*)(lds + (bufoff) + ldsw + _i * 8192), 16, 0, 0); } while (0)
#define PG_STAGE_A(bufoff, OFFS, h, kb) do { _Pragma("unroll") for (int _i = 0; _i < 2; ++_i) \
        __builtin_amdgcn_global_load_lds((const unsigned*)(g.A + (size_t)(OFFS)[h][_i] + (kb)), (LAS unsigned*)(lds + (bufoff) + ldsw + _i * 8192), 16, 0, 0); } while (0)
#define PG_ROWOFF(DST, U) do { _Pragma("unroll") for (int _h = 0; _h < 2; ++_h) _Pragma("unroll") for (int _i = 0; _i < 2; ++_i) { int _r = (U).m0 + _h * HALF + Rr[_i]; if (GATHER) _r = g.rowidx[_r]; \
        (DST)[_h][_i] = (unsigned)(((size_t)_r * K + Cc[_i]) * 2); } } while (0)
#define PG_LDA(dst, b, h) do { _Pragma("unroll") for (int m = 0; m < 4; ++m) { if constexpr (FP8) { const v4i32_t _x0 = *(const LAS v4i32_t*)(lds + PG_SA(b, h) + aoff + m * 2048), _x1 = *(const LAS v4i32_t*)(lds + PG_SA(b, h) + aoff + m * 2048 + 1024); \
        dst##8[m] = __builtin_shufflevector(_x0, _x1, 0, 1, 2, 3, 4, 5, 6, 7); } else { _Pragma("unroll") for (int k = 0; k < 2; ++k) dst[m][k] = *(const LAS bf16x8*)(lds + PG_SA(b, h) + aoff + m * 2048 + k * 1024); } } } while (0)
#define PG_LDB(dst, b, h) do { _Pragma("unroll") for (int n = 0; n < 2; ++n) { if constexpr (FP8) { const v4i32_t _x0 = *(const LAS v4i32_t*)(lds + PG_SB(b, h) + boff + n * 2048), _x1 = *(const LAS v4i32_t*)(lds + PG_SB(b, h) + boff + n * 2048 + 1024); \
        dst##8[n] = __builtin_shufflevector(_x0, _x1, 0, 1, 2, 3, 4, 5, 6, 7); } else { _Pragma("unroll") for (int k = 0; k < 2; ++k) dst[n][k] = *(const LAS bf16x8*)(lds + PG_SB(b, h) + boff + n * 2048 + k * 1024); } } } while (0)
#define PG_MMA(ai, bj, At, Bt) do { __builtin_amdgcn_s_setprio(1); _Pragma("unroll") for (int m = 0; m < 4; ++m) _Pragma("unroll") for (int n = 0; n < 2; ++n) { \
        if constexpr (FP8) asm volatile("s_nop 1\n\tv_mfma_scale_f32_16x16x128_f8f6f4 %0, %1, %2, %0, %3, %4 op_sel_hi:[0,0,0]" : "+v"(acc[ai][bj][m][n]) : "v"(Bt##8[n]), "v"(At##8[m]), "v"(sc_w), "v"(sc_a)); \
        else if constexpr (I8) { _Pragma("unroll") for (int k = 0; k < 2; ++k) acc[ai][bj][m][n] = __builtin_amdgcn_mfma_i32_16x16x64_i8(__builtin_bit_cast(v4i32_t, Bt[n][k]), __builtin_bit_cast(v4i32_t, At[m][k]), acc[ai][bj][m][n], 0, 0, 0); } \
        else if constexpr (!I8 && !FP8) { _Pragma("unroll") for (int k = 0; k < 2; ++k) acc[ai][bj][m][n] = __builtin_amdgcn_mfma_f32_16x16x32_bf16(Bt[n][k], At[m][k], acc[ai][bj][m][n], 0, 0, 0); } } \
        __builtin_amdgcn_s_setprio(0); } while (0)
#define PG_WAIT_V(n) asm volatile("s_waitcnt vmcnt(" #n ")" ::: "memory")
#define PG_WAIT_L(n) asm volatile("s_waitcnt lgkmcnt(" #n ")" ::: "memory")
#define PG_BAR __builtin_amdgcn_s_barrier()
#define PG_SCHED __builtin_amdgcn_sched_barrier(0)
    Unit cur, nxt; int ui = 0;
    if (!S.next(0, cur)) return;
    acc_t acc[2][2][4][2];
#pragma unroll
    for (int a = 0; a < 2; ++a)
#pragma unroll
        for (int b = 0; b < 2; ++b)
#pragma unroll
            for (int m = 0; m < 4; ++m)
#pragma unroll
                for (int n = 0; n < 2; ++n) { acc[a][b][m][n] = acc_t{}; if constexpr (FP8) asm volatile("" : "+v"(acc[a][b][m][n])); }
    bf16x8 At[4][2], B0[2][2], B1[2][2]; v8i32_t At8[4], B08[2], B18[2];
    int sc_w = SCALE_W, sc_a = SCALE_ONE; if constexpr (FP8) { asm volatile("" : "+v"(sc_w), "+v"(sc_a)); }
    unsigned offA[2][2], offN[2][2];
    float epre[8] = {0.f, 0.f, 0.f, 0.f, 0.f, 0.f, 0.f, 0.f};
    if constexpr (has_pre<Epi>::value) E.pre(epre, cur, wr, fr);
    PG_ROWOFF(offA, cur);
    if (GATHER) PG_WAIT_V(0);
    const char* cB = g.Bt + (size_t)cur.e * g.bstride + (size_t)cur.pn * BM * K * 2;
    PG_STAGE_B(PG_SB(0, 0), cB); PG_STAGE_B(PG_SB(0, 1), cB + hstep); PG_STAGE_A(PG_SA(0, 0), offA, 0, 0u); PG_STAGE_A(PG_SA(0, 1), offA, 1, 0u);
    if (wr == 1) PG_BAR;
    PG_WAIT_V(2); PG_BAR;
    PG_STAGE_B(PG_SB(1, 0), cB + kstep); PG_STAGE_A(PG_SA(1, 0), offA, 0, kstep); PG_STAGE_B(PG_SB(1, 1), cB + hstep + kstep);
    PG_WAIT_V(6); PG_BAR;
    for (;;) {
        const bool has_next = S.next(ui + 1, nxt);
        const char* nB = has_next ? g.Bt + (size_t)nxt.e * g.bstride + (size_t)nxt.pn * BM * K * 2 : cB;
        if (has_next) { PG_ROWOFF(offN, nxt); if (GATHER) PG_WAIT_V(0); }
        else {
#pragma unroll
            for (int h = 0; h < 2; ++h)
#pragma unroll
                for (int i = 0; i < 2; ++i) offN[h][i] = offA[h][i]; }
        for (int t = 0; t < nt; t += 2) {
            const bool last = (t == nt - 2);
            unsigned o2[2][2];
#pragma unroll
            for (int h = 0; h < 2; ++h)
#pragma unroll
                for (int i = 0; i < 2; ++i) o2[h][i] = last ? offN[h][i] : offA[h][i];
            const unsigned ka1 = (unsigned)(t + 1) * kstep, ka2 = last ? 0u : (unsigned)(t + 2) * kstep, ka3 = ka2 + kstep;
            const char* b2 = last ? nB : cB + (size_t)(t + 2) * kstep; const char* b3 = b2 + kstep;
            PG_LDB(B0, 0, 0); PG_LDB(B1, 0, 1); PG_SCHED; PG_LDA(At, 0, 0); PG_STAGE_A(PG_SA(1, 1), offA, 1, ka1);
            PG_WAIT_V(8); PG_WAIT_L(0); PG_BAR; PG_MMA(0, 0, At, B0); PG_MMA(0, 1, At, B1); PG_BAR; PG_SCHED;
            PG_LDA(At, 0, 1); PG_STAGE_B(PG_SB(0, 0), b2); PG_STAGE_B(PG_SB(0, 1), b2 + hstep); PG_STAGE_A(PG_SA(0, 0), o2, 0, ka2);
            PG_WAIT_V(8); PG_WAIT_L(0); PG_BAR; PG_MMA(1, 0, At, B0); PG_MMA(1, 1, At, B1); PG_BAR; PG_SCHED;
            PG_LDB(B0, 1, 0); PG_LDB(B1, 1, 1); PG_SCHED; PG_LDA(At, 1, 0); PG_STAGE_A(PG_SA(0, 1), o2, 1, ka2);
            PG_WAIT_V(8); PG_WAIT_L(0); PG_BAR; PG_MMA(0, 0, At, B0); PG_MMA(0, 1, At, B1); PG_BAR; PG_SCHED;
            PG_LDA(At, 1, 1); PG_STAGE_B(PG_SB(1, 0), b3); PG_STAGE_B(PG_SB(1, 1), b3 + hstep); PG_STAGE_A(PG_SA(1, 0), o2, 0, ka3);
            PG_WAIT_V(8); PG_WAIT_L(0); PG_BAR; PG_MMA(1, 0, At, B0); PG_MMA(1, 1, At, B1); PG_BAR; PG_SCHED;
        }
        if (wr == 0) PG_BAR;
        if constexpr (FP8) asm volatile("s_nop 15\n\ts_nop 7" ::: "memory");
        if constexpr (has_pre<Epi>::value) { E(acc, cur, wr, wc, fr, fq, epre); if (has_next) E.pre(epre, nxt, wr, fr); }
        else E(acc, cur, wr, wc, fr, fq);
        if (!has_next) break;
#pragma unroll
        for (int a = 0; a < 2; ++a)
#pragma unroll
            for (int b = 0; b < 2; ++b)
#pragma unroll
                for (int m = 0; m < 4; ++m)
#pragma unroll
                    for (int n = 0; n < 2; ++n) { acc[a][b][m][n] = acc_t{}; if constexpr (FP8) asm volatile("" : "+v"(acc[a][b][m][n])); }
        cur = nxt; cB = nB; ++ui;
#pragma unroll
        for (int h = 0; h < 2; ++h)
#pragma unroll
            for (int i = 0; i < 2; ++i) offA[h][i] = offN[h][i];
        if (wr == 1) PG_BAR;
    }
    PG_WAIT_V(0);
    PG_BAR;
#undef PG_SA
#undef PG_SB
#undef PG_STAGE_A
#undef PG_STAGE_B
#undef PG_ROWOFF
#undef PG_LDA
#undef PG_LDB
#undef PG_MMA
#undef PG_WAIT_V
#undef PG_WAIT_L
#undef PG_BAR
#undef PG_SCHED
}
struct EpiP {
    static constexpr bool PERM = true;
    bf16_t* P; const float* tab; const float* hxs; const float* wss;
    __device__ __forceinline__ void operator()(const v4i32_t (&acc)[2][2][4][2], const Unit& u, int wr, int wc, int fr, int fq) const {
        const bool lat = u.m0 < RL;
        float rs[8];
#pragma unroll
        for (int ai = 0; ai < 2; ++ai)
#pragma unroll
            for (int m = 0; m < 4; ++m) rs[ai * 4 + m] = hxs[u.m0 + ai * HALF + wr * 64 + m * 16 + fr];
        float cs; { const int ln = fr + 16 * fq; cs = 4.0f * sqrtf(wave_sum((wss[ln] + wss[ln + 64]) + (wss[ln + 128] + wss[ln + 192])) * (1.0f / ((float)D * (float)PROJ))) * (1.0f / 127.0f); }
#pragma unroll
        for (int bj = 0; bj < 2; ++bj) {
            const int ct = u.pn * BM + bj * HALF;
            const int c0 = ct + wc * 32 + 8 * fq;
            const int kind = ct < C_VA ? 1 : ((ct >= C_QD && ct < C_VD) ? 2 : 0);
            const float sc = ct < C_KA ? QSCALE_A : ((ct >= C_QD && ct < C_KD) ? QSCALE_D : 1.0f);
#pragma unroll
            for (int ai = 0; ai < 2; ++ai)
#pragma unroll
                for (int m = 0; m < 4; ++m) {
                    const int row = u.m0 + ai * HALF + wr * 64 + m * 16 + fr;
                    f32x4 v0, v1; { const v4i32_t i0 = acc[ai][bj][m][0], i1 = acc[ai][bj][m][1]; const float r_ = rs[ai * 4 + m];
#pragma unroll
                      for (int k = 0; k < 4; ++k) { v0[k] = (float)i0[k] * (r_ * cs); v1[k] = (float)i1[k] * (r_ * cs); } }
                    if (kind != 0 && lat) {
                        const int pos = row % SEQ, gr = pos / GRID_W, gc = pos % GRID_W; const float* t;
                        if (kind == 1) { const int p = c0 & 63, grp = p >> 5, i0 = (p & 31) >> 1; t = tab + (grp ? T_ACOL + gc * 32 : T_AROW + gr * 32) + i0 * 2; }
                        else { const int p = c0 & 31, grp = p >> 4, i0 = (p & 15) >> 1; t = tab + (grp ? T_DCOL + gc * 16 : T_DROW + gr * 16) + i0 * 2; }
                        const f32x4 t0 = *(const f32x4*)t, t1 = *(const f32x4*)(t + 4);
                        v0 = (f32x4){v0[0] * t0[0] - v0[1] * t0[1], v0[1] * t0[0] + v0[0] * t0[1], v0[2] * t0[2] - v0[3] * t0[3], v0[3] * t0[2] + v0[2] * t0[3]};
                        v1 = (f32x4){v1[0] * t1[0] - v1[1] * t1[1], v1[1] * t1[0] + v1[0] * t1[1], v1[2] * t1[2] - v1[3] * t1[3], v1[3] * t1[2] + v1[2] * t1[3]};
                    }
                    v0 = v0 * sc; v1 = v1 * sc;
                    u32x4 w; w.x = cvt_pk_bf16(v0[0], v0[1]); w.y = cvt_pk_bf16(v0[2], v0[3]); w.z = cvt_pk_bf16(v1[0], v1[1]); w.w = cvt_pk_bf16(v1[2], v1[3]);
                    *(u32x4*)(P + (size_t)row * PROJ + c0) = w;
                }
        }
    }
};
struct EpiX {
    static constexpr bool PERM = true;
    bf16_t* XB; const float* modl; float gscale;
    __device__ __forceinline__ void operator()(const f32x4 (&acc)[2][2][4][2], const Unit& u, int wr, int wc, int fr, int fq) const {
        const int b = u.m0 < RL ? u.m0 / SEQ : NB; const float* g1 = modl + (size_t)b * 6 * D + M_G1 + u.pn * BM + wc * 32 + 8 * fq;
        bf16_t* x0 = XB + (size_t)(u.m0 + wr * 64 + fr) * D + u.pn * BM + wc * 32 + 8 * fq;
        u32x4 xv[2][4][2];
#pragma unroll
        for (int ai = 0; ai < 2; ++ai)
#pragma unroll
            for (int m = 0; m < 4; ++m)
#pragma unroll
                for (int bj = 0; bj < 2; ++bj) xv[ai][m][bj] = *(const u32x4*)(x0 + (size_t)(ai * HALF + m * 16) * D + bj * HALF);
        f32x4 gv[2][2];
#pragma unroll
        for (int bj = 0; bj < 2; ++bj)
#pragma unroll
            for (int n = 0; n < 2; ++n) gv[bj][n] = *(const f32x4*)(g1 + bj * HALF + 4 * n) * gscale;
#pragma unroll
        for (int ai = 0; ai < 2; ++ai)
#pragma unroll
            for (int m = 0; m < 4; ++m)
#pragma unroll
                for (int bj = 0; bj < 2; ++bj) { const u32x4 x = xv[ai][m][bj];
                    const f32x4 a0 = acc[ai][bj][m][0] * gv[bj][0], a1 = acc[ai][bj][m][1] * gv[bj][1]; u32x4 w;
                    w.x = cvt_pk_bf16(__builtin_bit_cast(float, x.x << 16) + a0[0], __builtin_bit_cast(float, x.x & 0xffff0000u) + a0[1]);
                    w.y = cvt_pk_bf16(__builtin_bit_cast(float, x.y << 16) + a0[2], __builtin_bit_cast(float, x.y & 0xffff0000u) + a0[3]);
                    w.z = cvt_pk_bf16(__builtin_bit_cast(float, x.z << 16) + a1[0], __builtin_bit_cast(float, x.z & 0xffff0000u) + a1[1]);
                    w.w = cvt_pk_bf16(__builtin_bit_cast(float, x.w << 16) + a1[2], __builtin_bit_cast(float, x.w & 0xffff0000u) + a1[3]);
                    *(u32x4*)(x0 + (size_t)(ai * HALF + m * 16) * D + bj * HALF) = w; }
    }
};
__device__ __forceinline__ float silu_fast(float v) { return v * __builtin_amdgcn_rcpf(1.0f + __builtin_amdgcn_exp2f(-LOG2E * v)); }
__device__ __forceinline__ unsigned pk4_fp8(float a, float b, float c, float d) { int w = 0; w = __builtin_amdgcn_cvt_pk_fp8_f32(a, b, w, false); w = __builtin_amdgcn_cvt_pk_fp8_f32(c, d, w, true); return (unsigned)w; }
__device__ __forceinline__ void store_pair16_fq(unsigned char* p0, unsigned char* p1, u32x2 a, u32x2 b, int fq) {
    auto rx = __builtin_amdgcn_permlane16_swap(a.x, b.x, false, false); auto ry = __builtin_amdgcn_permlane16_swap(a.y, b.y, false, false);
    u32x4 w; w.x = rx[0]; w.y = ry[0]; w.z = rx[1]; w.w = ry[1];
    *(u32x4*)((fq & 1) ? p1 - 8 : p0) = w;
}
struct EpiH {
    static constexpr bool PERM = true;
    unsigned char* H;
    __device__ __forceinline__ void operator()(const f32x4 (&acc)[2][2][4][2], const Unit& u, int wr, int wc, int fr, int fq) const {
        const int hc = u.pn * HALF + wc * 32 + 8 * fq;
#pragma unroll
        for (int ai = 0; ai < 2; ++ai)
#pragma unroll
            for (int m = 0; m < 4; m += 2) {
                const int row = u.m0 + ai * HALF + wr * 64 + m * 16 + fr;
                u32x2 w[2];
#pragma unroll
                for (int q = 0; q < 2; ++q) {
                    const f32x4 g0 = acc[ai][0][m + q][0], g1 = acc[ai][0][m + q][1], u0 = acc[ai][1][m + q][0], u1 = acc[ai][1][m + q][1];
                    w[q].x = pk4_fp8(silu_fast(g0[0]) * u0[0], silu_fast(g0[1]) * u0[1], silu_fast(g0[2]) * u0[2], silu_fast(g0[3]) * u0[3]);
                    w[q].y = pk4_fp8(silu_fast(g1[0]) * u1[0], silu_fast(g1[1]) * u1[1], silu_fast(g1[2]) * u1[2], silu_fast(g1[3]) * u1[3]);
                }
                store_pair16_fq(H + (size_t)row * FF + hc, H + (size_t)(row + 16) * FF + hc, w[0], w[1], fq);
            }
    }
};
struct EpiY {
    static constexpr bool PERM = true, HAS_PRE = true;
    unsigned char* Y; const float* gate;
    __device__ __forceinline__ void pre(float (&gv)[8], const Unit& u, int wr, int fr) const {
#pragma unroll
        for (int ai = 0; ai < 2; ++ai)
#pragma unroll
            for (int m = 0; m < 4; ++m) gv[ai * 4 + m] = gate[u.m0 + ai * HALF + wr * 64 + m * 16 + fr];
    }
    __device__ __forceinline__ void operator()(const f32x4 (&acc)[2][2][4][2], const Unit& u, int wr, int wc, int fr, int fq, const float (&gv)[8]) const {
#pragma unroll
        for (int ai = 0; ai < 2; ++ai)
#pragma unroll
            for (int m = 0; m < 4; m += 2) {
                const int row = u.m0 + ai * HALF + wr * 64 + m * 16 + fr;
#pragma unroll
                for (int bj = 0; bj < 2; ++bj) {
                    u32x2 w[2];
#pragma unroll
                    for (int q = 0; q < 2; ++q) { const float gt = gv[ai * 4 + m + q] * 64.0f;
                        const f32x4 v0 = acc[ai][bj][m + q][0] * gt, v1 = acc[ai][bj][m + q][1] * gt;
                        w[q].x = pk4_fp8(v0[0], v0[1], v0[2], v0[3]); w[q].y = pk4_fp8(v1[0], v1[1], v1[2], v1[3]); }
                    unsigned char* p0 = Y + (size_t)row * D + u.pn * BM + bj * HALF + wc * 32 + 8 * fq;
                    store_pair16_fq(p0, p0 + (size_t)16 * D, w[0], w[1], fq);
                }
            }
    }
};
}

struct Args { const float* in[19]; float* out; unsigned char* ws; int ph_lo, ph_hi; };
struct Ctx {
    Ptrs p; LAS unsigned char* lds;
    float *tab, *mod, *aff, *gate, *xc, *xl; int *sel, *tokslot;
    bf16_t *win, *wout, *P, *H, *Y, *MIX, *HX2, *HX, *XB; float* TMP; int wv;
};
template <class Dest>
__device__ __forceinline__ void transpose_item_fp8(const float* W, int K, int N, unsigned char* WT, LAS float* scr, int item, int lane, Dest dest) {
    const int nblk = N / 32, kb = item / nblk, nb = item % nblk, k0 = 64 * kb, n0 = 32 * nb;
    float wv[32];
#pragma unroll
    for (int i = 0; i < 32; ++i) wv[i] = W[(size_t)(k0 + 2 * i + (lane >> 5)) * N + n0 + (lane & 31)];
#pragma unroll
    for (int i = 0; i < 32; ++i) { const int kk = 2 * i + (lane >> 5); scr[kk * 33 + (lane & 31)] = wv[i] * 64.0f; }
    LDS_WAIT(); asm volatile("" ::: "memory");
    const int c = lane & 7;
#pragma unroll
    for (int j = 0; j < 4; ++j) { const int n = (lane >> 3) + 8 * j; const LAS float* s = scr + (8 * c) * 33 + n;
        u32x2 o; o.x = pg::pk4_fp8(s[0 * 33], s[1 * 33], s[2 * 33], s[3 * 33]); o.y = pg::pk4_fp8(s[4 * 33], s[5 * 33], s[6 * 33], s[7 * 33]);
        *(u32x2*)(WT + (size_t)dest(n0 + n) * K + k0 + 8 * c) = o; }
    LDS_WAIT(); asm volatile("" ::: "memory");
}
template <class Dest>
__device__ __forceinline__ void transpose_item(const float* W, int K, int N, bf16_t* WT, LAS float* scr, int item, int lane, Dest dest) {
    const int nblk = N / 32, kb = item / nblk, nb = item % nblk, k0 = 64 * kb, n0 = 32 * nb;
#pragma unroll 8
    for (int i = 0; i < 32; ++i) { const int kk = 2 * i + (lane >> 5); scr[kk * 33 + (lane & 31)] = W[(size_t)(k0 + kk) * N + n0 + (lane & 31)]; }
    LDS_WAIT(); asm volatile("" ::: "memory");
    const int c = lane & 7;
#pragma unroll
    for (int j = 0; j < 4; ++j) { const int n = (lane >> 3) + 8 * j; const LAS float* s = scr + (8 * c) * 33 + n;
        u32x4 o; o.x = cvt_pk_bf16(s[0 * 33], s[1 * 33]); o.y = cvt_pk_bf16(s[2 * 33], s[3 * 33]); o.z = cvt_pk_bf16(s[4 * 33], s[5 * 33]); o.w = cvt_pk_bf16(s[6 * 33], s[7 * 33]);
        *(u32x4*)(WT + (size_t)dest(n0 + n) * K + k0 + 8 * c) = o; }
    LDS_WAIT(); asm volatile("" ::: "memory");
}
HD int invA(int q) { const int g = q / 32, r = q % 32; return 32 * g + (r < 16 ? 2 * r : 2 * (r - 16) + 1); }
HD int invD(int q) { const int g = q / 16, r = q % 16; return 16 * g + (r < 8 ? 2 * r : 2 * (r - 8) + 1); }
HD int inproj_dst_row(int nl) {
    if (nl < C_VA) return (nl / 64) * 64 + invA(nl % 64);
    if (nl >= C_QD && nl < C_VD) return (nl / 32) * 32 + invD(nl % 32);
    return nl;
}
struct DestIn { __device__ int operator()(int n) const { return inproj_dst_row(n); } };
struct DestId { __device__ int operator()(int n) const { return n; } };
struct DestGU { int up; __device__ int operator()(int n) const { return (n / 128) * 256 + up * 128 + n % 128; } };

__device__ __forceinline__ void phase_prologue(const Ctx& C) {
    const int tid = tid_l(), lane = tid & 63, wave = __builtin_amdgcn_readfirstlane(tid >> 6), gw = blockIdx.x * NWV + wave, NGW = gridDim.x * NWV; (void)lane; (void)gw; (void)NGW;
    for (long g = (long)tid * gridDim.x + blockIdx.x; g < (long)(NROWS + 64) * 24; g += (long)gridDim.x * NT) {
        const int pos = (int)(g / 24), f = (int)(g % 24);
        const float inv = f < 16 ? exp2f(-(float)f * (13.287712379549449f / 16.0f)) : exp2f(-(float)(f - 16) * (13.287712379549449f / 8.0f));
        const bool isrow = pos < NROWS; const int p = isrow ? pos : pos - NROWS;
        const float ang = (float)p * inv; float sn, cs; sincosf(ang, &sn, &cs);
        const int idx = f < 16 ? (isrow ? T_AROW : T_ACOL) + (p * 16 + f) * 2 : (isrow ? T_DROW : T_DCOL) + (p * 8 + (f - 16)) * 2;
        C.tab[idx] = cs; C.tab[idx + 1] = sn;
    }
    LAS float* sl = (LAS float*)C.lds;
    for (int i = tid; i < (NB + 1) * D; i += NT) { const int b = i / D, k = i % D; sl[i] = silu_f(b < NB ? C.p.c[b * D + k] : C.p.c_ctx[k]); }
    __syncthreads();
    constexpr int NBR = NB + 1, BG = 11, NBG = NBR / BG; static_assert(NBG * BG == NBR, "adaLN rows reduced in groups of 11");
    LAS float* pbuf = (LAS float*)(C.lds + NBR * D * 4);
    static_assert(NBR * D * 4 + 16 * BG * 32 * 4 <= LDS_MISC, "prologue LDS");
    for (int task = blockIdx.x; task < DEPTH * 6 * D / 32; task += gridDim.x) {
        const int jg = task * 32, l = jg / (6 * D), j0 = jg % (6 * D), c = lane & 31, half = lane >> 5, kb = 128 * wave + 64 * half;
        f32x2_t acc2[NBR];
#pragma unroll
        for (int b = 0; b < NBR; ++b) acc2[b] = (f32x2_t){0.f, 0.f};
        const float* w = C.p.w_ada + ((size_t)l * D + kb) * 6 * D + j0 + c; const LAS float* s0 = sl + kb;
        for (int kk = 0; kk < 64; kk += 4) {
            const f32x2_t w01 = (f32x2_t){w[(size_t)kk * 6 * D], w[(size_t)(kk + 1) * 6 * D]}, w23 = (f32x2_t){w[(size_t)(kk + 2) * 6 * D], w[(size_t)(kk + 3) * 6 * D]};
#pragma unroll
            for (int rr = 0; rr < NBG; ++rr) { f32x4 sv[BG]; const unsigned sa = (unsigned)(size_t)(s0 + rr * BG * D + kk);
                LDS_RD11_B128(sv, sa, D * 4);
#pragma unroll
                for (int bb = 0; bb < BG; ++bb) { acc2[rr * BG + bb] = __builtin_elementwise_fma((f32x2_t){sv[bb][0], sv[bb][1]}, w01, acc2[rr * BG + bb]);
                    acc2[rr * BG + bb] = __builtin_elementwise_fma((f32x2_t){sv[bb][2], sv[bb][3]}, w23, acc2[rr * BG + bb]); } }
        }
        float acc[NBR];
#pragma unroll
        for (int b = 0; b < NBR; ++b) acc[b] = acc2[b][0] + acc2[b][1];
#pragma unroll
        for (int rr = 0; rr < NBG; ++rr) {
#pragma unroll
            for (int bb = 0; bb < BG; ++bb) pbuf[((wave * 2 + half) * BG + bb) * 32 + c] = acc[rr * BG + bb];
            __syncthreads();
            if (tid < BG * 32) { const int bb = tid / 32, cc = tid % 32; float s = 0.f;
#pragma unroll
                for (int p = 0; p < 16; ++p) s += pbuf[(p * BG + bb) * 32 + cc];
                C.mod[((size_t)l * NBR + rr * BG + bb) * 6 * D + j0 + cc] = s + C.p.b_ada[l * 6 * D + j0 + cc]; }
            __syncthreads();
        }
    }
    __syncthreads();
    LAS float* scr = (LAS float*)(C.lds + wave * 16384);
    constexpr int I_OUT = (D / 64) * (D / 32);
    for (int it = gw; it < DEPTH * I_OUT; it += NGW) { const int l = it / I_OUT, r = it % I_OUT;
        transpose_item(C.p.w_out + (size_t)l * D * D, D, D, C.wout + (size_t)l * D * D, scr, r, lane, DestId{}); }
    float* wss = (float*)(C.p.ws + WS_CTL + CTL_WINMAX);
    LAS float* pm = (LAS float*)(C.lds + 8 * 16384);
    __syncthreads();
    for (int slot = blockIdx.x; slot < DEPTH * 256; slot += gridDim.x) {
        const int l = slot / 256, s = slot % 256; constexpr int PER = D * PROJ / 256;
        const float* w = C.p.w_in + (size_t)l * D * PROJ + (size_t)s * PER; float acc = 0.f;
        for (int i = tid; i < PER / 4; i += NT) { const f32x4 v = *(const f32x4*)(w + 4 * i); acc += (v[0] * v[0] + v[1] * v[1]) + (v[2] * v[2] + v[3] * v[3]); }
        acc = wave_sum(acc); if (lane == 0) pm[wave] = acc;
        __syncthreads();
        if (tid == 0) { float t = 0.f; for (int q = 0; q < NWV; ++q) t += pm[q]; wss[slot] = t; }
        __syncthreads();
    }
    __syncthreads();
}
__device__ __forceinline__ float win_amax(const unsigned char* ws, int l, int lane) {
    const float* wss = (const float*)(ws + WS_CTL + CTL_WINMAX) + l * 256;
    const float t = wave_sum((wss[lane] + wss[lane + 64]) + (wss[lane + 128] + wss[lane + 192]));
    return 4.0f * sqrtf(t * (1.0f / ((float)D * (float)PROJ)));
}
__device__ __forceinline__ void phase_prologue_b(const Ctx& C) {
    const int tid = tid_l(), lane = tid & 63, wave = __builtin_amdgcn_readfirstlane(tid >> 6), gw = blockIdx.x * NWV + wave, NGW = gridDim.x * NWV;
    LAS float* scr = (LAS float*)(C.lds + wave * 16384);
    constexpr int I_IN = (D / 64) * (PROJ / 32);
    for (int it = gw; it < DEPTH * I_IN; it += NGW) {
        const int l = it / I_IN, item = it % I_IN, nblk = PROJ / 32, kb = item / nblk, nb = item % nblk, k0 = 64 * kb, n0 = 32 * nb;
        const float* W = C.p.w_in + (size_t)l * D * PROJ; signed char* WT = (signed char*)C.win + (size_t)l * PROJ * D;
        { const int nl = n0 + (lane & 31); const float am = win_amax(C.p.ws, l, lane); const float inv = am > 0.f ? 127.0f / am : 0.f;
#pragma unroll 8
          for (int i = 0; i < 32; ++i) { const int kk = 2 * i + (lane >> 5); scr[kk * 33 + (lane & 31)] = W[(size_t)(k0 + kk) * PROJ + nl] * inv; } }
        LDS_WAIT(); asm volatile("" ::: "memory");
        const int c = lane & 7;
#pragma unroll
        for (int j = 0; j < 4; ++j) { const int n = (lane >> 3) + 8 * j; const LAS float* s = scr + (8 * c) * 33 + n; unsigned lo = 0u, hi = 0u;
#pragma unroll
            for (int q = 0; q < 4; ++q) { lo |= ((unsigned)__float2int_rn(fminf(fmaxf(s[q * 33], -127.f), 127.f)) & 0xffu) << (8 * q); hi |= ((unsigned)__float2int_rn(fminf(fmaxf(s[(4 + q) * 33], -127.f), 127.f)) & 0xffu) << (8 * q); }
            *(u32x2*)(WT + (size_t)inproj_dst_row(n0 + n) * D + k0 + 8 * c) = (u32x2){lo, hi}; }
        LDS_WAIT(); asm volatile("" ::: "memory");
    }
    __syncthreads();
}
constexpr int CVT_ITEMS = 3 * NE * (D / 64) * (FF / 32);
struct CvtItem { const float* src; unsigned char* dst; int mat, n0; };
__device__ __forceinline__ CvtItem cvt_decode(const Ctx& C, int l, int it, int lane) {
    constexpr int I_E = (D / 64) * (FF / 32), NBLK = FF / 32;
    const int mat = it / (NE * I_E), e = (it / I_E) % NE, r = it % I_E, kb = r / NBLK, nb = r % NBLK, k0 = 64 * kb, n0 = 32 * nb;
    const size_t wo = ((size_t)l * NE + e) * D * FF;
    const float* W = mat == 0 ? C.p.w_gate + wo : mat == 1 ? C.p.w_up + wo : C.p.w_down + wo;
    unsigned char* wgu = C.p.ws + WS_WGU + (size_t)(l & 1) * NE * 2 * FF * D; unsigned char* wd = C.p.ws + WS_WD + (size_t)(l & 1) * NE * D * FF;
    CvtItem c; c.src = W + (size_t)(k0 + (lane >> 5)) * FF + n0 + (lane & 31); c.dst = (mat == 2 ? wd + (size_t)e * D * FF : wgu + (size_t)e * 2 * FF * D) + k0; c.mat = mat; c.n0 = n0;
    return c;
}
__device__ __forceinline__ void phase_cvt_experts(const Ctx& C, int l, int it0, int it1, int w, int nw) {
    static_assert(D == FF, "expert matrices are square");
    const int tid = tid_l(), lane = tid & 63, wave = __builtin_amdgcn_readfirstlane(tid >> 6);
    LAS float* scr = (LAS float*)(C.lds + wave * 16384);
    float ra[32], rb[32];
    auto issue = [&](float (&r)[32], const CvtItem& c) {
#pragma unroll
        for (int i = 0; i < 32; ++i) r[i] = c.src[(size_t)(2 * i) * FF]; };
    auto process = [&](float (&r)[32], const CvtItem& cur) {
#pragma unroll
        for (int i = 0; i < 32; ++i) { const int kk = 2 * i + (lane >> 5); scr[kk * 33 + (lane & 31)] = r[i] * 64.0f; }
        LDS_WAIT(); asm volatile("" ::: "memory");
        const int c = lane & 7;
#pragma unroll
        for (int j = 0; j < 4; ++j) { const int n = cur.n0 + (lane >> 3) + 8 * j; const LAS float* sp = scr + (8 * c) * 33 + (lane >> 3) + 8 * j;
            u32x2 o; o.x = pg::pk4_fp8(sp[0 * 33], sp[1 * 33], sp[2 * 33], sp[3 * 33]); o.y = pg::pk4_fp8(sp[4 * 33], sp[5 * 33], sp[6 * 33], sp[7 * 33]);
            const int drow = cur.mat == 2 ? n : (n / 128) * 256 + cur.mat * 128 + n % 128;
            *(u32x2*)(cur.dst + (size_t)drow * D + 8 * c) = o; }
        LDS_WAIT(); asm volatile("" ::: "memory"); };
    int it = it0 + w;
    CvtItem ca{}, cb{};
    if (it < it1) { ca = cvt_decode(C, l, it, lane); issue(ra, ca); }
    while (it < it1) {
        cb = cvt_decode(C, l, it + nw < it1 ? it + nw : it, lane); issue(rb, cb);
        process(ra, ca);
        it += nw; if (it >= it1) break;
        ca = cvt_decode(C, l, it + nw < it1 ? it + nw : it, lane); issue(ra, ca);
        process(rb, cb);
        it += nw;
    }
    __syncthreads();
}
__device__ __forceinline__ void yf8_add(f32x4& a, const unsigned w, const float wf) {
    const f32x2_t lo = __builtin_amdgcn_cvt_pk_f32_fp8((int)w, false), hi = __builtin_amdgcn_cvt_pk_f32_fp8((int)w, true);
    a[0] += wf * lo[0]; a[1] += wf * lo[1]; a[2] += wf * hi[0]; a[3] += wf * hi[1];
}
template <bool FINAL, bool SRCF32>
__device__ __forceinline__ void phase_rowA(const Ctx& C, int l, float gscale = 1.0f) {
    const int tid = tid_l(), lane = tid & 63, wave = __builtin_amdgcn_readfirstlane(tid >> 6), gw = blockIdx.x * NWV + wave, NGW = gridDim.x * NWV;
    const int nrows = FINAL ? RL : RALL;
    const int per = (nrows + NGW - 1) / NGW, r0 = gw * per, r1 = (r0 + per < nrows) ? r0 + per : nrows;
#define RA_LOADX(dst, row) do { if (SRCF32) { const float* _s = ((row) < RL ? C.p.x + (size_t)(row) * D : C.p.ctx + (size_t)((row) - RL) * D); _Pragma("unroll") for (int j = 0; j < 4; ++j) dst[j] = __builtin_bit_cast(u32x4, *(const f32x4*)(_s + 4 * lane + 256 * j)); } \
        else { const bf16_t* _s = C.XB + (size_t)(row) * D + 4 * lane; _Pragma("unroll") for (int j = 0; j < 4; ++j) { const u32x2 _w = *(const u32x2*)(_s + 256 * j); dst[j] = (u32x4){_w.x, _w.y, 0u, 0u}; } } } while (0)
#define RA_LOADTS(dst, row) do { dst = (l > 0 && lane < NE) ? C.tokslot[(size_t)(row) * NE + lane] : -1; } while (0)
#define RA_ISSUEY(YY, WF, MSK, ts) do { unsigned _m = (unsigned)__ballot((ts) >= 0); int _s0 = 0, _s1, _s2, _s3; WF[0] = WF[1] = WF[2] = WF[3] = 0.f; \
        if (_m) { _s0 = __builtin_amdgcn_readlane((ts), __builtin_ctz(_m)); _m &= _m - 1; WF[0] = 1.f; } _s1 = _s2 = _s3 = _s0; \
        if (_m) { _s1 = __builtin_amdgcn_readlane((ts), __builtin_ctz(_m)); _m &= _m - 1; WF[1] = 1.f; } \
        if (_m) { _s2 = __builtin_amdgcn_readlane((ts), __builtin_ctz(_m)); _m &= _m - 1; WF[2] = 1.f; } \
        if (_m) { _s3 = __builtin_amdgcn_readlane((ts), __builtin_ctz(_m)); _m &= _m - 1; WF[3] = 1.f; } MSK = _m; \
        _Pragma("unroll") for (int j = 0; j < 4; ++j) { YY[0][j] = *(const unsigned*)(Yb + (size_t)_s0 * D + 4 * lane + 256 * j); YY[1][j] = *(const unsigned*)(Yb + (size_t)_s1 * D + 4 * lane + 256 * j); \
            YY[2][j] = *(const unsigned*)(Yb + (size_t)_s2 * D + 4 * lane + 256 * j); YY[3][j] = *(const unsigned*)(Yb + (size_t)_s3 * D + 4 * lane + 256 * j); } } while (0)
    const unsigned char* Yb = (const unsigned char*)C.Y;
    u32x4 xc[4], xn[4], x2[4]; int tsc = -1, tsn = -1, ts2 = -1; unsigned yc[4][4], yn[4][4]; float wc_[4], wn_[4]; unsigned mc = 0u, mn = 0u;
    f32x4 A[4], S[4], G[4]; int bcur = -1;
#pragma unroll
    for (int j = 0; j < 4; ++j) { xc[j] = xn[j] = x2[j] = (u32x4){0u, 0u, 0u, 0u}; A[j] = S[j] = G[j] = (f32x4){0.f, 0.f, 0.f, 0.f}; }
#pragma unroll
    for (int i = 0; i < 4; ++i) { wc_[i] = wn_[i] = 0.f;
#pragma unroll
        for (int j = 0; j < 4; ++j) yc[i][j] = yn[i][j] = 0u; }
    if (r0 < r1) { RA_LOADTS(tsc, r0); RA_LOADX(xc, r0); if (l > 0) RA_ISSUEY(yc, wc_, mc, tsc); }
    if (r0 + 1 < r1) { RA_LOADTS(tsn, r0 + 1); RA_LOADX(xn, r0 + 1); }
    for (int row = r0; row < r1; ++row) {
        if (l > 0 && row + 1 < r1) RA_ISSUEY(yn, wn_, mn, tsn);
        if (row + 2 < r1) { RA_LOADTS(ts2, row + 2); RA_LOADX(x2, row + 2); }
        const int b = row_batch(row);
        if (b != bcur) { bcur = b;
            if (FINAL) {
#pragma unroll
                for (int j = 0; j < 4; ++j) A[j] = *(const f32x4*)(C.p.norm_final + 4 * lane + 256 * j);
            } else { const float* m = C.mod + ((size_t)l * (NB + 1) + b) * 6 * D + 4 * lane; const float* nw = C.p.norm1 + (size_t)l * D + 4 * lane;
#pragma unroll
                for (int j = 0; j < 4; ++j) { A[j] = *(const f32x4*)(nw + 256 * j) * (*(const f32x4*)(m + M_SC1 + 256 * j) + 1.0f); S[j] = *(const f32x4*)(m + M_SH1 + 256 * j); } }
            if (l > 0) { const float* g2 = C.mod + ((size_t)(l - 1) * (NB + 1) + b) * 6 * D + M_G2 + 4 * lane;
#pragma unroll
                for (int j = 0; j < 4; ++j) G[j] = *(const f32x4*)(g2 + 256 * j) * (gscale * (1.0f / 64.0f)); } }
        f32x4 v[4];
#pragma unroll
        for (int j = 0; j < 4; ++j) { if (SRCF32) v[j] = __builtin_bit_cast(f32x4, xc[j]); else { const unsigned w0 = xc[j][0], w1 = xc[j][1];
            v[j] = (f32x4){__builtin_bit_cast(float, w0 << 16), __builtin_bit_cast(float, w0 & 0xffff0000u), __builtin_bit_cast(float, w1 << 16), __builtin_bit_cast(float, w1 & 0xffff0000u)}; } }
        if (l > 0) {
            f32x4 a[4];
#pragma unroll
            for (int j = 0; j < 4; ++j) { a[j] = (f32x4){0.f, 0.f, 0.f, 0.f};
#pragma unroll
                for (int i = 0; i < 4; ++i) yf8_add(a[j], yc[i][j], wc_[i]); }
            while (mc) { const int s = __builtin_amdgcn_readlane(tsc, __builtin_ctz(mc)); mc &= mc - 1;
#pragma unroll
                for (int j = 0; j < 4; ++j) yf8_add(a[j], *(const unsigned*)(Yb + (size_t)s * D + 4 * lane + 256 * j), 1.0f); }
#pragma unroll
            for (int j = 0; j < 4; ++j) v[j] = v[j] + G[j] * a[j];
        }
        float ss = 0.f;
#pragma unroll
        for (int j = 0; j < 4; ++j) ss += (v[j][0] * v[j][0] + v[j][1] * v[j][1]) + (v[j][2] * v[j][2] + v[j][3] * v[j][3]);
        const float rstd = 1.0f / sqrtf(wave_sum(ss) * (1.0f / D) + EPS);
        if (FINAL) {
            float* dst = C.p.out + (size_t)row * D;
#pragma unroll
            for (int j = 0; j < 4; ++j) *(f32x4*)(dst + 4 * lane + 256 * j) = v[j] * rstd * A[j];
        } else {
            bf16_t* xo = C.XB + (size_t)row * D + 4 * lane;
#pragma unroll
            for (int j = 0; j < 4; ++j) { u32x2 w; w.x = cvt_pk_bf16(v[j][0], v[j][1]); w.y = cvt_pk_bf16(v[j][2], v[j][3]); *(u32x2*)(xo + 256 * j) = w; }
            f32x4 hq[4]; float am = 0.f;
#pragma unroll
            for (int j = 0; j < 4; ++j) { hq[j] = v[j] * rstd * A[j] + S[j]; am = fmaxf(fmaxf(am, fmaxf(fabsf(hq[j][0]), fabsf(hq[j][1]))), fmaxf(fabsf(hq[j][2]), fabsf(hq[j][3]))); }
            am = wave_max(am); const float inv = am > 0.f ? 127.0f / am : 0.f;
            if (lane == 0) ((float*)(C.p.ws + WS_HXS))[row] = am * (1.0f / 127.0f);
            unsigned char* hr = (unsigned char*)C.HX + (size_t)row * D + 4 * lane;
#pragma unroll
            for (int j = 0; j < 4; ++j) { const unsigned w = ((unsigned)__float2int_rn(fminf(fmaxf(hq[j][0] * inv, -127.f), 127.f)) & 0xffu) | (((unsigned)__float2int_rn(fminf(fmaxf(hq[j][1] * inv, -127.f), 127.f)) & 0xffu) << 8) | (((unsigned)__float2int_rn(fminf(fmaxf(hq[j][2] * inv, -127.f), 127.f)) & 0xffu) << 16) | (((unsigned)__float2int_rn(fminf(fmaxf(hq[j][3] * inv, -127.f), 127.f)) & 0xffu) << 24);
                *(unsigned*)(hr + 256 * j) = w; }
        }
        tsc = tsn; tsn = ts2; mc = mn;
#pragma unroll
        for (int j = 0; j < 4; ++j) { xc[j] = xn[j]; xn[j] = x2[j]; }
#pragma unroll
        for (int i = 0; i < 4; ++i) { wc_[i] = wn_[i];
#pragma unroll
            for (int j = 0; j < 4; ++j) yc[i][j] = yn[i][j]; }
    }
#undef RA_LOADX
#undef RA_LOADTS
#undef RA_ISSUEY
}
__device__ __forceinline__ void phase_rowB(const Ctx& C, int l, int nq) {
    const int tid = tid_l(), lane = tid & 63, wave = __builtin_amdgcn_readfirstlane(tid >> 6), gw = blockIdx.x * NWV + wave, NGW = gridDim.x * NWV;
    LAS float* R = (LAS float*)C.lds;
    const float* rt = C.p.router + (size_t)l * D * NE;
    for (int i = tid; i < D * NE; i += NT) R[(i % NE) * D + i / NE] = rt[i];
    __syncthreads();
    const int per = (nq + NGW - 1) / NGW, r0 = gw * per, r1 = (r0 + per < nq) ? r0 + per : nq;
    f32x4 xn[4], A[4], S[4]; int bcur = -1; int row = r0;
    u32x2 xr_[4];
    if (row < r1) { const bf16_t* s = C.XB + (size_t)row * D + 4 * lane;
#pragma unroll
        for (int j = 0; j < 4; ++j) xr_[j] = *(const u32x2*)(s + 256 * j); }
    for (; row < r1; ++row) {
        f32x4 v[4]; float ss = 0.f;
#pragma unroll
        for (int j = 0; j < 4; ++j) xn[j] = (f32x4){__builtin_bit_cast(float, xr_[j].x << 16), __builtin_bit_cast(float, xr_[j].x & 0xffff0000u), __builtin_bit_cast(float, xr_[j].y << 16), __builtin_bit_cast(float, xr_[j].y & 0xffff0000u)};
        const int b = row_batch(row);
        if (b != bcur) { bcur = b; const float* m = C.mod + ((size_t)l * (NB + 1) + b) * 6 * D + 4 * lane; const float* nw = C.p.norm2 + (size_t)l * D + 4 * lane;
#pragma unroll
            for (int j = 0; j < 4; ++j) { A[j] = *(const f32x4*)(nw + 256 * j) * (*(const f32x4*)(m + M_SC2 + 256 * j) + 1.0f); S[j] = *(const f32x4*)(m + M_SH2 + 256 * j); } }
#pragma unroll
        for (int j = 0; j < 4; ++j) { v[j] = xn[j]; ss += (v[j][0] * v[j][0] + v[j][1] * v[j][1]) + (v[j][2] * v[j][2] + v[j][3] * v[j][3]); }
        if (row + 1 < r1) { const bf16_t* s = C.XB + (size_t)(row + 1) * D + 4 * lane;
#pragma unroll
            for (int j = 0; j < 4; ++j) xr_[j] = *(const u32x2*)(s + 256 * j); }
        const float rstd = 1.0f / sqrtf(wave_sum(ss) * (1.0f / D) + EPS);
        unsigned char* hr = (unsigned char*)C.HX2 + (size_t)row * D + 4 * lane;
#pragma unroll
        for (int j = 0; j < 4; ++j) { v[j] = v[j] * rstd * A[j] + S[j]; *(unsigned*)(hr + 256 * j) = pg::pk4_fp8(v[j][0], v[j][1], v[j][2], v[j][3]); }
        float p[NE];
        { f32x2_t q[NE];
#pragma unroll
          for (int e = 0; e < NE; ++e) q[e] = (f32x2_t){0.f, 0.f};
          f32x4 ra_[8], rb_[8]; const unsigned rbase = (unsigned)(size_t)(R + 4 * lane);
          LDS_ISSUE8_B128(ra_, rbase, D * 4);
#pragma unroll
          for (int k = 0; k < 8; k += 2) {
              const f32x2_t vlo = (f32x2_t){v[k >> 1][0], v[k >> 1][1]}, vhi = (f32x2_t){v[k >> 1][2], v[k >> 1][3]};
              LDS_ISSUE8_B128(rb_, rbase + (unsigned)((8 * D + 256 * (k >> 1)) * 4), D * 4); LDS_WAIT8(ra_, 8);
#pragma unroll
              for (int e = 0; e < 8; ++e) { q[e] = __builtin_elementwise_fma(vlo, (f32x2_t){ra_[e][0], ra_[e][1]}, q[e]); q[e] = __builtin_elementwise_fma(vhi, (f32x2_t){ra_[e][2], ra_[e][3]}, q[e]); }
              if (k + 2 < 8) { LDS_ISSUE8_B128(ra_, rbase + (unsigned)(256 * ((k >> 1) + 1) * 4), D * 4); LDS_WAIT8(rb_, 8); } else { LDS_WAIT8(rb_, 0); }
#pragma unroll
              for (int e = 0; e < 8; ++e) { q[8 + e] = __builtin_elementwise_fma(vlo, (f32x2_t){rb_[e][0], rb_[e][1]}, q[8 + e]); q[8 + e] = __builtin_elementwise_fma(vhi, (f32x2_t){rb_[e][2], rb_[e][3]}, q[8 + e]); }
          }
#pragma unroll
          for (int e = 0; e < NE; ++e) p[e] = q[e][0] + q[e][1]; }
#pragma unroll
        for (int j = 0; j < 8; ++j) { auto rr = __builtin_amdgcn_permlane32_swap(__float_as_uint(p[j]), __float_as_uint(p[j + 8]), false, false); p[j] = __uint_as_float(rr[0]) + __uint_as_float(rr[1]); }
#pragma unroll
        for (int j = 0; j < 4; ++j) { auto rr = __builtin_amdgcn_permlane16_swap(__float_as_uint(p[j]), __float_as_uint(p[j + 4]), false, false); p[j] = __uint_as_float(rr[0]) + __uint_as_float(rr[1]); }
#pragma unroll
        for (int j = 0; j < 2; ++j) { const float a = p[j] + dpp_f(p[j], 3), b2 = p[j + 2] + dpp_f(p[j + 2], 3); p[j] = (lane & 8) ? b2 : a; }
        float lg; { const float a = p[0] + dpp_f(p[0], 2), b2 = p[1] + dpp_f(p[1], 2); lg = (lane & 4) ? b2 : a; }
        lg += dpp_f(lg, 1); lg += dpp_f(lg, 0);
        const float mx = wave_max(lg);
        const float ex = expf(lg - mx); const float se = wave_sum(ex) * 0.25f;
        const int e = ((lane >> 5) & 1) * 8 + ((lane >> 4) & 1) * 4 + ((lane >> 3) & 1) * 2 + ((lane >> 2) & 1);
        if ((lane & 3) == 0) C.aff[(size_t)row * NE + e] = ex / se;
    }
    __syncthreads();
}
template <int NV>
__device__ __forceinline__ void select_task(const Ctx& C, int base_row, int cap, int e, int slot0, int lane) {
    unsigned v[NV];
#pragma unroll
    for (int i = 0; i < NV; ++i) v[i] = __builtin_bit_cast(unsigned, C.aff[(size_t)(base_row + i * 64 + lane) * NE + e]);
    unsigned T = 0u;
    for (int bit = 30; bit >= 0; --bit) { const unsigned cand = T | (1u << bit); int cnt = 0;
#pragma unroll
        for (int i = 0; i < NV; ++i) cnt += __builtin_popcountll(__ballot(v[i] >= cand));
        if (cnt >= cap) T = cand; }
    int ngt = 0;
#pragma unroll
    for (int i = 0; i < NV; ++i) ngt += __builtin_popcountll(__ballot(v[i] > T));
    const int need = cap - ngt;
    const unsigned long long lt = (1ull << lane) - 1ull; int nsel = 0, neq = 0;
#pragma unroll
    for (int i = 0; i < NV; ++i) {
        const bool gt = v[i] > T, eq = v[i] == T; const unsigned long long meq = __ballot(eq);
        const bool take = gt || (eq && (neq + __builtin_popcountll(meq & lt)) < need);
        const unsigned long long msel = __ballot(take);
        const int row = base_row + i * 64 + lane; int slot = -1;
        if (take) { slot = slot0 + nsel + __builtin_popcountll(msel & lt); C.sel[slot] = row; C.gate[slot] = __builtin_bit_cast(float, v[i]); }
        C.tokslot[(size_t)row * NE + e] = slot;
        nsel += __builtin_popcountll(msel); neq += __builtin_popcountll(meq);
    }
}
__device__ __forceinline__ void phase_select(const Ctx& C, bool need_ctx) {
    const int tid = tid_l(), lane = tid & 63, wave = __builtin_amdgcn_readfirstlane(tid >> 6), gw = blockIdx.x * NWV + wave, NGW = gridDim.x * NWV; (void)lane; (void)gw; (void)NGW;
    const int ntask = NB * NE * (need_ctx ? 2 : 1);
    for (int task = wave * (int)gridDim.x + (int)blockIdx.x; task < ntask; task += NGW) {
        const int set = task / (NB * NE), b = (task / NE) % NB, e = task % NE;
        if (set == 0) select_task<SEQ / 64>(C, b * SEQ, CAPL, e, e * SLOTS_E + b * CAPL, lane);
        else select_task<CTX / 64>(C, RL + b * CTX, CAPC, e, e * SLOTS_E + SLOTS_L + b * CAPC, lane);
    }
}
namespace att {
typedef float f32x16 __attribute__((ext_vector_type(16)));
typedef short v4i16_t __attribute__((ext_vector_type(4)));
typedef __bf16 bf16x2_t __attribute__((ext_vector_type(2)));
constexpr int KSTR = 144, VSTR = 192, TILE_B = 64 * KSTR, BUF_B = TILE_B + 64 * VSTR;
constexpr float THR = 8.0f, THR_LO = 32.0f;
__device__ __forceinline__ unsigned pk2(float a, float b) { bf16x2_t v = {(__bf16)a, (__bf16)b}; return __builtin_bit_cast(unsigned, v); }
__device__ __forceinline__ float xmax32(float x) { auto rr = __builtin_amdgcn_permlane32_swap(__float_as_uint(x), __float_as_uint(x), false, false); return fmaxf(__uint_as_float(rr[0]), __uint_as_float(rr[1])); }
__device__ __forceinline__ float xsum32(float x) { auto rr = __builtin_amdgcn_permlane32_swap(__float_as_uint(x), __float_as_uint(x), false, false); return __uint_as_float(rr[0]) + __uint_as_float(rr[1]); }
__device__ __forceinline__ int crow(int reg, int h) { return (reg & 3) + 8 * (reg >> 2) + 4 * h; }
#ifndef PROBE_ATT
#define PROBE_ATT 0
#endif
#define MFMA32(a, b, c) __builtin_amdgcn_mfma_f32_32x32x16_bf16((a), (b), (c), 0, 0, 0)
__device__ __forceinline__ void store_pair16(bf16_t* rowp, u32x2 a, u32x2 b, int h) {
    auto rx = __builtin_amdgcn_permlane32_swap(a.x, b.x, false, false); auto ry = __builtin_amdgcn_permlane32_swap(a.y, b.y, false, false);
    u32x4 w; w.x = rx[0]; w.y = ry[0]; w.z = rx[1]; w.w = ry[1];
    *(u32x4*)(rowp + 8 * h) = w;
}
__device__ __forceinline__ bf16x8 ones_rows(int lane) { const unsigned v = (lane == 0 || lane == 32 || lane == 17 || lane == 49) ? 0x3F803F80u : 0u; u32x4 w; w.x = v; w.y = v; w.z = v; w.w = v; return __builtin_bit_cast(bf16x8, w); }
__device__ __forceinline__ float rowsum(const f32x4& L, int lane) { const float a = __shfl(L[0], lane & 15), b = __shfl(L[1], lane & 15); return (lane & 16) ? b : a; }

#define ATT_VTR(n, ks, hi, db) "ds_read_b64_tr_b16 %" #n ", %16 offset:" #ks "*3072+" #hi "*1536+" #db "*64\n\t"
template <int DKS, bool WAIT>
__device__ __forceinline__ void katt_read(unsigned kb_, bf16x8 (&Kf)[8], int lane) {
    const int r = lane & 31, h = lane >> 5;
    const unsigned ka = kb_ + r * KSTR + 16 * h;
    constexpr int o1 = 32, o2 = (DKS == 4) ? 64 : 32 * KSTR, o3 = (DKS == 4) ? 96 : 32 * KSTR + 32, o4 = (DKS == 4) ? 32 * KSTR : 64, o5 = (DKS == 4) ? 32 * KSTR + 32 : 96,
                  o6 = 32 * KSTR + 64, o7 = 32 * KSTR + 96;
    if constexpr (WAIT)
        asm volatile("ds_read_b128 %0, %8\n\tds_read_b128 %1, %8 offset:%c9\n\tds_read_b128 %2, %8 offset:%c10\n\tds_read_b128 %3, %8 offset:%c11\n\t"
                     "ds_read_b128 %4, %8 offset:%c12\n\tds_read_b128 %5, %8 offset:%c13\n\tds_read_b128 %6, %8 offset:%c14\n\tds_read_b128 %7, %8 offset:%c15\n\ts_waitcnt lgkmcnt(0)"
                     : "=&v"(Kf[0]), "=&v"(Kf[1]), "=&v"(Kf[2]), "=&v"(Kf[3]), "=&v"(Kf[4]), "=&v"(Kf[5]), "=&v"(Kf[6]), "=&v"(Kf[7])
                     : "v"(ka), "i"(o1), "i"(o2), "i"(o3), "i"(o4), "i"(o5), "i"(o6), "i"(o7) : "memory");
    else
        asm volatile("ds_read_b128 %0, %8\n\tds_read_b128 %1, %8 offset:%c9\n\tds_read_b128 %2, %8 offset:%c10\n\tds_read_b128 %3, %8 offset:%c11\n\t"
                     "ds_read_b128 %4, %8 offset:%c12\n\tds_read_b128 %5, %8 offset:%c13\n\tds_read_b128 %6, %8 offset:%c14\n\tds_read_b128 %7, %8 offset:%c15"
                     : "=&v"(Kf[0]), "=&v"(Kf[1]), "=&v"(Kf[2]), "=&v"(Kf[3]), "=&v"(Kf[4]), "=&v"(Kf[5]), "=&v"(Kf[6]), "=&v"(Kf[7])
                     : "v"(ka), "i"(o1), "i"(o2), "i"(o3), "i"(o4), "i"(o5), "i"(o6), "i"(o7) : "memory");
}
__device__ __forceinline__ void katt_wait(bf16x8 (&Kf)[8]) {
    asm volatile("s_waitcnt lgkmcnt(0)" : "+v"(Kf[0]), "+v"(Kf[1]), "+v"(Kf[2]), "+v"(Kf[3]), "+v"(Kf[4]), "+v"(Kf[5]), "+v"(Kf[6]), "+v"(Kf[7]) :: "memory");
}
template <int NSUB, int DKS>
__device__ __forceinline__ void flash_tile(unsigned vb_, unsigned kn_, bool has_next, const bf16x8 (&Q)[NSUB][DKS], f32x16 (&O)[NSUB][2], float (&m)[NSUB], f32x4 (&L)[NSUB], const bf16x8& onesA,
                                           bf16x8 (&Kf)[8], int lane, bool masked, int dq, bool first) {
    static_assert(NSUB * DKS == 4, "eight K fragments per tile");
    const int r = lane & 31, h = lane >> 5; (void)r;
    f32x16 S[NSUB][2];
    bool allz = true;
#pragma unroll
    for (int sub = 0; sub < NSUB; ++sub) allz = allz && __all(m[sub] == 0.f);
    if (allz) {
#pragma unroll
        for (int sub = 0; sub < NSUB; ++sub)
#pragma unroll
            for (int kb = 0; kb < 2; ++kb) {
                const f32x16 zero = {0.f, 0.f, 0.f, 0.f, 0.f, 0.f, 0.f, 0.f, 0.f, 0.f, 0.f, 0.f, 0.f, 0.f, 0.f, 0.f};
                S[sub][kb] = MFMA32(Kf[(DKS == 4) ? (kb * 4) : (kb * 2 + 4 * sub)], Q[sub][0], zero);
#pragma unroll
                for (int s = 1; s < DKS; ++s) S[sub][kb] = MFMA32(Kf[(DKS == 4) ? (kb * 4 + s) : (kb * 2 + s + 4 * sub)], Q[sub][s], S[sub][kb]);
            }
    } else {
#pragma unroll
        for (int sub = 0; sub < NSUB; ++sub)
#pragma unroll
            for (int kb = 0; kb < 2; ++kb) {
#pragma unroll
                for (int i = 0; i < 16; ++i) S[sub][kb][i] = -m[sub];
#pragma unroll
                for (int s = 0; s < DKS; ++s) S[sub][kb] = MFMA32(Kf[(DKS == 4) ? (kb * 4 + s) : (kb * 2 + s + 4 * sub)], Q[sub][s], S[sub][kb]);
            }
    }
#pragma unroll
    for (int sub = 0; sub < NSUB; ++sub) asm volatile("" : "+v"(S[sub][0]), "+v"(S[sub][1]));
    v4i16_t Vr[16];
    { const int i16 = lane & 15, q = i16 >> 2, p = i16 & 3, rblk = (lane >> 4) & 1; const unsigned va = vb_ + (4 * h + q) * VSTR + (16 * rblk + 4 * p) * 2;
      asm volatile(ATT_VTR(0, 0, 0, 0) ATT_VTR(1, 0, 1, 0) ATT_VTR(2, 0, 0, 1) ATT_VTR(3, 0, 1, 1) ATT_VTR(4, 1, 0, 0) ATT_VTR(5, 1, 1, 0) ATT_VTR(6, 1, 0, 1) ATT_VTR(7, 1, 1, 1)
                   ATT_VTR(8, 2, 0, 0) ATT_VTR(9, 2, 1, 0) ATT_VTR(10, 2, 0, 1) ATT_VTR(11, 2, 1, 1) ATT_VTR(12, 3, 0, 0) ATT_VTR(13, 3, 1, 0) ATT_VTR(14, 3, 0, 1) ATT_VTR(15, 3, 1, 1)
                   : "=&v"(Vr[0]), "=&v"(Vr[1]), "=&v"(Vr[2]), "=&v"(Vr[3]), "=&v"(Vr[4]), "=&v"(Vr[5]), "=&v"(Vr[6]), "=&v"(Vr[7]),
                     "=&v"(Vr[8]), "=&v"(Vr[9]), "=&v"(Vr[10]), "=&v"(Vr[11]), "=&v"(Vr[12]), "=&v"(Vr[13]), "=&v"(Vr[14]), "=&v"(Vr[15])
                   : "v"(va) : "memory"); }
#pragma unroll
    for (int sub = 0; sub < NSUB; ++sub) {
        if (masked) {
#pragma unroll
            for (int kb = 0; kb < 2; ++kb)
#pragma unroll
                for (int i = 0; i < 16; ++i) { const int dl = dq - (32 * kb + crow(i, h)); S[sub][kb][i] = (dl > WINDOW || dl < -WINDOW) ? -1e30f : S[sub][kb][i]; }
        }
        float mx = S[sub][0][0];
#pragma unroll
        for (int i = 1; i < 16; ++i) mx = fmaxf(mx, S[sub][0][i]);
#pragma unroll
        for (int i = 0; i < 16; ++i) mx = fmaxf(mx, S[sub][1][i]);
        mx = xmax32(mx);
        if (!__all(mx <= THR) || (first && !__all(mx >= -THR_LO))) {
            const float up = first ? mx : fmaxf(mx, 0.f), alpha = first ? 1.0f : __builtin_amdgcn_exp2f(-up); m[sub] += up;
            L[sub][0] *= alpha; L[sub][1] *= __shfl(alpha, (lane & 15) + 16);
#pragma unroll
            for (int kb = 0; kb < 2; ++kb)
#pragma unroll
                for (int i = 0; i < 16; ++i) S[sub][kb][i] -= up;
#pragma unroll
            for (int db = 0; db < 2; ++db)
#pragma unroll
                for (int i = 0; i < 16; ++i) O[sub][db][i] *= alpha;
        }
#pragma unroll
        for (int kb = 0; kb < 2; ++kb)
#pragma unroll
            for (int i = 0; i < 16; ++i) S[sub][kb][i] = __builtin_amdgcn_exp2f(S[sub][kb][i]);
        bf16x8 Pf[4];
#pragma unroll
        for (int kb = 0; kb < 2; ++kb)
#pragma unroll
            for (int s = 0; s < 2; ++s) { u32x4 w; w.x = pk2(S[sub][kb][8 * s + 0], S[sub][kb][8 * s + 1]); w.y = pk2(S[sub][kb][8 * s + 2], S[sub][kb][8 * s + 3]);
                w.z = pk2(S[sub][kb][8 * s + 4], S[sub][kb][8 * s + 5]); w.w = pk2(S[sub][kb][8 * s + 6], S[sub][kb][8 * s + 7]); Pf[2 * kb + s] = __builtin_bit_cast(bf16x8, w); }
        if (sub == 0) {
            asm volatile("s_waitcnt lgkmcnt(0)" : "+v"(Vr[0]), "+v"(Vr[1]), "+v"(Vr[2]), "+v"(Vr[3]), "+v"(Vr[4]), "+v"(Vr[5]), "+v"(Vr[6]), "+v"(Vr[7]) :: "memory");
            asm volatile("" : "+v"(Vr[8]), "+v"(Vr[9]), "+v"(Vr[10]), "+v"(Vr[11]), "+v"(Vr[12]), "+v"(Vr[13]), "+v"(Vr[14]), "+v"(Vr[15]) :: "memory");
        }
        if (sub == NSUB - 1 && has_next) katt_read<DKS, false>(kn_, Kf, lane);
#pragma unroll
        for (int ks = 0; ks < 4; ++ks) {
#pragma unroll
            for (int db = 0; db < 2; ++db) {
                const bf16x8 vf = __builtin_shufflevector(Vr[(ks * 2 + db) * 2], Vr[(ks * 2 + db) * 2 + 1], 0, 1, 2, 3, 4, 5, 6, 7);
                O[sub][db] = MFMA32(vf, Pf[ks], O[sub][db]);
            }
            L[sub] = __builtin_amdgcn_mfma_f32_16x16x32_bf16(onesA, Pf[ks], L[sub], 0, 0, 0);
        }
#pragma unroll
        for (int db = 0; db < 2; ++db) asm volatile("" : "+v"(O[sub][db]));
    }
    if (has_next) katt_wait(Kf);
}
#define ATT_STG_LOAD2(krow0, KR, VR) do { const bf16_t* _p = C.P + (size_t)((krow0) + skey) * PROJ + 8 * schunk; KR = *(const u32x4*)(_p + kcol); VR = *(const u32x4*)(_p + vcol); } while (0)
#define ATT_STG_STORE2(buf, KR, VR) do { LAS unsigned char* _d = C.lds + (buf) * BUF_B + skey * KSTR + schunk * 16; *(LAS u32x4*)_d = KR; *(LAS u32x4*)(_d + TILE_B + skey * (VSTR - KSTR)) = VR; } while (0)
#define ATT_STG_LOAD(krow0) ATT_STG_LOAD2(krow0, kreg, vreg)
#define ATT_STG_STORE(buf) ATT_STG_STORE2(buf, kreg, vreg)
#define ATT_STG_STOREB(off) do { LAS unsigned char* _d = C.lds + (off) + skey * KSTR + schunk * 16; *(LAS u32x4*)_d = kreg; *(LAS u32x4*)(_d + TILE_B + skey * (VSTR - KSTR)) = vreg; } while (0)
#define ATT_PROLOGUE(DKS_) do { { u32x4 kreg2, vreg2; ATT_STG_LOAD(ATT_TROW(0)); ATT_STG_LOAD2(ATT_TROW(1), kreg2, vreg2); ATT_STG_STORE(0); ATT_STG_STORE2(1, kreg2, vreg2); } \
    if (nt > 2) ATT_STG_LOAD(ATT_TROW(2)); __syncthreads(); katt_read<DKS_, true>((unsigned)(size_t)C.lds, Kf, lane); } while (0)

struct AUnit { int b, kvh, qb, jlo, nt, kcol, vcol; bool lat; };
__device__ __forceinline__ AUnit attnA_decode(int u) {
    constexpr int NUL = NB * NKVA * (SEQ / 64);
    AUnit U; U.lat = u < NUL; const int uu = U.lat ? u : u - NUL; const int nqb = U.lat ? SEQ / 64 : CTX / 64;
    U.b = uu / (NKVA * nqb); U.kvh = (uu / nqb) % NKVA; U.qb = uu % nqb;
    U.kcol = C_KA + U.kvh * HDIM; U.vcol = C_VA + U.kvh * HDIM;
    U.jlo = U.lat ? (2 - U.qb > 0 ? 2 - U.qb : 0) : 0; const int jhi = U.lat ? (33 - U.qb < 4 ? 33 - U.qb : 4) : -1;
    U.nt = CTX / 64 + (jhi - U.jlo + 1);
    return U;
}
__device__ __forceinline__ int attnA_trow(const AUnit& U, int i) { return i < CTX / 64 ? RL + U.b * CTX + 64 * i : U.b * SEQ + 64 * U.qb - 128 + 64 * (U.jlo + i - CTX / 64); }
__device__ __forceinline__ void phase_attnA(const Ctx& C, int l, bool need_ctx) {
    const int tid = tid_l(), lane = tid & 63, wave = __builtin_amdgcn_readfirstlane(tid >> 6), skey = tid >> 3, schunk = tid & 7;
    const int r = lane & 31, h = lane >> 5, hq = wave & 3, ph = wave >> 2;
    const bf16x8 onesA = ones_rows(lane);
    constexpr int NUL = NB * NKVA * (SEQ / 64), NUC = NB * NKVA * (CTX / 64);
    const int nu = NUL + (need_ctx ? NUC : 0);
    int u = blockIdx.x;
    if (u >= nu) return;
    AUnit cu = attnA_decode(u);
#define ATT_QROW(U) (((U).lat ? (U).b * SEQ : RL + (U).b * CTX) + 64 * (U).qb + 32 * ph + r)
#define ATT_LOADQ(QQ, U) do { const bf16_t* _q = C.P + (size_t)ATT_QROW(U) * PROJ + C_QA + ((U).kvh * GQA + hq) * HDIM + 8 * h; _Pragma("unroll") for (int s = 0; s < 4; ++s) QQ[0][s] = *(const bf16x8*)(_q + 16 * s); } while (0)
#define ATT_LOADKV(U, i) do { const bf16_t* _p = C.P + (size_t)(attnA_trow(U, i) + skey) * PROJ + 8 * schunk; kreg = *(const u32x4*)(_p + (U).kcol); vreg = *(const u32x4*)(_p + (U).vcol); } while (0)
    bf16x8 Q[1][4], Qn[1][4];
    ATT_LOADQ(Q, cu);
#pragma unroll
    for (int s = 0; s < 4; ++s) Qn[0][s] = Q[0][s];
    u32x4 kreg, vreg; bf16x8 Kf[8];
    { u32x4 kreg2, vreg2; ATT_LOADKV(cu, 0); { const bf16_t* _p = C.P + (size_t)(attnA_trow(cu, 1) + skey) * PROJ + 8 * schunk; kreg2 = *(const u32x4*)(_p + cu.kcol); vreg2 = *(const u32x4*)(_p + cu.vcol); }
      ATT_STG_STORE(0); ATT_STG_STORE2(1, kreg2, vreg2); }
    ATT_LOADKV(cu, 2); __syncthreads(); katt_read<4, true>((unsigned)(size_t)C.lds, Kf, lane);
    int s0 = 0, s1 = BUF_B, s2 = 2 * BUF_B;
    for (;;) {
        const int un = u + (int)gridDim.x; const bool hn = un < nu; const AUnit nx = attnA_decode(hn ? un : u);
        const int head = cu.kvh * GQA + hq, q0 = 64 * cu.qb + 32 * ph, qrow = ATT_QROW(cu), nt = cu.nt;
        f32x16 O[1][2]; float m[1]; f32x4 L[1];
#pragma unroll
        for (int db = 0; db < 2; ++db)
#pragma unroll
            for (int i = 0; i < 16; ++i) O[0][db][i] = 0.f;
        m[0] = 0.f; L[0] = f32x4{0.f, 0.f, 0.f, 0.f};
        for (int i = 0; i < nt; ++i) {
            if (i + 2 < nt || hn) ATT_STG_STOREB(s2);
            if (i + 3 < nt) ATT_LOADKV(cu, i + 3); else if (hn) ATT_LOADKV(nx, i + 3 - nt);
            if (i == nt - 1 && hn) ATT_LOADQ(Qn, nx);
            const bool loc = i >= CTX / 64; const int d = loc ? q0 - (64 * cu.qb - 128 + 64 * (cu.jlo + i - CTX / 64)) : 0;
            const bool masked = loc && (d > 97 || d < -65);
            const unsigned lb = (unsigned)(size_t)C.lds;
            flash_tile<1, 4>(lb + s0 + TILE_B, lb + s1, i + 1 < nt || hn, Q, O, m, L, onesA, Kf, lane, masked, d + r, i == 0);
            __syncthreads();
            { const int t = s0; s0 = s1; s1 = s2; s2 = t; }
        }
        const float inv = 1.0f / (rowsum(L[0], lane) + __builtin_amdgcn_exp2f(C.p.attn_sink[l * NHA + head] * LOG2E - m[0]));
        bf16_t* op = C.MIX + (size_t)qrow * D + head * HDIM;
#pragma unroll
        for (int db = 0; db < 2; ++db)
#pragma unroll
            for (int g = 0; g < 4; g += 2) { u32x2 w[2];
#pragma unroll
                for (int q = 0; q < 2; ++q) { w[q].x = pk2(O[0][db][4 * (g + q)] * inv, O[0][db][4 * (g + q) + 1] * inv); w[q].y = pk2(O[0][db][4 * (g + q) + 2] * inv, O[0][db][4 * (g + q) + 3] * inv); }
                store_pair16(op + 32 * db + 8 * g, w[0], w[1], h); }
        if (!hn) break;
#pragma unroll
        for (int s = 0; s < 4; ++s) Q[0][s] = Qn[0][s];
        cu = nx; u = un;
    }
#undef ATT_QROW
#undef ATT_LOADQ
#undef ATT_LOADKV
}
__device__ __forceinline__ void phase_attnD(const Ctx& C, int l, bool need_ctx) {
    const int tid = tid_l(), lane = tid & 63, wave = __builtin_amdgcn_readfirstlane(tid >> 6), skey = tid >> 3, schunk = tid & 7;
    const int r = lane & 31, h = lane >> 5;
    const bf16x8 onesA = ones_rows(lane);
    const float lam_init = 0.8f - 0.6f * expf(-0.3f * (float)l);
    float lam;
    { const float* lp = C.p.diff_lambda + l * 4 * DD; const float a = lane < DD ? lp[lane] * lp[DD + lane] : 0.f, b2 = lane < DD ? lp[2 * DD + lane] * lp[3 * DD + lane] : 0.f;
      lam = expf(wave_sum(a)) - expf(wave_sum(b2)) + lam_init; }
    constexpr int NUL = NB * NHC * (SEQ / 256), NUC = NB * NHC * (CTX / 256);
    const int nu = NUL + (need_ctx ? NUC : 0);
    for (int u = blockIdx.x; u < nu; u += gridDim.x) {
        const bool lat = u < NUL; const int uu = lat ? u : u - NUL; const int nqb = lat ? SEQ / 256 : CTX / 256;
        const int b = uu / (NHC * nqb), hd = (uu / nqb) % NHC, qb = uu % nqb;
        const int kcol = C_KD + hd * 2 * DD, vcol = C_VD + hd * 2 * DD;
        const int qrow = (lat ? b * SEQ : RL + b * CTX) + 256 * qb + 32 * wave + r;
        const int nt = CTX / 64 + (lat ? SEQ / 64 : 0);
        bf16x8 Q[2][2];
#pragma unroll
        for (int j = 0; j < 2; ++j)
#pragma unroll
            for (int s = 0; s < 2; ++s) Q[j][s] = *(const bf16x8*)(C.P + (size_t)qrow * PROJ + C_QD + hd * 2 * DD + j * DD + 16 * s + 8 * h);
        f32x16 O[2][2]; float m[2]; f32x4 L[2];
#pragma unroll
        for (int j = 0; j < 2; ++j) { m[j] = 0.f; L[j] = f32x4{0.f, 0.f, 0.f, 0.f};
#pragma unroll
            for (int db = 0; db < 2; ++db)
#pragma unroll
                for (int i = 0; i < 16; ++i) O[j][db][i] = 0.f; }
        u32x4 kreg, vreg;
#define ATT_TROW(i) ((i) < CTX / 64 ? RL + b * CTX + 64 * (i) : b * SEQ + 64 * ((i) - CTX / 64))
        bf16x8 Kf[8];
        ATT_PROLOGUE(2);
        int s0 = 0, s1 = BUF_B, s2 = 2 * BUF_B;
#if PROBE_ATT
        unsigned long long pT0 = __builtin_readcyclecounter(), ptw = 0, ptb = 0;
#endif
        for (int i = 0; i < nt; ++i) {
#if PROBE_ATT
            { const unsigned long long t1 = __builtin_readcyclecounter(); asm volatile("s_waitcnt vmcnt(0)" ::: "memory"); ptw += __builtin_readcyclecounter() - t1; }
#endif
            if (i + 2 < nt) ATT_STG_STOREB(s2);
            if (i + 3 < nt) ATT_STG_LOAD(ATT_TROW(i + 3));
            const unsigned lb = (unsigned)(size_t)C.lds;
            flash_tile<2, 2>(lb + s0 + TILE_B, lb + s1, i + 1 < nt, Q, O, m, L, onesA, Kf, lane, false, 0, i == 0);
#if PROBE_ATT
            { const unsigned long long t1 = __builtin_readcyclecounter(); __syncthreads(); ptb += __builtin_readcyclecounter() - t1; }
#else
            __syncthreads();
#endif
            { const int t = s0; s0 = s1; s1 = s2; s2 = t; }
        }
#if PROBE_ATT
        if (l == 1 && u == 100 && tid == 64 * 3) { const float T = (float)(__builtin_readcyclecounter() - pT0);
            ((float*)(C.p.ws + WS_CTL))[8] = PROBE_ATT == 1 ? 1.0e4f * (float)ptw / T : PROBE_ATT == 2 ? 1.0e4f * (float)ptb / T : T / (float)nt; }
#endif
#undef ATT_TROW
        const float i0 = 1.0f / rowsum(L[0], lane), i1 = lam / rowsum(L[1], lane);
        float ss = 0.f;
#pragma unroll
        for (int db = 0; db < 2; ++db)
#pragma unroll
            for (int i = 0; i < 16; ++i) { const float y = O[0][db][i] * i0 - O[1][db][i] * i1; O[0][db][i] = y; ss += y * y; }
        const float rn = (1.0f - lam_init) / sqrtf(xsum32(ss) * (1.0f / (2 * DD)) + EPS);
        const float* sw = C.p.diff_subln + l * 2 * DD + 4 * h;
        bf16_t* op = C.MIX + (size_t)qrow * D + 768 + hd * 2 * DD;
#pragma unroll
        for (int db = 0; db < 2; ++db)
#pragma unroll
            for (int g = 0; g < 4; g += 2) { u32x2 w[2];
#pragma unroll
                for (int q = 0; q < 2; ++q) { const f32x4 s4 = *(const f32x4*)(sw + 32 * db + 8 * (g + q));
                    w[q].x = pk2(O[0][db][4 * (g + q)] * rn * s4[0], O[0][db][4 * (g + q) + 1] * rn * s4[1]); w[q].y = pk2(O[0][db][4 * (g + q) + 2] * rn * s4[2], O[0][db][4 * (g + q) + 3] * rn * s4[3]); }
                store_pair16(op + 32 * db + 8 * g, w[0], w[1], h); }
    }
}
#undef ATT_STG_LOAD
#undef ATT_STG_STORE
#undef ATT_STG_LOAD2
#undef ATT_STG_STORE2
#undef ATT_STG_STOREB
#undef ATT_PROLOGUE
}
__device__ __forceinline__ void phase_conv(const Ctx& C, int l, int nq) {
    const int tid = tid_l();
    const float* cw = C.p.conv_w + l * 3 * CONV_CH;
    for (long g = (long)blockIdx.x * NT + tid; g < (long)(nq / 8) * (CONV_CH / 8); g += (long)gridDim.x * NT) {
        const int row0 = (int)(g / (CONV_CH / 8)) * 8, c8 = (int)(g % (CONV_CH / 8)) * 8;
        const bool lat = row0 < RL; const int t0 = lat ? row0 % SEQ : (row0 - RL) % CTX, len = lat ? SEQ : CTX;
        float u[10][8];
#pragma unroll
        for (int i = 0; i < 10; ++i) { const int tt = t0 + i - 1;
            if (tt >= 0 && tt < len) { const bf16_t* pr = C.P + (size_t)(row0 + i - 1) * PROJ + c8; const u32x4 a = *(const u32x4*)(pr + C_CIN), c = *(const u32x4*)(pr + C_CC);
#pragma unroll
                for (int k = 0; k < 4; ++k) { u[i][2 * k] = __builtin_bit_cast(float, a[k] << 16) * __builtin_bit_cast(float, c[k] << 16); u[i][2 * k + 1] = __builtin_bit_cast(float, a[k] & 0xffff0000u) * __builtin_bit_cast(float, c[k] & 0xffff0000u); } }
            else {
#pragma unroll
                for (int k = 0; k < 8; ++k) u[i][k] = 0.f; } }
        float w[3][8];
#pragma unroll
        for (int j = 0; j < 3; ++j) { const f32x4 w0 = *(const f32x4*)(cw + j * CONV_CH + c8), w1 = *(const f32x4*)(cw + j * CONV_CH + c8 + 4);
#pragma unroll
            for (int k = 0; k < 4; ++k) { w[j][k] = w0[k]; w[j][4 + k] = w1[k]; } }
#pragma unroll
        for (int i = 0; i < 8; ++i) { const u32x4 gb = *(const u32x4*)(C.P + (size_t)(row0 + i) * PROJ + C_CB + c8); u32x4 o;
#pragma unroll
            for (int k = 0; k < 4; ++k) { const float y0 = w[0][2 * k] * u[i][2 * k] + w[1][2 * k] * u[i + 1][2 * k] + w[2][2 * k] * u[i + 2][2 * k];
                const float y1 = w[0][2 * k + 1] * u[i][2 * k + 1] + w[1][2 * k + 1] * u[i + 1][2 * k + 1] + w[2][2 * k + 1] * u[i + 2][2 * k + 1];
                o[k] = att::pk2(__builtin_bit_cast(float, gb[k] << 16) * y0, __builtin_bit_cast(float, gb[k] & 0xffff0000u) * y1); }
            *(u32x4*)(C.MIX + (size_t)(row0 + i) * D + 512 + c8) = o; }
    }
}
#ifndef ATT_A
#define ATT_A 1
#endif
#ifndef ATT_D
#define ATT_D 1
#endif
__device__ __forceinline__ void phase_mix_naive(const Ctx& C, int l, int nq) {
    const int tid = tid_l(), lane = tid & 63, wave = __builtin_amdgcn_readfirstlane(tid >> 6), gw = blockIdx.x * NWV + wave, NGW = gridDim.x * NWV; (void)lane; (void)gw; (void)NGW;
    const long g0 = (long)blockIdx.x * NT + tid, gs = (long)gridDim.x * NT; const float lam_init = 0.8f - 0.6f * expf(-0.3f * (float)l);
#if !ATT_A
    for (long g = g0; g < (long)nq * NHA; g += gs) b_attnA(g, C.P, C.p.attn_sink + l * NHA, C.MIX, nq);
#endif
#if !ATT_D
    for (long g = g0; g < (long)nq * NHC * 2; g += gs) b_attnD(g, C.P, C.TMP, nq);
#endif
    (void)g0; (void)gs;
}
__device__ __forceinline__ void phase_diffpost_naive(const Ctx& C, int l, int nq) {
    const int tid = tid_l(), lane = tid & 63, wave = __builtin_amdgcn_readfirstlane(tid >> 6), gw = blockIdx.x * NWV + wave, NGW = gridDim.x * NWV; (void)lane; (void)gw; (void)NGW;
    const long g0 = (long)blockIdx.x * NT + tid, gs = (long)gridDim.x * NT; const float lam_init = 0.8f - 0.6f * expf(-0.3f * (float)l);
    for (long g = g0; g < (long)nq * NHC; g += gs) b_diffpost(g, C.TMP, C.p.diff_lambda + l * 4 * DD, C.p.diff_subln + l * 2 * DD, lam_init, C.MIX, nq);
}

#ifndef DBL
#define DBL 0
#endif
#define REP(bit) for (int _rep = 0; _rep < (((DBL) & (bit)) ? 2 : 1); ++_rep)
constexpr int CVT_PER_WAVE = 60;
constexpr int NPH = 9, PH_L0 = 2, PH_FINAL = PH_L0 + DEPTH * NPH, PH_TOTAL = PH_FINAL + 1;
__global__ void __launch_bounds__(NT, 2) mega_fwd(Args args) {
    extern __shared__ __attribute__((aligned(16))) unsigned char lds_raw[];
    Ctx C;
    { int w = __builtin_amdgcn_readfirstlane(threadIdx.x >> 6); asm volatile("" : "+s"(w)); C.wv = w; }
    C.p.x = args.in[0]; C.p.c = args.in[1]; C.p.ctx = args.in[2]; C.p.c_ctx = args.in[3]; C.p.w_ada = args.in[4]; C.p.b_ada = args.in[5]; C.p.norm1 = args.in[6]; C.p.norm2 = args.in[7];
    C.p.w_in = args.in[8]; C.p.w_out = args.in[9]; C.p.attn_sink = args.in[10]; C.p.conv_w = args.in[11]; C.p.diff_lambda = args.in[12]; C.p.diff_subln = args.in[13]; C.p.router = args.in[14];
    C.p.w_gate = args.in[15]; C.p.w_up = args.in[16]; C.p.w_down = args.in[17]; C.p.norm_final = args.in[18];
    C.p.out = args.out; C.p.ws = args.ws;
    C.lds = (LAS unsigned char*)lds_raw;
    unsigned char* ws = args.ws;
    C.tab = (float*)(ws + WS_TAB); C.mod = (float*)(ws + WS_MOD); C.aff = (float*)(ws + WS_AFF); C.sel = (int*)(ws + WS_SEL); C.gate = (float*)(ws + WS_GATE); C.tokslot = (int*)(ws + WS_TOKSLOT);
    C.xc = (float*)(ws + WS_XC); C.xl = args.out; C.win = (bf16_t*)(ws + WS_WIN); C.wout = (bf16_t*)(ws + WS_WOUT);
    C.P = (bf16_t*)(ws + WS_R1); C.H = (bf16_t*)(ws + WS_R1); C.Y = (bf16_t*)(ws + WS_R2); C.MIX = (bf16_t*)(ws + WS_R2); C.HX2 = (bf16_t*)(ws + WS_R2 + (size_t)RALL * D * 2); C.TMP = (float*)C.HX2;
    C.HX = (bf16_t*)(ws + WS_R3); C.XB = (bf16_t*)(ws + WS_XB);
    volatile LAS unsigned* misc = (volatile LAS unsigned*)(C.lds + LDS_MISC);
    { const int t0 = tid_l(); if (t0 < 64) misc[t0] = 0u; }
    __syncthreads();
    const int lo = args.ph_lo, hi = args.ph_hi;
    XcdBarrier bar; bar.bar = (unsigned*)(ws + WS_CTL) + CW_BAR; bar.x = 0; bar.st = misc; bar.wv = C.wv;
    if (hi - lo > 1) bar = xcd_barrier_post((unsigned*)(ws + WS_CTL) + CW_BAR, misc, C.wv);
#define IN(k) (lo <= (k) && (k) < hi)
#define SEAM(k) do { if (IN(k) && IN((k) + 1)) xcd_barrier(bar); } while (0)
    const int G = (int)gridDim.x, bid = (int)blockIdx.x;
    if (IN(0)) REP(512) phase_prologue(C);
    SEAM(0);
    if (IN(1)) phase_prologue_b(C);
    SEAM(1);
    for (int l = 0; l < DEPTH; ++l) {
        const int pb = PH_L0 + l * NPH; const bool need_ctx = l < DEPTH - 1; const int nq = need_ctx ? RALL : RL;
        const float* modl = C.mod + (size_t)l * (NB + 1) * 6 * D;
        const int nu1 = (RALL / 256) * (PROJ / 256), G1 = (nu1 + (nu1 + G - 1) / G - 1) / ((nu1 + G - 1) / G);
        const int nu4 = (nq / 256) * (D / 256), G4 = (nu4 + (nu4 + G - 1) / G - 1) / ((nu4 + G - 1) / G);
        const int cn1 = (G - G1) * NWV * CVT_PER_WAVE < CVT_ITEMS ? (G - G1) * NWV * CVT_PER_WAVE : CVT_ITEMS;
        const int cn4 = cn1 + (G - G4) * NWV * CVT_PER_WAVE < CVT_ITEMS ? cn1 + (G - G4) * NWV * CVT_PER_WAVE : CVT_ITEMS;
        if (IN(pb + 0)) { { const int wv_ = C.wv; REP(256) phase_cvt_experts(C, l, cn4, CVT_ITEMS, bid * NWV + wv_, G * NWV); } if (l == 0) phase_rowA<false, true>(C, 0); else phase_rowA<false, false>(C, l); if ((DBL) & 1024) { if (l == 0) phase_rowA<false, true>(C, 0); else phase_rowA<false, false>(C, l, 0.0f); } }
        SEAM(pb + 0);
        if (IN(pb + 1)) { if (bid < G1) { pg::GemmD g{(const char*)C.HX, nullptr, (const char*)C.win + (size_t)l * PROJ * D, 0, D / 2}; pg::Order S; S.init(RALL / 256, PROJ / 256, G1, bid, 0);
            pg::EpiP E{C.P, C.tab, (const float*)(ws + WS_HXS), (const float*)(ws + WS_CTL + CTL_WINMAX) + l * 256}; REP(1) pg::gemm_phase<pg::EpiP, false, 2>(C.lds, g, S, E, C.wv); }
            else phase_cvt_experts(C, l, 0, cn1, (bid - G1) * NWV + C.wv, (G - G1) * NWV); }
        SEAM(pb + 1);
        if (IN(pb + 2)) {
#if ATT_A
            REP(2) att::phase_attnA(C, l, need_ctx);
#endif
#if ATT_D
            REP(4) att::phase_attnD(C, l, need_ctx);
#endif
            phase_mix_naive(C, l, nq); REP(128) phase_conv(C, l, nq); }
        SEAM(pb + 2);
#if !ATT_D
        if (IN(pb + 3)) phase_diffpost_naive(C, l, nq);
        SEAM(pb + 3);
#endif
        if (IN(pb + 4)) { if (bid < G4) { pg::GemmD g{(const char*)C.MIX, nullptr, (const char*)(C.wout + (size_t)l * D * D), 0, D}; pg::Order S; S.init(nq / 256, D / 256, G4, bid, 0);
            pg::EpiX E{C.XB, modl, 1.0f}; pg::gemm_phase<pg::EpiX, false>(C.lds, g, S, E, C.wv);
            if ((DBL) & 2048) { pg::EpiX E0{C.XB, modl, 0.0f}; pg::gemm_phase<pg::EpiX, false>(C.lds, g, S, E0, C.wv); } }
            else phase_cvt_experts(C, l, cn1, cn4, (bid - G4) * NWV + C.wv, (G - G4) * NWV); }
        SEAM(pb + 4);
        if (IN(pb + 5)) REP(8) phase_rowB(C, l, nq);
        SEAM(pb + 5);
        if (IN(pb + 6)) REP(16) phase_select(C, need_ctx);
        SEAM(pb + 6);
        const int tpe = need_ctx ? pg::TPE_FULL : SLOTS_L / 256;
        if (IN(pb + 7)) { pg::GemmD g{(const char*)C.HX2, C.sel, (const char*)(ws + WS_WGU + (size_t)(l & 1) * NE * 2 * FF * D), (size_t)2 * FF * D, D / 2}; pg::Order S; S.init(NE * tpe, 2 * FF / 256, G, bid, tpe);
            pg::EpiH E{(unsigned char*)C.H}; REP(32) pg::gemm_phase<pg::EpiH, true, 1>(C.lds, g, S, E, C.wv); }
        SEAM(pb + 7);
        if (IN(pb + 8)) { pg::GemmD g{(const char*)C.H, nullptr, (const char*)(ws + WS_WD + (size_t)(l & 1) * NE * D * FF), (size_t)D * FF, FF / 2}; pg::Order S; S.init(NE * tpe, D / 256, G, bid, tpe);
            pg::EpiY E{(unsigned char*)C.Y, C.gate}; REP(64) pg::gemm_phase<pg::EpiY, false, 1>(C.lds, g, S, E, C.wv); }
        SEAM(pb + 8);
    }
    if (IN(PH_FINAL)) phase_rowA<true, false>(C, DEPTH);
#if PROBE_ATT
    if (hi - lo > 1) xcd_barrier(bar);
    if (bid == 100 && tid_l() == 0) { asm volatile("s_waitcnt vmcnt(0)" ::: "memory"); C.p.out[0] = ((const float*)(C.p.ws + WS_CTL))[8]; }
#endif
#undef IN
#undef SEAM
}
#endif

#ifndef HOST_TEST
#ifndef MODE
#define MODE 2
#endif
extern "C" void kernel_launch(void* const* d_in, const int* in_sizes, int n_in, void* d_out, int out_size, void* d_ws, size_t ws_size, hipStream_t stream) {
    if (n_in != 19 || out_size != RL * D || ws_size < WS_END) { fprintf(stderr, "kernel_launch: unexpected shapes (n_in %d out %d ws %zu need %zu)\n", n_in, out_size, ws_size, (size_t)WS_END); return; }
#if MODE == 0
    Ptrs p{};
    const float** f = (const float**)&p;
    for (int i = 0; i < 19; ++i) f[i] = (const float*)d_in[i];
    p.out = (float*)d_out; p.ws = (unsigned char*)d_ws;
    forward(p, stream);
#else
    static int grid = 0;
    if (grid == 0) {
        int dev = 0, cus = 0;
        if (hipGetDevice(&dev) != hipSuccess || hipDeviceGetAttribute(&cus, hipDeviceAttributeMultiprocessorCount, dev) != hipSuccess) { fprintf(stderr, "kernel_launch: device query failed\n"); grid = -1; return; }
        if (hipFuncSetAttribute((const void*)mega_fwd, hipFuncAttributeMaxDynamicSharedMemorySize, LDS_BYTES) != hipSuccess) { fprintf(stderr, "kernel_launch: hipFuncSetAttribute failed\n"); grid = -1; return; }
        int per_cu = 0;
        if (hipOccupancyMaxActiveBlocksPerMultiprocessor(&per_cu, (const void*)mega_fwd, NT, LDS_BYTES) != hipSuccess || per_cu < 1) fprintf(stderr, "kernel_launch: occupancy query reports %d blocks per CU\n", per_cu);
        (void)hipGetLastError();
        grid = cus;
    }
    if (grid < 0) return;
    if (hipMemsetAsync((char*)d_ws + WS_CTL, 0, CTL_BYTES, stream) != hipSuccess) { fprintf(stderr, "kernel_launch: memset failed\n"); return; }
    Args a{};
    for (int i = 0; i < 19; ++i) a.in[i] = (const float*)d_in[i];
    a.out = (float*)d_out; a.ws = (unsigned char*)d_ws;
#if MODE == 2
    a.ph_lo = 0; a.ph_hi = PH_TOTAL;
    hipLaunchKernelGGL(mega_fwd, dim3(grid), dim3(NT), LDS_BYTES, stream, a);
#else
    for (int ph = 0; ph < PH_TOTAL; ++ph) { a.ph_lo = ph; a.ph_hi = ph + 1; hipLaunchKernelGGL(mega_fwd, dim3(grid), dim3(NT), LDS_BYTES, stream, a); }
#endif
    const hipError_t le = hipPeekAtLastError();
    if (le != hipSuccess) fprintf(stderr, "kernel_launch: launch failed: %s\n", hipGetErrorName(le));
#endif
}
#else
#include <vector>
#include <string>
static std::vector<float> rd(const std::string& fn) { FILE* f = fopen(fn.c_str(), "rb"); if (!f) { perror(fn.c_str()); exit(1); } fseek(f, 0, SEEK_END); long n = ftell(f); fseek(f, 0, SEEK_SET); std::vector<float> v(n / 4); if (fread(v.data(), 1, n, f) != (size_t)n) exit(1); fclose(f); return v; }
int main(int argc, char** argv) {
    std::string dir = argv[1]; std::vector<std::vector<float>> in(19);
    for (int i = 0; i < 19; ++i) in[i] = rd(dir + "/in" + std::to_string(i) + ".bin");
    std::vector<float> out((size_t)RL * D); std::vector<unsigned char> ws(WS_END, 0xAA);
    Ptrs p{}; const float** f = (const float**)&p; for (int i = 0; i < 19; ++i) f[i] = in[i].data();
    p.out = out.data(); p.ws = ws.data();
    forward(p, 0);
    FILE* fo = fopen((dir + "/out.bin").c_str(), "wb"); fwrite(out.data(), 4, out.size(), fo); fclose(fo);
    printf("done, ws bytes %zu\n", (size_t)WS_END); return 0;
}
#endif
```

```cpp
#ifndef HOST_TEST
#include <hip/hip_runtime.h>
#endif
#include <cstdio>
#include <cstdint>
#include <cstring>
#include <cmath>

#ifndef CFG_B
#define CFG_B 32
#endif
#ifndef CFG_SEQ
#define CFG_SEQ 2048
#endif
#ifndef CFG_CTX
#define CFG_CTX 256
#endif
#ifndef CFG_DEPTH
#define CFG_DEPTH 4
#endif
constexpr int D = 1024, NB = CFG_B, SEQ = CFG_SEQ, CTX = CFG_CTX, DEPTH = CFG_DEPTH;
constexpr int GRID_W = 64, NROWS = SEQ / GRID_W, HDIM = 64, NHA = 8, NKVA = 2, GQA = 4, WINDOW = 128;
constexpr int CONV_CH = 256, DD = 32, NHC = 4, NE = 16, FF = 1024, PROJ = 2304;
constexpr int RL = NB * SEQ, RC = NB * CTX, RALL = RL + RC;
constexpr int CAPL = 2 * SEQ / NE, CAPC = 2 * CTX / NE;
constexpr int SLOTS_L = NB * CAPL, SLOTS_C = NB * CAPC, SLOTS_E = SLOTS_L + SLOTS_C;
constexpr int NSLOT = NE * SLOTS_E;
constexpr int C_QA = 0, C_KA = 512, C_VA = 640, C_CIN = 768, C_CB = 1024, C_CC = 1280, C_QD = 1536, C_KD = 1792, C_VD = 2048;
constexpr int M_SH1 = 0, M_SC1 = D, M_G1 = 2 * D, M_SH2 = 3 * D, M_SC2 = 4 * D, M_G2 = 5 * D;
constexpr float EPS = 1e-6f, LOG2E = 1.4426950408889634f;
constexpr float QSCALE_A = 0.125f * LOG2E, QSCALE_D = 0.17677669529663687f * LOG2E;

#ifdef HOST_TEST
#define HD
#define KERNEL static void
static thread_local long g_gid;
#define GID g_gid
#include <omp.h>
#define LAUNCH(kern, nthreads, ...) do { const long _n = (long)(nthreads); _Pragma("omp parallel for schedule(static)") for (long _g = 0; _g < _n; ++_g) { g_gid = _g; kern(__VA_ARGS__); } } while (0)
#else
#define HD __host__ __device__ __forceinline__
#define KERNEL __global__ void __launch_bounds__(256)
#define GID ((long)blockIdx.x * blockDim.x + threadIdx.x)
#define LAUNCH(kern, nthreads, ...) do { const long _n = (long)(nthreads); if (_n > 0) hipLaunchKernelGGL(kern, dim3((unsigned)((_n + 255) / 256)), dim3(256), 0, stream, __VA_ARGS__); } while (0)
#endif

typedef unsigned short bf16_t;
HD float bf2f(bf16_t v) { unsigned u = (unsigned)v << 16; return __builtin_bit_cast(float, u); }
HD bf16_t f2bf(float f) { unsigned u = __builtin_bit_cast(unsigned, f); return (bf16_t)((u + 0x7fffu + ((u >> 16) & 1u)) >> 16); }

constexpr size_t al256(size_t x) { return (x + 255) & ~(size_t)255; }
constexpr size_t WS_CTL = 0, CTL_BYTES = 1u << 20;
constexpr size_t WS_TAB = WS_CTL + CTL_BYTES;
constexpr int T_AROW = 0, T_ACOL = T_AROW + NROWS * 16 * 2, T_DROW = T_ACOL + 64 * 16 * 2, T_DCOL = T_DROW + NROWS * 8 * 2, T_END = T_DCOL + 64 * 8 * 2;
constexpr size_t WS_SILU = WS_TAB + al256((size_t)T_END * 4);
constexpr size_t WS_MOD = WS_SILU + al256((size_t)(NB + 1) * D * 4);
constexpr size_t WS_RSTD = WS_MOD + al256((size_t)DEPTH * (NB + 1) * 6 * D * 4);
constexpr size_t WS_AFF = WS_RSTD + al256((size_t)RALL * 4);
constexpr size_t WS_SEL = WS_AFF + al256((size_t)RALL * NE * 4);
constexpr size_t WS_GATE = WS_SEL + al256((size_t)NSLOT * 4);
constexpr size_t WS_TOKSLOT = WS_GATE + al256((size_t)NSLOT * 4);
constexpr size_t WS_XC = WS_TOKSLOT + al256((size_t)RALL * NE * 4);
constexpr size_t WS_WIN = WS_XC + al256((size_t)RC * D * 4);
constexpr size_t WS_WOUT = WS_WIN + al256((size_t)DEPTH * PROJ * D * 2);
constexpr size_t WS_WGU = WS_WOUT + al256((size_t)DEPTH * D * D * 2);
constexpr size_t WS_WD = WS_WGU + al256((size_t)2 * NE * 2 * FF * D * 2);
constexpr size_t WS_R1 = WS_WD + al256((size_t)2 * NE * D * FF * 2);
constexpr size_t R1_BYTES = al256(((size_t)RALL * PROJ * 2 > (size_t)NSLOT * FF * 2) ? (size_t)RALL * PROJ * 2 : (size_t)NSLOT * FF * 2);
constexpr size_t WS_R2 = WS_R1 + R1_BYTES;
constexpr size_t R2_BYTES = al256(((size_t)NSLOT * D * 2 > (size_t)2 * RALL * D * 2) ? (size_t)NSLOT * D * 2 : (size_t)2 * RALL * D * 2);
constexpr size_t WS_R3 = WS_R2 + R2_BYTES;
constexpr size_t WS_XB = WS_R3 + al256((size_t)RALL * D * 2);
constexpr size_t WS_HXS = WS_XB + al256((size_t)RALL * D * 2);
constexpr size_t WS_END = WS_HXS + al256((size_t)RALL * 4);
constexpr size_t CTL_WINMAX = 262144;

struct Ptrs {
    const float *x, *c, *ctx, *c_ctx, *w_ada, *b_ada, *norm1, *norm2, *w_in, *w_out, *attn_sink, *conv_w, *diff_lambda, *diff_subln, *router, *w_gate, *w_up, *w_down, *norm_final;
    float* out; unsigned char* ws;
};

HD float* xrow_ptr(float* xl, float* xc, int row) { return row < RL ? xl + (size_t)row * D : xc + (size_t)(row - RL) * D; }
HD int row_batch(int row) { return row < RL ? row / SEQ : NB; }
HD float silu_f(float v) { return v / (1.0f + expf(-v)); }

KERNEL k_tables(float* tab) {
    const long g = GID; if (g >= (long)(NROWS + 64) * 24) return;
    const int pos = (int)(g / 24), f = (int)(g % 24);
    const double inv = f < 16 ? pow(10000.0, -(2.0 * f) / 32.0) : pow(10000.0, -(2.0 * (f - 16)) / 16.0);
    const bool isrow = pos < NROWS; const int p = isrow ? pos : pos - NROWS;
    const double ang = (double)p * inv; const float cs = (float)cos(ang), sn = (float)sin(ang);
    int idx;
    if (f < 16) idx = (isrow ? T_AROW : T_ACOL) + (p * 16 + f) * 2; else idx = (isrow ? T_DROW : T_DCOL) + (p * 8 + (f - 16)) * 2;
    tab[idx] = cs; tab[idx + 1] = sn;
}
KERNEL k_silu(const float* c, const float* c_ctx, float* out) {
    const long g = GID; if (g >= (long)(NB + 1) * D) return;
    const int b = (int)(g / D), k = (int)(g % D); const float v = b < NB ? c[b * D + k] : c_ctx[k];
    out[g] = silu_f(v);
}
KERNEL k_mod(const float* silu, const float* w_ada, const float* b_ada, float* mod) {
    const long g = GID; if (g >= (long)DEPTH * 6 * D) return;
    const int l = (int)(g / (6 * D)), j = (int)(g % (6 * D));
    float acc[NB + 1];
#pragma unroll
    for (int b = 0; b <= NB; ++b) acc[b] = 0.f;
    const float* w = w_ada + (size_t)l * D * 6 * D + j;
    for (int k = 0; k < D; ++k) { const float wv = w[(size_t)k * 6 * D];
#pragma unroll
        for (int b = 0; b <= NB; ++b) acc[b] += silu[b * D + k] * wv; }
    const float bias = b_ada[l * 6 * D + j];
#pragma unroll
    for (int b = 0; b <= NB; ++b) mod[((size_t)l * (NB + 1) + b) * 6 * D + j] = acc[b] + bias;
}
HD int permA(int p) { return (p / 32) * 32 + (p % 32) / 2 + 16 * (p % 2); }
HD int permD(int p) { return (p / 16) * 16 + (p % 16) / 2 + 8 * (p % 2); }
HD int inproj_src_col(int n) {
    if (n < C_VA) return (n / 64) * 64 + permA(n % 64);
    if (n < C_QD) return n;
    if (n < C_VD) return (n / 32) * 32 + permD(n % 32);
    return n;
}
KERNEL k_cvt_win(const float* w_in, bf16_t* wt) {
    const long g = GID; if (g >= (long)DEPTH * PROJ * D) return;
    const int k = (int)(g % D); const int n = (int)((g / D) % PROJ); const int l = (int)(g / ((long)D * PROJ));
    wt[g] = f2bf(w_in[((size_t)l * D + k) * PROJ + inproj_src_col(n)]);
}
KERNEL k_cvt_t(const float* w, bf16_t* wt, int nmat, int K, int N) {
    const long g = GID; if (g >= (long)nmat * K * N) return;
    const int k = (int)(g % K); const int n = (int)((g / K) % N); const int m = (int)(g / ((long)K * N));
    wt[g] = f2bf(w[((size_t)m * K + k) * N + n]);
}
KERNEL k_cvt_gu(const float* wg, const float* wu, bf16_t* wt) {
    const long g = GID; if (g >= (long)NE * 2 * FF * D) return;
    const int k = (int)(g % D); const int n = (int)((g / D) % (2 * FF)); const int e = (int)(g / ((long)D * 2 * FF));
    const int blk = n / 256, bj = (n % 256) / 128, j = n % 128; const float* src = bj ? wu : wg;
    wt[g] = f2bf(src[((size_t)e * D + k) * FF + blk * 128 + j]);
}
KERNEL k_rowstat(const float* xl, const float* xc, float* rstd, int nrows) {
    const long g = GID; if (g >= nrows) return;
    const float* xr = xrow_ptr((float*)xl, (float*)xc, (int)g); float s = 0.f;
    for (int k = 0; k < D; ++k) s += xr[k] * xr[k];
    rstd[g] = 1.0f / sqrtf(s / D + EPS);
}
KERNEL k_rowapply(const float* xl, const float* xc, const float* rstd, const float* nw, const float* modl, int sh_off, int sc_off, bf16_t* hx, int nrows) {
    const long g = GID; if (g >= (long)nrows * D) return;
    const int row = (int)(g / D), k = (int)(g % D); const float* xr = xrow_ptr((float*)xl, (float*)xc, row);
    const float* m = modl + (size_t)row_batch(row) * 6 * D;
    const float v = xr[k] * rstd[row] * nw[k] * (1.0f + m[sc_off + k]) + m[sh_off + k];
    hx[g] = f2bf(v);
}
struct EpiInProj {
    bf16_t* P; const float* tab;
    HD void operator()(int row, int c0, const float* v, const float*) const {
        float o[4] = {v[0], v[1], v[2], v[3]};
        const bool lat = row < RL; const int pos = lat ? row % SEQ : 0; const int gr = pos / GRID_W, gc = pos % GRID_W;
        if (c0 < C_VA) {
            if (lat) { const int p = c0 % 64, grp = p / 32, i0 = (p % 32) / 2;
                const float* t = tab + (grp == 0 ? T_AROW + gr * 32 : T_ACOL + gc * 32) + i0 * 2;
                const float a0 = o[0], b0 = o[1], a1 = o[2], b1 = o[3];
                o[0] = a0 * t[0] - b0 * t[1]; o[1] = b0 * t[0] + a0 * t[1]; o[2] = a1 * t[2] - b1 * t[3]; o[3] = b1 * t[2] + a1 * t[3]; }
            if (c0 < C_KA) { for (int j = 0; j < 4; ++j) o[j] *= QSCALE_A; }
        } else if (c0 >= C_QD && c0 < C_VD) {
            if (lat) { const int p = c0 % 32, grp = p / 16, i0 = (p % 16) / 2;
                const float* t = tab + (grp == 0 ? T_DROW + gr * 16 : T_DCOL + gc * 16) + i0 * 2;
                const float a0 = o[0], b0 = o[1], a1 = o[2], b1 = o[3];
                o[0] = a0 * t[0] - b0 * t[1]; o[1] = b0 * t[0] + a0 * t[1]; o[2] = a1 * t[2] - b1 * t[3]; o[3] = b1 * t[2] + a1 * t[3]; }
            if (c0 < C_KD) { for (int j = 0; j < 4; ++j) o[j] *= QSCALE_D; }
        }
        bf16_t* d = P + (size_t)row * PROJ + c0;
        for (int j = 0; j < 4; ++j) d[j] = f2bf(o[j]);
    }
};
struct EpiOutProj {
    float* xl; float* xc; const float* modl;
    HD void operator()(int row, int c0, const float* v, const float*) const {
        float* xr = xrow_ptr(xl, xc, row) + c0; const float* g1 = modl + (size_t)row_batch(row) * 6 * D + M_G1 + c0;
        for (int j = 0; j < 4; ++j) xr[j] += g1[j] * v[j];
    }
};
struct EpiGateUp {
    bf16_t* H;
    HD void operator()(int row, int c0, const float* v, const float* u) const {
        bf16_t* d = H + (size_t)row * FF + c0;
        for (int j = 0; j < 4; ++j) d[j] = f2bf(silu_f(v[j]) * u[j]);
    }
};
struct EpiDown {
    bf16_t* Y; const float* gate;
    HD void operator()(int row, int c0, const float* v, const float*) const {
        const float g = gate[row]; bf16_t* d = Y + (size_t)row * D + c0;
        for (int j = 0; j < 4; ++j) d[j] = f2bf(v[j] * g);
    }
};
template <class Epi, bool DUAL>
KERNEL k_gemm_naive(const bf16_t* A, const int* rowidx, const bf16_t* Bt, int M, int N, int K, int group_rows, int valid_rows, long bstride, Epi epi) {
    const long g = GID; if (g >= (long)M * (N / 4)) return;
    const int row = (int)(g / (N / 4)), c0 = (int)(g % (N / 4)) * 4;
    if (row % group_rows >= valid_rows) return;
    const int arow = rowidx ? rowidx[row] : row;
    const bf16_t* a = A + (size_t)arow * K; const bf16_t* B = Bt + (size_t)(row / group_rows) * bstride;
    float v[4], u[4];
    for (int j = 0; j < 4; ++j) { const int c = c0 + j; const int br = DUAL ? (c / 128) * 256 + c % 128 : c;
        const bf16_t* b0 = B + (size_t)br * K; float s = 0.f, s2 = 0.f;
        for (int k = 0; k < K; ++k) s += bf2f(a[k]) * bf2f(b0[k]);
        if (DUAL) { const bf16_t* b1 = b0 + (size_t)128 * K; for (int k = 0; k < K; ++k) s2 += bf2f(a[k]) * bf2f(b1[k]); }
        v[j] = s; u[j] = s2; }
    epi(row, c0, v, u);
}
HD void b_attnA(const long g, const bf16_t* P, const float* sink, bf16_t* MIX, int nrows) {
    if (g >= (long)nrows * NHA) return;
    const int h = (int)(g / nrows), row = (int)(g % nrows), kvh = h / GQA;
    const bool lat = row < RL; const int b = lat ? row / SEQ : (row - RL) / CTX; const int t = lat ? row % SEQ : 0;
    float q[HDIM], o[HDIM];
    const bf16_t* qp = P + (size_t)row * PROJ + C_QA + h * HDIM;
#pragma unroll
    for (int d = 0; d < HDIM; ++d) { q[d] = bf2f(qp[d]); o[d] = 0.f; }
    float m = sink[h] * LOG2E, l = 1.0f;
    const int nctx = CTX, lo = lat ? (t - WINDOW < 0 ? 0 : t - WINDOW) : 0, hi = lat ? (t + WINDOW > SEQ - 1 ? SEQ - 1 : t + WINDOW) : -1;
    const int nkeys = nctx + (hi - lo + 1);
    for (int i = 0; i < nkeys; ++i) {
        const int krow = i < nctx ? RL + b * CTX + i : b * SEQ + lo + (i - nctx);
        const bf16_t* kp = P + (size_t)krow * PROJ + C_KA + kvh * HDIM; const bf16_t* vp = P + (size_t)krow * PROJ + C_VA + kvh * HDIM;
        float s = 0.f;
#pragma unroll
        for (int d = 0; d < HDIM; ++d) s += q[d] * bf2f(kp[d]);
        if (s > m) { const float sc = exp2f(m - s); l *= sc;
#pragma unroll
            for (int d = 0; d < HDIM; ++d) o[d] *= sc;
            m = s; }
        const float p = exp2f(s - m); l += p;
#pragma unroll
        for (int d = 0; d < HDIM; ++d) o[d] += p * bf2f(vp[d]);
    }
    const float inv = 1.0f / l; bf16_t* op = MIX + (size_t)row * D + h * HDIM;
#pragma unroll
    for (int d = 0; d < HDIM; ++d) op[d] = f2bf(o[d] * inv);
}
KERNEL k_attnA(const bf16_t* P, const float* sink, bf16_t* MIX, int nrows) { b_attnA(GID, P, sink, MIX, nrows); }
HD void b_attnD(const long g, const bf16_t* P, float* TMP, int nrows) {
    if (g >= (long)nrows * NHC * 2) return;
    const int hc = (int)(g / nrows), row = (int)(g % nrows), h = hc / 2, comp = hc % 2;
    const bool lat = row < RL; const int b = lat ? row / SEQ : (row - RL) / CTX;
    float q[DD], o[2 * DD];
    const bf16_t* qp = P + (size_t)row * PROJ + C_QD + h * 2 * DD + comp * DD;
#pragma unroll
    for (int d = 0; d < DD; ++d) q[d] = bf2f(qp[d]);
#pragma unroll
    for (int d = 0; d < 2 * DD; ++d) o[d] = 0.f;
    float m = -1e30f, l = 0.f;
    const int nkeys = CTX + (lat ? SEQ : 0);
    for (int i = 0; i < nkeys; ++i) {
        const int krow = i < CTX ? RL + b * CTX + i : b * SEQ + (i - CTX);
        const bf16_t* kp = P + (size_t)krow * PROJ + C_KD + h * 2 * DD + comp * DD; const bf16_t* vp = P + (size_t)krow * PROJ + C_VD + h * 2 * DD;
        float s = 0.f;
#pragma unroll
        for (int d = 0; d < DD; ++d) s += q[d] * bf2f(kp[d]);
        if (s > m) { const float sc = exp2f(m - s); l *= sc;
#pragma unroll
            for (int d = 0; d < 2 * DD; ++d) o[d] *= sc;
            m = s; }
        const float p = exp2f(s - m); l += p;
#pragma unroll
        for (int d = 0; d < 2 * DD; ++d) o[d] += p * bf2f(vp[d]);
    }
    const float inv = 1.0f / l; float* op = TMP + (((size_t)row * NHC + h) * 2 + comp) * 2 * DD;
#pragma unroll
    for (int d = 0; d < 2 * DD; ++d) op[d] = o[d] * inv;
}
KERNEL k_attnD(const bf16_t* P, float* TMP, int nrows) { b_attnD(GID, P, TMP, nrows); }
HD void b_diffpost(const long g, const float* TMP, const float* lam_p, const float* subln, float lam_init, bf16_t* MIX, int nrows) {
    if (g >= (long)nrows * NHC) return;
    const int row = (int)(g / NHC), h = (int)(g % NHC);
    float s01 = 0.f, s23 = 0.f;
    for (int d = 0; d < DD; ++d) { s01 += lam_p[d] * lam_p[DD + d]; s23 += lam_p[2 * DD + d] * lam_p[3 * DD + d]; }
    const float lam = expf(s01) - expf(s23) + lam_init;
    const float* t = TMP + ((size_t)row * NHC + h) * 2 * 2 * DD; float y[2 * DD]; float ss = 0.f;
#pragma unroll
    for (int d = 0; d < 2 * DD; ++d) { y[d] = t[d] - lam * t[2 * DD + d]; ss += y[d] * y[d]; }
    const float r = 1.0f / sqrtf(ss / (2 * DD) + EPS) * (1.0f - lam_init);
    bf16_t* op = MIX + (size_t)row * D + 768 + h * 2 * DD;
#pragma unroll
    for (int d = 0; d < 2 * DD; ++d) op[d] = f2bf(y[d] * r * subln[d]);
}
KERNEL k_diffpost(const float* TMP, const float* lam_p, const float* subln, float lam_init, bf16_t* MIX, int nrows) { b_diffpost(GID, TMP, lam_p, subln, lam_init, MIX, nrows); }
HD void b_conv(const long g, const bf16_t* P, const float* cw, bf16_t* MIX, int nrows) {
    if (g >= (long)nrows * CONV_CH) return;
    const int row = (int)(g / CONV_CH), ch = (int)(g % CONV_CH);
    const bool lat = row < RL; const int t = lat ? row % SEQ : (row - RL) % CTX, len = lat ? SEQ : CTX;
    float y = 0.f;
    for (int j = 0; j < 3; ++j) { const int tt = t + j - 1; if (tt < 0 || tt >= len) continue;
        const bf16_t* pr = P + (size_t)(row + j - 1) * PROJ; y += cw[j * CONV_CH + ch] * (bf2f(pr[C_CC + ch]) * bf2f(pr[C_CIN + ch])); }
    MIX[(size_t)row * D + 512 + ch] = f2bf(bf2f(P[(size_t)row * PROJ + C_CB + ch]) * y);
}
KERNEL k_conv(const bf16_t* P, const float* cw, bf16_t* MIX, int nrows) { b_conv(GID, P, cw, MIX, nrows); }
KERNEL k_router(const float* xl, const float* xc, const float* rstd, const float* nw, const float* modl, const float* router, float* logits, int nrows) {
    const long g = GID; if (g >= (long)nrows * NE) return;
    const int row = (int)(g / NE), e = (int)(g % NE); const float* xr = xrow_ptr((float*)xl, (float*)xc, row);
    const float* m = modl + (size_t)row_batch(row) * 6 * D; const float rs = rstd[row]; float s = 0.f;
    for (int k = 0; k < D; ++k) { const float v = xr[k] * rs * nw[k] * (1.0f + m[M_SC2 + k]) + m[M_SH2 + k]; s += v * router[k * NE + e]; }
    logits[g] = s;
}
KERNEL k_aff(float* aff, int nrows) {
    const long g = GID; if (g >= nrows) return;
    float* a = aff + (size_t)g * NE; float m = a[0];
    for (int e = 1; e < NE; ++e) m = a[e] > m ? a[e] : m;
    float s = 0.f; float ex[NE];
#pragma unroll
    for (int e = 0; e < NE; ++e) { ex[e] = expf(a[e] - m); s += ex[e]; }
#pragma unroll
    for (int e = 0; e < NE; ++e) a[e] = ex[e] / s;
}
KERNEL k_select(const float* aff, int* sel, float* gate, int* tokslot, int nrows) {
    const long g = GID; if (g >= (long)nrows * NE) return;
    const int row = (int)(g / NE), e = (int)(g % NE);
    const bool lat = row < RL; const int b = lat ? row / SEQ : (row - RL) / CTX; const int t = lat ? row % SEQ : (row - RL) % CTX;
    const int n = lat ? SEQ : CTX, cap = lat ? CAPL : CAPC, base = lat ? b * SEQ : RL + b * CTX;
    const float a = aff[(size_t)row * NE + e]; int rank = 0;
    for (int j = 0; j < n; ++j) { const float o = aff[(size_t)(base + j) * NE + e]; rank += (o > a || (o == a && j < t)) ? 1 : 0; }
    int slot = -1;
    if (rank < cap) { slot = e * SLOTS_E + (lat ? b * CAPL + rank : SLOTS_L + b * CAPC + rank); sel[slot] = row; gate[slot] = a; }
    tokslot[g] = slot;
}
KERNEL k_combine(float* xl, float* xc, const bf16_t* Y, const int* tokslot, const float* modl, int nrows) {
    const long g = GID; if (g >= (long)nrows * D) return;
    const int row = (int)(g / D), k = (int)(g % D); float s = 0.f;
    for (int e = 0; e < NE; ++e) { const int sl = tokslot[(size_t)row * NE + e]; if (sl >= 0) s += bf2f(Y[(size_t)sl * D + k]); }
    float* xr = xrow_ptr(xl, xc, row); xr[k] += modl[(size_t)row_batch(row) * 6 * D + M_G2 + k] * s;
}
KERNEL k_final(float* xl, const float* rstd, const float* nw) {
    const long g = GID; if (g >= (long)RL * D) return;
    const int row = (int)(g / D), k = (int)(g % D); xl[g] = xl[g] * rstd[row] * nw[k];
}

#ifndef HOST_TEST
typedef short bf16x8 __attribute__((ext_vector_type(8)));
typedef float f32x4 __attribute__((ext_vector_type(4)));
template <class Epi, bool DUAL>
__global__ void __launch_bounds__(256) k_gemm_mfma(const bf16_t* __restrict__ A, const int* __restrict__ rowidx, const bf16_t* __restrict__ Bt, int M, int N, int K, int group_rows, int valid_rows, long bstride, Epi epi) {
    const int tid = threadIdx.x, wid = tid >> 6, lane = tid & 63, fr = lane & 15, fq = lane >> 4, wr = wid >> 1, wc = wid & 1;
    const int row0 = blockIdx.y * 128 + wr * 64;
    if ((blockIdx.y * 128) % group_rows >= valid_rows) return;
    const bf16_t* B = Bt + (size_t)((blockIdx.y * 128) / group_rows) * bstride;
    int brow[4], ocol[4];
    if (!DUAL) { for (int i = 0; i < 4; ++i) { brow[i] = blockIdx.x * 128 + wc * 64 + i * 16; ocol[i] = brow[i]; } }
    else { const int hc0 = blockIdx.x * 64 + wc * 32;
        for (int i = 0; i < 2; ++i) { ocol[i] = hc0 + i * 16; brow[i] = (ocol[i] / 128) * 256 + ocol[i] % 128; brow[i + 2] = brow[i] + 128; ocol[i + 2] = ocol[i]; } }
    const bf16_t* ap[4]; const bf16_t* bp[4];
#pragma unroll
    for (int m = 0; m < 4; ++m) { const int r = row0 + m * 16 + fr; const int ar = rowidx ? rowidx[r] : r; ap[m] = A + (size_t)ar * K + fq * 8; }
#pragma unroll
    for (int i = 0; i < 4; ++i) bp[i] = B + (size_t)(brow[i] + fr) * K + fq * 8;
    f32x4 acc[4][4];
#pragma unroll
    for (int m = 0; m < 4; ++m)
#pragma unroll
        for (int i = 0; i < 4; ++i) acc[m][i] = (f32x4){0.f, 0.f, 0.f, 0.f};
    for (int k0 = 0; k0 < K; k0 += 32) {
        bf16x8 af[4], bfr[4];
#pragma unroll
        for (int m = 0; m < 4; ++m) af[m] = *(const bf16x8*)(ap[m] + k0);
#pragma unroll
        for (int i = 0; i < 4; ++i) bfr[i] = *(const bf16x8*)(bp[i] + k0);
#pragma unroll
        for (int m = 0; m < 4; ++m)
#pragma unroll
            for (int i = 0; i < 4; ++i) acc[m][i] = __builtin_amdgcn_mfma_f32_16x16x32_bf16(bfr[i], af[m], acc[m][i], 0, 0, 0);
    }
#pragma unroll
    for (int m = 0; m < 4; ++m) { const int r = row0 + m * 16 + fr;
#pragma unroll
        for (int i = 0; i < (DUAL ? 2 : 4); ++i) {
            float v[4] = {acc[m][i][0], acc[m][i][1], acc[m][i][2], acc[m][i][3]};
            float u[4] = {acc[m][DUAL ? i + 2 : i][0], acc[m][DUAL ? i + 2 : i][1], acc[m][DUAL ? i + 2 : i][2], acc[m][DUAL ? i + 2 : i][3]};
            epi(r, ocol[i] + 4 * fq, v, u); } }
}
template <class Epi, bool DUAL>
static void launch_gemm(hipStream_t stream, const bf16_t* A, const int* rowidx, const bf16_t* Bt, int M, int N, int K, int group_rows, int valid_rows, long bstride, Epi epi) {
    dim3 grid(DUAL ? N / 64 : N / 128, M / 128);
    hipLaunchKernelGGL((k_gemm_mfma<Epi, DUAL>), grid, dim3(256), 0, stream, A, rowidx, Bt, M, N, K, group_rows, valid_rows, bstride, epi);
}
#define GEMM(Epi, DUAL, ...) launch_gemm<Epi, DUAL>(stream, __VA_ARGS__)
#else
#define GEMM(Epi, DUAL, A, rowidx, Bt, M, N, K, gr, vr, bs, epi) LAUNCH((k_gemm_naive<Epi, DUAL>), (long)(M) * ((N) / 4), A, rowidx, Bt, M, N, K, gr, vr, bs, epi)
#endif

#ifdef HOST_TEST
typedef int hipStream_t;
#endif
static void forward(const Ptrs& p, hipStream_t stream) {
    (void)stream;
    unsigned char* ws = p.ws;
    float* tab = (float*)(ws + WS_TAB); float* silu = (float*)(ws + WS_SILU); float* mod = (float*)(ws + WS_MOD); float* rstd = (float*)(ws + WS_RSTD);
    float* aff = (float*)(ws + WS_AFF); int* sel = (int*)(ws + WS_SEL); float* gate = (float*)(ws + WS_GATE); int* tokslot = (int*)(ws + WS_TOKSLOT);
    float* xc = (float*)(ws + WS_XC); float* xl = p.out;
    bf16_t* win = (bf16_t*)(ws + WS_WIN); bf16_t* wout = (bf16_t*)(ws + WS_WOUT);
    bf16_t* P = (bf16_t*)(ws + WS_R1); bf16_t* H = (bf16_t*)(ws + WS_R1);
    bf16_t* Y = (bf16_t*)(ws + WS_R2); bf16_t* MIX = (bf16_t*)(ws + WS_R2); bf16_t* HX2 = (bf16_t*)(ws + WS_R2 + (size_t)RALL * D * 2); float* TMP = (float*)HX2;
    bf16_t* HX = (bf16_t*)(ws + WS_R3);
    LAUNCH(k_tables, (long)(NROWS + 64) * 24, tab);
    LAUNCH(k_silu, (long)(NB + 1) * D, p.c, p.c_ctx, silu);
    LAUNCH(k_mod, (long)DEPTH * 6 * D, silu, p.w_ada, p.b_ada, mod);
    LAUNCH(k_cvt_win, (long)DEPTH * PROJ * D, p.w_in, win);
    LAUNCH(k_cvt_t, (long)DEPTH * D * D, p.w_out, wout, DEPTH, D, D);
#ifdef HOST_TEST
    memcpy(xl, p.x, (size_t)RL * D * 4); memcpy(xc, p.ctx, (size_t)RC * D * 4);
#else
    (void)hipMemcpyAsync(xl, p.x, (size_t)RL * D * 4, hipMemcpyDeviceToDevice, stream);
    (void)hipMemcpyAsync(xc, p.ctx, (size_t)RC * D * 4, hipMemcpyDeviceToDevice, stream);
#endif
    for (int l = 0; l < DEPTH; ++l) {
        const bool need_ctx = l < DEPTH - 1; const int nq = need_ctx ? RALL : RL;
        const float* modl = mod + (size_t)l * (NB + 1) * 6 * D; const float lam_init = 0.8f - 0.6f * expf(-0.3f * (float)l);
        bf16_t* wgu = (bf16_t*)(ws + WS_WGU) + (size_t)(l & 1) * NE * 2 * FF * D; bf16_t* wd = (bf16_t*)(ws + WS_WD) + (size_t)(l & 1) * NE * D * FF;
        LAUNCH(k_cvt_gu, (long)NE * 2 * FF * D, p.w_gate + (size_t)l * NE * D * FF, p.w_up + (size_t)l * NE * D * FF, wgu);
        LAUNCH(k_cvt_t, (long)NE * FF * D, p.w_down + (size_t)l * NE * FF * D, wd, NE, FF, D);
        LAUNCH(k_rowstat, RALL, xl, xc, rstd, RALL);
        LAUNCH(k_rowapply, (long)RALL * D, xl, xc, rstd, p.norm1 + l * D, modl, M_SH1, M_SC1, HX, RALL);
        GEMM(EpiInProj, false, HX, (const int*)nullptr, win + (size_t)l * PROJ * D, RALL, PROJ, D, RALL, RALL, 0L, (EpiInProj{P, tab}));
        LAUNCH(k_attnA, (long)nq * NHA, P, p.attn_sink + l * NHA, MIX, nq);
        LAUNCH(k_attnD, (long)nq * NHC * 2, P, TMP, nq);
        LAUNCH(k_diffpost, (long)nq * NHC, TMP, p.diff_lambda + l * 4 * DD, p.diff_subln + l * 2 * DD, lam_init, MIX, nq);
        LAUNCH(k_conv, (long)nq * CONV_CH, P, p.conv_w + l * 3 * CONV_CH, MIX, nq);
        GEMM(EpiOutProj, false, MIX, (const int*)nullptr, wout + (size_t)l * D * D, nq, D, D, nq, nq, 0L, (EpiOutProj{xl, xc, modl}));
        LAUNCH(k_rowstat, nq, xl, xc, rstd, nq);
        LAUNCH(k_rowapply, (long)nq * D, xl, xc, rstd, p.norm2 + l * D, modl, M_SH2, M_SC2, HX2, nq);
        LAUNCH(k_router, (long)nq * NE, xl, xc, rstd, p.norm2 + l * D, modl, p.router + (size_t)l * D * NE, aff, nq);
        LAUNCH(k_aff, nq, aff, nq);
        LAUNCH(k_select, (long)nq * NE, aff, sel, gate, tokslot, nq);
        const int vr = need_ctx ? SLOTS_E : SLOTS_L;
        GEMM(EpiGateUp, true, HX2, sel, wgu, NSLOT, FF, D, SLOTS_E, vr, (long)2 * FF * D, (EpiGateUp{H}));
        GEMM(EpiDown, false, H, (const int*)nullptr, wd, NSLOT, D, FF, SLOTS_E, vr, (long)D * FF, (EpiDown{Y, gate}));
        LAUNCH(k_combine, (long)nq * D, xl, xc, Y, tokslot, modl, nq);
    }
    LAUNCH(k_rowstat, RL, xl, xc, rstd, RL);
    LAUNCH(k_final, (long)RL * D, xl, rstd, p.norm_final);
}

#ifndef HOST_TEST
#define LAS __attribute__((address_space(3)))
#define GAS __attribute__((address_space(1)))
typedef unsigned u32x4 __attribute__((ext_vector_type(4)));
typedef unsigned u32x2 __attribute__((ext_vector_type(2)));
typedef float f32x2_t __attribute__((ext_vector_type(2)));
constexpr int NT = 512, NWV = 8;
constexpr int LDS_BYTES = 163840;
constexpr int LDS_MISC = LDS_BYTES - 256;
constexpr int CW_BAR = 4096;

__device__ __forceinline__ unsigned cvt_pk_bf16(float lo, float hi) { unsigned r; asm volatile("v_cvt_pk_bf16_f32 %0, %1, %2" : "=v"(r) : "v"(lo), "v"(hi)); return r; }
__device__ __forceinline__ float dpp_f(float v, const int ctrl_tag) {
    int r;
    switch (ctrl_tag) {
        case 0: r = __builtin_amdgcn_update_dpp(0, __builtin_bit_cast(int, v), 0xB1, 0xF, 0xF, true); break;
        case 1: r = __builtin_amdgcn_update_dpp(0, __builtin_bit_cast(int, v), 0x4E, 0xF, 0xF, true); break;
        case 2: r = __builtin_amdgcn_update_dpp(0, __builtin_bit_cast(int, v), 0x141, 0xF, 0xF, true); break;
        default: r = __builtin_amdgcn_update_dpp(0, __builtin_bit_cast(int, v), 0x140, 0xF, 0xF, true); break;
    }
    return __builtin_bit_cast(float, r);
}
__device__ __forceinline__ float wave_sum(float v) {
    v += dpp_f(v, 0); v += dpp_f(v, 1); v += dpp_f(v, 2); v += dpp_f(v, 3);
    const int b = __builtin_bit_cast(int, v);
    return (__builtin_bit_cast(float, __builtin_amdgcn_readlane(b, 0)) + __builtin_bit_cast(float, __builtin_amdgcn_readlane(b, 16)))
         + (__builtin_bit_cast(float, __builtin_amdgcn_readlane(b, 32)) + __builtin_bit_cast(float, __builtin_amdgcn_readlane(b, 48)));
}
#define LDS_WAIT() asm volatile("s_waitcnt lgkmcnt(0)" ::: "memory")
__device__ __forceinline__ float wave_max(float v) {
    v = fmaxf(v, dpp_f(v, 0)); v = fmaxf(v, dpp_f(v, 1)); v = fmaxf(v, dpp_f(v, 2)); v = fmaxf(v, dpp_f(v, 3));
    const int b = __builtin_bit_cast(int, v);
    return fmaxf(fmaxf(__builtin_bit_cast(float, __builtin_amdgcn_readlane(b, 0)), __builtin_bit_cast(float, __builtin_amdgcn_readlane(b, 16))),
                 fmaxf(__builtin_bit_cast(float, __builtin_amdgcn_readlane(b, 32)), __builtin_bit_cast(float, __builtin_amdgcn_readlane(b, 48))));
}

#define LDS_RD16_B128(r, addr, STRIDE) asm volatile( \
    "ds_read_b128 %0, %16\n\tds_read_b128 %1, %16 offset:%c17\n\tds_read_b128 %2, %16 offset:2*%c17\n\tds_read_b128 %3, %16 offset:3*%c17\n\t" \
    "ds_read_b128 %4, %16 offset:4*%c17\n\tds_read_b128 %5, %16 offset:5*%c17\n\tds_read_b128 %6, %16 offset:6*%c17\n\tds_read_b128 %7, %16 offset:7*%c17\n\t" \
    "ds_read_b128 %8, %16 offset:8*%c17\n\tds_read_b128 %9, %16 offset:9*%c17\n\tds_read_b128 %10, %16 offset:10*%c17\n\tds_read_b128 %11, %16 offset:11*%c17\n\t" \
    "ds_read_b128 %12, %16 offset:12*%c17\n\tds_read_b128 %13, %16 offset:13*%c17\n\tds_read_b128 %14, %16 offset:14*%c17\n\tds_read_b128 %15, %16 offset:15*%c17\n\ts_waitcnt lgkmcnt(0)" \
    : "=&v"(r[0]), "=&v"(r[1]), "=&v"(r[2]), "=&v"(r[3]), "=&v"(r[4]), "=&v"(r[5]), "=&v"(r[6]), "=&v"(r[7]), "=&v"(r[8]), "=&v"(r[9]), "=&v"(r[10]), "=&v"(r[11]), "=&v"(r[12]), "=&v"(r[13]), "=&v"(r[14]), "=&v"(r[15]) \
    : "v"(addr), "i"(STRIDE) : "memory")
#define LDS_ISSUE8_B128(r, addr, STRIDE) asm volatile( \
    "ds_read_b128 %0, %8\n\tds_read_b128 %1, %8 offset:%c9\n\tds_read_b128 %2, %8 offset:2*%c9\n\tds_read_b128 %3, %8 offset:3*%c9\n\t" \
    "ds_read_b128 %4, %8 offset:4*%c9\n\tds_read_b128 %5, %8 offset:5*%c9\n\tds_read_b128 %6, %8 offset:6*%c9\n\tds_read_b128 %7, %8 offset:7*%c9" \
    : "=&v"(r[0]), "=&v"(r[1]), "=&v"(r[2]), "=&v"(r[3]), "=&v"(r[4]), "=&v"(r[5]), "=&v"(r[6]), "=&v"(r[7]) \
    : "v"(addr), "i"(STRIDE) : "memory")
#define LDS_WAIT8(r, N) asm volatile("s_waitcnt lgkmcnt(" #N ")" : "+v"(r[0]), "+v"(r[1]), "+v"(r[2]), "+v"(r[3]), "+v"(r[4]), "+v"(r[5]), "+v"(r[6]), "+v"(r[7]) :: "memory")
#define LDS_RD11_B128(r, addr, STRIDE) asm volatile( \
    "ds_read_b128 %0, %11\n\tds_read_b128 %1, %11 offset:%c12\n\tds_read_b128 %2, %11 offset:2*%c12\n\tds_read_b128 %3, %11 offset:3*%c12\n\t" \
    "ds_read_b128 %4, %11 offset:4*%c12\n\tds_read_b128 %5, %11 offset:5*%c12\n\tds_read_b128 %6, %11 offset:6*%c12\n\tds_read_b128 %7, %11 offset:7*%c12\n\t" \
    "ds_read_b128 %8, %11 offset:8*%c12\n\tds_read_b128 %9, %11 offset:9*%c12\n\tds_read_b128 %10, %11 offset:10*%c12\n\ts_waitcnt lgkmcnt(0)" \
    : "=&v"(r[0]), "=&v"(r[1]), "=&v"(r[2]), "=&v"(r[3]), "=&v"(r[4]), "=&v"(r[5]), "=&v"(r[6]), "=&v"(r[7]), "=&v"(r[8]), "=&v"(r[9]), "=&v"(r[10]) \
    : "v"(addr), "i"(STRIDE) : "memory")
__device__ __forceinline__ int lane_id_asm() { int l; asm volatile("v_mbcnt_lo_u32_b32 %0, -1, 0\n\tv_mbcnt_hi_u32_b32 %0, -1, %0" : "=v"(l)); return l; }
__device__ __forceinline__ int tid_w(int wv) { return wv * 64 + lane_id_asm(); }
#define tid_l() tid_w(C.wv)

#define XB_TMO      128
#define XB_XCNT(j)  (256  + 64 * (j))
#define XB_XSUB(j)  (1280 + 64 * (j))
#define XB_XGEN(j)  (2304 + 64 * (j))
#define XB_TOP      3328
#define XB_TOPGEN   3392
#define XCD_BAR_WORDS 3456
#define XB_SPIN_CAP (1u << 24)
__device__ __forceinline__ unsigned xb_ld(unsigned* p)              { return __hip_atomic_load(p, __ATOMIC_RELAXED, __HIP_MEMORY_SCOPE_AGENT); }
__device__ __forceinline__ unsigned xb_add(unsigned* p, unsigned v) { return __hip_atomic_fetch_add(p, v, __ATOMIC_RELAXED, __HIP_MEMORY_SCOPE_AGENT); }
__device__ __forceinline__ unsigned xb_xcc_id() { return (unsigned)__builtin_amdgcn_s_getreg((3 << 11) | 20) & 0xFu; }
#define XB_SPIN(cond, bar) do { unsigned _sp = 0; while (cond) { __builtin_amdgcn_s_sleep(1); \
    if ((++_sp & 255u) == 0u) { if (xb_ld(&(bar)[XB_TMO])) break; if (_sp > XB_SPIN_CAP) { atomicAdd(&(bar)[XB_TMO], 1u); break; } } } } while (0)
struct XcdBarrier { unsigned* bar; unsigned x; volatile LAS unsigned* st; int wv; };
__device__ __forceinline__ XcdBarrier xcd_barrier_post(unsigned* bar, volatile LAS unsigned* st, int wv) {
    XcdBarrier b; b.bar = bar; b.x = xb_xcc_id(); b.st = st; b.wv = wv;
    if (tid_w(wv) == 0) (void)xb_add(&bar[XB_XCNT(b.x)], 1u);
    return b;
}
__device__ __forceinline__ void xcd_barrier_complete(unsigned* bar, unsigned x, unsigned& nloc, unsigned& nx) {
    const unsigned G = gridDim.x * gridDim.y * gridDim.z;
    unsigned sum, cnt, mine, sp = 0u;
    for (;;) {
        sum = 0u; cnt = 0u; mine = 0u;
#pragma unroll
        for (unsigned j = 0; j < 16; ++j) { const unsigned c = xb_ld(&bar[XB_XCNT(j)]); sum += c; cnt += (c > 0u) ? 1u : 0u; mine = (j == x) ? c : mine; }
        if (sum == G) break;
        __builtin_amdgcn_s_sleep(1);
        if ((++sp & 255u) == 0u) { if (xb_ld(&bar[XB_TMO])) break; if (sp > XB_SPIN_CAP) { atomicAdd(&bar[XB_TMO], 1u); break; } }
    }
    nloc = mine > 0u ? mine : 1u; nx = cnt > 0u ? cnt : 1u;
}
__device__ __forceinline__ void xcd_barrier(const XcdBarrier& b) {
    asm volatile("s_waitcnt vmcnt(0)" ::: "memory");
    __syncthreads();
    if (tid_w(b.wv) == 0) {
        unsigned* bar = b.bar;
        __builtin_amdgcn_s_waitcnt(0);
        unsigned nloc = b.st[0], nx = b.st[1];
        if (nloc == 0u) { xcd_barrier_complete(bar, b.x, nloc, nx); b.st[0] = nloc; b.st[1] = nx; }
        const unsigned old = xb_add(&bar[XB_XSUB(b.x)], 1u);
        const unsigned gen = old / nloc;
        if (old + 1u == (gen + 1u) * nloc) {
            __builtin_amdgcn_fence(__ATOMIC_RELEASE, "agent");
            asm volatile("s_waitcnt vmcnt(0)" ::: "memory");
            const unsigned og = xb_add(&bar[XB_TOP], 1u);
            const unsigned tg = og / nx;
            if (og + 1u == (tg + 1u) * nx) xb_add(&bar[XB_TOPGEN], 1u);
            else XB_SPIN(xb_ld(&bar[XB_TOPGEN]) == tg, bar);
            __builtin_amdgcn_fence(__ATOMIC_ACQUIRE, "agent");
            xb_add(&bar[XB_XGEN(b.x)], 1u);
            asm volatile("s_waitcnt vmcnt(0)" ::: "memory");
        } else {
            XB_SPIN(xb_ld(&bar[XB_XGEN(b.x)]) == gen, bar);
            __builtin_amdgcn_fence(__ATOMIC_ACQUIRE, "agent");
            asm volatile("s_waitcnt vmcnt(0)" ::: "memory");
        }
    }
    __syncthreads();
}

namespace pg {
constexpr int BM = 256, BK = 64, HALF = 128, HTB = HALF * BK * 2  , STAGE_BYTES = 8 * HTB, NXCD = 8, WGM = 8;
constexpr int TPE_FULL = SLOTS_E / BM;
__host__ __device__ __forceinline__ int lds_byte(int r, int c) { const int st = (r >> 4) * 2 + (c >> 5), rr = r & 15, cc = c & 31, ob = rr * 64 + cc * 2; return st * 1024 + (ob ^ (((ob >> 9) & 1) << 5)); }
__host__ __device__ __forceinline__ void stage_rc(int b, int& R, int& C) { const int st = b / 1024, sb = b % 1024, swz = sb ^ (((sb >> 9) & 1) << 5); R = (st >> 1) * 16 + swz / 64; C = (st & 1) * 32 + (swz % 64) / 2; }
__host__ __device__ __forceinline__ int perm32(int rho) { const int n = rho >> 4, i = rho & 15; return 8 * (i >> 2) + 4 * n + (i & 3); }
struct Unit { int m0, pn, e; };
struct GemmD { const char* A; const int* rowidx; const char* Bt; size_t bstride; int K; };
struct Order {
    int nM, nN, nwg, G, c, tpe;
    __device__ void init(int nM_, int nN_, int G_, int c_, int tpe_) { nM = nM_; nN = nN_; nwg = nM * nN; G = G_; c = c_; tpe = tpe_; }
    __device__ bool next(int i, Unit& u) const {
        const long L = (long)i * G + c; if (L >= nwg) return false;
        int wgid = (int)L; { const int q = nwg / NXCD, r = nwg % NXCD, xcd = wgid % NXCD, off = wgid / NXCD; wgid = (xcd < r ? xcd * (q + 1) : r * (q + 1) + (xcd - r) * q) + off; }
        const int nig = WGM * nN, gid = wgid / nig, fm = gid * WGM, gsz = (nM - fm) < WGM ? (nM - fm) : WGM;
        const int pm = fm + ((wgid % nig) % gsz); u.pn = (wgid % nig) / gsz;
        if (tpe > 0) { u.e = pm / tpe; u.m0 = (u.e * TPE_FULL + pm % tpe) * BM; } else { u.e = 0; u.m0 = pm * BM; }
        return true;
    }
};
template <class T> struct has_pre { template <class U> static constexpr bool test(decltype(U::HAS_PRE)*) { return U::HAS_PRE; } template <class U> static constexpr bool test(...) { return false; } static constexpr bool value = test<T>(nullptr); };
typedef int v4i32_t __attribute__((ext_vector_type(4)));
typedef int v8i32_t __attribute__((ext_vector_type(8)));
__device__ __forceinline__ v8i32_t cat8(const bf16x8 a, const bf16x8 b) { return __builtin_shufflevector(__builtin_bit_cast(v4i32_t, a), __builtin_bit_cast(v4i32_t, b), 0, 1, 2, 3, 4, 5, 6, 7); }
constexpr int SCALE_ONE = 0x7F7F7F7F, SCALE_W = 0x79797979;
template <bool I> struct acc_sel { typedef f32x4 type; };
template <> struct acc_sel<true> { typedef v4i32_t type; };
template <class Epi, bool GATHER, int QM = 0>
__device__ __forceinline__ void gemm_phase(LAS unsigned char* lds, const GemmD g, const Order& S, const Epi& E, int wv) {
    const int tid = tid_w(wv), wid = __builtin_amdgcn_readfirstlane(tid >> 6), lane = tid & 63, wr = wid >> 2, wc = wid & 3, fr = lane & 15, fq = lane >> 4;
    constexpr bool FP8 = (QM == 1), I8 = (QM == 2);
    typedef typename acc_sel<QM == 2>::type acc_t;
    const int K = g.K, nt = K / BK;
    int Rr[2], Cc[2]; unsigned voffB[2];
#pragma unroll
    for (int i = 0; i < 2; ++i) { int R, C; stage_rc(tid * 16 + i * 8192, R, C); Rr[i] = R; Cc[i] = C; const int Rb = Epi::PERM ? ((R & ~31) + perm32(R & 31)) : R; voffB[i] = (unsigned)(Rb * K + C) * 2u; }
    const unsigned kstep = (unsigned)(BK * 2);
    const size_t hstep = (size_t)HALF * K * 2;
    const unsigned ldsw = (unsigned)wid * 1024u;
    const int aoff = lds_byte(wr * 64 + fr, fq * 8), boff = lds_byte(wc * 32 + fr, fq * 8);
#define PG_SA(b, h) (((b) * 2 + (h)) * HTB)
#define PG_SB(b, h) ((4 + (b) * 2 + (h)) * HTB)
#define PG_STAGE_B(bufoff, gbase) do { _Pragma("unroll") for (int _i = 0; _i < 2; ++_i) \
        __builtin_amdgcn_global_load_lds((const unsigned*)((const char*)(gbase) + voffB[_i]), (LAS unsigned*)(lds + (bufoff) + ldsw + _i * 8192), 16, 0, 0); } while (0)
#define PG_STAGE_A(bufoff, OFFS, h, kb) do { _Pragma("unroll") for (int _i = 0; _i < 2; ++_i) \
        __builtin_amdgcn_global_load_lds((const unsigned*)(g.A + (size_t)(OFFS)[h][_i] + (kb)), (LAS unsigned*)(lds + (bufoff) + ldsw + _i * 8192), 16, 0, 0); } while (0)
#define PG_ROWOFF(DST, U) do { _Pragma("unroll") for (int _h = 0; _h < 2; ++_h) _Pragma("unroll") for (int _i = 0; _i < 2; ++_i) { int _r = (U).m0 + _h * HALF + Rr[_i]; if (GATHER) _r = g.rowidx[_r]; \
        (DST)[_h][_i] = (unsigned)(((size_t)_r * K + Cc[_i]) * 2); } } while (0)
#define PG_LDA(dst, b, h) do { _Pragma("unroll") for (int m = 0; m < 4; ++m) { if constexpr (FP8) { const v4i32_t _x0 = *(const LAS v4i32_t*)(lds + PG_SA(b, h) + aoff + m * 2048), _x1 = *(const LAS v4i32_t*)(lds + PG_SA(b, h) + aoff + m * 2048 + 1024); \
        dst##8[m] = __builtin_shufflevector(_x0, _x1, 0, 1, 2, 3, 4, 5, 6, 7); } else { _Pragma("unroll") for (int k = 0; k < 2; ++k) dst[m][k] = *(const LAS bf16x8*)(lds + PG_SA(b, h) + aoff + m * 2048 + k * 1024); } } } while (0)
#define PG_LDB(dst, b, h) do { _Pragma("unroll") for (int n = 0; n < 2; ++n) { if constexpr (FP8) { const v4i32_t _x0 = *(const LAS v4i32_t*)(lds + PG_SB(b, h) + boff + n * 2048), _x1 = *(const LAS v4i32_t*)(lds + PG_SB(b, h) + boff + n * 2048 + 1024); \
        dst##8[n] = __builtin_shufflevector(_x0, _x1, 0, 1, 2, 3, 4, 5, 6, 7); } else { _Pragma("unroll") for (int k = 0; k < 2; ++k) dst[n][k] = *(const LAS bf16x8*)(lds + PG_SB(b, h) + boff + n * 2048 + k * 1024); } } } while (0)
#define PG_MMA(ai, bj, At, Bt) do { __builtin_amdgcn_s_setprio(1); _Pragma("unroll") for (int m = 0; m < 4; ++m) _Pragma("unroll") for (int n = 0; n < 2; ++n) { \
        if constexpr (FP8) asm volatile("s_nop 1\n\tv_mfma_scale_f32_16x16x128_f8f6f4 %0, %1, %2, %0, %3, %4 op_sel_hi:[0,0,0]" : "+v"(acc[ai][bj][m][n]) : "v"(Bt##8[n]), "v"(At##8[m]), "v"(sc_w), "v"(sc_a)); \
        else if constexpr (I8) { _Pragma("unroll") for (int k = 0; k < 2; ++k) acc[ai][bj][m][n] = __builtin_amdgcn_mfma_i32_16x16x64_i8(__builtin_bit_cast(v4i32_t, Bt[n][k]), __builtin_bit_cast(v4i32_t, At[m][k]), acc[ai][bj][m][n], 0, 0, 0); } \
        else if constexpr (!I8 && !FP8) { _Pragma("unroll") for (int k = 0; k < 2; ++k) acc[ai][bj][m][n] = __builtin_amdgcn_mfma_f32_16x16x32_bf16(Bt[n][k], At[m][k], acc[ai][bj][m][n], 0, 0, 0); } } \
        __builtin_amdgcn_s_setprio(0); } while (0)
#define PG_WAIT_V(n) asm volatile("s_waitcnt vmcnt(" #n ")" ::: "memory")
#define PG_WAIT_L(n) asm volatile("s_waitcnt lgkmcnt(" #n ")" ::: "memory")
#define PG_BAR __builtin_amdgcn_s_barrier()
#define PG_SCHED __builtin_amdgcn_sched_barrier(0)
    Unit cur, nxt; int ui = 0;
    if (!S.next(0, cur)) return;
    acc_t acc[2][2][4][2];
#pragma unroll
    for (int a = 0; a < 2; ++a)
#pragma unroll
        for (int b = 0; b < 2; ++b)
#pragma unroll
            for (int m = 0; m < 4; ++m)
#pragma unroll
                for (int n = 0; n < 2; ++n) { acc[a][b][m][n] = acc_t{}; if constexpr (FP8) asm volatile("" : "+v"(acc[a][b][m][n])); }
    bf16x8 At[4][2], B0[2][2], B1[2][2]; v8i32_t At8[4], B08[2], B18[2];
    int sc_w = SCALE_W, sc_a = SCALE_ONE; if constexpr (FP8) { asm volatile("" : "+v"(sc_w), "+v"(sc_a)); }
    unsigned offA[2][2], offN[2][2];
    float epre[8] = {0.f, 0.f, 0.f, 0.f, 0.f, 0.f, 0.f, 0.f};
    if constexpr (has_pre<Epi>::value) E.pre(epre, cur, wr, fr);
    PG_ROWOFF(offA, cur);
    if (GATHER) PG_WAIT_V(0);
    const char* cB = g.Bt + (size_t)cur.e * g.bstride + (size_t)cur.pn * BM * K * 2;
    PG_STAGE_B(PG_SB(0, 0), cB); PG_STAGE_B(PG_SB(0, 1), cB + hstep); PG_STAGE_A(PG_SA(0, 0), offA, 0, 0u); PG_STAGE_A(PG_SA(0, 1), offA, 1, 0u);
    if (wr == 1) PG_BAR;
    PG_WAIT_V(2); PG_BAR;
    PG_STAGE_B(PG_SB(1, 0), cB + kstep); PG_STAGE_A(PG_SA(1, 0), offA, 0, kstep); PG_STAGE_B(PG_SB(1, 1), cB + hstep + kstep);
    PG_WAIT_V(6); PG_BAR;
    for (;;) {
        const bool has_next = S.next(ui + 1, nxt);
        const char* nB = has_next ? g.Bt + (size_t)nxt.e * g.bstride + (size_t)nxt.pn * BM * K * 2 : cB;
        if (has_next) { PG_ROWOFF(offN, nxt); if (GATHER) PG_WAIT_V(0); }
        else {
#pragma unroll
            for (int h = 0; h < 2; ++h)
#pragma unroll
                for (int i = 0; i < 2; ++i) offN[h][i] = offA[h][i]; }
        for (int t = 0; t < nt; t += 2) {
            const bool last = (t == nt - 2);
            unsigned o2[2][2];
#pragma unroll
            for (int h = 0; h < 2; ++h)
#pragma unroll
                for (int i = 0; i < 2; ++i) o2[h][i] = last ? offN[h][i] : offA[h][i];
            const unsigned ka1 = (unsigned)(t + 1) * kstep, ka2 = last ? 0u : (unsigned)(t + 2) * kstep, ka3 = ka2 + kstep;
            const char* b2 = last ? nB : cB + (size_t)(t + 2) * kstep; const char* b3 = b2 + kstep;
            PG_LDB(B0, 0, 0); PG_LDB(B1, 0, 1); PG_SCHED; PG_LDA(At, 0, 0); PG_STAGE_A(PG_SA(1, 1), offA, 1, ka1);
            PG_WAIT_V(8); PG_WAIT_L(0); PG_BAR; PG_MMA(0, 0, At, B0); PG_MMA(0, 1, At, B1); PG_BAR; PG_SCHED;
            PG_LDA(At, 0, 1); PG_STAGE_B(PG_SB(0, 0), b2); PG_STAGE_B(PG_SB(0, 1), b2 + hstep); PG_STAGE_A(PG_SA(0, 0), o2, 0, ka2);
            PG_WAIT_V(8); PG_WAIT_L(0); PG_BAR; PG_MMA(1, 0, At, B0); PG_MMA(1, 1, At, B1); PG_BAR; PG_SCHED;
            PG_LDB(B0, 1, 0); PG_LDB(B1, 1, 1); PG_SCHED; PG_LDA(At, 1, 0); PG_STAGE_A(PG_SA(0, 1), o2, 1, ka2);
            PG_WAIT_V(8); PG_WAIT_L(0); PG_BAR; PG_MMA(0, 0, At, B0); PG_MMA(0, 1, At, B1); PG_BAR; PG_SCHED;
            PG_LDA(At, 1, 1); PG_STAGE_B(PG_SB(1, 0), b3); PG_STAGE_B(PG_SB(1, 1), b3 + hstep); PG_STAGE_A(PG_SA(1, 0), o2, 0, ka3);
            PG_WAIT_V(8); PG_WAIT_L(0); PG_BAR; PG_MMA(1, 0, At, B0); PG_MMA(1, 1, At, B1); PG_BAR; PG_SCHED;
        }
        if (wr == 0) PG_BAR;
        if constexpr (FP8) asm volatile("s_nop 15\n\ts_nop 7" ::: "memory");
        if constexpr (has_pre<Epi>::value) { E(acc, cur, wr, wc, fr, fq, epre); if (has_next) E.pre(epre, nxt, wr, fr); }
        else E(acc, cur, wr, wc, fr, fq);
        if (!has_next) break;
#pragma unroll
        for (int a = 0; a < 2; ++a)
#pragma unroll
            for (int b = 0; b < 2; ++b)
#pragma unroll
                for (int m = 0; m < 4; ++m)
#pragma unroll
                    for (int n = 0; n < 2; ++n) { acc[a][b][m][n] = acc_t{}; if constexpr (FP8) asm volatile("" : "+v"(acc[a][b][m][n])); }
        cur = nxt; cB = nB; ++ui;
#pragma unroll
        for (int h = 0; h < 2; ++h)
#pragma unroll
            for (int i = 0; i < 2; ++i) offA[h][i] = offN[h][i];
        if (wr == 1) PG_BAR;
    }
    PG_WAIT_V(0);
    PG_BAR;
#undef PG_SA
#undef PG_SB
#undef PG_STAGE_A
#undef PG_STAGE_B
#undef PG_ROWOFF
#undef PG_LDA
#undef PG_LDB
#undef PG_MMA
#undef PG_WAIT_V
#undef PG_WAIT_L
#undef PG_BAR
#undef PG_SCHED
}
struct EpiP {
    static constexpr bool PERM = true;
    bf16_t* P; const float* tab; const float* hxs; const float* wss;
    __device__ __forceinline__ void operator()(const v4i32_t (&acc)[2][2][4][2], const Unit& u, int wr, int wc, int fr, int fq) const {
        const bool lat = u.m0 < RL;
        float rs[8];
#pragma unroll
        for (int ai = 0; ai < 2; ++ai)
#pragma unroll
            for (int m = 0; m < 4; ++m) rs[ai * 4 + m] = hxs[u.m0 + ai * HALF + wr * 64 + m * 16 + fr];
        float cs; { const int ln = fr + 16 * fq; cs = 4.0f * sqrtf(wave_sum((wss[ln] + wss[ln + 64]) + (wss[ln + 128] + wss[ln + 192])) * (1.0f / ((float)D * (float)PROJ))) * (1.0f / 127.0f); }
#pragma unroll
        for (int bj = 0; bj < 2; ++bj) {
            const int ct = u.pn * BM + bj * HALF;
            const int c0 = ct + wc * 32 + 8 * fq;
            const int kind = ct < C_VA ? 1 : ((ct >= C_QD && ct < C_VD) ? 2 : 0);
            const float sc = ct < C_KA ? QSCALE_A : ((ct >= C_QD && ct < C_KD) ? QSCALE_D : 1.0f);
#pragma unroll
            for (int ai = 0; ai < 2; ++ai)
#pragma unroll
                for (int m = 0; m < 4; ++m) {
                    const int row = u.m0 + ai * HALF + wr * 64 + m * 16 + fr;
                    f32x4 v0, v1; { const v4i32_t i0 = acc[ai][bj][m][0], i1 = acc[ai][bj][m][1]; const float r_ = rs[ai * 4 + m];
#pragma unroll
                      for (int k = 0; k < 4; ++k) { v0[k] = (float)i0[k] * (r_ * cs); v1[k] = (float)i1[k] * (r_ * cs); } }
                    if (kind != 0 && lat) {
                        const int pos = row % SEQ, gr = pos / GRID_W, gc = pos % GRID_W; const float* t;
                        if (kind == 1) { const int p = c0 & 63, grp = p >> 5, i0 = (p & 31) >> 1; t = tab + (grp ? T_ACOL + gc * 32 : T_AROW + gr * 32) + i0 * 2; }
                        else { const int p = c0 & 31, grp = p >> 4, i0 = (p & 15) >> 1; t = tab + (grp ? T_DCOL + gc * 16 : T_DROW + gr * 16) + i0 * 2; }
                        const f32x4 t0 = *(const f32x4*)t, t1 = *(const f32x4*)(t + 4);
                        v0 = (f32x4){v0[0] * t0[0] - v0[1] * t0[1], v0[1] * t0[0] + v0[0] * t0[1], v0[2] * t0[2] - v0[3] * t0[3], v0[3] * t0[2] + v0[2] * t0[3]};
                        v1 = (f32x4){v1[0] * t1[0] - v1[1] * t1[1], v1[1] * t1[0] + v1[0] * t1[1], v1[2] * t1[2] - v1[3] * t1[3], v1[3] * t1[2] + v1[2] * t1[3]};
                    }
                    v0 = v0 * sc; v1 = v1 * sc;
                    u32x4 w; w.x = cvt_pk_bf16(v0[0], v0[1]); w.y = cvt_pk_bf16(v0[2], v0[3]); w.z = cvt_pk_bf16(v1[0], v1[1]); w.w = cvt_pk_bf16(v1[2], v1[3]);
                    *(u32x4*)(P + (size_t)row * PROJ + c0) = w;
                }
        }
    }
};
struct EpiX {
    static constexpr bool PERM = true;
    bf16_t* XB; const float* modl; float gscale;
    __device__ __forceinline__ void operator()(const f32x4 (&acc)[2][2][4][2], const Unit& u, int wr, int wc, int fr, int fq) const {
        const int b = u.m0 < RL ? u.m0 / SEQ : NB; const float* g1 = modl + (size_t)b * 6 * D + M_G1 + u.pn * BM + wc * 32 + 8 * fq;
        bf16_t* x0 = XB + (size_t)(u.m0 + wr * 64 + fr) * D + u.pn * BM + wc * 32 + 8 * fq;
        u32x4 xv[2][4][2];
#pragma unroll
        for (int ai = 0; ai < 2; ++ai)
#pragma unroll
            for (int m = 0; m < 4; ++m)
#pragma unroll
                for (int bj = 0; bj < 2; ++bj) xv[ai][m][bj] = *(const u32x4*)(x0 + (size_t)(ai * HALF + m * 16) * D + bj * HALF);
        f32x4 gv[2][2];
#pragma unroll
        for (int bj = 0; bj < 2; ++bj)
#pragma unroll
            for (int n = 0; n < 2; ++n) gv[bj][n] = *(const f32x4*)(g1 + bj * HALF + 4 * n) * gscale;
#pragma unroll
        for (int ai = 0; ai < 2; ++ai)
#pragma unroll
            for (int m = 0; m < 4; ++m)
#pragma unroll
                for (int bj = 0; bj < 2; ++bj) { const u32x4 x = xv[ai][m][bj];
                    const f32x4 a0 = acc[ai][bj][m][0] * gv[bj][0], a1 = acc[ai][bj][m][1] * gv[bj][1]; u32x4 w;
                    w.x = cvt_pk_bf16(__builtin_bit_cast(float, x.x << 16) + a0[0], __builtin_bit_cast(float, x.x & 0xffff0000u) + a0[1]);
                    w.y = cvt_pk_bf16(__builtin_bit_cast(float, x.y << 16) + a0[2], __builtin_bit_cast(float, x.y & 0xffff0000u) + a0[3]);
                    w.z = cvt_pk_bf16(__builtin_bit_cast(float, x.z << 16) + a1[0], __builtin_bit_cast(float, x.z & 0xffff0000u) + a1[1]);
                    w.w = cvt_pk_bf16(__builtin_bit_cast(float, x.w << 16) + a1[2], __builtin_bit_cast(float, x.w & 0xffff0000u) + a1[3]);
                    *(u32x4*)(x0 + (size_t)(ai * HALF + m * 16) * D + bj * HALF) = w; }
    }
};
__device__ __forceinline__ float silu_fast(float v) { return v * __builtin_amdgcn_rcpf(1.0f + __builtin_amdgcn_exp2f(-LOG2E * v)); }
__device__ __forceinline__ unsigned pk4_fp8(float a, float b, float c, float d) { int w = 0; w = __builtin_amdgcn_cvt_pk_fp8_f32(a, b, w, false); w = __builtin_amdgcn_cvt_pk_fp8_f32(c, d, w, true); return (unsigned)w; }
__device__ __forceinline__ void store_pair16_fq(unsigned char* p0, unsigned char* p1, u32x2 a, u32x2 b, int fq) {
    auto rx = __builtin_amdgcn_permlane16_swap(a.x, b.x, false, false); auto ry = __builtin_amdgcn_permlane16_swap(a.y, b.y, false, false);
    u32x4 w; w.x = rx[0]; w.y = ry[0]; w.z = rx[1]; w.w = ry[1];
    *(u32x4*)((fq & 1) ? p1 - 8 : p0) = w;
}
struct EpiH {
    static constexpr bool PERM = true;
    unsigned char* H;
    __device__ __forceinline__ void operator()(const f32x4 (&acc)[2][2][4][2], const Unit& u, int wr, int wc, int fr, int fq) const {
        const int hc = u.pn * HALF + wc * 32 + 8 * fq;
#pragma unroll
        for (int ai = 0; ai < 2; ++ai)
#pragma unroll
            for (int m = 0; m < 4; m += 2) {
                const int row = u.m0 + ai * HALF + wr * 64 + m * 16 + fr;
                u32x2 w[2];
#pragma unroll
                for (int q = 0; q < 2; ++q) {
                    const f32x4 g0 = acc[ai][0][m + q][0], g1 = acc[ai][0][m + q][1], u0 = acc[ai][1][m + q][0], u1 = acc[ai][1][m + q][1];
                    w[q].x = pk4_fp8(silu_fast(g0[0]) * u0[0], silu_fast(g0[1]) * u0[1], silu_fast(g0[2]) * u0[2], silu_fast(g0[3]) * u0[3]);
                    w[q].y = pk4_fp8(silu_fast(g1[0]) * u1[0], silu_fast(g1[1]) * u1[1], silu_fast(g1[2]) * u1[2], silu_fast(g1[3]) * u1[3]);
                }
                store_pair16_fq(H + (size_t)row * FF + hc, H + (size_t)(row + 16) * FF + hc, w[0], w[1], fq);
            }
    }
};
struct EpiY {
    static constexpr bool PERM = true, HAS_PRE = true;
    unsigned char* Y; const float* gate;
    __device__ __forceinline__ void pre(float (&gv)[8], const Unit& u, int wr, int fr) const {
#pragma unroll
        for (int ai = 0; ai < 2; ++ai)
#pragma unroll
            for (int m = 0; m < 4; ++m) gv[ai * 4 + m] = gate[u.m0 + ai * HALF + wr * 64 + m * 16 + fr];
    }
    __device__ __forceinline__ void operator()(const f32x4 (&acc)[2][2][4][2], const Unit& u, int wr, int wc, int fr, int fq, const float (&gv)[8]) const {
#pragma unroll
        for (int ai = 0; ai < 2; ++ai)
#pragma unroll
            for (int m = 0; m < 4; m += 2) {
                const int row = u.m0 + ai * HALF + wr * 64 + m * 16 + fr;
#pragma unroll
                for (int bj = 0; bj < 2; ++bj) {
                    u32x2 w[2];
#pragma unroll
                    for (int q = 0; q < 2; ++q) { const float gt = gv[ai * 4 + m + q] * 64.0f;
                        const f32x4 v0 = acc[ai][bj][m + q][0] * gt, v1 = acc[ai][bj][m + q][1] * gt;
                        w[q].x = pk4_fp8(v0[0], v0[1], v0[2], v0[3]); w[q].y = pk4_fp8(v1[0], v1[1], v1[2], v1[3]); }
                    unsigned char* p0 = Y + (size_t)row * D + u.pn * BM + bj * HALF + wc * 32 + 8 * fq;
                    store_pair16_fq(p0, p0 + (size_t)16 * D, w[0], w[1], fq);
                }
            }
    }
};
}

struct Args { const float* in[19]; float* out; unsigned char* ws; int ph_lo, ph_hi; };
struct Ctx {
    Ptrs p; LAS unsigned char* lds;
    float *tab, *mod, *aff, *gate, *xc, *xl; int *sel, *tokslot;
    bf16_t *win, *wout, *P, *H, *Y, *MIX, *HX2, *HX, *XB; float* TMP; int wv;
};
template <class Dest>
__device__ __forceinline__ void transpose_item_fp8(const float* W, int K, int N, unsigned char* WT, LAS float* scr, int item, int lane, Dest dest) {
    const int nblk = N / 32, kb = item / nblk, nb = item % nblk, k0 = 64 * kb, n0 = 32 * nb;
    float wv[32];
#pragma unroll
    for (int i = 0; i < 32; ++i) wv[i] = W[(size_t)(k0 + 2 * i + (lane >> 5)) * N + n0 + (lane & 31)];
#pragma unroll
    for (int i = 0; i < 32; ++i) { const int kk = 2 * i + (lane >> 5); scr[kk * 33 + (lane & 31)] = wv[i] * 64.0f; }
    LDS_WAIT(); asm volatile("" ::: "memory");
    const int c = lane & 7;
#pragma unroll
    for (int j = 0; j < 4; ++j) { const int n = (lane >> 3) + 8 * j; const LAS float* s = scr + (8 * c) * 33 + n;
        u32x2 o; o.x = pg::pk4_fp8(s[0 * 33], s[1 * 33], s[2 * 33], s[3 * 33]); o.y = pg::pk4_fp8(s[4 * 33], s[5 * 33], s[6 * 33], s[7 * 33]);
        *(u32x2*)(WT + (size_t)dest(n0 + n) * K + k0 + 8 * c) = o; }
    LDS_WAIT(); asm volatile("" ::: "memory");
}
template <class Dest>
__device__ __forceinline__ void transpose_item(const float* W, int K, int N, bf16_t* WT, LAS float* scr, int item, int lane, Dest dest) {
    const int nblk = N / 32, kb = item / nblk, nb = item % nblk, k0 = 64 * kb, n0 = 32 * nb;
#pragma unroll 8
    for (int i = 0; i < 32; ++i) { const int kk = 2 * i + (lane >> 5); scr[kk * 33 + (lane & 31)] = W[(size_t)(k0 + kk) * N + n0 + (lane & 31)]; }
    LDS_WAIT(); asm volatile("" ::: "memory");
    const int c = lane & 7;
#pragma unroll
    for (int j = 0; j < 4; ++j) { const int n = (lane >> 3) + 8 * j; const LAS float* s = scr + (8 * c) * 33 + n;
        u32x4 o; o.x = cvt_pk_bf16(s[0 * 33], s[1 * 33]); o.y = cvt_pk_bf16(s[2 * 33], s[3 * 33]); o.z = cvt_pk_bf16(s[4 * 33], s[5 * 33]); o.w = cvt_pk_bf16(s[6 * 33], s[7 * 33]);
        *(u32x4*)(WT + (size_t)dest(n0 + n) * K + k0 + 8 * c) = o; }
    LDS_WAIT(); asm volatile("" ::: "memory");
}
HD int invA(int q) { const int g = q / 32, r = q % 32; return 32 * g + (r < 16 ? 2 * r : 2 * (r - 16) + 1); }
HD int invD(int q) { const int g = q / 16, r = q % 16; return 16 * g + (r < 8 ? 2 * r : 2 * (r - 8) + 1); }
HD int inproj_dst_row(int nl) {
    if (nl < C_VA) return (nl / 64) * 64 + invA(nl % 64);
    if (nl >= C_QD && nl < C_VD) return (nl / 32) * 32 + invD(nl % 32);
    return nl;
}
struct DestIn { __device__ int operator()(int n) const { return inproj_dst_row(n); } };
struct DestId { __device__ int operator()(int n) const { return n; } };
struct DestGU { int up; __device__ int operator()(int n) const { return (n / 128) * 256 + up * 128 + n % 128; } };

__device__ __forceinline__ void phase_prologue(const Ctx& C) {
    const int tid = tid_l(), lane = tid & 63, wave = __builtin_amdgcn_readfirstlane(tid >> 6), gw = blockIdx.x * NWV + wave, NGW = gridDim.x * NWV; (void)lane; (void)gw; (void)NGW;
    for (long g = (long)tid * gridDim.x + blockIdx.x; g < (long)(NROWS + 64) * 24; g += (long)gridDim.x * NT) {
        const int pos = (int)(g / 24), f = (int)(g % 24);
        const float inv = f < 16 ? exp2f(-(float)f * (13.287712379549449f / 16.0f)) : exp2f(-(float)(f - 16) * (13.287712379549449f / 8.0f));
        const bool isrow = pos < NROWS; const int p = isrow ? pos : pos - NROWS;
        const float ang = (float)p * inv; float sn, cs; sincosf(ang, &sn, &cs);
        const int idx = f < 16 ? (isrow ? T_AROW : T_ACOL) + (p * 16 + f) * 2 : (isrow ? T_DROW : T_DCOL) + (p * 8 + (f - 16)) * 2;
        C.tab[idx] = cs; C.tab[idx + 1] = sn;
    }
    LAS float* sl = (LAS float*)C.lds;
    for (int i = tid; i < (NB + 1) * D; i += NT) { const int b = i / D, k = i % D; sl[i] = silu_f(b < NB ? C.p.c[b * D + k] : C.p.c_ctx[k]); }
    __syncthreads();
    constexpr int NBR = NB + 1, BG = 11, NBG = NBR / BG; static_assert(NBG * BG == NBR, "adaLN rows reduced in groups of 11");
    LAS float* pbuf = (LAS float*)(C.lds + NBR * D * 4);
    static_assert(NBR * D * 4 + 16 * BG * 32 * 4 <= LDS_MISC, "prologue LDS");
    for (int task = blockIdx.x; task < DEPTH * 6 * D / 32; task += gridDim.x) {
        const int jg = task * 32, l = jg / (6 * D), j0 = jg % (6 * D), c = lane & 31, half = lane >> 5, kb = 128 * wave + 64 * half;
        f32x2_t acc2[NBR];
#pragma unroll
        for (int b = 0; b < NBR; ++b) acc2[b] = (f32x2_t){0.f, 0.f};
        const float* w = C.p.w_ada + ((size_t)l * D + kb) * 6 * D + j0 + c; const LAS float* s0 = sl + kb;
        for (int kk = 0; kk < 64; kk += 4) {
            const f32x2_t w01 = (f32x2_t){w[(size_t)kk * 6 * D], w[(size_t)(kk + 1) * 6 * D]}, w23 = (f32x2_t){w[(size_t)(kk + 2) * 6 * D], w[(size_t)(kk + 3) * 6 * D]};
#pragma unroll
            for (int rr = 0; rr < NBG; ++rr) { f32x4 sv[BG]; const unsigned sa = (unsigned)(size_t)(s0 + rr * BG * D + kk);
                LDS_RD11_B128(sv, sa, D * 4);
#pragma unroll
                for (int bb = 0; bb < BG; ++bb) { acc2[rr * BG + bb] = __builtin_elementwise_fma((f32x2_t){sv[bb][0], sv[bb][1]}, w01, acc2[rr * BG + bb]);
                    acc2[rr * BG + bb] = __builtin_elementwise_fma((f32x2_t){sv[bb][2], sv[bb][3]}, w23, acc2[rr * BG + bb]); } }
        }
        float acc[NBR];
#pragma unroll
        for (int b = 0; b < NBR; ++b) acc[b] = acc2[b][0] + acc2[b][1];
#pragma unroll
        for (int rr = 0; rr < NBG; ++rr) {
#pragma unroll
            for (int bb = 0; bb < BG; ++bb) pbuf[((wave * 2 + half) * BG + bb) * 32 + c] = acc[rr * BG + bb];
            __syncthreads();
            if (tid < BG * 32) { const int bb = tid / 32, cc = tid % 32; float s = 0.f;
#pragma unroll
                for (int p = 0; p < 16; ++p) s += pbuf[(p * BG + bb) * 32 + cc];
                C.mod[((size_t)l * NBR + rr * BG + bb) * 6 * D + j0 + cc] = s + C.p.b_ada[l * 6 * D + j0 + cc]; }
            __syncthreads();
        }
    }
    __syncthreads();
    LAS float* scr = (LAS float*)(C.lds + wave * 16384);
    constexpr int I_OUT = (D / 64) * (D / 32);
    for (int it = gw; it < DEPTH * I_OUT; it += NGW) { const int l = it / I_OUT, r = it % I_OUT;
        transpose_item(C.p.w_out + (size_t)l * D * D, D, D, C.wout + (size_t)l * D * D, scr, r, lane, DestId{}); }
    float* wss = (float*)(C.p.ws + WS_CTL + CTL_WINMAX);
    LAS float* pm = (LAS float*)(C.lds + 8 * 16384);
    __syncthreads();
    for (int slot = blockIdx.x; slot < DEPTH * 256; slot += gridDim.x) {
        const int l = slot / 256, s = slot % 256; constexpr int PER = D * PROJ / 256;
        const float* w = C.p.w_in + (size_t)l * D * PROJ + (size_t)s * PER; float acc = 0.f;
        for (int i = tid; i < PER / 4; i += NT) { const f32x4 v = *(const f32x4*)(w + 4 * i); acc += (v[0] * v[0] + v[1] * v[1]) + (v[2] * v[2] + v[3] * v[3]); }
        acc = wave_sum(acc); if (lane == 0) pm[wave] = acc;
        __syncthreads();
        if (tid == 0) { float t = 0.f; for (int q = 0; q < NWV; ++q) t += pm[q]; wss[slot] = t; }
        __syncthreads();
    }
    __syncthreads();
}
__device__ __forceinline__ float win_amax(const unsigned char* ws, int l, int lane) {
    const float* wss = (const float*)(ws + WS_CTL + CTL_WINMAX) + l * 256;
    const float t = wave_sum((wss[lane] + wss[lane + 64]) + (wss[lane + 128] + wss[lane + 192]));
    return 4.0f * sqrtf(t * (1.0f / ((float)D * (float)PROJ)));
}
__device__ __forceinline__ void phase_prologue_b(const Ctx& C) {
    const int tid = tid_l(), lane = tid & 63, wave = __builtin_amdgcn_readfirstlane(tid >> 6), gw = blockIdx.x * NWV + wave, NGW = gridDim.x * NWV;
    LAS float* scr = (LAS float*)(C.lds + wave * 16384);
    constexpr int I_IN = (D / 64) * (PROJ / 32);
    for (int it = gw; it < DEPTH * I_IN; it += NGW) {
        const int l = it / I_IN, item = it % I_IN, nblk = PROJ / 32, kb = item / nblk, nb = item % nblk, k0 = 64 * kb, n0 = 32 * nb;
        const float* W = C.p.w_in + (size_t)l * D * PROJ; signed char* WT = (signed char*)C.win + (size_t)l * PROJ * D;
        { const int nl = n0 + (lane & 31); const float am = win_amax(C.p.ws, l, lane); const float inv = am > 0.f ? 127.0f / am : 0.f;
#pragma unroll 8
          for (int i = 0; i < 32; ++i) { const int kk = 2 * i + (lane >> 5); scr[kk * 33 + (lane & 31)] = W[(size_t)(k0 + kk) * PROJ + nl] * inv; } }
        LDS_WAIT(); asm volatile("" ::: "memory");
        const int c = lane & 7;
#pragma unroll
        for (int j = 0; j < 4; ++j) { const int n = (lane >> 3) + 8 * j; const LAS float* s = scr + (8 * c) * 33 + n; unsigned lo = 0u, hi = 0u;
#pragma unroll
            for (int q = 0; q < 4; ++q) { lo |= ((unsigned)__float2int_rn(fminf(fmaxf(s[q * 33], -127.f), 127.f)) & 0xffu) << (8 * q); hi |= ((unsigned)__float2int_rn(fminf(fmaxf(s[(4 + q) * 33], -127.f), 127.f)) & 0xffu) << (8 * q); }
            *(u32x2*)(WT + (size_t)inproj_dst_row(n0 + n) * D + k0 + 8 * c) = (u32x2){lo, hi}; }
        LDS_WAIT(); asm volatile("" ::: "memory");
    }
    __syncthreads();
}
constexpr int CVT_ITEMS = 3 * NE * (D / 64) * (FF / 32);
struct CvtItem { const float* src; unsigned char* dst; int mat, n0; };
__device__ __forceinline__ CvtItem cvt_decode(const Ctx& C, int l, int it, int lane) {
    constexpr int I_E = (D / 64) * (FF / 32), NBLK = FF / 32;
    const int mat = it / (NE * I_E), e = (it / I_E) % NE, r = it % I_E, kb = r / NBLK, nb = r % NBLK, k0 = 64 * kb, n0 = 32 * nb;
    const size_t wo = ((size_t)l * NE + e) * D * FF;
    const float* W = mat == 0 ? C.p.w_gate + wo : mat == 1 ? C.p.w_up + wo : C.p.w_down + wo;
    unsigned char* wgu = C.p.ws + WS_WGU + (size_t)(l & 1) * NE * 2 * FF * D; unsigned char* wd = C.p.ws + WS_WD + (size_t)(l & 1) * NE * D * FF;
    CvtItem c; c.src = W + (size_t)(k0 + (lane >> 5)) * FF + n0 + (lane & 31); c.dst = (mat == 2 ? wd + (size_t)e * D * FF : wgu + (size_t)e * 2 * FF * D) + k0; c.mat = mat; c.n0 = n0;
    return c;
}
__device__ __forceinline__ void phase_cvt_experts(const Ctx& C, int l, int it0, int it1, int w, int nw) {
    static_assert(D == FF, "expert matrices are square");
    const int tid = tid_l(), lane = tid & 63, wave = __builtin_amdgcn_readfirstlane(tid >> 6);
    LAS float* scr = (LAS float*)(C.lds + wave * 16384);
    float ra[32], rb[32];
    auto issue = [&](float (&r)[32], const CvtItem& c) {
#pragma unroll
        for (int i = 0; i < 32; ++i) r[i] = c.src[(size_t)(2 * i) * FF]; };
    auto process = [&](float (&r)[32], const CvtItem& cur) {
#pragma unroll
        for (int i = 0; i < 32; ++i) { const int kk = 2 * i + (lane >> 5); scr[kk * 33 + (lane & 31)] = r[i] * 64.0f; }
        LDS_WAIT(); asm volatile("" ::: "memory");
        const int c = lane & 7;
#pragma unroll
        for (int j = 0; j < 4; ++j) { const int n = cur.n0 + (lane >> 3) + 8 * j; const LAS float* sp = scr + (8 * c) * 33 + (lane >> 3) + 8 * j;
            u32x2 o; o.x = pg::pk4_fp8(sp[0 * 33], sp[1 * 33], sp[2 * 33], sp[3 * 33]); o.y = pg::pk4_fp8(sp[4 * 33], sp[5 * 33], sp[6 * 33], sp[7 * 33]);
            const int drow = cur.mat == 2 ? n : (n / 128) * 256 + cur.mat * 128 + n % 128;
            *(u32x2*)(cur.dst + (size_t)drow * D + 8 * c) = o; }
        LDS_WAIT(); asm volatile("" ::: "memory"); };
    int it = it0 + w;
    CvtItem ca{}, cb{};
    if (it < it1) { ca = cvt_decode(C, l, it, lane); issue(ra, ca); }
    while (it < it1) {
        cb = cvt_decode(C, l, it + nw < it1 ? it + nw : it, lane); issue(rb, cb);
        process(ra, ca);
        it += nw; if (it >= it1) break;
        ca = cvt_decode(C, l, it + nw < it1 ? it + nw : it, lane); issue(ra, ca);
        process(rb, cb);
        it += nw;
    }
    __syncthreads();
}
__device__ __forceinline__ void yf8_add(f32x4& a, const unsigned w, const float wf) {
    const f32x2_t lo = __builtin_amdgcn_cvt_pk_f32_fp8((int)w, false), hi = __builtin_amdgcn_cvt_pk_f32_fp8((int)w, true);
    a[0] += wf * lo[0]; a[1] += wf * lo[1]; a[2] += wf * hi[0]; a[3] += wf * hi[1];
}
template <bool FINAL, bool SRCF32>
__device__ __forceinline__ void phase_rowA(const Ctx& C, int l, float gscale = 1.0f) {
    const int tid = tid_l(), lane = tid & 63, wave = __builtin_amdgcn_readfirstlane(tid >> 6), gw = blockIdx.x * NWV + wave, NGW = gridDim.x * NWV;
    const int nrows = FINAL ? RL : RALL;
    const int per = (nrows + NGW - 1) / NGW, r0 = gw * per, r1 = (r0 + per < nrows) ? r0 + per : nrows;
#define RA_LOADX(dst, row) do { if (SRCF32) { const float* _s = ((row) < RL ? C.p.x + (size_t)(row) * D : C.p.ctx + (size_t)((row) - RL) * D); _Pragma("unroll") for (int j = 0; j < 4; ++j) dst[j] = __builtin_bit_cast(u32x4, *(const f32x4*)(_s + 4 * lane + 256 * j)); } \
        else { const bf16_t* _s = C.XB + (size_t)(row) * D + 4 * lane; _Pragma("unroll") for (int j = 0; j < 4; ++j) { const u32x2 _w = *(const u32x2*)(_s + 256 * j); dst[j] = (u32x4){_w.x, _w.y, 0u, 0u}; } } } while (0)
#define RA_LOADTS(dst, row) do { dst = (l > 0 && lane < NE) ? C.tokslot[(size_t)(row) * NE + lane] : -1; } while (0)
#define RA_ISSUEY(YY, WF, MSK, ts) do { unsigned _m = (unsigned)__ballot((ts) >= 0); int _s0 = 0, _s1, _s2, _s3; WF[0] = WF[1] = WF[2] = WF[3] = 0.f; \
        if (_m) { _s0 = __builtin_amdgcn_readlane((ts), __builtin_ctz(_m)); _m &= _m - 1; WF[0] = 1.f; } _s1 = _s2 = _s3 = _s0; \
        if (_m) { _s1 = __builtin_amdgcn_readlane((ts), __builtin_ctz(_m)); _m &= _m - 1; WF[1] = 1.f; } \
        if (_m) { _s2 = __builtin_amdgcn_readlane((ts), __builtin_ctz(_m)); _m &= _m - 1; WF[2] = 1.f; } \
        if (_m) { _s3 = __builtin_amdgcn_readlane((ts), __builtin_ctz(_m)); _m &= _m - 1; WF[3] = 1.f; } MSK = _m; \
        _Pragma("unroll") for (int j = 0; j < 4; ++j) { YY[0][j] = *(const unsigned*)(Yb + (size_t)_s0 * D + 4 * lane + 256 * j); YY[1][j] = *(const unsigned*)(Yb + (size_t)_s1 * D + 4 * lane + 256 * j); \
            YY[2][j] = *(const unsigned*)(Yb + (size_t)_s2 * D + 4 * lane + 256 * j); YY[3][j] = *(const unsigned*)(Yb + (size_t)_s3 * D + 4 * lane + 256 * j); } } while (0)
    const unsigned char* Yb = (const unsigned char*)C.Y;
    u32x4 xc[4], xn[4], x2[4]; int tsc = -1, tsn = -1, ts2 = -1; unsigned yc[4][4], yn[4][4]; float wc_[4], wn_[4]; unsigned mc = 0u, mn = 0u;
    f32x4 A[4], S[4], G[4]; int bcur = -1;
#pragma unroll
    for (int j = 0; j < 4; ++j) { xc[j] = xn[j] = x2[j] = (u32x4){0u, 0u, 0u, 0u}; A[j] = S[j] = G[j] = (f32x4){0.f, 0.f, 0.f, 0.f}; }
#pragma unroll
    for (int i = 0; i < 4; ++i) { wc_[i] = wn_[i] = 0.f;
#pragma unroll
        for (int j = 0; j < 4; ++j) yc[i][j] = yn[i][j] = 0u; }
    if (r0 < r1) { RA_LOADTS(tsc, r0); RA_LOADX(xc, r0); if (l > 0) RA_ISSUEY(yc, wc_, mc, tsc); }
    if (r0 + 1 < r1) { RA_LOADTS(tsn, r0 + 1); RA_LOADX(xn, r0 + 1); }
    for (int row = r0; row < r1; ++row) {
        if (l > 0 && row + 1 < r1) RA_ISSUEY(yn, wn_, mn, tsn);
        if (row + 2 < r1) { RA_LOADTS(ts2, row + 2); RA_LOADX(x2, row + 2); }
        const int b = row_batch(row);
        if (b != bcur) { bcur = b;
            if (FINAL) {
#pragma unroll
                for (int j = 0; j < 4; ++j) A[j] = *(const f32x4*)(C.p.norm_final + 4 * lane + 256 * j);
            } else { const float* m = C.mod + ((size_t)l * (NB + 1) + b) * 6 * D + 4 * lane; const float* nw = C.p.norm1 + (size_t)l * D + 4 * lane;
#pragma unroll
                for (int j = 0; j < 4; ++j) { A[j] = *(const f32x4*)(nw + 256 * j) * (*(const f32x4*)(m + M_SC1 + 256 * j) + 1.0f); S[j] = *(const f32x4*)(m + M_SH1 + 256 * j); } }
            if (l > 0) { const float* g2 = C.mod + ((size_t)(l - 1) * (NB + 1) + b) * 6 * D + M_G2 + 4 * lane;
#pragma unroll
                for (int j = 0; j < 4; ++j) G[j] = *(const f32x4*)(g2 + 256 * j) * (gscale * (1.0f / 64.0f)); } }
        f32x4 v[4];
#pragma unroll
        for (int j = 0; j < 4; ++j) { if (SRCF32) v[j] = __builtin_bit_cast(f32x4, xc[j]); else { const unsigned w0 = xc[j][0], w1 = xc[j][1];
            v[j] = (f32x4){__builtin_bit_cast(float, w0 << 16), __builtin_bit_cast(float, w0 & 0xffff0000u), __builtin_bit_cast(float, w1 << 16), __builtin_bit_cast(float, w1 & 0xffff0000u)}; } }
        if (l > 0) {
            f32x4 a[4];
#pragma unroll
            for (int j = 0; j < 4; ++j) { a[j] = (f32x4){0.f, 0.f, 0.f, 0.f};
#pragma unroll
                for (int i = 0; i < 4; ++i) yf8_add(a[j], yc[i][j], wc_[i]); }
            while (mc) { const int s = __builtin_amdgcn_readlane(tsc, __builtin_ctz(mc)); mc &= mc - 1;
#pragma unroll
                for (int j = 0; j < 4; ++j) yf8_add(a[j], *(const unsigned*)(Yb + (size_t)s * D + 4 * lane + 256 * j), 1.0f); }
#pragma unroll
            for (int j = 0; j < 4; ++j) v[j] = v[j] + G[j] * a[j];
        }
        float ss = 0.f;
#pragma unroll
        for (int j = 0; j < 4; ++j) ss += (v[j][0] * v[j][0] + v[j][1] * v[j][1]) + (v[j][2] * v[j][2] + v[j][3] * v[j][3]);
        const float rstd = 1.0f / sqrtf(wave_sum(ss) * (1.0f / D) + EPS);
        if (FINAL) {
            float* dst = C.p.out + (size_t)row * D;
#pragma unroll
            for (int j = 0; j < 4; ++j) *(f32x4*)(dst + 4 * lane + 256 * j) = v[j] * rstd * A[j];
        } else {
            bf16_t* xo = C.XB + (size_t)row * D + 4 * lane;
#pragma unroll
            for (int j = 0; j < 4; ++j) { u32x2 w; w.x = cvt_pk_bf16(v[j][0], v[j][1]); w.y = cvt_pk_bf16(v[j][2], v[j][3]); *(u32x2*)(xo + 256 * j) = w; }
            f32x4 hq[4]; float am = 0.f;
#pragma unroll
            for (int j = 0; j < 4; ++j) { hq[j] = v[j] * rstd * A[j] + S[j]; am = fmaxf(fmaxf(am, fmaxf(fabsf(hq[j][0]), fabsf(hq[j][1]))), fmaxf(fabsf(hq[j][2]), fabsf(hq[j][3]))); }
            am = wave_max(am); const float inv = am > 0.f ? 127.0f / am : 0.f;
            if (lane == 0) ((float*)(C.p.ws + WS_HXS))[row] = am * (1.0f / 127.0f);
            unsigned char* hr = (unsigned char*)C.HX + (size_t)row * D + 4 * lane;
#pragma unroll
            for (int j = 0; j < 4; ++j) { const unsigned w = ((unsigned)__float2int_rn(fminf(fmaxf(hq[j][0] * inv, -127.f), 127.f)) & 0xffu) | (((unsigned)__float2int_rn(fminf(fmaxf(hq[j][1] * inv, -127.f), 127.f)) & 0xffu) << 8) | (((unsigned)__float2int_rn(fminf(fmaxf(hq[j][2] * inv, -127.f), 127.f)) & 0xffu) << 16) | (((unsigned)__float2int_rn(fminf(fmaxf(hq[j][3] * inv, -127.f), 127.f)) & 0xffu) << 24);
                *(unsigned*)(hr + 256 * j) = w; }
        }
        tsc = tsn; tsn = ts2; mc = mn;
#pragma unroll
        for (int j = 0; j < 4; ++j) { xc[j] = xn[j]; xn[j] = x2[j]; }
#pragma unroll
        for (int i = 0; i < 4; ++i) { wc_[i] = wn_[i];
#pragma unroll
            for (int j = 0; j < 4; ++j) yc[i][j] = yn[i][j]; }
    }
#undef RA_LOADX
#undef RA_LOADTS
#undef RA_ISSUEY
}
__device__ __forceinline__ void phase_rowB(const Ctx& C, int l, int nq) {
    const int tid = tid_l(), lane = tid & 63, wave = __builtin_amdgcn_readfirstlane(tid >> 6), gw = blockIdx.x * NWV + wave, NGW = gridDim.x * NWV;
    LAS float* R = (LAS float*)C.lds;
    const float* rt = C.p.router + (size_t)l * D * NE;
    for (int i = tid; i < D * NE; i += NT) R[(i % NE) * D + i / NE] = rt[i];
    __syncthreads();
    const int per = (nq + NGW - 1) / NGW, r0 = gw * per, r1 = (r0 + per < nq) ? r0 + per : nq;
    f32x4 xn[4], A[4], S[4]; int bcur = -1; int row = r0;
    u32x2 xr_[4];
    if (row < r1) { const bf16_t* s = C.XB + (size_t)row * D + 4 * lane;
#pragma unroll
        for (int j = 0; j < 4; ++j) xr_[j] = *(const u32x2*)(s + 256 * j); }
    for (; row < r1; ++row) {
        f32x4 v[4]; float ss = 0.f;
#pragma unroll
        for (int j = 0; j < 4; ++j) xn[j] = (f32x4){__builtin_bit_cast(float, xr_[j].x << 16), __builtin_bit_cast(float, xr_[j].x & 0xffff0000u), __builtin_bit_cast(float, xr_[j].y << 16), __builtin_bit_cast(float, xr_[j].y & 0xffff0000u)};
        const int b = row_batch(row);
        if (b != bcur) { bcur = b; const float* m = C.mod + ((size_t)l * (NB + 1) + b) * 6 * D + 4 * lane; const float* nw = C.p.norm2 + (size_t)l * D + 4 * lane;
#pragma unroll
            for (int j = 0; j < 4; ++j) { A[j] = *(const f32x4*)(nw + 256 * j) * (*(const f32x4*)(m + M_SC2 + 256 * j) + 1.0f); S[j] = *(const f32x4*)(m + M_SH2 + 256 * j); } }
#pragma unroll
        for (int j = 0; j < 4; ++j) { v[j] = xn[j]; ss += (v[j][0] * v[j][0] + v[j][1] * v[j][1]) + (v[j][2] * v[j][2] + v[j][3] * v[j][3]); }
        if (row + 1 < r1) { const bf16_t* s = C.XB + (size_t)(row + 1) * D + 4 * lane;
#pragma unroll
            for (int j = 0; j < 4; ++j) xr_[j] = *(const u32x2*)(s + 256 * j); }
        const float rstd = 1.0f / sqrtf(wave_sum(ss) * (1.0f / D) + EPS);
        unsigned char* hr = (unsigned char*)C.HX2 + (size_t)row * D + 4 * lane;
#pragma unroll
        for (int j = 0; j < 4; ++j) { v[j] = v[j] * rstd * A[j] + S[j]; *(unsigned*)(hr + 256 * j) = pg::pk4_fp8(v[j][0], v[j][1], v[j][2], v[j][3]); }
        float p[NE];
        { f32x2_t q[NE];
#pragma unroll
          for (int e = 0; e < NE; ++e) q[e] = (f32x2_t){0.f, 0.f};
          f32x4 ra_[8], rb_[8]; const unsigned rbase = (unsigned)(size_t)(R + 4 * lane);
          LDS_ISSUE8_B128(ra_, rbase, D * 4);
#pragma unroll
          for (int k = 0; k < 8; k += 2) {
              const f32x2_t vlo = (f32x2_t){v[k >> 1][0], v[k >> 1][1]}, vhi = (f32x2_t){v[k >> 1][2], v[k >> 1][3]};
              LDS_ISSUE8_B128(rb_, rbase + (unsigned)((8 * D + 256 * (k >> 1)) * 4), D * 4); LDS_WAIT8(ra_, 8);
#pragma unroll
              for (int e = 0; e < 8; ++e) q[e] = __builtin_elementwise_fma(vlo, (f32x2_t){ra_[e][0], ra_[e][1]}, q[e]);
#pragma unroll
              for (int e = 0; e < 8; ++e) q[e] = __builtin_elementwise_fma(vhi, (f32x2_t){ra_[e][2], ra_[e][3]}, q[e]);
              if (k + 2 < 8) { LDS_ISSUE8_B128(ra_, rbase + (unsigned)(256 * ((k >> 1) + 1) * 4), D * 4); LDS_WAIT8(rb_, 8); } else { LDS_WAIT8(rb_, 0); }
#pragma unroll
              for (int e = 0; e < 8; ++e) q[8 + e] = __builtin_elementwise_fma(vlo, (f32x2_t){rb_[e][0], rb_[e][1]}, q[8 + e]);
#pragma unroll
              for (int e = 0; e < 8; ++e) q[8 + e] = __builtin_elementwise_fma(vhi, (f32x2_t){rb_[e][2], rb_[e][3]}, q[8 + e]);
          }
#pragma unroll
          for (int e = 0; e < NE; ++e) p[e] = q[e][0] + q[e][1]; }
#pragma unroll
        for (int j = 0; j < 8; ++j) { auto rr = __builtin_amdgcn_permlane32_swap(__float_as_uint(p[j]), __float_as_uint(p[j + 8]), false, false); p[j] = __uint_as_float(rr[0]) + __uint_as_float(rr[1]); }
#pragma unroll
        for (int j = 0; j < 4; ++j) { auto rr = __builtin_amdgcn_permlane16_swap(__float_as_uint(p[j]), __float_as_uint(p[j + 4]), false, false); p[j] = __uint_as_float(rr[0]) + __uint_as_float(rr[1]); }
#pragma unroll
        for (int j = 0; j < 2; ++j) { const float a = p[j] + dpp_f(p[j], 3), b2 = p[j + 2] + dpp_f(p[j + 2], 3); p[j] = (lane & 8) ? b2 : a; }
        float lg; { const float a = p[0] + dpp_f(p[0], 2), b2 = p[1] + dpp_f(p[1], 2); lg = (lane & 4) ? b2 : a; }
        lg += dpp_f(lg, 1); lg += dpp_f(lg, 0);
        const float mx = wave_max(lg);
        const float ex = expf(lg - mx); const float se = wave_sum(ex) * 0.25f;
        const int e = ((lane >> 5) & 1) * 8 + ((lane >> 4) & 1) * 4 + ((lane >> 3) & 1) * 2 + ((lane >> 2) & 1);
        if ((lane & 3) == 0) C.aff[(size_t)row * NE + e] = ex / se;
    }
    __syncthreads();
}
template <int NV>
__device__ __forceinline__ void select_task(const Ctx& C, int base_row, int cap, int e, int slot0, int lane) {
    unsigned v[NV];
#pragma unroll
    for (int i = 0; i < NV; ++i) v[i] = __builtin_bit_cast(unsigned, C.aff[(size_t)(base_row + i * 64 + lane) * NE + e]);
    unsigned T = 0u;
    for (int bit = 30; bit >= 0; --bit) { const unsigned cand = T | (1u << bit); int cnt = 0;
#pragma unroll
        for (int i = 0; i < NV; ++i) cnt += __builtin_popcountll(__ballot(v[i] >= cand));
        if (cnt >= cap) T = cand; }
    int ngt = 0;
#pragma unroll
    for (int i = 0; i < NV; ++i) ngt += __builtin_popcountll(__ballot(v[i] > T));
    const int need = cap - ngt;
    const unsigned long long lt = (1ull << lane) - 1ull; int nsel = 0, neq = 0;
#pragma unroll
    for (int i = 0; i < NV; ++i) {
        const bool gt = v[i] > T, eq = v[i] == T; const unsigned long long meq = __ballot(eq);
        const bool take = gt || (eq && (neq + __builtin_popcountll(meq & lt)) < need);
        const unsigned long long msel = __ballot(take);
        const int row = base_row + i * 64 + lane; int slot = -1;
        if (take) { slot = slot0 + nsel + __builtin_popcountll(msel & lt); C.sel[slot] = row; C.gate[slot] = __builtin_bit_cast(float, v[i]); }
        C.tokslot[(size_t)row * NE + e] = slot;
        nsel += __builtin_popcountll(msel); neq += __builtin_popcountll(meq);
    }
}
__device__ __forceinline__ void phase_select(const Ctx& C, bool need_ctx) {
    const int tid = tid_l(), lane = tid & 63, wave = __builtin_amdgcn_readfirstlane(tid >> 6), gw = blockIdx.x * NWV + wave, NGW = gridDim.x * NWV; (void)lane; (void)gw; (void)NGW;
    const int ntask = NB * NE * (need_ctx ? 2 : 1);
    for (int task = wave * (int)gridDim.x + (int)blockIdx.x; task < ntask; task += NGW) {
        const int set = task / (NB * NE), b = (task / NE) % NB, e = task % NE;
        if (set == 0) select_task<SEQ / 64>(C, b * SEQ, CAPL, e, e * SLOTS_E + b * CAPL, lane);
        else select_task<CTX / 64>(C, RL + b * CTX, CAPC, e, e * SLOTS_E + SLOTS_L + b * CAPC, lane);
    }
}
namespace att {
typedef float f32x16 __attribute__((ext_vector_type(16)));
typedef short v4i16_t __attribute__((ext_vector_type(4)));
typedef __bf16 bf16x2_t __attribute__((ext_vector_type(2)));
constexpr int KSTR = 144, VSTR = 192, TILE_B = 64 * KSTR, BUF_B = TILE_B + 64 * VSTR;
constexpr float THR = 8.0f, THR_LO = 32.0f;
__device__ __forceinline__ unsigned pk2(float a, float b) { bf16x2_t v = {(__bf16)a, (__bf16)b}; return __builtin_bit_cast(unsigned, v); }
__device__ __forceinline__ float xmax32(float x) { auto rr = __builtin_amdgcn_permlane32_swap(__float_as_uint(x), __float_as_uint(x), false, false); return fmaxf(__uint_as_float(rr[0]), __uint_as_float(rr[1])); }
__device__ __forceinline__ float xsum32(float x) { auto rr = __builtin_amdgcn_permlane32_swap(__float_as_uint(x), __float_as_uint(x), false, false); return __uint_as_float(rr[0]) + __uint_as_float(rr[1]); }
__device__ __forceinline__ int crow(int reg, int h) { return (reg & 3) + 8 * (reg >> 2) + 4 * h; }
#ifndef PROBE_ATT
#define PROBE_ATT 0
#endif
#define MFMA32(a, b, c) __builtin_amdgcn_mfma_f32_32x32x16_bf16((a), (b), (c), 0, 0, 0)
__device__ __forceinline__ void store_pair16(bf16_t* rowp, u32x2 a, u32x2 b, int h) {
    auto rx = __builtin_amdgcn_permlane32_swap(a.x, b.x, false, false); auto ry = __builtin_amdgcn_permlane32_swap(a.y, b.y, false, false);
    u32x4 w; w.x = rx[0]; w.y = ry[0]; w.z = rx[1]; w.w = ry[1];
    *(u32x4*)(rowp + 8 * h) = w;
}
__device__ __forceinline__ bf16x8 ones_rows(int lane) { const unsigned v = (lane == 0 || lane == 32 || lane == 17 || lane == 49) ? 0x3F803F80u : 0u; u32x4 w; w.x = v; w.y = v; w.z = v; w.w = v; return __builtin_bit_cast(bf16x8, w); }
__device__ __forceinline__ float rowsum(const f32x4& L, int lane) { const float a = __shfl(L[0], lane & 15), b = __shfl(L[1], lane & 15); return (lane & 16) ? b : a; }

#define ATT_VTR(n, ks, hi, db) "ds_read_b64_tr_b16 %" #n ", %16 offset:" #ks "*3072+" #hi "*1536+" #db "*64\n\t"
template <int DKS, bool WAIT>
__device__ __forceinline__ void katt_read(unsigned kb_, bf16x8 (&Kf)[8], int lane) {
    const int r = lane & 31, h = lane >> 5;
    const unsigned ka = kb_ + r * KSTR + 16 * h;
    constexpr int o1 = 32, o2 = (DKS == 4) ? 64 : 32 * KSTR, o3 = (DKS == 4) ? 96 : 32 * KSTR + 32, o4 = (DKS == 4) ? 32 * KSTR : 64, o5 = (DKS == 4) ? 32 * KSTR + 32 : 96,
                  o6 = 32 * KSTR + 64, o7 = 32 * KSTR + 96;
    if constexpr (WAIT)
        asm volatile("ds_read_b128 %0, %8\n\tds_read_b128 %1, %8 offset:%c9\n\tds_read_b128 %2, %8 offset:%c10\n\tds_read_b128 %3, %8 offset:%c11\n\t"
                     "ds_read_b128 %4, %8 offset:%c12\n\tds_read_b128 %5, %8 offset:%c13\n\tds_read_b128 %6, %8 offset:%c14\n\tds_read_b128 %7, %8 offset:%c15\n\ts_waitcnt lgkmcnt(0)"
                     : "=&v"(Kf[0]), "=&v"(Kf[1]), "=&v"(Kf[2]), "=&v"(Kf[3]), "=&v"(Kf[4]), "=&v"(Kf[5]), "=&v"(Kf[6]), "=&v"(Kf[7])
                     : "v"(ka), "i"(o1), "i"(o2), "i"(o3), "i"(o4), "i"(o5), "i"(o6), "i"(o7) : "memory");
    else
        asm volatile("ds_read_b128 %0, %8\n\tds_read_b128 %1, %8 offset:%c9\n\tds_read_b128 %2, %8 offset:%c10\n\tds_read_b128 %3, %8 offset:%c11\n\t"
                     "ds_read_b128 %4, %8 offset:%c12\n\tds_read_b128 %5, %8 offset:%c13\n\tds_read_b128 %6, %8 offset:%c14\n\tds_read_b128 %7, %8 offset:%c15"
                     : "=&v"(Kf[0]), "=&v"(Kf[1]), "=&v"(Kf[2]), "=&v"(Kf[3]), "=&v"(Kf[4]), "=&v"(Kf[5]), "=&v"(Kf[6]), "=&v"(Kf[7])
                     : "v"(ka), "i"(o1), "i"(o2), "i"(o3), "i"(o4), "i"(o5), "i"(o6), "i"(o7) : "memory");
}
__device__ __forceinline__ void katt_wait(bf16x8 (&Kf)[8]) {
    asm volatile("s_waitcnt lgkmcnt(0)" : "+v"(Kf[0]), "+v"(Kf[1]), "+v"(Kf[2]), "+v"(Kf[3]), "+v"(Kf[4]), "+v"(Kf[5]), "+v"(Kf[6]), "+v"(Kf[7]) :: "memory");
}
template <int NSUB, int DKS>
__device__ __forceinline__ void flash_tile(unsigned vb_, unsigned kn_, bool has_next, const bf16x8 (&Q)[NSUB][DKS], f32x16 (&O)[NSUB][2], float (&m)[NSUB], f32x4 (&L)[NSUB], const bf16x8& onesA,
                                           bf16x8 (&Kf)[8], int lane, bool masked, int dq, bool first) {
    static_assert(NSUB * DKS == 4, "eight K fragments per tile");
    const int r = lane & 31, h = lane >> 5; (void)r;
    f32x16 S[NSUB][2];
    bool allz = true;
#pragma unroll
    for (int sub = 0; sub < NSUB; ++sub) allz = allz && __all(m[sub] == 0.f);
    if (allz) {
#pragma unroll
        for (int sub = 0; sub < NSUB; ++sub)
#pragma unroll
            for (int kb = 0; kb < 2; ++kb) {
                const f32x16 zero = {0.f, 0.f, 0.f, 0.f, 0.f, 0.f, 0.f, 0.f, 0.f, 0.f, 0.f, 0.f, 0.f, 0.f, 0.f, 0.f};
                S[sub][kb] = MFMA32(Kf[(DKS == 4) ? (kb * 4) : (kb * 2 + 4 * sub)], Q[sub][0], zero);
#pragma unroll
                for (int s = 1; s < DKS; ++s) S[sub][kb] = MFMA32(Kf[(DKS == 4) ? (kb * 4 + s) : (kb * 2 + s + 4 * sub)], Q[sub][s], S[sub][kb]);
            }
    } else {
#pragma unroll
        for (int sub = 0; sub < NSUB; ++sub)
#pragma unroll
            for (int kb = 0; kb < 2; ++kb) {
#pragma unroll
                for (int i = 0; i < 16; ++i) S[sub][kb][i] = -m[sub];
#pragma unroll
                for (int s = 0; s < DKS; ++s) S[sub][kb] = MFMA32(Kf[(DKS == 4) ? (kb * 4 + s) : (kb * 2 + s + 4 * sub)], Q[sub][s], S[sub][kb]);
            }
    }
#pragma unroll
    for (int sub = 0; sub < NSUB; ++sub) asm volatile("" : "+v"(S[sub][0]), "+v"(S[sub][1]));
    v4i16_t Vr[16];
    { const int i16 = lane & 15, q = i16 >> 2, p = i16 & 3, rblk = (lane >> 4) & 1; const unsigned va = vb_ + (4 * h + q) * VSTR + (16 * rblk + 4 * p) * 2;
      asm volatile(ATT_VTR(0, 0, 0, 0) ATT_VTR(1, 0, 1, 0) ATT_VTR(2, 0, 0, 1) ATT_VTR(3, 0, 1, 1) ATT_VTR(4, 1, 0, 0) ATT_VTR(5, 1, 1, 0) ATT_VTR(6, 1, 0, 1) ATT_VTR(7, 1, 1, 1)
                   ATT_VTR(8, 2, 0, 0) ATT_VTR(9, 2, 1, 0) ATT_VTR(10, 2, 0, 1) ATT_VTR(11, 2, 1, 1) ATT_VTR(12, 3, 0, 0) ATT_VTR(13, 3, 1, 0) ATT_VTR(14, 3, 0, 1) ATT_VTR(15, 3, 1, 1)
                   : "=&v"(Vr[0]), "=&v"(Vr[1]), "=&v"(Vr[2]), "=&v"(Vr[3]), "=&v"(Vr[4]), "=&v"(Vr[5]), "=&v"(Vr[6]), "=&v"(Vr[7]),
                     "=&v"(Vr[8]), "=&v"(Vr[9]), "=&v"(Vr[10]), "=&v"(Vr[11]), "=&v"(Vr[12]), "=&v"(Vr[13]), "=&v"(Vr[14]), "=&v"(Vr[15])
                   : "v"(va) : "memory"); }
#pragma unroll
    for (int sub = 0; sub < NSUB; ++sub) {
        if (masked) {
#pragma unroll
            for (int kb = 0; kb < 2; ++kb)
#pragma unroll
                for (int i = 0; i < 16; ++i) { const int dl = dq - (32 * kb + crow(i, h)); S[sub][kb][i] = (dl > WINDOW || dl < -WINDOW) ? -1e30f : S[sub][kb][i]; }
        }
        float mx = S[sub][0][0];
#pragma unroll
        for (int i = 1; i < 16; ++i) mx = fmaxf(mx, S[sub][0][i]);
#pragma unroll
        for (int i = 0; i < 16; ++i) mx = fmaxf(mx, S[sub][1][i]);
        mx = xmax32(mx);
        if (!__all(mx <= THR) || (first && !__all(mx >= -THR_LO))) {
            const float up = first ? mx : fmaxf(mx, 0.f), alpha = first ? 1.0f : __builtin_amdgcn_exp2f(-up); m[sub] += up;
            L[sub][0] *= alpha; L[sub][1] *= __shfl(alpha, (lane & 15) + 16);
#pragma unroll
            for (int kb = 0; kb < 2; ++kb)
#pragma unroll
                for (int i = 0; i < 16; ++i) S[sub][kb][i] -= up;
#pragma unroll
            for (int db = 0; db < 2; ++db)
#pragma unroll
                for (int i = 0; i < 16; ++i) O[sub][db][i] *= alpha;
        }
#pragma unroll
        for (int kb = 0; kb < 2; ++kb)
#pragma unroll
            for (int i = 0; i < 16; ++i) S[sub][kb][i] = __builtin_amdgcn_exp2f(S[sub][kb][i]);
        bf16x8 Pf[4];
#pragma unroll
        for (int kb = 0; kb < 2; ++kb)
#pragma unroll
            for (int s = 0; s < 2; ++s) { u32x4 w; w.x = pk2(S[sub][kb][8 * s + 0], S[sub][kb][8 * s + 1]); w.y = pk2(S[sub][kb][8 * s + 2], S[sub][kb][8 * s + 3]);
                w.z = pk2(S[sub][kb][8 * s + 4], S[sub][kb][8 * s + 5]); w.w = pk2(S[sub][kb][8 * s + 6], S[sub][kb][8 * s + 7]); Pf[2 * kb + s] = __builtin_bit_cast(bf16x8, w); }
        if (sub == 0) {
            asm volatile("s_waitcnt lgkmcnt(0)" : "+v"(Vr[0]), "+v"(Vr[1]), "+v"(Vr[2]), "+v"(Vr[3]), "+v"(Vr[4]), "+v"(Vr[5]), "+v"(Vr[6]), "+v"(Vr[7]) :: "memory");
            asm volatile("" : "+v"(Vr[8]), "+v"(Vr[9]), "+v"(Vr[10]), "+v"(Vr[11]), "+v"(Vr[12]), "+v"(Vr[13]), "+v"(Vr[14]), "+v"(Vr[15]) :: "memory");
        }
        if (sub == NSUB - 1 && has_next) katt_read<DKS, false>(kn_, Kf, lane);
#pragma unroll
        for (int ks = 0; ks < 4; ++ks) {
#pragma unroll
            for (int db = 0; db < 2; ++db) {
                const bf16x8 vf = __builtin_shufflevector(Vr[(ks * 2 + db) * 2], Vr[(ks * 2 + db) * 2 + 1], 0, 1, 2, 3, 4, 5, 6, 7);
                O[sub][db] = MFMA32(vf, Pf[ks], O[sub][db]);
            }
            L[sub] = __builtin_amdgcn_mfma_f32_16x16x32_bf16(onesA, Pf[ks], L[sub], 0, 0, 0);
        }
#pragma unroll
        for (int db = 0; db < 2; ++db) asm volatile("" : "+v"(O[sub][db]));
    }
    if (has_next) katt_wait(Kf);
}
#define ATT_STG_LOAD2(krow0, KR, VR) do { const bf16_t* _p = C.P + (size_t)((krow0) + skey) * PROJ + 8 * schunk; KR = *(const u32x4*)(_p + kcol); VR = *(const u32x4*)(_p + vcol); } while (0)
#define ATT_STG_STORE2(buf, KR, VR) do { LAS unsigned char* _d = C.lds + (buf) * BUF_B + skey * KSTR + schunk * 16; *(LAS u32x4*)_d = KR; *(LAS u32x4*)(_d + TILE_B + skey * (VSTR - KSTR)) = VR; } while (0)
#define ATT_STG_LOAD(krow0) ATT_STG_LOAD2(krow0, kreg, vreg)
#define ATT_STG_STORE(buf) ATT_STG_STORE2(buf, kreg, vreg)
#define ATT_STG_STOREB(off) do { LAS unsigned char* _d = C.lds + (off) + skey * KSTR + schunk * 16; *(LAS u32x4*)_d = kreg; *(LAS u32x4*)(_d + TILE_B + skey * (VSTR - KSTR)) = vreg; } while (0)
#define ATT_PROLOGUE(DKS_) do { { u32x4 kreg2, vreg2; ATT_STG_LOAD(ATT_TROW(0)); ATT_STG_LOAD2(ATT_TROW(1), kreg2, vreg2); ATT_STG_STORE(0); ATT_STG_STORE2(1, kreg2, vreg2); } \
    if (nt > 2) ATT_STG_LOAD(ATT_TROW(2)); __syncthreads(); katt_read<DKS_, true>((unsigned)(size_t)C.lds, Kf, lane); } while (0)

struct AUnit { int b, kvh, qb, jlo, nt, kcol, vcol; bool lat; };
__device__ __forceinline__ AUnit attnA_decode(int u) {
    constexpr int NUL = NB * NKVA * (SEQ / 64);
    AUnit U; U.lat = u < NUL; const int uu = U.lat ? u : u - NUL; const int nqb = U.lat ? SEQ / 64 : CTX / 64;
    U.b = uu / (NKVA * nqb); U.kvh = (uu / nqb) % NKVA; U.qb = uu % nqb;
    U.kcol = C_KA + U.kvh * HDIM; U.vcol = C_VA + U.kvh * HDIM;
    U.jlo = U.lat ? (2 - U.qb > 0 ? 2 - U.qb : 0) : 0; const int jhi = U.lat ? (33 - U.qb < 4 ? 33 - U.qb : 4) : -1;
    U.nt = CTX / 64 + (jhi - U.jlo + 1);
    return U;
}
__device__ __forceinline__ int attnA_trow(const AUnit& U, int i) { return i < CTX / 64 ? RL + U.b * CTX + 64 * i : U.b * SEQ + 64 * U.qb - 128 + 64 * (U.jlo + i - CTX / 64); }
__device__ __forceinline__ void phase_attnA(const Ctx& C, int l, bool need_ctx) {
    const int tid = tid_l(), lane = tid & 63, wave = __builtin_amdgcn_readfirstlane(tid >> 6), skey = tid >> 3, schunk = tid & 7;
    const int r = lane & 31, h = lane >> 5, hq = wave & 3, ph = wave >> 2;
    const bf16x8 onesA = ones_rows(lane);
    constexpr int NUL = NB * NKVA * (SEQ / 64), NUC = NB * NKVA * (CTX / 64);
    const int nu = NUL + (need_ctx ? NUC : 0);
    int u = blockIdx.x;
    if (u >= nu) return;
    AUnit cu = attnA_decode(u);
#define ATT_QROW(U) (((U).lat ? (U).b * SEQ : RL + (U).b * CTX) + 64 * (U).qb + 32 * ph + r)
#define ATT_LOADQ(QQ, U) do { const bf16_t* _q = C.P + (size_t)ATT_QROW(U) * PROJ + C_QA + ((U).kvh * GQA + hq) * HDIM + 8 * h; _Pragma("unroll") for (int s = 0; s < 4; ++s) QQ[0][s] = *(const bf16x8*)(_q + 16 * s); } while (0)
#define ATT_LOADKV(U, i) do { const bf16_t* _p = C.P + (size_t)(attnA_trow(U, i) + skey) * PROJ + 8 * schunk; kreg = *(const u32x4*)(_p + (U).kcol); vreg = *(const u32x4*)(_p + (U).vcol); } while (0)
    bf16x8 Q[1][4], Qn[1][4];
    ATT_LOADQ(Q, cu);
#pragma unroll
    for (int s = 0; s < 4; ++s) Qn[0][s] = Q[0][s];
    u32x4 kreg, vreg; bf16x8 Kf[8];
    { u32x4 kreg2, vreg2; ATT_LOADKV(cu, 0); { const bf16_t* _p = C.P + (size_t)(attnA_trow(cu, 1) + skey) * PROJ + 8 * schunk; kreg2 = *(const u32x4*)(_p + cu.kcol); vreg2 = *(const u32x4*)(_p + cu.vcol); }
      ATT_STG_STORE(0); ATT_STG_STORE2(1, kreg2, vreg2); }
    ATT_LOADKV(cu, 2); __syncthreads(); katt_read<4, true>((unsigned)(size_t)C.lds, Kf, lane);
    int s0 = 0, s1 = BUF_B, s2 = 2 * BUF_B;
    for (;;) {
        const int un = u + (int)gridDim.x; const bool hn = un < nu; const AUnit nx = attnA_decode(hn ? un : u);
        const int head = cu.kvh * GQA + hq, q0 = 64 * cu.qb + 32 * ph, qrow = ATT_QROW(cu), nt = cu.nt;
        f32x16 O[1][2]; float m[1]; f32x4 L[1];
#pragma unroll
        for (int db = 0; db < 2; ++db)
#pragma unroll
            for (int i = 0; i < 16; ++i) O[0][db][i] = 0.f;
        m[0] = 0.f; L[0] = f32x4{0.f, 0.f, 0.f, 0.f};
        for (int i = 0; i < nt; ++i) {
            if (i + 2 < nt || hn) ATT_STG_STOREB(s2);
            if (i + 3 < nt) ATT_LOADKV(cu, i + 3); else if (hn) ATT_LOADKV(nx, i + 3 - nt);
            if (i == nt - 1 && hn) ATT_LOADQ(Qn, nx);
            const bool loc = i >= CTX / 64; const int d = loc ? q0 - (64 * cu.qb - 128 + 64 * (cu.jlo + i - CTX / 64)) : 0;
            const bool masked = loc && (d > 97 || d < -65);
            const unsigned lb = (unsigned)(size_t)C.lds;
            flash_tile<1, 4>(lb + s0 + TILE_B, lb + s1, i + 1 < nt || hn, Q, O, m, L, onesA, Kf, lane, masked, d + r, i == 0);
            __syncthreads();
            { const int t = s0; s0 = s1; s1 = s2; s2 = t; }
        }
        const float inv = 1.0f / (rowsum(L[0], lane) + __builtin_amdgcn_exp2f(C.p.attn_sink[l * NHA + head] * LOG2E - m[0]));
        bf16_t* op = C.MIX + (size_t)qrow * D + head * HDIM;
#pragma unroll
        for (int db = 0; db < 2; ++db)
#pragma unroll
            for (int g = 0; g < 4; g += 2) { u32x2 w[2];
#pragma unroll
                for (int q = 0; q < 2; ++q) { w[q].x = pk2(O[0][db][4 * (g + q)] * inv, O[0][db][4 * (g + q) + 1] * inv); w[q].y = pk2(O[0][db][4 * (g + q) + 2] * inv, O[0][db][4 * (g + q) + 3] * inv); }
                store_pair16(op + 32 * db + 8 * g, w[0], w[1], h); }
        if (!hn) break;
#pragma unroll
        for (int s = 0; s < 4; ++s) Q[0][s] = Qn[0][s];
        cu = nx; u = un;
    }
#undef ATT_QROW
#undef ATT_LOADQ
#undef ATT_LOADKV
}
__device__ __forceinline__ void phase_attnD(const Ctx& C, int l, bool need_ctx) {
    const int tid = tid_l(), lane = tid & 63, wave = __builtin_amdgcn_readfirstlane(tid >> 6), skey = tid >> 3, schunk = tid & 7;
    const int r = lane & 31, h = lane >> 5;
    const bf16x8 onesA = ones_rows(lane);
    const float lam_init = 0.8f - 0.6f * expf(-0.3f * (float)l);
    float lam;
    { const float* lp = C.p.diff_lambda + l * 4 * DD; const float a = lane < DD ? lp[lane] * lp[DD + lane] : 0.f, b2 = lane < DD ? lp[2 * DD + lane] * lp[3 * DD + lane] : 0.f;
      lam = expf(wave_sum(a)) - expf(wave_sum(b2)) + lam_init; }
    constexpr int NUL = NB * NHC * (SEQ / 256), NUC = NB * NHC * (CTX / 256);
    const int nu = NUL + (need_ctx ? NUC : 0);
    for (int u = blockIdx.x; u < nu; u += gridDim.x) {
        const bool lat = u < NUL; const int uu = lat ? u : u - NUL; const int nqb = lat ? SEQ / 256 : CTX / 256;
        const int b = uu / (NHC * nqb), hd = (uu / nqb) % NHC, qb = uu % nqb;
        const int kcol = C_KD + hd * 2 * DD, vcol = C_VD + hd * 2 * DD;
        const int qrow = (lat ? b * SEQ : RL + b * CTX) + 256 * qb + 32 * wave + r;
        const int nt = CTX / 64 + (lat ? SEQ / 64 : 0);
        bf16x8 Q[2][2];
#pragma unroll
        for (int j = 0; j < 2; ++j)
#pragma unroll
            for (int s = 0; s < 2; ++s) Q[j][s] = *(const bf16x8*)(C.P + (size_t)qrow * PROJ + C_QD + hd * 2 * DD + j * DD + 16 * s + 8 * h);
        f32x16 O[2][2]; float m[2]; f32x4 L[2];
#pragma unroll
        for (int j = 0; j < 2; ++j) { m[j] = 0.f; L[j] = f32x4{0.f, 0.f, 0.f, 0.f};
#pragma unroll
            for (int db = 0; db < 2; ++db)
#pragma unroll
                for (int i = 0; i < 16; ++i) O[j][db][i] = 0.f; }
        u32x4 kreg, vreg;
#define ATT_TROW(i) ((i) < CTX / 64 ? RL + b * CTX + 64 * (i) : b * SEQ + 64 * ((i) - CTX / 64))
        bf16x8 Kf[8];
        ATT_PROLOGUE(2);
        int s0 = 0, s1 = BUF_B, s2 = 2 * BUF_B;
#if PROBE_ATT
        unsigned long long pT0 = __builtin_readcyclecounter(), ptw = 0, ptb = 0;
#endif
        for (int i = 0; i < nt; ++i) {
#if PROBE_ATT
            { const unsigned long long t1 = __builtin_readcyclecounter(); asm volatile("s_waitcnt vmcnt(0)" ::: "memory"); ptw += __builtin_readcyclecounter() - t1; }
#endif
            if (i + 2 < nt) ATT_STG_STOREB(s2);
            if (i + 3 < nt) ATT_STG_LOAD(ATT_TROW(i + 3));
            const unsigned lb = (unsigned)(size_t)C.lds;
            flash_tile<2, 2>(lb + s0 + TILE_B, lb + s1, i + 1 < nt, Q, O, m, L, onesA, Kf, lane, false, 0, i == 0);
#if PROBE_ATT
            { const unsigned long long t1 = __builtin_readcyclecounter(); __syncthreads(); ptb += __builtin_readcyclecounter() - t1; }
#else
            __syncthreads();
#endif
            { const int t = s0; s0 = s1; s1 = s2; s2 = t; }
        }
#if PROBE_ATT
        if (l == 1 && u == 100 && tid == 64 * 3) { const float T = (float)(__builtin_readcyclecounter() - pT0);
            ((float*)(C.p.ws + WS_CTL))[8] = PROBE_ATT == 1 ? 1.0e4f * (float)ptw / T : PROBE_ATT == 2 ? 1.0e4f * (float)ptb / T : T / (float)nt; }
#endif
#undef ATT_TROW
        const float i0 = 1.0f / rowsum(L[0], lane), i1 = lam / rowsum(L[1], lane);
        float ss = 0.f;
#pragma unroll
        for (int db = 0; db < 2; ++db)
#pragma unroll
            for (int i = 0; i < 16; ++i) { const float y = O[0][db][i] * i0 - O[1][db][i] * i1; O[0][db][i] = y; ss += y * y; }
        const float rn = (1.0f - lam_init) / sqrtf(xsum32(ss) * (1.0f / (2 * DD)) + EPS);
        const float* sw = C.p.diff_subln + l * 2 * DD + 4 * h;
        bf16_t* op = C.MIX + (size_t)qrow * D + 768 + hd * 2 * DD;
#pragma unroll
        for (int db = 0; db < 2; ++db)
#pragma unroll
            for (int g = 0; g < 4; g += 2) { u32x2 w[2];
#pragma unroll
                for (int q = 0; q < 2; ++q) { const f32x4 s4 = *(const f32x4*)(sw + 32 * db + 8 * (g + q));
                    w[q].x = pk2(O[0][db][4 * (g + q)] * rn * s4[0], O[0][db][4 * (g + q) + 1] * rn * s4[1]); w[q].y = pk2(O[0][db][4 * (g + q) + 2] * rn * s4[2], O[0][db][4 * (g + q) + 3] * rn * s4[3]); }
                store_pair16(op + 32 * db + 8 * g, w[0], w[1], h); }
    }
}
#undef ATT_STG_LOAD
#undef ATT_STG_STORE
#undef ATT_STG_LOAD2
#undef ATT_STG_STORE2
#undef ATT_STG_STOREB
#undef ATT_PROLOGUE
}
__device__ __forceinline__ void phase_conv(const Ctx& C, int l, int nq) {
    const int tid = tid_l();
    const float* cw = C.p.conv_w + l * 3 * CONV_CH;
    for (long g = (long)blockIdx.x * NT + tid; g < (long)(nq / 8) * (CONV_CH / 8); g += (long)gridDim.x * NT) {
        const int row0 = (int)(g / (CONV_CH / 8)) * 8, c8 = (int)(g % (CONV_CH / 8)) * 8;
        const bool lat = row0 < RL; const int t0 = lat ? row0 % SEQ : (row0 - RL) % CTX, len = lat ? SEQ : CTX;
        float u[10][8];
#pragma unroll
        for (int i = 0; i < 10; ++i) { const int tt = t0 + i - 1;
            if (tt >= 0 && tt < len) { const bf16_t* pr = C.P + (size_t)(row0 + i - 1) * PROJ + c8; const u32x4 a = *(const u32x4*)(pr + C_CIN), c = *(const u32x4*)(pr + C_CC);
#pragma unroll
                for (int k = 0; k < 4; ++k) { u[i][2 * k] = __builtin_bit_cast(float, a[k] << 16) * __builtin_bit_cast(float, c[k] << 16); u[i][2 * k + 1] = __builtin_bit_cast(float, a[k] & 0xffff0000u) * __builtin_bit_cast(float, c[k] & 0xffff0000u); } }
            else {
#pragma unroll
                for (int k = 0; k < 8; ++k) u[i][k] = 0.f; } }
        float w[3][8];
#pragma unroll
        for (int j = 0; j < 3; ++j) { const f32x4 w0 = *(const f32x4*)(cw + j * CONV_CH + c8), w1 = *(const f32x4*)(cw + j * CONV_CH + c8 + 4);
#pragma unroll
            for (int k = 0; k < 4; ++k) { w[j][k] = w0[k]; w[j][4 + k] = w1[k]; } }
#pragma unroll
        for (int i = 0; i < 8; ++i) { const u32x4 gb = *(const u32x4*)(C.P + (size_t)(row0 + i) * PROJ + C_CB + c8); u32x4 o;
#pragma unroll
            for (int k = 0; k < 4; ++k) { const float y0 = w[0][2 * k] * u[i][2 * k] + w[1][2 * k] * u[i + 1][2 * k] + w[2][2 * k] * u[i + 2][2 * k];
                const float y1 = w[0][2 * k + 1] * u[i][2 * k + 1] + w[1][2 * k + 1] * u[i + 1][2 * k + 1] + w[2][2 * k + 1] * u[i + 2][2 * k + 1];
                o[k] = att::pk2(__builtin_bit_cast(float, gb[k] << 16) * y0, __builtin_bit_cast(float, gb[k] & 0xffff0000u) * y1); }
            *(u32x4*)(C.MIX + (size_t)(row0 + i) * D + 512 + c8) = o; }
    }
}
#ifndef ATT_A
#define ATT_A 1
#endif
#ifndef ATT_D
#define ATT_D 1
#endif
__device__ __forceinline__ void phase_mix_naive(const Ctx& C, int l, int nq) {
    const int tid = tid_l(), lane = tid & 63, wave = __builtin_amdgcn_readfirstlane(tid >> 6), gw = blockIdx.x * NWV + wave, NGW = gridDim.x * NWV; (void)lane; (void)gw; (void)NGW;
    const long g0 = (long)blockIdx.x * NT + tid, gs = (long)gridDim.x * NT; const float lam_init = 0.8f - 0.6f * expf(-0.3f * (float)l);
#if !ATT_A
    for (long g = g0; g < (long)nq * NHA; g += gs) b_attnA(g, C.P, C.p.attn_sink + l * NHA, C.MIX, nq);
#endif
#if !ATT_D
    for (long g = g0; g < (long)nq * NHC * 2; g += gs) b_attnD(g, C.P, C.TMP, nq);
#endif
    (void)g0; (void)gs;
}
__device__ __forceinline__ void phase_diffpost_naive(const Ctx& C, int l, int nq) {
    const int tid = tid_l(), lane = tid & 63, wave = __builtin_amdgcn_readfirstlane(tid >> 6), gw = blockIdx.x * NWV + wave, NGW = gridDim.x * NWV; (void)lane; (void)gw; (void)NGW;
    const long g0 = (long)blockIdx.x * NT + tid, gs = (long)gridDim.x * NT; const float lam_init = 0.8f - 0.6f * expf(-0.3f * (float)l);
    for (long g = g0; g < (long)nq * NHC; g += gs) b_diffpost(g, C.TMP, C.p.diff_lambda + l * 4 * DD, C.p.diff_subln + l * 2 * DD, lam_init, C.MIX, nq);
}

#ifndef DBL
#define DBL 0
#endif
#define REP(bit) for (int _rep = 0; _rep < (((DBL) & (bit)) ? 2 : 1); ++_rep)
constexpr int CVT_PER_WAVE = 60;
constexpr int NPH = 9, PH_L0 = 2, PH_FINAL = PH_L0 + DEPTH * NPH, PH_TOTAL = PH_FINAL + 1;
__global__ void __launch_bounds__(NT, 2) mega_fwd(Args args) {
    extern __shared__ __attribute__((aligned(16))) unsigned char lds_raw[];
    Ctx C;
    { int w = __builtin_amdgcn_readfirstlane(threadIdx.x >> 6); asm volatile("" : "+s"(w)); C.wv = w; }
    C.p.x = args.in[0]; C.p.c = args.in[1]; C.p.ctx = args.in[2]; C.p.c_ctx = args.in[3]; C.p.w_ada = args.in[4]; C.p.b_ada = args.in[5]; C.p.norm1 = args.in[6]; C.p.norm2 = args.in[7];
    C.p.w_in = args.in[8]; C.p.w_out = args.in[9]; C.p.attn_sink = args.in[10]; C.p.conv_w = args.in[11]; C.p.diff_lambda = args.in[12]; C.p.diff_subln = args.in[13]; C.p.router = args.in[14];
    C.p.w_gate = args.in[15]; C.p.w_up = args.in[16]; C.p.w_down = args.in[17]; C.p.norm_final = args.in[18];
    C.p.out = args.out; C.p.ws = args.ws;
    C.lds = (LAS unsigned char*)lds_raw;
    unsigned char* ws = args.ws;
    C.tab = (float*)(ws + WS_TAB); C.mod = (float*)(ws + WS_MOD); C.aff = (float*)(ws + WS_AFF); C.sel = (int*)(ws + WS_SEL); C.gate = (float*)(ws + WS_GATE); C.tokslot = (int*)(ws + WS_TOKSLOT);
    C.xc = (float*)(ws + WS_XC); C.xl = args.out; C.win = (bf16_t*)(ws + WS_WIN); C.wout = (bf16_t*)(ws + WS_WOUT);
    C.P = (bf16_t*)(ws + WS_R1); C.H = (bf16_t*)(ws + WS_R1); C.Y = (bf16_t*)(ws + WS_R2); C.MIX = (bf16_t*)(ws + WS_R2); C.HX2 = (bf16_t*)(ws + WS_R2 + (size_t)RALL * D * 2); C.TMP = (float*)C.HX2;
    C.HX = (bf16_t*)(ws + WS_R3); C.XB = (bf16_t*)(ws + WS_XB);
    volatile LAS unsigned* misc = (volatile LAS unsigned*)(C.lds + LDS_MISC);
    { const int t0 = tid_l(); if (t0 < 64) misc[t0] = 0u; }
    __syncthreads();
    const int lo = args.ph_lo, hi = args.ph_hi;
    XcdBarrier bar; bar.bar = (unsigned*)(ws + WS_CTL) + CW_BAR; bar.x = 0; bar.st = misc; bar.wv = C.wv;
    if (hi - lo > 1) bar = xcd_barrier_post((unsigned*)(ws + WS_CTL) + CW_BAR, misc, C.wv);
#define IN(k) (lo <= (k) && (k) < hi)
#define SEAM(k) do { if (IN(k) && IN((k) + 1)) xcd_barrier(bar); } while (0)
    const int G = (int)gridDim.x, bid = (int)blockIdx.x;
    if (IN(0)) REP(512) phase_prologue(C);
    SEAM(0);
    if (IN(1)) phase_prologue_b(C);
    SEAM(1);
    for (int l = 0; l < DEPTH; ++l) {
        const int pb = PH_L0 + l * NPH; const bool need_ctx = l < DEPTH - 1; const int nq = need_ctx ? RALL : RL;
        const float* modl = C.mod + (size_t)l * (NB + 1) * 6 * D;
        const int nu1 = (RALL / 256) * (PROJ / 256), G1 = (nu1 + (nu1 + G - 1) / G - 1) / ((nu1 + G - 1) / G);
        const int nu4 = (nq / 256) * (D / 256), G4 = (nu4 + (nu4 + G - 1) / G - 1) / ((nu4 + G - 1) / G);
        const int cn1 = (G - G1) * NWV * CVT_PER_WAVE < CVT_ITEMS ? (G - G1) * NWV * CVT_PER_WAVE : CVT_ITEMS;
        const int cn4 = cn1 + (G - G4) * NWV * CVT_PER_WAVE < CVT_ITEMS ? cn1 + (G - G4) * NWV * CVT_PER_WAVE : CVT_ITEMS;
        if (IN(pb + 0)) { { const int wv_ = C.wv; REP(256) phase_cvt_experts(C, l, cn4, CVT_ITEMS, bid * NWV + wv_, G * NWV); } if (l == 0) phase_rowA<false, true>(C, 0); else phase_rowA<false, false>(C, l); if ((DBL) & 1024) { if (l == 0) phase_rowA<false, true>(C, 0); else phase_rowA<false, false>(C, l, 0.0f); } }
        SEAM(pb + 0);
        if (IN(pb + 1)) { if (bid < G1) { pg::GemmD g{(const char*)C.HX, nullptr, (const char*)C.win + (size_t)l * PROJ * D, 0, D / 2}; pg::Order S; S.init(RALL / 256, PROJ / 256, G1, bid, 0);
            pg::EpiP E{C.P, C.tab, (const float*)(ws + WS_HXS), (const float*)(ws + WS_CTL + CTL_WINMAX) + l * 256}; REP(1) pg::gemm_phase<pg::EpiP, false, 2>(C.lds, g, S, E, C.wv); }
            else phase_cvt_experts(C, l, 0, cn1, (bid - G1) * NWV + C.wv, (G - G1) * NWV); }
        SEAM(pb + 1);
        if (IN(pb + 2)) {
#if ATT_A
            REP(2) att::phase_attnA(C, l, need_ctx);
#endif
#if ATT_D
            REP(4) att::phase_attnD(C, l, need_ctx);
#endif
            phase_mix_naive(C, l, nq); REP(128) phase_conv(C, l, nq); }
        SEAM(pb + 2);
#if !ATT_D
        if (IN(pb + 3)) phase_diffpost_naive(C, l, nq);
        SEAM(pb + 3);
#endif
        if (IN(pb + 4)) { if (bid < G4) { pg::GemmD g{(const char*)C.MIX, nullptr, (const char*)(C.wout + (size_t)l * D * D), 0, D}; pg::Order S; S.init(nq / 256, D / 256, G4, bid, 0);
            pg::EpiX E{C.XB, modl, 1.0f}; pg::gemm_phase<pg::EpiX, false>(C.lds, g, S, E, C.wv);
            if ((DBL) & 2048) { pg::EpiX E0{C.XB, modl, 0.0f}; pg::gemm_phase<pg::EpiX, false>(C.lds, g, S, E0, C.wv); } }
            else phase_cvt_experts(C, l, cn1, cn4, (bid - G4) * NWV + C.wv, (G - G4) * NWV); }
        SEAM(pb + 4);
        if (IN(pb + 5)) REP(8) phase_rowB(C, l, nq);
        SEAM(pb + 5);
        if (IN(pb + 6)) REP(16) phase_select(C, need_ctx);
        SEAM(pb + 6);
        const int tpe = need_ctx ? pg::TPE_FULL : SLOTS_L / 256;
        if (IN(pb + 7)) { pg::GemmD g{(const char*)C.HX2, C.sel, (const char*)(ws + WS_WGU + (size_t)(l & 1) * NE * 2 * FF * D), (size_t)2 * FF * D, D / 2}; pg::Order S; S.init(NE * tpe, 2 * FF / 256, G, bid, tpe);
            pg::EpiH E{(unsigned char*)C.H}; REP(32) pg::gemm_phase<pg::EpiH, true, 1>(C.lds, g, S, E, C.wv); }
        SEAM(pb + 7);
        if (IN(pb + 8)) { pg::GemmD g{(const char*)C.H, nullptr, (const char*)(ws + WS_WD + (size_t)(l & 1) * NE * D * FF), (size_t)D * FF, FF / 2}; pg::Order S; S.init(NE * tpe, D / 256, G, bid, tpe);
            pg::EpiY E{(unsigned char*)C.Y, C.gate}; REP(64) pg::gemm_phase<pg::EpiY, false, 1>(C.lds, g, S, E, C.wv); }
        SEAM(pb + 8);
    }
    if (IN(PH_FINAL)) phase_rowA<true, false>(C, DEPTH);
#if PROBE_ATT
    if (hi - lo > 1) xcd_barrier(bar);
    if (bid == 100 && tid_l() == 0) { asm volatile("s_waitcnt vmcnt(0)" ::: "memory"); C.p.out[0] = ((const float*)(C.p.ws + WS_CTL))[8]; }
#endif
#undef IN
#undef SEAM
}
#endif

#ifndef HOST_TEST
#ifndef MODE
#define MODE 2
#endif
extern "C" void kernel_launch(void* const* d_in, const int* in_sizes, int n_in, void* d_out, int out_size, void* d_ws, size_t ws_size, hipStream_t stream) {
    if (n_in != 19 || out_size != RL * D || ws_size < WS_END) { fprintf(stderr, "kernel_launch: unexpected shapes (n_in %d out %d ws %zu need %zu)\n", n_in, out_size, ws_size, (size_t)WS_END); return; }
#if MODE == 0
    Ptrs p{};
    const float** f = (const float**)&p;
    for (int i = 0; i < 19; ++i) f[i] = (const float*)d_in[i];
    p.out = (float*)d_out; p.ws = (unsigned char*)d_ws;
    forward(p, stream);
#else
    static int grid = 0;
    if (grid == 0) {
        int dev = 0, cus = 0;
        if (hipGetDevice(&dev) != hipSuccess || hipDeviceGetAttribute(&cus, hipDeviceAttributeMultiprocessorCount, dev) != hipSuccess) { fprintf(stderr, "kernel_launch: device query failed\n"); grid = -1; return; }
        if (hipFuncSetAttribute((const void*)mega_fwd, hipFuncAttributeMaxDynamicSharedMemorySize, LDS_BYTES) != hipSuccess) { fprintf(stderr, "kernel_launch: hipFuncSetAttribute failed\n"); grid = -1; return; }
        int per_cu = 0;
        if (hipOccupancyMaxActiveBlocksPerMultiprocessor(&per_cu, (const void*)mega_fwd, NT, LDS_BYTES) != hipSuccess || per_cu < 1) fprintf(stderr, "kernel_launch: occupancy query reports %d blocks per CU\n", per_cu);
        (void)hipGetLastError();
        grid = cus;
    }
    if (grid < 0) return;
    if (hipMemsetAsync((char*)d_ws + WS_CTL, 0, CTL_BYTES, stream) != hipSuccess) { fprintf(stderr, "kernel_launch: memset failed\n"); return; }
    Args a{};
    for (int i = 0; i < 19; ++i) a.in[i] = (const float*)d_in[i];
    a.out = (float*)d_out; a.ws = (unsigned char*)d_ws;
#if MODE == 2
    a.ph_lo = 0; a.ph_hi = PH_TOTAL;
    hipLaunchKernelGGL(mega_fwd, dim3(grid), dim3(NT), LDS_BYTES, stream, a);
#else
    for (int ph = 0; ph < PH_TOTAL; ++ph) { a.ph_lo = ph; a.ph_hi = ph + 1; hipLaunchKernelGGL(mega_fwd, dim3(grid), dim3(NT), LDS_BYTES, stream, a); }
#endif
    const hipError_t le = hipPeekAtLastError();
    if (le != hipSuccess) fprintf(stderr, "kernel_launch: launch failed: %s\n", hipGetErrorName(le));
#endif
}
#else
#include <vector>
#include <string>
static std::vector<float> rd(const std::string& fn) { FILE* f = fopen(fn.c_str(), "rb"); if (!f) { perror(fn.c_str()); exit(1); } fseek(f, 0, SEEK_END); long n = ftell(f); fseek(f, 0, SEEK_SET); std::vector<float> v(n / 4); if (fread(v.data(), 1, n, f) != (size_t)n) exit(1); fclose(f); return v; }
int main(int argc, char** argv) {
    std::string dir = argv[1]; std::vector<std::vector<float>> in(19);
    for (int i = 0; i < 19; ++i) in[i] = rd(dir + "/in" + std::to_string(i) + ".bin");
    std::vector<float> out((size_t)RL * D); std::vector<unsigned char> ws(WS_END, 0xAA);
    Ptrs p{}; const float** f = (const float**)&p; for (int i = 0; i < 19; ++i) f[i] = in[i].data();
    p.out = out.data(); p.ws = ws.data();
    forward(p, 0);
    FILE* fo = fopen((dir + "/out.bin").c_str(), "wb"); fwrite(out.data(), 4, out.size(), fo); fclose(fo);
    printf("done, ws bytes %zu\n", (size_t)WS_END); return 0;
}
#endif
```

```cpp
#ifndef HOST_TEST
#include <hip/hip_runtime.h>
#endif
#include <cstdio>
#include <cstdint>
#include <cstring>
#include <cmath>

#ifndef CFG_B
#define CFG_B 32
#endif
#ifndef CFG_SEQ
#define CFG_SEQ 2048
#endif
#ifndef CFG_CTX
#define CFG_CTX 256
#endif
#ifndef CFG_DEPTH
#define CFG_DEPTH 4
#endif
constexpr int D = 1024, NB = CFG_B, SEQ = CFG_SEQ, CTX = CFG_CTX, DEPTH = CFG_DEPTH;
constexpr int GRID_W = 64, NROWS = SEQ / GRID_W, HDIM = 64, NHA = 8, NKVA = 2, GQA = 4, WINDOW = 128;
constexpr int CONV_CH = 256, DD = 32, NHC = 4, NE = 16, FF = 1024, PROJ = 2304;
constexpr int RL = NB * SEQ, RC = NB * CTX, RALL = RL + RC;
constexpr int CAPL = 2 * SEQ / NE, CAPC = 2 * CTX / NE;
constexpr int SLOTS_L = NB * CAPL, SLOTS_C = NB * CAPC, SLOTS_E = SLOTS_L + SLOTS_C;
constexpr int NSLOT = NE * SLOTS_E;
constexpr int C_QA = 0, C_KA = 512, C_VA = 640, C_CIN = 768, C_CB = 1024, C_CC = 1280, C_QD = 1536, C_KD = 1792, C_VD = 2048;
constexpr int M_SH1 = 0, M_SC1 = D, M_G1 = 2 * D, M_SH2 = 3 * D, M_SC2 = 4 * D, M_G2 = 5 * D;
constexpr float EPS = 1e-6f, LOG2E = 1.4426950408889634f;
constexpr float QSCALE_A = 0.125f * LOG2E, QSCALE_D = 0.17677669529663687f * LOG2E;

#ifdef HOST_TEST
#define HD
#define KERNEL static void
static thread_local long g_gid;
#define GID g_gid
#include <omp.h>
#define LAUNCH(kern, nthreads, ...) do { const long _n = (long)(nthreads); _Pragma("omp parallel for schedule(static)") for (long _g = 0; _g < _n; ++_g) { g_gid = _g; kern(__VA_ARGS__); } } while (0)
#else
#define HD __host__ __device__ __forceinline__
#define KERNEL __global__ void __launch_bounds__(256)
#define GID ((long)blockIdx.x * blockDim.x + threadIdx.x)
#define LAUNCH(kern, nthreads, ...) do { const long _n = (long)(nthreads); if (_n > 0) hipLaunchKernelGGL(kern, dim3((unsigned)((_n + 255) / 256)), dim3(256), 0, stream, __VA_ARGS__); } while (0)
#endif

typedef unsigned short bf16_t;
HD float bf2f(bf16_t v) { unsigned u = (unsigned)v << 16; return __builtin_bit_cast(float, u); }
HD bf16_t f2bf(float f) { unsigned u = __builtin_bit_cast(unsigned, f); return (bf16_t)((u + 0x7fffu + ((u >> 16) & 1u)) >> 16); }

constexpr size_t al256(size_t x) { return (x + 255) & ~(size_t)255; }
constexpr size_t WS_CTL = 0, CTL_BYTES = 1u << 20;
constexpr size_t WS_TAB = WS_CTL + CTL_BYTES;
constexpr int T_AROW = 0, T_ACOL = T_AROW + NROWS * 16 * 2, T_DROW = T_ACOL + 64 * 16 * 2, T_DCOL = T_DROW + NROWS * 8 * 2, T_END = T_DCOL + 64 * 8 * 2;
constexpr size_t WS_SILU = WS_TAB + al256((size_t)T_END * 4);
constexpr size_t WS_MOD = WS_SILU + al256((size_t)(NB + 1) * D * 4);
constexpr size_t WS_RSTD = WS_MOD + al256((size_t)DEPTH * (NB + 1) * 6 * D * 4);
constexpr size_t WS_AFF = WS_RSTD + al256((size_t)RALL * 4);
constexpr size_t WS_SEL = WS_AFF + al256((size_t)RALL * NE * 4);
constexpr size_t WS_GATE = WS_SEL + al256((size_t)NSLOT * 4);
constexpr size_t WS_TOKSLOT = WS_GATE + al256((size_t)NSLOT * 4);
constexpr size_t WS_XC = WS_TOKSLOT + al256((size_t)RALL * NE * 4);
constexpr size_t WS_WIN = WS_XC + al256((size_t)RC * D * 4);
constexpr size_t WS_WOUT = WS_WIN + al256((size_t)DEPTH * PROJ * D * 2);
constexpr size_t WS_WGU = WS_WOUT + al256((size_t)DEPTH * D * D * 2);
constexpr size_t WS_WD = WS_WGU + al256((size_t)2 * NE * 2 * FF * D * 2);
constexpr size_t WS_R1 = WS_WD + al256((size_t)2 * NE * D * FF * 2);
constexpr size_t R1_BYTES = al256(((size_t)RALL * PROJ * 2 > (size_t)NSLOT * FF * 2) ? (size_t)RALL * PROJ * 2 : (size_t)NSLOT * FF * 2);
constexpr size_t WS_R2 = WS_R1 + R1_BYTES;
constexpr size_t R2_BYTES = al256(((size_t)NSLOT * D * 2 > (size_t)2 * RALL * D * 2) ? (size_t)NSLOT * D * 2 : (size_t)2 * RALL * D * 2);
constexpr size_t WS_R3 = WS_R2 + R2_BYTES;
constexpr size_t WS_XB = WS_R3 + al256((size_t)RALL * D * 2);
constexpr size_t WS_HXS = WS_XB + al256((size_t)RALL * D * 2);
constexpr size_t WS_END = WS_HXS + al256((size_t)RALL * 4);
constexpr size_t CTL_WINMAX = 262144;

struct Ptrs {
    const float *x, *c, *ctx, *c_ctx, *w_ada, *b_ada, *norm1, *norm2, *w_in, *w_out, *attn_sink, *conv_w, *diff_lambda, *diff_subln, *router, *w_gate, *w_up, *w_down, *norm_final;
    float* out; unsigned char* ws;
};

HD float* xrow_ptr(float* xl, float* xc, int row) { return row < RL ? xl + (size_t)row * D : xc + (size_t)(row - RL) * D; }
HD int row_batch(int row) { return row < RL ? row / SEQ : NB; }
HD float silu_f(float v) { return v / (1.0f + expf(-v)); }

KERNEL k_tables(float* tab) {
    const long g = GID; if (g >= (long)(NROWS + 64) * 24) return;
    const int pos = (int)(g / 24), f = (int)(g % 24);
    const double inv = f < 16 ? pow(10000.0, -(2.0 * f) / 32.0) : pow(10000.0, -(2.0 * (f - 16)) / 16.0);
    const bool isrow = pos < NROWS; const int p = isrow ? pos : pos - NROWS;
    const double ang = (double)p * inv; const float cs = (float)cos(ang), sn = (float)sin(ang);
    int idx;
    if (f < 16) idx = (isrow ? T_AROW : T_ACOL) + (p * 16 + f) * 2; else idx = (isrow ? T_DROW : T_DCOL) + (p * 8 + (f - 16)) * 2;
    tab[idx] = cs; tab[idx + 1] = sn;
}
KERNEL k_silu(const float* c, const float* c_ctx, float* out) {
    const long g = GID; if (g >= (long)(NB + 1) * D) return;
    const int b = (int)(g / D), k = (int)(g % D); const float v = b < NB ? c[b * D + k] : c_ctx[k];
    out[g] = silu_f(v);
}
KERNEL k_mod(const float* silu, const float* w_ada, const float* b_ada, float* mod) {
    const long g = GID; if (g >= (long)DEPTH * 6 * D) return;
    const int l = (int)(g / (6 * D)), j = (int)(g % (6 * D));
    float acc[NB + 1];
#pragma unroll
    for (int b = 0; b <= NB; ++b) acc[b] = 0.f;
    const float* w = w_ada + (size_t)l * D * 6 * D + j;
    for (int k = 0; k < D; ++k) { const float wv = w[(size_t)k * 6 * D];
#pragma unroll
        for (int b = 0; b <= NB; ++b) acc[b] += silu[b * D + k] * wv; }
    const float bias = b_ada[l * 6 * D + j];
#pragma unroll
    for (int b = 0; b <= NB; ++b) mod[((size_t)l * (NB + 1) + b) * 6 * D + j] = acc[b] + bias;
}
HD int permA(int p) { return (p / 32) * 32 + (p % 32) / 2 + 16 * (p % 2); }
HD int permD(int p) { return (p / 16) * 16 + (p % 16) / 2 + 8 * (p % 2); }
HD int inproj_src_col(int n) {
    if (n < C_VA) return (n / 64) * 64 + permA(n % 64);
    if (n < C_QD) return n;
    if (n < C_VD) return (n / 32) * 32 + permD(n % 32);
    return n;
}
KERNEL k_cvt_win(const float* w_in, bf16_t* wt) {
    const long g = GID; if (g >= (long)DEPTH * PROJ * D) return;
    const int k = (int)(g % D); const int n = (int)((g / D) % PROJ); const int l = (int)(g / ((long)D * PROJ));
    wt[g] = f2bf(w_in[((size_t)l * D + k) * PROJ + inproj_src_col(n)]);
}
KERNEL k_cvt_t(const float* w, bf16_t* wt, int nmat, int K, int N) {
    const long g = GID; if (g >= (long)nmat * K * N) return;
    const int k = (int)(g % K); const int n = (int)((g / K) % N); const int m = (int)(g / ((long)K * N));
    wt[g] = f2bf(w[((size_t)m * K + k) * N + n]);
}
KERNEL k_cvt_gu(const float* wg, const float* wu, bf16_t* wt) {
    const long g = GID; if (g >= (long)NE * 2 * FF * D) return;
    const int k = (int)(g % D); const int n = (int)((g / D) % (2 * FF)); const int e = (int)(g / ((long)D * 2 * FF));
    const int blk = n / 256, bj = (n % 256) / 128, j = n % 128; const float* src = bj ? wu : wg;
    wt[g] = f2bf(src[((size_t)e * D + k) * FF + blk * 128 + j]);
}
KERNEL k_rowstat(const float* xl, const float* xc, float* rstd, int nrows) {
    const long g = GID; if (g >= nrows) return;
    const float* xr = xrow_ptr((float*)xl, (float*)xc, (int)g); float s = 0.f;
    for (int k = 0; k < D; ++k) s += xr[k] * xr[k];
    rstd[g] = 1.0f / sqrtf(s / D + EPS);
}
KERNEL k_rowapply(const float* xl, const float* xc, const float* rstd, const float* nw, const float* modl, int sh_off, int sc_off, bf16_t* hx, int nrows) {
    const long g = GID; if (g >= (long)nrows * D) return;
    const int row = (int)(g / D), k = (int)(g % D); const float* xr = xrow_ptr((float*)xl, (float*)xc, row);
    const float* m = modl + (size_t)row_batch(row) * 6 * D;
    const float v = xr[k] * rstd[row] * nw[k] * (1.0f + m[sc_off + k]) + m[sh_off + k];
    hx[g] = f2bf(v);
}
struct EpiInProj {
    bf16_t* P; const float* tab;
    HD void operator()(int row, int c0, const float* v, const float*) const {
        float o[4] = {v[0], v[1], v[2], v[3]};
        const bool lat = row < RL; const int pos = lat ? row % SEQ : 0; const int gr = pos / GRID_W, gc = pos % GRID_W;
        if (c0 < C_VA) {
            if (lat) { const int p = c0 % 64, grp = p / 32, i0 = (p % 32) / 2;
                const float* t = tab + (grp == 0 ? T_AROW + gr * 32 : T_ACOL + gc * 32) + i0 * 2;
                const float a0 = o[0], b0 = o[1], a1 = o[2], b1 = o[3];
                o[0] = a0 * t[0] - b0 * t[1]; o[1] = b0 * t[0] + a0 * t[1]; o[2] = a1 * t[2] - b1 * t[3]; o[3] = b1 * t[2] + a1 * t[3]; }
            if (c0 < C_KA) { for (int j = 0; j < 4; ++j) o[j] *= QSCALE_A; }
        } else if (c0 >= C_QD && c0 < C_VD) {
            if (lat) { const int p = c0 % 32, grp = p / 16, i0 = (p % 16) / 2;
                const float* t = tab + (grp == 0 ? T_DROW + gr * 16 : T_DCOL + gc * 16) + i0 * 2;
                const float a0 = o[0], b0 = o[1], a1 = o[2], b1 = o[3];
                o[0] = a0 * t[0] - b0 * t[1]; o[1] = b0 * t[0] + a0 * t[1]; o[2] = a1 * t[2] - b1 * t[3]; o[3] = b1 * t[2] + a1 * t[3]; }
            if (c0 < C_KD) { for (int j = 0; j < 4; ++j) o[j] *= QSCALE_D; }
        }
        bf16_t* d = P + (size_t)row * PROJ + c0;
        for (int j = 0; j < 4; ++j) d[j] = f2bf(o[j]);
    }
};
struct EpiOutProj {
    float* xl; float* xc; const float* modl;
    HD void operator()(int row, int c0, const float* v, const float*) const {
        float* xr = xrow_ptr(xl, xc, row) + c0; const float* g1 = modl + (size_t)row_batch(row) * 6 * D + M_G1 + c0;
        for (int j = 0; j < 4; ++j) xr[j] += g1[j] * v[j];
    }
};
struct EpiGateUp {
    bf16_t* H;
    HD void operator()(int row, int c0, const float* v, const float* u) const {
        bf16_t* d = H + (size_t)row * FF + c0;
        for (int j = 0; j < 4; ++j) d[j] = f2bf(silu_f(v[j]) * u[j]);
    }
};
struct EpiDown {
    bf16_t* Y; const float* gate;
    HD void operator()(int row, int c0, const float* v, const float*) const {
        const float g = gate[row]; bf16_t* d = Y + (size_t)row * D + c0;
        for (int j = 0; j < 4; ++j) d[j] = f2bf(v[j] * g);
    }
};
template <class Epi, bool DUAL>
KERNEL k_gemm_naive(const bf16_t* A, const int* rowidx, const bf16_t* Bt, int M, int N, int K, int group_rows, int valid_rows, long bstride, Epi epi) {
    const long g = GID; if (g >= (long)M * (N / 4)) return;
    const int row = (int)(g / (N / 4)), c0 = (int)(g % (N / 4)) * 4;
    if (row % group_rows >= valid_rows) return;
    const int arow = rowidx ? rowidx[row] : row;
    const bf16_t* a = A + (size_t)arow * K; const bf16_t* B = Bt + (size_t)(row / group_rows) * bstride;
    float v[4], u[4];
    for (int j = 0; j < 4; ++j) { const int c = c0 + j; const int br = DUAL ? (c / 128) * 256 + c % 128 : c;
        const bf16_t* b0 = B + (size_t)br * K; float s = 0.f, s2 = 0.f;
        for (int k = 0; k < K; ++k) s += bf2f(a[k]) * bf2f(b0[k]);
        if (DUAL) { const bf16_t* b1 = b0 + (size_t)128 * K; for (int k = 0; k < K; ++k) s2 += bf2f(a[k]) * bf2f(b1[k]); }
        v[j] = s; u[j] = s2; }
    epi(row, c0, v, u);
}
HD void b_attnA(const long g, const bf16_t* P, const float* sink, bf16_t* MIX, int nrows) {
    if (g >= (long)nrows * NHA) return;
    const int h = (int)(g / nrows), row = (int)(g % nrows), kvh = h / GQA;
    const bool lat = row < RL; const int b = lat ? row / SEQ : (row - RL) / CTX; const int t = lat ? row % SEQ : 0;
    float q[HDIM], o[HDIM];
    const bf16_t* qp = P + (size_t)row * PROJ + C_QA + h * HDIM;
#pragma unroll
    for (int d = 0; d < HDIM; ++d) { q[d] = bf2f(qp[d]); o[d] = 0.f; }
    float m = sink[h] * LOG2E, l = 1.0f;
    const int nctx = CTX, lo = lat ? (t - WINDOW < 0 ? 0 : t - WINDOW) : 0, hi = lat ? (t + WINDOW > SEQ - 1 ? SEQ - 1 : t + WINDOW) : -1;
    const int nkeys = nctx + (hi - lo + 1);
    for (int i = 0; i < nkeys; ++i) {
        const int krow = i < nctx ? RL + b * CTX + i : b * SEQ + lo + (i - nctx);
        const bf16_t* kp = P + (size_t)krow * PROJ + C_KA + kvh * HDIM; const bf16_t* vp = P + (size_t)krow * PROJ + C_VA + kvh * HDIM;
        float s = 0.f;
#pragma unroll
        for (int d = 0; d < HDIM; ++d) s += q[d] * bf2f(kp[d]);
        if (s > m) { const float sc = exp2f(m - s); l *= sc;
#pragma unroll
            for (int d = 0; d < HDIM; ++d) o[d] *= sc;
            m = s; }
        const float p = exp2f(s - m); l += p;
#pragma unroll
        for (int d = 0; d < HDIM; ++d) o[d] += p * bf2f(vp[d]);
    }
    const float inv = 1.0f / l; bf16_t* op = MIX + (size_t)row * D + h * HDIM;
#pragma unroll
    for (int d = 0; d < HDIM; ++d) op[d] = f2bf(o[d] * inv);
}
KERNEL k_attnA(const bf16_t* P, const float* sink, bf16_t* MIX, int nrows) { b_attnA(GID, P, sink, MIX, nrows); }
HD void b_attnD(const long g, const bf16_t* P, float* TMP, int nrows) {
    if (g >= (long)nrows * NHC * 2) return;
    const int hc = (int)(g / nrows), row = (int)(g % nrows), h = hc / 2, comp = hc % 2;
    const bool lat = row < RL; const int b = lat ? row / SEQ : (row - RL) / CTX;
    float q[DD], o[2 * DD];
    const bf16_t* qp = P + (size_t)row * PROJ + C_QD + h * 2 * DD + comp * DD;
#pragma unroll
    for (int d = 0; d < DD; ++d) q[d] = bf2f(qp[d]);
#pragma unroll
    for (int d = 0; d < 2 * DD; ++d) o[d] = 0.f;
    float m = -1e30f, l = 0.f;
    const int nkeys = CTX + (lat ? SEQ : 0);
    for (int i = 0; i < nkeys; ++i) {
        const int krow = i < CTX ? RL + b * CTX + i : b * SEQ + (i - CTX);
        const bf16_t* kp = P + (size_t)krow * PROJ + C_KD + h * 2 * DD + comp * DD; const bf16_t* vp = P + (size_t)krow * PROJ + C_VD + h * 2 * DD;
        float s = 0.f;
#pragma unroll
        for (int d = 0; d < DD; ++d) s += q[d] * bf2f(kp[d]);
        if (s > m) { const float sc = exp2f(m - s); l *= sc;
#pragma unroll
            for (int d = 0; d < 2 * DD; ++d) o[d] *= sc;
            m = s; }
        const float p = exp2f(s - m); l += p;
#pragma unroll
        for (int d = 0; d < 2 * DD; ++d) o[d] += p * bf2f(vp[d]);
    }
    const float inv = 1.0f / l; float* op = TMP + (((size_t)row * NHC + h) * 2 + comp) * 2 * DD;
#pragma unroll
    for (int d = 0; d < 2 * DD; ++d) op[d] = o[d] * inv;
}
KERNEL k_attnD(const bf16_t* P, float* TMP, int nrows) { b_attnD(GID, P, TMP, nrows); }
HD void b_diffpost(const long g, const float* TMP, const float* lam_p, const float* subln, float lam_init, bf16_t* MIX, int nrows) {
    if (g >= (long)nrows * NHC) return;
    const int row = (int)(g / NHC), h = (int)(g % NHC);
    float s01 = 0.f, s23 = 0.f;
    for (int d = 0; d < DD; ++d) { s01 += lam_p[d] * lam_p[DD + d]; s23 += lam_p[2 * DD + d] * lam_p[3 * DD + d]; }
    const float lam = expf(s01) - expf(s23) + lam_init;
    const float* t = TMP + ((size_t)row * NHC + h) * 2 * 2 * DD; float y[2 * DD]; float ss = 0.f;
#pragma unroll
    for (int d = 0; d < 2 * DD; ++d) { y[d] = t[d] - lam * t[2 * DD + d]; ss += y[d] * y[d]; }
    const float r = 1.0f / sqrtf(ss / (2 * DD) + EPS) * (1.0f - lam_init);
    bf16_t* op = MIX + (size_t)row * D + 768 + h * 2 * DD;
#pragma unroll
    for (int d = 0; d < 2 * DD; ++d) op[d] = f2bf(y[d] * r * subln[d]);
}
KERNEL k_diffpost(const float* TMP, const float* lam_p, const float* subln, float lam_init, bf16_t* MIX, int nrows) { b_diffpost(GID, TMP, lam_p, subln, lam_init, MIX, nrows); }
HD void b_conv(const long g, const bf16_t* P, const float* cw, bf16_t* MIX, int nrows) {
    if (g >= (long)nrows * CONV_CH) return;
    const int row = (int)(g / CONV_CH), ch = (int)(g % CONV_CH);
    const bool lat = row < RL; const int t = lat ? row % SEQ : (row - RL) % CTX, len = lat ? SEQ : CTX;
    float y = 0.f;
    for (int j = 0; j < 3; ++j) { const int tt = t + j - 1; if (tt < 0 || tt >= len) continue;
        const bf16_t* pr = P + (size_t)(row + j - 1) * PROJ; y += cw[j * CONV_CH + ch] * (bf2f(pr[C_CC + ch]) * bf2f(pr[C_CIN + ch])); }
    MIX[(size_t)row * D + 512 + ch] = f2bf(bf2f(P[(size_t)row * PROJ + C_CB + ch]) * y);
}
KERNEL k_conv(const bf16_t* P, const float* cw, bf16_t* MIX, int nrows) { b_conv(GID, P, cw, MIX, nrows); }
KERNEL k_router(const float* xl, const float* xc, const float* rstd, const float* nw, const float* modl, const float* router, float* logits, int nrows) {
    const long g = GID; if (g >= (long)nrows * NE) return;
    const int row = (int)(g / NE), e = (int)(g % NE); const float* xr = xrow_ptr((float*)xl, (float*)xc, row);
    const float* m = modl + (size_t)row_batch(row) * 6 * D; const float rs = rstd[row]; float s = 0.f;
    for (int k = 0; k < D; ++k) { const float v = xr[k] * rs * nw[k] * (1.0f + m[M_SC2 + k]) + m[M_SH2 + k]; s += v * router[k * NE + e]; }
    logits[g] = s;
}
KERNEL k_aff(float* aff, int nrows) {
    const long g = GID; if (g >= nrows) return;
    float* a = aff + (size_t)g * NE; float m = a[0];
    for (int e = 1; e < NE; ++e) m = a[e] > m ? a[e] : m;
    float s = 0.f; float ex[NE];
#pragma unroll
    for (int e = 0; e < NE; ++e) { ex[e] = expf(a[e] - m); s += ex[e]; }
#pragma unroll
    for (int e = 0; e < NE; ++e) a[e] = ex[e] / s;
}
KERNEL k_select(const float* aff, int* sel, float* gate, int* tokslot, int nrows) {
    const long g = GID; if (g >= (long)nrows * NE) return;
    const int row = (int)(g / NE), e = (int)(g % NE);
    const bool lat = row < RL; const int b = lat ? row / SEQ : (row - RL) / CTX; const int t = lat ? row % SEQ : (row - RL) % CTX;
    const int n = lat ? SEQ : CTX, cap = lat ? CAPL : CAPC, base = lat ? b * SEQ : RL + b * CTX;
    const float a = aff[(size_t)row * NE + e]; int rank = 0;
    for (int j = 0; j < n; ++j) { const float o = aff[(size_t)(base + j) * NE + e]; rank += (o > a || (o == a && j < t)) ? 1 : 0; }
    int slot = -1;
    if (rank < cap) { slot = e * SLOTS_E + (lat ? b * CAPL + rank : SLOTS_L + b * CAPC + rank); sel[slot] = row; gate[slot] = a; }
    tokslot[g] = slot;
}
KERNEL k_combine(float* xl, float* xc, const bf16_t* Y, const int* tokslot, const float* modl, int nrows) {
    const long g = GID; if (g >= (long)nrows * D) return;
    const int row = (int)(g / D), k = (int)(g % D); float s = 0.f;
    for (int e = 0; e < NE; ++e) { const int sl = tokslot[(size_t)row * NE + e]; if (sl >= 0) s += bf2f(Y[(size_t)sl * D + k]); }
    float* xr = xrow_ptr(xl, xc, row); xr[k] += modl[(size_t)row_batch(row) * 6 * D + M_G2 + k] * s;
}
KERNEL k_final(float* xl, const float* rstd, const float* nw) {
    const long g = GID; if (g >= (long)RL * D) return;
    const int row = (int)(g / D), k = (int)(g % D); xl[g] = xl[g] * rstd[row] * nw[k];
}

#ifndef HOST_TEST
typedef short bf16x8 __attribute__((ext_vector_type(8)));
typedef float f32x4 __attribute__((ext_vector_type(4)));
template <class Epi, bool DUAL>
__global__ void __launch_bounds__(256) k_gemm_mfma(const bf16_t* __restrict__ A, const int* __restrict__ rowidx, const bf16_t* __restrict__ Bt, int M, int N, int K, int group_rows, int valid_rows, long bstride, Epi epi) {
    const int tid = threadIdx.x, wid = tid >> 6, lane = tid & 63, fr = lane & 15, fq = lane >> 4, wr = wid >> 1, wc = wid & 1;
    const int row0 = blockIdx.y * 128 + wr * 64;
    if ((blockIdx.y * 128) % group_rows >= valid_rows) return;
    const bf16_t* B = Bt + (size_t)((blockIdx.y * 128) / group_rows) * bstride;
    int brow[4], ocol[4];
    if (!DUAL) { for (int i = 0; i < 4; ++i) { brow[i] = blockIdx.x * 128 + wc * 64 + i * 16; ocol[i] = brow[i]; } }
    else { const int hc0 = blockIdx.x * 64 + wc * 32;
        for (int i = 0; i < 2; ++i) { ocol[i] = hc0 + i * 16; brow[i] = (ocol[i] / 128) * 256 + ocol[i] % 128; brow[i + 2] = brow[i] + 128; ocol[i + 2] = ocol[i]; } }
    const bf16_t* ap[4]; const bf16_t* bp[4];
#pragma unroll
    for (int m = 0; m < 4; ++m) { const int r = row0 + m * 16 + fr; const int ar = rowidx ? rowidx[r] : r; ap[m] = A + (size_t)ar * K + fq * 8; }
#pragma unroll
    for (int i = 0; i < 4; ++i) bp[i] = B + (size_t)(brow[i] + fr) * K + fq * 8;
    f32x4 acc[4][4];
#pragma unroll
    for (int m = 0; m < 4; ++m)
#pragma unroll
        for (int i = 0; i < 4; ++i) acc[m][i] = (f32x4){0.f, 0.f, 0.f, 0.f};
    for (int k0 = 0; k0 < K; k0 += 32) {
        bf16x8 af[4], bfr[4];
#pragma unroll
        for (int m = 0; m < 4; ++m) af[m] = *(const bf16x8*)(ap[m] + k0);
#pragma unroll
        for (int i = 0; i < 4; ++i) bfr[i] = *(const bf16x8*)(bp[i] + k0);
#pragma unroll
        for (int m = 0; m < 4; ++m)
#pragma unroll
            for (int i = 0; i < 4; ++i) acc[m][i] = __builtin_amdgcn_mfma_f32_16x16x32_bf16(bfr[i], af[m], acc[m][i], 0, 0, 0);
    }
#pragma unroll
    for (int m = 0; m < 4; ++m) { const int r = row0 + m * 16 + fr;
#pragma unroll
        for (int i = 0; i < (DUAL ? 2 : 4); ++i) {
            float v[4] = {acc[m][i][0], acc[m][i][1], acc[m][i][2], acc[m][i][3]};
            float u[4] = {acc[m][DUAL ? i + 2 : i][0], acc[m][DUAL ? i + 2 : i][1], acc[m][DUAL ? i + 2 : i][2], acc[m][DUAL ? i + 2 : i][3]};
            epi(r, ocol[i] + 4 * fq, v, u); } }
}
template <class Epi, bool DUAL>
static void launch_gemm(hipStream_t stream, const bf16_t* A, const int* rowidx, const bf16_t* Bt, int M, int N, int K, int group_rows, int valid_rows, long bstride, Epi epi) {
    dim3 grid(DUAL ? N / 64 : N / 128, M / 128);
    hipLaunchKernelGGL((k_gemm_mfma<Epi, DUAL>), grid, dim3(256), 0, stream, A, rowidx, Bt, M, N, K, group_rows, valid_rows, bstride, epi);
}
#define GEMM(Epi, DUAL, ...) launch_gemm<Epi, DUAL>(stream, __VA_ARGS__)
#else
#define GEMM(Epi, DUAL, A, rowidx, Bt, M, N, K, gr, vr, bs, epi) LAUNCH((k_gemm_naive<Epi, DUAL>), (long)(M) * ((N) / 4), A, rowidx, Bt, M, N, K, gr, vr, bs, epi)
#endif

#ifdef HOST_TEST
typedef int hipStream_t;
#endif
static void forward(const Ptrs& p, hipStream_t stream) {
    (void)stream;
    unsigned char* ws = p.ws;
    float* tab = (float*)(ws + WS_TAB); float* silu = (float*)(ws + WS_SILU); float* mod = (float*)(ws + WS_MOD); float* rstd = (float*)(ws + WS_RSTD);
    float* aff = (float*)(ws + WS_AFF); int* sel = (int*)(ws + WS_SEL); float* gate = (float*)(ws + WS_GATE); int* tokslot = (int*)(ws + WS_TOKSLOT);
    float* xc = (float*)(ws + WS_XC); float* xl = p.out;
    bf16_t* win = (bf16_t*)(ws + WS_WIN); bf16_t* wout = (bf16_t*)(ws + WS_WOUT);
    bf16_t* P = (bf16_t*)(ws + WS_R1); bf16_t* H = (bf16_t*)(ws + WS_R1);
    bf16_t* Y = (bf16_t*)(ws + WS_R2); bf16_t* MIX = (bf16_t*)(ws + WS_R2); bf16_t* HX2 = (bf16_t*)(ws + WS_R2 + (size_t)RALL * D * 2); float* TMP = (float*)HX2;
    bf16_t* HX = (bf16_t*)(ws + WS_R3);
    LAUNCH(k_tables, (long)(NROWS + 64) * 24, tab);
    LAUNCH(k_silu, (long)(NB + 1) * D, p.c, p.c_ctx, silu);
    LAUNCH(k_mod, (long)DEPTH * 6 * D, silu, p.w_ada, p.b_ada, mod);
    LAUNCH(k_cvt_win, (long)DEPTH * PROJ * D, p.w_in, win);
    LAUNCH(k_cvt_t, (long)DEPTH * D * D, p.w_out, wout, DEPTH, D, D);
#ifdef HOST_TEST
    memcpy(xl, p.x, (size_t)RL * D * 4); memcpy(xc, p.ctx, (size_t)RC * D * 4);
#else
    (void)hipMemcpyAsync(xl, p.x, (size_t)RL * D * 4, hipMemcpyDeviceToDevice, stream);
    (void)hipMemcpyAsync(xc, p.ctx, (size_t)RC * D * 4, hipMemcpyDeviceToDevice, stream);
#endif
    for (int l = 0; l < DEPTH; ++l) {
        const bool need_ctx = l < DEPTH - 1; const int nq = need_ctx ? RALL : RL;
        const float* modl = mod + (size_t)l * (NB + 1) * 6 * D; const float lam_init = 0.8f - 0.6f * expf(-0.3f * (float)l);
        bf16_t* wgu = (bf16_t*)(ws + WS_WGU) + (size_t)(l & 1) * NE * 2 * FF * D; bf16_t* wd = (bf16_t*)(ws + WS_WD) + (size_t)(l & 1) * NE * D * FF;
        LAUNCH(k_cvt_gu, (long)NE * 2 * FF * D, p.w_gate + (size_t)l * NE * D * FF, p.w_up + (size_t)l * NE * D * FF, wgu);
        LAUNCH(k_cvt_t, (long)NE * FF * D, p.w_down + (size_t)l * NE * FF * D, wd, NE, FF, D);
        LAUNCH(k_rowstat, RALL, xl, xc, rstd, RALL);
        LAUNCH(k_rowapply, (long)RALL * D, xl, xc, rstd, p.norm1 + l * D, modl, M_SH1, M_SC1, HX, RALL);
        GEMM(EpiInProj, false, HX, (const int*)nullptr, win + (size_t)l * PROJ * D, RALL, PROJ, D, RALL, RALL, 0L, (EpiInProj{P, tab}));
        LAUNCH(k_attnA, (long)nq * NHA, P, p.attn_sink + l * NHA, MIX, nq);
        LAUNCH(k_attnD, (long)nq * NHC * 2, P, TMP, nq);
        LAUNCH(k_diffpost, (long)nq * NHC, TMP, p.diff_lambda + l * 4 * DD, p.diff_subln + l * 2 * DD, lam_init, MIX, nq);
        LAUNCH(k_conv, (long)nq * CONV_CH, P, p.conv_w + l * 3 * CONV_CH, MIX, nq);
        GEMM(EpiOutProj, false, MIX, (const int*)nullptr, wout + (size_t)l * D * D, nq, D, D, nq, nq, 0L, (EpiOutProj{xl, xc, modl}));
        LAUNCH(k_rowstat, nq, xl, xc, rstd, nq);
        LAUNCH(k_rowapply, (long)nq * D, xl, xc, rstd, p.norm2 + l * D, modl, M_SH2, M_SC2, HX2, nq);
        LAUNCH(k_router, (long)nq * NE, xl, xc, rstd, p.norm2 + l * D, modl, p.router + (size_t)l * D * NE, aff, nq);
        LAUNCH(k_aff, nq, aff, nq);
        LAUNCH(k_select, (long)nq * NE, aff, sel, gate, tokslot, nq);
        const int vr = need_ctx ? SLOTS_E : SLOTS_L;
        GEMM(EpiGateUp, true, HX2, sel, wgu, NSLOT, FF, D, SLOTS_E, vr, (long)2 * FF * D, (EpiGateUp{H}));
        GEMM(EpiDown, false, H, (const int*)nullptr, wd, NSLOT, D, FF, SLOTS_E, vr, (long)D * FF, (EpiDown{Y, gate}));
        LAUNCH(k_combine, (long)nq * D, xl, xc, Y, tokslot, modl, nq);
    }
    LAUNCH(k_rowstat, RL, xl, xc, rstd, RL);
    LAUNCH(k_final, (long)RL * D, xl, rstd, p.norm_final);
}

#ifndef HOST_TEST
#define LAS __attribute__((address_space(3)))
#define GAS __attribute__((address_space(1)))
typedef unsigned u32x4 __attribute__((ext_vector_type(4)));
typedef unsigned u32x2 __attribute__((ext_vector_type(2)));
typedef float f32x2_t __attribute__((ext_vector_type(2)));
constexpr int NT = 512, NWV = 8;
constexpr int LDS_BYTES = 163840;
constexpr int LDS_MISC = LDS_BYTES - 256;
constexpr int CW_BAR = 4096;

__device__ __forceinline__ unsigned cvt_pk_bf16(float lo, float hi) { unsigned r; asm volatile("v_cvt_pk_bf16_f32 %0, %1, %2" : "=v"(r) : "v"(lo), "v"(hi)); return r; }
__device__ __forceinline__ float dpp_f(float v, const int ctrl_tag) {
    int r;
    switch (ctrl_tag) {
        case 0: r = __builtin_amdgcn_update_dpp(0, __builtin_bit_cast(int, v), 0xB1, 0xF, 0xF, true); break;
        case 1: r = __builtin_amdgcn_update_dpp(0, __builtin_bit_cast(int, v), 0x4E, 0xF, 0xF, true); break;
        case 2: r = __builtin_amdgcn_update_dpp(0, __builtin_bit_cast(int, v), 0x141, 0xF, 0xF, true); break;
        default: r = __builtin_amdgcn_update_dpp(0, __builtin_bit_cast(int, v), 0x140, 0xF, 0xF, true); break;
    }
    return __builtin_bit_cast(float, r);
}
__device__ __forceinline__ float wave_sum(float v) {
    v += dpp_f(v, 0); v += dpp_f(v, 1); v += dpp_f(v, 2); v += dpp_f(v, 3);
    const int b = __builtin_bit_cast(int, v);
    return (__builtin_bit_cast(float, __builtin_amdgcn_readlane(b, 0)) + __builtin_bit_cast(float, __builtin_amdgcn_readlane(b, 16)))
         + (__builtin_bit_cast(float, __builtin_amdgcn_readlane(b, 32)) + __builtin_bit_cast(float, __builtin_amdgcn_readlane(b, 48)));
}
#define LDS_WAIT() asm volatile("s_waitcnt lgkmcnt(0)" ::: "memory")
__device__ __forceinline__ float wave_max(float v) {
    v = fmaxf(v, dpp_f(v, 0)); v = fmaxf(v, dpp_f(v, 1)); v = fmaxf(v, dpp_f(v, 2)); v = fmaxf(v, dpp_f(v, 3));
    const int b = __builtin_bit_cast(int, v);
    return fmaxf(fmaxf(__builtin_bit_cast(float, __builtin_amdgcn_readlane(b, 0)), __builtin_bit_cast(float, __builtin_amdgcn_readlane(b, 16))),
                 fmaxf(__builtin_bit_cast(float, __builtin_amdgcn_readlane(b, 32)), __builtin_bit_cast(float, __builtin_amdgcn_readlane(b, 48))));
}

#define LDS_RD16_B128(r, addr, STRIDE) asm volatile( \
    "ds_read_b128 %0, %16\n\tds_read_b128 %1, %16 offset:%c17\n\tds_read_b128 %2, %16 offset:2*%c17\n\tds_read_b128 %3, %16 offset:3*%c17\n\t" \
    "ds_read_b128 %4, %16 offset:4*%c17\n\tds_read_b128 %5, %16 offset:5*%c17\n\tds_read_b128 %6, %16 offset:6*%c17\n\tds_read_b128 %7, %16 offset:7*%c17\n\t" \
    "ds_read_b128 %8, %16 offset:8*%c17\n\tds_read_b128 %9, %16 offset:9*%c17\n\tds_read_b128 %10, %16 offset:10*%c17\n\tds_read_b128 %11, %16 offset:11*%c17\n\t" \
    "ds_read_b128 %12, %16 offset:12*%c17\n\tds_read_b128 %13, %16 offset:13*%c17\n\tds_read_b128 %14, %16 offset:14*%c17\n\tds_read_b128 %15, %16 offset:15*%c17\n\ts_waitcnt lgkmcnt(0)" \
    : "=&v"(r[0]), "=&v"(r[1]), "=&v"(r[2]), "=&v"(r[3]), "=&v"(r[4]), "=&v"(r[5]), "=&v"(r[6]), "=&v"(r[7]), "=&v"(r[8]), "=&v"(r[9]), "=&v"(r[10]), "=&v"(r[11]), "=&v"(r[12]), "=&v"(r[13]), "=&v"(r[14]), "=&v"(r[15]) \
    : "v"(addr), "i"(STRIDE) : "memory")
#define LDS_ISSUE8_B128(r, addr, STRIDE) asm volatile( \
    "ds_read_b128 %0, %8\n\tds_read_b128 %1, %8 offset:%c9\n\tds_read_b128 %2, %8 offset:2*%c9\n\tds_read_b128 %3, %8 offset:3*%c9\n\t" \
    "ds_read_b128 %4, %8 offset:4*%c9\n\tds_read_b128 %5, %8 offset:5*%c9\n\tds_read_b128 %6, %8 offset:6*%c9\n\tds_read_b128 %7, %8 offset:7*%c9" \
    : "=&v"(r[0]), "=&v"(r[1]), "=&v"(r[2]), "=&v"(r[3]), "=&v"(r[4]), "=&v"(r[5]), "=&v"(r[6]), "=&v"(r[7]) \
    : "v"(addr), "i"(STRIDE) : "memory")
#define LDS_WAIT8(r, N) asm volatile("s_waitcnt lgkmcnt(" #N ")" : "+v"(r[0]), "+v"(r[1]), "+v"(r[2]), "+v"(r[3]), "+v"(r[4]), "+v"(r[5]), "+v"(r[6]), "+v"(r[7]) :: "memory")
#define LDS_RD11_B128(r, addr, STRIDE) asm volatile( \
    "ds_read_b128 %0, %11\n\tds_read_b128 %1, %11 offset:%c12\n\tds_read_b128 %2, %11 offset:2*%c12\n\tds_read_b128 %3, %11 offset:3*%c12\n\t" \
    "ds_read_b128 %4, %11 offset:4*%c12\n\tds_read_b128 %5, %11 offset:5*%c12\n\tds_read_b128 %6, %11 offset:6*%c12\n\tds_read_b128 %7, %11 offset:7*%c12\n\t" \
    "ds_read_b128 %8, %11 offset:8*%c12\n\tds_read_b128 %9, %11 offset:9*%c12\n\tds_read_b128 %10, %11 offset:10*%c12\n\ts_waitcnt lgkmcnt(0)" \
    : "=&v"(r[0]), "=&v"(r[1]), "=&v"(r[2]), "=&v"(r[3]), "=&v"(r[4]), "=&v"(r[5]), "=&v"(r[6]), "=&v"(r[7]), "=&v"(r[8]), "=&v"(r[9]), "=&v"(r[10]) \
    : "v"(addr), "i"(STRIDE) : "memory")
__device__ __forceinline__ int lane_id_asm() { int l; asm volatile("v_mbcnt_lo_u32_b32 %0, -1, 0\n\tv_mbcnt_hi_u32_b32 %0, -1, %0" : "=v"(l)); return l; }
__device__ __forceinline__ int tid_w(int wv) { return wv * 64 + lane_id_asm(); }
#define tid_l() tid_w(C.wv)

#define XB_TMO      128
#define XB_XCNT(j)  (256  + 64 * (j))
#define XB_XSUB(j)  (1280 + 64 * (j))
#define XB_XGEN(j)  (2304 + 64 * (j))
#define XB_TOP      3328
#define XB_TOPGEN   3392
#define XCD_BAR_WORDS 3456
#define XB_SPIN_CAP (1u << 24)
__device__ __forceinline__ unsigned xb_ld(unsigned* p)              { return __hip_atomic_load(p, __ATOMIC_RELAXED, __HIP_MEMORY_SCOPE_AGENT); }
__device__ __forceinline__ unsigned xb_add(unsigned* p, unsigned v) { return __hip_atomic_fetch_add(p, v, __ATOMIC_RELAXED, __HIP_MEMORY_SCOPE_AGENT); }
__device__ __forceinline__ unsigned xb_xcc_id() { return (unsigned)__builtin_amdgcn_s_getreg((3 << 11) | 20) & 0xFu; }
#define XB_SPIN(cond, bar) do { unsigned _sp = 0; while (cond) { __builtin_amdgcn_s_sleep(1); \
    if ((++_sp & 255u) == 0u) { if (xb_ld(&(bar)[XB_TMO])) break; if (_sp > XB_SPIN_CAP) { atomicAdd(&(bar)[XB_TMO], 1u); break; } } } } while (0)
struct XcdBarrier { unsigned* bar; unsigned x; volatile LAS unsigned* st; int wv; };
__device__ __forceinline__ XcdBarrier xcd_barrier_post(unsigned* bar, volatile LAS unsigned* st, int wv) {
    XcdBarrier b; b.bar = bar; b.x = xb_xcc_id(); b.st = st; b.wv = wv;
    if (tid_w(wv) == 0) (void)xb_add(&bar[XB_XCNT(b.x)], 1u);
    return b;
}
__device__ __forceinline__ void xcd_barrier_complete(unsigned* bar, unsigned x, unsigned& nloc, unsigned& nx) {
    const unsigned G = gridDim.x * gridDim.y * gridDim.z;
    unsigned sum, cnt, mine, sp = 0u;
    for (;;) {
        sum = 0u; cnt = 0u; mine = 0u;
#pragma unroll
        for (unsigned j = 0; j < 16; ++j) { const unsigned c = xb_ld(&bar[XB_XCNT(j)]); sum += c; cnt += (c > 0u) ? 1u : 0u; mine = (j == x) ? c : mine; }
        if (sum == G) break;
        __builtin_amdgcn_s_sleep(1);
        if ((++sp & 255u) == 0u) { if (xb_ld(&bar[XB_TMO])) break; if (sp > XB_SPIN_CAP) { atomicAdd(&bar[XB_TMO], 1u); break; } }
    }
    nloc = mine > 0u ? mine : 1u; nx = cnt > 0u ? cnt : 1u;
}
__device__ __forceinline__ void xcd_barrier(const XcdBarrier& b) {
    asm volatile("s_waitcnt vmcnt(0)" ::: "memory");
    __syncthreads();
    if (tid_w(b.wv) == 0) {
        unsigned* bar = b.bar;
        __builtin_amdgcn_s_waitcnt(0);
        unsigned nloc = b.st[0], nx = b.st[1];
        if (nloc == 0u) { xcd_barrier_complete(bar, b.x, nloc, nx); b.st[0] = nloc; b.st[1] = nx; }
        const unsigned old = xb_add(&bar[XB_XSUB(b.x)], 1u);
        const unsigned gen = old / nloc;
        if (old + 1u == (gen + 1u) * nloc) {
            __builtin_amdgcn_fence(__ATOMIC_RELEASE, "agent");
            asm volatile("s_waitcnt vmcnt(0)" ::: "memory");
            const unsigned og = xb_add(&bar[XB_TOP], 1u);
            const unsigned tg = og / nx;
            if (og + 1u == (tg + 1u) * nx) xb_add(&bar[XB_TOPGEN], 1u);
            else XB_SPIN(xb_ld(&bar[XB_TOPGEN]) == tg, bar);
            __builtin_amdgcn_fence(__ATOMIC_ACQUIRE, "agent");
            xb_add(&bar[XB_XGEN(b.x)], 1u);
            asm volatile("s_waitcnt vmcnt(0)" ::: "memory");
        } else {
            XB_SPIN(xb_ld(&bar[XB_XGEN(b.x)]) == gen, bar);
            __builtin_amdgcn_fence(__ATOMIC_ACQUIRE, "agent");
            asm volatile("s_waitcnt vmcnt(0)" ::: "memory");
        }
    }
    __syncthreads();
}

namespace pg {
constexpr int BM = 256, BK = 64, HALF = 128, HTB = HALF * BK * 2  , STAGE_BYTES = 8 * HTB, NXCD = 8, WGM = 8;
constexpr int TPE_FULL = SLOTS_E / BM;
__host__ __device__ __forceinline__ int lds_byte(int r, int c) { const int st = (r >> 4) * 2 + (c >> 5), rr = r & 15, cc = c & 31, ob = rr * 64 + cc * 2; return st * 1024 + (ob ^ (((ob >> 9) & 1) << 5)); }
__host__ __device__ __forceinline__ void stage_rc(int b, int& R, int& C) { const int st = b / 1024, sb = b % 1024, swz = sb ^ (((sb >> 9) & 1) << 5); R = (st >> 1) * 16 + swz / 64; C = (st & 1) * 32 + (swz % 64) / 2; }
__host__ __device__ __forceinline__ int perm32(int rho) { const int n = rho >> 4, i = rho & 15; return 8 * (i >> 2) + 4 * n + (i & 3); }
struct Unit { int m0, pn, e; };
struct GemmD { const char* A; const int* rowidx; const char* Bt; size_t bstride; int K; };
struct Order {
    int nM, nN, nwg, G, c, tpe;
    __device__ void init(int nM_, int nN_, int G_, int c_, int tpe_) { nM = nM_; nN = nN_; nwg = nM * nN; G = G_; c = c_; tpe = tpe_; }
    __device__ bool next(int i, Unit& u) const {
        const long L = (long)i * G + c; if (L >= nwg) return false;
        int wgid = (int)L; { const int q = nwg / NXCD, r = nwg % NXCD, xcd = wgid % NXCD, off = wgid / NXCD; wgid = (xcd < r ? xcd * (q + 1) : r * (q + 1) + (xcd - r) * q) + off; }
        const int nig = WGM * nN, gid = wgid / nig, fm = gid * WGM, gsz = (nM - fm) < WGM ? (nM - fm) : WGM;
        const int pm = fm + ((wgid % nig) % gsz); u.pn = (wgid % nig) / gsz;
        if (tpe > 0) { u.e = pm / tpe; u.m0 = (u.e * TPE_FULL + pm % tpe) * BM; } else { u.e = 0; u.m0 = pm * BM; }
        return true;
    }
};
template <class T> struct has_pre { template <class U> static constexpr bool test(decltype(U::HAS_PRE)*) { return U::HAS_PRE; } template <class U> static constexpr bool test(...) { return false; } static constexpr bool value = test<T>(nullptr); };
typedef int v4i32_t __attribute__((ext_vector_type(4)));
typedef int v8i32_t __attribute__((ext_vector_type(8)));
__device__ __forceinline__ v8i32_t cat8(const bf16x8 a, const bf16x8 b) { return __builtin_shufflevector(__builtin_bit_cast(v4i32_t, a), __builtin_bit_cast(v4i32_t, b), 0, 1, 2, 3, 4, 5, 6, 7); }
constexpr int SCALE_ONE = 0x7F7F7F7F, SCALE_W = 0x79797979;
template <bool I> struct acc_sel { typedef f32x4 type; };
template <> struct acc_sel<true> { typedef v4i32_t type; };
template <class Epi, bool GATHER, int QM = 0>
__device__ __forceinline__ void gemm_phase(LAS unsigned char* lds, const GemmD g, const Order& S, const Epi& E, int wv) {
    const int tid = tid_w(wv), wid = __builtin_amdgcn_readfirstlane(tid >> 6), lane = tid & 63, wr = wid >> 2, wc = wid & 3, fr = lane & 15, fq = lane >> 4;
    constexpr bool FP8 = (QM == 1), I8 = (QM == 2);
    typedef typename acc_sel<QM == 2>::type acc_t;
    const int K = g.K, nt = K / BK;
    int Rr[2], Cc[2]; unsigned voffB[2];
#pragma unroll
    for (int i = 0; i < 2; ++i) { int R, C; stage_rc(tid * 16 + i * 8192, R, C); Rr[i] = R; Cc[i] = C; const int Rb = Epi::PERM ? ((R & ~31) + perm32(R & 31)) : R; voffB[i] = (unsigned)(Rb * K + C) * 2u; }
    const unsigned kstep = (unsigned)(BK * 2);
    const size_t hstep = (size_t)HALF * K * 2;
    const unsigned ldsw = (unsigned)wid * 1024u;
    const int aoff = lds_byte(wr * 64 + fr, fq * 8), boff = lds_byte(wc * 32 + fr, fq * 8);
#define PG_SA(b, h) (((b) * 2 + (h)) * HTB)
#define PG_SB(b, h) ((4 + (b) * 2 + (h)) * HTB)
#define PG_STAGE_B(bufoff, gbase) do { _Pragma("unroll") for (int _i = 0; _i < 2; ++_i) \
        __builtin_amdgcn_global_load_lds((const unsigned*)((const char*)(gbase) + voffB[_i]), (LAS unsigned*)(lds + (bufoff) + ldsw + _i * 8192), 16, 0, 0); } while (0)
#define PG_STAGE_A(bufoff, OFFS, h, kb) do { _Pragma("unroll") for (int _i = 0; _i < 2; ++_i) \
        __builtin_amdgcn_global_load_lds((const unsigned*)(g.A + (size_t)(OFFS)[h][_i] + (kb)), (LAS unsigned*)(lds + (bufoff) + ldsw + _i * 8192), 16, 0, 0); } while (0)
#define PG_ROWOFF(DST, U) do { _Pragma("unroll") for (int _h = 0; _h < 2; ++_h) _Pragma("unroll") for (int _i = 0; _i < 2; ++_i) { int _r = (U).m0 + _h * HALF + Rr[_i]; if (GATHER) _r = g.rowidx[_r]; \
        (DST)[_h][_i] = (unsigned)(((size_t)_r * K + Cc[_i]) * 2); } } while (0)
#define PG_LOADIDX(DST, U) do { _Pragma("unroll") for (int _h = 0; _h < 2; ++_h) _Pragma("unroll") for (int _i = 0; _i < 2; ++_i) (DST)[_h][_i] = g.rowidx[(U).m0 + _h * HALF + Rr[_i]]; } while (0)
#define PG_OFFIDX(DST, IDX) do { _Pragma("unroll") for (int _h = 0; _h < 2; ++_h) _Pragma("unroll") for (int _i = 0; _i < 2; ++_i) (DST)[_h][_i] = (unsigned)(((size_t)(IDX)[_h][_i] * K + Cc[_i]) * 2); } while (0)
#define PG_LDA(dst, b, h) do { _Pragma("unroll") for (int m = 0; m < 4; ++m) { if constexpr (FP8) { const v4i32_t _x0 = *(const LAS v4i32_t*)(lds + PG_SA(b, h) + aoff + m * 2048), _x1 = *(const LAS v4i32_t*)(lds + PG_SA(b, h) + aoff + m * 2048 + 1024); \
        dst##8[m] = __builtin_shufflevector(_x0, _x1, 0, 1, 2, 3, 4, 5, 6, 7); } else { _Pragma("unroll") for (int k = 0; k < 2; ++k) dst[m][k] = *(const LAS bf16x8*)(lds + PG_SA(b, h) + aoff + m * 2048 + k * 1024); } } } while (0)
#define PG_LDB(dst, b, h) do { _Pragma("unroll") for (int n = 0; n < 2; ++n) { if constexpr (FP8) { const v4i32_t _x0 = *(const LAS v4i32_t*)(lds + PG_SB(b, h) + boff + n * 2048), _x1 = *(const LAS v4i32_t*)(lds + PG_SB(b, h) + boff + n * 2048 + 1024); \
        dst##8[n] = __builtin_shufflevector(_x0, _x1, 0, 1, 2, 3, 4, 5, 6, 7); } else { _Pragma("unroll") for (int k = 0; k < 2; ++k) dst[n][k] = *(const LAS bf16x8*)(lds + PG_SB(b, h) + boff + n * 2048 + k * 1024); } } } while (0)
#define PG_MMA(ai, bj, At, Bt) do { __builtin_amdgcn_s_setprio(1); _Pragma("unroll") for (int m = 0; m < 4; ++m) _Pragma("unroll") for (int n = 0; n < 2; ++n) { \
        if constexpr (FP8) asm volatile("s_nop 1\n\tv_mfma_scale_f32_16x16x128_f8f6f4 %0, %1, %2, %0, %3, %4 op_sel_hi:[0,0,0]" : "+v"(acc[ai][bj][m][n]) : "v"(Bt##8[n]), "v"(At##8[m]), "v"(sc_w), "v"(sc_a)); \
        else if constexpr (I8) { _Pragma("unroll") for (int k = 0; k < 2; ++k) acc[ai][bj][m][n] = __builtin_amdgcn_mfma_i32_16x16x64_i8(__builtin_bit_cast(v4i32_t, Bt[n][k]), __builtin_bit_cast(v4i32_t, At[m][k]), acc[ai][bj][m][n], 0, 0, 0); } \
        else if constexpr (!I8 && !FP8) { _Pragma("unroll") for (int k = 0; k < 2; ++k) acc[ai][bj][m][n] = __builtin_amdgcn_mfma_f32_16x16x32_bf16(Bt[n][k], At[m][k], acc[ai][bj][m][n], 0, 0, 0); } } \
        __builtin_amdgcn_s_setprio(0); } while (0)
#define PG_WAIT_V(n) asm volatile("s_waitcnt vmcnt(" #n ")" ::: "memory")
#define PG_WAIT_L(n) asm volatile("s_waitcnt lgkmcnt(" #n ")" ::: "memory")
#define PG_BAR __builtin_amdgcn_s_barrier()
#define PG_SCHED __builtin_amdgcn_sched_barrier(0)
    Unit cur, nxt; int ui = 0;
    if (!S.next(0, cur)) return;
    acc_t acc[2][2][4][2];
#pragma unroll
    for (int a = 0; a < 2; ++a)
#pragma unroll
        for (int b = 0; b < 2; ++b)
#pragma unroll
            for (int m = 0; m < 4; ++m)
#pragma unroll
                for (int n = 0; n < 2; ++n) { acc[a][b][m][n] = acc_t{}; if constexpr (FP8) asm volatile("" : "+v"(acc[a][b][m][n])); }
    bf16x8 At[4][2], B0[2][2], B1[2][2]; v8i32_t At8[4], B08[2], B18[2];
    int sc_w = SCALE_W, sc_a = SCALE_ONE; if constexpr (FP8) { asm volatile("" : "+v"(sc_w), "+v"(sc_a)); }
    unsigned offA[2][2], offN[2][2];
    float epre[8] = {0.f, 0.f, 0.f, 0.f, 0.f, 0.f, 0.f, 0.f};
    if constexpr (has_pre<Epi>::value) E.pre(epre, cur, wr, fr);
    PG_ROWOFF(offA, cur);
    int ridx[2][2] = {{0, 0}, {0, 0}};
    if (GATHER) { Unit n1; const bool h1 = S.next(1, n1); if (!h1) n1 = cur; PG_LOADIDX(ridx, n1); }
    if (GATHER) PG_WAIT_V(0);
    const char* cB = g.Bt + (size_t)cur.e * g.bstride + (size_t)cur.pn * BM * K * 2;
    PG_STAGE_B(PG_SB(0, 0), cB); PG_STAGE_B(PG_SB(0, 1), cB + hstep); PG_STAGE_A(PG_SA(0, 0), offA, 0, 0u); PG_STAGE_A(PG_SA(0, 1), offA, 1, 0u);
    if (wr == 1) PG_BAR;
    PG_WAIT_V(2); PG_BAR;
    PG_STAGE_B(PG_SB(1, 0), cB + kstep); PG_STAGE_A(PG_SA(1, 0), offA, 0, kstep); PG_STAGE_B(PG_SB(1, 1), cB + hstep + kstep);
    PG_WAIT_V(6); PG_BAR;
    for (;;) {
        const bool has_next = S.next(ui + 1, nxt);
        const char* nB = has_next ? g.Bt + (size_t)nxt.e * g.bstride + (size_t)nxt.pn * BM * K * 2 : cB;
        if (has_next) { if (GATHER) PG_OFFIDX(offN, ridx); else PG_ROWOFF(offN, nxt); }
        else {
#pragma unroll
            for (int h = 0; h < 2; ++h)
#pragma unroll
                for (int i = 0; i < 2; ++i) offN[h][i] = offA[h][i]; }
        for (int t = 0; t < nt; t += 2) {
            const bool last = (t == nt - 2);
            unsigned o2[2][2];
#pragma unroll
            for (int h = 0; h < 2; ++h)
#pragma unroll
                for (int i = 0; i < 2; ++i) o2[h][i] = last ? offN[h][i] : offA[h][i];
            const unsigned ka1 = (unsigned)(t + 1) * kstep, ka2 = last ? 0u : (unsigned)(t + 2) * kstep, ka3 = ka2 + kstep;
            const char* b2 = last ? nB : cB + (size_t)(t + 2) * kstep; const char* b3 = b2 + kstep;
            PG_LDB(B0, 0, 0); PG_LDB(B1, 0, 1); PG_SCHED; PG_LDA(At, 0, 0); PG_STAGE_A(PG_SA(1, 1), offA, 1, ka1);
            PG_WAIT_V(8); PG_WAIT_L(0); PG_BAR; PG_MMA(0, 0, At, B0); PG_MMA(0, 1, At, B1); PG_BAR; PG_SCHED;
            PG_LDA(At, 0, 1); PG_STAGE_B(PG_SB(0, 0), b2); PG_STAGE_B(PG_SB(0, 1), b2 + hstep); PG_STAGE_A(PG_SA(0, 0), o2, 0, ka2);
            PG_WAIT_V(8); PG_WAIT_L(0); PG_BAR; PG_MMA(1, 0, At, B0); PG_MMA(1, 1, At, B1); PG_BAR; PG_SCHED;
            PG_LDB(B0, 1, 0); PG_LDB(B1, 1, 1); PG_SCHED; PG_LDA(At, 1, 0); PG_STAGE_A(PG_SA(0, 1), o2, 1, ka2);
            PG_WAIT_V(8); PG_WAIT_L(0); PG_BAR; PG_MMA(0, 0, At, B0); PG_MMA(0, 1, At, B1); PG_BAR; PG_SCHED;
            PG_LDA(At, 1, 1); PG_STAGE_B(PG_SB(1, 0), b3); PG_STAGE_B(PG_SB(1, 1), b3 + hstep); PG_STAGE_A(PG_SA(1, 0), o2, 0, ka3);
            PG_WAIT_V(8); PG_WAIT_L(0); PG_BAR; PG_MMA(1, 0, At, B0); PG_MMA(1, 1, At, B1); PG_BAR; PG_SCHED;
        }
        if (GATHER) { Unit n2; const bool h2 = S.next(ui + 2, n2); if (!h2) n2 = cur; PG_LOADIDX(ridx, n2); }
        if (wr == 0) PG_BAR;
        if constexpr (FP8) asm volatile("s_nop 15\n\ts_nop 7" ::: "memory");
        if constexpr (has_pre<Epi>::value) { E(acc, cur, wr, wc, fr, fq, epre); if (has_next) E.pre(epre, nxt, wr, fr); }
        else E(acc, cur, wr, wc, fr, fq);
        if (!has_next) break;
#pragma unroll
        for (int a = 0; a < 2; ++a)
#pragma unroll
            for (int b = 0; b < 2; ++b)
#pragma unroll
                for (int m = 0; m < 4; ++m)
#pragma unroll
                    for (int n = 0; n < 2; ++n) { acc[a][b][m][n] = acc_t{}; if constexpr (FP8) asm volatile("" : "+v"(acc[a][b][m][n])); }
        cur = nxt; cB = nB; ++ui;
#pragma unroll
        for (int h = 0; h < 2; ++h)
#pragma unroll
            for (int i = 0; i < 2; ++i) offA[h][i] = offN[h][i];
        if (wr == 1) PG_BAR;
    }
    PG_WAIT_V(0);
    PG_BAR;
#undef PG_SA
#undef PG_SB
#undef PG_STAGE_A
#undef PG_STAGE_B
#undef PG_ROWOFF
#undef PG_LDA
#undef PG_LOADIDX
#undef PG_OFFIDX
#undef PG_LDB
#undef PG_MMA
#undef PG_WAIT_V
#undef PG_WAIT_L
#undef PG_BAR
#undef PG_SCHED
}
struct EpiP {
    static constexpr bool PERM = true;
    bf16_t* P; const float* tab; const float* hxs; const float* wss;
    __device__ __forceinline__ void operator()(const v4i32_t (&acc)[2][2][4][2], const Unit& u, int wr, int wc, int fr, int fq) const {
        const bool lat = u.m0 < RL;
        float rs[8];
#pragma unroll
        for (int ai = 0; ai < 2; ++ai)
#pragma unroll
            for (int m = 0; m < 4; ++m) rs[ai * 4 + m] = hxs[u.m0 + ai * HALF + wr * 64 + m * 16 + fr];
        float cs; { const int ln = fr + 16 * fq; cs = 4.0f * sqrtf(wave_sum((wss[ln] + wss[ln + 64]) + (wss[ln + 128] + wss[ln + 192])) * (1.0f / ((float)D * (float)PROJ))) * (1.0f / 127.0f); }
#pragma unroll
        for (int bj = 0; bj < 2; ++bj) {
            const int ct = u.pn * BM + bj * HALF;
            const int c0 = ct + wc * 32 + 8 * fq;
            const int kind = ct < C_VA ? 1 : ((ct >= C_QD && ct < C_VD) ? 2 : 0);
            const float sc = ct < C_KA ? QSCALE_A : ((ct >= C_QD && ct < C_KD) ? QSCALE_D : 1.0f);
#pragma unroll
            for (int ai = 0; ai < 2; ++ai)
#pragma unroll
                for (int m = 0; m < 4; ++m) {
                    const int row = u.m0 + ai * HALF + wr * 64 + m * 16 + fr;
                    f32x4 v0, v1; { const v4i32_t i0 = acc[ai][bj][m][0], i1 = acc[ai][bj][m][1]; const float r_ = rs[ai * 4 + m];
#pragma unroll
                      for (int k = 0; k < 4; ++k) { v0[k] = (float)i0[k] * (r_ * cs); v1[k] = (float)i1[k] * (r_ * cs); } }
                    if (kind != 0 && lat) {
                        const int pos = row % SEQ, gr = pos / GRID_W, gc = pos % GRID_W; const float* t;
                        if (kind == 1) { const int p = c0 & 63, grp = p >> 5, i0 = (p & 31) >> 1; t = tab + (grp ? T_ACOL + gc * 32 : T_AROW + gr * 32) + i0 * 2; }
                        else { const int p = c0 & 31, grp = p >> 4, i0 = (p & 15) >> 1; t = tab + (grp ? T_DCOL + gc * 16 : T_DROW + gr * 16) + i0 * 2; }
                        const f32x4 t0 = *(const f32x4*)t, t1 = *(const f32x4*)(t + 4);
                        v0 = (f32x4){v0[0] * t0[0] - v0[1] * t0[1], v0[1] * t0[0] + v0[0] * t0[1], v0[2] * t0[2] - v0[3] * t0[3], v0[3] * t0[2] + v0[2] * t0[3]};
                        v1 = (f32x4){v1[0] * t1[0] - v1[1] * t1[1], v1[1] * t1[0] + v1[0] * t1[1], v1[2] * t1[2] - v1[3] * t1[3], v1[3] * t1[2] + v1[2] * t1[3]};
                    }
                    v0 = v0 * sc; v1 = v1 * sc;
                    u32x4 w; w.x = cvt_pk_bf16(v0[0], v0[1]); w.y = cvt_pk_bf16(v0[2], v0[3]); w.z = cvt_pk_bf16(v1[0], v1[1]); w.w = cvt_pk_bf16(v1[2], v1[3]);
                    *(u32x4*)(P + (size_t)row * PROJ + c0) = w;
                }
        }
    }
};
struct EpiX {
    static constexpr bool PERM = true;
    bf16_t* XB; const float* modl; float gscale;
    __device__ __forceinline__ void operator()(const f32x4 (&acc)[2][2][4][2], const Unit& u, int wr, int wc, int fr, int fq) const {
        const int b = u.m0 < RL ? u.m0 / SEQ : NB; const float* g1 = modl + (size_t)b * 6 * D + M_G1 + u.pn * BM + wc * 32 + 8 * fq;
        bf16_t* x0 = XB + (size_t)(u.m0 + wr * 64 + fr) * D + u.pn * BM + wc * 32 + 8 * fq;
        u32x4 xv[2][4][2];
#pragma unroll
        for (int ai = 0; ai < 2; ++ai)
#pragma unroll
            for (int m = 0; m < 4; ++m)
#pragma unroll
                for (int bj = 0; bj < 2; ++bj) xv[ai][m][bj] = *(const u32x4*)(x0 + (size_t)(ai * HALF + m * 16) * D + bj * HALF);
        f32x4 gv[2][2];
#pragma unroll
        for (int bj = 0; bj < 2; ++bj)
#pragma unroll
            for (int n = 0; n < 2; ++n) gv[bj][n] = *(const f32x4*)(g1 + bj * HALF + 4 * n) * gscale;
#pragma unroll
        for (int ai = 0; ai < 2; ++ai)
#pragma unroll
            for (int m = 0; m < 4; ++m)
#pragma unroll
                for (int bj = 0; bj < 2; ++bj) { const u32x4 x = xv[ai][m][bj];
                    const f32x4 a0 = acc[ai][bj][m][0] * gv[bj][0], a1 = acc[ai][bj][m][1] * gv[bj][1]; u32x4 w;
                    w.x = cvt_pk_bf16(__builtin_bit_cast(float, x.x << 16) + a0[0], __builtin_bit_cast(float, x.x & 0xffff0000u) + a0[1]);
                    w.y = cvt_pk_bf16(__builtin_bit_cast(float, x.y << 16) + a0[2], __builtin_bit_cast(float, x.y & 0xffff0000u) + a0[3]);
                    w.z = cvt_pk_bf16(__builtin_bit_cast(float, x.z << 16) + a1[0], __builtin_bit_cast(float, x.z & 0xffff0000u) + a1[1]);
                    w.w = cvt_pk_bf16(__builtin_bit_cast(float, x.w << 16) + a1[2], __builtin_bit_cast(float, x.w & 0xffff0000u) + a1[3]);
                    *(u32x4*)(x0 + (size_t)(ai * HALF + m * 16) * D + bj * HALF) = w; }
    }
};
__device__ __forceinline__ float silu_fast(float v) { return v * __builtin_amdgcn_rcpf(1.0f + __builtin_amdgcn_exp2f(-LOG2E * v)); }
__device__ __forceinline__ unsigned pk4_fp8(float a, float b, float c, float d) { int w = 0; w = __builtin_amdgcn_cvt_pk_fp8_f32(a, b, w, false); w = __builtin_amdgcn_cvt_pk_fp8_f32(c, d, w, true); return (unsigned)w; }
__device__ __forceinline__ void store_pair16_fq(unsigned char* p0, unsigned char* p1, u32x2 a, u32x2 b, int fq) {
    auto rx = __builtin_amdgcn_permlane16_swap(a.x, b.x, false, false); auto ry = __builtin_amdgcn_permlane16_swap(a.y, b.y, false, false);
    u32x4 w; w.x = rx[0]; w.y = ry[0]; w.z = rx[1]; w.w = ry[1];
    *(u32x4*)((fq & 1) ? p1 - 8 : p0) = w;
}
struct EpiH {
    static constexpr bool PERM = true;
    unsigned char* H;
    __device__ __forceinline__ void operator()(const f32x4 (&acc)[2][2][4][2], const Unit& u, int wr, int wc, int fr, int fq) const {
        const int hc = u.pn * HALF + wc * 32 + 8 * fq;
#pragma unroll
        for (int ai = 0; ai < 2; ++ai)
#pragma unroll
            for (int m = 0; m < 4; m += 2) {
                const int row = u.m0 + ai * HALF + wr * 64 + m * 16 + fr;
                u32x2 w[2];
#pragma unroll
                for (int q = 0; q < 2; ++q) {
                    const f32x4 g0 = acc[ai][0][m + q][0], g1 = acc[ai][0][m + q][1], u0 = acc[ai][1][m + q][0], u1 = acc[ai][1][m + q][1];
                    w[q].x = pk4_fp8(silu_fast(g0[0]) * u0[0], silu_fast(g0[1]) * u0[1], silu_fast(g0[2]) * u0[2], silu_fast(g0[3]) * u0[3]);
                    w[q].y = pk4_fp8(silu_fast(g1[0]) * u1[0], silu_fast(g1[1]) * u1[1], silu_fast(g1[2]) * u1[2], silu_fast(g1[3]) * u1[3]);
                }
                store_pair16_fq(H + (size_t)row * FF + hc, H + (size_t)(row + 16) * FF + hc, w[0], w[1], fq);
            }
    }
};
struct EpiY {
    static constexpr bool PERM = true, HAS_PRE = true;
    unsigned char* Y; const float* gate;
    __device__ __forceinline__ void pre(float (&gv)[8], const Unit& u, int wr, int fr) const {
#pragma unroll
        for (int ai = 0; ai < 2; ++ai)
#pragma unroll
            for (int m = 0; m < 4; ++m) gv[ai * 4 + m] = gate[u.m0 + ai * HALF + wr * 64 + m * 16 + fr];
    }
    __device__ __forceinline__ void operator()(const f32x4 (&acc)[2][2][4][2], const Unit& u, int wr, int wc, int fr, int fq, const float (&gv)[8]) const {
#pragma unroll
        for (int ai = 0; ai < 2; ++ai)
#pragma unroll
            for (int m = 0; m < 4; m += 2) {
                const int row = u.m0 + ai * HALF + wr * 64 + m * 16 + fr;
#pragma unroll
                for (int bj = 0; bj < 2; ++bj) {
                    u32x2 w[2];
#pragma unroll
                    for (int q = 0; q < 2; ++q) { const float gt = gv[ai * 4 + m + q] * 64.0f;
                        const f32x4 v0 = acc[ai][bj][m + q][0] * gt, v1 = acc[ai][bj][m + q][1] * gt;
                        w[q].x = pk4_fp8(v0[0], v0[1], v0[2], v0[3]); w[q].y = pk4_fp8(v1[0], v1[1], v1[2], v1[3]); }
                    unsigned char* p0 = Y + (size_t)row * D + u.pn * BM + bj * HALF + wc * 32 + 8 * fq;
                    store_pair16_fq(p0, p0 + (size_t)16 * D, w[0], w[1], fq);
                }
            }
    }
};
}

struct Args { const float* in[19]; float* out; unsigned char* ws; int ph_lo, ph_hi; };
struct Ctx {
    Ptrs p; LAS unsigned char* lds;
    float *tab, *mod, *aff, *gate, *xc, *xl; int *sel, *tokslot;
    bf16_t *win, *wout, *P, *H, *Y, *MIX, *HX2, *HX, *XB; float* TMP; int wv;
};
template <class Dest>
__device__ __forceinline__ void transpose_item_fp8(const float* W, int K, int N, unsigned char* WT, LAS float* scr, int item, int lane, Dest dest) {
    const int nblk = N / 32, kb = item / nblk, nb = item % nblk, k0 = 64 * kb, n0 = 32 * nb;
    float wv[32];
#pragma unroll
    for (int i = 0; i < 32; ++i) wv[i] = W[(size_t)(k0 + 2 * i + (lane >> 5)) * N + n0 + (lane & 31)];
#pragma unroll
    for (int i = 0; i < 32; ++i) { const int kk = 2 * i + (lane >> 5); scr[kk * 33 + (lane & 31)] = wv[i] * 64.0f; }
    LDS_WAIT(); asm volatile("" ::: "memory");
    const int c = lane & 7;
#pragma unroll
    for (int j = 0; j < 4; ++j) { const int n = (lane >> 3) + 8 * j; const LAS float* s = scr + (8 * c) * 33 + n;
        u32x2 o; o.x = pg::pk4_fp8(s[0 * 33], s[1 * 33], s[2 * 33], s[3 * 33]); o.y = pg::pk4_fp8(s[4 * 33], s[5 * 33], s[6 * 33], s[7 * 33]);
        *(u32x2*)(WT + (size_t)dest(n0 + n) * K + k0 + 8 * c) = o; }
    LDS_WAIT(); asm volatile("" ::: "memory");
}
template <class Dest>
__device__ __forceinline__ void transpose_item(const float* W, int K, int N, bf16_t* WT, LAS float* scr, int item, int lane, Dest dest) {
    const int nblk = N / 32, kb = item / nblk, nb = item % nblk, k0 = 64 * kb, n0 = 32 * nb;
#pragma unroll 8
    for (int i = 0; i < 32; ++i) { const int kk = 2 * i + (lane >> 5); scr[kk * 33 + (lane & 31)] = W[(size_t)(k0 + kk) * N + n0 + (lane & 31)]; }
    LDS_WAIT(); asm volatile("" ::: "memory");
    const int c = lane & 7;
#pragma unroll
    for (int j = 0; j < 4; ++j) { const int n = (lane >> 3) + 8 * j; const LAS float* s = scr + (8 * c) * 33 + n;
        u32x4 o; o.x = cvt_pk_bf16(s[0 * 33], s[1 * 33]); o.y = cvt_pk_bf16(s[2 * 33], s[3 * 33]); o.z = cvt_pk_bf16(s[4 * 33], s[5 * 33]); o.w = cvt_pk_bf16(s[6 * 33], s[7 * 33]);
        *(u32x4*)(WT + (size_t)dest(n0 + n) * K + k0 + 8 * c) = o; }
    LDS_WAIT(); asm volatile("" ::: "memory");
}
HD int invA(int q) { const int g = q / 32, r = q % 32; return 32 * g + (r < 16 ? 2 * r : 2 * (r - 16) + 1); }
HD int invD(int q) { const int g = q / 16, r = q % 16; return 16 * g + (r < 8 ? 2 * r : 2 * (r - 8) + 1); }
HD int inproj_dst_row(int nl) {
    if (nl < C_VA) return (nl / 64) * 64 + invA(nl % 64);
    if (nl >= C_QD && nl < C_VD) return (nl / 32) * 32 + invD(nl % 32);
    return nl;
}
struct DestIn { __device__ int operator()(int n) const { return inproj_dst_row(n); } };
struct DestId { __device__ int operator()(int n) const { return n; } };
struct DestGU { int up; __device__ int operator()(int n) const { return (n / 128) * 256 + up * 128 + n % 128; } };

__device__ __forceinline__ void phase_prologue(const Ctx& C) {
    const int tid = tid_l(), lane = tid & 63, wave = __builtin_amdgcn_readfirstlane(tid >> 6), gw = blockIdx.x * NWV + wave, NGW = gridDim.x * NWV; (void)lane; (void)gw; (void)NGW;
    for (long g = (long)tid * gridDim.x + blockIdx.x; g < (long)(NROWS + 64) * 24; g += (long)gridDim.x * NT) {
        const int pos = (int)(g / 24), f = (int)(g % 24);
        const float inv = f < 16 ? exp2f(-(float)f * (13.287712379549449f / 16.0f)) : exp2f(-(float)(f - 16) * (13.287712379549449f / 8.0f));
        const bool isrow = pos < NROWS; const int p = isrow ? pos : pos - NROWS;
        const float ang = (float)p * inv; float sn, cs; sincosf(ang, &sn, &cs);
        const int idx = f < 16 ? (isrow ? T_AROW : T_ACOL) + (p * 16 + f) * 2 : (isrow ? T_DROW : T_DCOL) + (p * 8 + (f - 16)) * 2;
        C.tab[idx] = cs; C.tab[idx + 1] = sn;
    }
    LAS float* sl = (LAS float*)C.lds;
    for (int i = tid; i < (NB + 1) * D; i += NT) { const int b = i / D, k = i % D; sl[i] = silu_f(b < NB ? C.p.c[b * D + k] : C.p.c_ctx[k]); }
    __syncthreads();
    constexpr int NBR = NB + 1, BG = 11, NBG = NBR / BG; static_assert(NBG * BG == NBR, "adaLN rows reduced in groups of 11");
    LAS float* pbuf = (LAS float*)(C.lds + NBR * D * 4);
    static_assert(NBR * D * 4 + 16 * BG * 32 * 4 <= LDS_MISC, "prologue LDS");
    for (int task = blockIdx.x; task < DEPTH * 6 * D / 32; task += gridDim.x) {
        const int jg = task * 32, l = jg / (6 * D), j0 = jg % (6 * D), c = lane & 31, half = lane >> 5, kb = 128 * wave + 64 * half;
        f32x2_t acc2[NBR];
#pragma unroll
        for (int b = 0; b < NBR; ++b) acc2[b] = (f32x2_t){0.f, 0.f};
        const float* w = C.p.w_ada + ((size_t)l * D + kb) * 6 * D + j0 + c; const LAS float* s0 = sl + kb;
        for (int kk = 0; kk < 64; kk += 4) {
            const f32x2_t w01 = (f32x2_t){w[(size_t)kk * 6 * D], w[(size_t)(kk + 1) * 6 * D]}, w23 = (f32x2_t){w[(size_t)(kk + 2) * 6 * D], w[(size_t)(kk + 3) * 6 * D]};
#pragma unroll
            for (int rr = 0; rr < NBG; ++rr) { f32x4 sv[BG]; const unsigned sa = (unsigned)(size_t)(s0 + rr * BG * D + kk);
                LDS_RD11_B128(sv, sa, D * 4);
#pragma unroll
                for (int bb = 0; bb < BG; ++bb) { acc2[rr * BG + bb] = __builtin_elementwise_fma((f32x2_t){sv[bb][0], sv[bb][1]}, w01, acc2[rr * BG + bb]);
                    acc2[rr * BG + bb] = __builtin_elementwise_fma((f32x2_t){sv[bb][2], sv[bb][3]}, w23, acc2[rr * BG + bb]); } }
        }
        float acc[NBR];
#pragma unroll
        for (int b = 0; b < NBR; ++b) acc[b] = acc2[b][0] + acc2[b][1];
#pragma unroll
        for (int rr = 0; rr < NBG; ++rr) {
#pragma unroll
            for (int bb = 0; bb < BG; ++bb) pbuf[((wave * 2 + half) * BG + bb) * 32 + c] = acc[rr * BG + bb];
            __syncthreads();
            if (tid < BG * 32) { const int bb = tid / 32, cc = tid % 32; float s = 0.f;
#pragma unroll
                for (int p = 0; p < 16; ++p) s += pbuf[(p * BG + bb) * 32 + cc];
                C.mod[((size_t)l * NBR + rr * BG + bb) * 6 * D + j0 + cc] = s + C.p.b_ada[l * 6 * D + j0 + cc]; }
            __syncthreads();
        }
    }
    __syncthreads();
    LAS float* scr = (LAS float*)(C.lds + wave * 16384);
    constexpr int I_OUT = (D / 64) * (D / 32);
    for (int it = gw; it < DEPTH * I_OUT; it += NGW) { const int l = it / I_OUT, r = it % I_OUT;
        transpose_item(C.p.w_out + (size_t)l * D * D, D, D, C.wout + (size_t)l * D * D, scr, r, lane, DestId{}); }
    float* wss = (float*)(C.p.ws + WS_CTL + CTL_WINMAX);
    LAS float* pm = (LAS float*)(C.lds + 8 * 16384);
    __syncthreads();
    for (int slot = blockIdx.x; slot < DEPTH * 256; slot += gridDim.x) {
        const int l = slot / 256, s = slot % 256; constexpr int PER = D * PROJ / 256;
        const float* w = C.p.w_in + (size_t)l * D * PROJ + (size_t)s * PER; float acc = 0.f;
        for (int i = tid; i < PER / 4; i += NT) { const f32x4 v = *(const f32x4*)(w + 4 * i); acc += (v[0] * v[0] + v[1] * v[1]) + (v[2] * v[2] + v[3] * v[3]); }
        acc = wave_sum(acc); if (lane == 0) pm[wave] = acc;
        __syncthreads();
        if (tid == 0) { float t = 0.f; for (int q = 0; q < NWV; ++q) t += pm[q]; wss[slot] = t; }
        __syncthreads();
    }
    __syncthreads();
}
__device__ __forceinline__ float win_amax(const unsigned char* ws, int l, int lane) {
    const float* wss = (const float*)(ws + WS_CTL + CTL_WINMAX) + l * 256;
    const float t = wave_sum((wss[lane] + wss[lane + 64]) + (wss[lane + 128] + wss[lane + 192]));
    return 4.0f * sqrtf(t * (1.0f / ((float)D * (float)PROJ)));
}
__device__ __forceinline__ void phase_prologue_b(const Ctx& C) {
    const int tid = tid_l(), lane = tid & 63, wave = __builtin_amdgcn_readfirstlane(tid >> 6), gw = blockIdx.x * NWV + wave, NGW = gridDim.x * NWV;
    LAS float* scr = (LAS float*)(C.lds + wave * 16384);
    constexpr int I_IN = (D / 64) * (PROJ / 32);
    for (int it = gw; it < DEPTH * I_IN; it += NGW) {
        const int l = it / I_IN, item = it % I_IN, nblk = PROJ / 32, kb = item / nblk, nb = item % nblk, k0 = 64 * kb, n0 = 32 * nb;
        const float* W = C.p.w_in + (size_t)l * D * PROJ; signed char* WT = (signed char*)C.win + (size_t)l * PROJ * D;
        { const int nl = n0 + (lane & 31); const float am = win_amax(C.p.ws, l, lane); const float inv = am > 0.f ? 127.0f / am : 0.f;
#pragma unroll 8
          for (int i = 0; i < 32; ++i) { const int kk = 2 * i + (lane >> 5); scr[kk * 33 + (lane & 31)] = W[(size_t)(k0 + kk) * PROJ + nl] * inv; } }
        LDS_WAIT(); asm volatile("" ::: "memory");
        const int c = lane & 7;
#pragma unroll
        for (int j = 0; j < 4; ++j) { const int n = (lane >> 3) + 8 * j; const LAS float* s = scr + (8 * c) * 33 + n; unsigned lo = 0u, hi = 0u;
#pragma unroll
            for (int q = 0; q < 4; ++q) { lo |= ((unsigned)__float2int_rn(fminf(fmaxf(s[q * 33], -127.f), 127.f)) & 0xffu) << (8 * q); hi |= ((unsigned)__float2int_rn(fminf(fmaxf(s[(4 + q) * 33], -127.f), 127.f)) & 0xffu) << (8 * q); }
            *(u32x2*)(WT + (size_t)inproj_dst_row(n0 + n) * D + k0 + 8 * c) = (u32x2){lo, hi}; }
        LDS_WAIT(); asm volatile("" ::: "memory");
    }
    __syncthreads();
}
constexpr int CVT_ITEMS = 3 * NE * (D / 64) * (FF / 32);
struct CvtItem { const float* src; unsigned char* dst; int mat, n0; };
__device__ __forceinline__ CvtItem cvt_decode(const Ctx& C, int l, int it, int lane) {
    constexpr int I_E = (D / 64) * (FF / 32), NBLK = FF / 32;
    const int mat = it / (NE * I_E), e = (it / I_E) % NE, r = it % I_E, kb = r / NBLK, nb = r % NBLK, k0 = 64 * kb, n0 = 32 * nb;
    const size_t wo = ((size_t)l * NE + e) * D * FF;
    const float* W = mat == 0 ? C.p.w_gate + wo : mat == 1 ? C.p.w_up + wo : C.p.w_down + wo;
    unsigned char* wgu = C.p.ws + WS_WGU + (size_t)(l & 1) * NE * 2 * FF * D; unsigned char* wd = C.p.ws + WS_WD + (size_t)(l & 1) * NE * D * FF;
    CvtItem c; c.src = W + (size_t)(k0 + (lane >> 5)) * FF + n0 + (lane & 31); c.dst = (mat == 2 ? wd + (size_t)e * D * FF : wgu + (size_t)e * 2 * FF * D) + k0; c.mat = mat; c.n0 = n0;
    return c;
}
__device__ __forceinline__ void phase_cvt_experts(const Ctx& C, int l, int it0, int it1, int w, int nw) {
    static_assert(D == FF, "expert matrices are square");
    const int tid = tid_l(), lane = tid & 63, wave = __builtin_amdgcn_readfirstlane(tid >> 6);
    LAS float* scr = (LAS float*)(C.lds + wave * 16384);
    float ra[32], rb[32];
    auto issue = [&](float (&r)[32], const CvtItem& c) {
#pragma unroll
        for (int i = 0; i < 32; ++i) r[i] = c.src[(size_t)(2 * i) * FF]; };
    auto process = [&](float (&r)[32], const CvtItem& cur) {
#pragma unroll
        for (int i = 0; i < 32; ++i) { const int kk = 2 * i + (lane >> 5); scr[kk * 33 + (lane & 31)] = r[i] * 64.0f; }
        LDS_WAIT(); asm volatile("" ::: "memory");
        const int c = lane & 7;
#pragma unroll
        for (int j = 0; j < 4; ++j) { const int n = cur.n0 + (lane >> 3) + 8 * j; const LAS float* sp = scr + (8 * c) * 33 + (lane >> 3) + 8 * j;
            u32x2 o; o.x = pg::pk4_fp8(sp[0 * 33], sp[1 * 33], sp[2 * 33], sp[3 * 33]); o.y = pg::pk4_fp8(sp[4 * 33], sp[5 * 33], sp[6 * 33], sp[7 * 33]);
            const int drow = cur.mat == 2 ? n : (n / 128) * 256 + cur.mat * 128 + n % 128;
            *(u32x2*)(cur.dst + (size_t)drow * D + 8 * c) = o; }
        LDS_WAIT(); asm volatile("" ::: "memory"); };
    int it = it0 + w;
    CvtItem ca{}, cb{};
    if (it < it1) { ca = cvt_decode(C, l, it, lane); issue(ra, ca); }
    while (it < it1) {
        cb = cvt_decode(C, l, it + nw < it1 ? it + nw : it, lane); issue(rb, cb);
        process(ra, ca);
        it += nw; if (it >= it1) break;
        ca = cvt_decode(C, l, it + nw < it1 ? it + nw : it, lane); issue(ra, ca);
        process(rb, cb);
        it += nw;
    }
    __syncthreads();
}
__device__ __forceinline__ void yf8_add(f32x4& a, const unsigned w, const float wf) {
    const f32x2_t lo = __builtin_amdgcn_cvt_pk_f32_fp8((int)w, false), hi = __builtin_amdgcn_cvt_pk_f32_fp8((int)w, true);
    a[0] += wf * lo[0]; a[1] += wf * lo[1]; a[2] += wf * hi[0]; a[3] += wf * hi[1];
}
template <bool FINAL, bool SRCF32>
__device__ __forceinline__ void phase_rowA(const Ctx& C, int l, float gscale = 1.0f) {
    const int tid = tid_l(), lane = tid & 63, wave = __builtin_amdgcn_readfirstlane(tid >> 6), gw = blockIdx.x * NWV + wave, NGW = gridDim.x * NWV;
    const int nrows = FINAL ? RL : RALL;
    const int per = (nrows + NGW - 1) / NGW, r0 = gw * per, r1 = (r0 + per < nrows) ? r0 + per : nrows;
#define RA_LOADX(dst, row) do { if (SRCF32) { const float* _s = ((row) < RL ? C.p.x + (size_t)(row) * D : C.p.ctx + (size_t)((row) - RL) * D); _Pragma("unroll") for (int j = 0; j < 4; ++j) dst[j] = __builtin_bit_cast(u32x4, *(const f32x4*)(_s + 4 * lane + 256 * j)); } \
        else { const bf16_t* _s = C.XB + (size_t)(row) * D + 4 * lane; _Pragma("unroll") for (int j = 0; j < 4; ++j) { const u32x2 _w = *(const u32x2*)(_s + 256 * j); dst[j] = (u32x4){_w.x, _w.y, 0u, 0u}; } } } while (0)
#define RA_LOADTS(dst, row) do { dst = (l > 0 && lane < NE) ? C.tokslot[(size_t)(row) * NE + lane] : -1; } while (0)
#define RA_ISSUEY(YY, WF, MSK, ts) do { unsigned _m = (unsigned)__ballot((ts) >= 0); int _s0 = 0, _s1, _s2, _s3; WF[0] = WF[1] = WF[2] = WF[3] = 0.f; \
        if (_m) { _s0 = __builtin_amdgcn_readlane((ts), __builtin_ctz(_m)); _m &= _m - 1; WF[0] = 1.f; } _s1 = _s2 = _s3 = _s0; \
        if (_m) { _s1 = __builtin_amdgcn_readlane((ts), __builtin_ctz(_m)); _m &= _m - 1; WF[1] = 1.f; } \
        if (_m) { _s2 = __builtin_amdgcn_readlane((ts), __builtin_ctz(_m)); _m &= _m - 1; WF[2] = 1.f; } \
        if (_m) { _s3 = __builtin_amdgcn_readlane((ts), __builtin_ctz(_m)); _m &= _m - 1; WF[3] = 1.f; } MSK = _m; \
        _Pragma("unroll") for (int j = 0; j < 4; ++j) { YY[0][j] = *(const unsigned*)(Yb + (size_t)_s0 * D + 4 * lane + 256 * j); YY[1][j] = *(const unsigned*)(Yb + (size_t)_s1 * D + 4 * lane + 256 * j); \
            YY[2][j] = *(const unsigned*)(Yb + (size_t)_s2 * D + 4 * lane + 256 * j); YY[3][j] = *(const unsigned*)(Yb + (size_t)_s3 * D + 4 * lane + 256 * j); } } while (0)
    const unsigned char* Yb = (const unsigned char*)C.Y;
    u32x4 xc[4], xn[4], x2[4]; int tsc = -1, tsn = -1, ts2 = -1; unsigned yc[4][4], yn[4][4]; float wc_[4], wn_[4]; unsigned mc = 0u, mn = 0u;
    f32x4 A[4], S[4], G[4]; int bcur = -1;
#pragma unroll
    for (int j = 0; j < 4; ++j) { xc[j] = xn[j] = x2[j] = (u32x4){0u, 0u, 0u, 0u}; A[j] = S[j] = G[j] = (f32x4){0.f, 0.f, 0.f, 0.f}; }
#pragma unroll
    for (int i = 0; i < 4; ++i) { wc_[i] = wn_[i] = 0.f;
#pragma unroll
        for (int j = 0; j < 4; ++j) yc[i][j] = yn[i][j] = 0u; }
    if (r0 < r1) { RA_LOADTS(tsc, r0); RA_LOADX(xc, r0); if (l > 0) RA_ISSUEY(yc, wc_, mc, tsc); }
    if (r0 + 1 < r1) { RA_LOADTS(tsn, r0 + 1); RA_LOADX(xn, r0 + 1); }
    for (int row = r0; row < r1; ++row) {
        if (l > 0 && row + 1 < r1) RA_ISSUEY(yn, wn_, mn, tsn);
        if (row + 2 < r1) { RA_LOADTS(ts2, row + 2); RA_LOADX(x2, row + 2); }
        const int b = row_batch(row);
        if (b != bcur) { bcur = b;
            if (FINAL) {
#pragma unroll
                for (int j = 0; j < 4; ++j) A[j] = *(const f32x4*)(C.p.norm_final + 4 * lane + 256 * j);
            } else { const float* m = C.mod + ((size_t)l * (NB + 1) + b) * 6 * D + 4 * lane; const float* nw = C.p.norm1 + (size_t)l * D + 4 * lane;
#pragma unroll
                for (int j = 0; j < 4; ++j) { A[j] = *(const f32x4*)(nw + 256 * j) * (*(const f32x4*)(m + M_SC1 + 256 * j) + 1.0f); S[j] = *(const f32x4*)(m + M_SH1 + 256 * j); } }
            if (l > 0) { const float* g2 = C.mod + ((size_t)(l - 1) * (NB + 1) + b) * 6 * D + M_G2 + 4 * lane;
#pragma unroll
                for (int j = 0; j < 4; ++j) G[j] = *(const f32x4*)(g2 + 256 * j) * (gscale * (1.0f / 64.0f)); } }
        f32x4 v[4];
#pragma unroll
        for (int j = 0; j < 4; ++j) { if (SRCF32) v[j] = __builtin_bit_cast(f32x4, xc[j]); else { const unsigned w0 = xc[j][0], w1 = xc[j][1];
            v[j] = (f32x4){__builtin_bit_cast(float, w0 << 16), __builtin_bit_cast(float, w0 & 0xffff0000u), __builtin_bit_cast(float, w1 << 16), __builtin_bit_cast(float, w1 & 0xffff0000u)}; } }
        if (l > 0) {
            f32x4 a[4];
#pragma unroll
            for (int j = 0; j < 4; ++j) { a[j] = (f32x4){0.f, 0.f, 0.f, 0.f};
#pragma unroll
                for (int i = 0; i < 4; ++i) yf8_add(a[j], yc[i][j], wc_[i]); }
            while (mc) { const int s = __builtin_amdgcn_readlane(tsc, __builtin_ctz(mc)); mc &= mc - 1;
#pragma unroll
                for (int j = 0; j < 4; ++j) yf8_add(a[j], *(const unsigned*)(Yb + (size_t)s * D + 4 * lane + 256 * j), 1.0f); }
#pragma unroll
            for (int j = 0; j < 4; ++j) v[j] = v[j] + G[j] * a[j];
        }
        float ss = 0.f;
#pragma unroll
        for (int j = 0; j < 4; ++j) ss += (v[j][0] * v[j][0] + v[j][1] * v[j][1]) + (v[j][2] * v[j][2] + v[j][3] * v[j][3]);
        const float rstd = 1.0f / sqrtf(wave_sum(ss) * (1.0f / D) + EPS);
        if (FINAL) {
            float* dst = C.p.out + (size_t)row * D;
#pragma unroll
            for (int j = 0; j < 4; ++j) *(f32x4*)(dst + 4 * lane + 256 * j) = v[j] * rstd * A[j];
        } else {
            bf16_t* xo = C.XB + (size_t)row * D + 4 * lane;
#pragma unroll
            for (int j = 0; j < 4; ++j) { u32x2 w; w.x = cvt_pk_bf16(v[j][0], v[j][1]); w.y = cvt_pk_bf16(v[j][2], v[j][3]); *(u32x2*)(xo + 256 * j) = w; }
            f32x4 hq[4]; float am = 0.f;
#pragma unroll
            for (int j = 0; j < 4; ++j) { hq[j] = v[j] * rstd * A[j] + S[j]; am = fmaxf(fmaxf(am, fmaxf(fabsf(hq[j][0]), fabsf(hq[j][1]))), fmaxf(fabsf(hq[j][2]), fabsf(hq[j][3]))); }
            am = wave_max(am); const float inv = am > 0.f ? 127.0f / am : 0.f;
            if (lane == 0) ((float*)(C.p.ws + WS_HXS))[row] = am * (1.0f / 127.0f);
            unsigned char* hr = (unsigned char*)C.HX + (size_t)row * D + 4 * lane;
#pragma unroll
            for (int j = 0; j < 4; ++j) { const unsigned w = ((unsigned)__float2int_rn(fminf(fmaxf(hq[j][0] * inv, -127.f), 127.f)) & 0xffu) | (((unsigned)__float2int_rn(fminf(fmaxf(hq[j][1] * inv, -127.f), 127.f)) & 0xffu) << 8) | (((unsigned)__float2int_rn(fminf(fmaxf(hq[j][2] * inv, -127.f), 127.f)) & 0xffu) << 16) | (((unsigned)__float2int_rn(fminf(fmaxf(hq[j][3] * inv, -127.f), 127.f)) & 0xffu) << 24);
                *(unsigned*)(hr + 256 * j) = w; }
        }
        tsc = tsn; tsn = ts2; mc = mn;
#pragma unroll
        for (int j = 0; j < 4; ++j) { xc[j] = xn[j]; xn[j] = x2[j]; }
#pragma unroll
        for (int i = 0; i < 4; ++i) { wc_[i] = wn_[i];
#pragma unroll
            for (int j = 0; j < 4; ++j) yc[i][j] = yn[i][j]; }
    }
#undef RA_LOADX
#undef RA_LOADTS
#undef RA_ISSUEY
}
__device__ __forceinline__ void phase_rowB(const Ctx& C, int l, int nq) {
    const int tid = tid_l(), lane = tid & 63, wave = __builtin_amdgcn_readfirstlane(tid >> 6), gw = blockIdx.x * NWV + wave, NGW = gridDim.x * NWV;
    LAS float* R = (LAS float*)C.lds;
    const float* rt = C.p.router + (size_t)l * D * NE;
    for (int i = tid; i < D * NE; i += NT) R[(i % NE) * D + i / NE] = rt[i];
    __syncthreads();
    const int per = (nq + NGW - 1) / NGW, r0 = gw * per, r1 = (r0 + per < nq) ? r0 + per : nq;
    f32x4 xn[4], A[4], S[4]; int bcur = -1; int row = r0;
    u32x2 xr_[4];
    if (row < r1) { const bf16_t* s = C.XB + (size_t)row * D + 4 * lane;
#pragma unroll
        for (int j = 0; j < 4; ++j) xr_[j] = *(const u32x2*)(s + 256 * j); }
    for (; row < r1; ++row) {
        f32x4 v[4]; float ss = 0.f;
#pragma unroll
        for (int j = 0; j < 4; ++j) xn[j] = (f32x4){__builtin_bit_cast(float, xr_[j].x << 16), __builtin_bit_cast(float, xr_[j].x & 0xffff0000u), __builtin_bit_cast(float, xr_[j].y << 16), __builtin_bit_cast(float, xr_[j].y & 0xffff0000u)};
        const int b = row_batch(row);
        if (b != bcur) { bcur = b; const float* m = C.mod + ((size_t)l * (NB + 1) + b) * 6 * D + 4 * lane; const float* nw = C.p.norm2 + (size_t)l * D + 4 * lane;
#pragma unroll
            for (int j = 0; j < 4; ++j) { A[j] = *(const f32x4*)(nw + 256 * j) * (*(const f32x4*)(m + M_SC2 + 256 * j) + 1.0f); S[j] = *(const f32x4*)(m + M_SH2 + 256 * j); } }
#pragma unroll
        for (int j = 0; j < 4; ++j) { v[j] = xn[j]; ss += (v[j][0] * v[j][0] + v[j][1] * v[j][1]) + (v[j][2] * v[j][2] + v[j][3] * v[j][3]); }
        if (row + 1 < r1) { const bf16_t* s = C.XB + (size_t)(row + 1) * D + 4 * lane;
#pragma unroll
            for (int j = 0; j < 4; ++j) xr_[j] = *(const u32x2*)(s + 256 * j); }
        const float rstd = 1.0f / sqrtf(wave_sum(ss) * (1.0f / D) + EPS);
        unsigned char* hr = (unsigned char*)C.HX2 + (size_t)row * D + 4 * lane;
#pragma unroll
        for (int j = 0; j < 4; ++j) { v[j] = v[j] * rstd * A[j] + S[j]; *(unsigned*)(hr + 256 * j) = pg::pk4_fp8(v[j][0], v[j][1], v[j][2], v[j][3]); }
        float p[NE];
        { f32x2_t q[NE];
#pragma unroll
          for (int e = 0; e < NE; ++e) q[e] = (f32x2_t){0.f, 0.f};
          f32x4 ra_[8], rb_[8]; const unsigned rbase = (unsigned)(size_t)(R + 4 * lane);
          LDS_ISSUE8_B128(ra_, rbase, D * 4);
#pragma unroll
          for (int k = 0; k < 8; k += 2) {
              const f32x2_t vlo = (f32x2_t){v[k >> 1][0], v[k >> 1][1]}, vhi = (f32x2_t){v[k >> 1][2], v[k >> 1][3]};
              LDS_ISSUE8_B128(rb_, rbase + (unsigned)((8 * D + 256 * (k >> 1)) * 4), D * 4); LDS_WAIT8(ra_, 8);
#pragma unroll
              for (int e = 0; e < 8; ++e) q[e] = __builtin_elementwise_fma(vlo, (f32x2_t){ra_[e][0], ra_[e][1]}, q[e]);
#pragma unroll
              for (int e = 0; e < 8; ++e) q[e] = __builtin_elementwise_fma(vhi, (f32x2_t){ra_[e][2], ra_[e][3]}, q[e]);
              if (k + 2 < 8) { LDS_ISSUE8_B128(ra_, rbase + (unsigned)(256 * ((k >> 1) + 1) * 4), D * 4); LDS_WAIT8(rb_, 8); } else { LDS_WAIT8(rb_, 0); }
#pragma unroll
              for (int e = 0; e < 8; ++e) q[8 + e] = __builtin_elementwise_fma(vlo, (f32x2_t){rb_[e][0], rb_[e][1]}, q[8 + e]);
#pragma unroll
              for (int e = 0; e < 8; ++e) q[8 + e] = __builtin_elementwise_fma(vhi, (f32x2_t){rb_[e][2], rb_[e][3]}, q[8 + e]);
          }
#pragma unroll
          for (int e = 0; e < NE; ++e) p[e] = q[e][0] + q[e][1]; }
#pragma unroll
        for (int j = 0; j < 8; ++j) { auto rr = __builtin_amdgcn_permlane32_swap(__float_as_uint(p[j]), __float_as_uint(p[j + 8]), false, false); p[j] = __uint_as_float(rr[0]) + __uint_as_float(rr[1]); }
#pragma unroll
        for (int j = 0; j < 4; ++j) { auto rr = __builtin_amdgcn_permlane16_swap(__float_as_uint(p[j]), __float_as_uint(p[j + 4]), false, false); p[j] = __uint_as_float(rr[0]) + __uint_as_float(rr[1]); }
#pragma unroll
        for (int j = 0; j < 2; ++j) { const float a = p[j] + dpp_f(p[j], 3), b2 = p[j + 2] + dpp_f(p[j + 2], 3); p[j] = (lane & 8) ? b2 : a; }
        float lg; { const float a = p[0] + dpp_f(p[0], 2), b2 = p[1] + dpp_f(p[1], 2); lg = (lane & 4) ? b2 : a; }
        lg += dpp_f(lg, 1); lg += dpp_f(lg, 0);
        const float mx = wave_max(lg);
        const float ex = expf(lg - mx); const float se = wave_sum(ex) * 0.25f;
        const int e = ((lane >> 5) & 1) * 8 + ((lane >> 4) & 1) * 4 + ((lane >> 3) & 1) * 2 + ((lane >> 2) & 1);
        if ((lane & 3) == 0) C.aff[(size_t)row * NE + e] = ex / se;
    }
    __syncthreads();
}
template <int NV>
__device__ __forceinline__ void select_task(const Ctx& C, int base_row, int cap, int e, int slot0, int lane) {
    unsigned v[NV];
#pragma unroll
    for (int i = 0; i < NV; ++i) v[i] = __builtin_bit_cast(unsigned, C.aff[(size_t)(base_row + i * 64 + lane) * NE + e]);
    unsigned T = 0u;
    for (int bit = 30; bit >= 0; --bit) { const unsigned cand = T | (1u << bit); int cnt = 0;
#pragma unroll
        for (int i = 0; i < NV; ++i) cnt += __builtin_popcountll(__ballot(v[i] >= cand));
        if (cnt >= cap) T = cand; }
    int ngt = 0;
#pragma unroll
    for (int i = 0; i < NV; ++i) ngt += __builtin_popcountll(__ballot(v[i] > T));
    const int need = cap - ngt;
    const unsigned long long lt = (1ull << lane) - 1ull; int nsel = 0, neq = 0;
#pragma unroll
    for (int i = 0; i < NV; ++i) {
        const bool gt = v[i] > T, eq = v[i] == T; const unsigned long long meq = __ballot(eq);
        const bool take = gt || (eq && (neq + __builtin_popcountll(meq & lt)) < need);
        const unsigned long long msel = __ballot(take);
        const int row = base_row + i * 64 + lane; int slot = -1;
        if (take) { slot = slot0 + nsel + __builtin_popcountll(msel & lt); C.sel[slot] = row; C.gate[slot] = __builtin_bit_cast(float, v[i]); }
        C.tokslot[(size_t)row * NE + e] = slot;
        nsel += __builtin_popcountll(msel); neq += __builtin_popcountll(meq);
    }
}
__device__ __forceinline__ void phase_select(const Ctx& C, bool need_ctx) {
    const int tid = tid_l(), lane = tid & 63, wave = __builtin_amdgcn_readfirstlane(tid >> 6), gw = blockIdx.x * NWV + wave, NGW = gridDim.x * NWV; (void)lane; (void)gw; (void)NGW;
    const int ntask = NB * NE * (need_ctx ? 2 : 1);
    for (int task = wave * (int)gridDim.x + (int)blockIdx.x; task < ntask; task += NGW) {
        const int set = task / (NB * NE), b = (task / NE) % NB, e = task % NE;
        if (set == 0) select_task<SEQ / 64>(C, b * SEQ, CAPL, e, e * SLOTS_E + b * CAPL, lane);
        else select_task<CTX / 64>(C, RL + b * CTX, CAPC, e, e * SLOTS_E + SLOTS_L + b * CAPC, lane);
    }
}
namespace att {
typedef float f32x16 __attribute__((ext_vector_type(16)));
typedef short v4i16_t __attribute__((ext_vector_type(4)));
typedef __bf16 bf16x2_t __attribute__((ext_vector_type(2)));
constexpr int KSTR = 144, VSTR = 192, TILE_B = 64 * KSTR, BUF_B = TILE_B + 64 * VSTR;
constexpr float THR = 8.0f, THR_LO = 32.0f;
__device__ __forceinline__ unsigned pk2(float a, float b) { bf16x2_t v = {(__bf16)a, (__bf16)b}; return __builtin_bit_cast(unsigned, v); }
__device__ __forceinline__ float xmax32(float x) { auto rr = __builtin_amdgcn_permlane32_swap(__float_as_uint(x), __float_as_uint(x), false, false); return fmaxf(__uint_as_float(rr[0]), __uint_as_float(rr[1])); }
__device__ __forceinline__ float xsum32(float x) { auto rr = __builtin_amdgcn_permlane32_swap(__float_as_uint(x), __float_as_uint(x), false, false); return __uint_as_float(rr[0]) + __uint_as_float(rr[1]); }
__device__ __forceinline__ int crow(int reg, int h) { return (reg & 3) + 8 * (reg >> 2) + 4 * h; }
#ifndef PROBE_ATT
#define PROBE_ATT 0
#endif
#define MFMA32(a, b, c) __builtin_amdgcn_mfma_f32_32x32x16_bf16((a), (b), (c), 0, 0, 0)
__device__ __forceinline__ void store_pair16(bf16_t* rowp, u32x2 a, u32x2 b, int h) {
    auto rx = __builtin_amdgcn_permlane32_swap(a.x, b.x, false, false); auto ry = __builtin_amdgcn_permlane32_swap(a.y, b.y, false, false);
    u32x4 w; w.x = rx[0]; w.y = ry[0]; w.z = rx[1]; w.w = ry[1];
    *(u32x4*)(rowp + 8 * h) = w;
}
__device__ __forceinline__ bf16x8 ones_rows(int lane) { const unsigned v = (lane == 0 || lane == 32 || lane == 17 || lane == 49) ? 0x3F803F80u : 0u; u32x4 w; w.x = v; w.y = v; w.z = v; w.w = v; return __builtin_bit_cast(bf16x8, w); }
__device__ __forceinline__ float rowsum(const f32x4& L, int lane) { const float a = __shfl(L[0], lane & 15), b = __shfl(L[1], lane & 15); return (lane & 16) ? b : a; }

#define ATT_VTR(n, ks, hi, db) "ds_read_b64_tr_b16 %" #n ", %16 offset:" #ks "*3072+" #hi "*1536+" #db "*64\n\t"
template <int DKS, bool WAIT>
__device__ __forceinline__ void katt_read(unsigned kb_, bf16x8 (&Kf)[8], int lane) {
    const int r = lane & 31, h = lane >> 5;
    const unsigned ka = kb_ + r * KSTR + 16 * h;
    constexpr int o1 = 32, o2 = (DKS == 4) ? 64 : 32 * KSTR, o3 = (DKS == 4) ? 96 : 32 * KSTR + 32, o4 = (DKS == 4) ? 32 * KSTR : 64, o5 = (DKS == 4) ? 32 * KSTR + 32 : 96,
                  o6 = 32 * KSTR + 64, o7 = 32 * KSTR + 96;
    if constexpr (WAIT)
        asm volatile("ds_read_b128 %0, %8\n\tds_read_b128 %1, %8 offset:%c9\n\tds_read_b128 %2, %8 offset:%c10\n\tds_read_b128 %3, %8 offset:%c11\n\t"
                     "ds_read_b128 %4, %8 offset:%c12\n\tds_read_b128 %5, %8 offset:%c13\n\tds_read_b128 %6, %8 offset:%c14\n\tds_read_b128 %7, %8 offset:%c15\n\ts_waitcnt lgkmcnt(0)"
                     : "=&v"(Kf[0]), "=&v"(Kf[1]), "=&v"(Kf[2]), "=&v"(Kf[3]), "=&v"(Kf[4]), "=&v"(Kf[5]), "=&v"(Kf[6]), "=&v"(Kf[7])
                     : "v"(ka), "i"(o1), "i"(o2), "i"(o3), "i"(o4), "i"(o5), "i"(o6), "i"(o7) : "memory");
    else
        asm volatile("ds_read_b128 %0, %8\n\tds_read_b128 %1, %8 offset:%c9\n\tds_read_b128 %2, %8 offset:%c10\n\tds_read_b128 %3, %8 offset:%c11\n\t"
                     "ds_read_b128 %4, %8 offset:%c12\n\tds_read_b128 %5, %8 offset:%c13\n\tds_read_b128 %6, %8 offset:%c14\n\tds_read_b128 %7, %8 offset:%c15"
                     : "=&v"(Kf[0]), "=&v"(Kf[1]), "=&v"(Kf[2]), "=&v"(Kf[3]), "=&v"(Kf[4]), "=&v"(Kf[5]), "=&v"(Kf[6]), "=&v"(Kf[7])
                     : "v"(ka), "i"(o1), "i"(o2), "i"(o3), "i"(o4), "i"(o5), "i"(o6), "i"(o7) : "memory");
}
__device__ __forceinline__ void katt_wait(bf16x8 (&Kf)[8]) {
    asm volatile("s_waitcnt lgkmcnt(0)" : "+v"(Kf[0]), "+v"(Kf[1]), "+v"(Kf[2]), "+v"(Kf[3]), "+v"(Kf[4]), "+v"(Kf[5]), "+v"(Kf[6]), "+v"(Kf[7]) :: "memory");
}
template <int NSUB, int DKS>
__device__ __forceinline__ void flash_tile(unsigned vb_, unsigned kn_, bool has_next, const bf16x8 (&Q)[NSUB][DKS], f32x16 (&O)[NSUB][2], float (&m)[NSUB], f32x4 (&L)[NSUB], const bf16x8& onesA,
                                           bf16x8 (&Kf)[8], int lane, bool masked, int dq, bool first) {
    static_assert(NSUB * DKS == 4, "eight K fragments per tile");
    const int r = lane & 31, h = lane >> 5; (void)r;
    f32x16 S[NSUB][2];
    bool allz = true;
#pragma unroll
    for (int sub = 0; sub < NSUB; ++sub) allz = allz && __all(m[sub] == 0.f);
    if (allz) {
#pragma unroll
        for (int sub = 0; sub < NSUB; ++sub)
#pragma unroll
            for (int kb = 0; kb < 2; ++kb) {
                const f32x16 zero = {0.f, 0.f, 0.f, 0.f, 0.f, 0.f, 0.f, 0.f, 0.f, 0.f, 0.f, 0.f, 0.f, 0.f, 0.f, 0.f};
                S[sub][kb] = MFMA32(Kf[(DKS == 4) ? (kb * 4) : (kb * 2 + 4 * sub)], Q[sub][0], zero);
#pragma unroll
                for (int s = 1; s < DKS; ++s) S[sub][kb] = MFMA32(Kf[(DKS == 4) ? (kb * 4 + s) : (kb * 2 + s + 4 * sub)], Q[sub][s], S[sub][kb]);
            }
    } else {
#pragma unroll
        for (int sub = 0; sub < NSUB; ++sub)
#pragma unroll
            for (int kb = 0; kb < 2; ++kb) {
#pragma unroll
                for (int i = 0; i < 16; ++i) S[sub][kb][i] = -m[sub];
#pragma unroll
                for (int s = 0; s < DKS; ++s) S[sub][kb] = MFMA32(Kf[(DKS == 4) ? (kb * 4 + s) : (kb * 2 + s + 4 * sub)], Q[sub][s], S[sub][kb]);
            }
    }
#pragma unroll
    for (int sub = 0; sub < NSUB; ++sub) asm volatile("" : "+v"(S[sub][0]), "+v"(S[sub][1]));
    v4i16_t Vr[16];
    { const int i16 = lane & 15, q = i16 >> 2, p = i16 & 3, rblk = (lane >> 4) & 1; const unsigned va = vb_ + (4 * h + q) * VSTR + (16 * rblk + 4 * p) * 2;
      asm volatile(ATT_VTR(0, 0, 0, 0) ATT_VTR(1, 0, 1, 0) ATT_VTR(2, 0, 0, 1) ATT_VTR(3, 0, 1, 1) ATT_VTR(4, 1, 0, 0) ATT_VTR(5, 1, 1, 0) ATT_VTR(6, 1, 0, 1) ATT_VTR(7, 1, 1, 1)
                   ATT_VTR(8, 2, 0, 0) ATT_VTR(9, 2, 1, 0) ATT_VTR(10, 2, 0, 1) ATT_VTR(11, 2, 1, 1) ATT_VTR(12, 3, 0, 0) ATT_VTR(13, 3, 1, 0) ATT_VTR(14, 3, 0, 1) ATT_VTR(15, 3, 1, 1)
                   : "=&v"(Vr[0]), "=&v"(Vr[1]), "=&v"(Vr[2]), "=&v"(Vr[3]), "=&v"(Vr[4]), "=&v"(Vr[5]), "=&v"(Vr[6]), "=&v"(Vr[7]),
                     "=&v"(Vr[8]), "=&v"(Vr[9]), "=&v"(Vr[10]), "=&v"(Vr[11]), "=&v"(Vr[12]), "=&v"(Vr[13]), "=&v"(Vr[14]), "=&v"(Vr[15])
                   : "v"(va) : "memory"); }
#pragma unroll
    for (int sub = 0; sub < NSUB; ++sub) {
        if (masked) {
#pragma unroll
            for (int kb = 0; kb < 2; ++kb)
#pragma unroll
                for (int i = 0; i < 16; ++i) { const int dl = dq - (32 * kb + crow(i, h)); S[sub][kb][i] = (dl > WINDOW || dl < -WINDOW) ? -1e30f : S[sub][kb][i]; }
        }
        float mx = S[sub][0][0];
#pragma unroll
        for (int i = 1; i < 16; ++i) mx = fmaxf(mx, S[sub][0][i]);
#pragma unroll
        for (int i = 0; i < 16; ++i) mx = fmaxf(mx, S[sub][1][i]);
        mx = xmax32(mx);
        if (!__all(mx <= THR) || (first && !__all(mx >= -THR_LO))) {
            const float up = first ? mx : fmaxf(mx, 0.f), alpha = first ? 1.0f : __builtin_amdgcn_exp2f(-up); m[sub] += up;
            L[sub][0] *= alpha; L[sub][1] *= __shfl(alpha, (lane & 15) + 16);
#pragma unroll
            for (int kb = 0; kb < 2; ++kb)
#pragma unroll
                for (int i = 0; i < 16; ++i) S[sub][kb][i] -= up;
#pragma unroll
            for (int db = 0; db < 2; ++db)
#pragma unroll
                for (int i = 0; i < 16; ++i) O[sub][db][i] *= alpha;
        }
#pragma unroll
        for (int kb = 0; kb < 2; ++kb)
#pragma unroll
            for (int i = 0; i < 16; ++i) S[sub][kb][i] = __builtin_amdgcn_exp2f(S[sub][kb][i]);
        bf16x8 Pf[4];
#pragma unroll
        for (int kb = 0; kb < 2; ++kb)
#pragma unroll
            for (int s = 0; s < 2; ++s) { u32x4 w; w.x = pk2(S[sub][kb][8 * s + 0], S[sub][kb][8 * s + 1]); w.y = pk2(S[sub][kb][8 * s + 2], S[sub][kb][8 * s + 3]);
                w.z = pk2(S[sub][kb][8 * s + 4], S[sub][kb][8 * s + 5]); w.w = pk2(S[sub][kb][8 * s + 6], S[sub][kb][8 * s + 7]); Pf[2 * kb + s] = __builtin_bit_cast(bf16x8, w); }
        if (sub == 0) {
            asm volatile("s_waitcnt lgkmcnt(0)" : "+v"(Vr[0]), "+v"(Vr[1]), "+v"(Vr[2]), "+v"(Vr[3]), "+v"(Vr[4]), "+v"(Vr[5]), "+v"(Vr[6]), "+v"(Vr[7]) :: "memory");
            asm volatile("" : "+v"(Vr[8]), "+v"(Vr[9]), "+v"(Vr[10]), "+v"(Vr[11]), "+v"(Vr[12]), "+v"(Vr[13]), "+v"(Vr[14]), "+v"(Vr[15]) :: "memory");
        }
        if (sub == NSUB - 1 && has_next) katt_read<DKS, false>(kn_, Kf, lane);
#pragma unroll
        for (int ks = 0; ks < 4; ++ks) {
#pragma unroll
            for (int db = 0; db < 2; ++db) {
                const bf16x8 vf = __builtin_shufflevector(Vr[(ks * 2 + db) * 2], Vr[(ks * 2 + db) * 2 + 1], 0, 1, 2, 3, 4, 5, 6, 7);
                O[sub][db] = MFMA32(vf, Pf[ks], O[sub][db]);
            }
            L[sub] = __builtin_amdgcn_mfma_f32_16x16x32_bf16(onesA, Pf[ks], L[sub], 0, 0, 0);
        }
#pragma unroll
        for (int db = 0; db < 2; ++db) asm volatile("" : "+v"(O[sub][db]));
    }
    if (has_next) katt_wait(Kf);
}
#define ATT_STG_LOAD2(krow0, KR, VR) do { const bf16_t* _p = C.P + (size_t)((krow0) + skey) * PROJ + 8 * schunk; KR = *(const u32x4*)(_p + kcol); VR = *(const u32x4*)(_p + vcol); } while (0)
#define ATT_STG_STORE2(buf, KR, VR) do { LAS unsigned char* _d = C.lds + (buf) * BUF_B + skey * KSTR + schunk * 16; *(LAS u32x4*)_d = KR; *(LAS u32x4*)(_d + TILE_B + skey * (VSTR - KSTR)) = VR; } while (0)
#define ATT_STG_LOAD(krow0) ATT_STG_LOAD2(krow0, kreg, vreg)
#define ATT_STG_STORE(buf) ATT_STG_STORE2(buf, kreg, vreg)
#define ATT_STG_STOREB(off) do { LAS unsigned char* _d = C.lds + (off) + skey * KSTR + schunk * 16; *(LAS u32x4*)_d = kreg; *(LAS u32x4*)(_d + TILE_B + skey * (VSTR - KSTR)) = vreg; } while (0)
#define ATT_PROLOGUE(DKS_) do { { u32x4 kreg2, vreg2; ATT_STG_LOAD(ATT_TROW(0)); ATT_STG_LOAD2(ATT_TROW(1), kreg2, vreg2); ATT_STG_STORE(0); ATT_STG_STORE2(1, kreg2, vreg2); } \
    if (nt > 2) ATT_STG_LOAD(ATT_TROW(2)); __syncthreads(); katt_read<DKS_, true>((unsigned)(size_t)C.lds, Kf, lane); } while (0)

struct AUnit { int b, kvh, qb, jlo, nt, kcol, vcol; bool lat; };
__device__ __forceinline__ AUnit attnA_decode(int u) {
    constexpr int NUL = NB * NKVA * (SEQ / 64);
    AUnit U; U.lat = u < NUL; const int uu = U.lat ? u : u - NUL; const int nqb = U.lat ? SEQ / 64 : CTX / 64;
    U.b = uu / (NKVA * nqb); U.kvh = (uu / nqb) % NKVA; U.qb = uu % nqb;
    U.kcol = C_KA + U.kvh * HDIM; U.vcol = C_VA + U.kvh * HDIM;
    U.jlo = U.lat ? (2 - U.qb > 0 ? 2 - U.qb : 0) : 0; const int jhi = U.lat ? (33 - U.qb < 4 ? 33 - U.qb : 4) : -1;
    U.nt = CTX / 64 + (jhi - U.jlo + 1);
    return U;
}
__device__ __forceinline__ int attnA_trow(const AUnit& U, int i) { return i < CTX / 64 ? RL + U.b * CTX + 64 * i : U.b * SEQ + 64 * U.qb - 128 + 64 * (U.jlo + i - CTX / 64); }
__device__ __forceinline__ void phase_attnA(const Ctx& C, int l, bool need_ctx) {
    const int tid = tid_l(), lane = tid & 63, wave = __builtin_amdgcn_readfirstlane(tid >> 6), skey = tid >> 3, schunk = tid & 7;
    const int r = lane & 31, h = lane >> 5, hq = wave & 3, ph = wave >> 2;
    const bf16x8 onesA = ones_rows(lane);
    constexpr int NUL = NB * NKVA * (SEQ / 64), NUC = NB * NKVA * (CTX / 64);
    const int nu = NUL + (need_ctx ? NUC : 0);
    int u = blockIdx.x;
    if (u >= nu) return;
    AUnit cu = attnA_decode(u);
#define ATT_QROW(U) (((U).lat ? (U).b * SEQ : RL + (U).b * CTX) + 64 * (U).qb + 32 * ph + r)
#define ATT_LOADQ(QQ, U) do { const bf16_t* _q = C.P + (size_t)ATT_QROW(U) * PROJ + C_QA + ((U).kvh * GQA + hq) * HDIM + 8 * h; _Pragma("unroll") for (int s = 0; s < 4; ++s) QQ[0][s] = *(const bf16x8*)(_q + 16 * s); } while (0)
#define ATT_LOADKV(U, i) do { const bf16_t* _p = C.P + (size_t)(attnA_trow(U, i) + skey) * PROJ + 8 * schunk; kreg = *(const u32x4*)(_p + (U).kcol); vreg = *(const u32x4*)(_p + (U).vcol); } while (0)
    bf16x8 Q[1][4], Qn[1][4];
    ATT_LOADQ(Q, cu);
#pragma unroll
    for (int s = 0; s < 4; ++s) Qn[0][s] = Q[0][s];
    u32x4 kreg, vreg; bf16x8 Kf[8];
    { u32x4 kreg2, vreg2; ATT_LOADKV(cu, 0); { const bf16_t* _p = C.P + (size_t)(attnA_trow(cu, 1) + skey) * PROJ + 8 * schunk; kreg2 = *(const u32x4*)(_p + cu.kcol); vreg2 = *(const u32x4*)(_p + cu.vcol); }
      ATT_STG_STORE(0); ATT_STG_STORE2(1, kreg2, vreg2); }
    ATT_LOADKV(cu, 2); __syncthreads(); katt_read<4, true>((unsigned)(size_t)C.lds, Kf, lane);
    int s0 = 0, s1 = BUF_B, s2 = 2 * BUF_B;
    for (;;) {
        const int un = u + (int)gridDim.x; const bool hn = un < nu; const AUnit nx = attnA_decode(hn ? un : u);
        const int head = cu.kvh * GQA + hq, q0 = 64 * cu.qb + 32 * ph, qrow = ATT_QROW(cu), nt = cu.nt;
        f32x16 O[1][2]; float m[1]; f32x4 L[1];
#pragma unroll
        for (int db = 0; db < 2; ++db)
#pragma unroll
            for (int i = 0; i < 16; ++i) O[0][db][i] = 0.f;
        m[0] = 0.f; L[0] = f32x4{0.f, 0.f, 0.f, 0.f};
        for (int i = 0; i < nt; ++i) {
            if (i + 2 < nt || hn) ATT_STG_STOREB(s2);
            if (i + 3 < nt) ATT_LOADKV(cu, i + 3); else if (hn) ATT_LOADKV(nx, i + 3 - nt);
            if (i == nt - 1 && hn) ATT_LOADQ(Qn, nx);
            const bool loc = i >= CTX / 64; const int d = loc ? q0 - (64 * cu.qb - 128 + 64 * (cu.jlo + i - CTX / 64)) : 0;
            const bool masked = loc && (d > 97 || d < -65);
            const unsigned lb = (unsigned)(size_t)C.lds;
            flash_tile<1, 4>(lb + s0 + TILE_B, lb + s1, i + 1 < nt || hn, Q, O, m, L, onesA, Kf, lane, masked, d + r, i == 0);
            __syncthreads();
            { const int t = s0; s0 = s1; s1 = s2; s2 = t; }
        }
        const float inv = 1.0f / (rowsum(L[0], lane) + __builtin_amdgcn_exp2f(C.p.attn_sink[l * NHA + head] * LOG2E - m[0]));
        bf16_t* op = C.MIX + (size_t)qrow * D + head * HDIM;
#pragma unroll
        for (int db = 0; db < 2; ++db)
#pragma unroll
            for (int g = 0; g < 4; g += 2) { u32x2 w[2];
#pragma unroll
                for (int q = 0; q < 2; ++q) { w[q].x = pk2(O[0][db][4 * (g + q)] * inv, O[0][db][4 * (g + q) + 1] * inv); w[q].y = pk2(O[0][db][4 * (g + q) + 2] * inv, O[0][db][4 * (g + q) + 3] * inv); }
                store_pair16(op + 32 * db + 8 * g, w[0], w[1], h); }
        if (!hn) break;
#pragma unroll
        for (int s = 0; s < 4; ++s) Q[0][s] = Qn[0][s];
        cu = nx; u = un;
    }
#undef ATT_QROW
#undef ATT_LOADQ
#undef ATT_LOADKV
}
__device__ __forceinline__ void phase_attnD(const Ctx& C, int l, bool need_ctx) {
    const int tid = tid_l(), lane = tid & 63, wave = __builtin_amdgcn_readfirstlane(tid >> 6), skey = tid >> 3, schunk = tid & 7;
    const int r = lane & 31, h = lane >> 5;
    const bf16x8 onesA = ones_rows(lane);
    const float lam_init = 0.8f - 0.6f * expf(-0.3f * (float)l);
    float lam;
    { const float* lp = C.p.diff_lambda + l * 4 * DD; const float a = lane < DD ? lp[lane] * lp[DD + lane] : 0.f, b2 = lane < DD ? lp[2 * DD + lane] * lp[3 * DD + lane] : 0.f;
      lam = expf(wave_sum(a)) - expf(wave_sum(b2)) + lam_init; }
    constexpr int NUL = NB * NHC * (SEQ / 256), NUC = NB * NHC * (CTX / 256);
    const int nu = NUL + (need_ctx ? NUC : 0);
    for (int u = blockIdx.x; u < nu; u += gridDim.x) {
        const bool lat = u < NUL; const int uu = lat ? u : u - NUL; const int nqb = lat ? SEQ / 256 : CTX / 256;
        const int b = uu / (NHC * nqb), hd = (uu / nqb) % NHC, qb = uu % nqb;
        const int kcol = C_KD + hd * 2 * DD, vcol = C_VD + hd * 2 * DD;
        const int qrow = (lat ? b * SEQ : RL + b * CTX) + 256 * qb + 32 * wave + r;
        const int nt = CTX / 64 + (lat ? SEQ / 64 : 0);
        bf16x8 Q[2][2];
#pragma unroll
        for (int j = 0; j < 2; ++j)
#pragma unroll
            for (int s = 0; s < 2; ++s) Q[j][s] = *(const bf16x8*)(C.P + (size_t)qrow * PROJ + C_QD + hd * 2 * DD + j * DD + 16 * s + 8 * h);
        f32x16 O[2][2]; float m[2]; f32x4 L[2];
#pragma unroll
        for (int j = 0; j < 2; ++j) { m[j] = 0.f; L[j] = f32x4{0.f, 0.f, 0.f, 0.f};
#pragma unroll
            for (int db = 0; db < 2; ++db)
#pragma unroll
                for (int i = 0; i < 16; ++i) O[j][db][i] = 0.f; }
        u32x4 kreg, vreg;
#define ATT_TROW(i) ((i) < CTX / 64 ? RL + b * CTX + 64 * (i) : b * SEQ + 64 * ((i) - CTX / 64))
        bf16x8 Kf[8];
        ATT_PROLOGUE(2);
        int s0 = 0, s1 = BUF_B, s2 = 2 * BUF_B;
#if PROBE_ATT
        unsigned long long pT0 = __builtin_readcyclecounter(), ptw = 0, ptb = 0;
#endif
        for (int i = 0; i < nt; ++i) {
#if PROBE_ATT
            { const unsigned long long t1 = __builtin_readcyclecounter(); asm volatile("s_waitcnt vmcnt(0)" ::: "memory"); ptw += __builtin_readcyclecounter() - t1; }
#endif
            if (i + 2 < nt) ATT_STG_STOREB(s2);
            if (i + 3 < nt) ATT_STG_LOAD(ATT_TROW(i + 3));
            const unsigned lb = (unsigned)(size_t)C.lds;
            flash_tile<2, 2>(lb + s0 + TILE_B, lb + s1, i + 1 < nt, Q, O, m, L, onesA, Kf, lane, false, 0, i == 0);
#if PROBE_ATT
            { const unsigned long long t1 = __builtin_readcyclecounter(); __syncthreads(); ptb += __builtin_readcyclecounter() - t1; }
#else
            __syncthreads();
#endif
            { const int t = s0; s0 = s1; s1 = s2; s2 = t; }
        }
#if PROBE_ATT
        if (l == 1 && u == 100 && tid == 64 * 3) { const float T = (float)(__builtin_readcyclecounter() - pT0);
            ((float*)(C.p.ws + WS_CTL))[8] = PROBE_ATT == 1 ? 1.0e4f * (float)ptw / T : PROBE_ATT == 2 ? 1.0e4f * (float)ptb / T : T / (float)nt; }
#endif
#undef ATT_TROW
        const float i0 = 1.0f / rowsum(L[0], lane), i1 = lam / rowsum(L[1], lane);
        float ss = 0.f;
#pragma unroll
        for (int db = 0; db < 2; ++db)
#pragma unroll
            for (int i = 0; i < 16; ++i) { const float y = O[0][db][i] * i0 - O[1][db][i] * i1; O[0][db][i] = y; ss += y * y; }
        const float rn = (1.0f - lam_init) / sqrtf(xsum32(ss) * (1.0f / (2 * DD)) + EPS);
        const float* sw = C.p.diff_subln + l * 2 * DD + 4 * h;
        bf16_t* op = C.MIX + (size_t)qrow * D + 768 + hd * 2 * DD;
#pragma unroll
        for (int db = 0; db < 2; ++db)
#pragma unroll
            for (int g = 0; g < 4; g += 2) { u32x2 w[2];
#pragma unroll
                for (int q = 0; q < 2; ++q) { const f32x4 s4 = *(const f32x4*)(sw + 32 * db + 8 * (g + q));
                    w[q].x = pk2(O[0][db][4 * (g + q)] * rn * s4[0], O[0][db][4 * (g + q) + 1] * rn * s4[1]); w[q].y = pk2(O[0][db][4 * (g + q) + 2] * rn * s4[2], O[0][db][4 * (g + q) + 3] * rn * s4[3]); }
                store_pair16(op + 32 * db + 8 * g, w[0], w[1], h); }
    }
}
#undef ATT_STG_LOAD
#undef ATT_STG_STORE
#undef ATT_STG_LOAD2
#undef ATT_STG_STORE2
#undef ATT_STG_STOREB
#undef ATT_PROLOGUE
}
__device__ __forceinline__ void phase_conv(const Ctx& C, int l, int nq) {
    const int tid = tid_l();
    const float* cw = C.p.conv_w + l * 3 * CONV_CH;
    for (long g = (long)blockIdx.x * NT + tid; g < (long)(nq / 8) * (CONV_CH / 8); g += (long)gridDim.x * NT) {
        const int row0 = (int)(g / (CONV_CH / 8)) * 8, c8 = (int)(g % (CONV_CH / 8)) * 8;
        const bool lat = row0 < RL; const int t0 = lat ? row0 % SEQ : (row0 - RL) % CTX, len = lat ? SEQ : CTX;
        float u[10][8];
#pragma unroll
        for (int i = 0; i < 10; ++i) { const int tt = t0 + i - 1;
            if (tt >= 0 && tt < len) { const bf16_t* pr = C.P + (size_t)(row0 + i - 1) * PROJ + c8; const u32x4 a = *(const u32x4*)(pr + C_CIN), c = *(const u32x4*)(pr + C_CC);
#pragma unroll
                for (int k = 0; k < 4; ++k) { u[i][2 * k] = __builtin_bit_cast(float, a[k] << 16) * __builtin_bit_cast(float, c[k] << 16); u[i][2 * k + 1] = __builtin_bit_cast(float, a[k] & 0xffff0000u) * __builtin_bit_cast(float, c[k] & 0xffff0000u); } }
            else {
#pragma unroll
                for (int k = 0; k < 8; ++k) u[i][k] = 0.f; } }
        float w[3][8];
#pragma unroll
        for (int j = 0; j < 3; ++j) { const f32x4 w0 = *(const f32x4*)(cw + j * CONV_CH + c8), w1 = *(const f32x4*)(cw + j * CONV_CH + c8 + 4);
#pragma unroll
            for (int k = 0; k < 4; ++k) { w[j][k] = w0[k]; w[j][4 + k] = w1[k]; } }
#pragma unroll
        for (int i = 0; i < 8; ++i) { const u32x4 gb = *(const u32x4*)(C.P + (size_t)(row0 + i) * PROJ + C_CB + c8); u32x4 o;
#pragma unroll
            for (int k = 0; k < 4; ++k) { const float y0 = w[0][2 * k] * u[i][2 * k] + w[1][2 * k] * u[i + 1][2 * k] + w[2][2 * k] * u[i + 2][2 * k];
                const float y1 = w[0][2 * k + 1] * u[i][2 * k + 1] + w[1][2 * k + 1] * u[i + 1][2 * k + 1] + w[2][2 * k + 1] * u[i + 2][2 * k + 1];
                o[k] = att::pk2(__builtin_bit_cast(float, gb[k] << 16) * y0, __builtin_bit_cast(float, gb[k] & 0xffff0000u) * y1); }
            *(u32x4*)(C.MIX + (size_t)(row0 + i) * D + 512 + c8) = o; }
    }
}
#ifndef ATT_A
#define ATT_A 1
#endif
#ifndef ATT_D
#define ATT_D 1
#endif
__device__ __forceinline__ void phase_mix_naive(const Ctx& C, int l, int nq) {
    const int tid = tid_l(), lane = tid & 63, wave = __builtin_amdgcn_readfirstlane(tid >> 6), gw = blockIdx.x * NWV + wave, NGW = gridDim.x * NWV; (void)lane; (void)gw; (void)NGW;
    const long g0 = (long)blockIdx.x * NT + tid, gs = (long)gridDim.x * NT; const float lam_init = 0.8f - 0.6f * expf(-0.3f * (float)l);
#if !ATT_A
    for (long g = g0; g < (long)nq * NHA; g += gs) b_attnA(g, C.P, C.p.attn_sink + l * NHA, C.MIX, nq);
#endif
#if !ATT_D
    for (long g = g0; g < (long)nq * NHC * 2; g += gs) b_attnD(g, C.P, C.TMP, nq);
#endif
    (void)g0; (void)gs;
}
__device__ __forceinline__ void phase_diffpost_naive(const Ctx& C, int l, int nq) {
    const int tid = tid_l(), lane = tid & 63, wave = __builtin_amdgcn_readfirstlane(tid >> 6), gw = blockIdx.x * NWV + wave, NGW = gridDim.x * NWV; (void)lane; (void)gw; (void)NGW;
    const long g0 = (long)blockIdx.x * NT + tid, gs = (long)gridDim.x * NT; const float lam_init = 0.8f - 0.6f * expf(-0.3f * (float)l);
    for (long g = g0; g < (long)nq * NHC; g += gs) b_diffpost(g, C.TMP, C.p.diff_lambda + l * 4 * DD, C.p.diff_subln + l * 2 * DD, lam_init, C.MIX, nq);
}

#ifndef DBL
#define DBL 0
#endif
#define REP(bit) for (int _rep = 0; _rep < (((DBL) & (bit)) ? 2 : 1); ++_rep)
constexpr int CVT_PER_WAVE = 60;
constexpr int NPH = 9, PH_L0 = 2, PH_FINAL = PH_L0 + DEPTH * NPH, PH_TOTAL = PH_FINAL + 1;
__global__ void __launch_bounds__(NT, 2) mega_fwd(Args args) {
    extern __shared__ __attribute__((aligned(16))) unsigned char lds_raw[];
    Ctx C;
    { int w = __builtin_amdgcn_readfirstlane(threadIdx.x >> 6); asm volatile("" : "+s"(w)); C.wv = w; }
    C.p.x = args.in[0]; C.p.c = args.in[1]; C.p.ctx = args.in[2]; C.p.c_ctx = args.in[3]; C.p.w_ada = args.in[4]; C.p.b_ada = args.in[5]; C.p.norm1 = args.in[6]; C.p.norm2 = args.in[7];
    C.p.w_in = args.in[8]; C.p.w_out = args.in[9]; C.p.attn_sink = args.in[10]; C.p.conv_w = args.in[11]; C.p.diff_lambda = args.in[12]; C.p.diff_subln = args.in[13]; C.p.router = args.in[14];
    C.p.w_gate = args.in[15]; C.p.w_up = args.in[16]; C.p.w_down = args.in[17]; C.p.norm_final = args.in[18];
    C.p.out = args.out; C.p.ws = args.ws;
    C.lds = (LAS unsigned char*)lds_raw;
    unsigned char* ws = args.ws;
    C.tab = (float*)(ws + WS_TAB); C.mod = (float*)(ws + WS_MOD); C.aff = (float*)(ws + WS_AFF); C.sel = (int*)(ws + WS_SEL); C.gate = (float*)(ws + WS_GATE); C.tokslot = (int*)(ws + WS_TOKSLOT);
    C.xc = (float*)(ws + WS_XC); C.xl = args.out; C.win = (bf16_t*)(ws + WS_WIN); C.wout = (bf16_t*)(ws + WS_WOUT);
    C.P = (bf16_t*)(ws + WS_R1); C.H = (bf16_t*)(ws + WS_R1); C.Y = (bf16_t*)(ws + WS_R2); C.MIX = (bf16_t*)(ws + WS_R2); C.HX2 = (bf16_t*)(ws + WS_R2 + (size_t)RALL * D * 2); C.TMP = (float*)C.HX2;
    C.HX = (bf16_t*)(ws + WS_R3); C.XB = (bf16_t*)(ws + WS_XB);
    volatile LAS unsigned* misc = (volatile LAS unsigned*)(C.lds + LDS_MISC);
    { const int t0 = tid_l(); if (t0 < 64) misc[t0] = 0u; }
    __syncthreads();
    const int lo = args.ph_lo, hi = args.ph_hi;
    XcdBarrier bar; bar.bar = (unsigned*)(ws + WS_CTL) + CW_BAR; bar.x = 0; bar.st = misc; bar.wv = C.wv;
    if (hi - lo > 1) bar = xcd_barrier_post((unsigned*)(ws + WS_CTL) + CW_BAR, misc, C.wv);
#define IN(k) (lo <= (k) && (k) < hi)
#define SEAM(k) do { if (IN(k) && IN((k) + 1)) xcd_barrier(bar); } while (0)
    const int G = (int)gridDim.x, bid = (int)blockIdx.x;
    if (IN(0)) REP(512) phase_prologue(C);
    SEAM(0);
    if (IN(1)) phase_prologue_b(C);
    SEAM(1);
    for (int l = 0; l < DEPTH; ++l) {
        const int pb = PH_L0 + l * NPH; const bool need_ctx = l < DEPTH - 1; const int nq = need_ctx ? RALL : RL;
        const float* modl = C.mod + (size_t)l * (NB + 1) * 6 * D;
        const int nu1 = (RALL / 256) * (PROJ / 256), G1 = (nu1 + (nu1 + G - 1) / G - 1) / ((nu1 + G - 1) / G);
        const int nu4 = (nq / 256) * (D / 256), G4 = (nu4 + (nu4 + G - 1) / G - 1) / ((nu4 + G - 1) / G);
        const int cn1 = (G - G1) * NWV * CVT_PER_WAVE < CVT_ITEMS ? (G - G1) * NWV * CVT_PER_WAVE : CVT_ITEMS;
        const int cn4 = cn1 + (G - G4) * NWV * CVT_PER_WAVE < CVT_ITEMS ? cn1 + (G - G4) * NWV * CVT_PER_WAVE : CVT_ITEMS;
        if (IN(pb + 0)) { { const int wv_ = C.wv; REP(256) phase_cvt_experts(C, l, cn4, CVT_ITEMS, bid * NWV + wv_, G * NWV); } if (l == 0) phase_rowA<false, true>(C, 0); else phase_rowA<false, false>(C, l); if ((DBL) & 1024) { if (l == 0) phase_rowA<false, true>(C, 0); else phase_rowA<false, false>(C, l, 0.0f); } }
        SEAM(pb + 0);
        if (IN(pb + 1)) { if (bid < G1) { pg::GemmD g{(const char*)C.HX, nullptr, (const char*)C.win + (size_t)l * PROJ * D, 0, D / 2}; pg::Order S; S.init(RALL / 256, PROJ / 256, G1, bid, 0);
            pg::EpiP E{C.P, C.tab, (const float*)(ws + WS_HXS), (const float*)(ws + WS_CTL + CTL_WINMAX) + l * 256}; REP(1) pg::gemm_phase<pg::EpiP, false, 2>(C.lds, g, S, E, C.wv); }
            else phase_cvt_experts(C, l, 0, cn1, (bid - G1) * NWV + C.wv, (G - G1) * NWV); }
        SEAM(pb + 1);
        if (IN(pb + 2)) {
#if ATT_A
            REP(2) att::phase_attnA(C, l, need_ctx);
#endif
#if ATT_D
            REP(4) att::phase_attnD(C, l, need_ctx);
#endif
            phase_mix_naive(C, l, nq); REP(128) phase_conv(C, l, nq); }
        SEAM(pb + 2);
#if !ATT_D
        if (IN(pb + 3)) phase_diffpost_naive(C, l, nq);
        SEAM(pb + 3);
#endif
        if (IN(pb + 4)) { if (bid < G4) { pg::GemmD g{(const char*)C.MIX, nullptr, (const char*)(C.wout + (size_t)l * D * D), 0, D}; pg::Order S; S.init(nq / 256, D / 256, G4, bid, 0);
            pg::EpiX E{C.XB, modl, 1.0f}; pg::gemm_phase<pg::EpiX, false>(C.lds, g, S, E, C.wv);
            if ((DBL) & 2048) { pg::EpiX E0{C.XB, modl, 0.0f}; pg::gemm_phase<pg::EpiX, false>(C.lds, g, S, E0, C.wv); } }
            else phase_cvt_experts(C, l, cn1, cn4, (bid - G4) * NWV + C.wv, (G - G4) * NWV); }
        SEAM(pb + 4);
        if (IN(pb + 5)) REP(8) phase_rowB(C, l, nq);
        SEAM(pb + 5);
        if (IN(pb + 6)) REP(16) phase_select(C, need_ctx);
        SEAM(pb + 6);
        const int tpe = need_ctx ? pg::TPE_FULL : SLOTS_L / 256;
        if (IN(pb + 7)) { pg::GemmD g{(const char*)C.HX2, C.sel, (const char*)(ws + WS_WGU + (size_t)(l & 1) * NE * 2 * FF * D), (size_t)2 * FF * D, D / 2}; pg::Order S; S.init(NE * tpe, 2 * FF / 256, G, bid, tpe);
            pg::EpiH E{(unsigned char*)C.H}; REP(32) pg::gemm_phase<pg::EpiH, true, 1>(C.lds, g, S, E, C.wv); }
        SEAM(pb + 7);
        if (IN(pb + 8)) { pg::GemmD g{(const char*)C.H, nullptr, (const char*)(ws + WS_WD + (size_t)(l & 1) * NE * D * FF), (size_t)D * FF, FF / 2}; pg::Order S; S.init(NE * tpe, D / 256, G, bid, tpe);
            pg::EpiY E{(unsigned char*)C.Y, C.gate}; REP(64) pg::gemm_phase<pg::EpiY, false, 1>(C.lds, g, S, E, C.wv); }
        SEAM(pb + 8);
    }
    if (IN(PH_FINAL)) phase_rowA<true, false>(C, DEPTH);
#if PROBE_ATT
    if (hi - lo > 1) xcd_barrier(bar);
    if (bid == 100 && tid_l() == 0) { asm volatile("s_waitcnt vmcnt(0)" ::: "memory"); C.p.out[0] = ((const float*)(C.p.ws + WS_CTL))[8]; }
#endif
#undef IN
#undef SEAM
}
#endif

#ifndef HOST_TEST
#ifndef MODE
#define MODE 2
#endif
extern "C" void kernel_launch(void* const* d_in, const int* in_sizes, int n_in, void* d_out, int out_size, void* d_ws, size_t ws_size, hipStream_t stream) {
    if (n_in != 19 || out_size != RL * D || ws_size < WS_END) { fprintf(stderr, "kernel_launch: unexpected shapes (n_in %d out %d ws %zu need %zu)\n", n_in, out_size, ws_size, (size_t)WS_END); return; }
#if MODE == 0
    Ptrs p{};
    const float** f = (const float**)&p;
    for (int i = 0; i < 19; ++i) f[i] = (const float*)d_in[i];
    p.out = (float*)d_out; p.ws = (unsigned char*)d_ws;
    forward(p, stream);
#else
    static int grid = 0;
    if (grid == 0) {
        int dev = 0, cus = 0;
        if (hipGetDevice(&dev) != hipSuccess || hipDeviceGetAttribute(&cus, hipDeviceAttributeMultiprocessorCount, dev) != hipSuccess) { fprintf(stderr, "kernel_launch: device query failed\n"); grid = -1; return; }
        if (hipFuncSetAttribute((const void*)mega_fwd, hipFuncAttributeMaxDynamicSharedMemorySize, LDS_BYTES) != hipSuccess) { fprintf(stderr, "kernel_launch: hipFuncSetAttribute failed\n"); grid = -1; return; }
        int per_cu = 0;
        if (hipOccupancyMaxActiveBlocksPerMultiprocessor(&per_cu, (const void*)mega_fwd, NT, LDS_BYTES) != hipSuccess || per_cu < 1) fprintf(stderr, "kernel_launch: occupancy query reports %d blocks per CU\n", per_cu);
        (void)hipGetLastError();
        grid = cus;
    }
    if (grid < 0) return;
    if (hipMemsetAsync((char*)d_ws + WS_CTL, 0, CTL_BYTES, stream) != hipSuccess) { fprintf(stderr, "kernel_launch: memset failed\n"); return; }
    Args a{};
    for (int i = 0; i < 19; ++i) a.in[i] = (const float*)d_in[i];
    a.out = (float*)d_out; a.ws = (unsigned char*)d_ws;
#if MODE == 2
    a.ph_lo = 0; a.ph_hi = PH_TOTAL;
    hipLaunchKernelGGL(mega_fwd, dim3(grid), dim3(NT), LDS_BYTES, stream, a);
#else
    for (int ph = 0; ph < PH_TOTAL; ++ph) { a.ph_lo = ph; a.ph_hi = ph + 1; hipLaunchKernelGGL(mega_fwd, dim3(grid), dim3(NT), LDS_BYTES, stream, a); }
#endif
    const hipError_t le = hipPeekAtLastError();
    if (le != hipSuccess) fprintf(stderr, "kernel_launch: launch failed: %s\n", hipGetErrorName(le));
#endif
}
#else
#include <vector>
#include <string>
static std::vector<float> rd(const std::string& fn) { FILE* f = fopen(fn.c_str(), "rb"); if (!f) { perror(fn.c_str()); exit(1); } fseek(f, 0, SEEK_END); long n = ftell(f); fseek(f, 0, SEEK_SET); std::vector<float> v(n / 4); if (fread(v.data(), 1, n, f) != (size_t)n) exit(1); fclose(f); return v; }
int main(int argc, char** argv) {
    std::string dir = argv[1]; std::vector<std::vector<float>> in(19);
    for (int i = 0; i < 19; ++i) in[i] = rd(dir + "/in" + std::to_string(i) + ".bin");
    std::vector<float> out((size_t)RL * D); std::vector<unsigned char> ws(WS_END, 0xAA);
    Ptrs p{}; const float** f = (const float**)&p; for (int i = 0; i < 19; ++i) f[i] = in[i].data();
    p.out = out.data(); p.ws = ws.data();
    forward(p, 0);
    FILE* fo = fopen((dir + "/out.bin").c_str(), "wb"); fwrite(out.data(), 4, out.size(), fo); fclose(fo);
    printf("done, ws bytes %zu\n", (size_t)WS_END); return 0;
}
#endif
```
